# Optimizing an MI355X kernel written in HIP

```python
import math
import jax, jax.numpy as jnp
from jax import lax
import numpy as np

D_MODEL = 1024
BATCH = 32
SEQ = 2048
DEPTH = 1

MEM_LEN = 256
D_MIX = D_MODEL
DIFF_WIDTH = D_MIX // 2
DIFF_HEADS = 4
DIFF_V_DIM = DIFF_WIDTH // DIFF_HEADS
DIFF_QK_DIM = DIFF_V_DIM // 2
MLSTM_WIDTH = D_MIX - DIFF_WIDTH
MLSTM_HEADS = 4
MLSTM_V_DIM = MLSTM_WIDTH // MLSTM_HEADS
MLSTM_QK_DIM = MLSTM_V_DIM // 2
CONV_K = 4
CHUNK = 128
Q_BLOCK = 128
IN_SIZES = (DIFF_HEADS * 2 * DIFF_QK_DIM, DIFF_HEADS * 2 * DIFF_QK_DIM, DIFF_HEADS * DIFF_V_DIM,
            2 * MLSTM_HEADS * MLSTM_QK_DIM, MLSTM_WIDTH, MLSTM_WIDTH, MLSTM_HEADS, MLSTM_HEADS)
D_IN = sum(IN_SIZES)
XATTN_HEADS = 4
XATTN_HEAD_DIM = D_MODEL // XATTN_HEADS
N_EXPERTS = 32
TOP_K = 4
D_EXPERT = D_MODEL
SWIGLU_ALPHA = 1.702
SWIGLU_LIMIT = 7.0
MOE_BLOCK = 512
RMS_EPS = 1e-5

kernel_name = 'hybrid_mlstm_diffattn_moe_block'


def rmsnorm(x, g):
    xf = x.astype(jnp.float32)
    y = xf * lax.rsqrt(jnp.mean(xf * xf, axis=-1, keepdims=True) + RMS_EPS)
    return (y * g.astype(jnp.float32)).astype(x.dtype)


def causal_dwconv_silu(u, w, b):
    s = u.shape[1]
    up = jnp.pad(u, ((0, 0), (CONV_K - 1, 0), (0, 0)))
    y = b + sum(up[:, j:j + s] * w[j] for j in range(CONV_K))
    return jax.nn.silu(y)


def diff_attention(q1, q2, k1, k2, v, lam):
    b, h, s, d = q1.shape
    nb = s // Q_BLOCK
    scale = d ** -0.5
    kpos = jnp.arange(s)

    def blocks(t):
        return jnp.moveaxis(t.reshape(b, h, nb, Q_BLOCK, d), 2, 0)

    def one_block(args):
        q1b, q2b, start = args
        qpos = start + jnp.arange(Q_BLOCK)
        mask = kpos[None, :] <= qpos[:, None]

        def probs(qb, k):
            sc = jnp.einsum('bhqd,bhkd->bhqk', qb, k).astype(jnp.float32) * scale
            return jax.nn.softmax(jnp.where(mask, sc, -jnp.inf), axis=-1)

        a = probs(q1b, k1) - lam * probs(q2b, k2)
        return jnp.einsum('bhqk,bhkv->bhqv', a.astype(v.dtype), v)

    out = lax.map(one_block, (blocks(q1), blocks(q2), jnp.arange(nb) * Q_BLOCK))
    return jnp.moveaxis(out, 0, 2).reshape(b, h, s, v.shape[-1])


def mlstm_chunkwise(q, k, v, ig, lf):
    b, h, s, dk = q.shape
    dv = v.shape[-1]
    nc = s // CHUNK

    def to_chunks(t):
        return jnp.moveaxis(t.reshape(t.shape[:2] + (nc, CHUNK) + t.shape[3:]), 2, 0)

    causal = jnp.tril(jnp.ones((CHUNK, CHUNK), dtype=bool))

    def step(carry, inp):
        c_st, n_st, m_st = carry
        q_, k_, v_, i_, f_ = inp
        bcum = jnp.cumsum(f_, axis=-1)
        dmat = jnp.where(causal, bcum[..., :, None] - bcum[..., None, :] + i_[..., None, :], -jnp.inf)
        inter = bcum + m_st[..., None]
        m_t = jnp.maximum(inter, jnp.max(dmat, axis=-1))
        w = jnp.einsum('bhtd,bhsd->bhts', q_, k_) * jnp.exp(dmat - m_t[..., None])
        g = jnp.exp(inter - m_t)
        num = g[..., None] * jnp.einsum('bhtd,bhde->bhte', q_, c_st) + jnp.einsum('bhts,bhse->bhte', w, v_)
        den = g * jnp.einsum('bhtd,bhd->bht', q_, n_st) + jnp.sum(w, axis=-1)
        h_t = num / jnp.maximum(jnp.abs(den), jnp.exp(-m_t))[..., None]
        b_last = bcum[..., -1]
        gs = b_last[..., None] - bcum + i_
        m_new = jnp.maximum(b_last + m_st, jnp.max(gs, axis=-1))
        decay = jnp.exp(b_last + m_st - m_new)
        ws = jnp.exp(gs - m_new[..., None])
        c_new = decay[..., None, None] * c_st + jnp.einsum('bhs,bhsd,bhse->bhde', ws, k_, v_)
        n_new = decay[..., None] * n_st + jnp.einsum('bhs,bhsd->bhd', ws, k_)
        return (c_new, n_new, m_new), h_t

    init = (jnp.zeros((b, h, dk, dv), jnp.float32), jnp.zeros((b, h, dk), jnp.float32),
            jnp.zeros((b, h), jnp.float32))
    _, hs = lax.scan(step, init, (to_chunks(q), to_chunks(k), to_chunks(v), to_chunks(ig), to_chunks(lf)))
    return jnp.moveaxis(hs, 0, 2).reshape(b, h, s, dv)


def hybrid_mixer(xn, w_in, conv_w, conv_b, b_igate, b_fgate, mlstm_norm_g,
                 lambda_q1, lambda_k1, lambda_q2, lambda_k2, diff_norm_g, w_out, lambda_init):
    b, s, _ = xn.shape
    f32 = jnp.float32
    proj = xn @ w_in
    cuts = np.cumsum(IN_SIZES)[:-1].tolist()
    dq, dk, dv, mqk, mv, mo, mi, mf = jnp.split(proj, cuts, axis=-1)

    def pair_heads(t):
        t = t.reshape(b, s, DIFF_HEADS, 2, DIFF_QK_DIM)
        return t[..., 0, :].transpose(0, 2, 1, 3), t[..., 1, :].transpose(0, 2, 1, 3)

    q1, q2 = pair_heads(dq)
    k1, k2 = pair_heads(dk)
    v = dv.reshape(b, s, DIFF_HEADS, DIFF_V_DIM).transpose(0, 2, 1, 3)
    lam = (jnp.exp(jnp.sum(lambda_q1.astype(f32) * lambda_k1.astype(f32)))
           - jnp.exp(jnp.sum(lambda_q2.astype(f32) * lambda_k2.astype(f32))) + lambda_init)
    od = diff_attention(q1, q2, k1, k2, v, lam)
    od = rmsnorm(od, diff_norm_g.reshape(DIFF_HEADS, 1, DIFF_V_DIM)) * (1.0 - lambda_init)
    od = od.transpose(0, 2, 1, 3).reshape(b, s, DIFF_WIDTH).astype(xn.dtype)

    qk = causal_dwconv_silu(mqk, conv_w, conv_b)
    mq, mk = jnp.split(qk, 2, axis=-1)

    def heads(t, d):
        return t.reshape(b, s, MLSTM_HEADS, d).transpose(0, 2, 1, 3).astype(f32)

    q = heads(mq, MLSTM_QK_DIM) * (MLSTM_QK_DIM ** -0.5)
    k = heads(mk, MLSTM_QK_DIM)
    vm = heads(mv, MLSTM_V_DIM)
    ig = (mi + b_igate).astype(f32).transpose(0, 2, 1)
    lf = jax.nn.log_sigmoid((mf + b_fgate).astype(f32)).transpose(0, 2, 1)
    hm = mlstm_chunkwise(q, k, vm, ig, lf)
    hm = rmsnorm(hm, mlstm_norm_g.reshape(MLSTM_HEADS, 1, MLSTM_V_DIM))
    hm = hm.transpose(0, 2, 1, 3).reshape(b, s, MLSTM_WIDTH)
    hm = (hm * jax.nn.sigmoid(mo.astype(f32))).astype(xn.dtype)

    return jnp.concatenate([od, hm], axis=-1) @ w_out


def cross_attention(xn, memn, w_cq, w_ckv, w_co):
    b, s, _ = xn.shape
    m = memn.shape[1]
    q = (xn @ w_cq).reshape(b, s, XATTN_HEADS, XATTN_HEAD_DIM)
    k, v = jnp.split(memn @ w_ckv, 2, axis=-1)
    k = k.reshape(b, m, XATTN_HEADS, XATTN_HEAD_DIM)
    v = v.reshape(b, m, XATTN_HEADS, XATTN_HEAD_DIM)
    sc = jnp.einsum('bqhd,bkhd->bhqk', q, k).astype(jnp.float32) * (XATTN_HEAD_DIM ** -0.5)
    p = jax.nn.softmax(sc, axis=-1)
    o = jnp.einsum('bhqk,bkhd->bqhd', p.astype(v.dtype), v).reshape(b, s, D_MODEL)
    return o @ w_co


def clamped_swiglu(hcat):
    hf = hcat.astype(jnp.float32)
    glu = jnp.minimum(hf[..., ::2], SWIGLU_LIMIT)
    lin = jnp.clip(hf[..., 1::2], -SWIGLU_LIMIT, SWIGLU_LIMIT)
    return (glu * jax.nn.sigmoid(SWIGLU_ALPHA * glu) * (lin + 1.0)).astype(hcat.dtype)


def moe_ffn(xn, w_router, b_router, w1, b1, w2, b2):
    b, s, d = xn.shape
    t = b * s
    a = t * TOP_K
    xf = xn.reshape(t, d)
    logits = xf.astype(jnp.float32) @ w_router.astype(jnp.float32) + b_router.astype(jnp.float32)
    top_v, top_e = lax.top_k(logits, TOP_K)
    gates = jax.nn.softmax(top_v, axis=-1)
    e_flat = top_e.reshape(a)
    order = jnp.argsort(e_flat)
    e_sorted = e_flat[order]
    tok_sorted = (order // TOP_K).astype(jnp.int32)
    gate_sorted = gates.reshape(a)[order]
    counts = jnp.bincount(e_flat, length=N_EXPERTS)
    padded = (counts + MOE_BLOCK - 1) // MOE_BLOCK * MOE_BLOCK
    start = jnp.cumsum(counts) - counts
    pend = jnp.cumsum(padded)
    pstart = pend - padded
    dest = pstart[e_sorted] + jnp.arange(a) - start[e_sorted]
    n_blocks = -(-a // MOE_BLOCK) + N_EXPERTS
    n_pad = n_blocks * MOE_BLOCK
    tok_pad = jnp.full((n_pad,), t, jnp.int32).at[dest].set(tok_sorted)
    gate_pad = jnp.zeros((n_pad,), jnp.float32).at[dest].set(gate_sorted)
    blk_expert = jnp.minimum(jnp.searchsorted(pend, jnp.arange(n_blocks) * MOE_BLOCK, side='right'),
                             N_EXPERTS - 1)
    x_ext = jnp.concatenate([xf, jnp.zeros((1, d), xf.dtype)], axis=0)

    def body(acc, inp):
        tok, g, e = inp
        hcat = x_ext[tok] @ w1[e] + b1[e]
        y = clamped_swiglu(hcat) @ w2[e] + b2[e]
        return acc.at[tok].add(y.astype(jnp.float32) * g[:, None]), None

    acc, _ = lax.scan(body, jnp.zeros((t + 1, d), jnp.float32),
                      (tok_pad.reshape(n_blocks, MOE_BLOCK), gate_pad.reshape(n_blocks, MOE_BLOCK), blk_expert))
    return acc[:t].reshape(b, s, d).astype(xn.dtype)


def setup_inputs(seed: int = 0) -> dict:
    key = jax.random.key(seed)
    ks = jax.random.split(key, 32)
    f32 = jnp.float32

    def nrm(k, shape, scale):
        return jax.random.normal(k, shape, f32) * scale

    def gain(k, n):
        return 1.0 + 0.02 * jax.random.normal(k, (DEPTH, n), f32)

    return {
        'x': nrm(ks[0], (BATCH, SEQ, D_MODEL), 1.0),
        'mem': nrm(ks[1], (BATCH, MEM_LEN, D_MODEL), 1.0),
        'norm_mix_g': gain(ks[2], D_MODEL),
        'w_in': nrm(ks[3], (DEPTH, D_MODEL, D_IN), D_MODEL ** -0.5),
        'conv_w': nrm(ks[4], (DEPTH, CONV_K, 2 * MLSTM_HEADS * MLSTM_QK_DIM), CONV_K ** -0.5),
        'conv_b': nrm(ks[5], (DEPTH, 2 * MLSTM_HEADS * MLSTM_QK_DIM), 0.02),
        'b_igate': nrm(ks[6], (DEPTH, MLSTM_HEADS), 0.1),
        'b_fgate': jnp.linspace(3.0, 6.0, MLSTM_HEADS, dtype=f32)[None, :] + nrm(ks[7], (DEPTH, MLSTM_HEADS), 0.1),
        'mlstm_norm_g': gain(ks[8], MLSTM_WIDTH),
        'lambda_q1': nrm(ks[9], (DEPTH, DIFF_QK_DIM), 0.1),
        'lambda_k1': nrm(ks[10], (DEPTH, DIFF_QK_DIM), 0.1),
        'lambda_q2': nrm(ks[11], (DEPTH, DIFF_QK_DIM), 0.1),
        'lambda_k2': nrm(ks[12], (DEPTH, DIFF_QK_DIM), 0.1),
        'diff_norm_g': gain(ks[13], DIFF_WIDTH),
        'w_out': nrm(ks[14], (DEPTH, D_MIX, D_MODEL), D_MIX ** -0.5),
        'norm_xattn_g': gain(ks[15], D_MODEL),
        'norm_mem_g': gain(ks[16], D_MODEL),
        'w_cq': nrm(ks[17], (DEPTH, D_MODEL, D_MODEL), D_MODEL ** -0.5),
        'w_ckv': nrm(ks[18], (DEPTH, D_MODEL, 2 * D_MODEL), D_MODEL ** -0.5),
        'w_co': nrm(ks[19], (DEPTH, D_MODEL, D_MODEL), D_MODEL ** -0.5),
        'norm_ffn_g': gain(ks[20], D_MODEL),
        'w_router': nrm(ks[21], (DEPTH, D_MODEL, N_EXPERTS), D_MODEL ** -0.5),
        'b_router': nrm(ks[22], (DEPTH, N_EXPERTS), 0.01),
        'w1': nrm(ks[23], (DEPTH, N_EXPERTS, D_MODEL, 2 * D_EXPERT), D_MODEL ** -0.5),
        'b1': nrm(ks[24], (DEPTH, N_EXPERTS, 2 * D_EXPERT), 0.01),
        'w2': nrm(ks[25], (DEPTH, N_EXPERTS, D_EXPERT, D_MODEL), D_EXPERT ** -0.5),
        'b2': nrm(ks[26], (DEPTH, N_EXPERTS, D_MODEL), 0.01),
        'norm_final_g': 1.0 + 0.02 * jax.random.normal(ks[27], (D_MODEL,), f32),
    }


def reference(x, mem, norm_mix_g, w_in, conv_w, conv_b, b_igate, b_fgate, mlstm_norm_g,
              lambda_q1, lambda_k1, lambda_q2, lambda_k2, diff_norm_g, w_out,
              norm_xattn_g, norm_mem_g, w_cq, w_ckv, w_co,
              norm_ffn_g, w_router, b_router, w1, b1, w2, b2, norm_final_g):
    h = x
    for l in range(DEPTH):
        lambda_init = 0.8 - 0.6 * math.exp(-0.3 * l)
        h = h + hybrid_mixer(rmsnorm(h, norm_mix_g[l]), w_in[l], conv_w[l], conv_b[l], b_igate[l], b_fgate[l],
                             mlstm_norm_g[l], lambda_q1[l], lambda_k1[l], lambda_q2[l], lambda_k2[l],
                             diff_norm_g[l], w_out[l], lambda_init).astype(h.dtype)
        h = h + cross_attention(rmsnorm(h, norm_xattn_g[l]), rmsnorm(mem, norm_mem_g[l]),
                                w_cq[l], w_ckv[l], w_co[l]).astype(h.dtype)
        h = h + moe_ffn(rmsnorm(h, norm_ffn_g[l]), w_router[l], b_router[l], w1[l], b1[l],
                        w2[l], b2[l]).astype(h.dtype)
    return rmsnorm(h, norm_final_g)
```

```cpp
#include <hip/hip_runtime.h>
#include <cstdio>
#include <cstdint>
#include <cmath>

#define GAS __attribute__((address_space(1)))
#define LAS __attribute__((address_space(3)))
typedef unsigned short bf16_t;
typedef short bf16x8 __attribute__((ext_vector_type(8)));
typedef float f32x4 __attribute__((ext_vector_type(4)));
typedef float f32x2 __attribute__((ext_vector_type(2)));
typedef unsigned u32x4 __attribute__((ext_vector_type(4)));
typedef unsigned u32x2 __attribute__((ext_vector_type(2)));
typedef int i32x8 __attribute__((ext_vector_type(8)));
typedef int i32x4 __attribute__((ext_vector_type(4)));

constexpr int BATCH = 32, SEQ = 2048, DM = 1024, T = BATCH * SEQ, MEMLEN = 256, MROWS = BATCH * MEMLEN;
constexpr int NPROJ = 3072, DIN = 3080, NP2 = 2048;
constexpr int NEXP = 32, TOPK = 4;
constexpr float EPS = 1e-5f;
constexpr float LAMBDA_INIT = 0.2f;

constexpr size_t MiB = 1u << 20;
constexpr size_t WS_CTL = 0, CTL_ZERO_BYTES = 64 * 1024;
constexpr size_t WS_RSTDX = 1 * MiB;
constexpr size_t WS_RSTDM = WS_RSTDX + (size_t)T * 4;
constexpr size_t WS_B1P = WS_RSTDM + (size_t)MROWS * 4;
constexpr size_t WS_MISC = WS_B1P + (size_t)NEXP * 2048 * 4;
constexpr size_t WS_RSTD2 = WS_MISC + 4096;
static_assert(WS_RSTD2 + (size_t)T * 4 <= 2 * MiB, "small region");
constexpr size_t WS_SSP1 = 2 * MiB;
constexpr size_t WS_SSP2 = 6 * MiB;
constexpr size_t WS_GATES = 10 * MiB;
constexpr size_t WS_TOKMAP = 12 * MiB;
constexpr size_t WS_GATEV = 13 * MiB;
constexpr size_t WS_LIST = 14 * MiB;
constexpr size_t WS_WIN = 24 * MiB;
constexpr size_t WS_WOUT = 30 * MiB;
constexpr size_t WS_WCQ = 32 * MiB;
constexpr size_t WS_WCKV = 34 * MiB;
constexpr size_t WS_WCO = 38 * MiB;
constexpr size_t WS_WR = 40 * MiB;
constexpr size_t WS_W1 = 64 * MiB;
constexpr size_t WS_H2F = 128 * MiB;
constexpr size_t WS_W2 = 192 * MiB;
constexpr size_t WS_XB = 256 * MiB;
constexpr size_t WS_PROJ = 384 * MiB;
constexpr size_t WS_H1F = 640 * MiB;
constexpr size_t WS_VT1 = 640 * MiB;
constexpr size_t WS_CAT = 768 * MiB;
constexpr size_t WS_MST = 896 * MiB;
constexpr size_t WS_MEMB = 962 * MiB;
constexpr size_t WS_KV = 978 * MiB;
constexpr size_t WS_VT2 = 994 * MiB;
constexpr size_t WS_QM = 128 * MiB;
constexpr size_t WS_KM = 160 * MiB;
constexpr size_t WS_CSTB = 224 * MiB;
constexpr size_t WS_BC = 1010 * MiB;
constexpr size_t WS_AV = 1011 * MiB;
constexpr size_t WS_AM = 1012 * MiB;
constexpr size_t WS_NLOC = 1013 * MiB;
constexpr size_t WS_NST = WS_NLOC + 512 * 1024;
constexpr size_t WS_CH = 1014 * MiB;
constexpr size_t WS_MSTATE = WS_CH + 64 * 1024;
constexpr size_t WS_Y = 256 * MiB;
constexpr size_t WS_HID = 512 * MiB;
constexpr size_t WS_HID1 = 896 * MiB;
constexpr size_t WS_END = 1024 * MiB;

constexpr int CW_CNT = 64;
constexpr int CW_BAR = 4096;
static_assert((CW_BAR + 3456) * 4 <= (int)CTL_ZERO_BYTES, "control words inside the per-call memset");

__device__ __forceinline__ float bf2f(bf16_t b) { return __uint_as_float(((unsigned)b) << 16); }
__device__ __forceinline__ unsigned f2bf(float f) { unsigned u = __float_as_uint(f); return (u + 0x7fffu + ((u >> 16) & 1u)) >> 16; }
__device__ __forceinline__ unsigned cvt_pk_bf16(float lo, float hi) { unsigned r; asm volatile("v_cvt_pk_bf16_f32 %0, %1, %2" : "=v"(r) : "v"(lo), "v"(hi)); return r; }
__device__ __forceinline__ float x32_sum(float v) { auto r = __builtin_amdgcn_permlane32_swap(__float_as_uint(v), __float_as_uint(v), false, false); return __uint_as_float(r[0]) + __uint_as_float(r[1]); }
__device__ __forceinline__ float x32_max(float v) { auto r = __builtin_amdgcn_permlane32_swap(__float_as_uint(v), __float_as_uint(v), false, false); return fmaxf(__uint_as_float(r[0]), __uint_as_float(r[1])); }
__device__ __forceinline__ float x32_other(float v, int hh) { auto r = __builtin_amdgcn_permlane32_swap(__float_as_uint(v), __float_as_uint(v), false, false); return hh ? __uint_as_float(r[0]) : __uint_as_float(r[1]); }
__device__ __forceinline__ float x16_sum(float v) { auto r = __builtin_amdgcn_permlane16_swap(__float_as_uint(v), __float_as_uint(v), false, false); return __uint_as_float(r[0]) + __uint_as_float(r[1]); }
__device__ __forceinline__ float row16_sum(float v) {
    v += __uint_as_float((unsigned)__builtin_amdgcn_update_dpp(0, (int)__float_as_uint(v), 0xB1, 0xf, 0xf, true));
    v += __uint_as_float((unsigned)__builtin_amdgcn_update_dpp(0, (int)__float_as_uint(v), 0x4E, 0xf, 0xf, true));
    v += __uint_as_float((unsigned)__builtin_amdgcn_update_dpp(0, (int)__float_as_uint(v), 0x141, 0xf, 0xf, true));
    v += __uint_as_float((unsigned)__builtin_amdgcn_update_dpp(0, (int)__float_as_uint(v), 0x140, 0xf, 0xf, true));
    return v; }
__device__ __forceinline__ float wave_sum(float v) { return x32_sum(x16_sum(row16_sum(v))); }
__device__ __forceinline__ int lane_id() { int l; asm volatile("v_mbcnt_lo_u32_b32 %0, -1, 0\n\tv_mbcnt_hi_u32_b32 %0, -1, %0" : "=v"(l)); return l; }
__device__ __forceinline__ float c8(float x) { return __builtin_amdgcn_fmed3f(x, -448.0f, 448.0f); }
__device__ __forceinline__ float lo_bf(unsigned w) { return __uint_as_float(w << 16); }
__device__ __forceinline__ float hi_bf(unsigned w) { return __uint_as_float(w & 0xffff0000u); }

namespace pg8 {
constexpr int BM = 256, BK = 64, HALF = 128, HTB = HALF * BK * 2, STAGE_BYTES = 8 * HTB, NXCD = 8, WGM = 8, KD = 1024, NT = KD / BK;
__host__ __device__ __forceinline__ int lds_byte(int r, int c) { const int st = (r >> 4) * 2 + (c >> 5), rr = r & 15, cc = c & 31, ob = rr * 64 + cc * 2; return st * 1024 + (ob ^ (((ob >> 9) & 1) << 5)); }
__host__ __device__ __forceinline__ void stage_rc(int b, int& R, int& C) { const int st = b / 1024, sb = b % 1024, swz = sb ^ (((sb >> 9) & 1) << 5); R = (st >> 1) * 16 + swz / 64; C = (st & 1) * 32 + (swz % 64) / 2; }
__host__ __device__ __forceinline__ int perm32(int rho) { const int n = rho >> 4, i = rho & 15; return 8 * (i >> 2) + 4 * n + (i & 3); }

struct Unit { const char* A; const char* B; int pm, pn, e, nvalid, y0, aux; };

__device__ __forceinline__ bool static_next(int i, int G, int c, int nM, int nN, int& pm, int& pn) {
    const int nwg = nM * nN; const long L = (long)i * G + c; if (L >= nwg) return false;
    int wgid = (int)L; { const int q = nwg / NXCD, r = nwg % NXCD, xcd = wgid % NXCD, off = wgid / NXCD; wgid = (xcd < r ? xcd * (q + 1) : r * (q + 1) + (xcd - r) * q) + off; }
    const int nig = WGM * nN, gid = wgid / nig, fm = gid * WGM, gsz = (nM - fm) < WGM ? (nM - fm) : WGM;
    pm = fm + ((wgid % nig) % gsz); pn = (wgid % nig) / gsz; return true;
}

template <class P, bool ALIGN_EPI>
__device__ __forceinline__ void gemm_phase(LAS unsigned char* lds, const P& prob, const int wid) {
    const int lane = lane_id(), tid = wid * 64 + lane, wr = wid >> 2, wc = wid & 3, fr = lane & 15, fq = lane >> 4;
    constexpr int ROWB = P::FP8 ? KD : 2 * KD;
    constexpr int nt = ROWB / 128;
    int RA[2], CA[2]; unsigned voffA[2], voffB[2];
#pragma unroll
    for (int i = 0; i < 2; ++i) { int R, C; stage_rc(tid * 16 + i * 8192, R, C); const int Rb = P::PERM ? ((R & ~31) + perm32(R & 31)) : R;
        RA[i] = R; CA[i] = C * 2; voffA[i] = (unsigned)(R * ROWB + C * 2); voffB[i] = (unsigned)(Rb * ROWB + C * 2); }
    constexpr int kstep = BK * 2;
    constexpr size_t hstep = (size_t)HALF * ROWB;
    const unsigned ldsw = (unsigned)wid * 1024u;
    const int aoff = lds_byte(wr * 64 + fr, fq * 8), boff = lds_byte(wc * 32 + fr, fq * 8);
#define PG8_SA(b, h) (((b) * 2 + (h)) * HTB)
#define PG8_SB(b, h) ((4 + (b) * 2 + (h)) * HTB)
#define PG8_STAGE_B(bufoff, gbase) do { _Pragma("unroll") for (int _i = 0; _i < 2; ++_i) \
        __builtin_amdgcn_global_load_lds((const unsigned*)((const char*)(gbase) + voffB[_i]), (LAS unsigned*)(lds + (bufoff) + ldsw + _i * 8192), 16, 0, 0); } while (0)
#define PG8_STAGE_A(bufoff, gbase, off, h) do { _Pragma("unroll") for (int _i = 0; _i < 2; ++_i) { const char* _p; \
        if constexpr (P::GATHER) _p = (const char*)(gbase) + (off)[h][_i]; else _p = (const char*)(gbase) + (size_t)(h) * hstep + voffA[_i]; \
        __builtin_amdgcn_global_load_lds((const unsigned*)_p, (LAS unsigned*)(lds + (bufoff) + ldsw + _i * 8192), 16, 0, 0); } } while (0)
#define PG8_LDA(dst, b, h) do { _Pragma("unroll") for (int m = 0; m < 4; ++m) _Pragma("unroll") for (int k = 0; k < 2; ++k) dst[m][k] = *(const LAS bf16x8*)(lds + PG8_SA(b, h) + aoff + m * 2048 + k * 1024); } while (0)
#define PG8_LDB(dst, b, h) do { _Pragma("unroll") for (int n = 0; n < 2; ++n) _Pragma("unroll") for (int k = 0; k < 2; ++k) dst[n][k] = *(const LAS bf16x8*)(lds + PG8_SB(b, h) + boff + n * 2048 + k * 1024); } while (0)
#define PG8_MMA(ai, bj, At, Bt) do { __builtin_amdgcn_s_setprio(1); _Pragma("unroll") for (int m = 0; m < 4; ++m) _Pragma("unroll") for (int n = 0; n < 2; ++n) { \
        if constexpr (P::FP8) { const i32x4 b0_ = __builtin_bit_cast(i32x4, Bt[n][0]), b1_ = __builtin_bit_cast(i32x4, Bt[n][1]), a0_ = __builtin_bit_cast(i32x4, At[m][0]), a1_ = __builtin_bit_cast(i32x4, At[m][1]); \
            acc[ai][bj][m][n] = __builtin_amdgcn_mfma_scale_f32_16x16x128_f8f6f4((i32x8){b0_[0], b0_[1], b0_[2], b0_[3], b1_[0], b1_[1], b1_[2], b1_[3]}, (i32x8){a0_[0], a0_[1], a0_[2], a0_[3], a1_[0], a1_[1], a1_[2], a1_[3]}, \
                acc[ai][bj][m][n], 0, 0, 0, 0x7f7f7f7f, 0, 0x7f7f7f7f); } \
        else { _Pragma("unroll") for (int k = 0; k < 2; ++k) acc[ai][bj][m][n] = __builtin_amdgcn_mfma_f32_16x16x32_bf16(Bt[n][k], At[m][k], acc[ai][bj][m][n], 0, 0, 0); } } \
        __builtin_amdgcn_s_setprio(0); } while (0)
#define PG8_WAIT_V(n) asm volatile("s_waitcnt vmcnt(" #n ")" ::: "memory")
#define PG8_WAIT_L(n) asm volatile("s_waitcnt lgkmcnt(" #n ")" ::: "memory")
#define PG8_BAR __builtin_amdgcn_s_barrier()
#define PG8_SCHED __builtin_amdgcn_sched_barrier(0)
    Unit cur, nxt; int ui = 0;
    if (!prob.next(0, cur)) return;
    f32x4 acc[2][2][4][2];
#pragma unroll
    for (int a = 0; a < 2; ++a)
#pragma unroll
        for (int b = 0; b < 2; ++b)
#pragma unroll
            for (int m = 0; m < 4; ++m)
#pragma unroll
                for (int n = 0; n < 2; ++n) acc[a][b][m][n] = (f32x4){0.f, 0.f, 0.f, 0.f};
    bf16x8 At[4][2], B0[2][2], B1[2][2];
    unsigned offC[2][2] = {{0u, 0u}, {0u, 0u}};
#define PG8_FILL(u, buf) do { if (tid < 256) prob.gtab[(buf) * 256 + tid] = prob.a_off(u, tid); } while (0)
#define PG8_OFFS(buf) do { _Pragma("unroll") for (int _h = 0; _h < 2; ++_h) _Pragma("unroll") for (int _i = 0; _i < 2; ++_i) offC[_h][_i] = prob.gtab[(buf) * 256 + _h * HALF + RA[_i]] + (unsigned)CA[_i]; } while (0)
    Unit nx2;
    bool has_next = prob.next(1, nxt);
    if constexpr (P::GATHER) { PG8_FILL(cur, 0); if (has_next) PG8_FILL(nxt, 1); PG8_WAIT_L(0); PG8_BAR; PG8_OFFS(0); }
    const char* cA = prob.a_tile(cur); const char* cB = cur.B;
    PG8_STAGE_B(PG8_SB(0, 0), cB); PG8_STAGE_B(PG8_SB(0, 1), cB + hstep); PG8_STAGE_A(PG8_SA(0, 0), cA, offC, 0); PG8_STAGE_A(PG8_SA(0, 1), cA, offC, 1);
    if (wr == 1) PG8_BAR;
    PG8_WAIT_V(2); PG8_BAR;
    PG8_STAGE_B(PG8_SB(1, 0), cB + kstep); PG8_STAGE_A(PG8_SA(1, 0), cA + kstep, offC, 0); PG8_STAGE_B(PG8_SB(1, 1), cB + hstep + kstep);
    PG8_WAIT_V(6); PG8_BAR;
    int bcur = 0;
    for (;;) {
        const bool has_nx2 = has_next && prob.next(ui + 2, nx2);
        const char* nA = has_next ? prob.a_tile(nxt) : cA; const char* nB = has_next ? nxt.B : cB;
        const int bnext = bcur == 2 ? 0 : bcur + 1, bnx2 = bnext == 2 ? 0 : bnext + 1;
#pragma unroll 1
        for (int t = 0; t < nt; t += 2) {
            const bool last = (t == nt - 2);
            const char* a1 = cA + (size_t)(t + 1) * kstep;
            const char* a2 = last ? nA : cA + (size_t)(t + 2) * kstep; const char* b2 = last ? nB : cB + (size_t)(t + 2) * kstep;
            const char* a3 = a2 + kstep; const char* b3 = b2 + kstep;
            PG8_LDB(B0, 0, 0); PG8_LDB(B1, 0, 1); PG8_SCHED; PG8_LDA(At, 0, 0); PG8_STAGE_A(PG8_SA(1, 1), a1, offC, 1);
            if constexpr (P::GATHER) { if (last && has_next) PG8_OFFS(bnext); }
            PG8_WAIT_V(8); PG8_WAIT_L(0); PG8_BAR; PG8_MMA(0, 0, At, B0); PG8_MMA(0, 1, At, B1); PG8_BAR; PG8_SCHED;
            PG8_LDA(At, 0, 1); PG8_STAGE_B(PG8_SB(0, 0), b2); PG8_STAGE_B(PG8_SB(0, 1), b2 + hstep); PG8_STAGE_A(PG8_SA(0, 0), a2, offC, 0);
            PG8_WAIT_V(8); PG8_WAIT_L(0); PG8_BAR; PG8_MMA(1, 0, At, B0); PG8_MMA(1, 1, At, B1); PG8_BAR; PG8_SCHED;
            PG8_LDB(B0, 1, 0); PG8_LDB(B1, 1, 1); PG8_SCHED; PG8_LDA(At, 1, 0); PG8_STAGE_A(PG8_SA(0, 1), a2, offC, 1);
            PG8_WAIT_V(8); PG8_WAIT_L(0); PG8_BAR; PG8_MMA(0, 0, At, B0); PG8_MMA(0, 1, At, B1); PG8_BAR; PG8_SCHED;
            PG8_LDA(At, 1, 1); PG8_STAGE_B(PG8_SB(1, 0), b3); PG8_STAGE_B(PG8_SB(1, 1), b3 + hstep); PG8_STAGE_A(PG8_SA(1, 0), a3, offC, 0);
            PG8_WAIT_V(8); PG8_WAIT_L(0); PG8_BAR; PG8_MMA(1, 0, At, B0); PG8_MMA(1, 1, At, B1); PG8_BAR; PG8_SCHED;
        }
        if constexpr (ALIGN_EPI) { if (wr == 0) PG8_BAR; }
        if constexpr (P::GATHER) { if (has_nx2) PG8_FILL(nx2, bnx2); }
        cur.aux = bcur;
        prob.epi(acc, cur, wr, wc, fr, fq);
        if (!has_next) break;
#pragma unroll
        for (int a = 0; a < 2; ++a)
#pragma unroll
            for (int b = 0; b < 2; ++b)
#pragma unroll
                for (int m = 0; m < 4; ++m)
#pragma unroll
                    for (int n = 0; n < 2; ++n) acc[a][b][m][n] = (f32x4){0.f, 0.f, 0.f, 0.f};
        cur = nxt; nxt = nx2; has_next = has_nx2; cA = nA; cB = nB; ++ui; bcur = bnext;
        if constexpr (ALIGN_EPI) { if (wr == 1) PG8_BAR; }
    }
    PG8_WAIT_V(0);
    if constexpr (!ALIGN_EPI) { if (wr == 0) PG8_BAR; }
    PG8_BAR;
#undef PG8_SA
#undef PG8_SB
#undef PG8_STAGE_A
#undef PG8_STAGE_B
#undef PG8_LDA
#undef PG8_LDB
#undef PG8_MMA
#undef PG8_WAIT_V
#undef PG8_WAIT_L
#undef PG8_BAR
#undef PG8_SCHED
#undef PG8_OFFS
#undef PG8_FILL
}
}

template <bool F8> struct ProbScaleT {
    static constexpr bool FP8 = F8, PERM = true, GATHER = F8;
    static constexpr int RB = F8 ? 1024 : 2048;
    __device__ __forceinline__ const char* a_tile(const pg8::Unit& u) const { return F8 ? u.A : u.A + (size_t)u.pm * (256 * RB); }
    LAS unsigned* gtab;
    const void* A; const void* Bt; int nM, nN, G, c;
    bf16_t* O; int ldo; const float* rstd; const float* ssp;
    __device__ __forceinline__ bool next(int i, pg8::Unit& u) const {
        int pm, pn; if (!pg8::static_next(i, G, c, nM, nN, pm, pn)) return false;
        u.A = (const char*)A; u.B = (const char*)Bt + (size_t)pn * 256 * RB; u.pm = pm; u.pn = pn; u.e = 0; u.nvalid = 256; u.y0 = 0; u.aux = 0; return true; }
    __device__ __forceinline__ unsigned a_off(const pg8::Unit& u, int r) const { return (unsigned)(u.pm * 256 + r) * (unsigned)RB; }
    __device__ __forceinline__ void epi(const f32x4 (&acc)[2][2][4][2], const pg8::Unit& u, int wr, int wc, int fr, int fq) const {
        asm volatile("" : "+v"(fr), "+v"(fq));
        const int rowu = u.pm * 256 + wr * 64;
        char* ub = (char*)O + ((size_t)rowu * ldo + u.pn * 256 + wc * 32) * 2;
        const unsigned lo = (unsigned)(fr * ldo + 8 * fq) * 2u;
        float rsv[8];
        if (rstd) {
#pragma unroll
            for (int q = 0; q < 8; ++q) rsv[q] = rstd[rowu + fr + (q >> 2) * 128 + (q & 3) * 16];
        } else { f32x4 pv[8];
#pragma unroll
            for (int q = 0; q < 8; ++q) pv[q] = *(const f32x4*)(ssp + (size_t)(rowu + fr + (q >> 2) * 128 + (q & 3) * 16) * 16 + fq * 4);
#pragma unroll
            for (int q = 0; q < 8; ++q) { float sq = (pv[q][0] + pv[q][1]) + (pv[q][2] + pv[q][3]); sq = x16_sum(sq); sq = x32_sum(sq); rsv[q] = rsqrtf(sq * (1.0f / 1024.0f) + EPS); } }
#pragma unroll
        for (int ai = 0; ai < 2; ++ai)
#pragma unroll
            for (int m = 0; m < 4; ++m) { const float rs = rsv[ai * 4 + m] * (F8 ? (1.0f / 64.0f) : 1.0f);
                char* rowp = ub + (size_t)(ai * 128 + m * 16) * ldo * 2 + lo;
#pragma unroll
                for (int bj = 0; bj < 2; ++bj) { const f32x4 v0 = acc[ai][bj][m][0] * rs, v1 = acc[ai][bj][m][1] * rs;
                    u32x4 w; w.x = cvt_pk_bf16(v0[0], v0[1]); w.y = cvt_pk_bf16(v0[2], v0[3]); w.z = cvt_pk_bf16(v1[0], v1[1]); w.w = cvt_pk_bf16(v1[2], v1[3]);
                    *(u32x4*)(rowp + bj * 256) = w; } }
    }
};
typedef ProbScaleT<false> ProbScaleBf16;
struct ProbColScaleBf16 {
    static constexpr bool FP8 = false, PERM = true, GATHER = false;
    __device__ __forceinline__ const char* a_tile(const pg8::Unit& u) const { return u.A + (size_t)u.pm * (256 * 2048); }
    const bf16_t* A; const bf16_t* Bt; int nM, nN, G, c;
    bf16_t* O; int ldo; const float* cs;
    __device__ __forceinline__ bool next(int i, pg8::Unit& u) const {
        const long L = (long)i * G + c; if (L >= (long)nM * nN) return false;
        const int pm = (int)(L % nM), pn = (int)(L / nM);
        u.A = (const char*)A; u.B = (const char*)(Bt + (size_t)pn * 256 * 1024); u.pm = pm; u.pn = pn; u.e = 0; u.nvalid = 256; u.y0 = 0; u.aux = 0; return true; }
    __device__ __forceinline__ unsigned a_off(const pg8::Unit& u, int r) const { return 0u; }
    __device__ __forceinline__ void epi(const f32x4 (&acc)[2][2][4][2], const pg8::Unit& u, int wr, int wc, int fr, int fq) const {
        asm volatile("" : "+v"(fr), "+v"(fq));
        const float* cp = cs + u.pn * 256 + wc * 32 + 8 * fq;
        f32x4 sc[2][2];
#pragma unroll
        for (int bj = 0; bj < 2; ++bj)
#pragma unroll
            for (int n = 0; n < 2; ++n) sc[bj][n] = *(const f32x4*)(cp + bj * 128 + 4 * n);
        char* ub = (char*)O + ((size_t)(u.pm * 256 + wr * 64) * ldo + u.pn * 256 + wc * 32) * 2;
        const unsigned lo = (unsigned)(fr * ldo + 8 * fq) * 2u;
#pragma unroll
        for (int ai = 0; ai < 2; ++ai)
#pragma unroll
            for (int m = 0; m < 4; ++m) { char* rowp = ub + (size_t)(ai * 128 + m * 16) * ldo * 2 + lo;
#pragma unroll
                for (int bj = 0; bj < 2; ++bj) { const f32x4 v0 = acc[ai][bj][m][0] * sc[bj][0], v1 = acc[ai][bj][m][1] * sc[bj][1];
                    u32x4 w; w.x = cvt_pk_bf16(v0[0], v0[1]); w.y = cvt_pk_bf16(v0[2], v0[3]); w.z = cvt_pk_bf16(v1[0], v1[1]); w.w = cvt_pk_bf16(v1[2], v1[3]);
                    *(u32x4*)(rowp + bj * 256) = w; } }
    }
};
struct ProbKV {
    static constexpr bool FP8 = true, PERM = true, GATHER = true;
    __device__ __forceinline__ const char* a_tile(const pg8::Unit& u) const { return u.A; }
    LAS unsigned* gtab;
    const unsigned char* memb; const unsigned char* wckv; bf16_t* Kout; bf16_t* VTout; const float* rstdm; int G, c;
    __device__ __forceinline__ bool next(int i, pg8::Unit& u) const {
        const long L = (long)i * G + c; if (L >= 256) return false;
        if (L < 128) { u.pm = (int)(L & 31); u.pn = (int)(L >> 5); u.e = 0; u.A = (const char*)memb; u.B = (const char*)(wckv + (size_t)u.pn * 256 * 1024); }
        else { const int l2 = (int)L - 128; u.pm = l2 & 3; u.pn = l2 >> 2; u.e = 1; u.A = (const char*)(wckv + (size_t)1024 * 1024); u.B = (const char*)(memb + (size_t)u.pn * 256 * 1024); }
        u.nvalid = 256; u.y0 = 0; u.aux = 0; return true; }
    __device__ __forceinline__ unsigned a_off(const pg8::Unit& u, int r) const { return (unsigned)(u.pm * 256 + r) * 1024u; }
    __device__ __forceinline__ void epi(const f32x4 (&acc)[2][2][4][2], const pg8::Unit& u, int wr, int wc, int fr, int fq) const {
        asm volatile("" : "+v"(fr), "+v"(fq));
        const int ldo = u.e ? MROWS : 1024;
        char* ub = (char*)(u.e ? VTout : Kout) + ((size_t)(u.pm * 256 + wr * 64) * ldo + u.pn * 256 + wc * 32) * 2;
        const unsigned lo = (unsigned)(fr * ldo + 8 * fq) * 2u;
        float rsv[8]; f32x4 sc[2][2];
        if (u.e == 0) {
#pragma unroll
            for (int q = 0; q < 8; ++q) rsv[q] = rstdm[u.pm * 256 + wr * 64 + fr + (q >> 2) * 128 + (q & 3) * 16] * (1.0f / 64.0f);
#pragma unroll
            for (int bj = 0; bj < 2; ++bj)
#pragma unroll
                for (int n = 0; n < 2; ++n) sc[bj][n] = (f32x4){1.f, 1.f, 1.f, 1.f};
        } else {
#pragma unroll
            for (int q = 0; q < 8; ++q) rsv[q] = 1.0f / 64.0f;
            const float* cp = rstdm + u.pn * 256 + wc * 32 + 8 * fq;
#pragma unroll
            for (int bj = 0; bj < 2; ++bj)
#pragma unroll
                for (int n = 0; n < 2; ++n) sc[bj][n] = *(const f32x4*)(cp + bj * 128 + 4 * n); }
#pragma unroll
        for (int ai = 0; ai < 2; ++ai)
#pragma unroll
            for (int m = 0; m < 4; ++m) { const float rs = rsv[ai * 4 + m]; char* rowp = ub + (size_t)(ai * 128 + m * 16) * ldo * 2 + lo;
#pragma unroll
                for (int bj = 0; bj < 2; ++bj) { const f32x4 v0 = acc[ai][bj][m][0] * sc[bj][0] * rs, v1 = acc[ai][bj][m][1] * sc[bj][1] * rs;
                    u32x4 w; w.x = cvt_pk_bf16(v0[0], v0[1]); w.y = cvt_pk_bf16(v0[2], v0[3]); w.z = cvt_pk_bf16(v1[0], v1[1]); w.w = cvt_pk_bf16(v1[2], v1[3]);
                    *(u32x4*)(rowp + bj * 256) = w; } }
    }
};
template <bool F8, bool WF8, bool RF32> struct ProbResidT {
    static constexpr bool FP8 = F8, PERM = true, GATHER = F8;
    static constexpr int RB = F8 ? 1024 : 2048;
    __device__ __forceinline__ const char* a_tile(const pg8::Unit& u) const { return F8 ? u.A : u.A + (size_t)u.pm * (256 * RB); }
    LAS unsigned* gtab;
    const void* A; const void* Bt; int nM, nN, G, c;
    const float* rf; const bf16_t* rb; bf16_t* ob; unsigned char* of8; float* ssp;
    __device__ __forceinline__ bool next(int i, pg8::Unit& u) const {
        int pm, pn; if (!pg8::static_next(i, G, c, nM, nN, pm, pn)) return false;
        u.A = (const char*)A; u.B = (const char*)Bt + (size_t)pn * 256 * RB; u.pm = pm; u.pn = pn; u.e = 0; u.nvalid = 256; u.y0 = 0; u.aux = 0; return true; }
    __device__ __forceinline__ unsigned a_off(const pg8::Unit& u, int r) const { return (unsigned)(u.pm * 256 + r) * (unsigned)RB; }
    __device__ __forceinline__ void epi(const f32x4 (&acc)[2][2][4][2], const pg8::Unit& u, int wr, int wc, int fr, int fq) const {
        asm volatile("" : "+v"(fr), "+v"(fq));
        const int rowu = u.pm * 256 + wr * 64;
        const size_t uoff = (size_t)rowu * 1024 + u.pn * 256 + wc * 32;
        const unsigned lo = (unsigned)(fr * 1024 + 8 * fq);
        const float sc = F8 ? (1.0f / 64.0f) : 1.0f;
#pragma unroll
        for (int ai = 0; ai < 2; ++ai) {
            f32x4 rv[4][2][2];
#pragma unroll
            for (int m = 0; m < 4; ++m) { const size_t ro = uoff + (size_t)(ai * 128 + m * 16) * 1024;
#pragma unroll
                for (int bj = 0; bj < 2; ++bj) {
                    if constexpr (RF32) { rv[m][bj][0] = *(const GAS f32x4*)(rf + ro + lo + bj * 128); rv[m][bj][1] = *(const GAS f32x4*)(rf + ro + lo + bj * 128 + 4); }
                    else { const u32x4 w = *(const GAS u32x4*)(rb + ro + lo + bj * 128); rv[m][bj][0] = (f32x4){lo_bf(w.x), hi_bf(w.x), lo_bf(w.y), hi_bf(w.y)}; rv[m][bj][1] = (f32x4){lo_bf(w.z), hi_bf(w.z), lo_bf(w.w), hi_bf(w.w)}; } } }
#pragma unroll
            for (int m = 0; m < 4; ++m) { const size_t ro = uoff + (size_t)(ai * 128 + m * 16) * 1024; float ss = 0.f;
#pragma unroll
                for (int bj = 0; bj < 2; ++bj) { const f32x4 v0 = acc[ai][bj][m][0] * sc + rv[m][bj][0], v1 = acc[ai][bj][m][1] * sc + rv[m][bj][1];
                    ss += (v0[0] * v0[0] + v0[1] * v0[1]) + (v0[2] * v0[2] + v0[3] * v0[3]) + (v1[0] * v1[0] + v1[1] * v1[1]) + (v1[2] * v1[2] + v1[3] * v1[3]);
                    u32x4 w; w.x = cvt_pk_bf16(v0[0], v0[1]); w.y = cvt_pk_bf16(v0[2], v0[3]); w.z = cvt_pk_bf16(v1[0], v1[1]); w.w = cvt_pk_bf16(v1[2], v1[3]);
                    *(u32x4*)(ob + ro + lo + bj * 128) = w;
                    if constexpr (WF8) { unsigned w0 = 0u, w1 = 0u;
                        w0 = __builtin_amdgcn_cvt_pk_fp8_f32(c8(v0[0]), c8(v0[1]), w0, false); w0 = __builtin_amdgcn_cvt_pk_fp8_f32(c8(v0[2]), c8(v0[3]), w0, true);
                        w1 = __builtin_amdgcn_cvt_pk_fp8_f32(c8(v1[0]), c8(v1[1]), w1, false); w1 = __builtin_amdgcn_cvt_pk_fp8_f32(c8(v1[2]), c8(v1[3]), w1, true);
                        *(u32x2*)(of8 + ro + lo + bj * 128) = (u32x2){w0, w1}; } }
                ss = x16_sum(ss); ss = x32_sum(ss);
                if (fq == 0) ssp[(size_t)(rowu + ai * 128 + m * 16 + fr) * 16 + u.pn * 4 + wc] = ss; } }
    }
};
__device__ __forceinline__ size_t hid_tile_off(int rt) { return rt < 1024 ? (size_t)rt * (256 * 1024) : (WS_HID1 - WS_HID) + (size_t)(rt - 1024) * (256 * 1024); }
constexpr int MOE_TS = 0, MOE_ST = 33, MOE_CNT = 66, MOE_RTE = 100, MOE_WORDS = 100 + 264;
struct ProbMoe1 {
    static constexpr bool FP8 = true, PERM = true, GATHER = true;
    __device__ __forceinline__ const char* a_tile(const pg8::Unit& u) const { return u.A; }
    const unsigned char* hb; const unsigned char* w1b; const float* b1p; const float* rstd2; const unsigned* list; unsigned char* hid;
    const volatile LAS int* tab; LAS unsigned* gtab; int rt0, nrt, G, c;
    __device__ __forceinline__ bool next(int i, pg8::Unit& u) const {
        const long L = (long)i * G + c; if (L >= (long)nrt * 8) return false;
        const int gidx = (int)(L >> 8), within = (int)(L & 255), gsz = (nrt - gidx * 32) < 32 ? (nrt - gidx * 32) : 32;
        const int rtl = gidx * 32 + within % gsz, pn = within / gsz, rt = rt0 + rtl;
        const int e = ((const volatile LAS unsigned char*)(tab + MOE_RTE))[rt];
        const int idx0 = (rt - tab[MOE_TS + e]) * 256;
        u.A = (const char*)hb; u.B = (const char*)(w1b + ((size_t)e * 2048 + (size_t)pn * 256) * 1024); u.pm = rt; u.pn = pn; u.e = e; u.nvalid = tab[MOE_CNT + e] - idx0; u.y0 = idx0; u.aux = 0; return true; }
    __device__ __forceinline__ unsigned tok_of(const pg8::Unit& u, int r) const { const int rr = r < u.nvalid ? r : 0; return list[(size_t)u.e * T + u.y0 + rr]; }
    __device__ __forceinline__ unsigned a_off(const pg8::Unit& u, int r) const { return tok_of(u, r) * 1024u; }
    __device__ __forceinline__ void epi(const f32x4 (&acc)[2][2][4][2], const pg8::Unit& u, int wr, int wc, int fr, int fq) const {
        asm volatile("" : "+v"(fr), "+v"(fq));
        const float* bp = b1p + (size_t)u.e * 2048 + u.pn * 256 + wc * 32 + 8 * fq;
        const f32x4 bg0 = *(const f32x4*)(bp), bg1 = *(const f32x4*)(bp + 4), bl0 = *(const f32x4*)(bp + 128), bl1 = *(const f32x4*)(bp + 132);
        char* ub = (char*)hid + hid_tile_off(u.pm) + ((size_t)(wr * 64) * 1024 + u.pn * 128 + wc * 32);
        const unsigned lo = (unsigned)(fr * 1024 + 8 * fq);
#pragma unroll
        for (int ai = 0; ai < 2; ++ai)
#pragma unroll
            for (int m = 0; m < 4; ++m) { const float rs = 1.0f / 64.0f;
                float a[8];
#pragma unroll
                for (int n = 0; n < 2; ++n) { const f32x4 g4 = acc[ai][0][m][n] * rs + (n ? bg1 : bg0), l4 = acc[ai][1][m][n] * rs + (n ? bl1 : bl0);
#pragma unroll
                    for (int j = 0; j < 4; ++j) { const float g = fminf(g4[j], 7.0f), l = fminf(fmaxf(l4[j], -7.0f), 7.0f);
                        a[n * 4 + j] = 4.0f * g * __builtin_amdgcn_rcpf(1.0f + __expf(-1.702f * g)) * (l + 1.0f); } }
                unsigned w0 = 0u, w1 = 0u;
                w0 = __builtin_amdgcn_cvt_pk_fp8_f32(a[0], a[1], w0, false); w0 = __builtin_amdgcn_cvt_pk_fp8_f32(a[2], a[3], w0, true);
                w1 = __builtin_amdgcn_cvt_pk_fp8_f32(a[4], a[5], w1, false); w1 = __builtin_amdgcn_cvt_pk_fp8_f32(a[6], a[7], w1, true);
                *(u32x2*)(ub + (size_t)(ai * 128 + m * 16) * 1024 + lo) = (u32x2){w0, w1}; }
    }
};
struct ProbMoe2 {
    static constexpr bool FP8 = true, PERM = true, GATHER = true;
    __device__ __forceinline__ const char* a_tile(const pg8::Unit& u) const { return u.A; }
    const unsigned char* hid; const unsigned char* w2b; const float* b2; unsigned char* y;
    const volatile LAS int* tab; LAS unsigned* gtab; int rt0, nrt, G, c;
    __device__ __forceinline__ bool next(int i, pg8::Unit& u) const {
        const long L = (long)i * G + c; if (L >= (long)nrt * 4) return false;
        const int gidx = (int)(L >> 8), within = (int)(L & 255), gsz = (nrt - gidx * 64) < 64 ? (nrt - gidx * 64) : 64;
        const int rtl = gidx * 64 + within % gsz, pn = within / gsz, rt = rt0 + rtl;
        const int e = ((const volatile LAS unsigned char*)(tab + MOE_RTE))[rt];
        const int idx0 = (rt - tab[MOE_TS + e]) * 256;
        u.A = (const char*)hid; u.B = (const char*)(w2b + ((size_t)e * 1024 + (size_t)pn * 256) * 1024); u.pm = rt; u.pn = pn; u.e = e; u.nvalid = tab[MOE_CNT + e] - idx0; u.y0 = tab[MOE_ST + e] + idx0; u.aux = 0; return true; }
    __device__ __forceinline__ unsigned a_off(const pg8::Unit& u, int r) const { return (unsigned)(hid_tile_off(u.pm) + (size_t)r * 1024u); }
    __device__ __forceinline__ void epi(const f32x4 (&acc)[2][2][4][2], const pg8::Unit& u, int wr, int wc, int fr, int fq) const {
        asm volatile("" : "+v"(fr), "+v"(fq));
        const float* bp = b2 + (size_t)u.e * 1024 + u.pn * 256 + wc * 32 + 8 * fq;
        f32x4 bv[2][2];
#pragma unroll
        for (int bj = 0; bj < 2; ++bj)
#pragma unroll
            for (int n = 0; n < 2; ++n) bv[bj][n] = *(const f32x4*)(bp + bj * 128 + 4 * n);
        char* ub = (char*)y + (((size_t)u.y0 + wr * 64) * 1024 + u.pn * 256 + wc * 32);
        const unsigned lo = (unsigned)(fr * 1024 + 8 * fq);
        const int r0 = wr * 64 + fr;
#pragma unroll
        for (int ai = 0; ai < 2; ++ai)
#pragma unroll
            for (int m = 0; m < 4; ++m) { const int r = r0 + ai * 128 + m * 16;
                if (r < u.nvalid) { char* rowp = ub + (size_t)(ai * 128 + m * 16) * 1024 + lo;
#pragma unroll
                    for (int bj = 0; bj < 2; ++bj) { const f32x4 v0 = acc[ai][bj][m][0] * (1.0f / 16.0f) + bv[bj][0] * 16.0f, v1 = acc[ai][bj][m][1] * (1.0f / 16.0f) + bv[bj][1] * 16.0f;
                        unsigned w0 = 0u, w1 = 0u;
                        w0 = __builtin_amdgcn_cvt_pk_fp8_f32(c8(v0[0]), c8(v0[1]), w0, false); w0 = __builtin_amdgcn_cvt_pk_fp8_f32(c8(v0[2]), c8(v0[3]), w0, true);
                        w1 = __builtin_amdgcn_cvt_pk_fp8_f32(c8(v1[0]), c8(v1[1]), w1, false); w1 = __builtin_amdgcn_cvt_pk_fp8_f32(c8(v1[2]), c8(v1[3]), w1, true);
                        *(u32x2*)(rowp + bj * 128) = (u32x2){w0, w1}; } } }
    }
};

#define XB_TMO      128
#define XB_XCNT(j)  (256  + 64 * (j))
#define XB_XSUB(j)  (1280 + 64 * (j))
#define XB_XGEN(j)  (2304 + 64 * (j))
#define XB_TOP      3328
#define XB_TOPGEN   3392
#define XCD_BAR_WORDS 3456
#define XB_SPIN_CAP (1u << 18)
__device__ __forceinline__ unsigned xb_ld(unsigned* p)              { return __hip_atomic_load(p, __ATOMIC_RELAXED, __HIP_MEMORY_SCOPE_AGENT); }
__device__ __forceinline__ unsigned xb_add(unsigned* p, unsigned v) { return __hip_atomic_fetch_add(p, v, __ATOMIC_RELAXED, __HIP_MEMORY_SCOPE_AGENT); }
__device__ __forceinline__ unsigned xb_xcc_id() { return (unsigned)__builtin_amdgcn_s_getreg((3 << 11) | 20) & 0xFu; }
#define XB_SPIN(cond, bar) do { unsigned _sp = 0; while (cond) { __builtin_amdgcn_s_sleep(1); \
    if ((++_sp & 255u) == 0u) { if (xb_ld(&(bar)[XB_TMO])) break; if (_sp > XB_SPIN_CAP) { atomicAdd(&(bar)[XB_TMO], 1u); break; } } } } while (0)
struct XcdBarrier { unsigned* bar; unsigned x; volatile LAS unsigned* st; int wave; };
__device__ __forceinline__ XcdBarrier xcd_barrier_post(unsigned* bar, volatile LAS unsigned* st, int wave) {
    XcdBarrier b; b.bar = bar; b.x = xb_xcc_id(); b.st = st; b.wave = wave;
    if (wave == 0 && lane_id() == 0) (void)xb_add(&bar[XB_XCNT(b.x)], 1u);
    return b;
}
__device__ __forceinline__ void xcd_barrier_complete(unsigned* bar, unsigned x, unsigned& nloc, unsigned& nx) {
    const unsigned G = gridDim.x * gridDim.y * gridDim.z;
    unsigned sum, cnt, mine, sp = 0u;
    for (;;) {
        sum = 0u; cnt = 0u; mine = 0u;
#pragma unroll
        for (unsigned j = 0; j < 16; ++j) { const unsigned c = xb_ld(&bar[XB_XCNT(j)]); sum += c; cnt += (c > 0u) ? 1u : 0u; mine = (j == x) ? c : mine; }
        if (sum == G) break;
        __builtin_amdgcn_s_sleep(1);
        if ((++sp & 255u) == 0u) { if (xb_ld(&bar[XB_TMO])) break; if (sp > XB_SPIN_CAP) { atomicAdd(&bar[XB_TMO], 1u); break; } }
    }
    nloc = mine > 0u ? mine : 1u; nx = cnt > 0u ? cnt : 1u;
}
__device__ __forceinline__ void xcd_barrier(const XcdBarrier& b) {
    asm volatile("s_waitcnt vmcnt(0)" ::: "memory");
    __syncthreads();
    if (b.wave == 0 && lane_id() == 0) {
        unsigned* bar = b.bar;
        __builtin_amdgcn_s_waitcnt(0);
        unsigned nloc = b.st[0], nx = b.st[1];
        if (nloc == 0u) { xcd_barrier_complete(bar, b.x, nloc, nx); b.st[0] = nloc; b.st[1] = nx; }
        const unsigned old = xb_add(&bar[XB_XSUB(b.x)], 1u);
        const unsigned gen = old / nloc;
        if (old + 1u == (gen + 1u) * nloc) {
            __builtin_amdgcn_fence(__ATOMIC_RELEASE, "agent");
            asm volatile("s_waitcnt vmcnt(0)" ::: "memory");
            const unsigned og = xb_add(&bar[XB_TOP], 1u);
            const unsigned tg = og / nx;
            if (og + 1u == (tg + 1u) * nx) xb_add(&bar[XB_TOPGEN], 1u);
            else XB_SPIN(xb_ld(&bar[XB_TOPGEN]) == tg, bar);
            __builtin_amdgcn_fence(__ATOMIC_ACQUIRE, "agent");
            xb_add(&bar[XB_XGEN(b.x)], 1u);
            asm volatile("s_waitcnt vmcnt(0)" ::: "memory");
        } else {
            XB_SPIN(xb_ld(&bar[XB_XGEN(b.x)]) == gen, bar);
            __builtin_amdgcn_fence(__ATOMIC_ACQUIRE, "agent");
            asm volatile("s_waitcnt vmcnt(0)" ::: "memory");
        }
    }
    __syncthreads();
}

typedef float f32x16 __attribute__((ext_vector_type(16)));
__device__ __forceinline__ int pi32(int i) { return (i & ~12) | ((i & 4) << 1) | ((i & 8) >> 1); }
__device__ __forceinline__ f32x16 zero16() { f32x16 z;
#pragma unroll
    for (int r = 0; r < 16; ++r) z[r] = 0.f;
    return z; }

__device__ __forceinline__ void xattn_phase(LAS unsigned char* lds, const bf16_t* Q, const bf16_t* Kb, const bf16_t* VT, unsigned char* O, int G, int bx, int wave) {
    const int lane = lane_id(), i = lane & 31, hh = lane >> 5;
    LAS unsigned char* ring = lds;
    for (int uid = bx; uid < BATCH * 4 * 8; uid += G) {
        const int b = uid >> 5, h = (uid >> 3) & 3, qblk = uid & 7;
        const int q0 = qblk * 256 + wave * 32;
        const bf16_t* qp = Q + (size_t)(b * SEQ + q0 + i) * 1024 + h * 256 + 8 * hh;
        bf16x8 qf[16];
#pragma unroll
        for (int ds = 0; ds < 16; ++ds) qf[ds] = *(const bf16x8*)(qp + 16 * ds);
        const bf16_t* ksrc = Kb + (size_t)(b * MEMLEN + pi32(i)) * 1024 + h * 256 + 16 * wave + 8 * hh;
        const bf16_t* vsrc = VT + (size_t)(h * 256 + i) * MROWS + b * MEMLEN + 32 * (wave >> 1) + 16 * (wave & 1) + 8 * hh;
#define XA_ISSUE(st_) do { LAS unsigned char* sl_ = ring + ((st_) & 3) * 16384; \
        if ((st_) < 8) { const bf16_t* g_ = ksrc + (size_t)(st_) * 32 * 1024; \
            __builtin_amdgcn_global_load_lds((const unsigned*)g_, (LAS unsigned*)(sl_ + wave * 1024), 16, 0, 0); \
            __builtin_amdgcn_global_load_lds((const unsigned*)(g_ + 128), (LAS unsigned*)(sl_ + (8 + wave) * 1024), 16, 0, 0); } \
        else { const bf16_t* g_ = vsrc + (size_t)((st_) - 8) * 32 * MROWS; \
            __builtin_amdgcn_global_load_lds((const unsigned*)g_, (LAS unsigned*)(sl_ + wave * 1024), 16, 0, 0); \
            __builtin_amdgcn_global_load_lds((const unsigned*)(g_ + 128), (LAS unsigned*)(sl_ + (8 + wave) * 1024), 16, 0, 0); } } while (0)
#define XA_SYNC(st_) do { const int n_ = ((st_) >= 11 ? 4 : 0) + ((st_) <= 14 ? 2 : 0) + ((st_) >= 10 ? 4 : 0) + ((st_) <= 13 ? 2 : 0) + ((st_) >= 9 ? 4 : 0); \
        if (n_ == 4) asm volatile("s_waitcnt vmcnt(4)" ::: "memory"); else if (n_ == 8) asm volatile("s_waitcnt vmcnt(8)" ::: "memory"); \
        else if (n_ == 12) asm volatile("s_waitcnt vmcnt(12)" ::: "memory"); else if (n_ == 14) asm volatile("s_waitcnt vmcnt(14)" ::: "memory"); else asm volatile("s_waitcnt vmcnt(16)" ::: "memory"); \
        __builtin_amdgcn_s_barrier(); asm volatile("" ::: "memory"); if ((st_) + 3 < 16) XA_ISSUE((st_) + 3); } while (0)
        XA_ISSUE(0); XA_ISSUE(1); XA_ISSUE(2);
        f32x16 s[8];
#pragma unroll
        for (int kt = 0; kt < 8; ++kt) { XA_SYNC(kt);
            const LAS unsigned char* sl = ring + (kt & 3) * 16384 + lane * 16;
            f32x16 acc = zero16();
#pragma unroll
            for (int q4 = 0; q4 < 4; ++q4) { __builtin_amdgcn_sched_barrier(0);
#pragma unroll
                for (int d4 = 0; d4 < 4; ++d4) { const int ds = q4 * 4 + d4; acc = __builtin_amdgcn_mfma_f32_32x32x16_bf16(*(const LAS bf16x8*)(sl + ds * 1024), qf[ds], acc, 0, 0, 0); } }
            s[kt] = acc; }
        float m = -INFINITY;
#pragma unroll
        for (int kt = 0; kt < 8; ++kt)
#pragma unroll
            for (int r = 0; r < 16; ++r) m = fmaxf(m, s[kt][r]);
        m = x32_max(m);
        const float c = 0.0625f * 1.4426950408889634f; float l = 0.f; const float mc = m * c;
        u32x4 pf[8][2];
#pragma unroll
        for (int kt = 0; kt < 8; ++kt) {
#pragma unroll
            for (int r = 0; r < 16; ++r) { const float p = __builtin_amdgcn_exp2f(s[kt][r] * c - mc); s[kt][r] = p; l += p; }
#pragma unroll
            for (int sb = 0; sb < 2; ++sb) { pf[kt][sb].x = cvt_pk_bf16(s[kt][8 * sb + 0], s[kt][8 * sb + 1]); pf[kt][sb].y = cvt_pk_bf16(s[kt][8 * sb + 2], s[kt][8 * sb + 3]);
                pf[kt][sb].z = cvt_pk_bf16(s[kt][8 * sb + 4], s[kt][8 * sb + 5]); pf[kt][sb].w = cvt_pk_bf16(s[kt][8 * sb + 6], s[kt][8 * sb + 7]); } }
        l = x32_sum(l);
        const float il = 1.0f / l;
        unsigned char* op = O + (size_t)(b * SEQ + q0 + i) * 1024 + h * 256 + 4 * hh;
#pragma unroll
        for (int dvt = 0; dvt < 8; ++dvt) { XA_SYNC(8 + dvt);
            const LAS unsigned char* sl = ring + (dvt & 3) * 16384 + lane * 16;
            f32x16 oacc = zero16();
#pragma unroll
            for (int q4 = 0; q4 < 4; ++q4) { __builtin_amdgcn_sched_barrier(0);
#pragma unroll
                for (int f4 = 0; f4 < 4; ++f4) { const int f = q4 * 4 + f4; oacc = __builtin_amdgcn_mfma_f32_32x32x16_bf16(*(const LAS bf16x8*)(sl + f * 1024), __builtin_bit_cast(bf16x8, pf[f >> 1][f & 1]), oacc, 0, 0, 0); } }
#pragma unroll
            for (int g = 0; g < 4; ++g) { unsigned w = 0u; w = __builtin_amdgcn_cvt_pk_fp8_f32(c8(oacc[4 * g] * il), c8(oacc[4 * g + 1] * il), w, false); w = __builtin_amdgcn_cvt_pk_fp8_f32(c8(oacc[4 * g + 2] * il), c8(oacc[4 * g + 3] * il), w, true);
                *(unsigned*)(op + dvt * 32 + 8 * g) = w; } }
#undef XA_ISSUE
#undef XA_SYNC
    }
}

__device__ __forceinline__ void diffattn_phase(LAS unsigned char* lds, const bf16_t* P2, const bf16_t* VT, const float* dng, const float lam, bf16_t* cat, int G, int vx, int wave) {
    const int lane = lane_id(), i_ = lane & 31, hh_ = lane >> 5;
    LAS unsigned char* ring = lds;
    LAS unsigned char* ql = lds + 65536 + wave * 8192 + lane * 16;
    const float c = 0.125f * 1.4426950408889634f;
    for (int pu = vx; pu < BATCH * 4 * 4; pu += G)
        for (int side = 0; side < 2; ++side) {
            const int bh = pu >> 2, x = pu & 3, qb = side ? 7 - x : x, b = bh >> 2, h = bh & 3, q0 = qb * 256 + wave * 32;
            const int ntile = 8 * qb + 8, ktw = 8 * qb + wave;
            int i = i_, hh = hh_; asm volatile("" : "+v"(i), "+v"(hh));
            const bf16_t* qp = P2 + (size_t)(b * SEQ + q0 + i) * NP2 + h * 128 + 8 * hh;
            { bf16x8 t[8];
#pragma unroll
              for (int f = 0; f < 8; ++f) t[f] = *(const bf16x8*)(qp + 16 * f);
#pragma unroll
              for (int f = 0; f < 8; ++f) *(LAS bf16x8*)(ql + f * 1024) = t[f]; }
            const char* kbase = (const char*)(P2 + (size_t)b * SEQ * NP2 + 512 + h * 128 + (wave >> 2) * 64 + 16 * (wave & 3));
            const char* vbase = (const char*)(VT + (size_t)(h * 128 + 32 * (wave >> 1)) * T + (size_t)b * SEQ + 16 * (wave & 1));
            const unsigned koff = (unsigned)(pi32(i) * NP2 + 8 * hh) * 2u, voff = (unsigned)(i * T + 8 * hh) * 2u;
#define DA_ISSUE(kt_) do { LAS unsigned char* sl_ = ring + ((kt_) & 3) * 16384; \
        __builtin_amdgcn_global_load_lds((const unsigned*)(kbase + (size_t)(kt_) * (32 * NP2 * 2) + koff), (LAS unsigned*)(sl_ + wave * 1024), 16, 0, 0); \
        __builtin_amdgcn_global_load_lds((const unsigned*)(vbase + (kt_) * 64 + voff), (LAS unsigned*)(sl_ + (8 + wave) * 1024), 16, 0, 0); } while (0)
            f32x16 o1[4], o2[4];
#pragma unroll
            for (int d = 0; d < 4; ++d) { o1[d] = zero16(); o2[d] = zero16(); }
            float mc1 = -INFINITY, mc2 = -INFINITY, l1 = 0.f, l2 = 0.f;
            u32x4 pp1[2], pp2[2];
#pragma unroll
            for (int sb = 0; sb < 2; ++sb) { pp1[sb] = (u32x4){0u, 0u, 0u, 0u}; pp2[sb] = pp1[sb]; }
            DA_ISSUE(0); DA_ISSUE(1);
            for (int kt = 0; kt <= ntile; ++kt) {
                if (kt < ntile) {
                    if (kt + 1 < ntile) asm volatile("s_waitcnt vmcnt(2)" ::: "memory"); else asm volatile("s_waitcnt vmcnt(0)" ::: "memory");
                    __builtin_amdgcn_s_barrier(); asm volatile("" ::: "memory");
                    if (kt + 2 < ntile) DA_ISSUE(kt + 2);
                }
                if (kt <= ktw + 1) {
                    const LAS unsigned char* sl = ring + (kt & 3) * 16384 + lane * 16;
                    const LAS unsigned char* sp = ring + ((kt == 0 ? 0 : kt - 1) & 3) * 16384 + lane * 16;
                    f32x16 s1 = zero16(), s2 = zero16();
#pragma unroll
                    for (int ds = 0; ds < 4; ++ds) { s1 = __builtin_amdgcn_mfma_f32_32x32x16_bf16(*(const LAS bf16x8*)(sl + ds * 1024), *(const LAS bf16x8*)(ql + ds * 1024), s1, 0, 0, 0);
                        s2 = __builtin_amdgcn_mfma_f32_32x32x16_bf16(*(const LAS bf16x8*)(sl + (4 + ds) * 1024), *(const LAS bf16x8*)(ql + (4 + ds) * 1024), s2, 0, 0, 0);
                        if (ds & 1) __builtin_amdgcn_sched_barrier(0); }
                    if (kt >= ktw) { const int lim = (kt == ktw) ? i : -1;
#pragma unroll
                        for (int r = 0; r < 16; ++r) { const int ko = 16 * (r >> 3) + 8 * hh + (r & 7); if (ko > lim) { s1[r] = -INFINITY; s2[r] = -INFINITY; } } }
                    float f1 = 1.f, f2 = 1.f; bool rs1, rs2;
                    { float tm = s1[0];
#pragma unroll
                      for (int r = 1; r < 16; ++r) tm = fmaxf(tm, s1[r]);
                      tm = x32_max(tm); const float tmc = tm * c; rs1 = __any(tmc > mc1 + 8.0f);
                      if (rs1) { const float mn = fmaxf(mc1, tmc); f1 = __builtin_amdgcn_exp2f(mc1 - mn); mc1 = mn; } }
                    { float tm = s2[0];
#pragma unroll
                      for (int r = 1; r < 16; ++r) tm = fmaxf(tm, s2[r]);
                      tm = x32_max(tm); const float tmc = tm * c; rs2 = __any(tmc > mc2 + 8.0f);
                      if (rs2) { const float mn = fmaxf(mc2, tmc); f2 = __builtin_amdgcn_exp2f(mc2 - mn); mc2 = mn; } }
                    float ls1 = 0.f, ls2 = 0.f; u32x4 pn1[2], pn2[2];
#define DA_SM(j) do { { const float pv_ = __builtin_amdgcn_exp2f(s1[j] * c - mc1); s1[j] = pv_; ls1 += pv_; } { const float pv_ = __builtin_amdgcn_exp2f(s2[j] * c - mc2); s2[j] = pv_; ls2 += pv_; } \
                        if ((j) & 1) { pn1[(j) >> 3][((j) & 7) >> 1] = cvt_pk_bf16(s1[(j) - 1], s1[j]); pn2[(j) >> 3][((j) & 7) >> 1] = cvt_pk_bf16(s2[(j) - 1], s2[j]); } } while (0)
                    { bf16x8 va, vb;
#define DA_VLD(p) (*(const LAS bf16x8*)(sp + (8 + ((p) & 3) * 2 + ((p) >> 2)) * 1024))
#define DA_SLOT(j, VF, LDNEXT) do { if ((j) & 1) o2[((j) >> 1) & 3] = __builtin_amdgcn_mfma_f32_32x32x16_bf16(VF, __builtin_bit_cast(bf16x8, pp2[(j) >> 3]), o2[((j) >> 1) & 3], 0, 0, 0); \
                            else o1[((j) >> 1) & 3] = __builtin_amdgcn_mfma_f32_32x32x16_bf16(VF, __builtin_bit_cast(bf16x8, pp1[(j) >> 3]), o1[((j) >> 1) & 3], 0, 0, 0); \
                            LDNEXT; DA_SM(j); __builtin_amdgcn_sched_barrier(0); } while (0)
                      va = DA_VLD(0);
                      __builtin_amdgcn_sched_barrier(0);
                      DA_SLOT(0, va, vb = DA_VLD(1)); DA_SLOT(1, va, (void)0); DA_SLOT(2, vb, va = DA_VLD(2)); DA_SLOT(3, vb, (void)0);
                      DA_SLOT(4, va, vb = DA_VLD(3)); DA_SLOT(5, va, (void)0); DA_SLOT(6, vb, va = DA_VLD(4)); DA_SLOT(7, vb, (void)0);
                      DA_SLOT(8, va, vb = DA_VLD(5)); DA_SLOT(9, va, (void)0); DA_SLOT(10, vb, va = DA_VLD(6)); DA_SLOT(11, vb, (void)0);
                      DA_SLOT(12, va, vb = DA_VLD(7)); DA_SLOT(13, va, (void)0); DA_SLOT(14, vb, (void)0); DA_SLOT(15, vb, (void)0);
#undef DA_VLD
#undef DA_SLOT
                    }
#undef DA_SM
                    l1 = l1 * f1 + ls1; l2 = l2 * f2 + ls2;
                    if (rs1) {
#pragma unroll
                        for (int d = 0; d < 4; ++d)
#pragma unroll
                            for (int r = 0; r < 16; ++r) o1[d][r] *= f1; }
                    if (rs2) {
#pragma unroll
                        for (int d = 0; d < 4; ++d)
#pragma unroll
                            for (int r = 0; r < 16; ++r) o2[d][r] *= f2; }
#pragma unroll
                    for (int sb = 0; sb < 2; ++sb) { pp1[sb] = pn1[sb]; pp2[sb] = pn2[sb]; }
                }
            }
#undef DA_ISSUE
            l1 = x32_sum(l1); l2 = x32_sum(l2);
            int ie = i, he = hh; asm volatile("" : "+v"(ie), "+v"(he));
            const float i1 = 1.0f / l1, i2 = lam / l2; float ss = 0.f;
#pragma unroll
            for (int d = 0; d < 4; ++d)
#pragma unroll
                for (int r = 0; r < 16; ++r) { const float o = o1[d][r] * i1 - o2[d][r] * i2; o1[d][r] = o; ss += o * o; }
            ss = x32_sum(ss);
            const float rn = rsqrtf(ss * (1.0f / 128.0f) + EPS) * (1.0f - LAMBDA_INIT);
            bf16_t* op = cat + (size_t)(b * SEQ + q0 + ie) * DM + h * 128 + 4 * he;
            const float* gp = dng + h * 128 + 4 * he;
#pragma unroll
            for (int d = 0; d < 4; ++d)
#pragma unroll
                for (int g = 0; g < 4; ++g) { const f32x4 gv = *(const f32x4*)(gp + d * 32 + 8 * g);
                    u32x2 w; w.x = cvt_pk_bf16(o1[d][4 * g] * rn * gv[0], o1[d][4 * g + 1] * rn * gv[1]); w.y = cvt_pk_bf16(o1[d][4 * g + 2] * rn * gv[2], o1[d][4 * g + 3] * rn * gv[3]);
                    *(u32x2*)(op + d * 32 + 8 * g) = w; }
        }
}

__device__ __forceinline__ void mlstm_prep_phase(LAS unsigned char* lds, const bf16_t* P2, const bf16_t* VT, const float* gates, const float* conv_w, const float* conv_b,
                                                 bf16_t* QM, bf16_t* KM, float* BC, float* AV, float* AM, float* CH, float* NLOC, float* CLOC, int G, int vx, int wave) {
    const int lane = lane_id(), i = lane & 31, hh = lane >> 5;
    LAS unsigned char* kl = lds + wave * 16384;
    for (int task = vx * 8 + wave; task < BATCH * 4 * 16; task += G * 8) {
        const int bh = task >> 4, c = task & 15, b = bh >> 2, h = bh & 3;
        const int t0 = b * SEQ + c * 128, tA = t0 + 2 * lane;
        const float lf0 = gates[(size_t)tA * 8 + 4 + h], lf1 = gates[(size_t)(tA + 1) * 8 + 4 + h], ig0 = gates[(size_t)tA * 8 + h], ig1 = gates[(size_t)(tA + 1) * 8 + h];
        float incl = lf0 + lf1;
#pragma unroll
        for (int off = 1; off < 64; off <<= 1) { const float v = __shfl_up(incl, off); if (lane >= off) incl += v; }
        const float bc1 = incl, bc0 = incl - lf1, blast = __shfl(incl, 63);
        const float a0 = ig0 - bc0, a1 = ig1 - bc1;
        float pm = fmaxf(a0, a1);
#pragma unroll
        for (int off = 1; off < 64; off <<= 1) { const float v = __shfl_up(pm, off); if (lane >= off) pm = fmaxf(pm, v); }
        const float pmprev = __shfl_up(pm, 1);
        const float am1 = pm, am0 = (lane > 0) ? fmaxf(pmprev, a0) : a0, amall = __shfl(pm, 63);
        const float ws0 = __expf(a0 - amall), ws1 = __expf(a1 - amall);
        *(f32x2*)(BC + (size_t)h * T + tA) = (f32x2){bc0, bc1};
        *(f32x2*)(AV + (size_t)h * T + tA) = (f32x2){a0, a1};
        *(f32x2*)(AM + (size_t)h * T + tA) = (f32x2){am0, am1};
        if (lane == 0) { CH[task * 2] = blast; CH[task * 2 + 1] = blast + amall; }
        {
            const int r8 = lane >> 3, cg = lane & 7;
            float cw[2][5][8];
#pragma unroll
            for (int part = 0; part < 2; ++part) { const int ch0 = (part ? 256 : 0) + h * 64 + 8 * cg;
#pragma unroll
                for (int k = 0; k < 4; ++k) { const f32x4 a = *(const f32x4*)(conv_w + k * 512 + ch0), bq = *(const f32x4*)(conv_w + k * 512 + ch0 + 4);
#pragma unroll
                    for (int j = 0; j < 4; ++j) { cw[part][k][j] = a[j]; cw[part][k][4 + j] = bq[j]; } }
                { const f32x4 a = *(const f32x4*)(conv_b + ch0), bq = *(const f32x4*)(conv_b + ch0 + 4);
#pragma unroll
                    for (int j = 0; j < 4; ++j) { cw[part][4][j] = a[j]; cw[part][4][4 + j] = bq[j]; } } }
#pragma unroll 4
            for (int jb = 0; jb < 16; ++jb) {
                const int p = 8 * jb + r8, tg = t0 + p, tseq = c * 128 + p;
                const float wa = __shfl(ws0, p >> 1), wb = __shfl(ws1, p >> 1); const float wsp = (p & 1) ? wb : wa;
                u32x4 uw[2][4];
#pragma unroll
                for (int part = 0; part < 2; ++part)
#pragma unroll
                    for (int k = 0; k < 4; ++k) { uw[part][k] = (u32x4){0u, 0u, 0u, 0u};
                        if (tseq - 3 + k >= 0) uw[part][k] = *(const u32x4*)(P2 + (size_t)(tg - 3 + k) * NP2 + 1024 + (part ? 256 : 0) + h * 64 + 8 * cg); }
#pragma unroll
                for (int part = 0; part < 2; ++part) { float y[8];
#pragma unroll
                    for (int j = 0; j < 8; ++j) { float pj = cw[part][4][j];
#pragma unroll
                        for (int k = 0; k < 4; ++k) { const unsigned wv = (j < 2) ? uw[part][k].x : (j < 4) ? uw[part][k].y : (j < 6) ? uw[part][k].z : uw[part][k].w; pj += cw[part][k][j] * ((j & 1) ? hi_bf(wv) : lo_bf(wv)); }
                        y[j] = pj * __builtin_amdgcn_rcpf(1.0f + __expf(-pj)); }
                    if (part == 0) { u32x4 w; w.x = cvt_pk_bf16(y[0] * 0.125f, y[1] * 0.125f); w.y = cvt_pk_bf16(y[2] * 0.125f, y[3] * 0.125f); w.z = cvt_pk_bf16(y[4] * 0.125f, y[5] * 0.125f); w.w = cvt_pk_bf16(y[6] * 0.125f, y[7] * 0.125f);
                        *(u32x4*)(QM + (size_t)tg * 256 + h * 64 + 8 * cg) = w; }
                    else { u32x4 w; w.x = cvt_pk_bf16(y[0], y[1]); w.y = cvt_pk_bf16(y[2], y[3]); w.z = cvt_pk_bf16(y[4], y[5]); w.w = cvt_pk_bf16(y[6], y[7]);
                        *(u32x4*)(KM + (size_t)tg * 256 + h * 64 + 8 * cg) = w;
#pragma unroll
                        for (int j = 0; j < 8; ++j) { const int d = 8 * cg + j;
                            *(LAS unsigned short*)(kl + d * 256 + ((jb ^ (d & 15)) * 16) + r8 * 2) = (unsigned short)f2bf(y[j] * wsp); } } }
            }
        }
        { float ns = 0.f;
#pragma unroll
          for (int cq = 0; cq < 16; ++cq) { const u32x4 w = *(const LAS u32x4*)(kl + lane * 256 + ((cq ^ (lane & 15)) * 16));
              ns += (lo_bf(w.x) + hi_bf(w.x)) + (lo_bf(w.y) + hi_bf(w.y)) + (lo_bf(w.z) + hi_bf(w.z)) + (lo_bf(w.w) + hi_bf(w.w)); }
          NLOC[(size_t)task * 64 + lane] = ns; }
        f32x16 acc[4][2];
#pragma unroll
        for (int et = 0; et < 4; ++et) { acc[et][0] = zero16(); acc[et][1] = zero16(); }
        const bf16_t* vp = VT + (size_t)(512 + h * 128 + i) * T + t0 + 8 * hh;
#pragma unroll
        for (int k2 = 0; k2 < 8; k2 += 2) {
            bf16x8 af[2][4];
#pragma unroll
            for (int q = 0; q < 2; ++q)
#pragma unroll
                for (int et = 0; et < 4; ++et) af[q][et] = *(const bf16x8*)(vp + (size_t)et * 32 * T + 16 * (k2 + q));
            __builtin_amdgcn_sched_barrier(0);
#pragma unroll
            for (int q = 0; q < 2; ++q) { const int ks = k2 + q; bf16x8 bfr[2];
#pragma unroll
                for (int dt = 0; dt < 2; ++dt) { const int d = 32 * dt + i; bfr[dt] = *(const LAS bf16x8*)(kl + d * 256 + (((2 * ks + hh) ^ (d & 15)) * 16)); }
#pragma unroll
                for (int et = 0; et < 4; ++et) {
                    acc[et][0] = __builtin_amdgcn_mfma_f32_32x32x16_bf16(af[q][et], bfr[0], acc[et][0], 0, 0, 0); acc[et][1] = __builtin_amdgcn_mfma_f32_32x32x16_bf16(af[q][et], bfr[1], acc[et][1], 0, 0, 0); } }
            __builtin_amdgcn_sched_barrier(0);
        }
        float* cp = CLOC + (size_t)task * 8192 + i + 256 * hh;
#pragma unroll
        for (int et = 0; et < 4; ++et)
#pragma unroll
            for (int dt = 0; dt < 2; ++dt)
#pragma unroll
                for (int r = 0; r < 16; ++r) cp[(32 * et + (r & 3) + 8 * (r >> 2)) * 64 + 32 * dt] = acc[et][dt][r];
    }
}
__device__ __forceinline__ void mlstm_scan_phase(const float* CLOC, const float* NLOC, const float* CH, bf16_t* CSTB, float* NST, float* MSTATE, int G, int bx, int tid) {
    for (int idx = bx * 512 + tid; idx < BATCH * 4 * 1024; idx += G * 512) {
        const int bh = idx >> 10, rem = idx & 1023, e = rem >> 3, d0 = (rem & 7) * 8;
        float C[8], nr[8]; float m = 0.f;
#pragma unroll
        for (int j = 0; j < 8; ++j) { C[j] = 0.f; nr[j] = 0.f; }
#pragma unroll 1
        for (int c8 = 0; c8 < 16; c8 += 8) {
            f32x4 cl[8][2], nl[8][2]; float bl[8], ml[8];
#pragma unroll
            for (int q = 0; q < 8; ++q) { const int task = bh * 16 + c8 + q;
                cl[q][0] = *(const f32x4*)(CLOC + (size_t)task * 8192 + e * 64 + d0); cl[q][1] = *(const f32x4*)(CLOC + (size_t)task * 8192 + e * 64 + d0 + 4);
                bl[q] = CH[task * 2]; ml[q] = CH[task * 2 + 1];
                if (rem < 8) { nl[q][0] = *(const f32x4*)(NLOC + (size_t)task * 64 + rem * 8); nl[q][1] = *(const f32x4*)(NLOC + (size_t)task * 64 + rem * 8 + 4); }
                else { nl[q][0] = (f32x4){0.f, 0.f, 0.f, 0.f}; nl[q][1] = nl[q][0]; } }
#pragma unroll
            for (int q = 0; q < 8; ++q) { const int task = bh * 16 + c8 + q;
                u32x4 w; w.x = cvt_pk_bf16(C[0], C[1]); w.y = cvt_pk_bf16(C[2], C[3]); w.z = cvt_pk_bf16(C[4], C[5]); w.w = cvt_pk_bf16(C[6], C[7]);
                *(u32x4*)(CSTB + (size_t)task * 8192 + e * 64 + d0) = w;
                if (rem < 8) { *(f32x4*)(NST + (size_t)task * 64 + rem * 8) = (f32x4){nr[0], nr[1], nr[2], nr[3]}; *(f32x4*)(NST + (size_t)task * 64 + rem * 8 + 4) = (f32x4){nr[4], nr[5], nr[6], nr[7]}; }
                if (rem == 0) MSTATE[task] = m;
                const float mn = fmaxf(bl[q] + m, ml[q]), a = __expf(bl[q] + m - mn), bco = __expf(ml[q] - mn);
#pragma unroll
                for (int j = 0; j < 4; ++j) { C[j] = a * C[j] + bco * cl[q][0][j]; C[4 + j] = a * C[4 + j] + bco * cl[q][1][j]; nr[j] = a * nr[j] + bco * nl[q][0][j]; nr[4 + j] = a * nr[4 + j] + bco * nl[q][1][j]; }
                m = mn; }
        }
    }
}
__device__ __forceinline__ void mlstm_out_phase(LAS unsigned char* lds, const bf16_t* P2, const bf16_t* VT, const bf16_t* QM, const bf16_t* KM, const float* BC, const float* AV, const float* AM,
                                                const bf16_t* CSTB, const float* NST, const float* MSTATE, const float* mng, bf16_t* cat, int G, int vx, int wave) {
    const int lane_ = lane_id();
    const int cw = wave >> 2, tq = wave & 3;
    LAS unsigned char* reg = lds + cw * 65536;
    for (int un = vx; un < BATCH * 4 * 8; un += G) {
        int lane = lane_; asm volatile("" : "+v"(lane));
        const int i = lane & 31, hh = lane >> 5;
        const int task = 2 * un + cw, bh = task >> 4, c = task & 15, b = bh >> 2, h = bh & 3;
        const int t0 = b * SEQ + c * 128;
        { const bf16_t* ks = KM + (size_t)(t0 + 32 * tq + pi32(i)) * 256 + h * 64 + 8 * hh;
          const bf16_t* cs = CSTB + (size_t)task * 8192 + (32 * tq + i) * 64 + 8 * hh;
          const bf16_t* vs = VT + (size_t)(512 + h * 128 + 32 * tq + i) * T + t0 + 8 * hh;
#pragma unroll
          for (int ds = 0; ds < 4; ++ds) { __builtin_amdgcn_global_load_lds((const unsigned*)(ks + 16 * ds), (LAS unsigned*)(reg + (tq * 4 + ds) * 1024), 16, 0, 0);
              __builtin_amdgcn_global_load_lds((const unsigned*)(cs + 16 * ds), (LAS unsigned*)(reg + 16384 + (tq * 4 + ds) * 1024), 16, 0, 0); }
#pragma unroll
          for (int k8 = 0; k8 < 8; ++k8) __builtin_amdgcn_global_load_lds((const unsigned*)(vs + 16 * k8), (LAS unsigned*)(reg + 32768 + (tq * 8 + k8) * 1024), 16, 0, 0); }
        const float m_c = MSTATE[task];
        const int tg = t0 + 32 * tq + i;
        const float bct = BC[(size_t)h * T + tg], amt = AM[(size_t)h * T + tg];
        bf16x8 qf[4];
#pragma unroll
        for (int ds = 0; ds < 4; ++ds) qf[ds] = *(const bf16x8*)(QM + (size_t)tg * 256 + h * 64 + 16 * ds + 8 * hh);
        float qn = 0.f;
#pragma unroll
        for (int ds = 0; ds < 4; ++ds) { const f32x4 n0 = *(const f32x4*)(NST + (size_t)task * 64 + 16 * ds + 8 * hh), n1 = *(const f32x4*)(NST + (size_t)task * 64 + 16 * ds + 8 * hh + 4);
            const u32x4 w = __builtin_bit_cast(u32x4, qf[ds]);
            qn += lo_bf(w.x) * n0[0] + hi_bf(w.x) * n0[1] + lo_bf(w.y) * n0[2] + hi_bf(w.y) * n0[3] + lo_bf(w.z) * n1[0] + hi_bf(w.z) * n1[1] + lo_bf(w.w) * n1[2] + hi_bf(w.w) * n1[3]; }
        qn = x32_sum(qn);
        const float M = fmaxf(m_c, amt), g = __expf(m_c - M), emt = __expf(-(bct + M));
        const bf16_t* mop = P2 + (size_t)tg * NP2 + 1536 + h * 128 + 4 * hh;
        u32x2 mov[4][4];
#pragma unroll
        for (int et = 0; et < 4; ++et)
#pragma unroll
            for (int g4 = 0; g4 < 4; ++g4) mov[et][g4] = *(const u32x2*)(mop + et * 32 + 8 * g4);
        asm volatile("s_waitcnt vmcnt(0)" ::: "memory"); __builtin_amdgcn_s_barrier(); asm volatile("" ::: "memory");
        const LAS unsigned char* rl = reg + lane * 16;
        f32x16 acc[4];
#pragma unroll
        for (int et = 0; et < 4; ++et) { acc[et] = zero16();
#pragma unroll
            for (int ds = 0; ds < 4; ++ds) acc[et] = __builtin_amdgcn_mfma_f32_32x32x16_bf16(*(const LAS bf16x8*)(rl + 16384 + (et * 4 + ds) * 1024), qf[ds], acc[et], 0, 0, 0);
#pragma unroll
            for (int r = 0; r < 16; ++r) acc[et][r] *= g; }
        float wsum = 0.f;
        for (int kt = 0; kt <= tq; ++kt) {
            f32x16 sc = zero16();
#pragma unroll
            for (int ds = 0; ds < 4; ++ds) sc = __builtin_amdgcn_mfma_f32_32x32x16_bf16(*(const LAS bf16x8*)(rl + (kt * 4 + ds) * 1024), qf[ds], sc, 0, 0, 0);
            const float* ap = AV + (size_t)h * T + t0 + 32 * kt + 8 * hh;
            const f32x4 a00 = *(const f32x4*)(ap), a01 = *(const f32x4*)(ap + 4), a10 = *(const f32x4*)(ap + 16), a11 = *(const f32x4*)(ap + 20);
#pragma unroll
            for (int r = 0; r < 16; ++r) { const float av = (r < 4) ? a00[r & 3] : (r < 8) ? a01[r & 3] : (r < 12) ? a10[r & 3] : a11[r & 3];
                const int ko = 16 * (r >> 3) + 8 * hh + (r & 7);
                float w = sc[r] * __expf(av - M);
                w = (kt == tq && ko > i) ? 0.f : w;
                sc[r] = w; wsum += w; }
            u32x4 wf[2];
#pragma unroll
            for (int sb = 0; sb < 2; ++sb) { wf[sb].x = cvt_pk_bf16(sc[8 * sb + 0], sc[8 * sb + 1]); wf[sb].y = cvt_pk_bf16(sc[8 * sb + 2], sc[8 * sb + 3]); wf[sb].z = cvt_pk_bf16(sc[8 * sb + 4], sc[8 * sb + 5]); wf[sb].w = cvt_pk_bf16(sc[8 * sb + 6], sc[8 * sb + 7]); }
#pragma unroll
            for (int et = 0; et < 4; ++et)
#pragma unroll
                for (int sb = 0; sb < 2; ++sb) acc[et] = __builtin_amdgcn_mfma_f32_32x32x16_bf16(*(const LAS bf16x8*)(rl + 32768 + (et * 8 + 2 * kt + sb) * 1024), __builtin_bit_cast(bf16x8, wf[sb]), acc[et], 0, 0, 0);
        }
        wsum = x32_sum(wsum);
        const float den = g * qn + wsum, idd = 1.0f / fmaxf(fabsf(den), emt);
        float ss = 0.f;
#pragma unroll
        for (int et = 0; et < 4; ++et)
#pragma unroll
            for (int r = 0; r < 16; ++r) { const float hv = acc[et][r] * idd; acc[et][r] = hv; ss += hv * hv; }
        ss = x32_sum(ss);
        const float rn = rsqrtf(ss * (1.0f / 128.0f) + EPS);
        bf16_t* op = cat + (size_t)tg * DM + 512 + h * 128 + 4 * hh;
        const float* gp = mng + h * 128 + 4 * hh;
#pragma unroll
        for (int et = 0; et < 4; ++et)
#pragma unroll
            for (int g4 = 0; g4 < 4; ++g4) { const f32x4 gv = *(const f32x4*)(gp + et * 32 + 8 * g4); const u32x2 mo = mov[et][g4];
                const float o0 = lo_bf(mo.x), o1 = hi_bf(mo.x), o2 = lo_bf(mo.y), o3 = hi_bf(mo.y);
                const float y0 = acc[et][4 * g4] * rn * gv[0] * __builtin_amdgcn_rcpf(1.0f + __expf(-o0)), y1 = acc[et][4 * g4 + 1] * rn * gv[1] * __builtin_amdgcn_rcpf(1.0f + __expf(-o1));
                const float y2 = acc[et][4 * g4 + 2] * rn * gv[2] * __builtin_amdgcn_rcpf(1.0f + __expf(-o2)), y3 = acc[et][4 * g4 + 3] * rn * gv[3] * __builtin_amdgcn_rcpf(1.0f + __expf(-o3));
                u32x2 w; w.x = cvt_pk_bf16(y0, y1); w.y = cvt_pk_bf16(y2, y3); *(u32x2*)(op + et * 32 + 8 * g4) = w; }
        asm volatile("s_waitcnt lgkmcnt(0)" ::: "memory"); __builtin_amdgcn_s_barrier(); asm volatile("" ::: "memory");
    }
}

constexpr int NWAVES = 8;
constexpr int RING_BYTES = 131072;
constexpr int LDSCTL_OFF = RING_BYTES;
constexpr int LDS_BYTES = RING_BYTES + 5120;

enum Phase { PH_PREP = 0, PH_INPROJ = 1, PH_MIX0 = 2, PH_MIX1 = 3, PH_MIX2 = 4, PH_OUTPROJ = 5, PH_QKV = 6, PH_XATTN = 7, PH_COPROJ = 8, PH_ROUTER = 9, PH_G1 = 10, PH_G2 = 11, PH_COMBINE = 12, PH_END = 13 };

struct Args { const float* in[28]; float* out; unsigned char* ws; int ph_lo, ph_hi, pass_lo, pass_hi; };

struct CJob { const float* src; const float* g; unsigned char* dst; int Nsrc, k0, n0, mode, f8; float scale; };
__device__ __forceinline__ void conv_load(const CJob& j, f32x4 (&v)[2], int tid) {
    const int kk = tid >> 4, c4 = (tid & 15) * 4;
#pragma unroll
    for (int rep = 0; rep < 2; ++rep) v[rep] = *(const f32x4*)(j.src + (size_t)(j.k0 + kk + 32 * rep) * j.Nsrc + j.n0 + c4);
}
__device__ __forceinline__ void conv_put(LAS float* tile, const f32x4 (&v)[2], int tid) {
    const int kk = tid >> 4, c4 = (tid & 15) * 4;
#pragma unroll
    for (int rep = 0; rep < 2; ++rep)
#pragma unroll
        for (int q = 0; q < 4; ++q) tile[(kk + 32 * rep) * 65 + c4 + q] = v[rep][q];
}
__device__ __forceinline__ void conv_store(const LAS float* tile, const CJob& j, int tid) {
    const int n = tid >> 3, kc = tid & 7; float vals[8];
    f32x4 g0 = (f32x4){1.f, 1.f, 1.f, 1.f}, g1 = g0;
    if (j.g) { g0 = *(const f32x4*)(j.g + j.k0 + 8 * kc); g1 = *(const f32x4*)(j.g + j.k0 + 8 * kc + 4); }
#pragma unroll
    for (int q = 0; q < 8; ++q) vals[q] = tile[(8 * kc + q) * 65 + n] * (q < 4 ? g0[q & 3] : g1[q & 3]) * j.scale;
    const int sc = j.n0 + n; int drow = sc;
    if (j.mode == 1) { const int jj = sc >> 1, s = sc & 1; drow = 256 * (jj >> 7) + 128 * s + (jj & 127); }
    if (j.mode == 2) { drow = sc < 1024 ? sc : sc < 1536 ? sc + 1024 : sc < 2048 ? sc - 512 : sc < 2560 ? sc + 512 : sc - 1024; }
    if (j.f8) { unsigned w0 = 0u, w1 = 0u;
        w0 = __builtin_amdgcn_cvt_pk_fp8_f32(c8(vals[0]), c8(vals[1]), w0, false); w0 = __builtin_amdgcn_cvt_pk_fp8_f32(c8(vals[2]), c8(vals[3]), w0, true);
        w1 = __builtin_amdgcn_cvt_pk_fp8_f32(c8(vals[4]), c8(vals[5]), w1, false); w1 = __builtin_amdgcn_cvt_pk_fp8_f32(c8(vals[6]), c8(vals[7]), w1, true);
        *(u32x2*)(j.dst + (size_t)drow * 1024 + j.k0 + 8 * kc) = (u32x2){w0, w1}; }
    else { u32x4 w; w.x = cvt_pk_bf16(vals[0], vals[1]); w.y = cvt_pk_bf16(vals[2], vals[3]); w.z = cvt_pk_bf16(vals[4], vals[5]); w.w = cvt_pk_bf16(vals[6], vals[7]);
        *(u32x4*)(j.dst + ((size_t)drow * 1024 + j.k0 + 8 * kc) * 2) = w; }
}

__global__ void __launch_bounds__(NWAVES * 64, 2) fwd(Args args) {
    extern __shared__ __attribute__((aligned(16))) unsigned char lds_raw[];
    LAS unsigned char* lds = (LAS unsigned char*)lds_raw;
    volatile LAS unsigned* LCTL = (volatile LAS unsigned*)(lds + LDSCTL_OFF);
    const int wave = __builtin_amdgcn_readfirstlane(threadIdx.x >> 6);
#define lane lane_id()
#define tid (wave * 64 + lane_id())
    const int G = gridDim.x, bx = blockIdx.x;
    unsigned char* ws = args.ws;
    unsigned* ctl = (unsigned*)(ws + WS_CTL);
    const int lo = args.ph_lo, hi = args.ph_hi;
#ifndef PHMASK
#define PHMASK 0xffffff
#endif
#ifndef DUPMASK
#define DUPMASK 0x0
#endif
#define IN(k) (((PHMASK >> (k)) & 1) && lo <= (k) && (k) < hi)
#define NREP(k) ((((DUPMASK) >> (k)) & 1) ? 2 : 1)
#define ENDBAR(k) (BOTH(k) || (((DUPMASK) >> (k)) & 1))
#define BOTH(k) (IN(k) && IN((k) + 1))
    for (int u = tid; u < (LDS_BYTES - LDSCTL_OFF) / 4; u += NWAVES * 64) LCTL[u] = 0u;
    __syncthreads();
    XcdBarrier bar; bar.bar = ctl + CW_BAR; bar.x = 0; bar.st = LCTL; bar.wave = wave;
    const bool multi = (hi - lo) > 1 || (args.pass_hi - args.pass_lo) > 1 || (IN(PH_G1) && IN(PH_G2));
    if (multi) bar = xcd_barrier_post(ctl + CW_BAR, LCTL, wave);
#define GRID_BAR() xcd_barrier(bar)

    const float* x = args.in[0]; const float* mem = args.in[1];
    bf16_t* XB = (bf16_t*)(ws + WS_XB); bf16_t* PROJ = (bf16_t*)(ws + WS_PROJ); bf16_t* CAT = (bf16_t*)(ws + WS_CAT);
    bf16_t* MEMB = (bf16_t*)(ws + WS_MEMB); bf16_t* KV = (bf16_t*)(ws + WS_KV); bf16_t* VT2 = (bf16_t*)(ws + WS_VT2); bf16_t* VT1 = (bf16_t*)(ws + WS_VT1); unsigned char* H1F = ws + WS_H1F;
    bf16_t* WIN = (bf16_t*)(ws + WS_WIN); bf16_t* WOUT = (bf16_t*)(ws + WS_WOUT); bf16_t* WCQ = (bf16_t*)(ws + WS_WCQ); bf16_t* WCKV = (bf16_t*)(ws + WS_WCKV);
    bf16_t* WCO = (bf16_t*)(ws + WS_WCO); bf16_t* WR = (bf16_t*)(ws + WS_WR); unsigned char* W1F = ws + WS_W1; unsigned char* W2F = ws + WS_W2; unsigned char* H2F = ws + WS_H2F;
    float* RSTDX = (float*)(ws + WS_RSTDX); float* RSTDM = (float*)(ws + WS_RSTDM); float* B1P = (float*)(ws + WS_B1P); float* MISC = (float*)(ws + WS_MISC); float* RSTD2 = (float*)(ws + WS_RSTD2);
    float* SSP1 = (float*)(ws + WS_SSP1); float* SSP2 = (float*)(ws + WS_SSP2); float* GATES = (float*)(ws + WS_GATES);
    unsigned* TOKMAP = (unsigned*)(ws + WS_TOKMAP); float* GATEV = (float*)(ws + WS_GATEV); unsigned* LIST = (unsigned*)(ws + WS_LIST);
    unsigned char* YB = ws + WS_Y; unsigned char* HID = ws + WS_HID;

    if (IN(PH_PREP)) for (int rep_ = 0; rep_ < NREP(PH_PREP); ++rep_) {
        constexpr int J0 = 768, J1 = J0 + 256, J2 = J1 + 256, J3 = J2 + 512, J4 = J3 + 256, J5 = J4 + 16384, J6 = J5 + 8192;
        auto decode = [&](int it, CJob& j) {
            if (it < J0) { j = CJob{args.in[3], args.in[2], (unsigned char*)WIN, DIN, (it / 48) * 64, (it % 48) * 64, 2, 0, 1.0f}; }
            else if (it < J1) { const int r = it - J0; j = CJob{args.in[14], nullptr, (unsigned char*)WOUT, 1024, (r / 16) * 64, (r % 16) * 64, 0, 0, 1.0f}; }
            else if (it < J2) { const int r = it - J1; j = CJob{args.in[17], args.in[15], (unsigned char*)WCQ, 1024, (r / 16) * 64, (r % 16) * 64, 0, 1, 64.0f}; }
            else if (it < J3) { const int r = it - J2; j = CJob{args.in[18], args.in[16], (unsigned char*)WCKV, 2048, (r / 32) * 64, (r % 32) * 64, 0, 1, 64.0f}; }
            else if (it < J4) { const int r = it - J3; j = CJob{args.in[19], nullptr, (unsigned char*)WCO, 1024, (r / 16) * 64, (r % 16) * 64, 0, 1, 64.0f}; }
            else if (it < J5) { const int r = it - J4; const int e = r >> 9, q = r & 511; j = CJob{args.in[23] + (size_t)e * 1024 * 2048, args.in[20], W1F + (size_t)e * 2048 * 1024, 2048, (q / 32) * 64, (q % 32) * 64, 1, 1, 64.0f}; }
            else { const int r = it - J5; const int e = r >> 8, q = r & 255; j = CJob{args.in[25] + (size_t)e * 1024 * 1024, nullptr, W2F + (size_t)e * 1024 * 1024, 1024, (q / 16) * 64, (q % 16) * 64, 0, 1, 64.0f}; } };
        for (int it0 = bx * 4; it0 < J6; it0 += G * 4) {
            CJob jb[4]; f32x4 v[4][2];
#pragma unroll
            for (int q = 0; q < 4; ++q) { decode(it0 + q < J6 ? it0 + q : J6 - 1, jb[q]); conv_load(jb[q], v[q], tid); }
#pragma unroll
            for (int q = 0; q < 4; ++q) conv_put((LAS float*)lds + q * (64 * 65), v[q], tid);
            __syncthreads();
#pragma unroll
            for (int q = 0; q < 4; ++q) if (it0 + q < J6) conv_store((const LAS float*)lds + q * (64 * 65), jb[q], tid);
            __syncthreads();
        }
        for (int i = bx * 512 + tid; i < NEXP * 1024; i += G * 512) { const int e = i >> 10, k = i & 1023; WR[i] = (bf16_t)f2bf(args.in[21][k * NEXP + e] * args.in[20][k]); }
        for (int i = bx * 512 + tid; i < NEXP * 2048; i += G * 512) { const int e = i >> 11, rho = i & 2047; const int pn = rho >> 8, s = (rho >> 7) & 1, ii = rho & 127; B1P[i] = args.in[24][e * 2048 + 2 * (128 * pn + ii) + s]; }
        if (bx == 0 && wave == 0) { const float a = wave_sum(args.in[9][lane] * args.in[10][lane]), b = wave_sum(args.in[11][lane] * args.in[12][lane]);
            if (lane == 0) MISC[0] = expf(a) - expf(b) + LAMBDA_INIT; }
        {
            const float* win = args.in[3]; const float* g = args.in[2];
            float wg[4][4][8];
#pragma unroll
            for (int jj = 0; jj < 4; ++jj)
#pragma unroll
                for (int q = 0; q < 4; ++q) { const int k = 4 * lane + 256 * jj + q; const float gk = g[k];
                    const f32x4 a = *(const f32x4*)(win + (size_t)k * DIN + 3072), b = *(const f32x4*)(win + (size_t)k * DIN + 3076);
#pragma unroll
                    for (int j = 0; j < 4; ++j) { wg[jj][q][j] = a[j] * gk; wg[jj][q][4 + j] = b[j] * gk; } }
            const int gw = bx * NWAVES + wave, NGW = G * NWAVES;
            f32x4 vn[4];
            if (gw < T) { const f32x4* xr = (const f32x4*)(x + (size_t)gw * DM) + lane;
#pragma unroll
                for (int jj = 0; jj < 4; ++jj) vn[jj] = xr[64 * jj]; }
            for (int row = gw; row < T; row += NGW) {
                f32x4 v[4]; float ss = 0.f; float d[8];
#pragma unroll
                for (int jj = 0; jj < 4; ++jj) v[jj] = vn[jj];
                if (row + NGW < T) { const f32x4* xr = (const f32x4*)(x + (size_t)(row + NGW) * DM) + lane;
#pragma unroll
                    for (int jj = 0; jj < 4; ++jj) vn[jj] = xr[64 * jj]; }
#pragma unroll
                for (int j = 0; j < 8; ++j) d[j] = 0.f;
#pragma unroll
                for (int jj = 0; jj < 4; ++jj) {
#pragma unroll
                    for (int q = 0; q < 4; ++q) { ss += v[jj][q] * v[jj][q];
#pragma unroll
                        for (int j = 0; j < 8; ++j) d[j] += v[jj][q] * wg[jj][q][j]; } }
                ss = wave_sum(ss);
#pragma unroll
                for (int j = 0; j < 8; ++j) d[j] = wave_sum(d[j]);
                const float rs = rsqrtf(ss * (1.0f / DM) + EPS);
                u32x2* o8 = (u32x2*)(XB + (size_t)row * DM) + lane;
#pragma unroll
                for (int jj = 0; jj < 4; ++jj) { u32x2 w; w.x = cvt_pk_bf16(v[jj][0], v[jj][1]); w.y = cvt_pk_bf16(v[jj][2], v[jj][3]); o8[64 * jj] = w; }
                if (lane == 0) RSTDX[row] = rs;
                if (lane < 8) { float dv = d[0];
#pragma unroll
                    for (int j = 1; j < 8; ++j) dv = (lane == j) ? d[j] : dv;
                    dv *= rs; float r;
                    if (lane < 4) r = dv + args.in[6][lane];
                    else { const float z = dv + args.in[7][lane - 4]; r = (z >= 0.f) ? -log1pf(expf(-z)) : (z - log1pf(expf(z))); }
                    GATES[(size_t)row * 8 + lane] = r; }
            }
            for (int row = gw; row < MROWS; row += NGW) {
                const f32x4* xr = (const f32x4*)(mem + (size_t)row * DM) + lane;
                f32x4 v[4]; float ss = 0.f;
#pragma unroll
                for (int jj = 0; jj < 4; ++jj) { v[jj] = xr[64 * jj]; ss += (v[jj][0] * v[jj][0] + v[jj][1] * v[jj][1]) + (v[jj][2] * v[jj][2] + v[jj][3] * v[jj][3]); }
                ss = wave_sum(ss);
                unsigned* o4 = (unsigned*)((unsigned char*)MEMB + (size_t)row * DM) + lane;
#pragma unroll
                for (int jj = 0; jj < 4; ++jj) { unsigned w = 0u; w = __builtin_amdgcn_cvt_pk_fp8_f32(c8(v[jj][0]), c8(v[jj][1]), w, false); w = __builtin_amdgcn_cvt_pk_fp8_f32(c8(v[jj][2]), c8(v[jj][3]), w, true); o4[64 * jj] = w; }
                if (lane == 0) RSTDM[row] = rsqrtf(ss * (1.0f / DM) + EPS);
            }
        }
        if (ENDBAR(PH_PREP)) GRID_BAR();
    }

    if (IN(PH_INPROJ)) for (int rep_ = 0; rep_ < NREP(PH_INPROJ); ++rep_) {
        { ProbScaleBf16 P{(LAS unsigned*)(lds + LDSCTL_OFF + 2048), XB, WIN, T / 256, NP2 / 256, G, bx, PROJ, NP2, RSTDX, nullptr};
          pg8::gemm_phase<ProbScaleBf16, true>(lds, P, wave); }
        { ProbColScaleBf16 P{WIN + (size_t)NP2 * 1024, XB, 4, T / 256, G, bx, VT1, T, RSTDX};
          pg8::gemm_phase<ProbColScaleBf16, true>(lds, P, wave); }
        if (ENDBAR(PH_INPROJ)) GRID_BAR();
    }

    const int vx = (G % 8 == 0) ? (bx % 8) * (G / 8) + bx / 8 : bx;
    bf16_t* QM = (bf16_t*)(ws + WS_QM); bf16_t* KM = (bf16_t*)(ws + WS_KM); bf16_t* CSTB = (bf16_t*)(ws + WS_CSTB);
    float* BC = (float*)(ws + WS_BC); float* AV = (float*)(ws + WS_AV); float* AM = (float*)(ws + WS_AM); float* NLOC = (float*)(ws + WS_NLOC); float* NST = (float*)(ws + WS_NST);
    float* CH = (float*)(ws + WS_CH); float* MSTATE = (float*)(ws + WS_MSTATE); float* CLOC = (float*)(ws + WS_MST);
    if (IN(PH_MIX0)) for (int rep_ = 0; rep_ < NREP(PH_MIX0); ++rep_) {
        mlstm_prep_phase(lds, PROJ, VT1, GATES, args.in[4], args.in[5], QM, KM, BC, AV, AM, CH, NLOC, CLOC, G, vx, wave);
        if (ENDBAR(PH_MIX0)) GRID_BAR();
    }
    if (IN(PH_MIX1)) for (int rep_ = 0; rep_ < NREP(PH_MIX1); ++rep_) {
        mlstm_scan_phase(CLOC, NLOC, CH, CSTB, NST, MSTATE, G, bx, tid);
        if (ENDBAR(PH_MIX1)) GRID_BAR();
    }
    if (IN(PH_MIX2)) for (int rep_ = 0; rep_ < NREP(PH_MIX2); ++rep_) {
        mlstm_out_phase(lds, PROJ, VT1, QM, KM, BC, AV, AM, CSTB, NST, MSTATE, args.in[8], CAT, G, vx, wave);
        __syncthreads();
        const float lam = __hip_atomic_load(MISC, __ATOMIC_RELAXED, __HIP_MEMORY_SCOPE_AGENT);
        diffattn_phase(lds, PROJ, VT1, args.in[13], lam, CAT, G, vx, wave);
        if (ENDBAR(PH_MIX2)) GRID_BAR();
    }

    if (IN(PH_OUTPROJ)) for (int rep_ = 0; rep_ < NREP(PH_OUTPROJ); ++rep_) {
        ProbResidT<false, true, false> P{(LAS unsigned*)(lds + LDSCTL_OFF + 2048), CAT, WOUT, T / 256, 4, G, bx, nullptr, XB, XB, H1F, SSP1};
        pg8::gemm_phase<ProbResidT<false, true, false>, true>(lds, P, wave);
        if (ENDBAR(PH_OUTPROJ)) GRID_BAR();
    }

    if (IN(PH_QKV)) for (int rep_ = 0; rep_ < NREP(PH_QKV); ++rep_) {
        { ProbScaleT<true> P{(LAS unsigned*)(lds + LDSCTL_OFF + 2048), H1F, WCQ, T / 256, 4, G, bx, PROJ, 1024, nullptr, SSP1};
          pg8::gemm_phase<ProbScaleT<true>, true>(lds, P, wave); }
        { ProbKV P{(LAS unsigned*)(lds + LDSCTL_OFF + 2048), (const unsigned char*)MEMB, (const unsigned char*)WCKV, KV, VT2, RSTDM, G, bx};
          pg8::gemm_phase<ProbKV, true>(lds, P, wave); }
        if (ENDBAR(PH_QKV)) GRID_BAR();
    }

    if (IN(PH_XATTN)) for (int rep_ = 0; rep_ < NREP(PH_XATTN); ++rep_) {
        xattn_phase(lds, PROJ, KV, VT2, (unsigned char*)(PROJ + (size_t)T * 1024), G, vx, wave);
        if (ENDBAR(PH_XATTN)) GRID_BAR();
    }

    if (IN(PH_COPROJ)) for (int rep_ = 0; rep_ < NREP(PH_COPROJ); ++rep_) {
        ProbResidT<true, false, false> P{(LAS unsigned*)(lds + LDSCTL_OFF + 2048), (unsigned char*)(PROJ + (size_t)T * 1024), WCO, T / 256, 4, G, bx, nullptr, XB, CAT, nullptr, SSP2};
        pg8::gemm_phase<ProbResidT<true, false, false>, true>(lds, P, wave);
        if (ENDBAR(PH_COPROJ)) GRID_BAR();
    }

    if (IN(PH_ROUTER)) for (int rep_ = 0; rep_ < NREP(PH_ROUTER); ++rep_) {
        { u32x4 wv[8];
#pragma unroll
          for (int q = 0; q < 8; ++q) { const int idx = q * (NWAVES * 64) + tid, ks = idx >> 6, ln = idx & 63; wv[q] = *(const u32x4*)(WR + (size_t)(ln & 31) * DM + 16 * ks + 8 * (ln >> 5)); }
#pragma unroll
          for (int q = 0; q < 8; ++q) { const int idx = q * (NWAVES * 64) + tid; *(LAS u32x4*)(lds + idx * 16) = wv[q]; } }
        __syncthreads();
        const float* brt = args.in[22];
        const int i = lane & 31, hh = lane >> 5;
        volatile LAS unsigned* lcnt = (volatile LAS unsigned*)(lds + 65536);
        const int ntrip = (T / 32 + G * NWAVES - 1) / (G * NWAVES);
        for (int trip = 0; trip < ntrip; ++trip) {
            const int tile = trip * G * NWAVES + bx * NWAVES + wave; const bool act = tile < T / 32;
            if (tid < 32) lcnt[tid] = 0u;
            __syncthreads();
            const int t = (act ? tile : 0) * 32 + i;
            const bf16_t* xp = CAT + (size_t)t * DM + 8 * hh;
            const f32x4 p0 = *(const f32x4*)(SSP2 + (size_t)t * 16 + 8 * hh), p1 = *(const f32x4*)(SSP2 + (size_t)t * 16 + 8 * hh + 4);
            float sp = (p0[0] + p0[1]) + (p0[2] + p0[3]) + (p1[0] + p1[1]) + (p1[2] + p1[3]); sp = x32_sum(sp);
            const float rs = rsqrtf(sp * (1.0f / DM) + EPS);
            f32x16 acc = zero16();
#pragma unroll 16
            for (int ks = 0; ks < 64; ++ks) { const bf16x8 xf = *(const bf16x8*)(xp + 16 * ks); const bf16x8 wf = *(const LAS bf16x8*)(lds + (ks * 64 + lane) * 16);
                acc = __builtin_amdgcn_mfma_f32_32x32x16_bf16(wf, xf, acc, 0, 0, 0);
                if (act) { const u32x4 xw = __builtin_bit_cast(u32x4, xf); unsigned w0 = 0u, w1 = 0u;
                    w0 = __builtin_amdgcn_cvt_pk_fp8_f32(lo_bf(xw.x) * rs, hi_bf(xw.x) * rs, w0, false); w0 = __builtin_amdgcn_cvt_pk_fp8_f32(lo_bf(xw.y) * rs, hi_bf(xw.y) * rs, w0, true);
                    w1 = __builtin_amdgcn_cvt_pk_fp8_f32(lo_bf(xw.z) * rs, hi_bf(xw.z) * rs, w1, false); w1 = __builtin_amdgcn_cvt_pk_fp8_f32(lo_bf(xw.w) * rs, hi_bf(xw.w) * rs, w1, true);
                    *(u32x2*)(H2F + (size_t)t * DM + 16 * ks + 8 * hh) = (u32x2){w0, w1}; } }
            float mine[16], oth[16];
#pragma unroll
            for (int r = 0; r < 16; ++r) { const int e = (r & 3) + 8 * (r >> 2); mine[r] = acc[r] * rs + brt[e + 4 * hh]; }
#pragma unroll
            for (int r = 0; r < 16; ++r) oth[r] = x32_other(mine[r], hh);
            float lg[NEXP];
#pragma unroll
            for (int r = 0; r < 16; ++r) { const int e = (r & 3) + 8 * (r >> 2); lg[e] = hh ? oth[r] : mine[r]; lg[e + 4] = hh ? mine[r] : oth[r]; }
            unsigned taken = 0u; float tv[4]; int te[4];
#pragma unroll
            for (int k = 0; k < TOPK; ++k) { float best = -INFINITY; int bi = 0;
#pragma unroll
                for (int e = 0; e < NEXP; ++e) { const bool ok = !((taken >> e) & 1u) && (lg[e] > best); best = ok ? lg[e] : best; bi = ok ? e : bi; }
                taken |= 1u << bi; tv[k] = best; te[k] = bi; }
            const float q1 = __expf(tv[1] - tv[0]), q2 = __expf(tv[2] - tv[0]), q3 = __expf(tv[3] - tv[0]); const float inv = 1.0f / (1.0f + q1 + q2 + q3);
            const float gk[4] = {inv, q1 * inv, q2 * inv, q3 * inv};
            unsigned lp[4] = {0u, 0u, 0u, 0u};
            if (act && hh == 0) {
#pragma unroll
                for (int k = 0; k < TOPK; ++k) lp[k] = __hip_atomic_fetch_add((LAS unsigned*)(lcnt + te[k]), 1u, __ATOMIC_RELAXED, __HIP_MEMORY_SCOPE_WORKGROUP); }
            __syncthreads();
            if (tid < 32) { const unsigned n = lcnt[tid]; lcnt[32 + tid] = n ? atomicAdd(&ctl[CW_CNT + tid], n) : 0u; }
            __syncthreads();
            if (act && hh == 0) { RSTD2[t] = rs;
                unsigned tm[4];
#pragma unroll
                for (int k = 0; k < TOPK; ++k) { const unsigned pos = lcnt[32 + te[k]] + lp[k]; LIST[(size_t)te[k] * T + pos] = (unsigned)t; tm[k] = ((unsigned)te[k] << 16) | pos; }
                *(u32x4*)(TOKMAP + (size_t)t * 4) = (u32x4){tm[0], tm[1], tm[2], tm[3]};
                *(f32x4*)(GATEV + (size_t)t * 4) = (f32x4){gk[0], gk[1], gk[2], gk[3]}; }
            __syncthreads();
        }
        if (ENDBAR(PH_ROUTER)) GRID_BAR();
    }

    volatile LAS int* tab = (volatile LAS int*)(LCTL + 16);
    int Rtot = 0;
    if (IN(PH_G1) || IN(PH_G2) || IN(PH_COMBINE)) {
        if (tid < NEXP) tab[MOE_CNT + tid] = (int)__hip_atomic_load(&ctl[CW_CNT + tid], __ATOMIC_RELAXED, __HIP_MEMORY_SCOPE_AGENT);
        __syncthreads();
        if (tid == 0) { int ts = 0, st = 0;
            for (int e = 0; e < NEXP; ++e) { const int c = tab[MOE_CNT + e]; tab[MOE_TS + e] = ts; tab[MOE_ST + e] = st; ts += (c + 255) >> 8; st += c; }
            tab[MOE_TS + NEXP] = ts; tab[MOE_ST + NEXP] = st; }
        __syncthreads();
        Rtot = tab[MOE_TS + NEXP];
    }
    if (IN(PH_G1) || IN(PH_G2)) {
        __syncthreads();
        for (int rt = tid; rt < Rtot; rt += NWAVES * 64) { int e = 0;
            for (int j = 1; j < NEXP; ++j) if (rt >= tab[MOE_TS + j]) e = j;
            ((volatile LAS unsigned char*)(tab + MOE_RTE))[rt] = (unsigned char)e; }
        __syncthreads();
        if (IN(PH_G1)) for (int rep_ = 0; rep_ < NREP(PH_G1); ++rep_) { ProbMoe1 P{H2F, W1F, B1P, RSTD2, LIST, HID, tab, (LAS unsigned*)(lds + LDSCTL_OFF + 2048), 0, Rtot, G, bx};
            pg8::gemm_phase<ProbMoe1, true>(lds, P, wave);
            if (IN(PH_G2) || NREP(PH_G1) > 1) GRID_BAR(); }
        if (IN(PH_G2)) for (int rep_ = 0; rep_ < NREP(PH_G2); ++rep_) { ProbMoe2 P{HID, W2F, args.in[26], YB, tab, (LAS unsigned*)(lds + LDSCTL_OFF + 2048), 0, Rtot, G, bx};
            pg8::gemm_phase<ProbMoe2, true>(lds, P, wave);
            if (IN(PH_COMBINE) || NREP(PH_G2) > 1) GRID_BAR(); }
    }
    if (IN(PH_COMBINE)) {
        const float* gf = args.in[27];
        const int gw = bx * NWAVES + wave, NGW = G * NWAVES;
        f32x4 gfv[4];
#pragma unroll
        for (int jj = 0; jj < 4; ++jj) gfv[jj] = *((const f32x4*)gf + 4 * lane + jj);
        u32x4 tmn = (u32x4){0u, 0u, 0u, 0u}; f32x4 gkn = (f32x4){0.f, 0.f, 0.f, 0.f};
        if (gw < T) { tmn = *(const u32x4*)(TOKMAP + (size_t)gw * 4); gkn = *(const f32x4*)(GATEV + (size_t)gw * 4); }
        for (int t = gw; t < T; t += NGW) {
            const u32x4 tm = tmn; const f32x4 gk = gkn;
            if (t + NGW < T) { tmn = *(const u32x4*)(TOKMAP + (size_t)(t + NGW) * 4); gkn = *(const f32x4*)(GATEV + (size_t)(t + NGW) * 4); }
            const u32x4* hb = (const u32x4*)(CAT + (size_t)t * DM) + 2 * lane;
            const u32x4 h0 = hb[0], h1 = hb[1];
            u32x4 yv[4];
#pragma unroll
            for (int k = 0; k < TOPK; ++k) { const int e = (int)(tm[k] >> 16), pos = (int)(tm[k] & 0xffffu); const size_t yrow = (size_t)(tab[MOE_ST + e] + pos);
                yv[k] = *((const u32x4*)(YB + yrow * DM) + lane); }
            float v[16];
            v[0] = lo_bf(h0.x); v[1] = hi_bf(h0.x); v[2] = lo_bf(h0.y); v[3] = hi_bf(h0.y); v[4] = lo_bf(h0.z); v[5] = hi_bf(h0.z); v[6] = lo_bf(h0.w); v[7] = hi_bf(h0.w);
            v[8] = lo_bf(h1.x); v[9] = hi_bf(h1.x); v[10] = lo_bf(h1.y); v[11] = hi_bf(h1.y); v[12] = lo_bf(h1.z); v[13] = hi_bf(h1.z); v[14] = lo_bf(h1.w); v[15] = hi_bf(h1.w);
#pragma unroll
            for (int k = 0; k < TOPK; ++k) { const float g16 = gk[k] * (1.0f / 16.0f);
#pragma unroll
                for (int q = 0; q < 4; ++q) { const f32x2 a = __builtin_amdgcn_cvt_pk_f32_fp8((int)yv[k][q], false), b2_ = __builtin_amdgcn_cvt_pk_f32_fp8((int)yv[k][q], true);
                    v[4 * q] += g16 * a[0]; v[4 * q + 1] += g16 * a[1]; v[4 * q + 2] += g16 * b2_[0]; v[4 * q + 3] += g16 * b2_[1]; } }
            float ss = 0.f;
#pragma unroll
            for (int q = 0; q < 16; ++q) ss += v[q] * v[q];
            ss = wave_sum(ss); const float rs = rsqrtf(ss * (1.0f / DM) + EPS);
            f32x4* orow = (f32x4*)(args.out + (size_t)t * DM) + 4 * lane;
#pragma unroll
            for (int jj = 0; jj < 4; ++jj) orow[jj] = (f32x4){v[4 * jj] * rs * gfv[jj][0], v[4 * jj + 1] * rs * gfv[jj][1], v[4 * jj + 2] * rs * gfv[jj][2], v[4 * jj + 3] * rs * gfv[jj][3]};
        }
    }
#undef IN
#undef BOTH
#undef GRID_BAR
#undef lane
#undef tid
}

extern "C" void kernel_launch(void* const* d_in, const int* in_sizes, int n_in, void* d_out, int out_size, void* d_ws, size_t ws_size, hipStream_t stream) {
    static int grid = 0;
    if (grid == 0) {
        if (n_in != 28 || out_size != T * DM || ws_size < WS_END) { fprintf(stderr, "kernel_launch: unexpected shapes: n_in %d out %d ws %zu\n", n_in, out_size, ws_size); grid = -1; return; }
        int dev = 0, cus = 0;
        if (hipGetDevice(&dev) != hipSuccess || hipDeviceGetAttribute(&cus, hipDeviceAttributeMultiprocessorCount, dev) != hipSuccess) { grid = -1; return; }
        if (hipFuncSetAttribute((const void*)fwd, hipFuncAttributeMaxDynamicSharedMemorySize, LDS_BYTES) != hipSuccess) { fprintf(stderr, "kernel_launch: hipFuncSetAttribute failed\n"); grid = -1; return; }
        int per_cu = 0;
        if (hipOccupancyMaxActiveBlocksPerMultiprocessor(&per_cu, (const void*)fwd, NWAVES * 64, LDS_BYTES) != hipSuccess || per_cu < 1) fprintf(stderr, "kernel_launch: occupancy query says %d\n", per_cu);
        (void)hipGetLastError();
        grid = cus;
    }
    if (grid < 0) return;
    (void)hipMemsetAsync((char*)d_ws + WS_CTL, 0, CTL_ZERO_BYTES, stream);
    Args a{};
    for (int i = 0; i < 28; ++i) a.in[i] = (const float*)d_in[i];
    a.out = (float*)d_out; a.ws = (unsigned char*)d_ws;
    unsigned char* ws = (unsigned char*)d_ws;
    auto run = [&](int lo, int hi, int p0, int p1) { a.ph_lo = lo; a.ph_hi = hi; a.pass_lo = p0; a.pass_hi = p1; hipLaunchKernelGGL(fwd, dim3(grid), dim3(NWAVES * 64), LDS_BYTES, stream, a); };
#ifdef MULTI_LAUNCH
    for (int ph = 0; ph < PH_G1; ++ph) run(ph, ph + 1, 0, 0);
    run(PH_G1, PH_G1 + 1, 0, 1); run(PH_G2, PH_G2 + 1, 0, 1);
    run(PH_COMBINE, PH_COMBINE + 1, 0, 0);
#else
    run(0, PH_END, 0, 5);
#endif
}
```

```cpp
#include <hip/hip_runtime.h>
#include <cstdio>
#include <cstdint>
#include <cmath>

#define GAS __attribute__((address_space(1)))
#define LAS __attribute__((address_space(3)))
typedef unsigned short bf16_t;
typedef short bf16x8 __attribute__((ext_vector_type(8)));
typedef float f32x4 __attribute__((ext_vector_type(4)));
typedef float f32x2 __attribute__((ext_vector_type(2)));
typedef unsigned u32x4 __attribute__((ext_vector_type(4)));
typedef unsigned u32x2 __attribute__((ext_vector_type(2)));
typedef int i32x8 __attribute__((ext_vector_type(8)));
typedef int i32x4 __attribute__((ext_vector_type(4)));

constexpr int BATCH = 32, SEQ = 2048, DM = 1024, T = BATCH * SEQ, MEMLEN = 256, MROWS = BATCH * MEMLEN;
constexpr int NPROJ = 3072, DIN = 3080, NP2 = 2048;
constexpr int NEXP = 32, TOPK = 4;
constexpr float EPS = 1e-5f;
constexpr float LAMBDA_INIT = 0.2f;

constexpr size_t MiB = 1u << 20;
constexpr size_t WS_CTL = 0, CTL_ZERO_BYTES = 64 * 1024;
constexpr size_t WS_RSTDX = 1 * MiB;
constexpr size_t WS_RSTDM = WS_RSTDX + (size_t)T * 4;
constexpr size_t WS_B1P = WS_RSTDM + (size_t)MROWS * 4;
constexpr size_t WS_MISC = WS_B1P + (size_t)NEXP * 2048 * 4;
constexpr size_t WS_RSTD2 = WS_MISC + 4096;
static_assert(WS_RSTD2 + (size_t)T * 4 <= 2 * MiB, "small region");
constexpr size_t WS_SSP1 = 2 * MiB;
constexpr size_t WS_SSP2 = 6 * MiB;
constexpr size_t WS_GATES = 10 * MiB;
constexpr size_t WS_TOKMAP = 12 * MiB;
constexpr size_t WS_GATEV = 13 * MiB;
constexpr size_t WS_LIST = 14 * MiB;
constexpr size_t WS_WIN = 24 * MiB;
constexpr size_t WS_WOUT = 30 * MiB;
constexpr size_t WS_WCQ = 32 * MiB;
constexpr size_t WS_WCKV = 34 * MiB;
constexpr size_t WS_WCO = 38 * MiB;
constexpr size_t WS_WR = 40 * MiB;
constexpr size_t WS_W1 = 64 * MiB;
constexpr size_t WS_H2F = 128 * MiB;
constexpr size_t WS_W2 = 192 * MiB;
constexpr size_t WS_XB = 256 * MiB;
constexpr size_t WS_PROJ = 384 * MiB;
constexpr size_t WS_H1F = 640 * MiB;
constexpr size_t WS_VT1 = 640 * MiB;
constexpr size_t WS_CAT = 768 * MiB;
constexpr size_t WS_MST = 896 * MiB;
constexpr size_t WS_MEMB = 962 * MiB;
constexpr size_t WS_KV = 978 * MiB;
constexpr size_t WS_VT2 = 994 * MiB;
constexpr size_t WS_QM = 128 * MiB;
constexpr size_t WS_KM = 160 * MiB;
constexpr size_t WS_CSTB = 224 * MiB;
constexpr size_t WS_BC = 1010 * MiB;
constexpr size_t WS_AV = 1011 * MiB;
constexpr size_t WS_AM = 1012 * MiB;
constexpr size_t WS_NLOC = 1013 * MiB;
constexpr size_t WS_NST = WS_NLOC + 512 * 1024;
constexpr size_t WS_CH = 1014 * MiB;
constexpr size_t WS_MSTATE = WS_CH + 64 * 1024;
constexpr size_t WS_Y = 256 * MiB;
constexpr size_t WS_HID = 512 * MiB;
constexpr size_t WS_HID1 = 896 * MiB;
constexpr size_t WS_END = 1024 * MiB;

constexpr int CW_CNT = 64;
constexpr int CW_BAR = 4096;
static_assert((CW_BAR + 3456) * 4 <= (int)CTL_ZERO_BYTES, "control words inside the per-call memset");

__device__ __forceinline__ float bf2f(bf16_t b) { return __uint_as_float(((unsigned)b) << 16); }
__device__ __forceinline__ unsigned f2bf(float f) { unsigned u = __float_as_uint(f); return (u + 0x7fffu + ((u >> 16) & 1u)) >> 16; }
__device__ __forceinline__ unsigned cvt_pk_bf16(float lo, float hi) { unsigned r; asm volatile("v_cvt_pk_bf16_f32 %0, %1, %2" : "=v"(r) : "v"(lo), "v"(hi)); return r; }
__device__ __forceinline__ float x32_sum(float v) { auto r = __builtin_amdgcn_permlane32_swap(__float_as_uint(v), __float_as_uint(v), false, false); return __uint_as_float(r[0]) + __uint_as_float(r[1]); }
__device__ __forceinline__ float x32_max(float v) { auto r = __builtin_amdgcn_permlane32_swap(__float_as_uint(v), __float_as_uint(v), false, false); return fmaxf(__uint_as_float(r[0]), __uint_as_float(r[1])); }
__device__ __forceinline__ float x32_other(float v, int hh) { auto r = __builtin_amdgcn_permlane32_swap(__float_as_uint(v), __float_as_uint(v), false, false); return hh ? __uint_as_float(r[0]) : __uint_as_float(r[1]); }
__device__ __forceinline__ float x16_sum(float v) { auto r = __builtin_amdgcn_permlane16_swap(__float_as_uint(v), __float_as_uint(v), false, false); return __uint_as_float(r[0]) + __uint_as_float(r[1]); }
__device__ __forceinline__ float row16_sum(float v) {
    v += __uint_as_float((unsigned)__builtin_amdgcn_update_dpp(0, (int)__float_as_uint(v), 0xB1, 0xf, 0xf, true));
    v += __uint_as_float((unsigned)__builtin_amdgcn_update_dpp(0, (int)__float_as_uint(v), 0x4E, 0xf, 0xf, true));
    v += __uint_as_float((unsigned)__builtin_amdgcn_update_dpp(0, (int)__float_as_uint(v), 0x141, 0xf, 0xf, true));
    v += __uint_as_float((unsigned)__builtin_amdgcn_update_dpp(0, (int)__float_as_uint(v), 0x140, 0xf, 0xf, true));
    return v; }
__device__ __forceinline__ float wave_sum(float v) { return x32_sum(x16_sum(row16_sum(v))); }
__device__ __forceinline__ int lane_id() { int l; asm volatile("v_mbcnt_lo_u32_b32 %0, -1, 0\n\tv_mbcnt_hi_u32_b32 %0, -1, %0" : "=v"(l)); return l; }
__device__ __forceinline__ float c8(float x) { return __builtin_amdgcn_fmed3f(x, -448.0f, 448.0f); }
__device__ __forceinline__ float lo_bf(unsigned w) { return __uint_as_float(w << 16); }
__device__ __forceinline__ float hi_bf(unsigned w) { return __uint_as_float(w & 0xffff0000u); }

namespace pg8 {
constexpr int BM = 256, BK = 64, HALF = 128, HTB = HALF * BK * 2, STAGE_BYTES = 8 * HTB, NXCD = 8, WGM = 8, KD = 1024, NT = KD / BK;
__host__ __device__ __forceinline__ int lds_byte(int r, int c) { const int st = (r >> 4) * 2 + (c >> 5), rr = r & 15, cc = c & 31, ob = rr * 64 + cc * 2; return st * 1024 + (ob ^ (((ob >> 9) & 1) << 5)); }
__host__ __device__ __forceinline__ void stage_rc(int b, int& R, int& C) { const int st = b / 1024, sb = b % 1024, swz = sb ^ (((sb >> 9) & 1) << 5); R = (st >> 1) * 16 + swz / 64; C = (st & 1) * 32 + (swz % 64) / 2; }
__host__ __device__ __forceinline__ int perm32(int rho) { const int n = rho >> 4, i = rho & 15; return 8 * (i >> 2) + 4 * n + (i & 3); }

struct Unit { const char* A; const char* B; int pm, pn, e, nvalid, y0, aux; };

__device__ __forceinline__ bool static_next(int i, int G, int c, int nM, int nN, int& pm, int& pn) {
    const int nwg = nM * nN; const long L = (long)i * G + c; if (L >= nwg) return false;
    int wgid = (int)L; { const int q = nwg / NXCD, r = nwg % NXCD, xcd = wgid % NXCD, off = wgid / NXCD; wgid = (xcd < r ? xcd * (q + 1) : r * (q + 1) + (xcd - r) * q) + off; }
    const int nig = WGM * nN, gid = wgid / nig, fm = gid * WGM, gsz = (nM - fm) < WGM ? (nM - fm) : WGM;
    pm = fm + ((wgid % nig) % gsz); pn = (wgid % nig) / gsz; return true;
}

template <class P, bool ALIGN_EPI>
__device__ __forceinline__ void gemm_phase(LAS unsigned char* lds, const P& prob, const int wid) {
    const int lane = lane_id(), tid = wid * 64 + lane, wr = wid >> 2, wc = wid & 3, fr = lane & 15, fq = lane >> 4;
    constexpr int ROWB = P::FP8 ? KD : 2 * KD;
    constexpr int nt = ROWB / 128;
    int RA[2], CA[2]; unsigned voffA[2], voffB[2];
#pragma unroll
    for (int i = 0; i < 2; ++i) { int R, C; stage_rc(tid * 16 + i * 8192, R, C); const int Rb = P::PERM ? ((R & ~31) + perm32(R & 31)) : R;
        RA[i] = R; CA[i] = C * 2; voffA[i] = (unsigned)(R * ROWB + C * 2); voffB[i] = (unsigned)(Rb * ROWB + C * 2); }
    constexpr int kstep = BK * 2;
    constexpr size_t hstep = (size_t)HALF * ROWB;
    const unsigned ldsw = (unsigned)wid * 1024u;
    const int aoff = lds_byte(wr * 64 + fr, fq * 8), boff = lds_byte(wc * 32 + fr, fq * 8);
#define PG8_SA(b, h) (((b) * 2 + (h)) * HTB)
#define PG8_SB(b, h) ((4 + (b) * 2 + (h)) * HTB)
#define PG8_STAGE_B(bufoff, gbase) do { _Pragma("unroll") for (int _i = 0; _i < 2; ++_i) \
        __builtin_amdgcn_global_load_lds((const unsigned*)((const char*)(gbase) + voffB[_i]), (LAS unsigned*)(lds + (bufoff) + ldsw + _i * 8192), 16, 0, 0); } while (0)
#define PG8_STAGE_A(bufoff, gbase, off, h) do { _Pragma("unroll") for (int _i = 0; _i < 2; ++_i) { const char* _p; \
        if constexpr (P::GATHER) _p = (const char*)(gbase) + (off)[h][_i]; else _p = (const char*)(gbase) + (size_t)(h) * hstep + voffA[_i]; \
        __builtin_amdgcn_global_load_lds((const unsigned*)_p, (LAS unsigned*)(lds + (bufoff) + ldsw + _i * 8192), 16, 0, 0); } } while (0)
#define PG8_LDA(dst, b, h) do { _Pragma("unroll") for (int m = 0; m < 4; ++m) _Pragma("unroll") for (int k = 0; k < 2; ++k) dst[m][k] = *(const LAS bf16x8*)(lds + PG8_SA(b, h) + aoff + m * 2048 + k * 1024); } while (0)
#define PG8_LDB(dst, b, h) do { _Pragma("unroll") for (int n = 0; n < 2; ++n) _Pragma("unroll") for (int k = 0; k < 2; ++k) dst[n][k] = *(const LAS bf16x8*)(lds + PG8_SB(b, h) + boff + n * 2048 + k * 1024); } while (0)
#define PG8_MMA(ai, bj, At, Bt) do { __builtin_amdgcn_s_setprio(1); _Pragma("unroll") for (int m = 0; m < 4; ++m) _Pragma("unroll") for (int n = 0; n < 2; ++n) { \
        if constexpr (P::FP8) { const i32x4 b0_ = __builtin_bit_cast(i32x4, Bt[n][0]), b1_ = __builtin_bit_cast(i32x4, Bt[n][1]), a0_ = __builtin_bit_cast(i32x4, At[m][0]), a1_ = __builtin_bit_cast(i32x4, At[m][1]); \
            acc[ai][bj][m][n] = __builtin_amdgcn_mfma_scale_f32_16x16x128_f8f6f4((i32x8){b0_[0], b0_[1], b0_[2], b0_[3], b1_[0], b1_[1], b1_[2], b1_[3]}, (i32x8){a0_[0], a0_[1], a0_[2], a0_[3], a1_[0], a1_[1], a1_[2], a1_[3]}, \
                acc[ai][bj][m][n], 0, 0, 0, 0x7f7f7f7f, 0, 0x7f7f7f7f); } \
        else { _Pragma("unroll") for (int k = 0; k < 2; ++k) acc[ai][bj][m][n] = __builtin_amdgcn_mfma_f32_16x16x32_bf16(Bt[n][k], At[m][k], acc[ai][bj][m][n], 0, 0, 0); } } \
        __builtin_amdgcn_s_setprio(0); } while (0)
#define PG8_WAIT_V(n) asm volatile("s_waitcnt vmcnt(" #n ")" ::: "memory")
#define PG8_WAIT_L(n) asm volatile("s_waitcnt lgkmcnt(" #n ")" ::: "memory")
#define PG8_BAR __builtin_amdgcn_s_barrier()
#define PG8_SCHED __builtin_amdgcn_sched_barrier(0)
    Unit cur, nxt; int ui = 0;
    if (!prob.next(0, cur)) return;
    f32x4 acc[2][2][4][2];
#pragma unroll
    for (int a = 0; a < 2; ++a)
#pragma unroll
        for (int b = 0; b < 2; ++b)
#pragma unroll
            for (int m = 0; m < 4; ++m)
#pragma unroll
                for (int n = 0; n < 2; ++n) acc[a][b][m][n] = (f32x4){0.f, 0.f, 0.f, 0.f};
    bf16x8 At[4][2], B0[2][2], B1[2][2];
    unsigned offC[2][2] = {{0u, 0u}, {0u, 0u}};
#define PG8_FILL(u, buf) do { if (tid < 256) prob.gtab[(buf) * 256 + tid] = prob.a_off(u, tid); } while (0)
#define PG8_OFFS(buf) do { _Pragma("unroll") for (int _h = 0; _h < 2; ++_h) _Pragma("unroll") for (int _i = 0; _i < 2; ++_i) offC[_h][_i] = prob.gtab[(buf) * 256 + _h * HALF + RA[_i]] + (unsigned)CA[_i]; } while (0)
    Unit nx2;
    bool has_next = prob.next(1, nxt);
    if constexpr (P::GATHER) { PG8_FILL(cur, 0); if (has_next) PG8_FILL(nxt, 1); PG8_WAIT_L(0); PG8_BAR; PG8_OFFS(0); }
    const char* cA = prob.a_tile(cur); const char* cB = cur.B;
    PG8_STAGE_B(PG8_SB(0, 0), cB); PG8_STAGE_B(PG8_SB(0, 1), cB + hstep); PG8_STAGE_A(PG8_SA(0, 0), cA, offC, 0); PG8_STAGE_A(PG8_SA(0, 1), cA, offC, 1);
    if (wr == 1) PG8_BAR;
    PG8_WAIT_V(2); PG8_BAR;
    PG8_STAGE_B(PG8_SB(1, 0), cB + kstep); PG8_STAGE_A(PG8_SA(1, 0), cA + kstep, offC, 0); PG8_STAGE_B(PG8_SB(1, 1), cB + hstep + kstep);
    PG8_WAIT_V(6); PG8_BAR;
    int bcur = 0;
    for (;;) {
        const bool has_nx2 = has_next && prob.next(ui + 2, nx2);
        const char* nA = has_next ? prob.a_tile(nxt) : cA; const char* nB = has_next ? nxt.B : cB;
        const int bnext = bcur == 2 ? 0 : bcur + 1, bnx2 = bnext == 2 ? 0 : bnext + 1;
#pragma unroll 1
        for (int t = 0; t < nt; t += 2) {
            const bool last = (t == nt - 2);
            const char* a1 = cA + (size_t)(t + 1) * kstep;
            const char* a2 = last ? nA : cA + (size_t)(t + 2) * kstep; const char* b2 = last ? nB : cB + (size_t)(t + 2) * kstep;
            const char* a3 = a2 + kstep; const char* b3 = b2 + kstep;
            PG8_LDB(B0, 0, 0); PG8_LDB(B1, 0, 1); PG8_SCHED; PG8_LDA(At, 0, 0); PG8_STAGE_A(PG8_SA(1, 1), a1, offC, 1);
            if constexpr (P::GATHER) { if (last && has_next) PG8_OFFS(bnext); }
            PG8_WAIT_V(8); PG8_WAIT_L(0); PG8_BAR; PG8_MMA(0, 0, At, B0); PG8_MMA(0, 1, At, B1); PG8_BAR; PG8_SCHED;
            PG8_LDA(At, 0, 1); PG8_STAGE_B(PG8_SB(0, 0), b2); PG8_STAGE_B(PG8_SB(0, 1), b2 + hstep); PG8_STAGE_A(PG8_SA(0, 0), a2, offC, 0);
            PG8_WAIT_V(8); PG8_WAIT_L(0); PG8_BAR; PG8_MMA(1, 0, At, B0); PG8_MMA(1, 1, At, B1); PG8_BAR; PG8_SCHED;
            PG8_LDB(B0, 1, 0); PG8_LDB(B1, 1, 1); PG8_SCHED; PG8_LDA(At, 1, 0); PG8_STAGE_A(PG8_SA(0, 1), a2, offC, 1);
            PG8_WAIT_V(8); PG8_WAIT_L(0); PG8_BAR; PG8_MMA(0, 0, At, B0); PG8_MMA(0, 1, At, B1); PG8_BAR; PG8_SCHED;
            PG8_LDA(At, 1, 1); PG8_STAGE_B(PG8_SB(1, 0), b3); PG8_STAGE_B(PG8_SB(1, 1), b3 + hstep); PG8_STAGE_A(PG8_SA(1, 0), a3, offC, 0);
            PG8_WAIT_V(8); PG8_WAIT_L(0); PG8_BAR; PG8_MMA(1, 0, At, B0); PG8_MMA(1, 1, At, B1); PG8_BAR; PG8_SCHED;
        }
        if constexpr (ALIGN_EPI) { if (wr == 0) PG8_BAR; }
        if constexpr (P::GATHER) { if (has_nx2) PG8_FILL(nx2, bnx2); }
        cur.aux = bcur;
        prob.epi(acc, cur, wr, wc, fr, fq);
        if (!has_next) break;
#pragma unroll
        for (int a = 0; a < 2; ++a)
#pragma unroll
            for (int b = 0; b < 2; ++b)
#pragma unroll
                for (int m = 0; m < 4; ++m)
#pragma unroll
                    for (int n = 0; n < 2; ++n) acc[a][b][m][n] = (f32x4){0.f, 0.f, 0.f, 0.f};
        cur = nxt; nxt = nx2; has_next = has_nx2; cA = nA; cB = nB; ++ui; bcur = bnext;
        if constexpr (ALIGN_EPI) { if (wr == 1) PG8_BAR; }
    }
    PG8_WAIT_V(0);
    if constexpr (!ALIGN_EPI) { if (wr == 0) PG8_BAR; }
    PG8_BAR;
#undef PG8_SA
#undef PG8_SB
#undef PG8_STAGE_A
#undef PG8_STAGE_B
#undef PG8_LDA
#undef PG8_LDB
#undef PG8_MMA
#undef PG8_WAIT_V
#undef PG8_WAIT_L
#undef PG8_BAR
#undef PG8_SCHED
#undef PG8_OFFS
#undef PG8_FILL
}
}

template <bool F8> struct ProbScaleT {
    static constexpr bool FP8 = F8, PERM = true, GATHER = F8;
    static constexpr int RB = F8 ? 1024 : 2048;
    __device__ __forceinline__ const char* a_tile(const pg8::Unit& u) const { return F8 ? u.A : u.A + (size_t)u.pm * (256 * RB); }
    LAS unsigned* gtab;
    const void* A; const void* Bt; int nM, nN, G, c;
    bf16_t* O; int ldo; const float* rstd; const float* ssp;
    __device__ __forceinline__ bool next(int i, pg8::Unit& u) const {
        int pm, pn; if (!pg8::static_next(i, G, c, nM, nN, pm, pn)) return false;
        u.A = (const char*)A; u.B = (const char*)Bt + (size_t)pn * 256 * RB; u.pm = pm; u.pn = pn; u.e = 0; u.nvalid = 256; u.y0 = 0; u.aux = 0; return true; }
    __device__ __forceinline__ unsigned a_off(const pg8::Unit& u, int r) const { return (unsigned)(u.pm * 256 + r) * (unsigned)RB; }
    __device__ __forceinline__ void epi(const f32x4 (&acc)[2][2][4][2], const pg8::Unit& u, int wr, int wc, int fr, int fq) const {
        asm volatile("" : "+v"(fr), "+v"(fq));
        const int rowu = u.pm * 256 + wr * 64;
        char* ub = (char*)O + ((size_t)rowu * ldo + u.pn * 256 + wc * 32) * 2;
        const unsigned lo = (unsigned)(fr * ldo + 8 * fq) * 2u;
        float rsv[8];
        if (rstd) {
#pragma unroll
            for (int q = 0; q < 8; ++q) rsv[q] = rstd[rowu + fr + (q >> 2) * 128 + (q & 3) * 16];
        } else { f32x4 pv[8];
#pragma unroll
            for (int q = 0; q < 8; ++q) pv[q] = *(const f32x4*)(ssp + (size_t)(rowu + fr + (q >> 2) * 128 + (q & 3) * 16) * 16 + fq * 4);
#pragma unroll
            for (int q = 0; q < 8; ++q) { float sq = (pv[q][0] + pv[q][1]) + (pv[q][2] + pv[q][3]); sq = x16_sum(sq); sq = x32_sum(sq); rsv[q] = rsqrtf(sq * (1.0f / 1024.0f) + EPS); } }
#pragma unroll
        for (int ai = 0; ai < 2; ++ai)
#pragma unroll
            for (int m = 0; m < 4; ++m) { const float rs = rsv[ai * 4 + m] * (F8 ? (1.0f / 64.0f) : 1.0f);
                char* rowp = ub + (size_t)(ai * 128 + m * 16) * ldo * 2 + lo;
#pragma unroll
                for (int bj = 0; bj < 2; ++bj) { const f32x4 v0 = acc[ai][bj][m][0] * rs, v1 = acc[ai][bj][m][1] * rs;
                    u32x4 w; w.x = cvt_pk_bf16(v0[0], v0[1]); w.y = cvt_pk_bf16(v0[2], v0[3]); w.z = cvt_pk_bf16(v1[0], v1[1]); w.w = cvt_pk_bf16(v1[2], v1[3]);
                    *(u32x4*)(rowp + bj * 256) = w; } }
    }
};
typedef ProbScaleT<false> ProbScaleBf16;
struct ProbColScaleBf16 {
    static constexpr bool FP8 = false, PERM = true, GATHER = false;
    __device__ __forceinline__ const char* a_tile(const pg8::Unit& u) const { return u.A + (size_t)u.pm * (256 * 2048); }
    const bf16_t* A; const bf16_t* Bt; int nM, nN, G, c;
    bf16_t* O; int ldo; const float* cs;
    __device__ __forceinline__ bool next(int i, pg8::Unit& u) const {
        const long L = (long)i * G + c; if (L >= (long)nM * nN) return false;
        const int pm = (int)(L % nM), pn = (int)(L / nM);
        u.A = (const char*)A; u.B = (const char*)(Bt + (size_t)pn * 256 * 1024); u.pm = pm; u.pn = pn; u.e = 0; u.nvalid = 256; u.y0 = 0; u.aux = 0; return true; }
    __device__ __forceinline__ unsigned a_off(const pg8::Unit& u, int r) const { return 0u; }
    __device__ __forceinline__ void epi(const f32x4 (&acc)[2][2][4][2], const pg8::Unit& u, int wr, int wc, int fr, int fq) const {
        asm volatile("" : "+v"(fr), "+v"(fq));
        const float* cp = cs + u.pn * 256 + wc * 32 + 8 * fq;
        f32x4 sc[2][2];
#pragma unroll
        for (int bj = 0; bj < 2; ++bj)
#pragma unroll
            for (int n = 0; n < 2; ++n) sc[bj][n] = *(const f32x4*)(cp + bj * 128 + 4 * n);
        char* ub = (char*)O + ((size_t)(u.pm * 256 + wr * 64) * ldo + u.pn * 256 + wc * 32) * 2;
        const unsigned lo = (unsigned)(fr * ldo + 8 * fq) * 2u;
#pragma unroll
        for (int ai = 0; ai < 2; ++ai)
#pragma unroll
            for (int m = 0; m < 4; ++m) { char* rowp = ub + (size_t)(ai * 128 + m * 16) * ldo * 2 + lo;
#pragma unroll
                for (int bj = 0; bj < 2; ++bj) { const f32x4 v0 = acc[ai][bj][m][0] * sc[bj][0], v1 = acc[ai][bj][m][1] * sc[bj][1];
                    u32x4 w; w.x = cvt_pk_bf16(v0[0], v0[1]); w.y = cvt_pk_bf16(v0[2], v0[3]); w.z = cvt_pk_bf16(v1[0], v1[1]); w.w = cvt_pk_bf16(v1[2], v1[3]);
                    *(u32x4*)(rowp + bj * 256) = w; } }
    }
};
struct ProbKV {
    static constexpr bool FP8 = true, PERM = true, GATHER = true;
    __device__ __forceinline__ const char* a_tile(const pg8::Unit& u) const { return u.A; }
    LAS unsigned* gtab;
    const unsigned char* memb; const unsigned char* wckv; bf16_t* Kout; bf16_t* VTout; const float* rstdm; int G, c;
    __device__ __forceinline__ bool next(int i, pg8::Unit& u) const {
        const long L = (long)i * G + c; if (L >= 256) return false;
        if (L < 128) { u.pm = (int)(L & 31); u.pn = (int)(L >> 5); u.e = 0; u.A = (const char*)memb; u.B = (const char*)(wckv + (size_t)u.pn * 256 * 1024); }
        else { const int l2 = (int)L - 128; u.pm = l2 & 3; u.pn = l2 >> 2; u.e = 1; u.A = (const char*)(wckv + (size_t)1024 * 1024); u.B = (const char*)(memb + (size_t)u.pn * 256 * 1024); }
        u.nvalid = 256; u.y0 = 0; u.aux = 0; return true; }
    __device__ __forceinline__ unsigned a_off(const pg8::Unit& u, int r) const { return (unsigned)(u.pm * 256 + r) * 1024u; }
    __device__ __forceinline__ void epi(const f32x4 (&acc)[2][2][4][2], const pg8::Unit& u, int wr, int wc, int fr, int fq) const {
        asm volatile("" : "+v"(fr), "+v"(fq));
        const int ldo = u.e ? MROWS : 1024;
        char* ub = (char*)(u.e ? VTout : Kout) + ((size_t)(u.pm * 256 + wr * 64) * ldo + u.pn * 256 + wc * 32) * 2;
        const unsigned lo = (unsigned)(fr * ldo + 8 * fq) * 2u;
        float rsv[8]; f32x4 sc[2][2];
        if (u.e == 0) {
#pragma unroll
            for (int q = 0; q < 8; ++q) rsv[q] = rstdm[u.pm * 256 + wr * 64 + fr + (q >> 2) * 128 + (q & 3) * 16] * (1.0f / 64.0f);
#pragma unroll
            for (int bj = 0; bj < 2; ++bj)
#pragma unroll
                for (int n = 0; n < 2; ++n) sc[bj][n] = (f32x4){1.f, 1.f, 1.f, 1.f};
        } else {
#pragma unroll
            for (int q = 0; q < 8; ++q) rsv[q] = 1.0f / 64.0f;
            const float* cp = rstdm + u.pn * 256 + wc * 32 + 8 * fq;
#pragma unroll
            for (int bj = 0; bj < 2; ++bj)
#pragma unroll
                for (int n = 0; n < 2; ++n) sc[bj][n] = *(const f32x4*)(cp + bj * 128 + 4 * n); }
#pragma unroll
        for (int ai = 0; ai < 2; ++ai)
#pragma unroll
            for (int m = 0; m < 4; ++m) { const float rs = rsv[ai * 4 + m]; char* rowp = ub + (size_t)(ai * 128 + m * 16) * ldo * 2 + lo;
#pragma unroll
                for (int bj = 0; bj < 2; ++bj) { const f32x4 v0 = acc[ai][bj][m][0] * sc[bj][0] * rs, v1 = acc[ai][bj][m][1] * sc[bj][1] * rs;
                    u32x4 w; w.x = cvt_pk_bf16(v0[0], v0[1]); w.y = cvt_pk_bf16(v0[2], v0[3]); w.z = cvt_pk_bf16(v1[0], v1[1]); w.w = cvt_pk_bf16(v1[2], v1[3]);
                    *(u32x4*)(rowp + bj * 256) = w; } }
    }
};
template <bool F8, bool WF8, bool RF32> struct ProbResidT {
    static constexpr bool FP8 = F8, PERM = true, GATHER = F8;
    static constexpr int RB = F8 ? 1024 : 2048;
    __device__ __forceinline__ const char* a_tile(const pg8::Unit& u) const { return F8 ? u.A : u.A + (size_t)u.pm * (256 * RB); }
    LAS unsigned* gtab;
    const void* A; const void* Bt; int nM, nN, G, c;
    const float* rf; const bf16_t* rb; bf16_t* ob; unsigned char* of8; float* ssp;
    __device__ __forceinline__ bool next(int i, pg8::Unit& u) const {
        int pm, pn; if (!pg8::static_next(i, G, c, nM, nN, pm, pn)) return false;
        u.A = (const char*)A; u.B = (const char*)Bt + (size_t)pn * 256 * RB; u.pm = pm; u.pn = pn; u.e = 0; u.nvalid = 256; u.y0 = 0; u.aux = 0; return true; }
    __device__ __forceinline__ unsigned a_off(const pg8::Unit& u, int r) const { return (unsigned)(u.pm * 256 + r) * (unsigned)RB; }
    __device__ __forceinline__ void epi(const f32x4 (&acc)[2][2][4][2], const pg8::Unit& u, int wr, int wc, int fr, int fq) const {
        asm volatile("" : "+v"(fr), "+v"(fq));
        const int rowu = u.pm * 256 + wr * 64;
        const size_t uoff = (size_t)rowu * 1024 + u.pn * 256 + wc * 32;
        const unsigned lo = (unsigned)(fr * 1024 + 8 * fq);
        const float sc = F8 ? (1.0f / 64.0f) : 1.0f;
#pragma unroll
        for (int ai = 0; ai < 2; ++ai) {
            f32x4 rv[4][2][2];
#pragma unroll
            for (int m = 0; m < 4; ++m) { const size_t ro = uoff + (size_t)(ai * 128 + m * 16) * 1024;
#pragma unroll
                for (int bj = 0; bj < 2; ++bj) {
                    if constexpr (RF32) { rv[m][bj][0] = *(const GAS f32x4*)(rf + ro + lo + bj * 128); rv[m][bj][1] = *(const GAS f32x4*)(rf + ro + lo + bj * 128 + 4); }
                    else { const u32x4 w = *(const GAS u32x4*)(rb + ro + lo + bj * 128); rv[m][bj][0] = (f32x4){lo_bf(w.x), hi_bf(w.x), lo_bf(w.y), hi_bf(w.y)}; rv[m][bj][1] = (f32x4){lo_bf(w.z), hi_bf(w.z), lo_bf(w.w), hi_bf(w.w)}; } } }
#pragma unroll
            for (int m = 0; m < 4; ++m) { const size_t ro = uoff + (size_t)(ai * 128 + m * 16) * 1024; float ss = 0.f;
#pragma unroll
                for (int bj = 0; bj < 2; ++bj) { const f32x4 v0 = acc[ai][bj][m][0] * sc + rv[m][bj][0], v1 = acc[ai][bj][m][1] * sc + rv[m][bj][1];
                    ss += (v0[0] * v0[0] + v0[1] * v0[1]) + (v0[2] * v0[2] + v0[3] * v0[3]) + (v1[0] * v1[0] + v1[1] * v1[1]) + (v1[2] * v1[2] + v1[3] * v1[3]);
                    u32x4 w; w.x = cvt_pk_bf16(v0[0], v0[1]); w.y = cvt_pk_bf16(v0[2], v0[3]); w.z = cvt_pk_bf16(v1[0], v1[1]); w.w = cvt_pk_bf16(v1[2], v1[3]);
                    *(u32x4*)(ob + ro + lo + bj * 128) = w;
                    if constexpr (WF8) { unsigned w0 = 0u, w1 = 0u;
                        w0 = __builtin_amdgcn_cvt_pk_fp8_f32(c8(v0[0]), c8(v0[1]), w0, false); w0 = __builtin_amdgcn_cvt_pk_fp8_f32(c8(v0[2]), c8(v0[3]), w0, true);
                        w1 = __builtin_amdgcn_cvt_pk_fp8_f32(c8(v1[0]), c8(v1[1]), w1, false); w1 = __builtin_amdgcn_cvt_pk_fp8_f32(c8(v1[2]), c8(v1[3]), w1, true);
                        *(u32x2*)(of8 + ro + lo + bj * 128) = (u32x2){w0, w1}; } }
                ss = x16_sum(ss); ss = x32_sum(ss);
                if (fq == 0) ssp[(size_t)(rowu + ai * 128 + m * 16 + fr) * 16 + u.pn * 4 + wc] = ss; } }
    }
};
__device__ __forceinline__ size_t hid_tile_off(int rt) { return rt < 1024 ? (size_t)rt * (256 * 1024) : (WS_HID1 - WS_HID) + (size_t)(rt - 1024) * (256 * 1024); }
constexpr int MOE_TS = 0, MOE_ST = 33, MOE_CNT = 66, MOE_RTE = 100, MOE_WORDS = 100 + 264;
struct ProbMoe1 {
    static constexpr bool FP8 = true, PERM = true, GATHER = true;
    __device__ __forceinline__ const char* a_tile(const pg8::Unit& u) const { return u.A; }
    const unsigned char* hb; const unsigned char* w1b; const float* b1p; const float* rstd2; const unsigned* list; unsigned char* hid;
    const volatile LAS int* tab; LAS unsigned* gtab; int rt0, nrt, G, c;
    __device__ __forceinline__ bool next(int i, pg8::Unit& u) const {
        const long L = (long)i * G + c; if (L >= (long)nrt * 8) return false;
        const int gidx = (int)(L >> 8), within = (int)(L & 255), gsz = (nrt - gidx * 32) < 32 ? (nrt - gidx * 32) : 32;
        const int rtl = gidx * 32 + within % gsz, pn = within / gsz, rt = rt0 + rtl;
        const int e = ((const volatile LAS unsigned char*)(tab + MOE_RTE))[rt];
        const int idx0 = (rt - tab[MOE_TS + e]) * 256;
        u.A = (const char*)hb; u.B = (const char*)(w1b + ((size_t)e * 2048 + (size_t)pn * 256) * 1024); u.pm = rt; u.pn = pn; u.e = e; u.nvalid = tab[MOE_CNT + e] - idx0; u.y0 = idx0; u.aux = 0; return true; }
    __device__ __forceinline__ unsigned tok_of(const pg8::Unit& u, int r) const { const int rr = r < u.nvalid ? r : 0; return list[(size_t)u.e * T + u.y0 + rr]; }
    __device__ __forceinline__ unsigned a_off(const pg8::Unit& u, int r) const { return tok_of(u, r) * 1024u; }
    __device__ __forceinline__ void epi(const f32x4 (&acc)[2][2][4][2], const pg8::Unit& u, int wr, int wc, int fr, int fq) const {
        asm volatile("" : "+v"(fr), "+v"(fq));
        const float* bp = b1p + (size_t)u.e * 2048 + u.pn * 256 + wc * 32 + 8 * fq;
        const f32x4 bg0 = *(const f32x4*)(bp), bg1 = *(const f32x4*)(bp + 4), bl0 = *(const f32x4*)(bp + 128), bl1 = *(const f32x4*)(bp + 132);
        char* ub = (char*)hid + hid_tile_off(u.pm) + ((size_t)(wr * 64) * 1024 + u.pn * 128 + wc * 32);
        const unsigned lo = (unsigned)(fr * 1024 + 8 * fq);
#pragma unroll
        for (int ai = 0; ai < 2; ++ai)
#pragma unroll
            for (int m = 0; m < 4; ++m) { const float rs = 1.0f / 64.0f;
                unsigned w[2];
#pragma unroll
                for (int n = 0; n < 2; ++n) { const f32x4 g4 = acc[ai][0][m][n] * rs + (n ? bg1 : bg0), l4 = acc[ai][1][m][n] * rs + (n ? bl1 : bl0);
                    unsigned wv = 0u;
#pragma unroll
                    for (int jp = 0; jp < 2; ++jp) {
                        f32x2 g2 = {fminf(g4[2 * jp], 7.0f), fminf(g4[2 * jp + 1], 7.0f)};
                        const f32x2 l2 = {__builtin_amdgcn_fmed3f(l4[2 * jp], -7.0f, 7.0f), __builtin_amdgcn_fmed3f(l4[2 * jp + 1], -7.0f, 7.0f)};
                        const f32x2 z2 = g2 * (-1.702f * 1.4426950408889634f);
                        const f32x2 d2 = (f32x2){__builtin_amdgcn_exp2f(z2[0]), __builtin_amdgcn_exp2f(z2[1])} + 1.0f;
                        const f32x2 r2 = {__builtin_amdgcn_rcpf(d2[0]), __builtin_amdgcn_rcpf(d2[1])};
                        const f32x2 o2 = (g2 * r2) * (l2 * 4.0f + 4.0f);
                        if (jp) wv = __builtin_amdgcn_cvt_pk_fp8_f32(o2[0], o2[1], wv, true); else wv = __builtin_amdgcn_cvt_pk_fp8_f32(o2[0], o2[1], wv, false); }
                    w[n] = wv; }
                *(u32x2*)(ub + (size_t)(ai * 128 + m * 16) * 1024 + lo) = (u32x2){w[0], w[1]}; }
    }
};
struct ProbMoe2 {
    static constexpr bool FP8 = true, PERM = true, GATHER = true;
    __device__ __forceinline__ const char* a_tile(const pg8::Unit& u) const { return u.A; }
    const unsigned char* hid; const unsigned char* w2b; const float* b2; unsigned char* y;
    const volatile LAS int* tab; LAS unsigned* gtab; int rt0, nrt, G, c;
    __device__ __forceinline__ bool next(int i, pg8::Unit& u) const {
        const long L = (long)i * G + c; if (L >= (long)nrt * 4) return false;
        const int gidx = (int)(L >> 8), within = (int)(L & 255), gsz = (nrt - gidx * 64) < 64 ? (nrt - gidx * 64) : 64;
        const int rtl = gidx * 64 + within % gsz, pn = within / gsz, rt = rt0 + rtl;
        const int e = ((const volatile LAS unsigned char*)(tab + MOE_RTE))[rt];
        const int idx0 = (rt - tab[MOE_TS + e]) * 256;
        u.A = (const char*)hid; u.B = (const char*)(w2b + ((size_t)e * 1024 + (size_t)pn * 256) * 1024); u.pm = rt; u.pn = pn; u.e = e; u.nvalid = tab[MOE_CNT + e] - idx0; u.y0 = tab[MOE_ST + e] + idx0; u.aux = 0; return true; }
    __device__ __forceinline__ unsigned a_off(const pg8::Unit& u, int r) const { return (unsigned)(hid_tile_off(u.pm) + (size_t)r * 1024u); }
    __device__ __forceinline__ void epi(const f32x4 (&acc)[2][2][4][2], const pg8::Unit& u, int wr, int wc, int fr, int fq) const {
        asm volatile("" : "+v"(fr), "+v"(fq));
        const float* bp = b2 + (size_t)u.e * 1024 + u.pn * 256 + wc * 32 + 8 * fq;
        f32x4 bv[2][2];
#pragma unroll
        for (int bj = 0; bj < 2; ++bj)
#pragma unroll
            for (int n = 0; n < 2; ++n) bv[bj][n] = *(const f32x4*)(bp + bj * 128 + 4 * n);
        char* ub = (char*)y + (((size_t)u.y0 + wr * 64) * 1024 + u.pn * 256 + wc * 32);
        const unsigned lo = (unsigned)(fr * 1024 + 8 * fq);
        const int r0 = wr * 64 + fr;
#pragma unroll
        for (int ai = 0; ai < 2; ++ai)
#pragma unroll
            for (int m = 0; m < 4; ++m) { const int r = r0 + ai * 128 + m * 16;
                if (r < u.nvalid) { char* rowp = ub + (size_t)(ai * 128 + m * 16) * 1024 + lo;
#pragma unroll
                    for (int bj = 0; bj < 2; ++bj) { const f32x4 v0 = acc[ai][bj][m][0] * (1.0f / 16.0f) + bv[bj][0] * 16.0f, v1 = acc[ai][bj][m][1] * (1.0f / 16.0f) + bv[bj][1] * 16.0f;
                        unsigned w0 = 0u, w1 = 0u;
                        w0 = __builtin_amdgcn_cvt_pk_fp8_f32(c8(v0[0]), c8(v0[1]), w0, false); w0 = __builtin_amdgcn_cvt_pk_fp8_f32(c8(v0[2]), c8(v0[3]), w0, true);
                        w1 = __builtin_amdgcn_cvt_pk_fp8_f32(c8(v1[0]), c8(v1[1]), w1, false); w1 = __builtin_amdgcn_cvt_pk_fp8_f32(c8(v1[2]), c8(v1[3]), w1, true);
                        *(u32x2*)(rowp + bj * 128) = (u32x2){w0, w1}; } } }
    }
};

#define XB_TMO      128
#define XB_XCNT(j)  (256  + 64 * (j))
#define XB_XSUB(j)  (1280 + 64 * (j))
#define XB_XGEN(j)  (2304 + 64 * (j))
#define XB_TOP      3328
#define XB_TOPGEN   3392
#define XCD_BAR_WORDS 3456
#define XB_SPIN_CAP (1u << 18)
__device__ __forceinline__ unsigned xb_ld(unsigned* p)              { return __hip_atomic_load(p, __ATOMIC_RELAXED, __HIP_MEMORY_SCOPE_AGENT); }
__device__ __forceinline__ unsigned xb_add(unsigned* p, unsigned v) { return __hip_atomic_fetch_add(p, v, __ATOMIC_RELAXED, __HIP_MEMORY_SCOPE_AGENT); }
__device__ __forceinline__ unsigned xb_xcc_id() { return (unsigned)__builtin_amdgcn_s_getreg((3 << 11) | 20) & 0xFu; }
#define XB_SPIN(cond, bar) do { unsigned _sp = 0; while (cond) { __builtin_amdgcn_s_sleep(1); \
    if ((++_sp & 255u) == 0u) { if (xb_ld(&(bar)[XB_TMO])) break; if (_sp > XB_SPIN_CAP) { atomicAdd(&(bar)[XB_TMO], 1u); break; } } } } while (0)
struct XcdBarrier { unsigned* bar; unsigned x; volatile LAS unsigned* st; int wave; };
__device__ __forceinline__ XcdBarrier xcd_barrier_post(unsigned* bar, volatile LAS unsigned* st, int wave) {
    XcdBarrier b; b.bar = bar; b.x = xb_xcc_id(); b.st = st; b.wave = wave;
    if (wave == 0 && lane_id() == 0) (void)xb_add(&bar[XB_XCNT(b.x)], 1u);
    return b;
}
__device__ __forceinline__ void xcd_barrier_complete(unsigned* bar, unsigned x, unsigned& nloc, unsigned& nx) {
    const unsigned G = gridDim.x * gridDim.y * gridDim.z;
    unsigned sum, cnt, mine, sp = 0u;
    for (;;) {
        sum = 0u; cnt = 0u; mine = 0u;
#pragma unroll
        for (unsigned j = 0; j < 16; ++j) { const unsigned c = xb_ld(&bar[XB_XCNT(j)]); sum += c; cnt += (c > 0u) ? 1u : 0u; mine = (j == x) ? c : mine; }
        if (sum == G) break;
        __builtin_amdgcn_s_sleep(1);
        if ((++sp & 255u) == 0u) { if (xb_ld(&bar[XB_TMO])) break; if (sp > XB_SPIN_CAP) { atomicAdd(&bar[XB_TMO], 1u); break; } }
    }
    nloc = mine > 0u ? mine : 1u; nx = cnt > 0u ? cnt : 1u;
}
__device__ __forceinline__ void xcd_barrier(const XcdBarrier& b) {
    asm volatile("s_waitcnt vmcnt(0)" ::: "memory");
    __syncthreads();
    if (b.wave == 0 && lane_id() == 0) {
        unsigned* bar = b.bar;
        __builtin_amdgcn_s_waitcnt(0);
        unsigned nloc = b.st[0], nx = b.st[1];
        if (nloc == 0u) { xcd_barrier_complete(bar, b.x, nloc, nx); b.st[0] = nloc; b.st[1] = nx; }
        const unsigned old = xb_add(&bar[XB_XSUB(b.x)], 1u);
        const unsigned gen = old / nloc;
        if (old + 1u == (gen + 1u) * nloc) {
            __builtin_amdgcn_fence(__ATOMIC_RELEASE, "agent");
            asm volatile("s_waitcnt vmcnt(0)" ::: "memory");
            const unsigned og = xb_add(&bar[XB_TOP], 1u);
            const unsigned tg = og / nx;
            if (og + 1u == (tg + 1u) * nx) xb_add(&bar[XB_TOPGEN], 1u);
            else XB_SPIN(xb_ld(&bar[XB_TOPGEN]) == tg, bar);
            __builtin_amdgcn_fence(__ATOMIC_ACQUIRE, "agent");
            xb_add(&bar[XB_XGEN(b.x)], 1u);
            asm volatile("s_waitcnt vmcnt(0)" ::: "memory");
        } else {
            XB_SPIN(xb_ld(&bar[XB_XGEN(b.x)]) == gen, bar);
            __builtin_amdgcn_fence(__ATOMIC_ACQUIRE, "agent");
            asm volatile("s_waitcnt vmcnt(0)" ::: "memory");
        }
    }
    __syncthreads();
}

typedef float f32x16 __attribute__((ext_vector_type(16)));
__device__ __forceinline__ int pi32(int i) { return (i & ~12) | ((i & 4) << 1) | ((i & 8) >> 1); }
__device__ __forceinline__ f32x16 zero16() { f32x16 z;
#pragma unroll
    for (int r = 0; r < 16; ++r) z[r] = 0.f;
    return z; }

__device__ __forceinline__ void xattn_phase(LAS unsigned char* lds, const bf16_t* Q, const bf16_t* Kb, const bf16_t* VT, unsigned char* O, int G, int bx, int wave) {
    const int lane = lane_id(), i = lane & 31, hh = lane >> 5;
    LAS unsigned char* ring = lds;
    for (int uid = bx; uid < BATCH * 4 * 8; uid += G) {
        const int b = uid >> 5, h = (uid >> 3) & 3, qblk = uid & 7;
        const int q0 = qblk * 256 + wave * 32;
        const bf16_t* qp = Q + (size_t)(b * SEQ + q0 + i) * 1024 + h * 256 + 8 * hh;
        bf16x8 qf[16];
#pragma unroll
        for (int ds = 0; ds < 16; ++ds) qf[ds] = *(const bf16x8*)(qp + 16 * ds);
        const bf16_t* ksrc = Kb + (size_t)(b * MEMLEN + pi32(i)) * 1024 + h * 256 + 16 * wave + 8 * hh;
        const bf16_t* vsrc = VT + (size_t)(h * 256 + i) * MROWS + b * MEMLEN + 32 * (wave >> 1) + 16 * (wave & 1) + 8 * hh;
#define XA_ISSUE(st_) do { LAS unsigned char* sl_ = ring + ((st_) & 3) * 16384; \
        if ((st_) < 8) { const bf16_t* g_ = ksrc + (size_t)(st_) * 32 * 1024; \
            __builtin_amdgcn_global_load_lds((const unsigned*)g_, (LAS unsigned*)(sl_ + wave * 1024), 16, 0, 0); \
            __builtin_amdgcn_global_load_lds((const unsigned*)(g_ + 128), (LAS unsigned*)(sl_ + (8 + wave) * 1024), 16, 0, 0); } \
        else { const bf16_t* g_ = vsrc + (size_t)((st_) - 8) * 32 * MROWS; \
            __builtin_amdgcn_global_load_lds((const unsigned*)g_, (LAS unsigned*)(sl_ + wave * 1024), 16, 0, 0); \
            __builtin_amdgcn_global_load_lds((const unsigned*)(g_ + 128), (LAS unsigned*)(sl_ + (8 + wave) * 1024), 16, 0, 0); } } while (0)
#define XA_SYNC(st_) do { const int n_ = ((st_) >= 11 ? 4 : 0) + ((st_) <= 14 ? 2 : 0) + ((st_) >= 10 ? 4 : 0) + ((st_) <= 13 ? 2 : 0) + ((st_) >= 9 ? 4 : 0); \
        if (n_ == 4) asm volatile("s_waitcnt vmcnt(4)" ::: "memory"); else if (n_ == 8) asm volatile("s_waitcnt vmcnt(8)" ::: "memory"); \
        else if (n_ == 12) asm volatile("s_waitcnt vmcnt(12)" ::: "memory"); else if (n_ == 14) asm volatile("s_waitcnt vmcnt(14)" ::: "memory"); else asm volatile("s_waitcnt vmcnt(16)" ::: "memory"); \
        __builtin_amdgcn_s_barrier(); asm volatile("" ::: "memory"); if ((st_) + 3 < 16) XA_ISSUE((st_) + 3); } while (0)
        XA_ISSUE(0); XA_ISSUE(1); XA_ISSUE(2);
        f32x16 s[8];
#pragma unroll
        for (int kt = 0; kt < 8; ++kt) { XA_SYNC(kt);
            const LAS unsigned char* sl = ring + (kt & 3) * 16384 + lane * 16;
            f32x16 acc = zero16();
#pragma unroll
            for (int q4 = 0; q4 < 4; ++q4) { __builtin_amdgcn_sched_barrier(0);
#pragma unroll
                for (int d4 = 0; d4 < 4; ++d4) { const int ds = q4 * 4 + d4; acc = __builtin_amdgcn_mfma_f32_32x32x16_bf16(*(const LAS bf16x8*)(sl + ds * 1024), qf[ds], acc, 0, 0, 0); } }
            s[kt] = acc; }
        float m = -INFINITY;
#pragma unroll
        for (int kt = 0; kt < 8; ++kt)
#pragma unroll
            for (int r = 0; r < 16; ++r) m = fmaxf(m, s[kt][r]);
        m = x32_max(m);
        const float c = 0.0625f * 1.4426950408889634f; float l = 0.f; const float mc = m * c;
        u32x4 pf[8][2];
#pragma unroll
        for (int kt = 0; kt < 8; ++kt) {
#pragma unroll
            for (int r = 0; r < 16; ++r) { const float p = __builtin_amdgcn_exp2f(s[kt][r] * c - mc); s[kt][r] = p; l += p; }
#pragma unroll
            for (int sb = 0; sb < 2; ++sb) { pf[kt][sb].x = cvt_pk_bf16(s[kt][8 * sb + 0], s[kt][8 * sb + 1]); pf[kt][sb].y = cvt_pk_bf16(s[kt][8 * sb + 2], s[kt][8 * sb + 3]);
                pf[kt][sb].z = cvt_pk_bf16(s[kt][8 * sb + 4], s[kt][8 * sb + 5]); pf[kt][sb].w = cvt_pk_bf16(s[kt][8 * sb + 6], s[kt][8 * sb + 7]); } }
        l = x32_sum(l);
        const float il = 1.0f / l;
        unsigned char* op = O + (size_t)(b * SEQ + q0 + i) * 1024 + h * 256 + 4 * hh;
#pragma unroll
        for (int dvt = 0; dvt < 8; ++dvt) { XA_SYNC(8 + dvt);
            const LAS unsigned char* sl = ring + (dvt & 3) * 16384 + lane * 16;
            f32x16 oacc = zero16();
#pragma unroll
            for (int q4 = 0; q4 < 4; ++q4) { __builtin_amdgcn_sched_barrier(0);
#pragma unroll
                for (int f4 = 0; f4 < 4; ++f4) { const int f = q4 * 4 + f4; oacc = __builtin_amdgcn_mfma_f32_32x32x16_bf16(*(const LAS bf16x8*)(sl + f * 1024), __builtin_bit_cast(bf16x8, pf[f >> 1][f & 1]), oacc, 0, 0, 0); } }
#pragma unroll
            for (int g = 0; g < 4; ++g) { unsigned w = 0u; w = __builtin_amdgcn_cvt_pk_fp8_f32(c8(oacc[4 * g] * il), c8(oacc[4 * g + 1] * il), w, false); w = __builtin_amdgcn_cvt_pk_fp8_f32(c8(oacc[4 * g + 2] * il), c8(oacc[4 * g + 3] * il), w, true);
                *(unsigned*)(op + dvt * 32 + 8 * g) = w; } }
#undef XA_ISSUE
#undef XA_SYNC
    }
}

__device__ __forceinline__ void diffattn_phase(LAS unsigned char* lds, const bf16_t* P2, const bf16_t* VT, const float* dng, const float lam, bf16_t* cat, int G, int vx, int wave) {
    const int lane = lane_id(), i_ = lane & 31, hh_ = lane >> 5;
    LAS unsigned char* ring = lds;
    LAS unsigned char* ql = lds + 65536 + wave * 8192 + lane * 16;
    const float c = 0.125f * 1.4426950408889634f;
    for (int pu = vx; pu < BATCH * 4 * 4; pu += G)
        for (int side = 0; side < 2; ++side) {
            const int bh = pu >> 2, x = pu & 3, qb = side ? 7 - x : x, b = bh >> 2, h = bh & 3, q0 = qb * 256 + wave * 32;
            const int ntile = 8 * qb + 8, ktw = 8 * qb + wave;
            int i = i_, hh = hh_; asm volatile("" : "+v"(i), "+v"(hh));
            const bf16_t* qp = P2 + (size_t)(b * SEQ + q0 + i) * NP2 + h * 128 + 8 * hh;
            { bf16x8 t[8];
#pragma unroll
              for (int f = 0; f < 8; ++f) t[f] = *(const bf16x8*)(qp + 16 * f);
#pragma unroll
              for (int f = 0; f < 8; ++f) *(LAS bf16x8*)(ql + f * 1024) = t[f]; }
            const char* kbase = (const char*)(P2 + (size_t)b * SEQ * NP2 + 512 + h * 128 + (wave >> 2) * 64 + 16 * (wave & 3));
            const char* vbase = (const char*)(VT + (size_t)(h * 128 + 32 * (wave >> 1)) * T + (size_t)b * SEQ + 16 * (wave & 1));
            const unsigned koff = (unsigned)(pi32(i) * NP2 + 8 * hh) * 2u, voff = (unsigned)(i * T + 8 * hh) * 2u;
#define DA_ISSUE(kt_) do { LAS unsigned char* sl_ = ring + ((kt_) & 3) * 16384; \
        __builtin_amdgcn_global_load_lds((const unsigned*)(kbase + (size_t)(kt_) * (32 * NP2 * 2) + koff), (LAS unsigned*)(sl_ + wave * 1024), 16, 0, 0); \
        __builtin_amdgcn_global_load_lds((const unsigned*)(vbase + (kt_) * 64 + voff), (LAS unsigned*)(sl_ + (8 + wave) * 1024), 16, 0, 0); } while (0)
            f32x16 o1[4], o2[4];
#pragma unroll
            for (int d = 0; d < 4; ++d) { o1[d] = zero16(); o2[d] = zero16(); }
            float mc1 = -INFINITY, mc2 = -INFINITY, l1 = 0.f, l2 = 0.f;
            u32x4 pp1[2], pp2[2];
#pragma unroll
            for (int sb = 0; sb < 2; ++sb) { pp1[sb] = (u32x4){0u, 0u, 0u, 0u}; pp2[sb] = pp1[sb]; }
            DA_ISSUE(0); DA_ISSUE(1);
            for (int kt = 0; kt <= ntile; ++kt) {
                if (kt < ntile) {
                    if (kt + 1 < ntile) asm volatile("s_waitcnt vmcnt(2)" ::: "memory"); else asm volatile("s_waitcnt vmcnt(0)" ::: "memory");
                    __builtin_amdgcn_s_barrier(); asm volatile("" ::: "memory");
                    if (kt + 2 < ntile) DA_ISSUE(kt + 2);
                }
                if (kt <= ktw + 1) {
                    const LAS unsigned char* sl = ring + (kt & 3) * 16384 + lane * 16;
                    const LAS unsigned char* sp = ring + ((kt == 0 ? 0 : kt - 1) & 3) * 16384 + lane * 16;
                    f32x16 s1 = zero16(), s2 = zero16();
#pragma unroll
                    for (int ds = 0; ds < 4; ++ds) { s1 = __builtin_amdgcn_mfma_f32_32x32x16_bf16(*(const LAS bf16x8*)(sl + ds * 1024), *(const LAS bf16x8*)(ql + ds * 1024), s1, 0, 0, 0);
                        s2 = __builtin_amdgcn_mfma_f32_32x32x16_bf16(*(const LAS bf16x8*)(sl + (4 + ds) * 1024), *(const LAS bf16x8*)(ql + (4 + ds) * 1024), s2, 0, 0, 0);
                        if (ds & 1) __builtin_amdgcn_sched_barrier(0); }
                    if (kt >= ktw) { const int lim = (kt == ktw) ? i : -1;
#pragma unroll
                        for (int r = 0; r < 16; ++r) { const int ko = 16 * (r >> 3) + 8 * hh + (r & 7); if (ko > lim) { s1[r] = -INFINITY; s2[r] = -INFINITY; } } }
                    float f1 = 1.f, f2 = 1.f; bool rs1, rs2;
                    { float tm = s1[0];
#pragma unroll
                      for (int r = 1; r < 16; ++r) tm = fmaxf(tm, s1[r]);
                      tm = x32_max(tm); const float tmc = tm * c; rs1 = __any(tmc > mc1 + 8.0f);
                      if (rs1) { const float mn = fmaxf(mc1, tmc); f1 = __builtin_amdgcn_exp2f(mc1 - mn); mc1 = mn; } }
                    { float tm = s2[0];
#pragma unroll
                      for (int r = 1; r < 16; ++r) tm = fmaxf(tm, s2[r]);
                      tm = x32_max(tm); const float tmc = tm * c; rs2 = __any(tmc > mc2 + 8.0f);
                      if (rs2) { const float mn = fmaxf(mc2, tmc); f2 = __builtin_amdgcn_exp2f(mc2 - mn); mc2 = mn; } }
                    float ls1 = 0.f, ls2 = 0.f; u32x4 pn1[2], pn2[2];
#define DA_SM(j) do { { const float pv_ = __builtin_amdgcn_exp2f(s1[j] * c - mc1); s1[j] = pv_; ls1 += pv_; } { const float pv_ = __builtin_amdgcn_exp2f(s2[j] * c - mc2); s2[j] = pv_; ls2 += pv_; } \
                        if ((j) & 1) { pn1[(j) >> 3][((j) & 7) >> 1] = cvt_pk_bf16(s1[(j) - 1], s1[j]); pn2[(j) >> 3][((j) & 7) >> 1] = cvt_pk_bf16(s2[(j) - 1], s2[j]); } } while (0)
                    { bf16x8 va, vb;
#define DA_VLD(p) (*(const LAS bf16x8*)(sp + (8 + ((p) & 3) * 2 + ((p) >> 2)) * 1024))
#define DA_SLOT(j, VF, LDNEXT) do { if ((j) & 1) o2[((j) >> 1) & 3] = __builtin_amdgcn_mfma_f32_32x32x16_bf16(VF, __builtin_bit_cast(bf16x8, pp2[(j) >> 3]), o2[((j) >> 1) & 3], 0, 0, 0); \
                            else o1[((j) >> 1) & 3] = __builtin_amdgcn_mfma_f32_32x32x16_bf16(VF, __builtin_bit_cast(bf16x8, pp1[(j) >> 3]), o1[((j) >> 1) & 3], 0, 0, 0); \
                            LDNEXT; DA_SM(j); __builtin_amdgcn_sched_barrier(0); } while (0)
                      va = DA_VLD(0);
                      __builtin_amdgcn_sched_barrier(0);
                      DA_SLOT(0, va, vb = DA_VLD(1)); DA_SLOT(1, va, (void)0); DA_SLOT(2, vb, va = DA_VLD(2)); DA_SLOT(3, vb, (void)0);
                      DA_SLOT(4, va, vb = DA_VLD(3)); DA_SLOT(5, va, (void)0); DA_SLOT(6, vb, va = DA_VLD(4)); DA_SLOT(7, vb, (void)0);
                      DA_SLOT(8, va, vb = DA_VLD(5)); DA_SLOT(9, va, (void)0); DA_SLOT(10, vb, va = DA_VLD(6)); DA_SLOT(11, vb, (void)0);
                      DA_SLOT(12, va, vb = DA_VLD(7)); DA_SLOT(13, va, (void)0); DA_SLOT(14, vb, (void)0); DA_SLOT(15, vb, (void)0);
#undef DA_VLD
#undef DA_SLOT
                    }
#undef DA_SM
                    l1 = l1 * f1 + ls1; l2 = l2 * f2 + ls2;
                    if (rs1) {
#pragma unroll
                        for (int d = 0; d < 4; ++d)
#pragma unroll
                            for (int r = 0; r < 16; ++r) o1[d][r] *= f1; }
                    if (rs2) {
#pragma unroll
                        for (int d = 0; d < 4; ++d)
#pragma unroll
                            for (int r = 0; r < 16; ++r) o2[d][r] *= f2; }
#pragma unroll
                    for (int sb = 0; sb < 2; ++sb) { pp1[sb] = pn1[sb]; pp2[sb] = pn2[sb]; }
                }
            }
#undef DA_ISSUE
            l1 = x32_sum(l1); l2 = x32_sum(l2);
            int ie = i, he = hh; asm volatile("" : "+v"(ie), "+v"(he));
            const float i1 = 1.0f / l1, i2 = lam / l2; float ss = 0.f;
#pragma unroll
            for (int d = 0; d < 4; ++d)
#pragma unroll
                for (int r = 0; r < 16; ++r) { const float o = o1[d][r] * i1 - o2[d][r] * i2; o1[d][r] = o; ss += o * o; }
            ss = x32_sum(ss);
            const float rn = rsqrtf(ss * (1.0f / 128.0f) + EPS) * (1.0f - LAMBDA_INIT);
            bf16_t* op = cat + (size_t)(b * SEQ + q0 + ie) * DM + h * 128 + 4 * he;
            const float* gp = dng + h * 128 + 4 * he;
#pragma unroll
            for (int d = 0; d < 4; ++d)
#pragma unroll
                for (int g = 0; g < 4; ++g) { const f32x4 gv = *(const f32x4*)(gp + d * 32 + 8 * g);
                    u32x2 w; w.x = cvt_pk_bf16(o1[d][4 * g] * rn * gv[0], o1[d][4 * g + 1] * rn * gv[1]); w.y = cvt_pk_bf16(o1[d][4 * g + 2] * rn * gv[2], o1[d][4 * g + 3] * rn * gv[3]);
                    *(u32x2*)(op + d * 32 + 8 * g) = w; }
        }
}

__device__ __forceinline__ void mlstm_prep_phase(LAS unsigned char* lds, const bf16_t* P2, const bf16_t* VT, const float* gates, const float* conv_w, const float* conv_b,
                                                 bf16_t* QM, bf16_t* KM, float* BC, float* AV, float* AM, float* CH, float* NLOC, float* CLOC, int G, int vx, int wave) {
    const int lane = lane_id(), i = lane & 31, hh = lane >> 5;
    LAS unsigned char* kl = lds + wave * 16384;
    for (int task = vx * 8 + wave; task < BATCH * 4 * 16; task += G * 8) {
        const int bh = task >> 4, c = task & 15, b = bh >> 2, h = bh & 3;
        const int t0 = b * SEQ + c * 128, tA = t0 + 2 * lane;
        const float lf0 = gates[(size_t)tA * 8 + 4 + h], lf1 = gates[(size_t)(tA + 1) * 8 + 4 + h], ig0 = gates[(size_t)tA * 8 + h], ig1 = gates[(size_t)(tA + 1) * 8 + h];
        float incl = lf0 + lf1;
#pragma unroll
        for (int off = 1; off < 64; off <<= 1) { const float v = __shfl_up(incl, off); if (lane >= off) incl += v; }
        const float bc1 = incl, bc0 = incl - lf1, blast = __shfl(incl, 63);
        const float a0 = ig0 - bc0, a1 = ig1 - bc1;
        float pm = fmaxf(a0, a1);
#pragma unroll
        for (int off = 1; off < 64; off <<= 1) { const float v = __shfl_up(pm, off); if (lane >= off) pm = fmaxf(pm, v); }
        const float pmprev = __shfl_up(pm, 1);
        const float am1 = pm, am0 = (lane > 0) ? fmaxf(pmprev, a0) : a0, amall = __shfl(pm, 63);
        const float ws0 = __expf(a0 - amall), ws1 = __expf(a1 - amall);
        *(f32x2*)(BC + (size_t)h * T + tA) = (f32x2){bc0, bc1};
        *(f32x2*)(AV + (size_t)h * T + tA) = (f32x2){a0, a1};
        *(f32x2*)(AM + (size_t)h * T + tA) = (f32x2){am0, am1};
        if (lane == 0) { CH[task * 2] = blast; CH[task * 2 + 1] = blast + amall; }
        {
            const int r8 = lane >> 3, cg = lane & 7;
            float cw[2][5][8];
#pragma unroll
            for (int part = 0; part < 2; ++part) { const int ch0 = (part ? 256 : 0) + h * 64 + 8 * cg;
#pragma unroll
                for (int k = 0; k < 4; ++k) { const f32x4 a = *(const f32x4*)(conv_w + k * 512 + ch0), bq = *(const f32x4*)(conv_w + k * 512 + ch0 + 4);
#pragma unroll
                    for (int j = 0; j < 4; ++j) { cw[part][k][j] = a[j]; cw[part][k][4 + j] = bq[j]; } }
                { const f32x4 a = *(const f32x4*)(conv_b + ch0), bq = *(const f32x4*)(conv_b + ch0 + 4);
#pragma unroll
                    for (int j = 0; j < 4; ++j) { cw[part][4][j] = a[j]; cw[part][4][4 + j] = bq[j]; } } }
#pragma unroll 4
            for (int jb = 0; jb < 16; ++jb) {
                const int p = 8 * jb + r8, tg = t0 + p, tseq = c * 128 + p;
                const float wa = __shfl(ws0, p >> 1), wb = __shfl(ws1, p >> 1); const float wsp = (p & 1) ? wb : wa;
                u32x4 uw[2][4];
#pragma unroll
                for (int part = 0; part < 2; ++part)
#pragma unroll
                    for (int k = 0; k < 4; ++k) { uw[part][k] = (u32x4){0u, 0u, 0u, 0u};
                        if (tseq - 3 + k >= 0) uw[part][k] = *(const u32x4*)(P2 + (size_t)(tg - 3 + k) * NP2 + 1024 + (part ? 256 : 0) + h * 64 + 8 * cg); }
#pragma unroll
                for (int part = 0; part < 2; ++part) { float y[8];
#pragma unroll
                    for (int j = 0; j < 8; ++j) { float pj = cw[part][4][j];
#pragma unroll
                        for (int k = 0; k < 4; ++k) { const unsigned wv = (j < 2) ? uw[part][k].x : (j < 4) ? uw[part][k].y : (j < 6) ? uw[part][k].z : uw[part][k].w; pj += cw[part][k][j] * ((j & 1) ? hi_bf(wv) : lo_bf(wv)); }
                        y[j] = pj * __builtin_amdgcn_rcpf(1.0f + __expf(-pj)); }
                    if (part == 0) { u32x4 w; w.x = cvt_pk_bf16(y[0] * 0.125f, y[1] * 0.125f); w.y = cvt_pk_bf16(y[2] * 0.125f, y[3] * 0.125f); w.z = cvt_pk_bf16(y[4] * 0.125f, y[5] * 0.125f); w.w = cvt_pk_bf16(y[6] * 0.125f, y[7] * 0.125f);
                        *(u32x4*)(QM + (size_t)tg * 256 + h * 64 + 8 * cg) = w; }
                    else { u32x4 w; w.x = cvt_pk_bf16(y[0], y[1]); w.y = cvt_pk_bf16(y[2], y[3]); w.z = cvt_pk_bf16(y[4], y[5]); w.w = cvt_pk_bf16(y[6], y[7]);
                        *(u32x4*)(KM + (size_t)tg * 256 + h * 64 + 8 * cg) = w;
#pragma unroll
                        for (int j = 0; j < 8; ++j) { const int d = 8 * cg + j;
                            *(LAS unsigned short*)(kl + d * 256 + ((jb ^ (d & 15)) * 16) + r8 * 2) = (unsigned short)f2bf(y[j] * wsp); } } }
            }
        }
        { float ns = 0.f;
#pragma unroll
          for (int cq = 0; cq < 16; ++cq) { const u32x4 w = *(const LAS u32x4*)(kl + lane * 256 + ((cq ^ (lane & 15)) * 16));
              ns += (lo_bf(w.x) + hi_bf(w.x)) + (lo_bf(w.y) + hi_bf(w.y)) + (lo_bf(w.z) + hi_bf(w.z)) + (lo_bf(w.w) + hi_bf(w.w)); }
          NLOC[(size_t)task * 64 + lane] = ns; }
        f32x16 acc[4][2];
#pragma unroll
        for (int et = 0; et < 4; ++et) { acc[et][0] = zero16(); acc[et][1] = zero16(); }
        const bf16_t* vp = VT + (size_t)(512 + h * 128 + i) * T + t0 + 8 * hh;
#pragma unroll
        for (int k2 = 0; k2 < 8; k2 += 2) {
            bf16x8 af[2][4];
#pragma unroll
            for (int q = 0; q < 2; ++q)
#pragma unroll
                for (int et = 0; et < 4; ++et) af[q][et] = *(const bf16x8*)(vp + (size_t)et * 32 * T + 16 * (k2 + q));
            __builtin_amdgcn_sched_barrier(0);
#pragma unroll
            for (int q = 0; q < 2; ++q) { const int ks = k2 + q; bf16x8 bfr[2];
#pragma unroll
                for (int dt = 0; dt < 2; ++dt) { const int d = 32 * dt + i; bfr[dt] = *(const LAS bf16x8*)(kl + d * 256 + (((2 * ks + hh) ^ (d & 15)) * 16)); }
#pragma unroll
                for (int et = 0; et < 4; ++et) {
                    acc[et][0] = __builtin_amdgcn_mfma_f32_32x32x16_bf16(af[q][et], bfr[0], acc[et][0], 0, 0, 0); acc[et][1] = __builtin_amdgcn_mfma_f32_32x32x16_bf16(af[q][et], bfr[1], acc[et][1], 0, 0, 0); } }
            __builtin_amdgcn_sched_barrier(0);
        }
        float* cp = CLOC + (size_t)task * 8192 + i + 256 * hh;
#pragma unroll
        for (int et = 0; et < 4; ++et)
#pragma unroll
            for (int dt = 0; dt < 2; ++dt)
#pragma unroll
                for (int r = 0; r < 16; ++r) cp[(32 * et + (r & 3) + 8 * (r >> 2)) * 64 + 32 * dt] = acc[et][dt][r];
    }
}
__device__ __forceinline__ void mlstm_scan_phase(const float* CLOC, const float* NLOC, const float* CH, bf16_t* CSTB, float* NST, float* MSTATE, int G, int bx, int tid) {
    for (int idx = bx * 512 + tid; idx < BATCH * 4 * 1024; idx += G * 512) {
        const int bh = idx >> 10, rem = idx & 1023, e = rem >> 3, d0 = (rem & 7) * 8;
        float C[8], nr[8]; float m = 0.f;
#pragma unroll
        for (int j = 0; j < 8; ++j) { C[j] = 0.f; nr[j] = 0.f; }
#pragma unroll 1
        for (int c8 = 0; c8 < 16; c8 += 8) {
            f32x4 cl[8][2], nl[8][2]; float bl[8], ml[8];
#pragma unroll
            for (int q = 0; q < 8; ++q) { const int task = bh * 16 + c8 + q;
                cl[q][0] = *(const f32x4*)(CLOC + (size_t)task * 8192 + e * 64 + d0); cl[q][1] = *(const f32x4*)(CLOC + (size_t)task * 8192 + e * 64 + d0 + 4);
                bl[q] = CH[task * 2]; ml[q] = CH[task * 2 + 1];
                if (rem < 8) { nl[q][0] = *(const f32x4*)(NLOC + (size_t)task * 64 + rem * 8); nl[q][1] = *(const f32x4*)(NLOC + (size_t)task * 64 + rem * 8 + 4); }
                else { nl[q][0] = (f32x4){0.f, 0.f, 0.f, 0.f}; nl[q][1] = nl[q][0]; } }
#pragma unroll
            for (int q = 0; q < 8; ++q) { const int task = bh * 16 + c8 + q;
                u32x4 w; w.x = cvt_pk_bf16(C[0], C[1]); w.y = cvt_pk_bf16(C[2], C[3]); w.z = cvt_pk_bf16(C[4], C[5]); w.w = cvt_pk_bf16(C[6], C[7]);
                *(u32x4*)(CSTB + (size_t)task * 8192 + e * 64 + d0) = w;
                if (rem < 8) { *(f32x4*)(NST + (size_t)task * 64 + rem * 8) = (f32x4){nr[0], nr[1], nr[2], nr[3]}; *(f32x4*)(NST + (size_t)task * 64 + rem * 8 + 4) = (f32x4){nr[4], nr[5], nr[6], nr[7]}; }
                if (rem == 0) MSTATE[task] = m;
                const float mn = fmaxf(bl[q] + m, ml[q]), a = __expf(bl[q] + m - mn), bco = __expf(ml[q] - mn);
#pragma unroll
                for (int j = 0; j < 4; ++j) { C[j] = a * C[j] + bco * cl[q][0][j]; C[4 + j] = a * C[4 + j] + bco * cl[q][1][j]; nr[j] = a * nr[j] + bco * nl[q][0][j]; nr[4 + j] = a * nr[4 + j] + bco * nl[q][1][j]; }
                m = mn; }
        }
    }
}
__device__ __forceinline__ void mlstm_out_phase(LAS unsigned char* lds, const bf16_t* P2, const bf16_t* VT, const bf16_t* QM, const bf16_t* KM, const float* BC, const float* AV, const float* AM,
                                                const bf16_t* CSTB, const float* NST, const float* MSTATE, const float* mng, bf16_t* cat, int G, int vx, int wave) {
    const int lane_ = lane_id();
    const int cw = wave >> 2, tq = wave & 3;
    LAS unsigned char* reg = lds + cw * 65536;
    for (int un = vx; un < BATCH * 4 * 8; un += G) {
        int lane = lane_; asm volatile("" : "+v"(lane));
        const int i = lane & 31, hh = lane >> 5;
        const int task = 2 * un + cw, bh = task >> 4, c = task & 15, b = bh >> 2, h = bh & 3;
        const int t0 = b * SEQ + c * 128;
        { const bf16_t* ks = KM + (size_t)(t0 + 32 * tq + pi32(i)) * 256 + h * 64 + 8 * hh;
          const bf16_t* cs = CSTB + (size_t)task * 8192 + (32 * tq + i) * 64 + 8 * hh;
          const bf16_t* vs = VT + (size_t)(512 + h * 128 + 32 * tq + i) * T + t0 + 8 * hh;
#pragma unroll
          for (int ds = 0; ds < 4; ++ds) { __builtin_amdgcn_global_load_lds((const unsigned*)(ks + 16 * ds), (LAS unsigned*)(reg + (tq * 4 + ds) * 1024), 16, 0, 0);
              __builtin_amdgcn_global_load_lds((const unsigned*)(cs + 16 * ds), (LAS unsigned*)(reg + 16384 + (tq * 4 + ds) * 1024), 16, 0, 0); }
#pragma unroll
          for (int k8 = 0; k8 < 8; ++k8) __builtin_amdgcn_global_load_lds((const unsigned*)(vs + 16 * k8), (LAS unsigned*)(reg + 32768 + (tq * 8 + k8) * 1024), 16, 0, 0); }
        const float m_c = MSTATE[task];
        const int tg = t0 + 32 * tq + i;
        const float bct = BC[(size_t)h * T + tg], amt = AM[(size_t)h * T + tg];
        bf16x8 qf[4];
#pragma unroll
        for (int ds = 0; ds < 4; ++ds) qf[ds] = *(const bf16x8*)(QM + (size_t)tg * 256 + h * 64 + 16 * ds + 8 * hh);
        float qn = 0.f;
#pragma unroll
        for (int ds = 0; ds < 4; ++ds) { const f32x4 n0 = *(const f32x4*)(NST + (size_t)task * 64 + 16 * ds + 8 * hh), n1 = *(const f32x4*)(NST + (size_t)task * 64 + 16 * ds + 8 * hh + 4);
            const u32x4 w = __builtin_bit_cast(u32x4, qf[ds]);
            qn += lo_bf(w.x) * n0[0] + hi_bf(w.x) * n0[1] + lo_bf(w.y) * n0[2] + hi_bf(w.y) * n0[3] + lo_bf(w.z) * n1[0] + hi_bf(w.z) * n1[1] + lo_bf(w.w) * n1[2] + hi_bf(w.w) * n1[3]; }
        qn = x32_sum(qn);
        const float M = fmaxf(m_c, amt), g = __expf(m_c - M), emt = __expf(-(bct + M));
        const bf16_t* mop = P2 + (size_t)tg * NP2 + 1536 + h * 128 + 4 * hh;
        u32x2 mov[4][4];
#pragma unroll
        for (int et = 0; et < 4; ++et)
#pragma unroll
            for (int g4 = 0; g4 < 4; ++g4) mov[et][g4] = *(const u32x2*)(mop + et * 32 + 8 * g4);
        asm volatile("s_waitcnt vmcnt(0)" ::: "memory"); __builtin_amdgcn_s_barrier(); asm volatile("" ::: "memory");
        const LAS unsigned char* rl = reg + lane * 16;
        f32x16 acc[4];
#pragma unroll
        for (int et = 0; et < 4; ++et) { acc[et] = zero16();
#pragma unroll
            for (int ds = 0; ds < 4; ++ds) acc[et] = __builtin_amdgcn_mfma_f32_32x32x16_bf16(*(const LAS bf16x8*)(rl + 16384 + (et * 4 + ds) * 1024), qf[ds], acc[et], 0, 0, 0);
#pragma unroll
            for (int r = 0; r < 16; ++r) acc[et][r] *= g; }
        float wsum = 0.f;
        for (int kt = 0; kt <= tq; ++kt) {
            f32x16 sc = zero16();
#pragma unroll
            for (int ds = 0; ds < 4; ++ds) sc = __builtin_amdgcn_mfma_f32_32x32x16_bf16(*(const LAS bf16x8*)(rl + (kt * 4 + ds) * 1024), qf[ds], sc, 0, 0, 0);
            const float* ap = AV + (size_t)h * T + t0 + 32 * kt + 8 * hh;
            const f32x4 a00 = *(const f32x4*)(ap), a01 = *(const f32x4*)(ap + 4), a10 = *(const f32x4*)(ap + 16), a11 = *(const f32x4*)(ap + 20);
#pragma unroll
            for (int r = 0; r < 16; ++r) { const float av = (r < 4) ? a00[r & 3] : (r < 8) ? a01[r & 3] : (r < 12) ? a10[r & 3] : a11[r & 3];
                const int ko = 16 * (r >> 3) + 8 * hh + (r & 7);
                float w = sc[r] * __expf(av - M);
                w = (kt == tq && ko > i) ? 0.f : w;
                sc[r] = w; wsum += w; }
            u32x4 wf[2];
#pragma unroll
            for (int sb = 0; sb < 2; ++sb) { wf[sb].x = cvt_pk_bf16(sc[8 * sb + 0], sc[8 * sb + 1]); wf[sb].y = cvt_pk_bf16(sc[8 * sb + 2], sc[8 * sb + 3]); wf[sb].z = cvt_pk_bf16(sc[8 * sb + 4], sc[8 * sb + 5]); wf[sb].w = cvt_pk_bf16(sc[8 * sb + 6], sc[8 * sb + 7]); }
#pragma unroll
            for (int et = 0; et < 4; ++et)
#pragma unroll
                for (int sb = 0; sb < 2; ++sb) acc[et] = __builtin_amdgcn_mfma_f32_32x32x16_bf16(*(const LAS bf16x8*)(rl + 32768 + (et * 8 + 2 * kt + sb) * 1024), __builtin_bit_cast(bf16x8, wf[sb]), acc[et], 0, 0, 0);
        }
        wsum = x32_sum(wsum);
        const float den = g * qn + wsum, idd = 1.0f / fmaxf(fabsf(den), emt);
        float ss = 0.f;
#pragma unroll
        for (int et = 0; et < 4; ++et)
#pragma unroll
            for (int r = 0; r < 16; ++r) { const float hv = acc[et][r] * idd; acc[et][r] = hv; ss += hv * hv; }
        ss = x32_sum(ss);
        const float rn = rsqrtf(ss * (1.0f / 128.0f) + EPS);
        bf16_t* op = cat + (size_t)tg * DM + 512 + h * 128 + 4 * hh;
        const float* gp = mng + h * 128 + 4 * hh;
#pragma unroll
        for (int et = 0; et < 4; ++et)
#pragma unroll
            for (int g4 = 0; g4 < 4; ++g4) { const f32x4 gv = *(const f32x4*)(gp + et * 32 + 8 * g4); const u32x2 mo = mov[et][g4];
                const float o0 = lo_bf(mo.x), o1 = hi_bf(mo.x), o2 = lo_bf(mo.y), o3 = hi_bf(mo.y);
                const float y0 = acc[et][4 * g4] * rn * gv[0] * __builtin_amdgcn_rcpf(1.0f + __expf(-o0)), y1 = acc[et][4 * g4 + 1] * rn * gv[1] * __builtin_amdgcn_rcpf(1.0f + __expf(-o1));
                const float y2 = acc[et][4 * g4 + 2] * rn * gv[2] * __builtin_amdgcn_rcpf(1.0f + __expf(-o2)), y3 = acc[et][4 * g4 + 3] * rn * gv[3] * __builtin_amdgcn_rcpf(1.0f + __expf(-o3));
                u32x2 w; w.x = cvt_pk_bf16(y0, y1); w.y = cvt_pk_bf16(y2, y3); *(u32x2*)(op + et * 32 + 8 * g4) = w; }
        asm volatile("s_waitcnt lgkmcnt(0)" ::: "memory"); __builtin_amdgcn_s_barrier(); asm volatile("" ::: "memory");
    }
}

constexpr int NWAVES = 8;
constexpr int RING_BYTES = 131072;
constexpr int LDSCTL_OFF = RING_BYTES;
constexpr int LDS_BYTES = RING_BYTES + 5120;

enum Phase { PH_PREP = 0, PH_INPROJ = 1, PH_MIX0 = 2, PH_MIX1 = 3, PH_MIX2 = 4, PH_OUTPROJ = 5, PH_QKV = 6, PH_XATTN = 7, PH_COPROJ = 8, PH_ROUTER = 9, PH_G1 = 10, PH_G2 = 11, PH_COMBINE = 12, PH_END = 13 };

struct Args { const float* in[28]; float* out; unsigned char* ws; int ph_lo, ph_hi, pass_lo, pass_hi; };

struct CJob { const float* src; const float* g; unsigned char* dst; int Nsrc, k0, n0, mode, f8; float scale; };
__device__ __forceinline__ void conv_load(const CJob& j, f32x4 (&v)[2], int tid) {
    const int kk = tid >> 4, c4 = (tid & 15) * 4;
#pragma unroll
    for (int rep = 0; rep < 2; ++rep) v[rep] = *(const f32x4*)(j.src + (size_t)(j.k0 + kk + 32 * rep) * j.Nsrc + j.n0 + c4);
}
__device__ __forceinline__ void conv_put(LAS float* tile, const f32x4 (&v)[2], int tid) {
    const int kk = tid >> 4, c4 = (tid & 15) * 4;
#pragma unroll
    for (int rep = 0; rep < 2; ++rep)
#pragma unroll
        for (int q = 0; q < 4; ++q) tile[(kk + 32 * rep) * 65 + c4 + q] = v[rep][q];
}
__device__ __forceinline__ void conv_store(const LAS float* tile, const CJob& j, int tid) {
    const int n = tid >> 3, kc = tid & 7; float vals[8];
    f32x4 g0 = (f32x4){1.f, 1.f, 1.f, 1.f}, g1 = g0;
    if (j.g) { g0 = *(const f32x4*)(j.g + j.k0 + 8 * kc); g1 = *(const f32x4*)(j.g + j.k0 + 8 * kc + 4); }
#pragma unroll
    for (int q = 0; q < 8; ++q) vals[q] = tile[(8 * kc + q) * 65 + n] * (q < 4 ? g0[q & 3] : g1[q & 3]) * j.scale;
    const int sc = j.n0 + n; int drow = sc;
    if (j.mode == 1) { const int jj = sc >> 1, s = sc & 1; drow = 256 * (jj >> 7) + 128 * s + (jj & 127); }
    if (j.mode == 2) { drow = sc < 1024 ? sc : sc < 1536 ? sc + 1024 : sc < 2048 ? sc - 512 : sc < 2560 ? sc + 512 : sc - 1024; }
    if (j.f8) { unsigned w0 = 0u, w1 = 0u;
        w0 = __builtin_amdgcn_cvt_pk_fp8_f32(c8(vals[0]), c8(vals[1]), w0, false); w0 = __builtin_amdgcn_cvt_pk_fp8_f32(c8(vals[2]), c8(vals[3]), w0, true);
        w1 = __builtin_amdgcn_cvt_pk_fp8_f32(c8(vals[4]), c8(vals[5]), w1, false); w1 = __builtin_amdgcn_cvt_pk_fp8_f32(c8(vals[6]), c8(vals[7]), w1, true);
        *(u32x2*)(j.dst + (size_t)drow * 1024 + j.k0 + 8 * kc) = (u32x2){w0, w1}; }
    else { u32x4 w; w.x = cvt_pk_bf16(vals[0], vals[1]); w.y = cvt_pk_bf16(vals[2], vals[3]); w.z = cvt_pk_bf16(vals[4], vals[5]); w.w = cvt_pk_bf16(vals[6], vals[7]);
        *(u32x4*)(j.dst + ((size_t)drow * 1024 + j.k0 + 8 * kc) * 2) = w; }
}

__global__ void __launch_bounds__(NWAVES * 64, 2) fwd(Args args) {
    extern __shared__ __attribute__((aligned(16))) unsigned char lds_raw[];
    LAS unsigned char* lds = (LAS unsigned char*)lds_raw;
    volatile LAS unsigned* LCTL = (volatile LAS unsigned*)(lds + LDSCTL_OFF);
    const int wave = __builtin_amdgcn_readfirstlane(threadIdx.x >> 6);
#define lane lane_id()
#define tid (wave * 64 + lane_id())
    const int G = gridDim.x, bx = blockIdx.x;
    unsigned char* ws = args.ws;
    unsigned* ctl = (unsigned*)(ws + WS_CTL);
    const int lo = args.ph_lo, hi = args.ph_hi;
#ifndef PHMASK
#define PHMASK 0xffffff
#endif
#ifndef DUPMASK
#define DUPMASK 0x0
#endif
#define IN(k) (((PHMASK >> (k)) & 1) && lo <= (k) && (k) < hi)
#define NREP(k) ((((DUPMASK) >> (k)) & 1) ? 2 : 1)
#define ENDBAR(k) (BOTH(k) || (((DUPMASK) >> (k)) & 1))
#define BOTH(k) (IN(k) && IN((k) + 1))
    for (int u = tid; u < (LDS_BYTES - LDSCTL_OFF) / 4; u += NWAVES * 64) LCTL[u] = 0u;
    __syncthreads();
    XcdBarrier bar; bar.bar = ctl + CW_BAR; bar.x = 0; bar.st = LCTL; bar.wave = wave;
    const bool multi = (hi - lo) > 1 || (args.pass_hi - args.pass_lo) > 1 || (IN(PH_G1) && IN(PH_G2));
    if (multi) bar = xcd_barrier_post(ctl + CW_BAR, LCTL, wave);
#define GRID_BAR() xcd_barrier(bar)

    const float* x = args.in[0]; const float* mem = args.in[1];
    bf16_t* XB = (bf16_t*)(ws + WS_XB); bf16_t* PROJ = (bf16_t*)(ws + WS_PROJ); bf16_t* CAT = (bf16_t*)(ws + WS_CAT);
    bf16_t* MEMB = (bf16_t*)(ws + WS_MEMB); bf16_t* KV = (bf16_t*)(ws + WS_KV); bf16_t* VT2 = (bf16_t*)(ws + WS_VT2); bf16_t* VT1 = (bf16_t*)(ws + WS_VT1); unsigned char* H1F = ws + WS_H1F;
    bf16_t* WIN = (bf16_t*)(ws + WS_WIN); bf16_t* WOUT = (bf16_t*)(ws + WS_WOUT); bf16_t* WCQ = (bf16_t*)(ws + WS_WCQ); bf16_t* WCKV = (bf16_t*)(ws + WS_WCKV);
    bf16_t* WCO = (bf16_t*)(ws + WS_WCO); bf16_t* WR = (bf16_t*)(ws + WS_WR); unsigned char* W1F = ws + WS_W1; unsigned char* W2F = ws + WS_W2; unsigned char* H2F = ws + WS_H2F;
    float* RSTDX = (float*)(ws + WS_RSTDX); float* RSTDM = (float*)(ws + WS_RSTDM); float* B1P = (float*)(ws + WS_B1P); float* MISC = (float*)(ws + WS_MISC); float* RSTD2 = (float*)(ws + WS_RSTD2);
    float* SSP1 = (float*)(ws + WS_SSP1); float* SSP2 = (float*)(ws + WS_SSP2); float* GATES = (float*)(ws + WS_GATES);
    unsigned* TOKMAP = (unsigned*)(ws + WS_TOKMAP); float* GATEV = (float*)(ws + WS_GATEV); unsigned* LIST = (unsigned*)(ws + WS_LIST);
    unsigned char* YB = ws + WS_Y; unsigned char* HID = ws + WS_HID;

    if (IN(PH_PREP)) for (int rep_ = 0; rep_ < NREP(PH_PREP); ++rep_) {
        constexpr int J0 = 768, J1 = J0 + 256, J2 = J1 + 256, J3 = J2 + 512, J4 = J3 + 256, J5 = J4 + 16384, J6 = J5 + 8192;
        auto decode = [&](int it, CJob& j) {
            if (it < J0) { j = CJob{args.in[3], args.in[2], (unsigned char*)WIN, DIN, (it / 48) * 64, (it % 48) * 64, 2, 0, 1.0f}; }
            else if (it < J1) { const int r = it - J0; j = CJob{args.in[14], nullptr, (unsigned char*)WOUT, 1024, (r / 16) * 64, (r % 16) * 64, 0, 0, 1.0f}; }
            else if (it < J2) { const int r = it - J1; j = CJob{args.in[17], args.in[15], (unsigned char*)WCQ, 1024, (r / 16) * 64, (r % 16) * 64, 0, 1, 64.0f}; }
            else if (it < J3) { const int r = it - J2; j = CJob{args.in[18], args.in[16], (unsigned char*)WCKV, 2048, (r / 32) * 64, (r % 32) * 64, 0, 1, 64.0f}; }
            else if (it < J4) { const int r = it - J3; j = CJob{args.in[19], nullptr, (unsigned char*)WCO, 1024, (r / 16) * 64, (r % 16) * 64, 0, 1, 64.0f}; }
            else if (it < J5) { const int r = it - J4; const int e = r >> 9, q = r & 511; j = CJob{args.in[23] + (size_t)e * 1024 * 2048, args.in[20], W1F + (size_t)e * 2048 * 1024, 2048, (q / 32) * 64, (q % 32) * 64, 1, 1, 64.0f}; }
            else { const int r = it - J5; const int e = r >> 8, q = r & 255; j = CJob{args.in[25] + (size_t)e * 1024 * 1024, nullptr, W2F + (size_t)e * 1024 * 1024, 1024, (q / 16) * 64, (q % 16) * 64, 0, 1, 64.0f}; } };
        for (int it0 = bx * 4; it0 < J6; it0 += G * 4) {
            CJob jb[4]; f32x4 v[4][2];
#pragma unroll
            for (int q = 0; q < 4; ++q) { decode(it0 + q < J6 ? it0 + q : J6 - 1, jb[q]); conv_load(jb[q], v[q], tid); }
#pragma unroll
            for (int q = 0; q < 4; ++q) conv_put((LAS float*)lds + q * (64 * 65), v[q], tid);
            __syncthreads();
#pragma unroll
            for (int q = 0; q < 4; ++q) if (it0 + q < J6) conv_store((const LAS float*)lds + q * (64 * 65), jb[q], tid);
            __syncthreads();
        }
        for (int i = bx * 512 + tid; i < NEXP * 1024; i += G * 512) { const int e = i >> 10, k = i & 1023; WR[i] = (bf16_t)f2bf(args.in[21][k * NEXP + e] * args.in[20][k]); }
        for (int i = bx * 512 + tid; i < NEXP * 2048; i += G * 512) { const int e = i >> 11, rho = i & 2047; const int pn = rho >> 8, s = (rho >> 7) & 1, ii = rho & 127; B1P[i] = args.in[24][e * 2048 + 2 * (128 * pn + ii) + s]; }
        if (bx == 0 && wave == 0) { const float a = wave_sum(args.in[9][lane] * args.in[10][lane]), b = wave_sum(args.in[11][lane] * args.in[12][lane]);
            if (lane == 0) MISC[0] = expf(a) - expf(b) + LAMBDA_INIT; }
        {
            const float* win = args.in[3]; const float* g = args.in[2];
            float wg[4][4][8];
#pragma unroll
            for (int jj = 0; jj < 4; ++jj)
#pragma unroll
                for (int q = 0; q < 4; ++q) { const int k = 4 * lane + 256 * jj + q; const float gk = g[k];
                    const f32x4 a = *(const f32x4*)(win + (size_t)k * DIN + 3072), b = *(const f32x4*)(win + (size_t)k * DIN + 3076);
#pragma unroll
                    for (int j = 0; j < 4; ++j) { wg[jj][q][j] = a[j] * gk; wg[jj][q][4 + j] = b[j] * gk; } }
            const int gw = bx * NWAVES + wave, NGW = G * NWAVES;
            f32x4 vn[4];
            if (gw < T) { const f32x4* xr = (const f32x4*)(x + (size_t)gw * DM) + lane;
#pragma unroll
                for (int jj = 0; jj < 4; ++jj) vn[jj] = xr[64 * jj]; }
            for (int row = gw; row < T; row += NGW) {
                f32x4 v[4]; float ss = 0.f; float d[8];
#pragma unroll
                for (int jj = 0; jj < 4; ++jj) v[jj] = vn[jj];
                if (row + NGW < T) { const f32x4* xr = (const f32x4*)(x + (size_t)(row + NGW) * DM) + lane;
#pragma unroll
                    for (int jj = 0; jj < 4; ++jj) vn[jj] = xr[64 * jj]; }
#pragma unroll
                for (int j = 0; j < 8; ++j) d[j] = 0.f;
#pragma unroll
                for (int jj = 0; jj < 4; ++jj) {
#pragma unroll
                    for (int q = 0; q < 4; ++q) { ss += v[jj][q] * v[jj][q];
#pragma unroll
                        for (int j = 0; j < 8; ++j) d[j] += v[jj][q] * wg[jj][q][j]; } }
                ss = wave_sum(ss);
#pragma unroll
                for (int j = 0; j < 8; ++j) d[j] = wave_sum(d[j]);
                const float rs = rsqrtf(ss * (1.0f / DM) + EPS);
                u32x2* o8 = (u32x2*)(XB + (size_t)row * DM) + lane;
#pragma unroll
                for (int jj = 0; jj < 4; ++jj) { u32x2 w; w.x = cvt_pk_bf16(v[jj][0], v[jj][1]); w.y = cvt_pk_bf16(v[jj][2], v[jj][3]); o8[64 * jj] = w; }
                if (lane == 0) RSTDX[row] = rs;
                if (lane < 8) { float dv = d[0];
#pragma unroll
                    for (int j = 1; j < 8; ++j) dv = (lane == j) ? d[j] : dv;
                    dv *= rs; float r;
                    if (lane < 4) r = dv + args.in[6][lane];
                    else { const float z = dv + args.in[7][lane - 4]; r = (z >= 0.f) ? -log1pf(expf(-z)) : (z - log1pf(expf(z))); }
                    GATES[(size_t)row * 8 + lane] = r; }
            }
            for (int row = gw; row < MROWS; row += NGW) {
                const f32x4* xr = (const f32x4*)(mem + (size_t)row * DM) + lane;
                f32x4 v[4]; float ss = 0.f;
#pragma unroll
                for (int jj = 0; jj < 4; ++jj) { v[jj] = xr[64 * jj]; ss += (v[jj][0] * v[jj][0] + v[jj][1] * v[jj][1]) + (v[jj][2] * v[jj][2] + v[jj][3] * v[jj][3]); }
                ss = wave_sum(ss);
                unsigned* o4 = (unsigned*)((unsigned char*)MEMB + (size_t)row * DM) + lane;
#pragma unroll
                for (int jj = 0; jj < 4; ++jj) { unsigned w = 0u; w = __builtin_amdgcn_cvt_pk_fp8_f32(c8(v[jj][0]), c8(v[jj][1]), w, false); w = __builtin_amdgcn_cvt_pk_fp8_f32(c8(v[jj][2]), c8(v[jj][3]), w, true); o4[64 * jj] = w; }
                if (lane == 0) RSTDM[row] = rsqrtf(ss * (1.0f / DM) + EPS);
            }
        }
        if (ENDBAR(PH_PREP)) GRID_BAR();
    }

    if (IN(PH_INPROJ)) for (int rep_ = 0; rep_ < NREP(PH_INPROJ); ++rep_) {
        { ProbScaleBf16 P{(LAS unsigned*)(lds + LDSCTL_OFF + 2048), XB, WIN, T / 256, NP2 / 256, G, bx, PROJ, NP2, RSTDX, nullptr};
          pg8::gemm_phase<ProbScaleBf16, true>(lds, P, wave); }
        { ProbColScaleBf16 P{WIN + (size_t)NP2 * 1024, XB, 4, T / 256, G, bx, VT1, T, RSTDX};
          pg8::gemm_phase<ProbColScaleBf16, true>(lds, P, wave); }
        if (ENDBAR(PH_INPROJ)) GRID_BAR();
    }

    const int vx = (G % 8 == 0) ? (bx % 8) * (G / 8) + bx / 8 : bx;
    bf16_t* QM = (bf16_t*)(ws + WS_QM); bf16_t* KM = (bf16_t*)(ws + WS_KM); bf16_t* CSTB = (bf16_t*)(ws + WS_CSTB);
    float* BC = (float*)(ws + WS_BC); float* AV = (float*)(ws + WS_AV); float* AM = (float*)(ws + WS_AM); float* NLOC = (float*)(ws + WS_NLOC); float* NST = (float*)(ws + WS_NST);
    float* CH = (float*)(ws + WS_CH); float* MSTATE = (float*)(ws + WS_MSTATE); float* CLOC = (float*)(ws + WS_MST);
    if (IN(PH_MIX0)) for (int rep_ = 0; rep_ < NREP(PH_MIX0); ++rep_) {
        mlstm_prep_phase(lds, PROJ, VT1, GATES, args.in[4], args.in[5], QM, KM, BC, AV, AM, CH, NLOC, CLOC, G, vx, wave);
        if (ENDBAR(PH_MIX0)) GRID_BAR();
    }
    if (IN(PH_MIX1)) for (int rep_ = 0; rep_ < NREP(PH_MIX1); ++rep_) {
        mlstm_scan_phase(CLOC, NLOC, CH, CSTB, NST, MSTATE, G, bx, tid);
        if (ENDBAR(PH_MIX1)) GRID_BAR();
    }
    if (IN(PH_MIX2)) for (int rep_ = 0; rep_ < NREP(PH_MIX2); ++rep_) {
        mlstm_out_phase(lds, PROJ, VT1, QM, KM, BC, AV, AM, CSTB, NST, MSTATE, args.in[8], CAT, G, vx, wave);
        __syncthreads();
        const float lam = __hip_atomic_load(MISC, __ATOMIC_RELAXED, __HIP_MEMORY_SCOPE_AGENT);
        diffattn_phase(lds, PROJ, VT1, args.in[13], lam, CAT, G, vx, wave);
        if (ENDBAR(PH_MIX2)) GRID_BAR();
    }

    if (IN(PH_OUTPROJ)) for (int rep_ = 0; rep_ < NREP(PH_OUTPROJ); ++rep_) {
        ProbResidT<false, true, false> P{(LAS unsigned*)(lds + LDSCTL_OFF + 2048), CAT, WOUT, T / 256, 4, G, bx, nullptr, XB, XB, H1F, SSP1};
        pg8::gemm_phase<ProbResidT<false, true, false>, true>(lds, P, wave);
        if (ENDBAR(PH_OUTPROJ)) GRID_BAR();
    }

    if (IN(PH_QKV)) for (int rep_ = 0; rep_ < NREP(PH_QKV); ++rep_) {
        { ProbScaleT<true> P{(LAS unsigned*)(lds + LDSCTL_OFF + 2048), H1F, WCQ, T / 256, 4, G, bx, PROJ, 1024, nullptr, SSP1};
          pg8::gemm_phase<ProbScaleT<true>, true>(lds, P, wave); }
        { ProbKV P{(LAS unsigned*)(lds + LDSCTL_OFF + 2048), (const unsigned char*)MEMB, (const unsigned char*)WCKV, KV, VT2, RSTDM, G, bx};
          pg8::gemm_phase<ProbKV, true>(lds, P, wave); }
        if (ENDBAR(PH_QKV)) GRID_BAR();
    }

    if (IN(PH_XATTN)) for (int rep_ = 0; rep_ < NREP(PH_XATTN); ++rep_) {
        xattn_phase(lds, PROJ, KV, VT2, (unsigned char*)(PROJ + (size_t)T * 1024), G, vx, wave);
        if (ENDBAR(PH_XATTN)) GRID_BAR();
    }

    if (IN(PH_COPROJ)) for (int rep_ = 0; rep_ < NREP(PH_COPROJ); ++rep_) {
        ProbResidT<true, false, false> P{(LAS unsigned*)(lds + LDSCTL_OFF + 2048), (unsigned char*)(PROJ + (size_t)T * 1024), WCO, T / 256, 4, G, bx, nullptr, XB, CAT, nullptr, SSP2};
        pg8::gemm_phase<ProbResidT<true, false, false>, true>(lds, P, wave);
        if (ENDBAR(PH_COPROJ)) GRID_BAR();
    }

    if (IN(PH_ROUTER)) for (int rep_ = 0; rep_ < NREP(PH_ROUTER); ++rep_) {
        { u32x4 wv[8];
#pragma unroll
          for (int q = 0; q < 8; ++q) { const int idx = q * (NWAVES * 64) + tid, ks = idx >> 6, ln = idx & 63; wv[q] = *(const u32x4*)(WR + (size_t)(ln & 31) * DM + 16 * ks + 8 * (ln >> 5)); }
#pragma unroll
          for (int q = 0; q < 8; ++q) { const int idx = q * (NWAVES * 64) + tid; *(LAS u32x4*)(lds + idx * 16) = wv[q]; } }
        __syncthreads();
        const float* brt = args.in[22];
        const int i = lane & 31, hh = lane >> 5;
        volatile LAS unsigned* lcnt = (volatile LAS unsigned*)(lds + 65536);
        const int ntrip = (T / 32 + G * NWAVES - 1) / (G * NWAVES);
        for (int trip = 0; trip < ntrip; ++trip) {
            const int tile = trip * G * NWAVES + bx * NWAVES + wave; const bool act = tile < T / 32;
            if (tid < 32) lcnt[tid] = 0u;
            __syncthreads();
            const int t = (act ? tile : 0) * 32 + i;
            const bf16_t* xp = CAT + (size_t)t * DM + 8 * hh;
            const f32x4 p0 = *(const f32x4*)(SSP2 + (size_t)t * 16 + 8 * hh), p1 = *(const f32x4*)(SSP2 + (size_t)t * 16 + 8 * hh + 4);
            float sp = (p0[0] + p0[1]) + (p0[2] + p0[3]) + (p1[0] + p1[1]) + (p1[2] + p1[3]); sp = x32_sum(sp);
            const float rs = rsqrtf(sp * (1.0f / DM) + EPS);
            f32x16 acc = zero16();
#pragma unroll 16
            for (int ks = 0; ks < 64; ++ks) { const bf16x8 xf = *(const bf16x8*)(xp + 16 * ks); const bf16x8 wf = *(const LAS bf16x8*)(lds + (ks * 64 + lane) * 16);
                acc = __builtin_amdgcn_mfma_f32_32x32x16_bf16(wf, xf, acc, 0, 0, 0);
                if (act) { const u32x4 xw = __builtin_bit_cast(u32x4, xf); unsigned w0 = 0u, w1 = 0u;
                    w0 = __builtin_amdgcn_cvt_pk_fp8_f32(lo_bf(xw.x) * rs, hi_bf(xw.x) * rs, w0, false); w0 = __builtin_amdgcn_cvt_pk_fp8_f32(lo_bf(xw.y) * rs, hi_bf(xw.y) * rs, w0, true);
                    w1 = __builtin_amdgcn_cvt_pk_fp8_f32(lo_bf(xw.z) * rs, hi_bf(xw.z) * rs, w1, false); w1 = __builtin_amdgcn_cvt_pk_fp8_f32(lo_bf(xw.w) * rs, hi_bf(xw.w) * rs, w1, true);
                    *(u32x2*)(H2F + (size_t)t * DM + 16 * ks + 8 * hh) = (u32x2){w0, w1}; } }
            float mine[16], oth[16];
#pragma unroll
            for (int r = 0; r < 16; ++r) { const int e = (r & 3) + 8 * (r >> 2); mine[r] = acc[r] * rs + brt[e + 4 * hh]; }
#pragma unroll
            for (int r = 0; r < 16; ++r) oth[r] = x32_other(mine[r], hh);
            float lg[NEXP];
#pragma unroll
            for (int r = 0; r < 16; ++r) { const int e = (r & 3) + 8 * (r >> 2); lg[e] = hh ? oth[r] : mine[r]; lg[e + 4] = hh ? mine[r] : oth[r]; }
            unsigned taken = 0u; float tv[4]; int te[4];
#pragma unroll
            for (int k = 0; k < TOPK; ++k) { float best = -INFINITY; int bi = 0;
#pragma unroll
                for (int e = 0; e < NEXP; ++e) { const bool ok = !((taken >> e) & 1u) && (lg[e] > best); best = ok ? lg[e] : best; bi = ok ? e : bi; }
                taken |= 1u << bi; tv[k] = best; te[k] = bi; }
            const float q1 = __expf(tv[1] - tv[0]), q2 = __expf(tv[2] - tv[0]), q3 = __expf(tv[3] - tv[0]); const float inv = 1.0f / (1.0f + q1 + q2 + q3);
            const float gk[4] = {inv, q1 * inv, q2 * inv, q3 * inv};
            unsigned lp[4] = {0u, 0u, 0u, 0u};
            if (act && hh == 0) {
#pragma unroll
                for (int k = 0; k < TOPK; ++k) lp[k] = __hip_atomic_fetch_add((LAS unsigned*)(lcnt + te[k]), 1u, __ATOMIC_RELAXED, __HIP_MEMORY_SCOPE_WORKGROUP); }
            __syncthreads();
            if (tid < 32) { const unsigned n = lcnt[tid]; lcnt[32 + tid] = n ? atomicAdd(&ctl[CW_CNT + tid], n) : 0u; }
            __syncthreads();
            if (act && hh == 0) { RSTD2[t] = rs;
                unsigned tm[4];
#pragma unroll
                for (int k = 0; k < TOPK; ++k) { const unsigned pos = lcnt[32 + te[k]] + lp[k]; LIST[(size_t)te[k] * T + pos] = (unsigned)t; tm[k] = ((unsigned)te[k] << 16) | pos; }
                *(u32x4*)(TOKMAP + (size_t)t * 4) = (u32x4){tm[0], tm[1], tm[2], tm[3]};
                *(f32x4*)(GATEV + (size_t)t * 4) = (f32x4){gk[0], gk[1], gk[2], gk[3]}; }
            __syncthreads();
        }
        if (ENDBAR(PH_ROUTER)) GRID_BAR();
    }

    volatile LAS int* tab = (volatile LAS int*)(LCTL + 16);
    int Rtot = 0;
    if (IN(PH_G1) || IN(PH_G2) || IN(PH_COMBINE)) {
        if (tid < NEXP) tab[MOE_CNT + tid] = (int)__hip_atomic_load(&ctl[CW_CNT + tid], __ATOMIC_RELAXED, __HIP_MEMORY_SCOPE_AGENT);
        __syncthreads();
        if (tid == 0) { int ts = 0, st = 0;
            for (int e = 0; e < NEXP; ++e) { const int c = tab[MOE_CNT + e]; tab[MOE_TS + e] = ts; tab[MOE_ST + e] = st; ts += (c + 255) >> 8; st += c; }
            tab[MOE_TS + NEXP] = ts; tab[MOE_ST + NEXP] = st; }
        __syncthreads();
        Rtot = tab[MOE_TS + NEXP];
    }
    if (IN(PH_G1) || IN(PH_G2)) {
        __syncthreads();
        for (int rt = tid; rt < Rtot; rt += NWAVES * 64) { int e = 0;
            for (int j = 1; j < NEXP; ++j) if (rt >= tab[MOE_TS + j]) e = j;
            ((volatile LAS unsigned char*)(tab + MOE_RTE))[rt] = (unsigned char)e; }
        __syncthreads();
        if (IN(PH_G1)) for (int rep_ = 0; rep_ < NREP(PH_G1); ++rep_) { ProbMoe1 P{H2F, W1F, B1P, RSTD2, LIST, HID, tab, (LAS unsigned*)(lds + LDSCTL_OFF + 2048), 0, Rtot, G, bx};
            pg8::gemm_phase<ProbMoe1, true>(lds, P, wave);
            if (IN(PH_G2) || NREP(PH_G1) > 1) GRID_BAR(); }
        if (IN(PH_G2)) for (int rep_ = 0; rep_ < NREP(PH_G2); ++rep_) { ProbMoe2 P{HID, W2F, args.in[26], YB, tab, (LAS unsigned*)(lds + LDSCTL_OFF + 2048), 0, Rtot, G, bx};
            pg8::gemm_phase<ProbMoe2, true>(lds, P, wave);
            if (IN(PH_COMBINE) || NREP(PH_G2) > 1) GRID_BAR(); }
    }
    if (IN(PH_COMBINE)) {
        const float* gf = args.in[27];
        const int gw = bx * NWAVES + wave, NGW = G * NWAVES;
        f32x4 gfv[4];
#pragma unroll
        for (int jj = 0; jj < 4; ++jj) gfv[jj] = *((const f32x4*)gf + 4 * lane + jj);
        u32x4 tmn = (u32x4){0u, 0u, 0u, 0u}; f32x4 gkn = (f32x4){0.f, 0.f, 0.f, 0.f};
        if (gw < T) { tmn = *(const u32x4*)(TOKMAP + (size_t)gw * 4); gkn = *(const f32x4*)(GATEV + (size_t)gw * 4); }
        for (int t = gw; t < T; t += NGW) {
            const u32x4 tm = tmn; const f32x4 gk = gkn;
            if (t + NGW < T) { tmn = *(const u32x4*)(TOKMAP + (size_t)(t + NGW) * 4); gkn = *(const f32x4*)(GATEV + (size_t)(t + NGW) * 4); }
            const u32x4* hb = (const u32x4*)(CAT + (size_t)t * DM) + 2 * lane;
            const u32x4 h0 = hb[0], h1 = hb[1];
            u32x4 yv[4];
#pragma unroll
            for (int k = 0; k < TOPK; ++k) { const int e = (int)(tm[k] >> 16), pos = (int)(tm[k] & 0xffffu); const size_t yrow = (size_t)(tab[MOE_ST + e] + pos);
                yv[k] = *((const u32x4*)(YB + yrow * DM) + lane); }
            float v[16];
            v[0] = lo_bf(h0.x); v[1] = hi_bf(h0.x); v[2] = lo_bf(h0.y); v[3] = hi_bf(h0.y); v[4] = lo_bf(h0.z); v[5] = hi_bf(h0.z); v[6] = lo_bf(h0.w); v[7] = hi_bf(h0.w);
            v[8] = lo_bf(h1.x); v[9] = hi_bf(h1.x); v[10] = lo_bf(h1.y); v[11] = hi_bf(h1.y); v[12] = lo_bf(h1.z); v[13] = hi_bf(h1.z); v[14] = lo_bf(h1.w); v[15] = hi_bf(h1.w);
#pragma unroll
            for (int k = 0; k < TOPK; ++k) { const float g16 = gk[k] * (1.0f / 16.0f);
#pragma unroll
                for (int q = 0; q < 4; ++q) { const f32x2 a = __builtin_amdgcn_cvt_pk_f32_fp8((int)yv[k][q], false), b2_ = __builtin_amdgcn_cvt_pk_f32_fp8((int)yv[k][q], true);
                    v[4 * q] += g16 * a[0]; v[4 * q + 1] += g16 * a[1]; v[4 * q + 2] += g16 * b2_[0]; v[4 * q + 3] += g16 * b2_[1]; } }
            float ss = 0.f;
#pragma unroll
            for (int q = 0; q < 16; ++q) ss += v[q] * v[q];
            ss = wave_sum(ss); const float rs = rsqrtf(ss * (1.0f / DM) + EPS);
            f32x4* orow = (f32x4*)(args.out + (size_t)t * DM) + 4 * lane;
#pragma unroll
            for (int jj = 0; jj < 4; ++jj) orow[jj] = (f32x4){v[4 * jj] * rs * gfv[jj][0], v[4 * jj + 1] * rs * gfv[jj][1], v[4 * jj + 2] * rs * gfv[jj][2], v[4 * jj + 3] * rs * gfv[jj][3]};
        }
    }
#undef IN
#undef BOTH
#undef GRID_BAR
#undef lane
#undef tid
}

extern "C" void kernel_launch(void* const* d_in, const int* in_sizes, int n_in, void* d_out, int out_size, void* d_ws, size_t ws_size, hipStream_t stream) {
    static int grid = 0;
    if (grid == 0) {
        if (n_in != 28 || out_size != T * DM || ws_size < WS_END) { fprintf(stderr, "kernel_launch: unexpected shapes: n_in %d out %d ws %zu\n", n_in, out_size, ws_size); grid = -1; return; }
        int dev = 0, cus = 0;
        if (hipGetDevice(&dev) != hipSuccess || hipDeviceGetAttribute(&cus, hipDeviceAttributeMultiprocessorCount, dev) != hipSuccess) { grid = -1; return; }
        if (hipFuncSetAttribute((const void*)fwd, hipFuncAttributeMaxDynamicSharedMemorySize, LDS_BYTES) != hipSuccess) { fprintf(stderr, "kernel_launch: hipFuncSetAttribute failed\n"); grid = -1; return; }
        int per_cu = 0;
        if (hipOccupancyMaxActiveBlocksPerMultiprocessor(&per_cu, (const void*)fwd, NWAVES * 64, LDS_BYTES) != hipSuccess || per_cu < 1) fprintf(stderr, "kernel_launch: occupancy query says %d\n", per_cu);
        (void)hipGetLastError();
        grid = cus;
    }
    if (grid < 0) return;
    (void)hipMemsetAsync((char*)d_ws + WS_CTL, 0, CTL_ZERO_BYTES, stream);
    Args a{};
    for (int i = 0; i < 28; ++i) a.in[i] = (const float*)d_in[i];
    a.out = (float*)d_out; a.ws = (unsigned char*)d_ws;
    unsigned char* ws = (unsigned char*)d_ws;
    auto run = [&](int lo, int hi, int p0, int p1) { a.ph_lo = lo; a.ph_hi = hi; a.pass_lo = p0; a.pass_hi = p1; hipLaunchKernelGGL(fwd, dim3(grid), dim3(NWAVES * 64), LDS_BYTES, stream, a); };
#ifdef MULTI_LAUNCH
    for (int ph = 0; ph < PH_G1; ++ph) run(ph, ph + 1, 0, 0);
    run(PH_G1, PH_G1 + 1, 0, 1); run(PH_G2, PH_G2 + 1, 0, 1);
    run(PH_COMBINE, PH_COMBINE + 1, 0, 0);
#else
    run(0, PH_END, 0, 5);
#endif
}
```

```cpp
#include <hip/hip_runtime.h>
#include <cstdio>
#include <cstdint>
#include <cmath>

#define GAS __attribute__((address_space(1)))
#define LAS __attribute__((address_space(3)))
typedef unsigned short bf16_t;
typedef short bf16x8 __attribute__((ext_vector_type(8)));
typedef float f32x4 __attribute__((ext_vector_type(4)));
typedef float f32x2 __attribute__((ext_vector_type(2)));
typedef unsigned u32x4 __attribute__((ext_vector_type(4)));
typedef unsigned u32x2 __attribute__((ext_vector_type(2)));
typedef int i32x8 __attribute__((ext_vector_type(8)));
typedef int i32x4 __attribute__((ext_vector_type(4)));

constexpr int BATCH = 32, SEQ = 2048, DM = 1024, T = BATCH * SEQ, MEMLEN = 256, MROWS = BATCH * MEMLEN;
constexpr int NPROJ = 3072, DIN = 3080, NP2 = 2048;
constexpr int NEXP = 32, TOPK = 4;
constexpr float EPS = 1e-5f;
constexpr float LAMBDA_INIT = 0.2f;

constexpr size_t MiB = 1u << 20;
constexpr size_t WS_CTL = 0, CTL_ZERO_BYTES = 64 * 1024;
constexpr size_t WS_RSTDX = 1 * MiB;
constexpr size_t WS_RSTDM = WS_RSTDX + (size_t)T * 4;
constexpr size_t WS_B1P = WS_RSTDM + (size_t)MROWS * 4;
constexpr size_t WS_MISC = WS_B1P + (size_t)NEXP * 2048 * 4;
constexpr size_t WS_RSTD2 = WS_MISC + 4096;
static_assert(WS_RSTD2 + (size_t)T * 4 <= 2 * MiB, "small region");
constexpr size_t WS_SSP1 = 2 * MiB;
constexpr size_t WS_SSP2 = 6 * MiB;
constexpr size_t WS_GATES = 10 * MiB;
constexpr size_t WS_TOKMAP = 12 * MiB;
constexpr size_t WS_GATEV = 13 * MiB;
constexpr size_t WS_LIST = 14 * MiB;
constexpr size_t WS_WIN = 24 * MiB;
constexpr size_t WS_WOUT = 30 * MiB;
constexpr size_t WS_WCQ = 32 * MiB;
constexpr size_t WS_WCKV = 34 * MiB;
constexpr size_t WS_WCO = 38 * MiB;
constexpr size_t WS_WR = 40 * MiB;
constexpr size_t WS_W1 = 64 * MiB;
constexpr size_t WS_H2F = 128 * MiB;
constexpr size_t WS_W2 = 192 * MiB;
constexpr size_t WS_XB = 256 * MiB;
constexpr size_t WS_PROJ = 384 * MiB;
constexpr size_t WS_H1F = 640 * MiB;
constexpr size_t WS_VT1 = 640 * MiB;
constexpr size_t WS_CAT = 768 * MiB;
constexpr size_t WS_MST = 896 * MiB;
constexpr size_t WS_MEMB = 962 * MiB;
constexpr size_t WS_KV = 978 * MiB;
constexpr size_t WS_VT2 = 994 * MiB;
constexpr size_t WS_QM = 128 * MiB;
constexpr size_t WS_KM = 160 * MiB;
constexpr size_t WS_CSTB = 224 * MiB;
constexpr size_t WS_BC = 1010 * MiB;
constexpr size_t WS_AV = 1011 * MiB;
constexpr size_t WS_AM = 1012 * MiB;
constexpr size_t WS_NLOC = 1013 * MiB;
constexpr size_t WS_NST = WS_NLOC + 512 * 1024;
constexpr size_t WS_CH = 1014 * MiB;
constexpr size_t WS_MSTATE = WS_CH + 64 * 1024;
constexpr size_t WS_Y = 256 * MiB;
constexpr size_t WS_HID = 512 * MiB;
constexpr size_t WS_HID1 = 896 * MiB;
constexpr size_t WS_END = 1024 * MiB;

constexpr int CW_CNT = 64;
constexpr int CW_BAR = 4096;
static_assert((CW_BAR + 3456) * 4 <= (int)CTL_ZERO_BYTES, "control words inside the per-call memset");

__device__ __forceinline__ float bf2f(bf16_t b) { return __uint_as_float(((unsigned)b) << 16); }
__device__ __forceinline__ unsigned f2bf(float f) { unsigned u = __float_as_uint(f); return (u + 0x7fffu + ((u >> 16) & 1u)) >> 16; }
__device__ __forceinline__ unsigned cvt_pk_bf16(float lo, float hi) { unsigned r; asm volatile("v_cvt_pk_bf16_f32 %0, %1, %2" : "=v"(r) : "v"(lo), "v"(hi)); return r; }
__device__ __forceinline__ float x32_sum(float v) { auto r = __builtin_amdgcn_permlane32_swap(__float_as_uint(v), __float_as_uint(v), false, false); return __uint_as_float(r[0]) + __uint_as_float(r[1]); }
__device__ __forceinline__ float x32_max(float v) { auto r = __builtin_amdgcn_permlane32_swap(__float_as_uint(v), __float_as_uint(v), false, false); return fmaxf(__uint_as_float(r[0]), __uint_as_float(r[1])); }
__device__ __forceinline__ float x32_other(float v, int hh) { auto r = __builtin_amdgcn_permlane32_swap(__float_as_uint(v), __float_as_uint(v), false, false); return hh ? __uint_as_float(r[0]) : __uint_as_float(r[1]); }
__device__ __forceinline__ float x16_sum(float v) { auto r = __builtin_amdgcn_permlane16_swap(__float_as_uint(v), __float_as_uint(v), false, false); return __uint_as_float(r[0]) + __uint_as_float(r[1]); }
__device__ __forceinline__ float row16_sum(float v) {
    v += __uint_as_float((unsigned)__builtin_amdgcn_update_dpp(0, (int)__float_as_uint(v), 0xB1, 0xf, 0xf, true));
    v += __uint_as_float((unsigned)__builtin_amdgcn_update_dpp(0, (int)__float_as_uint(v), 0x4E, 0xf, 0xf, true));
    v += __uint_as_float((unsigned)__builtin_amdgcn_update_dpp(0, (int)__float_as_uint(v), 0x141, 0xf, 0xf, true));
    v += __uint_as_float((unsigned)__builtin_amdgcn_update_dpp(0, (int)__float_as_uint(v), 0x140, 0xf, 0xf, true));
    return v; }
__device__ __forceinline__ float wave_sum(float v) { return x32_sum(x16_sum(row16_sum(v))); }
__device__ __forceinline__ int lane_id() { int l; asm volatile("v_mbcnt_lo_u32_b32 %0, -1, 0\n\tv_mbcnt_hi_u32_b32 %0, -1, %0" : "=v"(l)); return l; }
__device__ __forceinline__ float c8(float x) { return __builtin_amdgcn_fmed3f(x, -448.0f, 448.0f); }
__device__ __forceinline__ float lo_bf(unsigned w) { return __uint_as_float(w << 16); }
__device__ __forceinline__ float hi_bf(unsigned w) { return __uint_as_float(w & 0xffff0000u); }

namespace pg8 {
constexpr int BM = 256, BK = 64, HALF = 128, HTB = HALF * BK * 2, STAGE_BYTES = 8 * HTB, NXCD = 8, WGM = 8, KD = 1024, NT = KD / BK;
__host__ __device__ __forceinline__ int lds_byte(int r, int c) { const int st = (r >> 4) * 2 + (c >> 5), rr = r & 15, cc = c & 31, ob = rr * 64 + cc * 2; return st * 1024 + (ob ^ (((ob >> 9) & 1) << 5)); }
__host__ __device__ __forceinline__ void stage_rc(int b, int& R, int& C) { const int st = b / 1024, sb = b % 1024, swz = sb ^ (((sb >> 9) & 1) << 5); R = (st >> 1) * 16 + swz / 64; C = (st & 1) * 32 + (swz % 64) / 2; }
__host__ __device__ __forceinline__ int perm32(int rho) { const int n = rho >> 4, i = rho & 15; return 8 * (i >> 2) + 4 * n + (i & 3); }

struct Unit { const char* A; const char* B; int pm, pn, e, nvalid, y0, aux; };

__device__ __forceinline__ bool static_next(int i, int G, int c, int nM, int nN, int& pm, int& pn) {
    const int nwg = nM * nN; const long L = (long)i * G + c; if (L >= nwg) return false;
    int wgid = (int)L; { const int q = nwg / NXCD, r = nwg % NXCD, xcd = wgid % NXCD, off = wgid / NXCD; wgid = (xcd < r ? xcd * (q + 1) : r * (q + 1) + (xcd - r) * q) + off; }
    const int nig = WGM * nN, gid = wgid / nig, fm = gid * WGM, gsz = (nM - fm) < WGM ? (nM - fm) : WGM;
    pm = fm + ((wgid % nig) % gsz); pn = (wgid % nig) / gsz; return true;
}

template <class P, bool ALIGN_EPI>
__device__ __forceinline__ void gemm_phase(LAS unsigned char* lds, const P& prob, const int wid) {
    const int lane = lane_id(), tid = wid * 64 + lane, wr = wid >> 2, wc = wid & 3, fr = lane & 15, fq = lane >> 4;
    constexpr int ROWB = P::FP8 ? KD : 2 * KD;
    constexpr int nt = ROWB / 128;
    int RA[2], CA[2]; unsigned voffA[2], voffB[2];
#pragma unroll
    for (int i = 0; i < 2; ++i) { int R, C; stage_rc(tid * 16 + i * 8192, R, C); const int Rb = P::PERM ? ((R & ~31) + perm32(R & 31)) : R;
        RA[i] = R; CA[i] = C * 2; voffA[i] = (unsigned)(R * ROWB + C * 2); voffB[i] = (unsigned)(Rb * ROWB + C * 2); }
    constexpr int kstep = BK * 2;
    constexpr size_t hstep = (size_t)HALF * ROWB;
    const unsigned ldsw = (unsigned)wid * 1024u;
    const int aoff = lds_byte(wr * 64 + fr, fq * 8), boff = lds_byte(wc * 32 + fr, fq * 8);
#define PG8_SA(b, h) (((b) * 2 + (h)) * HTB)
#define PG8_SB(b, h) ((4 + (b) * 2 + (h)) * HTB)
#define PG8_STAGE_B(bufoff, gbase) do { _Pragma("unroll") for (int _i = 0; _i < 2; ++_i) \
        __builtin_amdgcn_global_load_lds((const unsigned*)((const char*)(gbase) + voffB[_i]), (LAS unsigned*)(lds + (bufoff) + ldsw + _i * 8192), 16, 0, 0); } while (0)
#define PG8_STAGE_A(bufoff, gbase, off, h) do { _Pragma("unroll") for (int _i = 0; _i < 2; ++_i) { const char* _p; \
        if constexpr (P::GATHER) _p = (const char*)(gbase) + (off)[h][_i]; else _p = (const char*)(gbase) + (size_t)(h) * hstep + voffA[_i]; \
        __builtin_amdgcn_global_load_lds((const unsigned*)_p, (LAS unsigned*)(lds + (bufoff) + ldsw + _i * 8192), 16, 0, 0); } } while (0)
#define PG8_LDA(dst, b, h) do { _Pragma("unroll") for (int m = 0; m < 4; ++m) _Pragma("unroll") for (int k = 0; k < 2; ++k) dst[m][k] = *(const LAS bf16x8*)(lds + PG8_SA(b, h) + aoff + m * 2048 + k * 1024); } while (0)
#define PG8_LDB(dst, b, h) do { _Pragma("unroll") for (int n = 0; n < 2; ++n) _Pragma("unroll") for (int k = 0; k < 2; ++k) dst[n][k] = *(const LAS bf16x8*)(lds + PG8_SB(b, h) + boff + n * 2048 + k * 1024); } while (0)
#define PG8_MMA(ai, bj, At, Bt) do { __builtin_amdgcn_s_setprio(1); _Pragma("unroll") for (int m = 0; m < 4; ++m) _Pragma("unroll") for (int n = 0; n < 2; ++n) { \
        if constexpr (P::FP8) { const i32x4 b0_ = __builtin_bit_cast(i32x4, Bt[n][0]), b1_ = __builtin_bit_cast(i32x4, Bt[n][1]), a0_ = __builtin_bit_cast(i32x4, At[m][0]), a1_ = __builtin_bit_cast(i32x4, At[m][1]); \
            acc[ai][bj][m][n] = __builtin_amdgcn_mfma_scale_f32_16x16x128_f8f6f4((i32x8){b0_[0], b0_[1], b0_[2], b0_[3], b1_[0], b1_[1], b1_[2], b1_[3]}, (i32x8){a0_[0], a0_[1], a0_[2], a0_[3], a1_[0], a1_[1], a1_[2], a1_[3]}, \
                acc[ai][bj][m][n], 0, 0, 0, 0x7f7f7f7f, 0, 0x7f7f7f7f); } \
        else { _Pragma("unroll") for (int k = 0; k < 2; ++k) acc[ai][bj][m][n] = __builtin_amdgcn_mfma_f32_16x16x32_bf16(Bt[n][k], At[m][k], acc[ai][bj][m][n], 0, 0, 0); } } \
        __builtin_amdgcn_s_setprio(0); } while (0)
#define PG8_WAIT_V(n) asm volatile("s_waitcnt vmcnt(" #n ")" ::: "memory")
#define PG8_WAIT_L(n) asm volatile("s_waitcnt lgkmcnt(" #n ")" ::: "memory")
#define PG8_BAR __builtin_amdgcn_s_barrier()
#define PG8_SCHED __builtin_amdgcn_sched_barrier(0)
    Unit cur, nxt; int ui = 0;
    if (!prob.next(0, cur)) return;
    f32x4 acc[2][2][4][2];
#pragma unroll
    for (int a = 0; a < 2; ++a)
#pragma unroll
        for (int b = 0; b < 2; ++b)
#pragma unroll
            for (int m = 0; m < 4; ++m)
#pragma unroll
                for (int n = 0; n < 2; ++n) acc[a][b][m][n] = (f32x4){0.f, 0.f, 0.f, 0.f};
    bf16x8 At[4][2], B0[2][2], B1[2][2];
    unsigned offC[2][2] = {{0u, 0u}, {0u, 0u}};
#define PG8_FILL(u, buf) do { if (tid < 256) prob.gtab[(buf) * 256 + tid] = prob.a_off(u, tid); } while (0)
#define PG8_OFFS(buf) do { _Pragma("unroll") for (int _h = 0; _h < 2; ++_h) _Pragma("unroll") for (int _i = 0; _i < 2; ++_i) offC[_h][_i] = prob.gtab[(buf) * 256 + _h * HALF + RA[_i]] + (unsigned)CA[_i]; } while (0)
    Unit nx2;
    bool has_next = prob.next(1, nxt);
    if constexpr (P::GATHER) { PG8_FILL(cur, 0); if (has_next) PG8_FILL(nxt, 1); PG8_WAIT_L(0); PG8_BAR; PG8_OFFS(0); }
    const char* cA = prob.a_tile(cur); const char* cB = cur.B;
    PG8_STAGE_B(PG8_SB(0, 0), cB); PG8_STAGE_B(PG8_SB(0, 1), cB + hstep); PG8_STAGE_A(PG8_SA(0, 0), cA, offC, 0); PG8_STAGE_A(PG8_SA(0, 1), cA, offC, 1);
    if (wr == 1) PG8_BAR;
    PG8_WAIT_V(2); PG8_BAR;
    PG8_STAGE_B(PG8_SB(1, 0), cB + kstep); PG8_STAGE_A(PG8_SA(1, 0), cA + kstep, offC, 0); PG8_STAGE_B(PG8_SB(1, 1), cB + hstep + kstep);
    PG8_WAIT_V(6); PG8_BAR;
    int bcur = 0;
    for (;;) {
        const bool has_nx2 = has_next && prob.next(ui + 2, nx2);
        const char* nA = has_next ? prob.a_tile(nxt) : cA; const char* nB = has_next ? nxt.B : cB;
        const int bnext = bcur == 2 ? 0 : bcur + 1, bnx2 = bnext == 2 ? 0 : bnext + 1;
#pragma unroll 1
        for (int t = 0; t < nt; t += 2) {
            const bool last = (t == nt - 2);
            const char* a1 = cA + (size_t)(t + 1) * kstep;
            const char* a2 = last ? nA : cA + (size_t)(t + 2) * kstep; const char* b2 = last ? nB : cB + (size_t)(t + 2) * kstep;
            const char* a3 = a2 + kstep; const char* b3 = b2 + kstep;
            PG8_LDB(B0, 0, 0); PG8_LDB(B1, 0, 1); PG8_SCHED; PG8_LDA(At, 0, 0); PG8_STAGE_A(PG8_SA(1, 1), a1, offC, 1);
            if constexpr (P::GATHER) { if (last && has_next) PG8_OFFS(bnext); }
            PG8_WAIT_V(8); PG8_WAIT_L(0); PG8_BAR; PG8_MMA(0, 0, At, B0); PG8_MMA(0, 1, At, B1); PG8_BAR; PG8_SCHED;
            PG8_LDA(At, 0, 1); PG8_STAGE_B(PG8_SB(0, 0), b2); PG8_STAGE_B(PG8_SB(0, 1), b2 + hstep); PG8_STAGE_A(PG8_SA(0, 0), a2, offC, 0);
            PG8_WAIT_V(8); PG8_WAIT_L(0); PG8_BAR; PG8_MMA(1, 0, At, B0); PG8_MMA(1, 1, At, B1); PG8_BAR; PG8_SCHED;
            PG8_LDB(B0, 1, 0); PG8_LDB(B1, 1, 1); PG8_SCHED; PG8_LDA(At, 1, 0); PG8_STAGE_A(PG8_SA(0, 1), a2, offC, 1);
            PG8_WAIT_V(8); PG8_WAIT_L(0); PG8_BAR; PG8_MMA(0, 0, At, B0); PG8_MMA(0, 1, At, B1); PG8_BAR; PG8_SCHED;
            PG8_LDA(At, 1, 1); PG8_STAGE_B(PG8_SB(1, 0), b3); PG8_STAGE_B(PG8_SB(1, 1), b3 + hstep); PG8_STAGE_A(PG8_SA(1, 0), a3, offC, 0);
            PG8_WAIT_V(8); PG8_WAIT_L(0); PG8_BAR; PG8_MMA(1, 0, At, B0); PG8_MMA(1, 1, At, B1); PG8_BAR; PG8_SCHED;
        }
        if constexpr (ALIGN_EPI) { if (wr == 0) PG8_BAR; }
        if constexpr (P::GATHER) { if (has_nx2) PG8_FILL(nx2, bnx2); }
        cur.aux = bcur;
        prob.epi(acc, cur, wr, wc, fr, fq);
        if (!has_next) break;
#pragma unroll
        for (int a = 0; a < 2; ++a)
#pragma unroll
            for (int b = 0; b < 2; ++b)
#pragma unroll
                for (int m = 0; m < 4; ++m)
#pragma unroll
                    for (int n = 0; n < 2; ++n) acc[a][b][m][n] = (f32x4){0.f, 0.f, 0.f, 0.f};
        cur = nxt; nxt = nx2; has_next = has_nx2; cA = nA; cB = nB; ++ui; bcur = bnext;
        if constexpr (ALIGN_EPI) { if (wr == 1) PG8_BAR; }
    }
    PG8_WAIT_V(0);
    if constexpr (!ALIGN_EPI) { if (wr == 0) PG8_BAR; }
    PG8_BAR;
#undef PG8_SA
#undef PG8_SB
#undef PG8_STAGE_A
#undef PG8_STAGE_B
#undef PG8_LDA
#undef PG8_LDB
#undef PG8_MMA
#undef PG8_WAIT_V
#undef PG8_WAIT_L
#undef PG8_BAR
#undef PG8_SCHED
#undef PG8_OFFS
#undef PG8_FILL
}
}

template <bool F8> struct ProbScaleT {
    static constexpr bool FP8 = F8, PERM = true, GATHER = F8;
    static constexpr int RB = F8 ? 1024 : 2048;
    __device__ __forceinline__ const char* a_tile(const pg8::Unit& u) const { return F8 ? u.A : u.A + (size_t)u.pm * (256 * RB); }
    LAS unsigned* gtab;
    const void* A; const void* Bt; int nM, nN, G, c;
    bf16_t* O; int ldo; const float* rstd; const float* ssp;
    __device__ __forceinline__ bool next(int i, pg8::Unit& u) const {
        int pm, pn; if (!pg8::static_next(i, G, c, nM, nN, pm, pn)) return false;
        u.A = (const char*)A; u.B = (const char*)Bt + (size_t)pn * 256 * RB; u.pm = pm; u.pn = pn; u.e = 0; u.nvalid = 256; u.y0 = 0; u.aux = 0; return true; }
    __device__ __forceinline__ unsigned a_off(const pg8::Unit& u, int r) const { return (unsigned)(u.pm * 256 + r) * (unsigned)RB; }
    __device__ __forceinline__ void epi(const f32x4 (&acc)[2][2][4][2], const pg8::Unit& u, int wr, int wc, int fr, int fq) const {
        asm volatile("" : "+v"(fr), "+v"(fq));
        const int rowu = u.pm * 256 + wr * 64;
        char* ub = (char*)O + ((size_t)rowu * ldo + u.pn * 256 + wc * 32) * 2;
        const unsigned lo = (unsigned)(fr * ldo + 8 * fq) * 2u;
        float rsv[8];
        if (rstd) {
#pragma unroll
            for (int q = 0; q < 8; ++q) rsv[q] = rstd[rowu + fr + (q >> 2) * 128 + (q & 3) * 16];
        } else { f32x4 pv[8];
#pragma unroll
            for (int q = 0; q < 8; ++q) pv[q] = *(const f32x4*)(ssp + (size_t)(rowu + fr + (q >> 2) * 128 + (q & 3) * 16) * 16 + fq * 4);
#pragma unroll
            for (int q = 0; q < 8; ++q) { float sq = (pv[q][0] + pv[q][1]) + (pv[q][2] + pv[q][3]); sq = x16_sum(sq); sq = x32_sum(sq); rsv[q] = rsqrtf(sq * (1.0f / 1024.0f) + EPS); } }
#pragma unroll
        for (int ai = 0; ai < 2; ++ai)
#pragma unroll
            for (int m = 0; m < 4; ++m) { const float rs = rsv[ai * 4 + m] * (F8 ? (1.0f / 64.0f) : 1.0f);
                char* rowp = ub + (size_t)(ai * 128 + m * 16) * ldo * 2 + lo;
#pragma unroll
                for (int bj = 0; bj < 2; ++bj) { const f32x4 v0 = acc[ai][bj][m][0] * rs, v1 = acc[ai][bj][m][1] * rs;
                    u32x4 w; w.x = cvt_pk_bf16(v0[0], v0[1]); w.y = cvt_pk_bf16(v0[2], v0[3]); w.z = cvt_pk_bf16(v1[0], v1[1]); w.w = cvt_pk_bf16(v1[2], v1[3]);
                    *(u32x4*)(rowp + bj * 256) = w; } }
    }
};
typedef ProbScaleT<false> ProbScaleBf16;
struct ProbColScaleBf16 {
    static constexpr bool FP8 = false, PERM = true, GATHER = false;
    __device__ __forceinline__ const char* a_tile(const pg8::Unit& u) const { return u.A + (size_t)u.pm * (256 * 2048); }
    const bf16_t* A; const bf16_t* Bt; int nM, nN, G, c;
    bf16_t* O; int ldo; const float* cs;
    __device__ __forceinline__ bool next(int i, pg8::Unit& u) const {
        const long L = (long)i * G + c; if (L >= (long)nM * nN) return false;
        const int pm = (int)(L % nM), pn = (int)(L / nM);
        u.A = (const char*)A; u.B = (const char*)(Bt + (size_t)pn * 256 * 1024); u.pm = pm; u.pn = pn; u.e = 0; u.nvalid = 256; u.y0 = 0; u.aux = 0; return true; }
    __device__ __forceinline__ unsigned a_off(const pg8::Unit& u, int r) const { return 0u; }
    __device__ __forceinline__ void epi(const f32x4 (&acc)[2][2][4][2], const pg8::Unit& u, int wr, int wc, int fr, int fq) const {
        asm volatile("" : "+v"(fr), "+v"(fq));
        const float* cp = cs + u.pn * 256 + wc * 32 + 8 * fq;
        f32x4 sc[2][2];
#pragma unroll
        for (int bj = 0; bj < 2; ++bj)
#pragma unroll
            for (int n = 0; n < 2; ++n) sc[bj][n] = *(const f32x4*)(cp + bj * 128 + 4 * n);
        char* ub = (char*)O + ((size_t)(u.pm * 256 + wr * 64) * ldo + u.pn * 256 + wc * 32) * 2;
        const unsigned lo = (unsigned)(fr * ldo + 8 * fq) * 2u;
#pragma unroll
        for (int ai = 0; ai < 2; ++ai)
#pragma unroll
            for (int m = 0; m < 4; ++m) { char* rowp = ub + (size_t)(ai * 128 + m * 16) * ldo * 2 + lo;
#pragma unroll
                for (int bj = 0; bj < 2; ++bj) { const f32x4 v0 = acc[ai][bj][m][0] * sc[bj][0], v1 = acc[ai][bj][m][1] * sc[bj][1];
                    u32x4 w; w.x = cvt_pk_bf16(v0[0], v0[1]); w.y = cvt_pk_bf16(v0[2], v0[3]); w.z = cvt_pk_bf16(v1[0], v1[1]); w.w = cvt_pk_bf16(v1[2], v1[3]);
                    *(u32x4*)(rowp + bj * 256) = w; } }
    }
};
struct ProbKV {
    static constexpr bool FP8 = true, PERM = true, GATHER = true;
    __device__ __forceinline__ const char* a_tile(const pg8::Unit& u) const { return u.A; }
    LAS unsigned* gtab;
    const unsigned char* memb; const unsigned char* wckv; bf16_t* Kout; bf16_t* VTout; const float* rstdm; int G, c;
    __device__ __forceinline__ bool next(int i, pg8::Unit& u) const {
        const long L = (long)i * G + c; if (L >= 256) return false;
        if (L < 128) { u.pm = (int)(L & 31); u.pn = (int)(L >> 5); u.e = 0; u.A = (const char*)memb; u.B = (const char*)(wckv + (size_t)u.pn * 256 * 1024); }
        else { const int l2 = (int)L - 128; u.pm = l2 & 3; u.pn = l2 >> 2; u.e = 1; u.A = (const char*)(wckv + (size_t)1024 * 1024); u.B = (const char*)(memb + (size_t)u.pn * 256 * 1024); }
        u.nvalid = 256; u.y0 = 0; u.aux = 0; return true; }
    __device__ __forceinline__ unsigned a_off(const pg8::Unit& u, int r) const { return (unsigned)(u.pm * 256 + r) * 1024u; }
    __device__ __forceinline__ void epi(const f32x4 (&acc)[2][2][4][2], const pg8::Unit& u, int wr, int wc, int fr, int fq) const {
        asm volatile("" : "+v"(fr), "+v"(fq));
        const int ldo = u.e ? MROWS : 1024;
        char* ub = (char*)(u.e ? VTout : Kout) + ((size_t)(u.pm * 256 + wr * 64) * ldo + u.pn * 256 + wc * 32) * 2;
        const unsigned lo = (unsigned)(fr * ldo + 8 * fq) * 2u;
        float rsv[8]; f32x4 sc[2][2];
        if (u.e == 0) {
#pragma unroll
            for (int q = 0; q < 8; ++q) rsv[q] = rstdm[u.pm * 256 + wr * 64 + fr + (q >> 2) * 128 + (q & 3) * 16] * (1.0f / 64.0f);
#pragma unroll
            for (int bj = 0; bj < 2; ++bj)
#pragma unroll
                for (int n = 0; n < 2; ++n) sc[bj][n] = (f32x4){1.f, 1.f, 1.f, 1.f};
        } else {
#pragma unroll
            for (int q = 0; q < 8; ++q) rsv[q] = 1.0f / 64.0f;
            const float* cp = rstdm + u.pn * 256 + wc * 32 + 8 * fq;
#pragma unroll
            for (int bj = 0; bj < 2; ++bj)
#pragma unroll
                for (int n = 0; n < 2; ++n) sc[bj][n] = *(const f32x4*)(cp + bj * 128 + 4 * n); }
#pragma unroll
        for (int ai = 0; ai < 2; ++ai)
#pragma unroll
            for (int m = 0; m < 4; ++m) { const float rs = rsv[ai * 4 + m]; char* rowp = ub + (size_t)(ai * 128 + m * 16) * ldo * 2 + lo;
#pragma unroll
                for (int bj = 0; bj < 2; ++bj) { const f32x4 v0 = acc[ai][bj][m][0] * sc[bj][0] * rs, v1 = acc[ai][bj][m][1] * sc[bj][1] * rs;
                    u32x4 w; w.x = cvt_pk_bf16(v0[0], v0[1]); w.y = cvt_pk_bf16(v0[2], v0[3]); w.z = cvt_pk_bf16(v1[0], v1[1]); w.w = cvt_pk_bf16(v1[2], v1[3]);
                    *(u32x4*)(rowp + bj * 256) = w; } }
    }
};
template <bool F8, bool WF8, bool RF32> struct ProbResidT {
    static constexpr bool FP8 = F8, PERM = true, GATHER = F8;
    static constexpr int RB = F8 ? 1024 : 2048;
    __device__ __forceinline__ const char* a_tile(const pg8::Unit& u) const { return F8 ? u.A : u.A + (size_t)u.pm * (256 * RB); }
    LAS unsigned* gtab;
    const void* A; const void* Bt; int nM, nN, G, c;
    const float* rf; const bf16_t* rb; bf16_t* ob; unsigned char* of8; float* ssp;
    __device__ __forceinline__ bool next(int i, pg8::Unit& u) const {
        int pm, pn; if (!pg8::static_next(i, G, c, nM, nN, pm, pn)) return false;
        u.A = (const char*)A; u.B = (const char*)Bt + (size_t)pn * 256 * RB; u.pm = pm; u.pn = pn; u.e = 0; u.nvalid = 256; u.y0 = 0; u.aux = 0; return true; }
    __device__ __forceinline__ unsigned a_off(const pg8::Unit& u, int r) const { return (unsigned)(u.pm * 256 + r) * (unsigned)RB; }
    __device__ __forceinline__ void epi(const f32x4 (&acc)[2][2][4][2], const pg8::Unit& u, int wr, int wc, int fr, int fq) const {
        asm volatile("" : "+v"(fr), "+v"(fq));
        const int rowu = u.pm * 256 + wr * 64;
        const size_t uoff = (size_t)rowu * 1024 + u.pn * 256 + wc * 32;
        const unsigned lo = (unsigned)(fr * 1024 + 8 * fq);
        const float sc = F8 ? (1.0f / 64.0f) : 1.0f;
#pragma unroll
        for (int ai = 0; ai < 2; ++ai) {
            f32x4 rv[4][2][2];
#pragma unroll
            for (int m = 0; m < 4; ++m) { const size_t ro = uoff + (size_t)(ai * 128 + m * 16) * 1024;
#pragma unroll
                for (int bj = 0; bj < 2; ++bj) {
                    if constexpr (RF32) { rv[m][bj][0] = *(const GAS f32x4*)(rf + ro + lo + bj * 128); rv[m][bj][1] = *(const GAS f32x4*)(rf + ro + lo + bj * 128 + 4); }
                    else { const u32x4 w = *(const GAS u32x4*)(rb + ro + lo + bj * 128); rv[m][bj][0] = (f32x4){lo_bf(w.x), hi_bf(w.x), lo_bf(w.y), hi_bf(w.y)}; rv[m][bj][1] = (f32x4){lo_bf(w.z), hi_bf(w.z), lo_bf(w.w), hi_bf(w.w)}; } } }
#pragma unroll
            for (int m = 0; m < 4; ++m) { const size_t ro = uoff + (size_t)(ai * 128 + m * 16) * 1024; float ss = 0.f;
#pragma unroll
                for (int bj = 0; bj < 2; ++bj) { const f32x4 v0 = acc[ai][bj][m][0] * sc + rv[m][bj][0], v1 = acc[ai][bj][m][1] * sc + rv[m][bj][1];
                    ss += (v0[0] * v0[0] + v0[1] * v0[1]) + (v0[2] * v0[2] + v0[3] * v0[3]) + (v1[0] * v1[0] + v1[1] * v1[1]) + (v1[2] * v1[2] + v1[3] * v1[3]);
                    u32x4 w; w.x = cvt_pk_bf16(v0[0], v0[1]); w.y = cvt_pk_bf16(v0[2], v0[3]); w.z = cvt_pk_bf16(v1[0], v1[1]); w.w = cvt_pk_bf16(v1[2], v1[3]);
                    *(u32x4*)(ob + ro + lo + bj * 128) = w;
                    if constexpr (WF8) { unsigned w0 = 0u, w1 = 0u;
                        w0 = __builtin_amdgcn_cvt_pk_fp8_f32(c8(v0[0]), c8(v0[1]), w0, false); w0 = __builtin_amdgcn_cvt_pk_fp8_f32(c8(v0[2]), c8(v0[3]), w0, true);
                        w1 = __builtin_amdgcn_cvt_pk_fp8_f32(c8(v1[0]), c8(v1[1]), w1, false); w1 = __builtin_amdgcn_cvt_pk_fp8_f32(c8(v1[2]), c8(v1[3]), w1, true);
                        *(u32x2*)(of8 + ro + lo + bj * 128) = (u32x2){w0, w1}; } }
                ss = x16_sum(ss); ss = x32_sum(ss);
                if (fq == 0) ssp[(size_t)(rowu + ai * 128 + m * 16 + fr) * 16 + u.pn * 4 + wc] = ss; } }
    }
};
__device__ __forceinline__ size_t hid_tile_off(int rt) { return rt < 1024 ? (size_t)rt * (256 * 1024) : (WS_HID1 - WS_HID) + (size_t)(rt - 1024) * (256 * 1024); }
constexpr int MOE_TS = 0, MOE_ST = 33, MOE_CNT = 66, MOE_RTE = 100, MOE_WORDS = 100 + 264;
struct ProbMoe1 {
    static constexpr bool FP8 = true, PERM = true, GATHER = true;
    __device__ __forceinline__ const char* a_tile(const pg8::Unit& u) const { return u.A; }
    const unsigned char* hb; const unsigned char* w1b; const float* b1p; const float* rstd2; const unsigned* list; unsigned char* hid;
    const volatile LAS int* tab; LAS unsigned* gtab; int rt0, nrt, G, c;
    __device__ __forceinline__ bool next(int i, pg8::Unit& u) const {
        const long L = (long)i * G + c; if (L >= (long)nrt * 8) return false;
        const int gidx = (int)(L >> 8), within = (int)(L & 255), gsz = (nrt - gidx * 32) < 32 ? (nrt - gidx * 32) : 32;
        const int rtl = gidx * 32 + within % gsz, pn = within / gsz, rt = rt0 + rtl;
        const int e = ((const volatile LAS unsigned char*)(tab + MOE_RTE))[rt];
        const int idx0 = (rt - tab[MOE_TS + e]) * 256;
        u.A = (const char*)hb; u.B = (const char*)(w1b + ((size_t)e * 2048 + (size_t)pn * 256) * 1024); u.pm = rt; u.pn = pn; u.e = e; u.nvalid = tab[MOE_CNT + e] - idx0; u.y0 = idx0; u.aux = 0; return true; }
    __device__ __forceinline__ unsigned tok_of(const pg8::Unit& u, int r) const { const int rr = r < u.nvalid ? r : 0; return list[(size_t)u.e * T + u.y0 + rr]; }
    __device__ __forceinline__ unsigned a_off(const pg8::Unit& u, int r) const { return tok_of(u, r) * 1024u; }
    __device__ __forceinline__ void epi(const f32x4 (&acc)[2][2][4][2], const pg8::Unit& u, int wr, int wc, int fr, int fq) const {
        asm volatile("" : "+v"(fr), "+v"(fq));
        const float* bp = b1p + (size_t)u.e * 2048 + u.pn * 256 + wc * 32 + 8 * fq;
        const f32x4 bg0 = *(const f32x4*)(bp), bg1 = *(const f32x4*)(bp + 4), bl0 = *(const f32x4*)(bp + 128), bl1 = *(const f32x4*)(bp + 132);
        char* ub = (char*)hid + hid_tile_off(u.pm) + ((size_t)(wr * 64) * 1024 + u.pn * 128 + wc * 32);
        const unsigned lo = (unsigned)(fr * 1024 + 8 * fq);
        unsigned wk[2][2];
#pragma unroll
        for (int ai = 0; ai < 2; ++ai)
#pragma unroll
            for (int m = 0; m < 4; ++m) { const float rs = 1.0f / 64.0f;
                unsigned w[2];
#pragma unroll
                for (int n = 0; n < 2; ++n) { const f32x4 g4 = acc[ai][0][m][n] * rs + (n ? bg1 : bg0), l4 = acc[ai][1][m][n] * rs + (n ? bl1 : bl0);
                    unsigned wv = 0u;
#pragma unroll
                    for (int jp = 0; jp < 2; ++jp) {
                        f32x2 g2 = {fminf(g4[2 * jp], 7.0f), fminf(g4[2 * jp + 1], 7.0f)};
                        const f32x2 l2 = {__builtin_amdgcn_fmed3f(l4[2 * jp], -7.0f, 7.0f), __builtin_amdgcn_fmed3f(l4[2 * jp + 1], -7.0f, 7.0f)};
                        const f32x2 z2 = g2 * (-1.702f * 1.4426950408889634f);
                        const f32x2 d2 = (f32x2){__builtin_amdgcn_exp2f(z2[0]), __builtin_amdgcn_exp2f(z2[1])} + 1.0f;
                        const f32x2 r2 = {__builtin_amdgcn_rcpf(d2[0]), __builtin_amdgcn_rcpf(d2[1])};
                        const f32x2 o2 = (g2 * r2) * (l2 * 4.0f + 4.0f);
                        if (jp) wv = __builtin_amdgcn_cvt_pk_fp8_f32(o2[0], o2[1], wv, true); else wv = __builtin_amdgcn_cvt_pk_fp8_f32(o2[0], o2[1], wv, false); }
                    w[n] = wv; }
                wk[m & 1][0] = w[0]; wk[m & 1][1] = w[1];
                if (m & 1) {
                    const auto s0 = __builtin_amdgcn_permlane16_swap(wk[0][0], wk[1][0], false, false), s1 = __builtin_amdgcn_permlane16_swap(wk[0][1], wk[1][1], false, false);
                    *(u32x4*)(ub + (size_t)(ai * 128 + (m - 1) * 16) * 1024 + lo + ((fq & 1) ? 16u * 1024u - 8u : 0u)) = (u32x4){s0[0], s1[0], s0[1], s1[1]}; } }
    }
};
struct ProbMoe2 {
    static constexpr bool FP8 = true, PERM = true, GATHER = true;
    __device__ __forceinline__ const char* a_tile(const pg8::Unit& u) const { return u.A; }
    const unsigned char* hid; const unsigned char* w2b; const float* b2; unsigned char* y;
    const volatile LAS int* tab; LAS unsigned* gtab; int rt0, nrt, G, c;
    __device__ __forceinline__ bool next(int i, pg8::Unit& u) const {
        const long L = (long)i * G + c; if (L >= (long)nrt * 4) return false;
        const int gidx = (int)(L >> 8), within = (int)(L & 255), gsz = (nrt - gidx * 64) < 64 ? (nrt - gidx * 64) : 64;
        const int rtl = gidx * 64 + within % gsz, pn = within / gsz, rt = rt0 + rtl;
        const int e = ((const volatile LAS unsigned char*)(tab + MOE_RTE))[rt];
        const int idx0 = (rt - tab[MOE_TS + e]) * 256;
        u.A = (const char*)hid; u.B = (const char*)(w2b + ((size_t)e * 1024 + (size_t)pn * 256) * 1024); u.pm = rt; u.pn = pn; u.e = e; u.nvalid = tab[MOE_CNT + e] - idx0; u.y0 = tab[MOE_ST + e] + idx0; u.aux = 0; return true; }
    __device__ __forceinline__ unsigned a_off(const pg8::Unit& u, int r) const { return (unsigned)(hid_tile_off(u.pm) + (size_t)r * 1024u); }
    __device__ __forceinline__ void epi(const f32x4 (&acc)[2][2][4][2], const pg8::Unit& u, int wr, int wc, int fr, int fq) const {
        asm volatile("" : "+v"(fr), "+v"(fq));
        const float* bp = b2 + (size_t)u.e * 1024 + u.pn * 256 + wc * 32 + 8 * fq;
        f32x4 bv[2][2];
#pragma unroll
        for (int bj = 0; bj < 2; ++bj)
#pragma unroll
            for (int n = 0; n < 2; ++n) bv[bj][n] = *(const f32x4*)(bp + bj * 128 + 4 * n);
        char* ub = (char*)y + (((size_t)u.y0 + wr * 64) * 1024 + u.pn * 256 + wc * 32);
        const unsigned lo2 = (unsigned)(fr * 1024 + 8 * fq) + ((fq & 1) ? 120u : 0u);
        const int r0 = wr * 64 + fr;
#pragma unroll
        for (int ai = 0; ai < 2; ++ai)
#pragma unroll
            for (int m = 0; m < 4; ++m) { const int r = r0 + ai * 128 + m * 16;
                unsigned pk[2][2];
#pragma unroll
                for (int bj = 0; bj < 2; ++bj) { const f32x4 v0 = acc[ai][bj][m][0] * (1.0f / 16.0f) + bv[bj][0] * 16.0f, v1 = acc[ai][bj][m][1] * (1.0f / 16.0f) + bv[bj][1] * 16.0f;
                    unsigned w0 = 0u, w1 = 0u;
                    w0 = __builtin_amdgcn_cvt_pk_fp8_f32(c8(v0[0]), c8(v0[1]), w0, false); w0 = __builtin_amdgcn_cvt_pk_fp8_f32(c8(v0[2]), c8(v0[3]), w0, true);
                    w1 = __builtin_amdgcn_cvt_pk_fp8_f32(c8(v1[0]), c8(v1[1]), w1, false); w1 = __builtin_amdgcn_cvt_pk_fp8_f32(c8(v1[2]), c8(v1[3]), w1, true);
                    pk[bj][0] = w0; pk[bj][1] = w1; }
                const auto s0 = __builtin_amdgcn_permlane16_swap(pk[0][0], pk[1][0], false, false), s1 = __builtin_amdgcn_permlane16_swap(pk[0][1], pk[1][1], false, false);
                if (r < u.nvalid) *(u32x4*)(ub + (size_t)(ai * 128 + m * 16) * 1024 + lo2) = (u32x4){s0[0], s1[0], s0[1], s1[1]}; }
    }
};

#define XB_TMO      128
#define XB_XCNT(j)  (256  + 64 * (j))
#define XB_XSUB(j)  (1280 + 64 * (j))
#define XB_XGEN(j)  (2304 + 64 * (j))
#define XB_TOP      3328
#define XB_TOPGEN   3392
#define XCD_BAR_WORDS 3456
#define XB_SPIN_CAP (1u << 18)
__device__ __forceinline__ unsigned xb_ld(unsigned* p)              { return __hip_atomic_load(p, __ATOMIC_RELAXED, __HIP_MEMORY_SCOPE_AGENT); }
__device__ __forceinline__ unsigned xb_add(unsigned* p, unsigned v) { return __hip_atomic_fetch_add(p, v, __ATOMIC_RELAXED, __HIP_MEMORY_SCOPE_AGENT); }
__device__ __forceinline__ unsigned xb_xcc_id() { return (unsigned)__builtin_amdgcn_s_getreg((3 << 11) | 20) & 0xFu; }
#define XB_SPIN(cond, bar) do { unsigned _sp = 0; while (cond) { __builtin_amdgcn_s_sleep(1); \
    if ((++_sp & 255u) == 0u) { if (xb_ld(&(bar)[XB_TMO])) break; if (_sp > XB_SPIN_CAP) { atomicAdd(&(bar)[XB_TMO], 1u); break; } } } } while (0)
struct XcdBarrier { unsigned* bar; unsigned x; volatile LAS unsigned* st; int wave; };
__device__ __forceinline__ XcdBarrier xcd_barrier_post(unsigned* bar, volatile LAS unsigned* st, int wave) {
    XcdBarrier b; b.bar = bar; b.x = xb_xcc_id(); b.st = st; b.wave = wave;
    if (wave == 0 && lane_id() == 0) (void)xb_add(&bar[XB_XCNT(b.x)], 1u);
    return b;
}
__device__ __forceinline__ void xcd_barrier_complete(unsigned* bar, unsigned x, unsigned& nloc, unsigned& nx) {
    const unsigned G = gridDim.x * gridDim.y * gridDim.z;
    unsigned sum, cnt, mine, sp = 0u;
    for (;;) {
        sum = 0u; cnt = 0u; mine = 0u;
#pragma unroll
        for (unsigned j = 0; j < 16; ++j) { const unsigned c = xb_ld(&bar[XB_XCNT(j)]); sum += c; cnt += (c > 0u) ? 1u : 0u; mine = (j == x) ? c : mine; }
        if (sum == G) break;
        __builtin_amdgcn_s_sleep(1);
        if ((++sp & 255u) == 0u) { if (xb_ld(&bar[XB_TMO])) break; if (sp > XB_SPIN_CAP) { atomicAdd(&bar[XB_TMO], 1u); break; } }
    }
    nloc = mine > 0u ? mine : 1u; nx = cnt > 0u ? cnt : 1u;
}
__device__ __forceinline__ void xcd_barrier(const XcdBarrier& b) {
    asm volatile("s_waitcnt vmcnt(0)" ::: "memory");
    __syncthreads();
    if (b.wave == 0 && lane_id() == 0) {
        unsigned* bar = b.bar;
        __builtin_amdgcn_s_waitcnt(0);
        unsigned nloc = b.st[0], nx = b.st[1];
        if (nloc == 0u) { xcd_barrier_complete(bar, b.x, nloc, nx); b.st[0] = nloc; b.st[1] = nx; }
        const unsigned old = xb_add(&bar[XB_XSUB(b.x)], 1u);
        const unsigned gen = old / nloc;
        if (old + 1u == (gen + 1u) * nloc) {
            __builtin_amdgcn_fence(__ATOMIC_RELEASE, "agent");
            asm volatile("s_waitcnt vmcnt(0)" ::: "memory");
            const unsigned og = xb_add(&bar[XB_TOP], 1u);
            const unsigned tg = og / nx;
            if (og + 1u == (tg + 1u) * nx) xb_add(&bar[XB_TOPGEN], 1u);
            else XB_SPIN(xb_ld(&bar[XB_TOPGEN]) == tg, bar);
            __builtin_amdgcn_fence(__ATOMIC_ACQUIRE, "agent");
            xb_add(&bar[XB_XGEN(b.x)], 1u);
            asm volatile("s_waitcnt vmcnt(0)" ::: "memory");
        } else {
            XB_SPIN(xb_ld(&bar[XB_XGEN(b.x)]) == gen, bar);
            __builtin_amdgcn_fence(__ATOMIC_ACQUIRE, "agent");
            asm volatile("s_waitcnt vmcnt(0)" ::: "memory");
        }
    }
    __syncthreads();
}

typedef float f32x16 __attribute__((ext_vector_type(16)));
__device__ __forceinline__ int pi32(int i) { return (i & ~12) | ((i & 4) << 1) | ((i & 8) >> 1); }
__device__ __forceinline__ f32x16 zero16() { f32x16 z;
#pragma unroll
    for (int r = 0; r < 16; ++r) z[r] = 0.f;
    return z; }

__device__ __forceinline__ void xattn_phase(LAS unsigned char* lds, const bf16_t* Q, const bf16_t* Kb, const bf16_t* VT, unsigned char* O, int G, int bx, int wave) {
    const int lane = lane_id(), i = lane & 31, hh = lane >> 5;
    LAS unsigned char* ring = lds;
    for (int uid = bx; uid < BATCH * 4 * 8; uid += G) {
        const int b = uid >> 5, h = (uid >> 3) & 3, qblk = uid & 7;
        const int q0 = qblk * 256 + wave * 32;
        const bf16_t* qp = Q + (size_t)(b * SEQ + q0 + i) * 1024 + h * 256 + 8 * hh;
        bf16x8 qf[16];
#pragma unroll
        for (int ds = 0; ds < 16; ++ds) qf[ds] = *(const bf16x8*)(qp + 16 * ds);
        const bf16_t* ksrc = Kb + (size_t)(b * MEMLEN + pi32(i)) * 1024 + h * 256 + 16 * wave + 8 * hh;
        const bf16_t* vsrc = VT + (size_t)(h * 256 + i) * MROWS + b * MEMLEN + 32 * (wave >> 1) + 16 * (wave & 1) + 8 * hh;
#define XA_ISSUE(st_) do { LAS unsigned char* sl_ = ring + ((st_) & 3) * 16384; \
        if ((st_) < 8) { const bf16_t* g_ = ksrc + (size_t)(st_) * 32 * 1024; \
            __builtin_amdgcn_global_load_lds((const unsigned*)g_, (LAS unsigned*)(sl_ + wave * 1024), 16, 0, 0); \
            __builtin_amdgcn_global_load_lds((const unsigned*)(g_ + 128), (LAS unsigned*)(sl_ + (8 + wave) * 1024), 16, 0, 0); } \
        else { const bf16_t* g_ = vsrc + (size_t)((st_) - 8) * 32 * MROWS; \
            __builtin_amdgcn_global_load_lds((const unsigned*)g_, (LAS unsigned*)(sl_ + wave * 1024), 16, 0, 0); \
            __builtin_amdgcn_global_load_lds((const unsigned*)(g_ + 128), (LAS unsigned*)(sl_ + (8 + wave) * 1024), 16, 0, 0); } } while (0)
#define XA_SYNC(st_) do { const int n_ = ((st_) >= 11 ? 4 : 0) + ((st_) <= 14 ? 2 : 0) + ((st_) >= 10 ? 4 : 0) + ((st_) <= 13 ? 2 : 0) + ((st_) >= 9 ? 4 : 0); \
        if (n_ == 4) asm volatile("s_waitcnt vmcnt(4)" ::: "memory"); else if (n_ == 8) asm volatile("s_waitcnt vmcnt(8)" ::: "memory"); \
        else if (n_ == 12) asm volatile("s_waitcnt vmcnt(12)" ::: "memory"); else if (n_ == 14) asm volatile("s_waitcnt vmcnt(14)" ::: "memory"); else asm volatile("s_waitcnt vmcnt(16)" ::: "memory"); \
        __builtin_amdgcn_s_barrier(); asm volatile("" ::: "memory"); if ((st_) + 3 < 16) XA_ISSUE((st_) + 3); } while (0)
        XA_ISSUE(0); XA_ISSUE(1); XA_ISSUE(2);
        f32x16 s[8];
#pragma unroll
        for (int kt = 0; kt < 8; ++kt) { XA_SYNC(kt);
            const LAS unsigned char* sl = ring + (kt & 3) * 16384 + lane * 16;
            f32x16 acc = zero16();
#pragma unroll
            for (int q4 = 0; q4 < 4; ++q4) { __builtin_amdgcn_sched_barrier(0);
#pragma unroll
                for (int d4 = 0; d4 < 4; ++d4) { const int ds = q4 * 4 + d4; acc = __builtin_amdgcn_mfma_f32_32x32x16_bf16(*(const LAS bf16x8*)(sl + ds * 1024), qf[ds], acc, 0, 0, 0); } }
            s[kt] = acc; }
        float m = -INFINITY;
#pragma unroll
        for (int kt = 0; kt < 8; ++kt)
#pragma unroll
            for (int r = 0; r < 16; ++r) m = fmaxf(m, s[kt][r]);
        m = x32_max(m);
        const float c = 0.0625f * 1.4426950408889634f; float l = 0.f; const float mc = m * c;
        u32x4 pf[8][2];
#pragma unroll
        for (int kt = 0; kt < 8; ++kt) {
#pragma unroll
            for (int r = 0; r < 16; ++r) { const float p = __builtin_amdgcn_exp2f(s[kt][r] * c - mc); s[kt][r] = p; l += p; }
#pragma unroll
            for (int sb = 0; sb < 2; ++sb) { pf[kt][sb].x = cvt_pk_bf16(s[kt][8 * sb + 0], s[kt][8 * sb + 1]); pf[kt][sb].y = cvt_pk_bf16(s[kt][8 * sb + 2], s[kt][8 * sb + 3]);
                pf[kt][sb].z = cvt_pk_bf16(s[kt][8 * sb + 4], s[kt][8 * sb + 5]); pf[kt][sb].w = cvt_pk_bf16(s[kt][8 * sb + 6], s[kt][8 * sb + 7]); } }
        l = x32_sum(l);
        const float il = 1.0f / l;
        unsigned char* op = O + (size_t)(b * SEQ + q0 + i) * 1024 + h * 256 + 4 * hh;
#pragma unroll
        for (int dvt = 0; dvt < 8; ++dvt) { XA_SYNC(8 + dvt);
            const LAS unsigned char* sl = ring + (dvt & 3) * 16384 + lane * 16;
            f32x16 oacc = zero16();
#pragma unroll
            for (int q4 = 0; q4 < 4; ++q4) { __builtin_amdgcn_sched_barrier(0);
#pragma unroll
                for (int f4 = 0; f4 < 4; ++f4) { const int f = q4 * 4 + f4; oacc = __builtin_amdgcn_mfma_f32_32x32x16_bf16(*(const LAS bf16x8*)(sl + f * 1024), __builtin_bit_cast(bf16x8, pf[f >> 1][f & 1]), oacc, 0, 0, 0); } }
#pragma unroll
            for (int g = 0; g < 4; ++g) { unsigned w = 0u; w = __builtin_amdgcn_cvt_pk_fp8_f32(c8(oacc[4 * g] * il), c8(oacc[4 * g + 1] * il), w, false); w = __builtin_amdgcn_cvt_pk_fp8_f32(c8(oacc[4 * g + 2] * il), c8(oacc[4 * g + 3] * il), w, true);
                *(unsigned*)(op + dvt * 32 + 8 * g) = w; } }
#undef XA_ISSUE
#undef XA_SYNC
    }
}

__device__ __forceinline__ void diffattn_phase(LAS unsigned char* lds, const bf16_t* P2, const bf16_t* VT, const float* dng, const float lam, bf16_t* cat, int G, int vx, int wave) {
    const int lane = lane_id(), i_ = lane & 31, hh_ = lane >> 5;
    LAS unsigned char* ring = lds;
    LAS unsigned char* ql = lds + 65536 + wave * 8192 + lane * 16;
    const float c = 0.125f * 1.4426950408889634f;
    for (int pu = vx; pu < BATCH * 4 * 4; pu += G)
        for (int side = 0; side < 2; ++side) {
            const int bh = pu >> 2, x = pu & 3, qb = side ? 7 - x : x, b = bh >> 2, h = bh & 3, q0 = qb * 256 + wave * 32;
            const int ntile = 8 * qb + 8, ktw = 8 * qb + wave;
            int i = i_, hh = hh_; asm volatile("" : "+v"(i), "+v"(hh));
            const bf16_t* qp = P2 + (size_t)(b * SEQ + q0 + i) * NP2 + h * 128 + 8 * hh;
            { bf16x8 t[8];
#pragma unroll
              for (int f = 0; f < 8; ++f) t[f] = *(const bf16x8*)(qp + 16 * f);
#pragma unroll
              for (int f = 0; f < 8; ++f) *(LAS bf16x8*)(ql + f * 1024) = t[f]; }
            const char* kbase = (const char*)(P2 + (size_t)b * SEQ * NP2 + 512 + h * 128 + (wave >> 2) * 64 + 16 * (wave & 3));
            const char* vbase = (const char*)(VT + (size_t)(h * 128 + 32 * (wave >> 1)) * T + (size_t)b * SEQ + 16 * (wave & 1));
            const unsigned koff = (unsigned)(pi32(i) * NP2 + 8 * hh) * 2u, voff = (unsigned)(i * T + 8 * hh) * 2u;
#define DA_ISSUE(kt_) do { LAS unsigned char* sl_ = ring + ((kt_) & 3) * 16384; \
        __builtin_amdgcn_global_load_lds((const unsigned*)(kbase + (size_t)(kt_) * (32 * NP2 * 2) + koff), (LAS unsigned*)(sl_ + wave * 1024), 16, 0, 0); \
        __builtin_amdgcn_global_load_lds((const unsigned*)(vbase + (kt_) * 64 + voff), (LAS unsigned*)(sl_ + (8 + wave) * 1024), 16, 0, 0); } while (0)
            f32x16 o1[4], o2[4];
#pragma unroll
            for (int d = 0; d < 4; ++d) { o1[d] = zero16(); o2[d] = zero16(); }
            float mc1 = -INFINITY, mc2 = -INFINITY, l1 = 0.f, l2 = 0.f;
            u32x4 pp1[2], pp2[2];
#pragma unroll
            for (int sb = 0; sb < 2; ++sb) { pp1[sb] = (u32x4){0u, 0u, 0u, 0u}; pp2[sb] = pp1[sb]; }
            DA_ISSUE(0); DA_ISSUE(1);
            for (int kt = 0; kt <= ntile; ++kt) {
                if (kt < ntile) {
                    if (kt + 1 < ntile) asm volatile("s_waitcnt vmcnt(2)" ::: "memory"); else asm volatile("s_waitcnt vmcnt(0)" ::: "memory");
                    __builtin_amdgcn_s_barrier(); asm volatile("" ::: "memory");
                    if (kt + 2 < ntile) DA_ISSUE(kt + 2);
                }
                if (kt <= ktw + 1) {
                    const LAS unsigned char* sl = ring + (kt & 3) * 16384 + lane * 16;
                    const LAS unsigned char* sp = ring + ((kt == 0 ? 0 : kt - 1) & 3) * 16384 + lane * 16;
                    f32x16 s1 = zero16(), s2 = zero16();
#pragma unroll
                    for (int ds = 0; ds < 4; ++ds) { s1 = __builtin_amdgcn_mfma_f32_32x32x16_bf16(*(const LAS bf16x8*)(sl + ds * 1024), *(const LAS bf16x8*)(ql + ds * 1024), s1, 0, 0, 0);
                        s2 = __builtin_amdgcn_mfma_f32_32x32x16_bf16(*(const LAS bf16x8*)(sl + (4 + ds) * 1024), *(const LAS bf16x8*)(ql + (4 + ds) * 1024), s2, 0, 0, 0);
                        if (ds & 1) __builtin_amdgcn_sched_barrier(0); }
                    if (kt >= ktw) { const int lim = (kt == ktw) ? i : -1;
#pragma unroll
                        for (int r = 0; r < 16; ++r) { const int ko = 16 * (r >> 3) + 8 * hh + (r & 7); if (ko > lim) { s1[r] = -INFINITY; s2[r] = -INFINITY; } } }
                    float f1 = 1.f, f2 = 1.f; bool rs1, rs2;
                    { float tm = s1[0];
#pragma unroll
                      for (int r = 1; r < 16; ++r) tm = fmaxf(tm, s1[r]);
                      tm = x32_max(tm); const float tmc = tm * c; rs1 = __any(tmc > mc1 + 8.0f);
                      if (rs1) { const float mn = fmaxf(mc1, tmc); f1 = __builtin_amdgcn_exp2f(mc1 - mn); mc1 = mn; } }
                    { float tm = s2[0];
#pragma unroll
                      for (int r = 1; r < 16; ++r) tm = fmaxf(tm, s2[r]);
                      tm = x32_max(tm); const float tmc = tm * c; rs2 = __any(tmc > mc2 + 8.0f);
                      if (rs2) { const float mn = fmaxf(mc2, tmc); f2 = __builtin_amdgcn_exp2f(mc2 - mn); mc2 = mn; } }
                    float ls1 = 0.f, ls2 = 0.f; u32x4 pn1[2], pn2[2];
#define DA_SM(j) do { { const float pv_ = __builtin_amdgcn_exp2f(s1[j] * c - mc1); s1[j] = pv_; ls1 += pv_; } { const float pv_ = __builtin_amdgcn_exp2f(s2[j] * c - mc2); s2[j] = pv_; ls2 += pv_; } \
                        if ((j) & 1) { pn1[(j) >> 3][((j) & 7) >> 1] = cvt_pk_bf16(s1[(j) - 1], s1[j]); pn2[(j) >> 3][((j) & 7) >> 1] = cvt_pk_bf16(s2[(j) - 1], s2[j]); } } while (0)
                    { bf16x8 va, vb;
#define DA_VLD(p) (*(const LAS bf16x8*)(sp + (8 + ((p) & 3) * 2 + ((p) >> 2)) * 1024))
#define DA_SLOT(j, VF, LDNEXT) do { if ((j) & 1) o2[((j) >> 1) & 3] = __builtin_amdgcn_mfma_f32_32x32x16_bf16(VF, __builtin_bit_cast(bf16x8, pp2[(j) >> 3]), o2[((j) >> 1) & 3], 0, 0, 0); \
                            else o1[((j) >> 1) & 3] = __builtin_amdgcn_mfma_f32_32x32x16_bf16(VF, __builtin_bit_cast(bf16x8, pp1[(j) >> 3]), o1[((j) >> 1) & 3], 0, 0, 0); \
                            LDNEXT; DA_SM(j); __builtin_amdgcn_sched_barrier(0); } while (0)
                      va = DA_VLD(0);
                      __builtin_amdgcn_sched_barrier(0);
                      DA_SLOT(0, va, vb = DA_VLD(1)); DA_SLOT(1, va, (void)0); DA_SLOT(2, vb, va = DA_VLD(2)); DA_SLOT(3, vb, (void)0);
                      DA_SLOT(4, va, vb = DA_VLD(3)); DA_SLOT(5, va, (void)0); DA_SLOT(6, vb, va = DA_VLD(4)); DA_SLOT(7, vb, (void)0);
                      DA_SLOT(8, va, vb = DA_VLD(5)); DA_SLOT(9, va, (void)0); DA_SLOT(10, vb, va = DA_VLD(6)); DA_SLOT(11, vb, (void)0);
                      DA_SLOT(12, va, vb = DA_VLD(7)); DA_SLOT(13, va, (void)0); DA_SLOT(14, vb, (void)0); DA_SLOT(15, vb, (void)0);
#undef DA_VLD
#undef DA_SLOT
                    }
#undef DA_SM
                    l1 = l1 * f1 + ls1; l2 = l2 * f2 + ls2;
                    if (rs1) {
#pragma unroll
                        for (int d = 0; d < 4; ++d)
#pragma unroll
                            for (int r = 0; r < 16; ++r) o1[d][r] *= f1; }
                    if (rs2) {
#pragma unroll
                        for (int d = 0; d < 4; ++d)
#pragma unroll
                            for (int r = 0; r < 16; ++r) o2[d][r] *= f2; }
#pragma unroll
                    for (int sb = 0; sb < 2; ++sb) { pp1[sb] = pn1[sb]; pp2[sb] = pn2[sb]; }
                }
            }
#undef DA_ISSUE
            l1 = x32_sum(l1); l2 = x32_sum(l2);
            int ie = i, he = hh; asm volatile("" : "+v"(ie), "+v"(he));
            const float i1 = 1.0f / l1, i2 = lam / l2; float ss = 0.f;
#pragma unroll
            for (int d = 0; d < 4; ++d)
#pragma unroll
                for (int r = 0; r < 16; ++r) { const float o = o1[d][r] * i1 - o2[d][r] * i2; o1[d][r] = o; ss += o * o; }
            ss = x32_sum(ss);
            const float rn = rsqrtf(ss * (1.0f / 128.0f) + EPS) * (1.0f - LAMBDA_INIT);
            bf16_t* op = cat + (size_t)(b * SEQ + q0 + ie) * DM + h * 128 + 4 * he;
            const float* gp = dng + h * 128 + 4 * he;
#pragma unroll
            for (int d = 0; d < 4; ++d)
#pragma unroll
                for (int g = 0; g < 4; ++g) { const f32x4 gv = *(const f32x4*)(gp + d * 32 + 8 * g);
                    u32x2 w; w.x = cvt_pk_bf16(o1[d][4 * g] * rn * gv[0], o1[d][4 * g + 1] * rn * gv[1]); w.y = cvt_pk_bf16(o1[d][4 * g + 2] * rn * gv[2], o1[d][4 * g + 3] * rn * gv[3]);
                    *(u32x2*)(op + d * 32 + 8 * g) = w; }
        }
}

__device__ __forceinline__ void mlstm_prep_phase(LAS unsigned char* lds, const bf16_t* P2, const bf16_t* VT, const float* gates, const float* conv_w, const float* conv_b,
                                                 bf16_t* QM, bf16_t* KM, float* BC, float* AV, float* AM, float* CH, float* NLOC, float* CLOC, int G, int vx, int wave) {
    const int lane = lane_id(), i = lane & 31, hh = lane >> 5;
    LAS unsigned char* kl = lds + wave * 16384;
    for (int task = vx * 8 + wave; task < BATCH * 4 * 16; task += G * 8) {
        const int bh = task >> 4, c = task & 15, b = bh >> 2, h = bh & 3;
        const int t0 = b * SEQ + c * 128, tA = t0 + 2 * lane;
        const float lf0 = gates[(size_t)tA * 8 + 4 + h], lf1 = gates[(size_t)(tA + 1) * 8 + 4 + h], ig0 = gates[(size_t)tA * 8 + h], ig1 = gates[(size_t)(tA + 1) * 8 + h];
        float incl = lf0 + lf1;
#pragma unroll
        for (int off = 1; off < 64; off <<= 1) { const float v = __shfl_up(incl, off); if (lane >= off) incl += v; }
        const float bc1 = incl, bc0 = incl - lf1, blast = __shfl(incl, 63);
        const float a0 = ig0 - bc0, a1 = ig1 - bc1;
        float pm = fmaxf(a0, a1);
#pragma unroll
        for (int off = 1; off < 64; off <<= 1) { const float v = __shfl_up(pm, off); if (lane >= off) pm = fmaxf(pm, v); }
        const float pmprev = __shfl_up(pm, 1);
        const float am1 = pm, am0 = (lane > 0) ? fmaxf(pmprev, a0) : a0, amall = __shfl(pm, 63);
        const float ws0 = __expf(a0 - amall), ws1 = __expf(a1 - amall);
        *(f32x2*)(BC + (size_t)h * T + tA) = (f32x2){bc0, bc1};
        *(f32x2*)(AV + (size_t)h * T + tA) = (f32x2){a0, a1};
        *(f32x2*)(AM + (size_t)h * T + tA) = (f32x2){am0, am1};
        if (lane == 0) { CH[task * 2] = blast; CH[task * 2 + 1] = blast + amall; }
        {
            const int r8 = lane >> 3, cg = lane & 7;
            float cw[2][5][8];
#pragma unroll
            for (int part = 0; part < 2; ++part) { const int ch0 = (part ? 256 : 0) + h * 64 + 8 * cg;
#pragma unroll
                for (int k = 0; k < 4; ++k) { const f32x4 a = *(const f32x4*)(conv_w + k * 512 + ch0), bq = *(const f32x4*)(conv_w + k * 512 + ch0 + 4);
#pragma unroll
                    for (int j = 0; j < 4; ++j) { cw[part][k][j] = a[j]; cw[part][k][4 + j] = bq[j]; } }
                { const f32x4 a = *(const f32x4*)(conv_b + ch0), bq = *(const f32x4*)(conv_b + ch0 + 4);
#pragma unroll
                    for (int j = 0; j < 4; ++j) { cw[part][4][j] = a[j]; cw[part][4][4 + j] = bq[j]; } } }
#pragma unroll 4
            for (int jb = 0; jb < 16; ++jb) {
                const int p = 8 * jb + r8, tg = t0 + p, tseq = c * 128 + p;
                const float wa = __shfl(ws0, p >> 1), wb = __shfl(ws1, p >> 1); const float wsp = (p & 1) ? wb : wa;
                u32x4 uw[2][4];
#pragma unroll
                for (int part = 0; part < 2; ++part)
#pragma unroll
                    for (int k = 0; k < 4; ++k) { uw[part][k] = (u32x4){0u, 0u, 0u, 0u};
                        if (tseq - 3 + k >= 0) uw[part][k] = *(const u32x4*)(P2 + (size_t)(tg - 3 + k) * NP2 + 1024 + (part ? 256 : 0) + h * 64 + 8 * cg); }
#pragma unroll
                for (int part = 0; part < 2; ++part) { float y[8];
#pragma unroll
                    for (int j = 0; j < 8; ++j) { float pj = cw[part][4][j];
#pragma unroll
                        for (int k = 0; k < 4; ++k) { const unsigned wv = (j < 2) ? uw[part][k].x : (j < 4) ? uw[part][k].y : (j < 6) ? uw[part][k].z : uw[part][k].w; pj += cw[part][k][j] * ((j & 1) ? hi_bf(wv) : lo_bf(wv)); }
                        y[j] = pj * __builtin_amdgcn_rcpf(1.0f + __expf(-pj)); }
                    if (part == 0) { u32x4 w; w.x = cvt_pk_bf16(y[0] * 0.125f, y[1] * 0.125f); w.y = cvt_pk_bf16(y[2] * 0.125f, y[3] * 0.125f); w.z = cvt_pk_bf16(y[4] * 0.125f, y[5] * 0.125f); w.w = cvt_pk_bf16(y[6] * 0.125f, y[7] * 0.125f);
                        *(u32x4*)(QM + (size_t)tg * 256 + h * 64 + 8 * cg) = w; }
                    else { u32x4 w; w.x = cvt_pk_bf16(y[0], y[1]); w.y = cvt_pk_bf16(y[2], y[3]); w.z = cvt_pk_bf16(y[4], y[5]); w.w = cvt_pk_bf16(y[6], y[7]);
                        *(u32x4*)(KM + (size_t)tg * 256 + h * 64 + 8 * cg) = w;
#pragma unroll
                        for (int j = 0; j < 8; ++j) { const int d = 8 * cg + j;
                            *(LAS unsigned short*)(kl + d * 256 + ((jb ^ (d & 15)) * 16) + r8 * 2) = (unsigned short)f2bf(y[j] * wsp); } } }
            }
        }
        { float ns = 0.f;
#pragma unroll
          for (int cq = 0; cq < 16; ++cq) { const u32x4 w = *(const LAS u32x4*)(kl + lane * 256 + ((cq ^ (lane & 15)) * 16));
              ns += (lo_bf(w.x) + hi_bf(w.x)) + (lo_bf(w.y) + hi_bf(w.y)) + (lo_bf(w.z) + hi_bf(w.z)) + (lo_bf(w.w) + hi_bf(w.w)); }
          NLOC[(size_t)task * 64 + lane] = ns; }
        f32x16 acc[4][2];
#pragma unroll
        for (int et = 0; et < 4; ++et) { acc[et][0] = zero16(); acc[et][1] = zero16(); }
        const bf16_t* vp = VT + (size_t)(512 + h * 128 + i) * T + t0 + 8 * hh;
#pragma unroll
        for (int k2 = 0; k2 < 8; k2 += 2) {
            bf16x8 af[2][4];
#pragma unroll
            for (int q = 0; q < 2; ++q)
#pragma unroll
                for (int et = 0; et < 4; ++et) af[q][et] = *(const bf16x8*)(vp + (size_t)et * 32 * T + 16 * (k2 + q));
            __builtin_amdgcn_sched_barrier(0);
#pragma unroll
            for (int q = 0; q < 2; ++q) { const int ks = k2 + q; bf16x8 bfr[2];
#pragma unroll
                for (int dt = 0; dt < 2; ++dt) { const int d = 32 * dt + i; bfr[dt] = *(const LAS bf16x8*)(kl + d * 256 + (((2 * ks + hh) ^ (d & 15)) * 16)); }
#pragma unroll
                for (int et = 0; et < 4; ++et) {
                    acc[et][0] = __builtin_amdgcn_mfma_f32_32x32x16_bf16(af[q][et], bfr[0], acc[et][0], 0, 0, 0); acc[et][1] = __builtin_amdgcn_mfma_f32_32x32x16_bf16(af[q][et], bfr[1], acc[et][1], 0, 0, 0); } }
            __builtin_amdgcn_sched_barrier(0);
        }
        float* cp = CLOC + (size_t)task * 8192 + i + 256 * hh;
#pragma unroll
        for (int et = 0; et < 4; ++et)
#pragma unroll
            for (int dt = 0; dt < 2; ++dt)
#pragma unroll
                for (int r = 0; r < 16; ++r) cp[(32 * et + (r & 3) + 8 * (r >> 2)) * 64 + 32 * dt] = acc[et][dt][r];
    }
}
__device__ __forceinline__ void mlstm_scan_phase(const float* CLOC, const float* NLOC, const float* CH, bf16_t* CSTB, float* NST, float* MSTATE, int G, int bx, int tid) {
    for (int idx = bx * 512 + tid; idx < BATCH * 4 * 1024; idx += G * 512) {
        const int bh = idx >> 10, rem = idx & 1023, e = rem >> 3, d0 = (rem & 7) * 8;
        float C[8], nr[8]; float m = 0.f;
#pragma unroll
        for (int j = 0; j < 8; ++j) { C[j] = 0.f; nr[j] = 0.f; }
#pragma unroll 1
        for (int c8 = 0; c8 < 16; c8 += 8) {
            f32x4 cl[8][2], nl[8][2]; float bl[8], ml[8];
#pragma unroll
            for (int q = 0; q < 8; ++q) { const int task = bh * 16 + c8 + q;
                cl[q][0] = *(const f32x4*)(CLOC + (size_t)task * 8192 + e * 64 + d0); cl[q][1] = *(const f32x4*)(CLOC + (size_t)task * 8192 + e * 64 + d0 + 4);
                bl[q] = CH[task * 2]; ml[q] = CH[task * 2 + 1];
                if (rem < 8) { nl[q][0] = *(const f32x4*)(NLOC + (size_t)task * 64 + rem * 8); nl[q][1] = *(const f32x4*)(NLOC + (size_t)task * 64 + rem * 8 + 4); }
                else { nl[q][0] = (f32x4){0.f, 0.f, 0.f, 0.f}; nl[q][1] = nl[q][0]; } }
#pragma unroll
            for (int q = 0; q < 8; ++q) { const int task = bh * 16 + c8 + q;
                u32x4 w; w.x = cvt_pk_bf16(C[0], C[1]); w.y = cvt_pk_bf16(C[2], C[3]); w.z = cvt_pk_bf16(C[4], C[5]); w.w = cvt_pk_bf16(C[6], C[7]);
                *(u32x4*)(CSTB + (size_t)task * 8192 + e * 64 + d0) = w;
                if (rem < 8) { *(f32x4*)(NST + (size_t)task * 64 + rem * 8) = (f32x4){nr[0], nr[1], nr[2], nr[3]}; *(f32x4*)(NST + (size_t)task * 64 + rem * 8 + 4) = (f32x4){nr[4], nr[5], nr[6], nr[7]}; }
                if (rem == 0) MSTATE[task] = m;
                const float mn = fmaxf(bl[q] + m, ml[q]), a = __expf(bl[q] + m - mn), bco = __expf(ml[q] - mn);
#pragma unroll
                for (int j = 0; j < 4; ++j) { C[j] = a * C[j] + bco * cl[q][0][j]; C[4 + j] = a * C[4 + j] + bco * cl[q][1][j]; nr[j] = a * nr[j] + bco * nl[q][0][j]; nr[4 + j] = a * nr[4 + j] + bco * nl[q][1][j]; }
                m = mn; }
        }
    }
}
__device__ __forceinline__ void mlstm_out_phase(LAS unsigned char* lds, const bf16_t* P2, const bf16_t* VT, const bf16_t* QM, const bf16_t* KM, const float* BC, const float* AV, const float* AM,
                                                const bf16_t* CSTB, const float* NST, const float* MSTATE, const float* mng, bf16_t* cat, int G, int vx, int wave) {
    const int lane_ = lane_id();
    const int cw = wave >> 2, tq = wave & 3;
    LAS unsigned char* reg = lds + cw * 65536;
    for (int un = vx; un < BATCH * 4 * 8; un += G) {
        int lane = lane_; asm volatile("" : "+v"(lane));
        const int i = lane & 31, hh = lane >> 5;
        const int task = 2 * un + cw, bh = task >> 4, c = task & 15, b = bh >> 2, h = bh & 3;
        const int t0 = b * SEQ + c * 128;
        { const bf16_t* ks = KM + (size_t)(t0 + 32 * tq + pi32(i)) * 256 + h * 64 + 8 * hh;
          const bf16_t* cs = CSTB + (size_t)task * 8192 + (32 * tq + i) * 64 + 8 * hh;
          const bf16_t* vs = VT + (size_t)(512 + h * 128 + 32 * tq + i) * T + t0 + 8 * hh;
#pragma unroll
          for (int ds = 0; ds < 4; ++ds) { __builtin_amdgcn_global_load_lds((const unsigned*)(ks + 16 * ds), (LAS unsigned*)(reg + (tq * 4 + ds) * 1024), 16, 0, 0);
              __builtin_amdgcn_global_load_lds((const unsigned*)(cs + 16 * ds), (LAS unsigned*)(reg + 16384 + (tq * 4 + ds) * 1024), 16, 0, 0); }
#pragma unroll
          for (int k8 = 0; k8 < 8; ++k8) __builtin_amdgcn_global_load_lds((const unsigned*)(vs + 16 * k8), (LAS unsigned*)(reg + 32768 + (tq * 8 + k8) * 1024), 16, 0, 0); }
        const float m_c = MSTATE[task];
        const int tg = t0 + 32 * tq + i;
        const float bct = BC[(size_t)h * T + tg], amt = AM[(size_t)h * T + tg];
        bf16x8 qf[4];
#pragma unroll
        for (int ds = 0; ds < 4; ++ds) qf[ds] = *(const bf16x8*)(QM + (size_t)tg * 256 + h * 64 + 16 * ds + 8 * hh);
        float qn = 0.f;
#pragma unroll
        for (int ds = 0; ds < 4; ++ds) { const f32x4 n0 = *(const f32x4*)(NST + (size_t)task * 64 + 16 * ds + 8 * hh), n1 = *(const f32x4*)(NST + (size_t)task * 64 + 16 * ds + 8 * hh + 4);
            const u32x4 w = __builtin_bit_cast(u32x4, qf[ds]);
            qn += lo_bf(w.x) * n0[0] + hi_bf(w.x) * n0[1] + lo_bf(w.y) * n0[2] + hi_bf(w.y) * n0[3] + lo_bf(w.z) * n1[0] + hi_bf(w.z) * n1[1] + lo_bf(w.w) * n1[2] + hi_bf(w.w) * n1[3]; }
        qn = x32_sum(qn);
        const float M = fmaxf(m_c, amt), g = __expf(m_c - M), emt = __expf(-(bct + M));
        const bf16_t* mop = P2 + (size_t)tg * NP2 + 1536 + h * 128 + 4 * hh;
        u32x2 mov[4][4];
#pragma unroll
        for (int et = 0; et < 4; ++et)
#pragma unroll
            for (int g4 = 0; g4 < 4; ++g4) mov[et][g4] = *(const u32x2*)(mop + et * 32 + 8 * g4);
        asm volatile("s_waitcnt vmcnt(0)" ::: "memory"); __builtin_amdgcn_s_barrier(); asm volatile("" ::: "memory");
        const LAS unsigned char* rl = reg + lane * 16;
        f32x16 acc[4];
#pragma unroll
        for (int et = 0; et < 4; ++et) { acc[et] = zero16();
#pragma unroll
            for (int ds = 0; ds < 4; ++ds) acc[et] = __builtin_amdgcn_mfma_f32_32x32x16_bf16(*(const LAS bf16x8*)(rl + 16384 + (et * 4 + ds) * 1024), qf[ds], acc[et], 0, 0, 0);
#pragma unroll
            for (int r = 0; r < 16; ++r) acc[et][r] *= g; }
        float wsum = 0.f;
        for (int kt = 0; kt <= tq; ++kt) {
            f32x16 sc = zero16();
#pragma unroll
            for (int ds = 0; ds < 4; ++ds) sc = __builtin_amdgcn_mfma_f32_32x32x16_bf16(*(const LAS bf16x8*)(rl + (kt * 4 + ds) * 1024), qf[ds], sc, 0, 0, 0);
            const float* ap = AV + (size_t)h * T + t0 + 32 * kt + 8 * hh;
            const f32x4 a00 = *(const f32x4*)(ap), a01 = *(const f32x4*)(ap + 4), a10 = *(const f32x4*)(ap + 16), a11 = *(const f32x4*)(ap + 20);
#pragma unroll
            for (int r = 0; r < 16; ++r) { const float av = (r < 4) ? a00[r & 3] : (r < 8) ? a01[r & 3] : (r < 12) ? a10[r & 3] : a11[r & 3];
                const int ko = 16 * (r >> 3) + 8 * hh + (r & 7);
                float w = sc[r] * __expf(av - M);
                w = (kt == tq && ko > i) ? 0.f : w;
                sc[r] = w; wsum += w; }
            u32x4 wf[2];
#pragma unroll
            for (int sb = 0; sb < 2; ++sb) { wf[sb].x = cvt_pk_bf16(sc[8 * sb + 0], sc[8 * sb + 1]); wf[sb].y = cvt_pk_bf16(sc[8 * sb + 2], sc[8 * sb + 3]); wf[sb].z = cvt_pk_bf16(sc[8 * sb + 4], sc[8 * sb + 5]); wf[sb].w = cvt_pk_bf16(sc[8 * sb + 6], sc[8 * sb + 7]); }
#pragma unroll
            for (int et = 0; et < 4; ++et)
#pragma unroll
                for (int sb = 0; sb < 2; ++sb) acc[et] = __builtin_amdgcn_mfma_f32_32x32x16_bf16(*(const LAS bf16x8*)(rl + 32768 + (et * 8 + 2 * kt + sb) * 1024), __builtin_bit_cast(bf16x8, wf[sb]), acc[et], 0, 0, 0);
        }
        wsum = x32_sum(wsum);
        const float den = g * qn + wsum, idd = 1.0f / fmaxf(fabsf(den), emt);
        float ss = 0.f;
#pragma unroll
        for (int et = 0; et < 4; ++et)
#pragma unroll
            for (int r = 0; r < 16; ++r) { const float hv = acc[et][r] * idd; acc[et][r] = hv; ss += hv * hv; }
        ss = x32_sum(ss);
        const float rn = rsqrtf(ss * (1.0f / 128.0f) + EPS);
        bf16_t* op = cat + (size_t)tg * DM + 512 + h * 128 + 4 * hh;
        const float* gp = mng + h * 128 + 4 * hh;
#pragma unroll
        for (int et = 0; et < 4; ++et)
#pragma unroll
            for (int g4 = 0; g4 < 4; ++g4) { const f32x4 gv = *(const f32x4*)(gp + et * 32 + 8 * g4); const u32x2 mo = mov[et][g4];
                const float o0 = lo_bf(mo.x), o1 = hi_bf(mo.x), o2 = lo_bf(mo.y), o3 = hi_bf(mo.y);
                const float y0 = acc[et][4 * g4] * rn * gv[0] * __builtin_amdgcn_rcpf(1.0f + __expf(-o0)), y1 = acc[et][4 * g4 + 1] * rn * gv[1] * __builtin_amdgcn_rcpf(1.0f + __expf(-o1));
                const float y2 = acc[et][4 * g4 + 2] * rn * gv[2] * __builtin_amdgcn_rcpf(1.0f + __expf(-o2)), y3 = acc[et][4 * g4 + 3] * rn * gv[3] * __builtin_amdgcn_rcpf(1.0f + __expf(-o3));
                u32x2 w; w.x = cvt_pk_bf16(y0, y1); w.y = cvt_pk_bf16(y2, y3); *(u32x2*)(op + et * 32 + 8 * g4) = w; }
        asm volatile("s_waitcnt lgkmcnt(0)" ::: "memory"); __builtin_amdgcn_s_barrier(); asm volatile("" ::: "memory");
    }
}

constexpr int NWAVES = 8;
constexpr int RING_BYTES = 131072;
constexpr int LDSCTL_OFF = RING_BYTES;
constexpr int LDS_BYTES = RING_BYTES + 5120;

enum Phase { PH_PREP = 0, PH_INPROJ = 1, PH_MIX0 = 2, PH_MIX1 = 3, PH_MIX2 = 4, PH_OUTPROJ = 5, PH_QKV = 6, PH_XATTN = 7, PH_COPROJ = 8, PH_ROUTER = 9, PH_G1 = 10, PH_G2 = 11, PH_COMBINE = 12, PH_END = 13 };

struct Args { const float* in[28]; float* out; unsigned char* ws; int ph_lo, ph_hi, pass_lo, pass_hi; };

struct CJob { const float* src; const float* g; unsigned char* dst; int Nsrc, k0, n0, mode, f8; float scale; };
__device__ __forceinline__ void conv_load(const CJob& j, f32x4 (&v)[2], int tid) {
    const int kk = tid >> 4, c4 = (tid & 15) * 4;
#pragma unroll
    for (int rep = 0; rep < 2; ++rep) v[rep] = *(const f32x4*)(j.src + (size_t)(j.k0 + kk + 32 * rep) * j.Nsrc + j.n0 + c4);
}
__device__ __forceinline__ void conv_put(LAS float* tile, const f32x4 (&v)[2], int tid) {
    const int kk = tid >> 4, c4 = (tid & 15) * 4;
#pragma unroll
    for (int rep = 0; rep < 2; ++rep)
#pragma unroll
        for (int q = 0; q < 4; ++q) tile[(kk + 32 * rep) * 65 + c4 + q] = v[rep][q];
}
__device__ __forceinline__ void conv_store(const LAS float* tile, const CJob& j, int tid) {
    const int n = tid >> 3, kc = tid & 7; float vals[8];
    f32x4 g0 = (f32x4){1.f, 1.f, 1.f, 1.f}, g1 = g0;
    if (j.g) { g0 = *(const f32x4*)(j.g + j.k0 + 8 * kc); g1 = *(const f32x4*)(j.g + j.k0 + 8 * kc + 4); }
#pragma unroll
    for (int q = 0; q < 8; ++q) vals[q] = tile[(8 * kc + q) * 65 + n] * (q < 4 ? g0[q & 3] : g1[q & 3]) * j.scale;
    const int sc = j.n0 + n; int drow = sc;
    if (j.mode == 1) { const int jj = sc >> 1, s = sc & 1; drow = 256 * (jj >> 7) + 128 * s + (jj & 127); }
    if (j.mode == 2) { drow = sc < 1024 ? sc : sc < 1536 ? sc + 1024 : sc < 2048 ? sc - 512 : sc < 2560 ? sc + 512 : sc - 1024; }
    if (j.f8) { unsigned w0 = 0u, w1 = 0u;
        w0 = __builtin_amdgcn_cvt_pk_fp8_f32(c8(vals[0]), c8(vals[1]), w0, false); w0 = __builtin_amdgcn_cvt_pk_fp8_f32(c8(vals[2]), c8(vals[3]), w0, true);
        w1 = __builtin_amdgcn_cvt_pk_fp8_f32(c8(vals[4]), c8(vals[5]), w1, false); w1 = __builtin_amdgcn_cvt_pk_fp8_f32(c8(vals[6]), c8(vals[7]), w1, true);
        *(u32x2*)(j.dst + (size_t)drow * 1024 + j.k0 + 8 * kc) = (u32x2){w0, w1}; }
    else { u32x4 w; w.x = cvt_pk_bf16(vals[0], vals[1]); w.y = cvt_pk_bf16(vals[2], vals[3]); w.z = cvt_pk_bf16(vals[4], vals[5]); w.w = cvt_pk_bf16(vals[6], vals[7]);
        *(u32x4*)(j.dst + ((size_t)drow * 1024 + j.k0 + 8 * kc) * 2) = w; }
}

__global__ void __launch_bounds__(NWAVES * 64, 2) fwd(Args args) {
    extern __shared__ __attribute__((aligned(16))) unsigned char lds_raw[];
    LAS unsigned char* lds = (LAS unsigned char*)lds_raw;
    volatile LAS unsigned* LCTL = (volatile LAS unsigned*)(lds + LDSCTL_OFF);
    const int wave = __builtin_amdgcn_readfirstlane(threadIdx.x >> 6);
#define lane lane_id()
#define tid (wave * 64 + lane_id())
    const int G = gridDim.x, bx = blockIdx.x;
    unsigned char* ws = args.ws;
    unsigned* ctl = (unsigned*)(ws + WS_CTL);
    const int lo = args.ph_lo, hi = args.ph_hi;
#ifndef PHMASK
#define PHMASK 0xffffff
#endif
#ifndef DUPMASK
#define DUPMASK 0x0
#endif
#define IN(k) (((PHMASK >> (k)) & 1) && lo <= (k) && (k) < hi)
#define NREP(k) ((((DUPMASK) >> (k)) & 1) ? 2 : 1)
#define ENDBAR(k) (BOTH(k) || (((DUPMASK) >> (k)) & 1))
#define BOTH(k) (IN(k) && IN((k) + 1))
    for (int u = tid; u < (LDS_BYTES - LDSCTL_OFF) / 4; u += NWAVES * 64) LCTL[u] = 0u;
    __syncthreads();
    XcdBarrier bar; bar.bar = ctl + CW_BAR; bar.x = 0; bar.st = LCTL; bar.wave = wave;
    const bool multi = (hi - lo) > 1 || (args.pass_hi - args.pass_lo) > 1 || (IN(PH_G1) && IN(PH_G2));
    if (multi) bar = xcd_barrier_post(ctl + CW_BAR, LCTL, wave);
#define GRID_BAR() xcd_barrier(bar)

    const float* x = args.in[0]; const float* mem = args.in[1];
    bf16_t* XB = (bf16_t*)(ws + WS_XB); bf16_t* PROJ = (bf16_t*)(ws + WS_PROJ); bf16_t* CAT = (bf16_t*)(ws + WS_CAT);
    bf16_t* MEMB = (bf16_t*)(ws + WS_MEMB); bf16_t* KV = (bf16_t*)(ws + WS_KV); bf16_t* VT2 = (bf16_t*)(ws + WS_VT2); bf16_t* VT1 = (bf16_t*)(ws + WS_VT1); unsigned char* H1F = ws + WS_H1F;
    bf16_t* WIN = (bf16_t*)(ws + WS_WIN); bf16_t* WOUT = (bf16_t*)(ws + WS_WOUT); bf16_t* WCQ = (bf16_t*)(ws + WS_WCQ); bf16_t* WCKV = (bf16_t*)(ws + WS_WCKV);
    bf16_t* WCO = (bf16_t*)(ws + WS_WCO); bf16_t* WR = (bf16_t*)(ws + WS_WR); unsigned char* W1F = ws + WS_W1; unsigned char* W2F = ws + WS_W2; unsigned char* H2F = ws + WS_H2F;
    float* RSTDX = (float*)(ws + WS_RSTDX); float* RSTDM = (float*)(ws + WS_RSTDM); float* B1P = (float*)(ws + WS_B1P); float* MISC = (float*)(ws + WS_MISC); float* RSTD2 = (float*)(ws + WS_RSTD2);
    float* SSP1 = (float*)(ws + WS_SSP1); float* SSP2 = (float*)(ws + WS_SSP2); float* GATES = (float*)(ws + WS_GATES);
    unsigned* TOKMAP = (unsigned*)(ws + WS_TOKMAP); float* GATEV = (float*)(ws + WS_GATEV); unsigned* LIST = (unsigned*)(ws + WS_LIST);
    unsigned char* YB = ws + WS_Y; unsigned char* HID = ws + WS_HID;

    if (IN(PH_PREP)) for (int rep_ = 0; rep_ < NREP(PH_PREP); ++rep_) {
        constexpr int J0 = 768, J1 = J0 + 256, J2 = J1 + 256, J3 = J2 + 512, J4 = J3 + 256, J5 = J4 + 16384, J6 = J5 + 8192;
        auto decode = [&](int it, CJob& j) {
            if (it < J0) { j = CJob{args.in[3], args.in[2], (unsigned char*)WIN, DIN, (it / 48) * 64, (it % 48) * 64, 2, 0, 1.0f}; }
            else if (it < J1) { const int r = it - J0; j = CJob{args.in[14], nullptr, (unsigned char*)WOUT, 1024, (r / 16) * 64, (r % 16) * 64, 0, 0, 1.0f}; }
            else if (it < J2) { const int r = it - J1; j = CJob{args.in[17], args.in[15], (unsigned char*)WCQ, 1024, (r / 16) * 64, (r % 16) * 64, 0, 1, 64.0f}; }
            else if (it < J3) { const int r = it - J2; j = CJob{args.in[18], args.in[16], (unsigned char*)WCKV, 2048, (r / 32) * 64, (r % 32) * 64, 0, 1, 64.0f}; }
            else if (it < J4) { const int r = it - J3; j = CJob{args.in[19], nullptr, (unsigned char*)WCO, 1024, (r / 16) * 64, (r % 16) * 64, 0, 1, 64.0f}; }
            else if (it < J5) { const int r = it - J4; const int e = r >> 9, q = r & 511; j = CJob{args.in[23] + (size_t)e * 1024 * 2048, args.in[20], W1F + (size_t)e * 2048 * 1024, 2048, (q / 32) * 64, (q % 32) * 64, 1, 1, 64.0f}; }
            else { const int r = it - J5; const int e = r >> 8, q = r & 255; j = CJob{args.in[25] + (size_t)e * 1024 * 1024, nullptr, W2F + (size_t)e * 1024 * 1024, 1024, (q / 16) * 64, (q % 16) * 64, 0, 1, 64.0f}; } };
        for (int it0 = bx * 4; it0 < J6; it0 += G * 4) {
            CJob jb[4]; f32x4 v[4][2];
#pragma unroll
            for (int q = 0; q < 4; ++q) { decode(it0 + q < J6 ? it0 + q : J6 - 1, jb[q]); conv_load(jb[q], v[q], tid); }
#pragma unroll
            for (int q = 0; q < 4; ++q) conv_put((LAS float*)lds + q * (64 * 65), v[q], tid);
            __syncthreads();
#pragma unroll
            for (int q = 0; q < 4; ++q) if (it0 + q < J6) conv_store((const LAS float*)lds + q * (64 * 65), jb[q], tid);
            __syncthreads();
        }
        for (int i = bx * 512 + tid; i < NEXP * 1024; i += G * 512) { const int e = i >> 10, k = i & 1023; WR[i] = (bf16_t)f2bf(args.in[21][k * NEXP + e] * args.in[20][k]); }
        for (int i = bx * 512 + tid; i < NEXP * 2048; i += G * 512) { const int e = i >> 11, rho = i & 2047; const int pn = rho >> 8, s = (rho >> 7) & 1, ii = rho & 127; B1P[i] = args.in[24][e * 2048 + 2 * (128 * pn + ii) + s]; }
        if (bx == 0 && wave == 0) { const float a = wave_sum(args.in[9][lane] * args.in[10][lane]), b = wave_sum(args.in[11][lane] * args.in[12][lane]);
            if (lane == 0) MISC[0] = expf(a) - expf(b) + LAMBDA_INIT; }
        {
            const float* win = args.in[3]; const float* g = args.in[2];
            float wg[4][4][8];
#pragma unroll
            for (int jj = 0; jj < 4; ++jj)
#pragma unroll
                for (int q = 0; q < 4; ++q) { const int k = 4 * lane + 256 * jj + q; const float gk = g[k];
                    const f32x4 a = *(const f32x4*)(win + (size_t)k * DIN + 3072), b = *(const f32x4*)(win + (size_t)k * DIN + 3076);
#pragma unroll
                    for (int j = 0; j < 4; ++j) { wg[jj][q][j] = a[j] * gk; wg[jj][q][4 + j] = b[j] * gk; } }
            const int gw = bx * NWAVES + wave, NGW = G * NWAVES;
            f32x4 vn[4];
            if (gw < T) { const f32x4* xr = (const f32x4*)(x + (size_t)gw * DM) + lane;
#pragma unroll
                for (int jj = 0; jj < 4; ++jj) vn[jj] = xr[64 * jj]; }
            for (int row = gw; row < T; row += NGW) {
                f32x4 v[4]; float ss = 0.f; float d[8];
#pragma unroll
                for (int jj = 0; jj < 4; ++jj) v[jj] = vn[jj];
                if (row + NGW < T) { const f32x4* xr = (const f32x4*)(x + (size_t)(row + NGW) * DM) + lane;
#pragma unroll
                    for (int jj = 0; jj < 4; ++jj) vn[jj] = xr[64 * jj]; }
#pragma unroll
                for (int j = 0; j < 8; ++j) d[j] = 0.f;
#pragma unroll
                for (int jj = 0; jj < 4; ++jj) {
#pragma unroll
                    for (int q = 0; q < 4; ++q) { ss += v[jj][q] * v[jj][q];
#pragma unroll
                        for (int j = 0; j < 8; ++j) d[j] += v[jj][q] * wg[jj][q][j]; } }
                ss = wave_sum(ss);
#pragma unroll
                for (int j = 0; j < 8; ++j) d[j] = wave_sum(d[j]);
                const float rs = rsqrtf(ss * (1.0f / DM) + EPS);
                u32x2* o8 = (u32x2*)(XB + (size_t)row * DM) + lane;
#pragma unroll
                for (int jj = 0; jj < 4; ++jj) { u32x2 w; w.x = cvt_pk_bf16(v[jj][0], v[jj][1]); w.y = cvt_pk_bf16(v[jj][2], v[jj][3]); o8[64 * jj] = w; }
                if (lane == 0) RSTDX[row] = rs;
                if (lane < 8) { float dv = d[0];
#pragma unroll
                    for (int j = 1; j < 8; ++j) dv = (lane == j) ? d[j] : dv;
                    dv *= rs; float r;
                    if (lane < 4) r = dv + args.in[6][lane];
                    else { const float z = dv + args.in[7][lane - 4]; r = (z >= 0.f) ? -log1pf(expf(-z)) : (z - log1pf(expf(z))); }
                    GATES[(size_t)row * 8 + lane] = r; }
            }
            for (int row = gw; row < MROWS; row += NGW) {
                const f32x4* xr = (const f32x4*)(mem + (size_t)row * DM) + lane;
                f32x4 v[4]; float ss = 0.f;
#pragma unroll
                for (int jj = 0; jj < 4; ++jj) { v[jj] = xr[64 * jj]; ss += (v[jj][0] * v[jj][0] + v[jj][1] * v[jj][1]) + (v[jj][2] * v[jj][2] + v[jj][3] * v[jj][3]); }
                ss = wave_sum(ss);
                unsigned* o4 = (unsigned*)((unsigned char*)MEMB + (size_t)row * DM) + lane;
#pragma unroll
                for (int jj = 0; jj < 4; ++jj) { unsigned w = 0u; w = __builtin_amdgcn_cvt_pk_fp8_f32(c8(v[jj][0]), c8(v[jj][1]), w, false); w = __builtin_amdgcn_cvt_pk_fp8_f32(c8(v[jj][2]), c8(v[jj][3]), w, true); o4[64 * jj] = w; }
                if (lane == 0) RSTDM[row] = rsqrtf(ss * (1.0f / DM) + EPS);
            }
        }
        if (ENDBAR(PH_PREP)) GRID_BAR();
    }

    if (IN(PH_INPROJ)) for (int rep_ = 0; rep_ < NREP(PH_INPROJ); ++rep_) {
        { ProbScaleBf16 P{(LAS unsigned*)(lds + LDSCTL_OFF + 2048), XB, WIN, T / 256, NP2 / 256, G, bx, PROJ, NP2, RSTDX, nullptr};
          pg8::gemm_phase<ProbScaleBf16, true>(lds, P, wave); }
        { ProbColScaleBf16 P{WIN + (size_t)NP2 * 1024, XB, 4, T / 256, G, bx, VT1, T, RSTDX};
          pg8::gemm_phase<ProbColScaleBf16, true>(lds, P, wave); }
        if (ENDBAR(PH_INPROJ)) GRID_BAR();
    }

    const int vx = (G % 8 == 0) ? (bx % 8) * (G / 8) + bx / 8 : bx;
    bf16_t* QM = (bf16_t*)(ws + WS_QM); bf16_t* KM = (bf16_t*)(ws + WS_KM); bf16_t* CSTB = (bf16_t*)(ws + WS_CSTB);
    float* BC = (float*)(ws + WS_BC); float* AV = (float*)(ws + WS_AV); float* AM = (float*)(ws + WS_AM); float* NLOC = (float*)(ws + WS_NLOC); float* NST = (float*)(ws + WS_NST);
    float* CH = (float*)(ws + WS_CH); float* MSTATE = (float*)(ws + WS_MSTATE); float* CLOC = (float*)(ws + WS_MST);
    if (IN(PH_MIX0)) for (int rep_ = 0; rep_ < NREP(PH_MIX0); ++rep_) {
        mlstm_prep_phase(lds, PROJ, VT1, GATES, args.in[4], args.in[5], QM, KM, BC, AV, AM, CH, NLOC, CLOC, G, vx, wave);
        if (ENDBAR(PH_MIX0)) GRID_BAR();
    }
    if (IN(PH_MIX1)) for (int rep_ = 0; rep_ < NREP(PH_MIX1); ++rep_) {
        mlstm_scan_phase(CLOC, NLOC, CH, CSTB, NST, MSTATE, G, bx, tid);
        if (ENDBAR(PH_MIX1)) GRID_BAR();
    }
    if (IN(PH_MIX2)) for (int rep_ = 0; rep_ < NREP(PH_MIX2); ++rep_) {
        mlstm_out_phase(lds, PROJ, VT1, QM, KM, BC, AV, AM, CSTB, NST, MSTATE, args.in[8], CAT, G, vx, wave);
        __syncthreads();
        const float lam = __hip_atomic_load(MISC, __ATOMIC_RELAXED, __HIP_MEMORY_SCOPE_AGENT);
        diffattn_phase(lds, PROJ, VT1, args.in[13], lam, CAT, G, vx, wave);
        if (ENDBAR(PH_MIX2)) GRID_BAR();
    }

    if (IN(PH_OUTPROJ)) for (int rep_ = 0; rep_ < NREP(PH_OUTPROJ); ++rep_) {
        ProbResidT<false, true, false> P{(LAS unsigned*)(lds + LDSCTL_OFF + 2048), CAT, WOUT, T / 256, 4, G, bx, nullptr, XB, XB, H1F, SSP1};
        pg8::gemm_phase<ProbResidT<false, true, false>, true>(lds, P, wave);
        if (ENDBAR(PH_OUTPROJ)) GRID_BAR();
    }

    if (IN(PH_QKV)) for (int rep_ = 0; rep_ < NREP(PH_QKV); ++rep_) {
        { ProbScaleT<true> P{(LAS unsigned*)(lds + LDSCTL_OFF + 2048), H1F, WCQ, T / 256, 4, G, bx, PROJ, 1024, nullptr, SSP1};
          pg8::gemm_phase<ProbScaleT<true>, true>(lds, P, wave); }
        { ProbKV P{(LAS unsigned*)(lds + LDSCTL_OFF + 2048), (const unsigned char*)MEMB, (const unsigned char*)WCKV, KV, VT2, RSTDM, G, bx};
          pg8::gemm_phase<ProbKV, true>(lds, P, wave); }
        if (ENDBAR(PH_QKV)) GRID_BAR();
    }

    if (IN(PH_XATTN)) for (int rep_ = 0; rep_ < NREP(PH_XATTN); ++rep_) {
        xattn_phase(lds, PROJ, KV, VT2, (unsigned char*)(PROJ + (size_t)T * 1024), G, vx, wave);
        if (ENDBAR(PH_XATTN)) GRID_BAR();
    }

    if (IN(PH_COPROJ)) for (int rep_ = 0; rep_ < NREP(PH_COPROJ); ++rep_) {
        ProbResidT<true, false, false> P{(LAS unsigned*)(lds + LDSCTL_OFF + 2048), (unsigned char*)(PROJ + (size_t)T * 1024), WCO, T / 256, 4, G, bx, nullptr, XB, CAT, nullptr, SSP2};
        pg8::gemm_phase<ProbResidT<true, false, false>, true>(lds, P, wave);
        if (ENDBAR(PH_COPROJ)) GRID_BAR();
    }

    if (IN(PH_ROUTER)) for (int rep_ = 0; rep_ < NREP(PH_ROUTER); ++rep_) {
        { u32x4 wv[8];
#pragma unroll
          for (int q = 0; q < 8; ++q) { const int idx = q * (NWAVES * 64) + tid, ks = idx >> 6, ln = idx & 63; wv[q] = *(const u32x4*)(WR + (size_t)(ln & 31) * DM + 16 * ks + 8 * (ln >> 5)); }
#pragma unroll
          for (int q = 0; q < 8; ++q) { const int idx = q * (NWAVES * 64) + tid; *(LAS u32x4*)(lds + idx * 16) = wv[q]; } }
        __syncthreads();
        const float* brt = args.in[22];
        const int i = lane & 31, hh = lane >> 5;
        volatile LAS unsigned* lcnt = (volatile LAS unsigned*)(lds + 65536);
        const int ntrip = (T / 32 + G * NWAVES - 1) / (G * NWAVES);
        for (int trip = 0; trip < ntrip; ++trip) {
            const int tile = trip * G * NWAVES + bx * NWAVES + wave; const bool act = tile < T / 32;
            if (tid < 32) lcnt[tid] = 0u;
            __syncthreads();
            const int t = (act ? tile : 0) * 32 + i;
            const bf16_t* xp = CAT + (size_t)t * DM + 8 * hh;
            const f32x4 p0 = *(const f32x4*)(SSP2 + (size_t)t * 16 + 8 * hh), p1 = *(const f32x4*)(SSP2 + (size_t)t * 16 + 8 * hh + 4);
            float sp = (p0[0] + p0[1]) + (p0[2] + p0[3]) + (p1[0] + p1[1]) + (p1[2] + p1[3]); sp = x32_sum(sp);
            const float rs = rsqrtf(sp * (1.0f / DM) + EPS);
            f32x16 acc = zero16();
#pragma unroll 16
            for (int ks = 0; ks < 64; ++ks) { const bf16x8 xf = *(const bf16x8*)(xp + 16 * ks); const bf16x8 wf = *(const LAS bf16x8*)(lds + (ks * 64 + lane) * 16);
                acc = __builtin_amdgcn_mfma_f32_32x32x16_bf16(wf, xf, acc, 0, 0, 0);
                if (act) { const u32x4 xw = __builtin_bit_cast(u32x4, xf); unsigned w0 = 0u, w1 = 0u;
                    w0 = __builtin_amdgcn_cvt_pk_fp8_f32(lo_bf(xw.x) * rs, hi_bf(xw.x) * rs, w0, false); w0 = __builtin_amdgcn_cvt_pk_fp8_f32(lo_bf(xw.y) * rs, hi_bf(xw.y) * rs, w0, true);
                    w1 = __builtin_amdgcn_cvt_pk_fp8_f32(lo_bf(xw.z) * rs, hi_bf(xw.z) * rs, w1, false); w1 = __builtin_amdgcn_cvt_pk_fp8_f32(lo_bf(xw.w) * rs, hi_bf(xw.w) * rs, w1, true);
                    *(u32x2*)(H2F + (size_t)t * DM + 16 * ks + 8 * hh) = (u32x2){w0, w1}; } }
            float mine[16], oth[16];
#pragma unroll
            for (int r = 0; r < 16; ++r) { const int e = (r & 3) + 8 * (r >> 2); mine[r] = acc[r] * rs + brt[e + 4 * hh]; }
#pragma unroll
            for (int r = 0; r < 16; ++r) oth[r] = x32_other(mine[r], hh);
            float lg[NEXP];
#pragma unroll
            for (int r = 0; r < 16; ++r) { const int e = (r & 3) + 8 * (r >> 2); lg[e] = hh ? oth[r] : mine[r]; lg[e + 4] = hh ? mine[r] : oth[r]; }
            unsigned taken = 0u; float tv[4]; int te[4];
#pragma unroll
            for (int k = 0; k < TOPK; ++k) { float best = -INFINITY; int bi = 0;
#pragma unroll
                for (int e = 0; e < NEXP; ++e) { const bool ok = !((taken >> e) & 1u) && (lg[e] > best); best = ok ? lg[e] : best; bi = ok ? e : bi; }
                taken |= 1u << bi; tv[k] = best; te[k] = bi; }
            const float q1 = __expf(tv[1] - tv[0]), q2 = __expf(tv[2] - tv[0]), q3 = __expf(tv[3] - tv[0]); const float inv = 1.0f / (1.0f + q1 + q2 + q3);
            const float gk[4] = {inv, q1 * inv, q2 * inv, q3 * inv};
            unsigned lp[4] = {0u, 0u, 0u, 0u};
            if (act && hh == 0) {
#pragma unroll
                for (int k = 0; k < TOPK; ++k) lp[k] = __hip_atomic_fetch_add((LAS unsigned*)(lcnt + te[k]), 1u, __ATOMIC_RELAXED, __HIP_MEMORY_SCOPE_WORKGROUP); }
            __syncthreads();
            if (tid < 32) { const unsigned n = lcnt[tid]; lcnt[32 + tid] = n ? atomicAdd(&ctl[CW_CNT + tid], n) : 0u; }
            __syncthreads();
            if (act && hh == 0) { RSTD2[t] = rs;
                unsigned tm[4];
#pragma unroll
                for (int k = 0; k < TOPK; ++k) { const unsigned pos = lcnt[32 + te[k]] + lp[k]; LIST[(size_t)te[k] * T + pos] = (unsigned)t; tm[k] = ((unsigned)te[k] << 16) | pos; }
                *(u32x4*)(TOKMAP + (size_t)t * 4) = (u32x4){tm[0], tm[1], tm[2], tm[3]};
                *(f32x4*)(GATEV + (size_t)t * 4) = (f32x4){gk[0], gk[1], gk[2], gk[3]}; }
            __syncthreads();
        }
        if (ENDBAR(PH_ROUTER)) GRID_BAR();
    }

    volatile LAS int* tab = (volatile LAS int*)(LCTL + 16);
    int Rtot = 0;
    if (IN(PH_G1) || IN(PH_G2) || IN(PH_COMBINE)) {
        if (tid < NEXP) tab[MOE_CNT + tid] = (int)__hip_atomic_load(&ctl[CW_CNT + tid], __ATOMIC_RELAXED, __HIP_MEMORY_SCOPE_AGENT);
        __syncthreads();
        if (tid == 0) { int ts = 0, st = 0;
            for (int e = 0; e < NEXP; ++e) { const int c = tab[MOE_CNT + e]; tab[MOE_TS + e] = ts; tab[MOE_ST + e] = st; ts += (c + 255) >> 8; st += c; }
            tab[MOE_TS + NEXP] = ts; tab[MOE_ST + NEXP] = st; }
        __syncthreads();
        Rtot = tab[MOE_TS + NEXP];
    }
    if (IN(PH_G1) || IN(PH_G2)) {
        __syncthreads();
        for (int rt = tid; rt < Rtot; rt += NWAVES * 64) { int e = 0;
            for (int j = 1; j < NEXP; ++j) if (rt >= tab[MOE_TS + j]) e = j;
            ((volatile LAS unsigned char*)(tab + MOE_RTE))[rt] = (unsigned char)e; }
        __syncthreads();
        if (IN(PH_G1)) for (int rep_ = 0; rep_ < NREP(PH_G1); ++rep_) { ProbMoe1 P{H2F, W1F, B1P, RSTD2, LIST, HID, tab, (LAS unsigned*)(lds + LDSCTL_OFF + 2048), 0, Rtot, G, bx};
            pg8::gemm_phase<ProbMoe1, true>(lds, P, wave);
            if (IN(PH_G2) || NREP(PH_G1) > 1) GRID_BAR(); }
        if (IN(PH_G2)) for (int rep_ = 0; rep_ < NREP(PH_G2); ++rep_) { ProbMoe2 P{HID, W2F, args.in[26], YB, tab, (LAS unsigned*)(lds + LDSCTL_OFF + 2048), 0, Rtot, G, bx};
            pg8::gemm_phase<ProbMoe2, true>(lds, P, wave);
            if (IN(PH_COMBINE) || NREP(PH_G2) > 1) GRID_BAR(); }
    }
    if (IN(PH_COMBINE)) {
        const float* gf = args.in[27];
        const int gw = bx * NWAVES + wave, NGW = G * NWAVES;
        f32x4 gfv[4];
#pragma unroll
        for (int jj = 0; jj < 4; ++jj) gfv[jj] = *((const f32x4*)gf + 4 * lane + jj);
        u32x4 tmn = (u32x4){0u, 0u, 0u, 0u}; f32x4 gkn = (f32x4){0.f, 0.f, 0.f, 0.f};
        if (gw < T) { tmn = *(const u32x4*)(TOKMAP + (size_t)gw * 4); gkn = *(const f32x4*)(GATEV + (size_t)gw * 4); }
        for (int t = gw; t < T; t += NGW) {
            const u32x4 tm = tmn; const f32x4 gk = gkn;
            if (t + NGW < T) { tmn = *(const u32x4*)(TOKMAP + (size_t)(t + NGW) * 4); gkn = *(const f32x4*)(GATEV + (size_t)(t + NGW) * 4); }
            const u32x4* hb = (const u32x4*)(CAT + (size_t)t * DM) + 2 * lane;
            const u32x4 h0 = hb[0], h1 = hb[1];
            u32x4 yv[4];
#pragma unroll
            for (int k = 0; k < TOPK; ++k) { const int e = (int)(tm[k] >> 16), pos = (int)(tm[k] & 0xffffu); const size_t yrow = (size_t)(tab[MOE_ST + e] + pos);
                yv[k] = *((const u32x4*)(YB + yrow * DM) + lane); }
            float v[16];
            v[0] = lo_bf(h0.x); v[1] = hi_bf(h0.x); v[2] = lo_bf(h0.y); v[3] = hi_bf(h0.y); v[4] = lo_bf(h0.z); v[5] = hi_bf(h0.z); v[6] = lo_bf(h0.w); v[7] = hi_bf(h0.w);
            v[8] = lo_bf(h1.x); v[9] = hi_bf(h1.x); v[10] = lo_bf(h1.y); v[11] = hi_bf(h1.y); v[12] = lo_bf(h1.z); v[13] = hi_bf(h1.z); v[14] = lo_bf(h1.w); v[15] = hi_bf(h1.w);
#pragma unroll
            for (int k = 0; k < TOPK; ++k) { const float g16 = gk[k] * (1.0f / 16.0f);
#pragma unroll
                for (int q = 0; q < 4; ++q) { const f32x2 a = __builtin_amdgcn_cvt_pk_f32_fp8((int)yv[k][q], false), b2_ = __builtin_amdgcn_cvt_pk_f32_fp8((int)yv[k][q], true);
                    v[4 * q] += g16 * a[0]; v[4 * q + 1] += g16 * a[1]; v[4 * q + 2] += g16 * b2_[0]; v[4 * q + 3] += g16 * b2_[1]; } }
            float ss = 0.f;
#pragma unroll
            for (int q = 0; q < 16; ++q) ss += v[q] * v[q];
            ss = wave_sum(ss); const float rs = rsqrtf(ss * (1.0f / DM) + EPS);
            f32x4* orow = (f32x4*)(args.out + (size_t)t * DM) + 4 * lane;
#pragma unroll
            for (int jj = 0; jj < 4; ++jj) orow[jj] = (f32x4){v[4 * jj] * rs * gfv[jj][0], v[4 * jj + 1] * rs * gfv[jj][1], v[4 * jj + 2] * rs * gfv[jj][2], v[4 * jj + 3] * rs * gfv[jj][3]};
        }
    }
#undef IN
#undef BOTH
#undef GRID_BAR
#undef lane
#undef tid
}

extern "C" void kernel_launch(void* const* d_in, const int* in_sizes, int n_in, void* d_out, int out_size, void* d_ws, size_t ws_size, hipStream_t stream) {
    static int grid = 0;
    if (grid == 0) {
        if (n_in != 28 || out_size != T * DM || ws_size < WS_END) { fprintf(stderr, "kernel_launch: unexpected shapes: n_in %d out %d ws %zu\n", n_in, out_size, ws_size); grid = -1; return; }
        int dev = 0, cus = 0;
        if (hipGetDevice(&dev) != hipSuccess || hipDeviceGetAttribute(&cus, hipDeviceAttributeMultiprocessorCount, dev) != hipSuccess) { grid = -1; return; }
        if (hipFuncSetAttribute((const void*)fwd, hipFuncAttributeMaxDynamicSharedMemorySize, LDS_BYTES) != hipSuccess) { fprintf(stderr, "kernel_launch: hipFuncSetAttribute failed\n"); grid = -1; return; }
        int per_cu = 0;
        if (hipOccupancyMaxActiveBlocksPerMultiprocessor(&per_cu, (const void*)fwd, NWAVES * 64, LDS_BYTES) != hipSuccess || per_cu < 1) fprintf(stderr, "kernel_launch: occupancy query says %d\n", per_cu);
        (void)hipGetLastError();
        grid = cus;
    }
    if (grid < 0) return;
    (void)hipMemsetAsync((char*)d_ws + WS_CTL, 0, CTL_ZERO_BYTES, stream);
    Args a{};
    for (int i = 0; i < 28; ++i) a.in[i] = (const float*)d_in[i];
    a.out = (float*)d_out; a.ws = (unsigned char*)d_ws;
    unsigned char* ws = (unsigned char*)d_ws;
    auto run = [&](int lo, int hi, int p0, int p1) { a.ph_lo = lo; a.ph_hi = hi; a.pass_lo = p0; a.pass_hi = p1; hipLaunchKernelGGL(fwd, dim3(grid), dim3(NWAVES * 64), LDS_BYTES, stream, a); };
#ifdef MULTI_LAUNCH
    for (int ph = 0; ph < PH_G1; ++ph) run(ph, ph + 1, 0, 0);
    run(PH_G1, PH_G1 + 1, 0, 1); run(PH_G2, PH_G2 + 1, 0, 1);
    run(PH_COMBINE, PH_COMBINE + 1, 0, 0);
#else
    run(0, PH_END, 0, 5);
#endif
}
```

```cpp
#include <hip/hip_runtime.h>
#include <cstdio>
#include <cstdint>
#include <cmath>

#define GAS __attribute__((address_space(1)))
#define LAS __attribute__((address_space(3)))
typedef unsigned short bf16_t;
typedef short bf16x8 __attribute__((ext_vector_type(8)));
typedef float f32x4 __attribute__((ext_vector_type(4)));
typedef float f32x2 __attribute__((ext_vector_type(2)));
typedef unsigned u32x4 __attribute__((ext_vector_type(4)));
typedef unsigned u32x2 __attribute__((ext_vector_type(2)));
typedef int i32x8 __attribute__((ext_vector_type(8)));
typedef int i32x4 __attribute__((ext_vector_type(4)));

constexpr int BATCH = 32, SEQ = 2048, DM = 1024, T = BATCH * SEQ, MEMLEN = 256, MROWS = BATCH * MEMLEN;
constexpr int NPROJ = 3072, DIN = 3080, NP2 = 2048;
constexpr int NEXP = 32, TOPK = 4;
constexpr float EPS = 1e-5f;
constexpr float LAMBDA_INIT = 0.2f;

constexpr size_t MiB = 1u << 20;
constexpr size_t WS_CTL = 0, CTL_ZERO_BYTES = 64 * 1024;
constexpr size_t WS_RSTDX = 1 * MiB;
constexpr size_t WS_RSTDM = WS_RSTDX + (size_t)T * 4;
constexpr size_t WS_B1P = WS_RSTDM + (size_t)MROWS * 4;
constexpr size_t WS_MISC = WS_B1P + (size_t)NEXP * 2048 * 4;
constexpr size_t WS_RSTD2 = WS_MISC + 4096;
static_assert(WS_RSTD2 + (size_t)T * 4 <= 2 * MiB, "small region");
constexpr size_t WS_SSP1 = 2 * MiB;
constexpr size_t WS_SSP2 = 6 * MiB;
constexpr size_t WS_GATES = 10 * MiB;
constexpr size_t WS_TOKMAP = 12 * MiB;
constexpr size_t WS_GATEV = 13 * MiB;
constexpr size_t WS_LIST = 14 * MiB;
constexpr size_t WS_WIN = 24 * MiB;
constexpr size_t WS_WOUT = 30 * MiB;
constexpr size_t WS_WCQ = 32 * MiB;
constexpr size_t WS_WCKV = 34 * MiB;
constexpr size_t WS_WCO = 38 * MiB;
constexpr size_t WS_WR = 40 * MiB;
constexpr size_t WS_W1 = 64 * MiB;
constexpr size_t WS_H2F = 128 * MiB;
constexpr size_t WS_W2 = 192 * MiB;
constexpr size_t WS_XB = 256 * MiB;
constexpr size_t WS_PROJ = 384 * MiB;
constexpr size_t WS_H1F = 640 * MiB;
constexpr size_t WS_VT1 = 640 * MiB;
constexpr size_t WS_CAT = 768 * MiB;
constexpr size_t WS_MST = 896 * MiB;
constexpr size_t WS_MEMB = 962 * MiB;
constexpr size_t WS_KV = 978 * MiB;
constexpr size_t WS_VT2 = 994 * MiB;
constexpr size_t WS_QM = 128 * MiB;
constexpr size_t WS_KM = 160 * MiB;
constexpr size_t WS_CSTB = 224 * MiB;
constexpr size_t WS_BC = 1010 * MiB;
constexpr size_t WS_AV = 1011 * MiB;
constexpr size_t WS_AM = 1012 * MiB;
constexpr size_t WS_NLOC = 1013 * MiB;
constexpr size_t WS_NST = WS_NLOC + 512 * 1024;
constexpr size_t WS_CH = 1014 * MiB;
constexpr size_t WS_MSTATE = WS_CH + 64 * 1024;
constexpr size_t WS_Y = 256 * MiB;
constexpr size_t WS_HID = 512 * MiB;
constexpr size_t WS_HID1 = 896 * MiB;
constexpr size_t WS_END = 1024 * MiB;

constexpr int CW_CNT = 64;
constexpr int CW_BAR = 4096;
static_assert((CW_BAR + 3456) * 4 <= (int)CTL_ZERO_BYTES, "control words inside the per-call memset");

__device__ __forceinline__ float bf2f(bf16_t b) { return __uint_as_float(((unsigned)b) << 16); }
__device__ __forceinline__ unsigned f2bf(float f) { unsigned u = __float_as_uint(f); return (u + 0x7fffu + ((u >> 16) & 1u)) >> 16; }
__device__ __forceinline__ unsigned cvt_pk_bf16(float lo, float hi) { unsigned r; asm volatile("v_cvt_pk_bf16_f32 %0, %1, %2" : "=v"(r) : "v"(lo), "v"(hi)); return r; }
__device__ __forceinline__ float x32_sum(float v) { auto r = __builtin_amdgcn_permlane32_swap(__float_as_uint(v), __float_as_uint(v), false, false); return __uint_as_float(r[0]) + __uint_as_float(r[1]); }
__device__ __forceinline__ float x32_max(float v) { auto r = __builtin_amdgcn_permlane32_swap(__float_as_uint(v), __float_as_uint(v), false, false); return fmaxf(__uint_as_float(r[0]), __uint_as_float(r[1])); }
__device__ __forceinline__ float x32_other(float v, int hh) { auto r = __builtin_amdgcn_permlane32_swap(__float_as_uint(v), __float_as_uint(v), false, false); return hh ? __uint_as_float(r[0]) : __uint_as_float(r[1]); }
__device__ __forceinline__ float x16_sum(float v) { auto r = __builtin_amdgcn_permlane16_swap(__float_as_uint(v), __float_as_uint(v), false, false); return __uint_as_float(r[0]) + __uint_as_float(r[1]); }
__device__ __forceinline__ float row16_sum(float v) {
    v += __uint_as_float((unsigned)__builtin_amdgcn_update_dpp(0, (int)__float_as_uint(v), 0xB1, 0xf, 0xf, true));
    v += __uint_as_float((unsigned)__builtin_amdgcn_update_dpp(0, (int)__float_as_uint(v), 0x4E, 0xf, 0xf, true));
    v += __uint_as_float((unsigned)__builtin_amdgcn_update_dpp(0, (int)__float_as_uint(v), 0x141, 0xf, 0xf, true));
    v += __uint_as_float((unsigned)__builtin_amdgcn_update_dpp(0, (int)__float_as_uint(v), 0x140, 0xf, 0xf, true));
    return v; }
__device__ __forceinline__ float wave_sum(float v) { return x32_sum(x16_sum(row16_sum(v))); }
__device__ __forceinline__ int lane_id() { int l; asm volatile("v_mbcnt_lo_u32_b32 %0, -1, 0\n\tv_mbcnt_hi_u32_b32 %0, -1, %0" : "=v"(l)); return l; }
__device__ __forceinline__ float c8(float x) { return __builtin_amdgcn_fmed3f(x, -448.0f, 448.0f); }
__device__ __forceinline__ float lo_bf(unsigned w) { return __uint_as_float(w << 16); }
__device__ __forceinline__ float hi_bf(unsigned w) { return __uint_as_float(w & 0xffff0000u); }

namespace pg8 {
constexpr int BM = 256, BK = 64, HALF = 128, HTB = HALF * BK * 2, STAGE_BYTES = 8 * HTB, NXCD = 8, WGM = 8, KD = 1024, NT = KD / BK;
__host__ __device__ __forceinline__ int lds_byte(int r, int c) { const int st = (r >> 4) * 2 + (c >> 5), rr = r & 15, cc = c & 31, ob = rr * 64 + cc * 2; return st * 1024 + (ob ^ (((ob >> 9) & 1) << 5)); }
__host__ __device__ __forceinline__ void stage_rc(int b, int& R, int& C) { const int st = b / 1024, sb = b % 1024, swz = sb ^ (((sb >> 9) & 1) << 5); R = (st >> 1) * 16 + swz / 64; C = (st & 1) * 32 + (swz % 64) / 2; }
__host__ __device__ __forceinline__ int perm32(int rho) { const int n = rho >> 4, i = rho & 15; return 8 * (i >> 2) + 4 * n + (i & 3); }

struct Unit { const char* A; const char* B; int pm, pn, e, nvalid, y0, aux; };

__device__ __forceinline__ bool static_next(int i, int G, int c, int nM, int nN, int& pm, int& pn) {
    const int nwg = nM * nN; const long L = (long)i * G + c; if (L >= nwg) return false;
    int wgid = (int)L; { const int q = nwg / NXCD, r = nwg % NXCD, xcd = wgid % NXCD, off = wgid / NXCD; wgid = (xcd < r ? xcd * (q + 1) : r * (q + 1) + (xcd - r) * q) + off; }
    const int nig = WGM * nN, gid = wgid / nig, fm = gid * WGM, gsz = (nM - fm) < WGM ? (nM - fm) : WGM;
    pm = fm + ((wgid % nig) % gsz); pn = (wgid % nig) / gsz; return true;
}

template <class P, bool ALIGN_EPI>
__device__ __forceinline__ void gemm_phase(LAS unsigned char* lds, const P& prob, const int wid) {
    const int lane = lane_id(), tid = wid * 64 + lane, wr = wid >> 2, wc = wid & 3, fr = lane & 15, fq = lane >> 4;
    constexpr int ROWB = P::FP8 ? KD : 2 * KD;
    constexpr int nt = ROWB / 128;
    int RA[2], CA[2]; unsigned voffA[2], voffB[2];
#pragma unroll
    for (int i = 0; i < 2; ++i) { int R, C; stage_rc(tid * 16 + i * 8192, R, C); const int Rb = P::PERM ? ((R & ~31) + perm32(R & 31)) : R;
        RA[i] = R; CA[i] = C * 2; voffA[i] = (unsigned)(R * ROWB + C * 2); voffB[i] = (unsigned)(Rb * ROWB + C * 2); }
    constexpr int kstep = BK * 2;
    constexpr size_t hstep = (size_t)HALF * ROWB;
    const unsigned ldsw = (unsigned)wid * 1024u;
    const int aoff = lds_byte(wr * 64 + fr, fq * 8), boff = lds_byte(wc * 32 + fr, fq * 8);
#define PG8_SA(b, h) (((b) * 2 + (h)) * HTB)
#define PG8_SB(b, h) ((4 + (b) * 2 + (h)) * HTB)
#define PG8_STAGE_B(bufoff, gbase) do { _Pragma("unroll") for (int _i = 0; _i < 2; ++_i) \
        __builtin_amdgcn_global_load_lds((const unsigned*)((const char*)(gbase) + voffB[_i]), (LAS unsigned*)(lds + (bufoff) + ldsw + _i * 8192), 16, 0, 0); } while (0)
#define PG8_STAGE_A(bufoff, gbase, off, h) do { _Pragma("unroll") for (int _i = 0; _i < 2; ++_i) { const char* _p; \
        if constexpr (P::GATHER) _p = (const char*)(gbase) + (off)[h][_i]; else _p = (const char*)(gbase) + (size_t)(h) * hstep + voffA[_i]; \
        __builtin_amdgcn_global_load_lds((const unsigned*)_p, (LAS unsigned*)(lds + (bufoff) + ldsw + _i * 8192), 16, 0, 0); } } while (0)
#define PG8_LDA(dst, b, h) do { _Pragma("unroll") for (int m = 0; m < 4; ++m) _Pragma("unroll") for (int k = 0; k < 2; ++k) dst[m][k] = *(const LAS bf16x8*)(lds + PG8_SA(b, h) + aoff + m * 2048 + k * 1024); } while (0)
#define PG8_LDB(dst, b, h) do { _Pragma("unroll") for (int n = 0; n < 2; ++n) _Pragma("unroll") for (int k = 0; k < 2; ++k) dst[n][k] = *(const LAS bf16x8*)(lds + PG8_SB(b, h) + boff + n * 2048 + k * 1024); } while (0)
#define PG8_MMA(ai, bj, At, Bt) do { __builtin_amdgcn_s_setprio(1); _Pragma("unroll") for (int m = 0; m < 4; ++m) _Pragma("unroll") for (int n = 0; n < 2; ++n) { \
        if constexpr (P::FP8) { const i32x4 b0_ = __builtin_bit_cast(i32x4, Bt[n][0]), b1_ = __builtin_bit_cast(i32x4, Bt[n][1]), a0_ = __builtin_bit_cast(i32x4, At[m][0]), a1_ = __builtin_bit_cast(i32x4, At[m][1]); \
            acc[ai][bj][m][n] = __builtin_amdgcn_mfma_scale_f32_16x16x128_f8f6f4((i32x8){b0_[0], b0_[1], b0_[2], b0_[3], b1_[0], b1_[1], b1_[2], b1_[3]}, (i32x8){a0_[0], a0_[1], a0_[2], a0_[3], a1_[0], a1_[1], a1_[2], a1_[3]}, \
                acc[ai][bj][m][n], 0, 0, 0, 0x7f7f7f7f, 0, 0x7f7f7f7f); } \
        else { _Pragma("unroll") for (int k = 0; k < 2; ++k) acc[ai][bj][m][n] = __builtin_amdgcn_mfma_f32_16x16x32_bf16(Bt[n][k], At[m][k], acc[ai][bj][m][n], 0, 0, 0); } } \
        __builtin_amdgcn_s_setprio(0); } while (0)
#define PG8_WAIT_V(n) asm volatile("s_waitcnt vmcnt(" #n ")" ::: "memory")
#define PG8_WAIT_L(n) asm volatile("s_waitcnt lgkmcnt(" #n ")" ::: "memory")
#define PG8_BAR __builtin_amdgcn_s_barrier()
#define PG8_SCHED __builtin_amdgcn_sched_barrier(0)
    Unit cur, nxt; int ui = 0;
    if (!prob.next(0, cur)) return;
    f32x4 acc[2][2][4][2];
#pragma unroll
    for (int a = 0; a < 2; ++a)
#pragma unroll
        for (int b = 0; b < 2; ++b)
#pragma unroll
            for (int m = 0; m < 4; ++m)
#pragma unroll
                for (int n = 0; n < 2; ++n) acc[a][b][m][n] = (f32x4){0.f, 0.f, 0.f, 0.f};
    bf16x8 At[4][2], B0[2][2], B1[2][2];
    unsigned offC[2][2] = {{0u, 0u}, {0u, 0u}};
#define PG8_FILL(u, buf) do { if (tid < 256) prob.gtab[(buf) * 256 + tid] = prob.a_off(u, tid); } while (0)
#define PG8_OFFS(buf) do { _Pragma("unroll") for (int _h = 0; _h < 2; ++_h) _Pragma("unroll") for (int _i = 0; _i < 2; ++_i) offC[_h][_i] = prob.gtab[(buf) * 256 + _h * HALF + RA[_i]] + (unsigned)CA[_i]; } while (0)
    Unit nx2;
    bool has_next = prob.next(1, nxt);
    if constexpr (P::GATHER) { PG8_FILL(cur, 0); if (has_next) PG8_FILL(nxt, 1); PG8_WAIT_L(0); PG8_BAR; PG8_OFFS(0); }
    const char* cA = prob.a_tile(cur); const char* cB = cur.B;
    PG8_STAGE_B(PG8_SB(0, 0), cB); PG8_STAGE_B(PG8_SB(0, 1), cB + hstep); PG8_STAGE_A(PG8_SA(0, 0), cA, offC, 0); PG8_STAGE_A(PG8_SA(0, 1), cA, offC, 1);
    if (wr == 1) PG8_BAR;
    PG8_WAIT_V(2); PG8_BAR;
    PG8_STAGE_B(PG8_SB(1, 0), cB + kstep); PG8_STAGE_A(PG8_SA(1, 0), cA + kstep, offC, 0); PG8_STAGE_B(PG8_SB(1, 1), cB + hstep + kstep);
    PG8_WAIT_V(6); PG8_BAR;
    int bcur = 0;
    for (;;) {
        const bool has_nx2 = has_next && prob.next(ui + 2, nx2);
        const char* nA = has_next ? prob.a_tile(nxt) : cA; const char* nB = has_next ? nxt.B : cB;
        const int bnext = bcur == 2 ? 0 : bcur + 1, bnx2 = bnext == 2 ? 0 : bnext + 1;
#pragma unroll 1
        for (int t = 0; t < nt; t += 2) {
            const bool last = (t == nt - 2);
            const char* a1 = cA + (size_t)(t + 1) * kstep;
            const char* a2 = last ? nA : cA + (size_t)(t + 2) * kstep; const char* b2 = last ? nB : cB + (size_t)(t + 2) * kstep;
            const char* a3 = a2 + kstep; const char* b3 = b2 + kstep;
            PG8_LDB(B0, 0, 0); PG8_LDB(B1, 0, 1); PG8_SCHED; PG8_LDA(At, 0, 0); PG8_STAGE_A(PG8_SA(1, 1), a1, offC, 1);
            if constexpr (P::GATHER) { if (last && has_next) PG8_OFFS(bnext); }
            PG8_WAIT_V(8); PG8_WAIT_L(0); PG8_BAR; PG8_MMA(0, 0, At, B0); PG8_MMA(0, 1, At, B1); PG8_BAR; PG8_SCHED;
            PG8_LDA(At, 0, 1); PG8_STAGE_B(PG8_SB(0, 0), b2); PG8_STAGE_B(PG8_SB(0, 1), b2 + hstep); PG8_STAGE_A(PG8_SA(0, 0), a2, offC, 0);
            PG8_WAIT_V(8); PG8_WAIT_L(0); PG8_BAR; PG8_MMA(1, 0, At, B0); PG8_MMA(1, 1, At, B1); PG8_BAR; PG8_SCHED;
            PG8_LDB(B0, 1, 0); PG8_LDB(B1, 1, 1); PG8_SCHED; PG8_LDA(At, 1, 0); PG8_STAGE_A(PG8_SA(0, 1), a2, offC, 1);
            PG8_WAIT_V(8); PG8_WAIT_L(0); PG8_BAR; PG8_MMA(0, 0, At, B0); PG8_MMA(0, 1, At, B1); PG8_BAR; PG8_SCHED;
            PG8_LDA(At, 1, 1); PG8_STAGE_B(PG8_SB(1, 0), b3); PG8_STAGE_B(PG8_SB(1, 1), b3 + hstep); PG8_STAGE_A(PG8_SA(1, 0), a3, offC, 0);
            PG8_WAIT_V(8); PG8_WAIT_L(0); PG8_BAR; PG8_MMA(1, 0, At, B0); PG8_MMA(1, 1, At, B1); PG8_BAR; PG8_SCHED;
        }
        if constexpr (ALIGN_EPI) { if (wr == 0) PG8_BAR; }
        if constexpr (P::GATHER) { if (has_nx2) PG8_FILL(nx2, bnx2); }
        cur.aux = bcur;
        prob.epi(acc, cur, wr, wc, fr, fq);
        if (!has_next) break;
#pragma unroll
        for (int a = 0; a < 2; ++a)
#pragma unroll
            for (int b = 0; b < 2; ++b)
#pragma unroll
                for (int m = 0; m < 4; ++m)
#pragma unroll
                    for (int n = 0; n < 2; ++n) acc[a][b][m][n] = (f32x4){0.f, 0.f, 0.f, 0.f};
        cur = nxt; nxt = nx2; has_next = has_nx2; cA = nA; cB = nB; ++ui; bcur = bnext;
        if constexpr (ALIGN_EPI) { if (wr == 1) PG8_BAR; }
    }
    PG8_WAIT_V(0);
    if constexpr (!ALIGN_EPI) { if (wr == 0) PG8_BAR; }
    PG8_BAR;
#undef PG8_SA
#undef PG8_SB
#undef PG8_STAGE_A
#undef PG8_STAGE_B
#undef PG8_LDA
#undef PG8_LDB
#undef PG8_MMA
#undef PG8_WAIT_V
#undef PG8_WAIT_L
#undef PG8_BAR
#undef PG8_SCHED
#undef PG8_OFFS
#undef PG8_FILL
}
}

template <bool F8> struct ProbScaleT {
    static constexpr bool FP8 = F8, PERM = true, GATHER = F8;
    static constexpr int RB = F8 ? 1024 : 2048;
    __device__ __forceinline__ const char* a_tile(const pg8::Unit& u) const { return F8 ? u.A : u.A + (size_t)u.pm * (256 * RB); }
    LAS unsigned* gtab;
    const void* A; const void* Bt; int nM, nN, G, c;
    bf16_t* O; int ldo; const float* rstd; const float* ssp;
    __device__ __forceinline__ bool next(int i, pg8::Unit& u) const {
        int pm, pn; if (!pg8::static_next(i, G, c, nM, nN, pm, pn)) return false;
        u.A = (const char*)A; u.B = (const char*)Bt + (size_t)pn * 256 * RB; u.pm = pm; u.pn = pn; u.e = 0; u.nvalid = 256; u.y0 = 0; u.aux = 0; return true; }
    __device__ __forceinline__ unsigned a_off(const pg8::Unit& u, int r) const { return (unsigned)(u.pm * 256 + r) * (unsigned)RB; }
    __device__ __forceinline__ void epi(const f32x4 (&acc)[2][2][4][2], const pg8::Unit& u, int wr, int wc, int fr, int fq) const {
        asm volatile("" : "+v"(fr), "+v"(fq));
        const int rowu = u.pm * 256 + wr * 64;
        char* ub = (char*)O + ((size_t)rowu * ldo + u.pn * 256 + wc * 32) * 2;
        const unsigned lo = (unsigned)(fr * ldo + 8 * fq) * 2u;
        float rsv[8];
        if (rstd) {
#pragma unroll
            for (int q = 0; q < 8; ++q) rsv[q] = rstd[rowu + fr + (q >> 2) * 128 + (q & 3) * 16];
        } else { f32x4 pv[8];
#pragma unroll
            for (int q = 0; q < 8; ++q) pv[q] = *(const f32x4*)(ssp + (size_t)(rowu + fr + (q >> 2) * 128 + (q & 3) * 16) * 16 + fq * 4);
#pragma unroll
            for (int q = 0; q < 8; ++q) { float sq = (pv[q][0] + pv[q][1]) + (pv[q][2] + pv[q][3]); sq = x16_sum(sq); sq = x32_sum(sq); rsv[q] = rsqrtf(sq * (1.0f / 1024.0f) + EPS); } }
#pragma unroll
        for (int ai = 0; ai < 2; ++ai)
#pragma unroll
            for (int m = 0; m < 4; ++m) { const float rs = rsv[ai * 4 + m] * (F8 ? (1.0f / 64.0f) : 1.0f);
                char* rowp = ub + (size_t)(ai * 128 + m * 16) * ldo * 2 + lo;
#pragma unroll
                for (int bj = 0; bj < 2; ++bj) { const f32x4 v0 = acc[ai][bj][m][0] * rs, v1 = acc[ai][bj][m][1] * rs;
                    u32x4 w; w.x = cvt_pk_bf16(v0[0], v0[1]); w.y = cvt_pk_bf16(v0[2], v0[3]); w.z = cvt_pk_bf16(v1[0], v1[1]); w.w = cvt_pk_bf16(v1[2], v1[3]);
                    *(u32x4*)(rowp + bj * 256) = w; } }
    }
};
typedef ProbScaleT<false> ProbScaleBf16;
struct ProbColScaleBf16 {
    static constexpr bool FP8 = false, PERM = true, GATHER = false;
    __device__ __forceinline__ const char* a_tile(const pg8::Unit& u) const { return u.A + (size_t)u.pm * (256 * 2048); }
    const bf16_t* A; const bf16_t* Bt; int nM, nN, G, c;
    bf16_t* O; int ldo; const float* cs;
    __device__ __forceinline__ bool next(int i, pg8::Unit& u) const {
        const long L = (long)i * G + c; if (L >= (long)nM * nN) return false;
        const int pm = (int)(L % nM), pn = (int)(L / nM);
        u.A = (const char*)A; u.B = (const char*)(Bt + (size_t)pn * 256 * 1024); u.pm = pm; u.pn = pn; u.e = 0; u.nvalid = 256; u.y0 = 0; u.aux = 0; return true; }
    __device__ __forceinline__ unsigned a_off(const pg8::Unit& u, int r) const { return 0u; }
    __device__ __forceinline__ void epi(const f32x4 (&acc)[2][2][4][2], const pg8::Unit& u, int wr, int wc, int fr, int fq) const {
        asm volatile("" : "+v"(fr), "+v"(fq));
        const float* cp = cs + u.pn * 256 + wc * 32 + 8 * fq;
        f32x4 sc[2][2];
#pragma unroll
        for (int bj = 0; bj < 2; ++bj)
#pragma unroll
            for (int n = 0; n < 2; ++n) sc[bj][n] = *(const f32x4*)(cp + bj * 128 + 4 * n);
        char* ub = (char*)O + ((size_t)(u.pm * 256 + wr * 64) * ldo + u.pn * 256 + wc * 32) * 2;
        const unsigned lo = (unsigned)(fr * ldo + 8 * fq) * 2u;
#pragma unroll
        for (int ai = 0; ai < 2; ++ai)
#pragma unroll
            for (int m = 0; m < 4; ++m) { char* rowp = ub + (size_t)(ai * 128 + m * 16) * ldo * 2 + lo;
#pragma unroll
                for (int bj = 0; bj < 2; ++bj) { const f32x4 v0 = acc[ai][bj][m][0] * sc[bj][0], v1 = acc[ai][bj][m][1] * sc[bj][1];
                    u32x4 w; w.x = cvt_pk_bf16(v0[0], v0[1]); w.y = cvt_pk_bf16(v0[2], v0[3]); w.z = cvt_pk_bf16(v1[0], v1[1]); w.w = cvt_pk_bf16(v1[2], v1[3]);
                    *(u32x4*)(rowp + bj * 256) = w; } }
    }
};
struct ProbKV {
    static constexpr bool FP8 = true, PERM = true, GATHER = true;
    __device__ __forceinline__ const char* a_tile(const pg8::Unit& u) const { return u.A; }
    LAS unsigned* gtab;
    const unsigned char* memb; const unsigned char* wckv; bf16_t* Kout; bf16_t* VTout; const float* rstdm; int G, c;
    __device__ __forceinline__ bool next(int i, pg8::Unit& u) const {
        const long L = (long)i * G + c; if (L >= 256) return false;
        if (L < 128) { u.pm = (int)(L & 31); u.pn = (int)(L >> 5); u.e = 0; u.A = (const char*)memb; u.B = (const char*)(wckv + (size_t)u.pn * 256 * 1024); }
        else { const int l2 = (int)L - 128; u.pm = l2 & 3; u.pn = l2 >> 2; u.e = 1; u.A = (const char*)(wckv + (size_t)1024 * 1024); u.B = (const char*)(memb + (size_t)u.pn * 256 * 1024); }
        u.nvalid = 256; u.y0 = 0; u.aux = 0; return true; }
    __device__ __forceinline__ unsigned a_off(const pg8::Unit& u, int r) const { return (unsigned)(u.pm * 256 + r) * 1024u; }
    __device__ __forceinline__ void epi(const f32x4 (&acc)[2][2][4][2], const pg8::Unit& u, int wr, int wc, int fr, int fq) const {
        asm volatile("" : "+v"(fr), "+v"(fq));
        const int ldo = u.e ? MROWS : 1024;
        char* ub = (char*)(u.e ? VTout : Kout) + ((size_t)(u.pm * 256 + wr * 64) * ldo + u.pn * 256 + wc * 32) * 2;
        const unsigned lo = (unsigned)(fr * ldo + 8 * fq) * 2u;
        float rsv[8]; f32x4 sc[2][2];
        if (u.e == 0) {
#pragma unroll
            for (int q = 0; q < 8; ++q) rsv[q] = rstdm[u.pm * 256 + wr * 64 + fr + (q >> 2) * 128 + (q & 3) * 16] * (1.0f / 64.0f);
#pragma unroll
            for (int bj = 0; bj < 2; ++bj)
#pragma unroll
                for (int n = 0; n < 2; ++n) sc[bj][n] = (f32x4){1.f, 1.f, 1.f, 1.f};
        } else {
#pragma unroll
            for (int q = 0; q < 8; ++q) rsv[q] = 1.0f / 64.0f;
            const float* cp = rstdm + u.pn * 256 + wc * 32 + 8 * fq;
#pragma unroll
            for (int bj = 0; bj < 2; ++bj)
#pragma unroll
                for (int n = 0; n < 2; ++n) sc[bj][n] = *(const f32x4*)(cp + bj * 128 + 4 * n); }
#pragma unroll
        for (int ai = 0; ai < 2; ++ai)
#pragma unroll
            for (int m = 0; m < 4; ++m) { const float rs = rsv[ai * 4 + m]; char* rowp = ub + (size_t)(ai * 128 + m * 16) * ldo * 2 + lo;
#pragma unroll
                for (int bj = 0; bj < 2; ++bj) { const f32x4 v0 = acc[ai][bj][m][0] * sc[bj][0] * rs, v1 = acc[ai][bj][m][1] * sc[bj][1] * rs;
                    u32x4 w; w.x = cvt_pk_bf16(v0[0], v0[1]); w.y = cvt_pk_bf16(v0[2], v0[3]); w.z = cvt_pk_bf16(v1[0], v1[1]); w.w = cvt_pk_bf16(v1[2], v1[3]);
                    *(u32x4*)(rowp + bj * 256) = w; } }
    }
};
template <bool F8, bool WF8, bool RF32> struct ProbResidT {
    static constexpr bool FP8 = F8, PERM = true, GATHER = F8;
    static constexpr int RB = F8 ? 1024 : 2048;
    __device__ __forceinline__ const char* a_tile(const pg8::Unit& u) const { return F8 ? u.A : u.A + (size_t)u.pm * (256 * RB); }
    LAS unsigned* gtab;
    const void* A; const void* Bt; int nM, nN, G, c;
    const float* rf; const bf16_t* rb; bf16_t* ob; unsigned char* of8; float* ssp;
    __device__ __forceinline__ bool next(int i, pg8::Unit& u) const {
        int pm, pn; if (!pg8::static_next(i, G, c, nM, nN, pm, pn)) return false;
        u.A = (const char*)A; u.B = (const char*)Bt + (size_t)pn * 256 * RB; u.pm = pm; u.pn = pn; u.e = 0; u.nvalid = 256; u.y0 = 0; u.aux = 0; return true; }
    __device__ __forceinline__ unsigned a_off(const pg8::Unit& u, int r) const { return (unsigned)(u.pm * 256 + r) * (unsigned)RB; }
    __device__ __forceinline__ void epi(const f32x4 (&acc)[2][2][4][2], const pg8::Unit& u, int wr, int wc, int fr, int fq) const {
        asm volatile("" : "+v"(fr), "+v"(fq));
        const int rowu = u.pm * 256 + wr * 64;
        const size_t uoff = (size_t)rowu * 1024 + u.pn * 256 + wc * 32;
        const unsigned lo = (unsigned)(fr * 1024 + 8 * fq);
        const float sc = F8 ? (1.0f / 64.0f) : 1.0f;
#pragma unroll
        for (int ai = 0; ai < 2; ++ai) {
            f32x4 rv[4][2][2];
#pragma unroll
            for (int m = 0; m < 4; ++m) { const size_t ro = uoff + (size_t)(ai * 128 + m * 16) * 1024;
#pragma unroll
                for (int bj = 0; bj < 2; ++bj) {
                    if constexpr (RF32) { rv[m][bj][0] = *(const GAS f32x4*)(rf + ro + lo + bj * 128); rv[m][bj][1] = *(const GAS f32x4*)(rf + ro + lo + bj * 128 + 4); }
                    else { const u32x4 w = *(const GAS u32x4*)(rb + ro + lo + bj * 128); rv[m][bj][0] = (f32x4){lo_bf(w.x), hi_bf(w.x), lo_bf(w.y), hi_bf(w.y)}; rv[m][bj][1] = (f32x4){lo_bf(w.z), hi_bf(w.z), lo_bf(w.w), hi_bf(w.w)}; } } }
#pragma unroll
            for (int m = 0; m < 4; ++m) { const size_t ro = uoff + (size_t)(ai * 128 + m * 16) * 1024; float ss = 0.f;
                unsigned pk[2][2];
#pragma unroll
                for (int bj = 0; bj < 2; ++bj) { const f32x4 v0 = acc[ai][bj][m][0] * sc + rv[m][bj][0], v1 = acc[ai][bj][m][1] * sc + rv[m][bj][1];
                    ss += (v0[0] * v0[0] + v0[1] * v0[1]) + (v0[2] * v0[2] + v0[3] * v0[3]) + (v1[0] * v1[0] + v1[1] * v1[1]) + (v1[2] * v1[2] + v1[3] * v1[3]);
                    u32x4 w; w.x = cvt_pk_bf16(v0[0], v0[1]); w.y = cvt_pk_bf16(v0[2], v0[3]); w.z = cvt_pk_bf16(v1[0], v1[1]); w.w = cvt_pk_bf16(v1[2], v1[3]);
                    *(u32x4*)(ob + ro + lo + bj * 128) = w;
                    if constexpr (WF8) { unsigned w0 = 0u, w1 = 0u;
                        w0 = __builtin_amdgcn_cvt_pk_fp8_f32(c8(v0[0]), c8(v0[1]), w0, false); w0 = __builtin_amdgcn_cvt_pk_fp8_f32(c8(v0[2]), c8(v0[3]), w0, true);
                        w1 = __builtin_amdgcn_cvt_pk_fp8_f32(c8(v1[0]), c8(v1[1]), w1, false); w1 = __builtin_amdgcn_cvt_pk_fp8_f32(c8(v1[2]), c8(v1[3]), w1, true);
                        pk[bj][0] = w0; pk[bj][1] = w1; } }
                if constexpr (WF8) {
                    const auto s0 = __builtin_amdgcn_permlane16_swap(pk[0][0], pk[1][0], false, false), s1 = __builtin_amdgcn_permlane16_swap(pk[0][1], pk[1][1], false, false);
                    *(u32x4*)(of8 + ro + lo + ((fq & 1) ? 120u : 0u)) = (u32x4){s0[0], s1[0], s0[1], s1[1]}; }
                ss = x16_sum(ss); ss = x32_sum(ss);
                if (fq == 0) ssp[(size_t)(rowu + ai * 128 + m * 16 + fr) * 16 + u.pn * 4 + wc] = ss; } }
    }
};
__device__ __forceinline__ size_t hid_tile_off(int rt) { return rt < 1024 ? (size_t)rt * (256 * 1024) : (WS_HID1 - WS_HID) + (size_t)(rt - 1024) * (256 * 1024); }
constexpr int MOE_TS = 0, MOE_ST = 33, MOE_CNT = 66, MOE_RTE = 100, MOE_WORDS = 100 + 264;
struct ProbMoe1 {
    static constexpr bool FP8 = true, PERM = true, GATHER = true;
    __device__ __forceinline__ const char* a_tile(const pg8::Unit& u) const { return u.A; }
    const unsigned char* hb; const unsigned char* w1b; const float* b1p; const float* rstd2; const unsigned* list; unsigned char* hid;
    const volatile LAS int* tab; LAS unsigned* gtab; int rt0, nrt, G, c;
    __device__ __forceinline__ bool next(int i, pg8::Unit& u) const {
        const long L = (long)i * G + c; if (L >= (long)nrt * 8) return false;
        const int gidx = (int)(L >> 8), within = (int)(L & 255), gsz = (nrt - gidx * 32) < 32 ? (nrt - gidx * 32) : 32;
        const int rtl = gidx * 32 + within % gsz, pn = within / gsz, rt = rt0 + rtl;
        const int e = ((const volatile LAS unsigned char*)(tab + MOE_RTE))[rt];
        const int idx0 = (rt - tab[MOE_TS + e]) * 256;
        u.A = (const char*)hb; u.B = (const char*)(w1b + ((size_t)e * 2048 + (size_t)pn * 256) * 1024); u.pm = rt; u.pn = pn; u.e = e; u.nvalid = tab[MOE_CNT + e] - idx0; u.y0 = idx0; u.aux = 0; return true; }
    __device__ __forceinline__ unsigned tok_of(const pg8::Unit& u, int r) const { const int rr = r < u.nvalid ? r : 0; return list[(size_t)u.e * T + u.y0 + rr]; }
    __device__ __forceinline__ unsigned a_off(const pg8::Unit& u, int r) const { return tok_of(u, r) * 1024u; }
    __device__ __forceinline__ void epi(const f32x4 (&acc)[2][2][4][2], const pg8::Unit& u, int wr, int wc, int fr, int fq) const {
        asm volatile("" : "+v"(fr), "+v"(fq));
        const float* bp = b1p + (size_t)u.e * 2048 + u.pn * 256 + wc * 32 + 8 * fq;
        const f32x4 bg0 = *(const f32x4*)(bp), bg1 = *(const f32x4*)(bp + 4), bl0 = *(const f32x4*)(bp + 128), bl1 = *(const f32x4*)(bp + 132);
        char* ub = (char*)hid + hid_tile_off(u.pm) + ((size_t)(wr * 64) * 1024 + u.pn * 128 + wc * 32);
        const unsigned lo = (unsigned)(fr * 1024 + 8 * fq);
        unsigned wk[2][2];
#pragma unroll
        for (int ai = 0; ai < 2; ++ai)
#pragma unroll
            for (int m = 0; m < 4; ++m) { const float rs = 1.0f / 64.0f;
                unsigned w[2];
#pragma unroll
                for (int n = 0; n < 2; ++n) { const f32x4 g4 = acc[ai][0][m][n] * rs + (n ? bg1 : bg0), l4 = acc[ai][1][m][n] * rs + (n ? bl1 : bl0);
                    unsigned wv = 0u;
#pragma unroll
                    for (int jp = 0; jp < 2; ++jp) {
                        f32x2 g2 = {fminf(g4[2 * jp], 7.0f), fminf(g4[2 * jp + 1], 7.0f)};
                        const f32x2 l2 = {__builtin_amdgcn_fmed3f(l4[2 * jp], -7.0f, 7.0f), __builtin_amdgcn_fmed3f(l4[2 * jp + 1], -7.0f, 7.0f)};
                        const f32x2 z2 = g2 * (-1.702f * 1.4426950408889634f);
                        const f32x2 d2 = (f32x2){__builtin_amdgcn_exp2f(z2[0]), __builtin_amdgcn_exp2f(z2[1])} + 1.0f;
                        const f32x2 r2 = {__builtin_amdgcn_rcpf(d2[0]), __builtin_amdgcn_rcpf(d2[1])};
                        const f32x2 o2 = (g2 * r2) * (l2 * 4.0f + 4.0f);
                        if (jp) wv = __builtin_amdgcn_cvt_pk_fp8_f32(o2[0], o2[1], wv, true); else wv = __builtin_amdgcn_cvt_pk_fp8_f32(o2[0], o2[1], wv, false); }
                    w[n] = wv; }
                wk[m & 1][0] = w[0]; wk[m & 1][1] = w[1];
                if (m & 1) {
                    const auto s0 = __builtin_amdgcn_permlane16_swap(wk[0][0], wk[1][0], false, false), s1 = __builtin_amdgcn_permlane16_swap(wk[0][1], wk[1][1], false, false);
                    *(u32x4*)(ub + (size_t)(ai * 128 + (m - 1) * 16) * 1024 + lo + ((fq & 1) ? 16u * 1024u - 8u : 0u)) = (u32x4){s0[0], s1[0], s0[1], s1[1]}; } }
    }
};
struct ProbMoe2 {
    static constexpr bool FP8 = true, PERM = true, GATHER = true;
    __device__ __forceinline__ const char* a_tile(const pg8::Unit& u) const { return u.A; }
    const unsigned char* hid; const unsigned char* w2b; const float* b2; unsigned char* y;
    const volatile LAS int* tab; LAS unsigned* gtab; int rt0, nrt, G, c;
    __device__ __forceinline__ bool next(int i, pg8::Unit& u) const {
        const long L = (long)i * G + c; if (L >= (long)nrt * 4) return false;
        const int gidx = (int)(L >> 8), within = (int)(L & 255), gsz = (nrt - gidx * 64) < 64 ? (nrt - gidx * 64) : 64;
        const int rtl = gidx * 64 + within % gsz, pn = within / gsz, rt = rt0 + rtl;
        const int e = ((const volatile LAS unsigned char*)(tab + MOE_RTE))[rt];
        const int idx0 = (rt - tab[MOE_TS + e]) * 256;
        u.A = (const char*)hid; u.B = (const char*)(w2b + ((size_t)e * 1024 + (size_t)pn * 256) * 1024); u.pm = rt; u.pn = pn; u.e = e; u.nvalid = tab[MOE_CNT + e] - idx0; u.y0 = tab[MOE_ST + e] + idx0; u.aux = 0; return true; }
    __device__ __forceinline__ unsigned a_off(const pg8::Unit& u, int r) const { return (unsigned)(hid_tile_off(u.pm) + (size_t)r * 1024u); }
    __device__ __forceinline__ void epi(const f32x4 (&acc)[2][2][4][2], const pg8::Unit& u, int wr, int wc, int fr, int fq) const {
        asm volatile("" : "+v"(fr), "+v"(fq));
        const float* bp = b2 + (size_t)u.e * 1024 + u.pn * 256 + wc * 32 + 8 * fq;
        f32x4 bv[2][2];
#pragma unroll
        for (int bj = 0; bj < 2; ++bj)
#pragma unroll
            for (int n = 0; n < 2; ++n) bv[bj][n] = *(const f32x4*)(bp + bj * 128 + 4 * n);
        char* ub = (char*)y + (((size_t)u.y0 + wr * 64) * 1024 + u.pn * 256 + wc * 32);
        const unsigned lo2 = (unsigned)(fr * 1024 + 8 * fq) + ((fq & 1) ? 120u : 0u);
        const int r0 = wr * 64 + fr;
#pragma unroll
        for (int ai = 0; ai < 2; ++ai)
#pragma unroll
            for (int m = 0; m < 4; ++m) { const int r = r0 + ai * 128 + m * 16;
                unsigned pk[2][2];
#pragma unroll
                for (int bj = 0; bj < 2; ++bj) { const f32x4 v0 = acc[ai][bj][m][0] * (1.0f / 16.0f) + bv[bj][0] * 16.0f, v1 = acc[ai][bj][m][1] * (1.0f / 16.0f) + bv[bj][1] * 16.0f;
                    unsigned w0 = 0u, w1 = 0u;
                    w0 = __builtin_amdgcn_cvt_pk_fp8_f32(c8(v0[0]), c8(v0[1]), w0, false); w0 = __builtin_amdgcn_cvt_pk_fp8_f32(c8(v0[2]), c8(v0[3]), w0, true);
                    w1 = __builtin_amdgcn_cvt_pk_fp8_f32(c8(v1[0]), c8(v1[1]), w1, false); w1 = __builtin_amdgcn_cvt_pk_fp8_f32(c8(v1[2]), c8(v1[3]), w1, true);
                    pk[bj][0] = w0; pk[bj][1] = w1; }
                const auto s0 = __builtin_amdgcn_permlane16_swap(pk[0][0], pk[1][0], false, false), s1 = __builtin_amdgcn_permlane16_swap(pk[0][1], pk[1][1], false, false);
                if (r < u.nvalid) *(u32x4*)(ub + (size_t)(ai * 128 + m * 16) * 1024 + lo2) = (u32x4){s0[0], s1[0], s0[1], s1[1]}; }
    }
};

#define XB_TMO      128
#define XB_XCNT(j)  (256  + 64 * (j))
#define XB_XSUB(j)  (1280 + 64 * (j))
#define XB_XGEN(j)  (2304 + 64 * (j))
#define XB_TOP      3328
#define XB_TOPGEN   3392
#define XCD_BAR_WORDS 3456
#define XB_SPIN_CAP (1u << 18)
__device__ __forceinline__ unsigned xb_ld(unsigned* p)              { return __hip_atomic_load(p, __ATOMIC_RELAXED, __HIP_MEMORY_SCOPE_AGENT); }
__device__ __forceinline__ unsigned xb_add(unsigned* p, unsigned v) { return __hip_atomic_fetch_add(p, v, __ATOMIC_RELAXED, __HIP_MEMORY_SCOPE_AGENT); }
__device__ __forceinline__ unsigned xb_xcc_id() { return (unsigned)__builtin_amdgcn_s_getreg((3 << 11) | 20) & 0xFu; }
#define XB_SPIN(cond, bar) do { unsigned _sp = 0; while (cond) { __builtin_amdgcn_s_sleep(1); \
    if ((++_sp & 255u) == 0u) { if (xb_ld(&(bar)[XB_TMO])) break; if (_sp > XB_SPIN_CAP) { atomicAdd(&(bar)[XB_TMO], 1u); break; } } } } while (0)
struct XcdBarrier { unsigned* bar; unsigned x; volatile LAS unsigned* st; int wave; };
__device__ __forceinline__ XcdBarrier xcd_barrier_post(unsigned* bar, volatile LAS unsigned* st, int wave) {
    XcdBarrier b; b.bar = bar; b.x = xb_xcc_id(); b.st = st; b.wave = wave;
    if (wave == 0 && lane_id() == 0) (void)xb_add(&bar[XB_XCNT(b.x)], 1u);
    return b;
}
__device__ __forceinline__ void xcd_barrier_complete(unsigned* bar, unsigned x, unsigned& nloc, unsigned& nx) {
    const unsigned G = gridDim.x * gridDim.y * gridDim.z;
    unsigned sum, cnt, mine, sp = 0u;
    for (;;) {
        sum = 0u; cnt = 0u; mine = 0u;
#pragma unroll
        for (unsigned j = 0; j < 16; ++j) { const unsigned c = xb_ld(&bar[XB_XCNT(j)]); sum += c; cnt += (c > 0u) ? 1u : 0u; mine = (j == x) ? c : mine; }
        if (sum == G) break;
        __builtin_amdgcn_s_sleep(1);
        if ((++sp & 255u) == 0u) { if (xb_ld(&bar[XB_TMO])) break; if (sp > XB_SPIN_CAP) { atomicAdd(&bar[XB_TMO], 1u); break; } }
    }
    nloc = mine > 0u ? mine : 1u; nx = cnt > 0u ? cnt : 1u;
}
__device__ __forceinline__ void xcd_barrier(const XcdBarrier& b) {
    asm volatile("s_waitcnt vmcnt(0)" ::: "memory");
    __syncthreads();
    if (b.wave == 0 && lane_id() == 0) {
        unsigned* bar = b.bar;
        __builtin_amdgcn_s_waitcnt(0);
        unsigned nloc = b.st[0], nx = b.st[1];
        if (nloc == 0u) { xcd_barrier_complete(bar, b.x, nloc, nx); b.st[0] = nloc; b.st[1] = nx; }
        const unsigned old = xb_add(&bar[XB_XSUB(b.x)], 1u);
        const unsigned gen = old / nloc;
        if (old + 1u == (gen + 1u) * nloc) {
            __builtin_amdgcn_fence(__ATOMIC_RELEASE, "agent");
            asm volatile("s_waitcnt vmcnt(0)" ::: "memory");
            const unsigned og = xb_add(&bar[XB_TOP], 1u);
            const unsigned tg = og / nx;
            if (og + 1u == (tg + 1u) * nx) xb_add(&bar[XB_TOPGEN], 1u);
            else XB_SPIN(xb_ld(&bar[XB_TOPGEN]) == tg, bar);
            __builtin_amdgcn_fence(__ATOMIC_ACQUIRE, "agent");
            xb_add(&bar[XB_XGEN(b.x)], 1u);
            asm volatile("s_waitcnt vmcnt(0)" ::: "memory");
        } else {
            XB_SPIN(xb_ld(&bar[XB_XGEN(b.x)]) == gen, bar);
            __builtin_amdgcn_fence(__ATOMIC_ACQUIRE, "agent");
            asm volatile("s_waitcnt vmcnt(0)" ::: "memory");
        }
    }
    __syncthreads();
}

typedef float f32x16 __attribute__((ext_vector_type(16)));
__device__ __forceinline__ int pi32(int i) { return (i & ~12) | ((i & 4) << 1) | ((i & 8) >> 1); }
__device__ __forceinline__ f32x16 zero16() { f32x16 z;
#pragma unroll
    for (int r = 0; r < 16; ++r) z[r] = 0.f;
    return z; }

__device__ __forceinline__ void xattn_phase(LAS unsigned char* lds, const bf16_t* Q, const bf16_t* Kb, const bf16_t* VT, unsigned char* O, int G, int bx, int wave) {
    const int lane = lane_id(), i = lane & 31, hh = lane >> 5;
    LAS unsigned char* ring = lds;
    for (int uid = bx; uid < BATCH * 4 * 8; uid += G) {
        const int b = uid >> 5, h = (uid >> 3) & 3, qblk = uid & 7;
        const int q0 = qblk * 256 + wave * 32;
        const bf16_t* qp = Q + (size_t)(b * SEQ + q0 + i) * 1024 + h * 256 + 8 * hh;
        bf16x8 qf[16];
#pragma unroll
        for (int ds = 0; ds < 16; ++ds) qf[ds] = *(const bf16x8*)(qp + 16 * ds);
        const bf16_t* ksrc = Kb + (size_t)(b * MEMLEN + pi32(i)) * 1024 + h * 256 + 16 * wave + 8 * hh;
        const bf16_t* vsrc = VT + (size_t)(h * 256 + i) * MROWS + b * MEMLEN + 32 * (wave >> 1) + 16 * (wave & 1) + 8 * hh;
#define XA_ISSUE(st_) do { LAS unsigned char* sl_ = ring + ((st_) & 3) * 16384; \
        if ((st_) < 8) { const bf16_t* g_ = ksrc + (size_t)(st_) * 32 * 1024; \
            __builtin_amdgcn_global_load_lds((const unsigned*)g_, (LAS unsigned*)(sl_ + wave * 1024), 16, 0, 0); \
            __builtin_amdgcn_global_load_lds((const unsigned*)(g_ + 128), (LAS unsigned*)(sl_ + (8 + wave) * 1024), 16, 0, 0); } \
        else { const bf16_t* g_ = vsrc + (size_t)((st_) - 8) * 32 * MROWS; \
            __builtin_amdgcn_global_load_lds((const unsigned*)g_, (LAS unsigned*)(sl_ + wave * 1024), 16, 0, 0); \
            __builtin_amdgcn_global_load_lds((const unsigned*)(g_ + 128), (LAS unsigned*)(sl_ + (8 + wave) * 1024), 16, 0, 0); } } while (0)
#define XA_SYNC(st_) do { const int n_ = ((st_) >= 11 ? 1 : 0) + ((st_) <= 14 ? 2 : 0) + ((st_) >= 10 ? 1 : 0) + ((st_) <= 13 ? 2 : 0) + ((st_) >= 9 ? 1 : 0); \
        if (n_ == 3) asm volatile("s_waitcnt vmcnt(3)" ::: "memory"); else if (n_ == 4) asm volatile("s_waitcnt vmcnt(4)" ::: "memory"); else if (n_ == 5) asm volatile("s_waitcnt vmcnt(5)" ::: "memory"); \
        else if (n_ == 6) asm volatile("s_waitcnt vmcnt(6)" ::: "memory"); else asm volatile("s_waitcnt vmcnt(7)" ::: "memory"); \
        __builtin_amdgcn_s_barrier(); asm volatile("" ::: "memory"); if ((st_) + 3 < 16) XA_ISSUE((st_) + 3); } while (0)
        XA_ISSUE(0); XA_ISSUE(1); XA_ISSUE(2);
        f32x16 s[8];
#pragma unroll
        for (int kt = 0; kt < 8; ++kt) { XA_SYNC(kt);
            const LAS unsigned char* sl = ring + (kt & 3) * 16384 + lane * 16;
            f32x16 acc = zero16();
#pragma unroll
            for (int q4 = 0; q4 < 4; ++q4) { __builtin_amdgcn_sched_barrier(0);
#pragma unroll
                for (int d4 = 0; d4 < 4; ++d4) { const int ds = q4 * 4 + d4; acc = __builtin_amdgcn_mfma_f32_32x32x16_bf16(*(const LAS bf16x8*)(sl + ds * 1024), qf[ds], acc, 0, 0, 0); } }
            s[kt] = acc; }
        float m = -INFINITY;
#pragma unroll
        for (int kt = 0; kt < 8; ++kt)
#pragma unroll
            for (int r = 0; r < 16; ++r) m = fmaxf(m, s[kt][r]);
        m = x32_max(m);
        const float c = 0.0625f * 1.4426950408889634f; float l = 0.f; const float mc = m * c;
        u32x4 pf[8][2];
#pragma unroll
        for (int kt = 0; kt < 8; ++kt) {
#pragma unroll
            for (int r = 0; r < 16; ++r) { const float p = __builtin_amdgcn_exp2f(s[kt][r] * c - mc); s[kt][r] = p; l += p; }
#pragma unroll
            for (int sb = 0; sb < 2; ++sb) { pf[kt][sb].x = cvt_pk_bf16(s[kt][8 * sb + 0], s[kt][8 * sb + 1]); pf[kt][sb].y = cvt_pk_bf16(s[kt][8 * sb + 2], s[kt][8 * sb + 3]);
                pf[kt][sb].z = cvt_pk_bf16(s[kt][8 * sb + 4], s[kt][8 * sb + 5]); pf[kt][sb].w = cvt_pk_bf16(s[kt][8 * sb + 6], s[kt][8 * sb + 7]); } }
        l = x32_sum(l);
        const float il = 1.0f / l;
        unsigned char* op = O + (size_t)(b * SEQ + q0 + i) * 1024 + h * 256 + 16 * hh;
#pragma unroll
        for (int dvt = 0; dvt < 8; ++dvt) { XA_SYNC(8 + dvt);
            const LAS unsigned char* sl = ring + (dvt & 3) * 16384 + lane * 16;
            f32x16 oacc = zero16();
#pragma unroll
            for (int q4 = 0; q4 < 4; ++q4) { __builtin_amdgcn_sched_barrier(0);
#pragma unroll
                for (int f4 = 0; f4 < 4; ++f4) { const int f = q4 * 4 + f4; oacc = __builtin_amdgcn_mfma_f32_32x32x16_bf16(*(const LAS bf16x8*)(sl + f * 1024), __builtin_bit_cast(bf16x8, pf[f >> 1][f & 1]), oacc, 0, 0, 0); } }
            unsigned wg[4];
#pragma unroll
            for (int g = 0; g < 4; ++g) { unsigned w = 0u; w = __builtin_amdgcn_cvt_pk_fp8_f32(c8(oacc[4 * g] * il), c8(oacc[4 * g + 1] * il), w, false); w = __builtin_amdgcn_cvt_pk_fp8_f32(c8(oacc[4 * g + 2] * il), c8(oacc[4 * g + 3] * il), w, true); wg[g] = w; }
            { const auto s02 = __builtin_amdgcn_permlane32_swap(wg[0], wg[2], false, false), s13 = __builtin_amdgcn_permlane32_swap(wg[1], wg[3], false, false);
              *(u32x4*)(op + dvt * 32) = (u32x4){s02[0], s02[1], s13[0], s13[1]}; } }
#undef XA_ISSUE
#undef XA_SYNC
    }
}

__device__ __forceinline__ void diffattn_phase(LAS unsigned char* lds, const bf16_t* P2, const bf16_t* VT, const float* dng, const float lam, bf16_t* cat, int G, int vx, int wave) {
    const int lane = lane_id(), i_ = lane & 31, hh_ = lane >> 5;
    LAS unsigned char* ring = lds;
    LAS unsigned char* ql = lds + 65536 + wave * 8192 + lane * 16;
    const float c = 0.125f * 1.4426950408889634f;
    for (int pu = vx; pu < BATCH * 4 * 4; pu += G)
        for (int side = 0; side < 2; ++side) {
            const int bh = pu >> 2, x = pu & 3, qb = side ? 7 - x : x, b = bh >> 2, h = bh & 3, q0 = qb * 256 + wave * 32;
            const int ntile = 8 * qb + 8, ktw = 8 * qb + wave;
            int i = i_, hh = hh_; asm volatile("" : "+v"(i), "+v"(hh));
            const bf16_t* qp = P2 + (size_t)(b * SEQ + q0 + i) * NP2 + h * 128 + 8 * hh;
            { bf16x8 t[8];
#pragma unroll
              for (int f = 0; f < 8; ++f) t[f] = *(const bf16x8*)(qp + 16 * f);
#pragma unroll
              for (int f = 0; f < 8; ++f) *(LAS bf16x8*)(ql + f * 1024) = t[f]; }
            const char* kbase = (const char*)(P2 + (size_t)b * SEQ * NP2 + 512 + h * 128 + (wave >> 2) * 64 + 16 * (wave & 3));
            const char* vbase = (const char*)(VT + (size_t)(h * 128 + 32 * (wave >> 1)) * T + (size_t)b * SEQ + 16 * (wave & 1));
            const unsigned koff = (unsigned)(pi32(i) * NP2 + 8 * hh) * 2u, voff = (unsigned)(i * T + 8 * hh) * 2u;
#define DA_ISSUE(kt_) do { LAS unsigned char* sl_ = ring + ((kt_) & 3) * 16384; \
        __builtin_amdgcn_global_load_lds((const unsigned*)(kbase + (size_t)(kt_) * (32 * NP2 * 2) + koff), (LAS unsigned*)(sl_ + wave * 1024), 16, 0, 0); \
        __builtin_amdgcn_global_load_lds((const unsigned*)(vbase + (kt_) * 64 + voff), (LAS unsigned*)(sl_ + (8 + wave) * 1024), 16, 0, 0); } while (0)
            f32x16 o1[4], o2[4];
#pragma unroll
            for (int d = 0; d < 4; ++d) { o1[d] = zero16(); o2[d] = zero16(); }
            float mc1 = -INFINITY, mc2 = -INFINITY, l1 = 0.f, l2 = 0.f;
            u32x4 pp1[2], pp2[2];
#pragma unroll
            for (int sb = 0; sb < 2; ++sb) { pp1[sb] = (u32x4){0u, 0u, 0u, 0u}; pp2[sb] = pp1[sb]; }
            DA_ISSUE(0); DA_ISSUE(1);
            for (int kt = 0; kt <= ntile; ++kt) {
                if (kt < ntile) {
                    if (kt + 1 < ntile) asm volatile("s_waitcnt vmcnt(2)" ::: "memory"); else asm volatile("s_waitcnt vmcnt(0)" ::: "memory");
                    __builtin_amdgcn_s_barrier(); asm volatile("" ::: "memory");
                    if (kt + 2 < ntile) DA_ISSUE(kt + 2);
                }
                if (kt <= ktw + 1) {
                    const LAS unsigned char* sl = ring + (kt & 3) * 16384 + lane * 16;
                    const LAS unsigned char* sp = ring + ((kt == 0 ? 0 : kt - 1) & 3) * 16384 + lane * 16;
                    f32x16 s1 = zero16(), s2 = zero16();
#pragma unroll
                    for (int ds = 0; ds < 4; ++ds) { s1 = __builtin_amdgcn_mfma_f32_32x32x16_bf16(*(const LAS bf16x8*)(sl + ds * 1024), *(const LAS bf16x8*)(ql + ds * 1024), s1, 0, 0, 0);
                        s2 = __builtin_amdgcn_mfma_f32_32x32x16_bf16(*(const LAS bf16x8*)(sl + (4 + ds) * 1024), *(const LAS bf16x8*)(ql + (4 + ds) * 1024), s2, 0, 0, 0);
                        if (ds & 1) __builtin_amdgcn_sched_barrier(0); }
                    if (kt >= ktw) { const int lim = (kt == ktw) ? i : -1;
#pragma unroll
                        for (int r = 0; r < 16; ++r) { const int ko = 16 * (r >> 3) + 8 * hh + (r & 7); if (ko > lim) { s1[r] = -INFINITY; s2[r] = -INFINITY; } } }
                    float f1 = 1.f, f2 = 1.f; bool rs1, rs2;
                    { float tm = s1[0];
#pragma unroll
                      for (int r = 1; r < 16; ++r) tm = fmaxf(tm, s1[r]);
                      tm = x32_max(tm); const float tmc = tm * c; rs1 = __any(tmc > mc1 + 8.0f);
                      if (rs1) { const float mn = fmaxf(mc1, tmc); f1 = __builtin_amdgcn_exp2f(mc1 - mn); mc1 = mn; } }
                    { float tm = s2[0];
#pragma unroll
                      for (int r = 1; r < 16; ++r) tm = fmaxf(tm, s2[r]);
                      tm = x32_max(tm); const float tmc = tm * c; rs2 = __any(tmc > mc2 + 8.0f);
                      if (rs2) { const float mn = fmaxf(mc2, tmc); f2 = __builtin_amdgcn_exp2f(mc2 - mn); mc2 = mn; } }
                    float ls1 = 0.f, ls2 = 0.f; u32x4 pn1[2], pn2[2];
#define DA_SM(j) do { { const float pv_ = __builtin_amdgcn_exp2f(s1[j] * c - mc1); s1[j] = pv_; ls1 += pv_; } { const float pv_ = __builtin_amdgcn_exp2f(s2[j] * c - mc2); s2[j] = pv_; ls2 += pv_; } \
                        if ((j) & 1) { pn1[(j) >> 3][((j) & 7) >> 1] = cvt_pk_bf16(s1[(j) - 1], s1[j]); pn2[(j) >> 3][((j) & 7) >> 1] = cvt_pk_bf16(s2[(j) - 1], s2[j]); } } while (0)
                    { bf16x8 va, vb;
#define DA_VLD(p) (*(const LAS bf16x8*)(sp + (8 + ((p) & 3) * 2 + ((p) >> 2)) * 1024))
#define DA_SLOT(j, VF, LDNEXT) do { if ((j) & 1) o2[((j) >> 1) & 3] = __builtin_amdgcn_mfma_f32_32x32x16_bf16(VF, __builtin_bit_cast(bf16x8, pp2[(j) >> 3]), o2[((j) >> 1) & 3], 0, 0, 0); \
                            else o1[((j) >> 1) & 3] = __builtin_amdgcn_mfma_f32_32x32x16_bf16(VF, __builtin_bit_cast(bf16x8, pp1[(j) >> 3]), o1[((j) >> 1) & 3], 0, 0, 0); \
                            LDNEXT; DA_SM(j); __builtin_amdgcn_sched_barrier(0); } while (0)
                      va = DA_VLD(0);
                      __builtin_amdgcn_sched_barrier(0);
                      DA_SLOT(0, va, vb = DA_VLD(1)); DA_SLOT(1, va, (void)0); DA_SLOT(2, vb, va = DA_VLD(2)); DA_SLOT(3, vb, (void)0);
                      DA_SLOT(4, va, vb = DA_VLD(3)); DA_SLOT(5, va, (void)0); DA_SLOT(6, vb, va = DA_VLD(4)); DA_SLOT(7, vb, (void)0);
                      DA_SLOT(8, va, vb = DA_VLD(5)); DA_SLOT(9, va, (void)0); DA_SLOT(10, vb, va = DA_VLD(6)); DA_SLOT(11, vb, (void)0);
                      DA_SLOT(12, va, vb = DA_VLD(7)); DA_SLOT(13, va, (void)0); DA_SLOT(14, vb, (void)0); DA_SLOT(15, vb, (void)0);
#undef DA_VLD
#undef DA_SLOT
                    }
#undef DA_SM
                    l1 = l1 * f1 + ls1; l2 = l2 * f2 + ls2;
                    if (rs1) {
#pragma unroll
                        for (int d = 0; d < 4; ++d)
#pragma unroll
                            for (int r = 0; r < 16; ++r) o1[d][r] *= f1; }
                    if (rs2) {
#pragma unroll
                        for (int d = 0; d < 4; ++d)
#pragma unroll
                            for (int r = 0; r < 16; ++r) o2[d][r] *= f2; }
#pragma unroll
                    for (int sb = 0; sb < 2; ++sb) { pp1[sb] = pn1[sb]; pp2[sb] = pn2[sb]; }
                }
            }
#undef DA_ISSUE
            l1 = x32_sum(l1); l2 = x32_sum(l2);
            int ie = i, he = hh; asm volatile("" : "+v"(ie), "+v"(he));
            const float i1 = 1.0f / l1, i2 = lam / l2; float ss = 0.f;
#pragma unroll
            for (int d = 0; d < 4; ++d)
#pragma unroll
                for (int r = 0; r < 16; ++r) { const float o = o1[d][r] * i1 - o2[d][r] * i2; o1[d][r] = o; ss += o * o; }
            ss = x32_sum(ss);
            const float rn = rsqrtf(ss * (1.0f / 128.0f) + EPS) * (1.0f - LAMBDA_INIT);
            bf16_t* op = cat + (size_t)(b * SEQ + q0 + ie) * DM + h * 128 + 8 * he;
            const float* gp = dng + h * 128 + 4 * he;
#pragma unroll
            for (int d = 0; d < 4; ++d)
#pragma unroll
                for (int g2 = 0; g2 < 2; ++g2) { u32x2 w[2];
#pragma unroll
                    for (int q = 0; q < 2; ++q) { const int g = 2 * g2 + q; const f32x4 gv = *(const f32x4*)(gp + d * 32 + 8 * g);
                        w[q].x = cvt_pk_bf16(o1[d][4 * g] * rn * gv[0], o1[d][4 * g + 1] * rn * gv[1]); w[q].y = cvt_pk_bf16(o1[d][4 * g + 2] * rn * gv[2], o1[d][4 * g + 3] * rn * gv[3]); }
                    const auto sa = __builtin_amdgcn_permlane32_swap(w[0].x, w[1].x, false, false), sb = __builtin_amdgcn_permlane32_swap(w[0].y, w[1].y, false, false);
                    *(u32x4*)(op + d * 32 + 16 * g2) = (u32x4){sa[0], sb[0], sa[1], sb[1]}; }
        }
}

__device__ __forceinline__ void mlstm_prep_phase(LAS unsigned char* lds, const bf16_t* P2, const bf16_t* VT, const float* gates, const float* conv_w, const float* conv_b,
                                                 bf16_t* QM, bf16_t* KM, float* BC, float* AV, float* AM, float* CH, float* NLOC, float* CLOC, int G, int vx, int wave) {
    const int lane = lane_id(), i = lane & 31, hh = lane >> 5;
    LAS unsigned char* kl = lds + wave * 16384;
    for (int task = vx * 8 + wave; task < BATCH * 4 * 16; task += G * 8) {
        const int bh = task >> 4, c = task & 15, b = bh >> 2, h = bh & 3;
        const int t0 = b * SEQ + c * 128, tA = t0 + 2 * lane;
        const float lf0 = gates[(size_t)tA * 8 + 4 + h], lf1 = gates[(size_t)(tA + 1) * 8 + 4 + h], ig0 = gates[(size_t)tA * 8 + h], ig1 = gates[(size_t)(tA + 1) * 8 + h];
        float incl = lf0 + lf1;
#pragma unroll
        for (int off = 1; off < 64; off <<= 1) { const float v = __shfl_up(incl, off); if (lane >= off) incl += v; }
        const float bc1 = incl, bc0 = incl - lf1, blast = __shfl(incl, 63);
        const float a0 = ig0 - bc0, a1 = ig1 - bc1;
        float pm = fmaxf(a0, a1);
#pragma unroll
        for (int off = 1; off < 64; off <<= 1) { const float v = __shfl_up(pm, off); if (lane >= off) pm = fmaxf(pm, v); }
        const float pmprev = __shfl_up(pm, 1);
        const float am1 = pm, am0 = (lane > 0) ? fmaxf(pmprev, a0) : a0, amall = __shfl(pm, 63);
        const float ws0 = __expf(a0 - amall), ws1 = __expf(a1 - amall);
        *(f32x2*)(BC + (size_t)h * T + tA) = (f32x2){bc0, bc1};
        *(f32x2*)(AV + (size_t)h * T + tA) = (f32x2){a0, a1};
        *(f32x2*)(AM + (size_t)h * T + tA) = (f32x2){am0, am1};
        if (lane == 0) { CH[task * 2] = blast; CH[task * 2 + 1] = blast + amall; }
        {
            const int r8 = lane >> 3, cg = lane & 7;
            float cw[2][5][8];
#pragma unroll
            for (int part = 0; part < 2; ++part) { const int ch0 = (part ? 256 : 0) + h * 64 + 8 * cg;
#pragma unroll
                for (int k = 0; k < 4; ++k) { const f32x4 a = *(const f32x4*)(conv_w + k * 512 + ch0), bq = *(const f32x4*)(conv_w + k * 512 + ch0 + 4);
#pragma unroll
                    for (int j = 0; j < 4; ++j) { cw[part][k][j] = a[j]; cw[part][k][4 + j] = bq[j]; } }
                { const f32x4 a = *(const f32x4*)(conv_b + ch0), bq = *(const f32x4*)(conv_b + ch0 + 4);
#pragma unroll
                    for (int j = 0; j < 4; ++j) { cw[part][4][j] = a[j]; cw[part][4][4 + j] = bq[j]; } } }
#pragma unroll 4
            for (int jb = 0; jb < 16; ++jb) {
                const int p = 8 * jb + r8, tg = t0 + p, tseq = c * 128 + p;
                const float wa = __shfl(ws0, p >> 1), wb = __shfl(ws1, p >> 1); const float wsp = (p & 1) ? wb : wa;
                u32x4 uw[2][4];
#pragma unroll
                for (int part = 0; part < 2; ++part)
#pragma unroll
                    for (int k = 0; k < 4; ++k) { uw[part][k] = (u32x4){0u, 0u, 0u, 0u};
                        if (tseq - 3 + k >= 0) uw[part][k] = *(const u32x4*)(P2 + (size_t)(tg - 3 + k) * NP2 + 1024 + (part ? 256 : 0) + h * 64 + 8 * cg); }
#pragma unroll
                for (int part = 0; part < 2; ++part) { float y[8];
#pragma unroll
                    for (int j = 0; j < 8; ++j) { float pj = cw[part][4][j];
#pragma unroll
                        for (int k = 0; k < 4; ++k) { const unsigned wv = (j < 2) ? uw[part][k].x : (j < 4) ? uw[part][k].y : (j < 6) ? uw[part][k].z : uw[part][k].w; pj += cw[part][k][j] * ((j & 1) ? hi_bf(wv) : lo_bf(wv)); }
                        y[j] = pj * __builtin_amdgcn_rcpf(1.0f + __expf(-pj)); }
                    if (part == 0) { u32x4 w; w.x = cvt_pk_bf16(y[0] * 0.125f, y[1] * 0.125f); w.y = cvt_pk_bf16(y[2] * 0.125f, y[3] * 0.125f); w.z = cvt_pk_bf16(y[4] * 0.125f, y[5] * 0.125f); w.w = cvt_pk_bf16(y[6] * 0.125f, y[7] * 0.125f);
                        *(u32x4*)(QM + (size_t)tg * 256 + h * 64 + 8 * cg) = w; }
                    else { u32x4 w; w.x = cvt_pk_bf16(y[0], y[1]); w.y = cvt_pk_bf16(y[2], y[3]); w.z = cvt_pk_bf16(y[4], y[5]); w.w = cvt_pk_bf16(y[6], y[7]);
                        *(u32x4*)(KM + (size_t)tg * 256 + h * 64 + 8 * cg) = w;
#pragma unroll
                        for (int j = 0; j < 8; ++j) { const int d = 8 * cg + j;
                            *(LAS unsigned short*)(kl + d * 256 + ((jb ^ (d & 15)) * 16) + r8 * 2) = (unsigned short)f2bf(y[j] * wsp); } } }
            }
        }
        { float ns = 0.f;
#pragma unroll
          for (int cq = 0; cq < 16; ++cq) { const u32x4 w = *(const LAS u32x4*)(kl + lane * 256 + ((cq ^ (lane & 15)) * 16));
              ns += (lo_bf(w.x) + hi_bf(w.x)) + (lo_bf(w.y) + hi_bf(w.y)) + (lo_bf(w.z) + hi_bf(w.z)) + (lo_bf(w.w) + hi_bf(w.w)); }
          NLOC[(size_t)task * 64 + lane] = ns; }
        f32x16 acc[4][2];
#pragma unroll
        for (int et = 0; et < 4; ++et) { acc[et][0] = zero16(); acc[et][1] = zero16(); }
        const bf16_t* vp = VT + (size_t)(512 + h * 128 + i) * T + t0 + 8 * hh;
#pragma unroll
        for (int k2 = 0; k2 < 8; k2 += 2) {
            bf16x8 af[2][4];
#pragma unroll
            for (int q = 0; q < 2; ++q)
#pragma unroll
                for (int et = 0; et < 4; ++et) af[q][et] = *(const bf16x8*)(vp + (size_t)et * 32 * T + 16 * (k2 + q));
            __builtin_amdgcn_sched_barrier(0);
#pragma unroll
            for (int q = 0; q < 2; ++q) { const int ks = k2 + q; bf16x8 bfr[2];
#pragma unroll
                for (int dt = 0; dt < 2; ++dt) { const int d = 32 * dt + i; bfr[dt] = *(const LAS bf16x8*)(kl + d * 256 + (((2 * ks + hh) ^ (d & 15)) * 16)); }
#pragma unroll
                for (int et = 0; et < 4; ++et) {
                    acc[et][0] = __builtin_amdgcn_mfma_f32_32x32x16_bf16(af[q][et], bfr[0], acc[et][0], 0, 0, 0); acc[et][1] = __builtin_amdgcn_mfma_f32_32x32x16_bf16(af[q][et], bfr[1], acc[et][1], 0, 0, 0); } }
            __builtin_amdgcn_sched_barrier(0);
        }
        float* cp = CLOC + (size_t)task * 8192 + i + 256 * hh;
#pragma unroll
        for (int et = 0; et < 4; ++et)
#pragma unroll
            for (int dt = 0; dt < 2; ++dt)
#pragma unroll
                for (int r = 0; r < 16; ++r) cp[(32 * et + (r & 3) + 8 * (r >> 2)) * 64 + 32 * dt] = acc[et][dt][r];
    }
}
__device__ __forceinline__ void mlstm_scan_phase(const float* CLOC, const float* NLOC, const float* CH, bf16_t* CSTB, float* NST, float* MSTATE, int G, int bx, int tid) {
    for (int idx = bx * 512 + tid; idx < BATCH * 4 * 1024; idx += G * 512) {
        const int bh = idx >> 10, rem = idx & 1023, e = rem >> 3, d0 = (rem & 7) * 8;
        float C[8], nr[8]; float m = 0.f;
#pragma unroll
        for (int j = 0; j < 8; ++j) { C[j] = 0.f; nr[j] = 0.f; }
#pragma unroll 1
        for (int c8 = 0; c8 < 16; c8 += 8) {
            f32x4 cl[8][2], nl[8][2]; float bl[8], ml[8];
#pragma unroll
            for (int q = 0; q < 8; ++q) { const int task = bh * 16 + c8 + q;
                cl[q][0] = *(const f32x4*)(CLOC + (size_t)task * 8192 + e * 64 + d0); cl[q][1] = *(const f32x4*)(CLOC + (size_t)task * 8192 + e * 64 + d0 + 4);
                bl[q] = CH[task * 2]; ml[q] = CH[task * 2 + 1];
                if (rem < 8) { nl[q][0] = *(const f32x4*)(NLOC + (size_t)task * 64 + rem * 8); nl[q][1] = *(const f32x4*)(NLOC + (size_t)task * 64 + rem * 8 + 4); }
                else { nl[q][0] = (f32x4){0.f, 0.f, 0.f, 0.f}; nl[q][1] = nl[q][0]; } }
#pragma unroll
            for (int q = 0; q < 8; ++q) { const int task = bh * 16 + c8 + q;
                u32x4 w; w.x = cvt_pk_bf16(C[0], C[1]); w.y = cvt_pk_bf16(C[2], C[3]); w.z = cvt_pk_bf16(C[4], C[5]); w.w = cvt_pk_bf16(C[6], C[7]);
                *(u32x4*)(CSTB + (size_t)task * 8192 + e * 64 + d0) = w;
                if (rem < 8) { *(f32x4*)(NST + (size_t)task * 64 + rem * 8) = (f32x4){nr[0], nr[1], nr[2], nr[3]}; *(f32x4*)(NST + (size_t)task * 64 + rem * 8 + 4) = (f32x4){nr[4], nr[5], nr[6], nr[7]}; }
                if (rem == 0) MSTATE[task] = m;
                const float mn = fmaxf(bl[q] + m, ml[q]), a = __expf(bl[q] + m - mn), bco = __expf(ml[q] - mn);
#pragma unroll
                for (int j = 0; j < 4; ++j) { C[j] = a * C[j] + bco * cl[q][0][j]; C[4 + j] = a * C[4 + j] + bco * cl[q][1][j]; nr[j] = a * nr[j] + bco * nl[q][0][j]; nr[4 + j] = a * nr[4 + j] + bco * nl[q][1][j]; }
                m = mn; }
        }
    }
}
__device__ __forceinline__ void mlstm_out_phase(LAS unsigned char* lds, const bf16_t* P2, const bf16_t* VT, const bf16_t* QM, const bf16_t* KM, const float* BC, const float* AV, const float* AM,
                                                const bf16_t* CSTB, const float* NST, const float* MSTATE, const float* mng, bf16_t* cat, int G, int vx, int wave) {
    const int lane_ = lane_id();
    const int cw = wave >> 2, tq = wave & 3;
    LAS unsigned char* reg = lds + cw * 65536;
    for (int un = vx; un < BATCH * 4 * 8; un += G) {
        int lane = lane_; asm volatile("" : "+v"(lane));
        const int i = lane & 31, hh = lane >> 5;
        const int task = 2 * un + cw, bh = task >> 4, c = task & 15, b = bh >> 2, h = bh & 3;
        const int t0 = b * SEQ + c * 128;
        { const bf16_t* ks = KM + (size_t)(t0 + 32 * tq + pi32(i)) * 256 + h * 64 + 8 * hh;
          const bf16_t* cs = CSTB + (size_t)task * 8192 + (32 * tq + i) * 64 + 8 * hh;
          const bf16_t* vs = VT + (size_t)(512 + h * 128 + 32 * tq + i) * T + t0 + 8 * hh;
#pragma unroll
          for (int ds = 0; ds < 4; ++ds) { __builtin_amdgcn_global_load_lds((const unsigned*)(ks + 16 * ds), (LAS unsigned*)(reg + (tq * 4 + ds) * 1024), 16, 0, 0);
              __builtin_amdgcn_global_load_lds((const unsigned*)(cs + 16 * ds), (LAS unsigned*)(reg + 16384 + (tq * 4 + ds) * 1024), 16, 0, 0); }
#pragma unroll
          for (int k8 = 0; k8 < 8; ++k8) __builtin_amdgcn_global_load_lds((const unsigned*)(vs + 16 * k8), (LAS unsigned*)(reg + 32768 + (tq * 8 + k8) * 1024), 16, 0, 0); }
        const float m_c = MSTATE[task];
        const int tg = t0 + 32 * tq + i;
        const float bct = BC[(size_t)h * T + tg], amt = AM[(size_t)h * T + tg];
        bf16x8 qf[4];
#pragma unroll
        for (int ds = 0; ds < 4; ++ds) qf[ds] = *(const bf16x8*)(QM + (size_t)tg * 256 + h * 64 + 16 * ds + 8 * hh);
        float qn = 0.f;
#pragma unroll
        for (int ds = 0; ds < 4; ++ds) { const f32x4 n0 = *(const f32x4*)(NST + (size_t)task * 64 + 16 * ds + 8 * hh), n1 = *(const f32x4*)(NST + (size_t)task * 64 + 16 * ds + 8 * hh + 4);
            const u32x4 w = __builtin_bit_cast(u32x4, qf[ds]);
            qn += lo_bf(w.x) * n0[0] + hi_bf(w.x) * n0[1] + lo_bf(w.y) * n0[2] + hi_bf(w.y) * n0[3] + lo_bf(w.z) * n1[0] + hi_bf(w.z) * n1[1] + lo_bf(w.w) * n1[2] + hi_bf(w.w) * n1[3]; }
        qn = x32_sum(qn);
        const float M = fmaxf(m_c, amt), g = __expf(m_c - M), emt = __expf(-(bct + M));
        const bf16_t* mop = P2 + (size_t)tg * NP2 + 1536 + h * 128 + 4 * hh;
        u32x2 mov[4][4];
#pragma unroll
        for (int et = 0; et < 4; ++et)
#pragma unroll
            for (int g4 = 0; g4 < 4; ++g4) mov[et][g4] = *(const u32x2*)(mop + et * 32 + 8 * g4);
        asm volatile("s_waitcnt vmcnt(0)" ::: "memory"); __builtin_amdgcn_s_barrier(); asm volatile("" ::: "memory");
        const LAS unsigned char* rl = reg + lane * 16;
        f32x16 acc[4];
#pragma unroll
        for (int et = 0; et < 4; ++et) { acc[et] = zero16();
#pragma unroll
            for (int ds = 0; ds < 4; ++ds) acc[et] = __builtin_amdgcn_mfma_f32_32x32x16_bf16(*(const LAS bf16x8*)(rl + 16384 + (et * 4 + ds) * 1024), qf[ds], acc[et], 0, 0, 0);
#pragma unroll
            for (int r = 0; r < 16; ++r) acc[et][r] *= g; }
        float wsum = 0.f;
        for (int kt = 0; kt <= tq; ++kt) {
            f32x16 sc = zero16();
#pragma unroll
            for (int ds = 0; ds < 4; ++ds) sc = __builtin_amdgcn_mfma_f32_32x32x16_bf16(*(const LAS bf16x8*)(rl + (kt * 4 + ds) * 1024), qf[ds], sc, 0, 0, 0);
            const float* ap = AV + (size_t)h * T + t0 + 32 * kt + 8 * hh;
            const f32x4 a00 = *(const f32x4*)(ap), a01 = *(const f32x4*)(ap + 4), a10 = *(const f32x4*)(ap + 16), a11 = *(const f32x4*)(ap + 20);
#pragma unroll
            for (int r = 0; r < 16; ++r) { const float av = (r < 4) ? a00[r & 3] : (r < 8) ? a01[r & 3] : (r < 12) ? a10[r & 3] : a11[r & 3];
                const int ko = 16 * (r >> 3) + 8 * hh + (r & 7);
                float w = sc[r] * __expf(av - M);
                w = (kt == tq && ko > i) ? 0.f : w;
                sc[r] = w; wsum += w; }
            u32x4 wf[2];
#pragma unroll
            for (int sb = 0; sb < 2; ++sb) { wf[sb].x = cvt_pk_bf16(sc[8 * sb + 0], sc[8 * sb + 1]); wf[sb].y = cvt_pk_bf16(sc[8 * sb + 2], sc[8 * sb + 3]); wf[sb].z = cvt_pk_bf16(sc[8 * sb + 4], sc[8 * sb + 5]); wf[sb].w = cvt_pk_bf16(sc[8 * sb + 6], sc[8 * sb + 7]); }
#pragma unroll
            for (int et = 0; et < 4; ++et)
#pragma unroll
                for (int sb = 0; sb < 2; ++sb) acc[et] = __builtin_amdgcn_mfma_f32_32x32x16_bf16(*(const LAS bf16x8*)(rl + 32768 + (et * 8 + 2 * kt + sb) * 1024), __builtin_bit_cast(bf16x8, wf[sb]), acc[et], 0, 0, 0);
        }
        wsum = x32_sum(wsum);
        const float den = g * qn + wsum, idd = 1.0f / fmaxf(fabsf(den), emt);
        float ss = 0.f;
#pragma unroll
        for (int et = 0; et < 4; ++et)
#pragma unroll
            for (int r = 0; r < 16; ++r) { const float hv = acc[et][r] * idd; acc[et][r] = hv; ss += hv * hv; }
        ss = x32_sum(ss);
        const float rn = rsqrtf(ss * (1.0f / 128.0f) + EPS);
        bf16_t* op = cat + (size_t)tg * DM + 512 + h * 128 + 8 * hh;
        const float* gp = mng + h * 128 + 4 * hh;
#pragma unroll
        for (int et = 0; et < 4; ++et)
#pragma unroll
            for (int gq = 0; gq < 2; ++gq) { u32x2 w[2];
#pragma unroll
                for (int q = 0; q < 2; ++q) { const int g4 = 2 * gq + q; const f32x4 gv = *(const f32x4*)(gp + et * 32 + 8 * g4); const u32x2 mo = mov[et][g4];
                    const float o0 = lo_bf(mo.x), o1 = hi_bf(mo.x), o2 = lo_bf(mo.y), o3 = hi_bf(mo.y);
                    const float y0 = acc[et][4 * g4] * rn * gv[0] * __builtin_amdgcn_rcpf(1.0f + __expf(-o0)), y1 = acc[et][4 * g4 + 1] * rn * gv[1] * __builtin_amdgcn_rcpf(1.0f + __expf(-o1));
                    const float y2 = acc[et][4 * g4 + 2] * rn * gv[2] * __builtin_amdgcn_rcpf(1.0f + __expf(-o2)), y3 = acc[et][4 * g4 + 3] * rn * gv[3] * __builtin_amdgcn_rcpf(1.0f + __expf(-o3));
                    w[q].x = cvt_pk_bf16(y0, y1); w[q].y = cvt_pk_bf16(y2, y3); }
                const auto sa = __builtin_amdgcn_permlane32_swap(w[0].x, w[1].x, false, false), sb = __builtin_amdgcn_permlane32_swap(w[0].y, w[1].y, false, false);
                *(u32x4*)(op + et * 32 + 16 * gq) = (u32x4){sa[0], sb[0], sa[1], sb[1]}; }
        asm volatile("s_waitcnt lgkmcnt(0)" ::: "memory"); __builtin_amdgcn_s_barrier(); asm volatile("" ::: "memory");
    }
}

constexpr int NWAVES = 8;
constexpr int RING_BYTES = 131072;
constexpr int LDSCTL_OFF = RING_BYTES;
constexpr int LDS_BYTES = RING_BYTES + 5120;

enum Phase { PH_PREP = 0, PH_INPROJ = 1, PH_MIX0 = 2, PH_MIX1 = 3, PH_MIX2 = 4, PH_OUTPROJ = 5, PH_QKV = 6, PH_XATTN = 7, PH_COPROJ = 8, PH_ROUTER = 9, PH_G1 = 10, PH_G2 = 11, PH_COMBINE = 12, PH_END = 13 };

struct Args { const float* in[28]; float* out; unsigned char* ws; int ph_lo, ph_hi, pass_lo, pass_hi; };

struct CJob { const float* src; const float* g; unsigned char* dst; int Nsrc, k0, n0, mode, f8; float scale; };
__device__ __forceinline__ void conv_load(const CJob& j, f32x4 (&v)[2], int tid) {
    const int kk = tid >> 4, c4 = (tid & 15) * 4;
#pragma unroll
    for (int rep = 0; rep < 2; ++rep) v[rep] = *(const f32x4*)(j.src + (size_t)(j.k0 + kk + 32 * rep) * j.Nsrc + j.n0 + c4);
}
__device__ __forceinline__ void conv_put(LAS float* tile, const f32x4 (&v)[2], int tid) {
    const int kk = tid >> 4, c4 = (tid & 15) * 4;
#pragma unroll
    for (int rep = 0; rep < 2; ++rep)
#pragma unroll
        for (int q = 0; q < 4; ++q) tile[(kk + 32 * rep) * 65 + c4 + q] = v[rep][q];
}
__device__ __forceinline__ void conv_store(const LAS float* tile, const CJob& j, int tid) {
    const int n = tid >> 3, kc = tid & 7; float vals[8];
    f32x4 g0 = (f32x4){1.f, 1.f, 1.f, 1.f}, g1 = g0;
    if (j.g) { g0 = *(const f32x4*)(j.g + j.k0 + 8 * kc); g1 = *(const f32x4*)(j.g + j.k0 + 8 * kc + 4); }
#pragma unroll
    for (int q = 0; q < 8; ++q) vals[q] = tile[(8 * kc + q) * 65 + n] * (q < 4 ? g0[q & 3] : g1[q & 3]) * j.scale;
    const int sc = j.n0 + n; int drow = sc;
    if (j.mode == 1) { const int jj = sc >> 1, s = sc & 1; drow = 256 * (jj >> 7) + 128 * s + (jj & 127); }
    if (j.mode == 2) { drow = sc < 1024 ? sc : sc < 1536 ? sc + 1024 : sc < 2048 ? sc - 512 : sc < 2560 ? sc + 512 : sc - 1024; }
    if (j.f8) { unsigned w0 = 0u, w1 = 0u;
        w0 = __builtin_amdgcn_cvt_pk_fp8_f32(c8(vals[0]), c8(vals[1]), w0, false); w0 = __builtin_amdgcn_cvt_pk_fp8_f32(c8(vals[2]), c8(vals[3]), w0, true);
        w1 = __builtin_amdgcn_cvt_pk_fp8_f32(c8(vals[4]), c8(vals[5]), w1, false); w1 = __builtin_amdgcn_cvt_pk_fp8_f32(c8(vals[6]), c8(vals[7]), w1, true);
        *(u32x2*)(j.dst + (size_t)drow * 1024 + j.k0 + 8 * kc) = (u32x2){w0, w1}; }
    else { u32x4 w; w.x = cvt_pk_bf16(vals[0], vals[1]); w.y = cvt_pk_bf16(vals[2], vals[3]); w.z = cvt_pk_bf16(vals[4], vals[5]); w.w = cvt_pk_bf16(vals[6], vals[7]);
        *(u32x4*)(j.dst + ((size_t)drow * 1024 + j.k0 + 8 * kc) * 2) = w; }
}

__global__ void __launch_bounds__(NWAVES * 64, 2) fwd(Args args) {
    extern __shared__ __attribute__((aligned(16))) unsigned char lds_raw[];
    LAS unsigned char* lds = (LAS unsigned char*)lds_raw;
    volatile LAS unsigned* LCTL = (volatile LAS unsigned*)(lds + LDSCTL_OFF);
    const int wave = __builtin_amdgcn_readfirstlane(threadIdx.x >> 6);
#define lane lane_id()
#define tid (wave * 64 + lane_id())
    const int G = gridDim.x, bx = blockIdx.x;
    unsigned char* ws = args.ws;
    unsigned* ctl = (unsigned*)(ws + WS_CTL);
    const int lo = args.ph_lo, hi = args.ph_hi;
#ifndef PHMASK
#define PHMASK 0xffffff
#endif
#ifndef DUPMASK
#define DUPMASK 0x0
#endif
#define IN(k) (((PHMASK >> (k)) & 1) && lo <= (k) && (k) < hi)
#define NREP(k) ((((DUPMASK) >> (k)) & 1) ? 2 : 1)
#define ENDBAR(k) (BOTH(k) || (((DUPMASK) >> (k)) & 1))
#define BOTH(k) (IN(k) && IN((k) + 1))
    for (int u = tid; u < (LDS_BYTES - LDSCTL_OFF) / 4; u += NWAVES * 64) LCTL[u] = 0u;
    __syncthreads();
    XcdBarrier bar; bar.bar = ctl + CW_BAR; bar.x = 0; bar.st = LCTL; bar.wave = wave;
    const bool multi = (hi - lo) > 1 || (args.pass_hi - args.pass_lo) > 1 || (IN(PH_G1) && IN(PH_G2));
    if (multi) bar = xcd_barrier_post(ctl + CW_BAR, LCTL, wave);
#define GRID_BAR() xcd_barrier(bar)

    const float* x = args.in[0]; const float* mem = args.in[1];
    bf16_t* XB = (bf16_t*)(ws + WS_XB); bf16_t* PROJ = (bf16_t*)(ws + WS_PROJ); bf16_t* CAT = (bf16_t*)(ws + WS_CAT);
    bf16_t* MEMB = (bf16_t*)(ws + WS_MEMB); bf16_t* KV = (bf16_t*)(ws + WS_KV); bf16_t* VT2 = (bf16_t*)(ws + WS_VT2); bf16_t* VT1 = (bf16_t*)(ws + WS_VT1); unsigned char* H1F = ws + WS_H1F;
    bf16_t* WIN = (bf16_t*)(ws + WS_WIN); bf16_t* WOUT = (bf16_t*)(ws + WS_WOUT); bf16_t* WCQ = (bf16_t*)(ws + WS_WCQ); bf16_t* WCKV = (bf16_t*)(ws + WS_WCKV);
    bf16_t* WCO = (bf16_t*)(ws + WS_WCO); bf16_t* WR = (bf16_t*)(ws + WS_WR); unsigned char* W1F = ws + WS_W1; unsigned char* W2F = ws + WS_W2; unsigned char* H2F = ws + WS_H2F;
    float* RSTDX = (float*)(ws + WS_RSTDX); float* RSTDM = (float*)(ws + WS_RSTDM); float* B1P = (float*)(ws + WS_B1P); float* MISC = (float*)(ws + WS_MISC); float* RSTD2 = (float*)(ws + WS_RSTD2);
    float* SSP1 = (float*)(ws + WS_SSP1); float* SSP2 = (float*)(ws + WS_SSP2); float* GATES = (float*)(ws + WS_GATES);
    unsigned* TOKMAP = (unsigned*)(ws + WS_TOKMAP); float* GATEV = (float*)(ws + WS_GATEV); unsigned* LIST = (unsigned*)(ws + WS_LIST);
    unsigned char* YB = ws + WS_Y; unsigned char* HID = ws + WS_HID;

    if (IN(PH_PREP)) for (int rep_ = 0; rep_ < NREP(PH_PREP); ++rep_) {
        constexpr int J0 = 768, J1 = J0 + 256, J2 = J1 + 256, J3 = J2 + 512, J4 = J3 + 256, J5 = J4 + 16384, J6 = J5 + 8192;
        auto decode = [&](int it, CJob& j) {
            if (it < J0) { j = CJob{args.in[3], args.in[2], (unsigned char*)WIN, DIN, (it / 48) * 64, (it % 48) * 64, 2, 0, 1.0f}; }
            else if (it < J1) { const int r = it - J0; j = CJob{args.in[14], nullptr, (unsigned char*)WOUT, 1024, (r / 16) * 64, (r % 16) * 64, 0, 0, 1.0f}; }
            else if (it < J2) { const int r = it - J1; j = CJob{args.in[17], args.in[15], (unsigned char*)WCQ, 1024, (r / 16) * 64, (r % 16) * 64, 0, 1, 64.0f}; }
            else if (it < J3) { const int r = it - J2; j = CJob{args.in[18], args.in[16], (unsigned char*)WCKV, 2048, (r / 32) * 64, (r % 32) * 64, 0, 1, 64.0f}; }
            else if (it < J4) { const int r = it - J3; j = CJob{args.in[19], nullptr, (unsigned char*)WCO, 1024, (r / 16) * 64, (r % 16) * 64, 0, 1, 64.0f}; }
            else if (it < J5) { const int r = it - J4; const int e = r >> 9, q = r & 511; j = CJob{args.in[23] + (size_t)e * 1024 * 2048, args.in[20], W1F + (size_t)e * 2048 * 1024, 2048, (q / 32) * 64, (q % 32) * 64, 1, 1, 64.0f}; }
            else { const int r = it - J5; const int e = r >> 8, q = r & 255; j = CJob{args.in[25] + (size_t)e * 1024 * 1024, nullptr, W2F + (size_t)e * 1024 * 1024, 1024, (q / 16) * 64, (q % 16) * 64, 0, 1, 64.0f}; } };
        for (int it0 = bx * 4; it0 < J6; it0 += G * 4) {
            CJob jb[4]; f32x4 v[4][2];
#pragma unroll
            for (int q = 0; q < 4; ++q) { decode(it0 + q < J6 ? it0 + q : J6 - 1, jb[q]); conv_load(jb[q], v[q], tid); }
#pragma unroll
            for (int q = 0; q < 4; ++q) conv_put((LAS float*)lds + q * (64 * 65), v[q], tid);
            __syncthreads();
#pragma unroll
            for (int q = 0; q < 4; ++q) if (it0 + q < J6) conv_store((const LAS float*)lds + q * (64 * 65), jb[q], tid);
            __syncthreads();
        }
        for (int i = bx * 512 + tid; i < NEXP * 1024; i += G * 512) { const int e = i >> 10, k = i & 1023; WR[i] = (bf16_t)f2bf(args.in[21][k * NEXP + e] * args.in[20][k]); }
        for (int i = bx * 512 + tid; i < NEXP * 2048; i += G * 512) { const int e = i >> 11, rho = i & 2047; const int pn = rho >> 8, s = (rho >> 7) & 1, ii = rho & 127; B1P[i] = args.in[24][e * 2048 + 2 * (128 * pn + ii) + s]; }
        if (bx == 0 && wave == 0) { const float a = wave_sum(args.in[9][lane] * args.in[10][lane]), b = wave_sum(args.in[11][lane] * args.in[12][lane]);
            if (lane == 0) MISC[0] = expf(a) - expf(b) + LAMBDA_INIT; }
        {
            const float* win = args.in[3]; const float* g = args.in[2];
            float wg[4][4][8];
#pragma unroll
            for (int jj = 0; jj < 4; ++jj)
#pragma unroll
                for (int q = 0; q < 4; ++q) { const int k = 4 * lane + 256 * jj + q; const float gk = g[k];
                    const f32x4 a = *(const f32x4*)(win + (size_t)k * DIN + 3072), b = *(const f32x4*)(win + (size_t)k * DIN + 3076);
#pragma unroll
                    for (int j = 0; j < 4; ++j) { wg[jj][q][j] = a[j] * gk; wg[jj][q][4 + j] = b[j] * gk; } }
            const int gw = bx * NWAVES + wave, NGW = G * NWAVES;
            f32x4 vn[4];
            if (gw < T) { const f32x4* xr = (const f32x4*)(x + (size_t)gw * DM) + lane;
#pragma unroll
                for (int jj = 0; jj < 4; ++jj) vn[jj] = xr[64 * jj]; }
            for (int row = gw; row < T; row += NGW) {
                f32x4 v[4]; float ss = 0.f; float d[8];
#pragma unroll
                for (int jj = 0; jj < 4; ++jj) v[jj] = vn[jj];
                if (row + NGW < T) { const f32x4* xr = (const f32x4*)(x + (size_t)(row + NGW) * DM) + lane;
#pragma unroll
                    for (int jj = 0; jj < 4; ++jj) vn[jj] = xr[64 * jj]; }
#pragma unroll
                for (int j = 0; j < 8; ++j) d[j] = 0.f;
#pragma unroll
                for (int jj = 0; jj < 4; ++jj) {
#pragma unroll
                    for (int q = 0; q < 4; ++q) { ss += v[jj][q] * v[jj][q];
#pragma unroll
                        for (int j = 0; j < 8; ++j) d[j] += v[jj][q] * wg[jj][q][j]; } }
                ss = wave_sum(ss);
#pragma unroll
                for (int j = 0; j < 8; ++j) d[j] = wave_sum(d[j]);
                const float rs = rsqrtf(ss * (1.0f / DM) + EPS);
                u32x2* o8 = (u32x2*)(XB + (size_t)row * DM) + lane;
#pragma unroll
                for (int jj = 0; jj < 4; ++jj) { u32x2 w; w.x = cvt_pk_bf16(v[jj][0], v[jj][1]); w.y = cvt_pk_bf16(v[jj][2], v[jj][3]); o8[64 * jj] = w; }
                if (lane == 0) RSTDX[row] = rs;
                if (lane < 8) { float dv = d[0];
#pragma unroll
                    for (int j = 1; j < 8; ++j) dv = (lane == j) ? d[j] : dv;
                    dv *= rs; float r;
                    if (lane < 4) r = dv + args.in[6][lane];
                    else { const float z = dv + args.in[7][lane - 4]; r = (z >= 0.f) ? -log1pf(expf(-z)) : (z - log1pf(expf(z))); }
                    GATES[(size_t)row * 8 + lane] = r; }
            }
            for (int row = gw; row < MROWS; row += NGW) {
                const f32x4* xr = (const f32x4*)(mem + (size_t)row * DM) + lane;
                f32x4 v[4]; float ss = 0.f;
#pragma unroll
                for (int jj = 0; jj < 4; ++jj) { v[jj] = xr[64 * jj]; ss += (v[jj][0] * v[jj][0] + v[jj][1] * v[jj][1]) + (v[jj][2] * v[jj][2] + v[jj][3] * v[jj][3]); }
                ss = wave_sum(ss);
                unsigned* o4 = (unsigned*)((unsigned char*)MEMB + (size_t)row * DM) + lane;
#pragma unroll
                for (int jj = 0; jj < 4; ++jj) { unsigned w = 0u; w = __builtin_amdgcn_cvt_pk_fp8_f32(c8(v[jj][0]), c8(v[jj][1]), w, false); w = __builtin_amdgcn_cvt_pk_fp8_f32(c8(v[jj][2]), c8(v[jj][3]), w, true); o4[64 * jj] = w; }
                if (lane == 0) RSTDM[row] = rsqrtf(ss * (1.0f / DM) + EPS);
            }
        }
        if (ENDBAR(PH_PREP)) GRID_BAR();
    }

    if (IN(PH_INPROJ)) for (int rep_ = 0; rep_ < NREP(PH_INPROJ); ++rep_) {
        { ProbScaleBf16 P{(LAS unsigned*)(lds + LDSCTL_OFF + 2048), XB, WIN, T / 256, NP2 / 256, G, bx, PROJ, NP2, RSTDX, nullptr};
          pg8::gemm_phase<ProbScaleBf16, true>(lds, P, wave); }
        { ProbColScaleBf16 P{WIN + (size_t)NP2 * 1024, XB, 4, T / 256, G, bx, VT1, T, RSTDX};
          pg8::gemm_phase<ProbColScaleBf16, true>(lds, P, wave); }
        if (ENDBAR(PH_INPROJ)) GRID_BAR();
    }

    const int vx = (G % 8 == 0) ? (bx % 8) * (G / 8) + bx / 8 : bx;
    bf16_t* QM = (bf16_t*)(ws + WS_QM); bf16_t* KM = (bf16_t*)(ws + WS_KM); bf16_t* CSTB = (bf16_t*)(ws + WS_CSTB);
    float* BC = (float*)(ws + WS_BC); float* AV = (float*)(ws + WS_AV); float* AM = (float*)(ws + WS_AM); float* NLOC = (float*)(ws + WS_NLOC); float* NST = (float*)(ws + WS_NST);
    float* CH = (float*)(ws + WS_CH); float* MSTATE = (float*)(ws + WS_MSTATE); float* CLOC = (float*)(ws + WS_MST);
    if (IN(PH_MIX0)) for (int rep_ = 0; rep_ < NREP(PH_MIX0); ++rep_) {
        mlstm_prep_phase(lds, PROJ, VT1, GATES, args.in[4], args.in[5], QM, KM, BC, AV, AM, CH, NLOC, CLOC, G, vx, wave);
        if (ENDBAR(PH_MIX0)) GRID_BAR();
    }
    if (IN(PH_MIX1)) for (int rep_ = 0; rep_ < NREP(PH_MIX1); ++rep_) {
        mlstm_scan_phase(CLOC, NLOC, CH, CSTB, NST, MSTATE, G, bx, tid);
        if (ENDBAR(PH_MIX1)) GRID_BAR();
    }
    if (IN(PH_MIX2)) for (int rep_ = 0; rep_ < NREP(PH_MIX2); ++rep_) {
        mlstm_out_phase(lds, PROJ, VT1, QM, KM, BC, AV, AM, CSTB, NST, MSTATE, args.in[8], CAT, G, vx, wave);
        __syncthreads();
        const float lam = __hip_atomic_load(MISC, __ATOMIC_RELAXED, __HIP_MEMORY_SCOPE_AGENT);
        diffattn_phase(lds, PROJ, VT1, args.in[13], lam, CAT, G, vx, wave);
        if (ENDBAR(PH_MIX2)) GRID_BAR();
    }

    if (IN(PH_OUTPROJ)) for (int rep_ = 0; rep_ < NREP(PH_OUTPROJ); ++rep_) {
        ProbResidT<false, true, false> P{(LAS unsigned*)(lds + LDSCTL_OFF + 2048), CAT, WOUT, T / 256, 4, G, bx, nullptr, XB, XB, H1F, SSP1};
        pg8::gemm_phase<ProbResidT<false, true, false>, true>(lds, P, wave);
        if (ENDBAR(PH_OUTPROJ)) GRID_BAR();
    }

    if (IN(PH_QKV)) for (int rep_ = 0; rep_ < NREP(PH_QKV); ++rep_) {
        { ProbScaleT<true> P{(LAS unsigned*)(lds + LDSCTL_OFF + 2048), H1F, WCQ, T / 256, 4, G, bx, PROJ, 1024, nullptr, SSP1};
          pg8::gemm_phase<ProbScaleT<true>, true>(lds, P, wave); }
        { ProbKV P{(LAS unsigned*)(lds + LDSCTL_OFF + 2048), (const unsigned char*)MEMB, (const unsigned char*)WCKV, KV, VT2, RSTDM, G, bx};
          pg8::gemm_phase<ProbKV, true>(lds, P, wave); }
        if (ENDBAR(PH_QKV)) GRID_BAR();
    }

    if (IN(PH_XATTN)) for (int rep_ = 0; rep_ < NREP(PH_XATTN); ++rep_) {
        xattn_phase(lds, PROJ, KV, VT2, (unsigned char*)(PROJ + (size_t)T * 1024), G, vx, wave);
        if (ENDBAR(PH_XATTN)) GRID_BAR();
    }

    if (IN(PH_COPROJ)) for (int rep_ = 0; rep_ < NREP(PH_COPROJ); ++rep_) {
        ProbResidT<true, false, false> P{(LAS unsigned*)(lds + LDSCTL_OFF + 2048), (unsigned char*)(PROJ + (size_t)T * 1024), WCO, T / 256, 4, G, bx, nullptr, XB, CAT, nullptr, SSP2};
        pg8::gemm_phase<ProbResidT<true, false, false>, true>(lds, P, wave);
        if (ENDBAR(PH_COPROJ)) GRID_BAR();
    }

    if (IN(PH_ROUTER)) for (int rep_ = 0; rep_ < NREP(PH_ROUTER); ++rep_) {
        { u32x4 wv[8];
#pragma unroll
          for (int q = 0; q < 8; ++q) { const int idx = q * (NWAVES * 64) + tid, ks = idx >> 6, ln = idx & 63; wv[q] = *(const u32x4*)(WR + (size_t)(ln & 31) * DM + 16 * ks + 8 * (ln >> 5)); }
#pragma unroll
          for (int q = 0; q < 8; ++q) { const int idx = q * (NWAVES * 64) + tid; *(LAS u32x4*)(lds + idx * 16) = wv[q]; } }
        __syncthreads();
        const float* brt = args.in[22];
        const int i = lane & 31, hh = lane >> 5;
        volatile LAS unsigned* lcnt = (volatile LAS unsigned*)(lds + 65536);
        const int ntrip = (T / 32 + G * NWAVES - 1) / (G * NWAVES);
        for (int trip = 0; trip < ntrip; ++trip) {
            const int tile = trip * G * NWAVES + bx * NWAVES + wave; const bool act = tile < T / 32;
            if (tid < 32) lcnt[tid] = 0u;
            __syncthreads();
            const int t = (act ? tile : 0) * 32 + i;
            const bf16_t* xp = CAT + (size_t)t * DM + 8 * hh;
            const f32x4 p0 = *(const f32x4*)(SSP2 + (size_t)t * 16 + 8 * hh), p1 = *(const f32x4*)(SSP2 + (size_t)t * 16 + 8 * hh + 4);
            float sp = (p0[0] + p0[1]) + (p0[2] + p0[3]) + (p1[0] + p1[1]) + (p1[2] + p1[3]); sp = x32_sum(sp);
            const float rs = rsqrtf(sp * (1.0f / DM) + EPS);
            f32x16 acc = zero16();
#pragma unroll 8
            for (int ks = 0; ks < 64; ks += 2) { bf16x8 xf[2]; unsigned pw[2][2];
#pragma unroll
                for (int q = 0; q < 2; ++q) { xf[q] = *(const bf16x8*)(xp + 16 * (ks + q)); const bf16x8 wf = *(const LAS bf16x8*)(lds + ((ks + q) * 64 + lane) * 16);
                    acc = __builtin_amdgcn_mfma_f32_32x32x16_bf16(wf, xf[q], acc, 0, 0, 0); }
                if (act) {
#pragma unroll
                    for (int q = 0; q < 2; ++q) { const u32x4 xw = __builtin_bit_cast(u32x4, xf[q]); unsigned w0 = 0u, w1 = 0u;
                        w0 = __builtin_amdgcn_cvt_pk_fp8_f32(lo_bf(xw.x) * rs, hi_bf(xw.x) * rs, w0, false); w0 = __builtin_amdgcn_cvt_pk_fp8_f32(lo_bf(xw.y) * rs, hi_bf(xw.y) * rs, w0, true);
                        w1 = __builtin_amdgcn_cvt_pk_fp8_f32(lo_bf(xw.z) * rs, hi_bf(xw.z) * rs, w1, false); w1 = __builtin_amdgcn_cvt_pk_fp8_f32(lo_bf(xw.w) * rs, hi_bf(xw.w) * rs, w1, true);
                        pw[q][0] = w0; pw[q][1] = w1; }
                    const auto sa = __builtin_amdgcn_permlane32_swap(pw[0][0], pw[1][0], false, false), sb = __builtin_amdgcn_permlane32_swap(pw[0][1], pw[1][1], false, false);
                    *(u32x4*)(H2F + (size_t)t * DM + 16 * ks + 16 * hh) = (u32x4){sa[0], sb[0], sa[1], sb[1]}; } }
            float mine[16], oth[16];
#pragma unroll
            for (int r = 0; r < 16; ++r) { const int e = (r & 3) + 8 * (r >> 2); mine[r] = acc[r] * rs + brt[e + 4 * hh]; }
#pragma unroll
            for (int r = 0; r < 16; ++r) oth[r] = x32_other(mine[r], hh);
            float lg[NEXP];
#pragma unroll
            for (int r = 0; r < 16; ++r) { const int e = (r & 3) + 8 * (r >> 2); lg[e] = hh ? oth[r] : mine[r]; lg[e + 4] = hh ? mine[r] : oth[r]; }
            unsigned taken = 0u; float tv[4]; int te[4];
#pragma unroll
            for (int k = 0; k < TOPK; ++k) { float best = -INFINITY; int bi = 0;
#pragma unroll
                for (int e = 0; e < NEXP; ++e) { const bool ok = !((taken >> e) & 1u) && (lg[e] > best); best = ok ? lg[e] : best; bi = ok ? e : bi; }
                taken |= 1u << bi; tv[k] = best; te[k] = bi; }
            const float q1 = __expf(tv[1] - tv[0]), q2 = __expf(tv[2] - tv[0]), q3 = __expf(tv[3] - tv[0]); const float inv = 1.0f / (1.0f + q1 + q2 + q3);
            const float gk[4] = {inv, q1 * inv, q2 * inv, q3 * inv};
            unsigned lp[4] = {0u, 0u, 0u, 0u};
            if (act && hh == 0) {
#pragma unroll
                for (int k = 0; k < TOPK; ++k) lp[k] = __hip_atomic_fetch_add((LAS unsigned*)(lcnt + te[k]), 1u, __ATOMIC_RELAXED, __HIP_MEMORY_SCOPE_WORKGROUP); }
            __syncthreads();
            if (tid < 32) { const unsigned n = lcnt[tid]; lcnt[32 + tid] = n ? atomicAdd(&ctl[CW_CNT + tid], n) : 0u; }
            __syncthreads();
            if (act && hh == 0) { RSTD2[t] = rs;
                unsigned tm[4];
#pragma unroll
                for (int k = 0; k < TOPK; ++k) { const unsigned pos = lcnt[32 + te[k]] + lp[k]; LIST[(size_t)te[k] * T + pos] = (unsigned)t; tm[k] = ((unsigned)te[k] << 16) | pos; }
                *(u32x4*)(TOKMAP + (size_t)t * 4) = (u32x4){tm[0], tm[1], tm[2], tm[3]};
                *(f32x4*)(GATEV + (size_t)t * 4) = (f32x4){gk[0], gk[1], gk[2], gk[3]}; }
            __syncthreads();
        }
        if (ENDBAR(PH_ROUTER)) GRID_BAR();
    }

    volatile LAS int* tab = (volatile LAS int*)(LCTL + 16);
    int Rtot = 0;
    if (IN(PH_G1) || IN(PH_G2) || IN(PH_COMBINE)) {
        if (tid < NEXP) tab[MOE_CNT + tid] = (int)__hip_atomic_load(&ctl[CW_CNT + tid], __ATOMIC_RELAXED, __HIP_MEMORY_SCOPE_AGENT);
        __syncthreads();
        if (tid == 0) { int ts = 0, st = 0;
            for (int e = 0; e < NEXP; ++e) { const int c = tab[MOE_CNT + e]; tab[MOE_TS + e] = ts; tab[MOE_ST + e] = st; ts += (c + 255) >> 8; st += c; }
            tab[MOE_TS + NEXP] = ts; tab[MOE_ST + NEXP] = st; }
        __syncthreads();
        Rtot = tab[MOE_TS + NEXP];
    }
    if (IN(PH_G1) || IN(PH_G2)) {
        __syncthreads();
        for (int rt = tid; rt < Rtot; rt += NWAVES * 64) { int e = 0;
            for (int j = 1; j < NEXP; ++j) if (rt >= tab[MOE_TS + j]) e = j;
            ((volatile LAS unsigned char*)(tab + MOE_RTE))[rt] = (unsigned char)e; }
        __syncthreads();
        if (IN(PH_G1)) for (int rep_ = 0; rep_ < NREP(PH_G1); ++rep_) { ProbMoe1 P{H2F, W1F, B1P, RSTD2, LIST, HID, tab, (LAS unsigned*)(lds + LDSCTL_OFF + 2048), 0, Rtot, G, bx};
            pg8::gemm_phase<ProbMoe1, true>(lds, P, wave);
            if (IN(PH_G2) || NREP(PH_G1) > 1) GRID_BAR(); }
        if (IN(PH_G2)) for (int rep_ = 0; rep_ < NREP(PH_G2); ++rep_) { ProbMoe2 P{HID, W2F, args.in[26], YB, tab, (LAS unsigned*)(lds + LDSCTL_OFF + 2048), 0, Rtot, G, bx};
            pg8::gemm_phase<ProbMoe2, true>(lds, P, wave);
            if (IN(PH_COMBINE) || NREP(PH_G2) > 1) GRID_BAR(); }
    }
    if (IN(PH_COMBINE)) {
        const float* gf = args.in[27];
        const int gw = bx * NWAVES + wave, NGW = G * NWAVES;
        f32x4 gfv[4];
#pragma unroll
        for (int jj = 0; jj < 4; ++jj) gfv[jj] = *((const f32x4*)gf + 4 * lane + jj);
        u32x4 tmn = (u32x4){0u, 0u, 0u, 0u}; f32x4 gkn = (f32x4){0.f, 0.f, 0.f, 0.f};
        if (gw < T) { tmn = *(const u32x4*)(TOKMAP + (size_t)gw * 4); gkn = *(const f32x4*)(GATEV + (size_t)gw * 4); }
        for (int t = gw; t < T; t += NGW) {
            const u32x4 tm = tmn; const f32x4 gk = gkn;
            if (t + NGW < T) { tmn = *(const u32x4*)(TOKMAP + (size_t)(t + NGW) * 4); gkn = *(const f32x4*)(GATEV + (size_t)(t + NGW) * 4); }
            const u32x4* hb = (const u32x4*)(CAT + (size_t)t * DM) + 2 * lane;
            const u32x4 h0 = hb[0], h1 = hb[1];
            u32x4 yv[4];
#pragma unroll
            for (int k = 0; k < TOPK; ++k) { const int e = (int)(tm[k] >> 16), pos = (int)(tm[k] & 0xffffu); const size_t yrow = (size_t)(tab[MOE_ST + e] + pos);
                yv[k] = *((const u32x4*)(YB + yrow * DM) + lane); }
            float v[16];
            v[0] = lo_bf(h0.x); v[1] = hi_bf(h0.x); v[2] = lo_bf(h0.y); v[3] = hi_bf(h0.y); v[4] = lo_bf(h0.z); v[5] = hi_bf(h0.z); v[6] = lo_bf(h0.w); v[7] = hi_bf(h0.w);
            v[8] = lo_bf(h1.x); v[9] = hi_bf(h1.x); v[10] = lo_bf(h1.y); v[11] = hi_bf(h1.y); v[12] = lo_bf(h1.z); v[13] = hi_bf(h1.z); v[14] = lo_bf(h1.w); v[15] = hi_bf(h1.w);
#pragma unroll
            for (int k = 0; k < TOPK; ++k) { const float g16 = gk[k] * (1.0f / 16.0f);
#pragma unroll
                for (int q = 0; q < 4; ++q) { const f32x2 a = __builtin_amdgcn_cvt_pk_f32_fp8((int)yv[k][q], false), b2_ = __builtin_amdgcn_cvt_pk_f32_fp8((int)yv[k][q], true);
                    v[4 * q] += g16 * a[0]; v[4 * q + 1] += g16 * a[1]; v[4 * q + 2] += g16 * b2_[0]; v[4 * q + 3] += g16 * b2_[1]; } }
            float ss = 0.f;
#pragma unroll
            for (int q = 0; q < 16; ++q) ss += v[q] * v[q];
            ss = wave_sum(ss); const float rs = rsqrtf(ss * (1.0f / DM) + EPS);
            f32x4* orow = (f32x4*)(args.out + (size_t)t * DM) + 4 * lane;
#pragma unroll
            for (int jj = 0; jj < 4; ++jj) orow[jj] = (f32x4){v[4 * jj] * rs * gfv[jj][0], v[4 * jj + 1] * rs * gfv[jj][1], v[4 * jj + 2] * rs * gfv[jj][2], v[4 * jj + 3] * rs * gfv[jj][3]};
        }
    }
#undef IN
#undef BOTH
#undef GRID_BAR
#undef lane
#undef tid
}

extern "C" void kernel_launch(void* const* d_in, const int* in_sizes, int n_in, void* d_out, int out_size, void* d_ws, size_t ws_size, hipStream_t stream) {
    static int grid = 0;
    if (grid == 0) {
        if (n_in != 28 || out_size != T * DM || ws_size < WS_END) { fprintf(stderr, "kernel_launch: unexpected shapes: n_in %d out %d ws %zu\n", n_in, out_size, ws_size); grid = -1; return; }
        int dev = 0, cus = 0;
        if (hipGetDevice(&dev) != hipSuccess || hipDeviceGetAttribute(&cus, hipDeviceAttributeMultiprocessorCount, dev) != hipSuccess) { grid = -1; return; }
        if (hipFuncSetAttribute((const void*)fwd, hipFuncAttributeMaxDynamicSharedMemorySize, LDS_BYTES) != hipSuccess) { fprintf(stderr, "kernel_launch: hipFuncSetAttribute failed\n"); grid = -1; return; }
        int per_cu = 0;
        if (hipOccupancyMaxActiveBlocksPerMultiprocessor(&per_cu, (const void*)fwd, NWAVES * 64, LDS_BYTES) != hipSuccess || per_cu < 1) fprintf(stderr, "kernel_launch: occupancy query says %d\n", per_cu);
        (void)hipGetLastError();
        grid = cus;
    }
    if (grid < 0) return;
    (void)hipMemsetAsync((char*)d_ws + WS_CTL, 0, CTL_ZERO_BYTES, stream);
    Args a{};
    for (int i = 0; i < 28; ++i) a.in[i] = (const float*)d_in[i];
    a.out = (float*)d_out; a.ws = (unsigned char*)d_ws;
    unsigned char* ws = (unsigned char*)d_ws;
    auto run = [&](int lo, int hi, int p0, int p1) { a.ph_lo = lo; a.ph_hi = hi; a.pass_lo = p0; a.pass_hi = p1; hipLaunchKernelGGL(fwd, dim3(grid), dim3(NWAVES * 64), LDS_BYTES, stream, a); };
#ifdef MULTI_LAUNCH
    for (int ph = 0; ph < PH_G1; ++ph) run(ph, ph + 1, 0, 0);
    run(PH_G1, PH_G1 + 1, 0, 1); run(PH_G2, PH_G2 + 1, 0, 1);
    run(PH_COMBINE, PH_COMBINE + 1, 0, 0);
#else
    run(0, PH_END, 0, 5);
#endif
}
```

```cpp
#include <hip/hip_runtime.h>
#include <cstdio>
#include <cstdint>
#include <cmath>

#define GAS __attribute__((address_space(1)))
#define LAS __attribute__((address_space(3)))
typedef unsigned short bf16_t;
typedef short bf16x8 __attribute__((ext_vector_type(8)));
typedef float f32x4 __attribute__((ext_vector_type(4)));
typedef float f32x2 __attribute__((ext_vector_type(2)));
typedef unsigned u32x4 __attribute__((ext_vector_type(4)));
typedef unsigned u32x2 __attribute__((ext_vector_type(2)));
typedef int i32x8 __attribute__((ext_vector_type(8)));
typedef int i32x4 __attribute__((ext_vector_type(4)));

constexpr int BATCH = 32, SEQ = 2048, DM = 1024, T = BATCH * SEQ, MEMLEN = 256, MROWS = BATCH * MEMLEN;
constexpr int NPROJ = 3072, DIN = 3080, NP2 = 2048;
constexpr int NEXP = 32, TOPK = 4;
constexpr float EPS = 1e-5f;
constexpr float LAMBDA_INIT = 0.2f;

constexpr size_t MiB = 1u << 20;
constexpr size_t WS_CTL = 0, CTL_ZERO_BYTES = 64 * 1024;
constexpr size_t WS_RSTDX = 1 * MiB;
constexpr size_t WS_RSTDM = WS_RSTDX + (size_t)T * 4;
constexpr size_t WS_B1P = WS_RSTDM + (size_t)MROWS * 4;
constexpr size_t WS_MISC = WS_B1P + (size_t)NEXP * 2048 * 4;
constexpr size_t WS_RSTD2 = WS_MISC + 4096;
static_assert(WS_RSTD2 + (size_t)T * 4 <= 2 * MiB, "small region");
constexpr size_t WS_SSP1 = 2 * MiB;
constexpr size_t WS_SSP2 = 6 * MiB;
constexpr size_t WS_GATES = 10 * MiB;
constexpr size_t WS_TOKMAP = 12 * MiB;
constexpr size_t WS_GATEV = 13 * MiB;
constexpr size_t WS_LIST = 14 * MiB;
constexpr size_t WS_WIN = 24 * MiB;
constexpr size_t WS_WOUT = 30 * MiB;
constexpr size_t WS_WCQ = 32 * MiB;
constexpr size_t WS_WCKV = 34 * MiB;
constexpr size_t WS_WCO = 38 * MiB;
constexpr size_t WS_WR = 40 * MiB;
constexpr size_t WS_W1 = 64 * MiB;
constexpr size_t WS_H2F = 128 * MiB;
constexpr size_t WS_W2 = 192 * MiB;
constexpr size_t WS_XB = 256 * MiB;
constexpr size_t WS_PROJ = 384 * MiB;
constexpr size_t WS_H1F = 640 * MiB;
constexpr size_t WS_VT1 = 640 * MiB;
constexpr size_t WS_CAT = 768 * MiB;
constexpr size_t WS_MST = 896 * MiB;
constexpr size_t WS_MEMB = 962 * MiB;
constexpr size_t WS_KV = 978 * MiB;
constexpr size_t WS_VT2 = 994 * MiB;
constexpr size_t WS_QM = 128 * MiB;
constexpr size_t WS_KM = 160 * MiB;
constexpr size_t WS_CSTB = 224 * MiB;
constexpr size_t WS_BC = 1010 * MiB;
constexpr size_t WS_AV = 1011 * MiB;
constexpr size_t WS_AM = 1012 * MiB;
constexpr size_t WS_NLOC = 1013 * MiB;
constexpr size_t WS_NST = WS_NLOC + 512 * 1024;
constexpr size_t WS_CH = 1014 * MiB;
constexpr size_t WS_MSTATE = WS_CH + 64 * 1024;
constexpr size_t WS_Y = 256 * MiB;
constexpr size_t WS_HID = 512 * MiB;
constexpr size_t WS_HID1 = 896 * MiB;
constexpr size_t WS_END = 1024 * MiB;

constexpr int CW_CNT = 64;
constexpr int CW_BAR = 4096;
static_assert((CW_BAR + 3456) * 4 <= (int)CTL_ZERO_BYTES, "control words inside the per-call memset");

__device__ __forceinline__ float bf2f(bf16_t b) { return __uint_as_float(((unsigned)b) << 16); }
__device__ __forceinline__ unsigned f2bf(float f) { unsigned u = __float_as_uint(f); return (u + 0x7fffu + ((u >> 16) & 1u)) >> 16; }
__device__ __forceinline__ unsigned cvt_pk_bf16(float lo, float hi) { unsigned r; asm volatile("v_cvt_pk_bf16_f32 %0, %1, %2" : "=v"(r) : "v"(lo), "v"(hi)); return r; }
__device__ __forceinline__ float x32_sum(float v) { auto r = __builtin_amdgcn_permlane32_swap(__float_as_uint(v), __float_as_uint(v), false, false); return __uint_as_float(r[0]) + __uint_as_float(r[1]); }
__device__ __forceinline__ float x32_max(float v) { auto r = __builtin_amdgcn_permlane32_swap(__float_as_uint(v), __float_as_uint(v), false, false); return fmaxf(__uint_as_float(r[0]), __uint_as_float(r[1])); }
__device__ __forceinline__ float x32_other(float v, int hh) { auto r = __builtin_amdgcn_permlane32_swap(__float_as_uint(v), __float_as_uint(v), false, false); return hh ? __uint_as_float(r[0]) : __uint_as_float(r[1]); }
__device__ __forceinline__ float x16_sum(float v) { auto r = __builtin_amdgcn_permlane16_swap(__float_as_uint(v), __float_as_uint(v), false, false); return __uint_as_float(r[0]) + __uint_as_float(r[1]); }
__device__ __forceinline__ float row16_sum(float v) {
    v += __uint_as_float((unsigned)__builtin_amdgcn_update_dpp(0, (int)__float_as_uint(v), 0xB1, 0xf, 0xf, true));
    v += __uint_as_float((unsigned)__builtin_amdgcn_update_dpp(0, (int)__float_as_uint(v), 0x4E, 0xf, 0xf, true));
    v += __uint_as_float((unsigned)__builtin_amdgcn_update_dpp(0, (int)__float_as_uint(v), 0x141, 0xf, 0xf, true));
    v += __uint_as_float((unsigned)__builtin_amdgcn_update_dpp(0, (int)__float_as_uint(v), 0x140, 0xf, 0xf, true));
    return v; }
__device__ __forceinline__ float wave_sum(float v) { return x32_sum(x16_sum(row16_sum(v))); }
__device__ __forceinline__ int lane_id() { int l; asm volatile("v_mbcnt_lo_u32_b32 %0, -1, 0\n\tv_mbcnt_hi_u32_b32 %0, -1, %0" : "=v"(l)); return l; }
__device__ __forceinline__ float c8(float x) { return __builtin_amdgcn_fmed3f(x, -448.0f, 448.0f); }
__device__ __forceinline__ float lo_bf(unsigned w) { return __uint_as_float(w << 16); }
__device__ __forceinline__ float hi_bf(unsigned w) { return __uint_as_float(w & 0xffff0000u); }

namespace pg8 {
constexpr int BM = 256, BK = 64, HALF = 128, HTB = HALF * BK * 2, STAGE_BYTES = 8 * HTB, NXCD = 8, WGM = 8, KD = 1024, NT = KD / BK;
__host__ __device__ __forceinline__ int lds_byte(int r, int c) { const int st = (r >> 4) * 2 + (c >> 5), rr = r & 15, cc = c & 31, ob = rr * 64 + cc * 2; return st * 1024 + (ob ^ (((ob >> 9) & 1) << 5)); }
__host__ __device__ __forceinline__ void stage_rc(int b, int& R, int& C) { const int st = b / 1024, sb = b % 1024, swz = sb ^ (((sb >> 9) & 1) << 5); R = (st >> 1) * 16 + swz / 64; C = (st & 1) * 32 + (swz % 64) / 2; }
__host__ __device__ __forceinline__ int perm32(int rho) { const int n = rho >> 4, i = rho & 15; return 8 * (i >> 2) + 4 * n + (i & 3); }

struct Unit { const char* A; const char* B; int pm, pn, e, nvalid, y0, aux; };

__device__ __forceinline__ bool static_next(int i, int G, int c, int nM, int nN, int& pm, int& pn) {
    const int nwg = nM * nN; const long L = (long)i * G + c; if (L >= nwg) return false;
    int wgid = (int)L; { const int q = nwg / NXCD, r = nwg % NXCD, xcd = wgid % NXCD, off = wgid / NXCD; wgid = (xcd < r ? xcd * (q + 1) : r * (q + 1) + (xcd - r) * q) + off; }
    const int nig = WGM * nN, gid = wgid / nig, fm = gid * WGM, gsz = (nM - fm) < WGM ? (nM - fm) : WGM;
    pm = fm + ((wgid % nig) % gsz); pn = (wgid % nig) / gsz; return true;
}

template <class P, bool ALIGN_EPI>
__device__ __forceinline__ void gemm_phase(LAS unsigned char* lds, const P& prob, const int wid) {
    const int lane = lane_id(), tid = wid * 64 + lane, wr = wid >> 2, wc = wid & 3, fr = lane & 15, fq = lane >> 4;
    constexpr int ROWB = P::FP8 ? KD : 2 * KD;
    constexpr int nt = ROWB / 128;
    int RA[2], CA[2]; unsigned voffA[2], voffB[2];
#pragma unroll
    for (int i = 0; i < 2; ++i) { int R, C; stage_rc(tid * 16 + i * 8192, R, C); const int Rb = P::PERM ? ((R & ~31) + perm32(R & 31)) : R;
        RA[i] = R; CA[i] = C * 2; voffA[i] = (unsigned)(R * ROWB + C * 2); voffB[i] = (unsigned)(Rb * ROWB + C * 2); }
    constexpr int kstep = BK * 2;
    constexpr size_t hstep = (size_t)HALF * ROWB;
    const unsigned ldsw = (unsigned)wid * 1024u;
    const int aoff = lds_byte(wr * 64 + fr, fq * 8), boff = lds_byte(wc * 32 + fr, fq * 8);
#define PG8_SA(b, h) (((b) * 2 + (h)) * HTB)
#define PG8_SB(b, h) ((4 + (b) * 2 + (h)) * HTB)
#define PG8_STAGE_B(bufoff, gbase) do { _Pragma("unroll") for (int _i = 0; _i < 2; ++_i) \
        __builtin_amdgcn_global_load_lds((const unsigned*)((const char*)(gbase) + voffB[_i]), (LAS unsigned*)(lds + (bufoff) + ldsw + _i * 8192), 16, 0, 0); } while (0)
#define PG8_STAGE_A(bufoff, gbase, off, h) do { _Pragma("unroll") for (int _i = 0; _i < 2; ++_i) { const char* _p; \
        if constexpr (P::GATHER) _p = (const char*)(gbase) + (off)[h][_i]; else _p = (const char*)(gbase) + (size_t)(h) * hstep + voffA[_i]; \
        __builtin_amdgcn_global_load_lds((const unsigned*)_p, (LAS unsigned*)(lds + (bufoff) + ldsw + _i * 8192), 16, 0, 0); } } while (0)
#define PG8_LDA(dst, b, h) do { _Pragma("unroll") for (int m = 0; m < 4; ++m) _Pragma("unroll") for (int k = 0; k < 2; ++k) dst[m][k] = *(const LAS bf16x8*)(lds + PG8_SA(b, h) + aoff + m * 2048 + k * 1024); } while (0)
#define PG8_LDB(dst, b, h) do { _Pragma("unroll") for (int n = 0; n < 2; ++n) _Pragma("unroll") for (int k = 0; k < 2; ++k) dst[n][k] = *(const LAS bf16x8*)(lds + PG8_SB(b, h) + boff + n * 2048 + k * 1024); } while (0)
#define PG8_MMA(ai, bj, At, Bt) do { __builtin_amdgcn_s_setprio(1); _Pragma("unroll") for (int m = 0; m < 4; ++m) _Pragma("unroll") for (int n = 0; n < 2; ++n) { \
        if constexpr (P::FP8) { const i32x4 b0_ = __builtin_bit_cast(i32x4, Bt[n][0]), b1_ = __builtin_bit_cast(i32x4, Bt[n][1]), a0_ = __builtin_bit_cast(i32x4, At[m][0]), a1_ = __builtin_bit_cast(i32x4, At[m][1]); \
            acc[ai][bj][m][n] = __builtin_amdgcn_mfma_scale_f32_16x16x128_f8f6f4((i32x8){b0_[0], b0_[1], b0_[2], b0_[3], b1_[0], b1_[1], b1_[2], b1_[3]}, (i32x8){a0_[0], a0_[1], a0_[2], a0_[3], a1_[0], a1_[1], a1_[2], a1_[3]}, \
                acc[ai][bj][m][n], 0, 0, 0, 0x7f7f7f7f, 0, 0x7f7f7f7f); } \
        else { _Pragma("unroll") for (int k = 0; k < 2; ++k) acc[ai][bj][m][n] = __builtin_amdgcn_mfma_f32_16x16x32_bf16(Bt[n][k], At[m][k], acc[ai][bj][m][n], 0, 0, 0); } } \
        __builtin_amdgcn_s_setprio(0); } while (0)
#define PG8_WAIT_V(n) asm volatile("s_waitcnt vmcnt(" #n ")" ::: "memory")
#define PG8_WAIT_L(n) asm volatile("s_waitcnt lgkmcnt(" #n ")" ::: "memory")
#define PG8_BAR __builtin_amdgcn_s_barrier()
#define PG8_SCHED __builtin_amdgcn_sched_barrier(0)
    Unit cur, nxt; int ui = 0;
    if (!prob.next(0, cur)) return;
    f32x4 acc[2][2][4][2];
#pragma unroll
    for (int a = 0; a < 2; ++a)
#pragma unroll
        for (int b = 0; b < 2; ++b)
#pragma unroll
            for (int m = 0; m < 4; ++m)
#pragma unroll
                for (int n = 0; n < 2; ++n) acc[a][b][m][n] = (f32x4){0.f, 0.f, 0.f, 0.f};
    bf16x8 At[4][2], B0[2][2], B1[2][2];
    unsigned offC[2][2] = {{0u, 0u}, {0u, 0u}};
#define PG8_FILL(u, buf) do { if (tid < 256) prob.gtab[(buf) * 256 + tid] = prob.a_off(u, tid); } while (0)
#define PG8_OFFS(buf) do { _Pragma("unroll") for (int _h = 0; _h < 2; ++_h) _Pragma("unroll") for (int _i = 0; _i < 2; ++_i) offC[_h][_i] = prob.gtab[(buf) * 256 + _h * HALF + RA[_i]] + (unsigned)CA[_i]; } while (0)
    Unit nx2;
    bool has_next = prob.next(1, nxt);
    if constexpr (P::GATHER) { PG8_FILL(cur, 0); if (has_next) PG8_FILL(nxt, 1); PG8_WAIT_L(0); PG8_BAR; PG8_OFFS(0); }
    const char* cA = prob.a_tile(cur); const char* cB = cur.B;
    PG8_STAGE_B(PG8_SB(0, 0), cB); PG8_STAGE_B(PG8_SB(0, 1), cB + hstep); PG8_STAGE_A(PG8_SA(0, 0), cA, offC, 0); PG8_STAGE_A(PG8_SA(0, 1), cA, offC, 1);
    if (wr == 1) PG8_BAR;
    PG8_WAIT_V(2); PG8_BAR;
    PG8_STAGE_B(PG8_SB(1, 0), cB + kstep); PG8_STAGE_A(PG8_SA(1, 0), cA + kstep, offC, 0); PG8_STAGE_B(PG8_SB(1, 1), cB + hstep + kstep);
    PG8_WAIT_V(6); PG8_BAR;
    int bcur = 0;
    for (;;) {
        const bool has_nx2 = has_next && prob.next(ui + 2, nx2);
        const char* nA = has_next ? prob.a_tile(nxt) : cA; const char* nB = has_next ? nxt.B : cB;
        const int bnext = bcur == 2 ? 0 : bcur + 1, bnx2 = bnext == 2 ? 0 : bnext + 1;
#pragma unroll 1
        for (int t = 0; t < nt; t += 2) {
            const bool last = (t == nt - 2);
            const char* a1 = cA + (size_t)(t + 1) * kstep;
            const char* a2 = last ? nA : cA + (size_t)(t + 2) * kstep; const char* b2 = last ? nB : cB + (size_t)(t + 2) * kstep;
            const char* a3 = a2 + kstep; const char* b3 = b2 + kstep;
            PG8_LDB(B0, 0, 0); PG8_LDB(B1, 0, 1); PG8_SCHED; PG8_LDA(At, 0, 0); PG8_STAGE_A(PG8_SA(1, 1), a1, offC, 1);
            if constexpr (P::GATHER) { if (last && has_next) PG8_OFFS(bnext); }
            PG8_WAIT_V(8); PG8_WAIT_L(0); PG8_BAR; PG8_MMA(0, 0, At, B0); PG8_MMA(0, 1, At, B1); PG8_BAR; PG8_SCHED;
            PG8_LDA(At, 0, 1); PG8_STAGE_B(PG8_SB(0, 0), b2); PG8_STAGE_B(PG8_SB(0, 1), b2 + hstep); PG8_STAGE_A(PG8_SA(0, 0), a2, offC, 0);
            PG8_WAIT_V(8); PG8_WAIT_L(0); PG8_BAR; PG8_MMA(1, 0, At, B0); PG8_MMA(1, 1, At, B1); PG8_BAR; PG8_SCHED;
            PG8_LDB(B0, 1, 0); PG8_LDB(B1, 1, 1); PG8_SCHED; PG8_LDA(At, 1, 0); PG8_STAGE_A(PG8_SA(0, 1), a2, offC, 1);
            PG8_WAIT_V(8); PG8_WAIT_L(0); PG8_BAR; PG8_MMA(0, 0, At, B0); PG8_MMA(0, 1, At, B1); PG8_BAR; PG8_SCHED;
            PG8_LDA(At, 1, 1); PG8_STAGE_B(PG8_SB(1, 0), b3); PG8_STAGE_B(PG8_SB(1, 1), b3 + hstep); PG8_STAGE_A(PG8_SA(1, 0), a3, offC, 0);
            PG8_WAIT_V(8); PG8_WAIT_L(0); PG8_BAR; PG8_MMA(1, 0, At, B0); PG8_MMA(1, 1, At, B1); PG8_BAR; PG8_SCHED;
        }
        if constexpr (ALIGN_EPI) { if (wr == 0) PG8_BAR; }
        if constexpr (P::GATHER) { if (has_nx2) PG8_FILL(nx2, bnx2); }
        cur.aux = bcur;
        prob.epi(acc, cur, wr, wc, fr, fq);
        if (!has_next) break;
#pragma unroll
        for (int a = 0; a < 2; ++a)
#pragma unroll
            for (int b = 0; b < 2; ++b)
#pragma unroll
                for (int m = 0; m < 4; ++m)
#pragma unroll
                    for (int n = 0; n < 2; ++n) acc[a][b][m][n] = (f32x4){0.f, 0.f, 0.f, 0.f};
        cur = nxt; nxt = nx2; has_next = has_nx2; cA = nA; cB = nB; ++ui; bcur = bnext;
        if constexpr (ALIGN_EPI) { if (wr == 1) PG8_BAR; }
    }
    PG8_WAIT_V(0);
    if constexpr (!ALIGN_EPI) { if (wr == 0) PG8_BAR; }
    PG8_BAR;
#undef PG8_SA
#undef PG8_SB
#undef PG8_STAGE_A
#undef PG8_STAGE_B
#undef PG8_LDA
#undef PG8_LDB
#undef PG8_MMA
#undef PG8_WAIT_V
#undef PG8_WAIT_L
#undef PG8_BAR
#undef PG8_SCHED
#undef PG8_OFFS
#undef PG8_FILL
}
}

template <bool F8> struct ProbScaleT {
    static constexpr bool FP8 = F8, PERM = true, GATHER = F8;
    static constexpr int RB = F8 ? 1024 : 2048;
    __device__ __forceinline__ const char* a_tile(const pg8::Unit& u) const { return F8 ? u.A : u.A + (size_t)u.pm * (256 * RB); }
    LAS unsigned* gtab;
    const void* A; const void* Bt; int nM, nN, G, c;
    bf16_t* O; int ldo; const float* rstd; const float* ssp;
    __device__ __forceinline__ bool next(int i, pg8::Unit& u) const {
        int pm, pn; if (!pg8::static_next(i, G, c, nM, nN, pm, pn)) return false;
        u.A = (const char*)A; u.B = (const char*)Bt + (size_t)pn * 256 * RB; u.pm = pm; u.pn = pn; u.e = 0; u.nvalid = 256; u.y0 = 0; u.aux = 0; return true; }
    __device__ __forceinline__ unsigned a_off(const pg8::Unit& u, int r) const { return (unsigned)(u.pm * 256 + r) * (unsigned)RB; }
    __device__ __forceinline__ void epi(const f32x4 (&acc)[2][2][4][2], const pg8::Unit& u, int wr, int wc, int fr, int fq) const {
        asm volatile("" : "+v"(fr), "+v"(fq));
        const int rowu = u.pm * 256 + wr * 64;
        char* ub = (char*)O + ((size_t)rowu * ldo + u.pn * 256 + wc * 32) * 2;
        const unsigned lo = (unsigned)(fr * ldo + 8 * fq) * 2u;
        float rsv[8];
        if (rstd) {
#pragma unroll
            for (int q = 0; q < 8; ++q) rsv[q] = rstd[rowu + fr + (q >> 2) * 128 + (q & 3) * 16];
        } else { f32x4 pv[8];
#pragma unroll
            for (int q = 0; q < 8; ++q) pv[q] = *(const f32x4*)(ssp + (size_t)(rowu + fr + (q >> 2) * 128 + (q & 3) * 16) * 16 + fq * 4);
#pragma unroll
            for (int q = 0; q < 8; ++q) { float sq = (pv[q][0] + pv[q][1]) + (pv[q][2] + pv[q][3]); sq = x16_sum(sq); sq = x32_sum(sq); rsv[q] = rsqrtf(sq * (1.0f / 1024.0f) + EPS); } }
#pragma unroll
        for (int ai = 0; ai < 2; ++ai)
#pragma unroll
            for (int m = 0; m < 4; ++m) { const float rs = rsv[ai * 4 + m] * (F8 ? (1.0f / 64.0f) : 1.0f);
                char* rowp = ub + (size_t)(ai * 128 + m * 16) * ldo * 2 + lo;
#pragma unroll
                for (int bj = 0; bj < 2; ++bj) { const f32x4 v0 = acc[ai][bj][m][0] * rs, v1 = acc[ai][bj][m][1] * rs;
                    u32x4 w; w.x = cvt_pk_bf16(v0[0], v0[1]); w.y = cvt_pk_bf16(v0[2], v0[3]); w.z = cvt_pk_bf16(v1[0], v1[1]); w.w = cvt_pk_bf16(v1[2], v1[3]);
                    *(u32x4*)(rowp + bj * 256) = w; } }
    }
};
typedef ProbScaleT<false> ProbScaleBf16;
struct ProbColScaleBf16 {
    static constexpr bool FP8 = false, PERM = true, GATHER = false;
    __device__ __forceinline__ const char* a_tile(const pg8::Unit& u) const { return u.A + (size_t)u.pm * (256 * 2048); }
    const bf16_t* A; const bf16_t* Bt; int nM, nN, G, c;
    bf16_t* O; int ldo; const float* cs;
    __device__ __forceinline__ bool next(int i, pg8::Unit& u) const {
        const long L = (long)i * G + c; if (L >= (long)nM * nN) return false;
        const int pm = (int)(L % nM), pn = (int)(L / nM);
        u.A = (const char*)A; u.B = (const char*)(Bt + (size_t)pn * 256 * 1024); u.pm = pm; u.pn = pn; u.e = 0; u.nvalid = 256; u.y0 = 0; u.aux = 0; return true; }
    __device__ __forceinline__ unsigned a_off(const pg8::Unit& u, int r) const { return 0u; }
    __device__ __forceinline__ void epi(const f32x4 (&acc)[2][2][4][2], const pg8::Unit& u, int wr, int wc, int fr, int fq) const {
        asm volatile("" : "+v"(fr), "+v"(fq));
        const float* cp = cs + u.pn * 256 + wc * 32 + 8 * fq;
        f32x4 sc[2][2];
#pragma unroll
        for (int bj = 0; bj < 2; ++bj)
#pragma unroll
            for (int n = 0; n < 2; ++n) sc[bj][n] = *(const f32x4*)(cp + bj * 128 + 4 * n);
        char* ub = (char*)O + ((size_t)(u.pm * 256 + wr * 64) * ldo + u.pn * 256 + wc * 32) * 2;
        const unsigned lo = (unsigned)(fr * ldo + 8 * fq) * 2u;
#pragma unroll
        for (int ai = 0; ai < 2; ++ai)
#pragma unroll
            for (int m = 0; m < 4; ++m) { char* rowp = ub + (size_t)(ai * 128 + m * 16) * ldo * 2 + lo;
#pragma unroll
                for (int bj = 0; bj < 2; ++bj) { const f32x4 v0 = acc[ai][bj][m][0] * sc[bj][0], v1 = acc[ai][bj][m][1] * sc[bj][1];
                    u32x4 w; w.x = cvt_pk_bf16(v0[0], v0[1]); w.y = cvt_pk_bf16(v0[2], v0[3]); w.z = cvt_pk_bf16(v1[0], v1[1]); w.w = cvt_pk_bf16(v1[2], v1[3]);
                    *(u32x4*)(rowp + bj * 256) = w; } }
    }
};
struct ProbKV {
    static constexpr bool FP8 = true, PERM = true, GATHER = true;
    __device__ __forceinline__ const char* a_tile(const pg8::Unit& u) const { return u.A; }
    LAS unsigned* gtab;
    const unsigned char* memb; const unsigned char* wckv; bf16_t* Kout; bf16_t* VTout; const float* rstdm; int G, c;
    __device__ __forceinline__ bool next(int i, pg8::Unit& u) const {
        const long L = (long)i * G + c; if (L >= 256) return false;
        if (L < 128) { u.pm = (int)(L & 31); u.pn = (int)(L >> 5); u.e = 0; u.A = (const char*)memb; u.B = (const char*)(wckv + (size_t)u.pn * 256 * 1024); }
        else { const int l2 = (int)L - 128; u.pm = l2 & 3; u.pn = l2 >> 2; u.e = 1; u.A = (const char*)(wckv + (size_t)1024 * 1024); u.B = (const char*)(memb + (size_t)u.pn * 256 * 1024); }
        u.nvalid = 256; u.y0 = 0; u.aux = 0; return true; }
    __device__ __forceinline__ unsigned a_off(const pg8::Unit& u, int r) const { return (unsigned)(u.pm * 256 + r) * 1024u; }
    __device__ __forceinline__ void epi(const f32x4 (&acc)[2][2][4][2], const pg8::Unit& u, int wr, int wc, int fr, int fq) const {
        asm volatile("" : "+v"(fr), "+v"(fq));
        const int ldo = u.e ? MROWS : 1024;
        char* ub = (char*)(u.e ? VTout : Kout) + ((size_t)(u.pm * 256 + wr * 64) * ldo + u.pn * 256 + wc * 32) * 2;
        const unsigned lo = (unsigned)(fr * ldo + 8 * fq) * 2u;
        float rsv[8]; f32x4 sc[2][2];
        if (u.e == 0) {
#pragma unroll
            for (int q = 0; q < 8; ++q) rsv[q] = rstdm[u.pm * 256 + wr * 64 + fr + (q >> 2) * 128 + (q & 3) * 16] * (1.0f / 64.0f);
#pragma unroll
            for (int bj = 0; bj < 2; ++bj)
#pragma unroll
                for (int n = 0; n < 2; ++n) sc[bj][n] = (f32x4){1.f, 1.f, 1.f, 1.f};
        } else {
#pragma unroll
            for (int q = 0; q < 8; ++q) rsv[q] = 1.0f / 64.0f;
            const float* cp = rstdm + u.pn * 256 + wc * 32 + 8 * fq;
#pragma unroll
            for (int bj = 0; bj < 2; ++bj)
#pragma unroll
                for (int n = 0; n < 2; ++n) sc[bj][n] = *(const f32x4*)(cp + bj * 128 + 4 * n); }
#pragma unroll
        for (int ai = 0; ai < 2; ++ai)
#pragma unroll
            for (int m = 0; m < 4; ++m) { const float rs = rsv[ai * 4 + m]; char* rowp = ub + (size_t)(ai * 128 + m * 16) * ldo * 2 + lo;
#pragma unroll
                for (int bj = 0; bj < 2; ++bj) { const f32x4 v0 = acc[ai][bj][m][0] * sc[bj][0] * rs, v1 = acc[ai][bj][m][1] * sc[bj][1] * rs;
                    u32x4 w; w.x = cvt_pk_bf16(v0[0], v0[1]); w.y = cvt_pk_bf16(v0[2], v0[3]); w.z = cvt_pk_bf16(v1[0], v1[1]); w.w = cvt_pk_bf16(v1[2], v1[3]);
                    *(u32x4*)(rowp + bj * 256) = w; } }
    }
};
template <bool F8, bool WF8, bool RF32> struct ProbResidT {
    static constexpr bool FP8 = F8, PERM = true, GATHER = F8;
    static constexpr int RB = F8 ? 1024 : 2048;
    __device__ __forceinline__ const char* a_tile(const pg8::Unit& u) const { return F8 ? u.A : u.A + (size_t)u.pm * (256 * RB); }
    LAS unsigned* gtab;
    const void* A; const void* Bt; int nM, nN, G, c;
    const float* rf; const bf16_t* rb; bf16_t* ob; unsigned char* of8; float* ssp;
    __device__ __forceinline__ bool next(int i, pg8::Unit& u) const {
        int pm, pn; if (!pg8::static_next(i, G, c, nM, nN, pm, pn)) return false;
        u.A = (const char*)A; u.B = (const char*)Bt + (size_t)pn * 256 * RB; u.pm = pm; u.pn = pn; u.e = 0; u.nvalid = 256; u.y0 = 0; u.aux = 0; return true; }
    __device__ __forceinline__ unsigned a_off(const pg8::Unit& u, int r) const { return (unsigned)(u.pm * 256 + r) * (unsigned)RB; }
    __device__ __forceinline__ void epi(const f32x4 (&acc)[2][2][4][2], const pg8::Unit& u, int wr, int wc, int fr, int fq) const {
        asm volatile("" : "+v"(fr), "+v"(fq));
        const int rowu = u.pm * 256 + wr * 64;
        const size_t uoff = (size_t)rowu * 1024 + u.pn * 256 + wc * 32;
        const unsigned lo = (unsigned)(fr * 1024 + 8 * fq);
        const float sc = F8 ? (1.0f / 64.0f) : 1.0f;
#pragma unroll
        for (int ai = 0; ai < 2; ++ai) {
            f32x4 rv[4][2][2];
#pragma unroll
            for (int m = 0; m < 4; ++m) { const size_t ro = uoff + (size_t)(ai * 128 + m * 16) * 1024;
#pragma unroll
                for (int bj = 0; bj < 2; ++bj) {
                    if constexpr (RF32) { rv[m][bj][0] = *(const GAS f32x4*)(rf + ro + lo + bj * 128); rv[m][bj][1] = *(const GAS f32x4*)(rf + ro + lo + bj * 128 + 4); }
                    else { const u32x4 w = *(const GAS u32x4*)(rb + ro + lo + bj * 128); rv[m][bj][0] = (f32x4){lo_bf(w.x), hi_bf(w.x), lo_bf(w.y), hi_bf(w.y)}; rv[m][bj][1] = (f32x4){lo_bf(w.z), hi_bf(w.z), lo_bf(w.w), hi_bf(w.w)}; } } }
#pragma unroll
            for (int m = 0; m < 4; ++m) { const size_t ro = uoff + (size_t)(ai * 128 + m * 16) * 1024; float ss = 0.f;
                unsigned pk[2][2];
#pragma unroll
                for (int bj = 0; bj < 2; ++bj) { const f32x4 v0 = acc[ai][bj][m][0] * sc + rv[m][bj][0], v1 = acc[ai][bj][m][1] * sc + rv[m][bj][1];
                    ss += (v0[0] * v0[0] + v0[1] * v0[1]) + (v0[2] * v0[2] + v0[3] * v0[3]) + (v1[0] * v1[0] + v1[1] * v1[1]) + (v1[2] * v1[2] + v1[3] * v1[3]);
                    u32x4 w; w.x = cvt_pk_bf16(v0[0], v0[1]); w.y = cvt_pk_bf16(v0[2], v0[3]); w.z = cvt_pk_bf16(v1[0], v1[1]); w.w = cvt_pk_bf16(v1[2], v1[3]);
                    *(u32x4*)(ob + ro + lo + bj * 128) = w;
                    if constexpr (WF8) { unsigned w0 = 0u, w1 = 0u;
                        w0 = __builtin_amdgcn_cvt_pk_fp8_f32(c8(v0[0]), c8(v0[1]), w0, false); w0 = __builtin_amdgcn_cvt_pk_fp8_f32(c8(v0[2]), c8(v0[3]), w0, true);
                        w1 = __builtin_amdgcn_cvt_pk_fp8_f32(c8(v1[0]), c8(v1[1]), w1, false); w1 = __builtin_amdgcn_cvt_pk_fp8_f32(c8(v1[2]), c8(v1[3]), w1, true);
                        pk[bj][0] = w0; pk[bj][1] = w1; } }
                if constexpr (WF8) {
                    const auto s0 = __builtin_amdgcn_permlane16_swap(pk[0][0], pk[1][0], false, false), s1 = __builtin_amdgcn_permlane16_swap(pk[0][1], pk[1][1], false, false);
                    *(u32x4*)(of8 + ro + lo + ((fq & 1) ? 120u : 0u)) = (u32x4){s0[0], s1[0], s0[1], s1[1]}; }
                ss = x16_sum(ss); ss = x32_sum(ss);
                if (fq == 0) ssp[(size_t)(rowu + ai * 128 + m * 16 + fr) * 16 + u.pn * 4 + wc] = ss; } }
    }
};
__device__ __forceinline__ size_t hid_tile_off(int rt) { return rt < 1024 ? (size_t)rt * (256 * 1024) : (WS_HID1 - WS_HID) + (size_t)(rt - 1024) * (256 * 1024); }
constexpr int MOE_TS = 0, MOE_ST = 33, MOE_CNT = 66, MOE_RTE = 100, MOE_WORDS = 100 + 264;
struct ProbMoe1 {
    static constexpr bool FP8 = true, PERM = true, GATHER = true;
    __device__ __forceinline__ const char* a_tile(const pg8::Unit& u) const { return u.A; }
    const unsigned char* hb; const unsigned char* w1b; const float* b1p; const float* rstd2; const unsigned* list; unsigned char* hid;
    const volatile LAS int* tab; LAS unsigned* gtab; int rt0, nrt, G, c;
    __device__ __forceinline__ bool next(int i, pg8::Unit& u) const {
        const long L = (long)i * G + c; if (L >= (long)nrt * 8) return false;
        const int gidx = (int)(L >> 8), within = (int)(L & 255), gsz = (nrt - gidx * 32) < 32 ? (nrt - gidx * 32) : 32;
        const int rtl = gidx * 32 + within % gsz, pn = within / gsz, rt = rt0 + rtl;
        const int e = ((const volatile LAS unsigned char*)(tab + MOE_RTE))[rt];
        const int idx0 = (rt - tab[MOE_TS + e]) * 256;
        u.A = (const char*)hb; u.B = (const char*)(w1b + ((size_t)e * 2048 + (size_t)pn * 256) * 1024); u.pm = rt; u.pn = pn; u.e = e; u.nvalid = tab[MOE_CNT + e] - idx0; u.y0 = idx0; u.aux = 0; return true; }
    __device__ __forceinline__ unsigned tok_of(const pg8::Unit& u, int r) const { const int rr = r < u.nvalid ? r : 0; return list[(size_t)u.e * T + u.y0 + rr]; }
    __device__ __forceinline__ unsigned a_off(const pg8::Unit& u, int r) const { return tok_of(u, r) * 1024u; }
    __device__ __forceinline__ void epi(const f32x4 (&acc)[2][2][4][2], const pg8::Unit& u, int wr, int wc, int fr, int fq) const {
        asm volatile("" : "+v"(fr), "+v"(fq));
        const float* bp = b1p + (size_t)u.e * 2048 + u.pn * 256 + wc * 32 + 8 * fq;
        const f32x4 bg0 = *(const f32x4*)(bp), bg1 = *(const f32x4*)(bp + 4), bl0 = *(const f32x4*)(bp + 128), bl1 = *(const f32x4*)(bp + 132);
        char* ub = (char*)hid + hid_tile_off(u.pm) + ((size_t)(wr * 64) * 1024 + u.pn * 128 + wc * 32);
        const unsigned lo = (unsigned)(fr * 1024 + 8 * fq);
        unsigned wk[2][2];
#pragma unroll
        for (int ai = 0; ai < 2; ++ai)
#pragma unroll
            for (int m = 0; m < 4; ++m) { const float rs = 1.0f / 64.0f;
                unsigned w[2];
#pragma unroll
                for (int n = 0; n < 2; ++n) { const f32x4 g4 = acc[ai][0][m][n] * rs + (n ? bg1 : bg0), l4 = acc[ai][1][m][n] * rs + (n ? bl1 : bl0);
                    unsigned wv = 0u;
#pragma unroll
                    for (int jp = 0; jp < 2; ++jp) {
                        f32x2 g2 = {fminf(g4[2 * jp], 7.0f), fminf(g4[2 * jp + 1], 7.0f)};
                        const f32x2 l2 = {__builtin_amdgcn_fmed3f(l4[2 * jp], -7.0f, 7.0f), __builtin_amdgcn_fmed3f(l4[2 * jp + 1], -7.0f, 7.0f)};
                        const f32x2 z2 = g2 * (-1.702f * 1.4426950408889634f);
                        const f32x2 d2 = (f32x2){__builtin_amdgcn_exp2f(z2[0]), __builtin_amdgcn_exp2f(z2[1])} + 1.0f;
                        const f32x2 r2 = {__builtin_amdgcn_rcpf(d2[0]), __builtin_amdgcn_rcpf(d2[1])};
                        const f32x2 o2 = (g2 * r2) * (l2 * 4.0f + 4.0f);
                        if (jp) wv = __builtin_amdgcn_cvt_pk_fp8_f32(o2[0], o2[1], wv, true); else wv = __builtin_amdgcn_cvt_pk_fp8_f32(o2[0], o2[1], wv, false); }
                    w[n] = wv; }
                wk[m & 1][0] = w[0]; wk[m & 1][1] = w[1];
                if (m & 1) {
                    const auto s0 = __builtin_amdgcn_permlane16_swap(wk[0][0], wk[1][0], false, false), s1 = __builtin_amdgcn_permlane16_swap(wk[0][1], wk[1][1], false, false);
                    *(u32x4*)(ub + (size_t)(ai * 128 + (m - 1) * 16) * 1024 + lo + ((fq & 1) ? 16u * 1024u - 8u : 0u)) = (u32x4){s0[0], s1[0], s0[1], s1[1]}; } }
    }
};
struct ProbMoe2 {
    static constexpr bool FP8 = true, PERM = true, GATHER = true;
    __device__ __forceinline__ const char* a_tile(const pg8::Unit& u) const { return u.A; }
    const unsigned char* hid; const unsigned char* w2b; const float* b2; unsigned char* y;
    const volatile LAS int* tab; LAS unsigned* gtab; int rt0, nrt, G, c;
    __device__ __forceinline__ bool next(int i, pg8::Unit& u) const {
        const long L = (long)i * G + c; if (L >= (long)nrt * 4) return false;
        const int gidx = (int)(L >> 8), within = (int)(L & 255), gsz = (nrt - gidx * 64) < 64 ? (nrt - gidx * 64) : 64;
        const int rtl = gidx * 64 + within % gsz, pn = within / gsz, rt = rt0 + rtl;
        const int e = ((const volatile LAS unsigned char*)(tab + MOE_RTE))[rt];
        const int idx0 = (rt - tab[MOE_TS + e]) * 256;
        u.A = (const char*)hid; u.B = (const char*)(w2b + ((size_t)e * 1024 + (size_t)pn * 256) * 1024); u.pm = rt; u.pn = pn; u.e = e; u.nvalid = tab[MOE_CNT + e] - idx0; u.y0 = tab[MOE_ST + e] + idx0; u.aux = 0; return true; }
    __device__ __forceinline__ unsigned a_off(const pg8::Unit& u, int r) const { return (unsigned)(hid_tile_off(u.pm) + (size_t)r * 1024u); }
    __device__ __forceinline__ void epi(const f32x4 (&acc)[2][2][4][2], const pg8::Unit& u, int wr, int wc, int fr, int fq) const {
        asm volatile("" : "+v"(fr), "+v"(fq));
        const float* bp = b2 + (size_t)u.e * 1024 + u.pn * 256 + wc * 32 + 8 * fq;
        f32x4 bv[2][2];
#pragma unroll
        for (int bj = 0; bj < 2; ++bj)
#pragma unroll
            for (int n = 0; n < 2; ++n) bv[bj][n] = *(const f32x4*)(bp + bj * 128 + 4 * n);
        char* ub = (char*)y + (((size_t)u.y0 + wr * 64) * 1024 + u.pn * 256 + wc * 32);
        const unsigned lo2 = (unsigned)(fr * 1024 + 8 * fq) + ((fq & 1) ? 120u : 0u);
        const int r0 = wr * 64 + fr;
#pragma unroll
        for (int ai = 0; ai < 2; ++ai)
#pragma unroll
            for (int m = 0; m < 4; ++m) { const int r = r0 + ai * 128 + m * 16;
                unsigned pk[2][2];
#pragma unroll
                for (int bj = 0; bj < 2; ++bj) { const f32x4 v0 = acc[ai][bj][m][0] * (1.0f / 16.0f) + bv[bj][0] * 16.0f, v1 = acc[ai][bj][m][1] * (1.0f / 16.0f) + bv[bj][1] * 16.0f;
                    unsigned w0 = 0u, w1 = 0u;
                    w0 = __builtin_amdgcn_cvt_pk_fp8_f32(c8(v0[0]), c8(v0[1]), w0, false); w0 = __builtin_amdgcn_cvt_pk_fp8_f32(c8(v0[2]), c8(v0[3]), w0, true);
                    w1 = __builtin_amdgcn_cvt_pk_fp8_f32(c8(v1[0]), c8(v1[1]), w1, false); w1 = __builtin_amdgcn_cvt_pk_fp8_f32(c8(v1[2]), c8(v1[3]), w1, true);
                    pk[bj][0] = w0; pk[bj][1] = w1; }
                const auto s0 = __builtin_amdgcn_permlane16_swap(pk[0][0], pk[1][0], false, false), s1 = __builtin_amdgcn_permlane16_swap(pk[0][1], pk[1][1], false, false);
                if (r < u.nvalid) *(u32x4*)(ub + (size_t)(ai * 128 + m * 16) * 1024 + lo2) = (u32x4){s0[0], s1[0], s0[1], s1[1]}; }
    }
};

#define XB_TMO      128
#define XB_XCNT(j)  (256  + 64 * (j))
#define XB_XSUB(j)  (1280 + 64 * (j))
#define XB_XGEN(j)  (2304 + 64 * (j))
#define XB_TOP      3328
#define XB_TOPGEN   3392
#define XCD_BAR_WORDS 3456
#define XB_SPIN_CAP (1u << 18)
__device__ __forceinline__ unsigned xb_ld(unsigned* p)              { return __hip_atomic_load(p, __ATOMIC_RELAXED, __HIP_MEMORY_SCOPE_AGENT); }
__device__ __forceinline__ unsigned xb_add(unsigned* p, unsigned v) { return __hip_atomic_fetch_add(p, v, __ATOMIC_RELAXED, __HIP_MEMORY_SCOPE_AGENT); }
__device__ __forceinline__ unsigned xb_xcc_id() { return (unsigned)__builtin_amdgcn_s_getreg((3 << 11) | 20) & 0xFu; }
#define XB_SPIN(cond, bar) do { unsigned _sp = 0; while (cond) { __builtin_amdgcn_s_sleep(1); \
    if ((++_sp & 255u) == 0u) { if (xb_ld(&(bar)[XB_TMO])) break; if (_sp > XB_SPIN_CAP) { atomicAdd(&(bar)[XB_TMO], 1u); break; } } } } while (0)
struct XcdBarrier { unsigned* bar; unsigned x; volatile LAS unsigned* st; int wave; };
__device__ __forceinline__ XcdBarrier xcd_barrier_post(unsigned* bar, volatile LAS unsigned* st, int wave) {
    XcdBarrier b; b.bar = bar; b.x = xb_xcc_id(); b.st = st; b.wave = wave;
    if (wave == 0 && lane_id() == 0) (void)xb_add(&bar[XB_XCNT(b.x)], 1u);
    return b;
}
__device__ __forceinline__ void xcd_barrier_complete(unsigned* bar, unsigned x, unsigned& nloc, unsigned& nx) {
    const unsigned G = gridDim.x * gridDim.y * gridDim.z;
    unsigned sum, cnt, mine, sp = 0u;
    for (;;) {
        sum = 0u; cnt = 0u; mine = 0u;
#pragma unroll
        for (unsigned j = 0; j < 16; ++j) { const unsigned c = xb_ld(&bar[XB_XCNT(j)]); sum += c; cnt += (c > 0u) ? 1u : 0u; mine = (j == x) ? c : mine; }
        if (sum == G) break;
        __builtin_amdgcn_s_sleep(1);
        if ((++sp & 255u) == 0u) { if (xb_ld(&bar[XB_TMO])) break; if (sp > XB_SPIN_CAP) { atomicAdd(&bar[XB_TMO], 1u); break; } }
    }
    nloc = mine > 0u ? mine : 1u; nx = cnt > 0u ? cnt : 1u;
}
__device__ __forceinline__ void xcd_barrier(const XcdBarrier& b) {
    asm volatile("s_waitcnt vmcnt(0)" ::: "memory");
    __syncthreads();
    if (b.wave == 0 && lane_id() == 0) {
        unsigned* bar = b.bar;
        __builtin_amdgcn_s_waitcnt(0);
        unsigned nloc = b.st[0], nx = b.st[1];
        if (nloc == 0u) { xcd_barrier_complete(bar, b.x, nloc, nx); b.st[0] = nloc; b.st[1] = nx; }
        const unsigned old = xb_add(&bar[XB_XSUB(b.x)], 1u);
        const unsigned gen = old / nloc;
        if (old + 1u == (gen + 1u) * nloc) {
            __builtin_amdgcn_fence(__ATOMIC_RELEASE, "agent");
            asm volatile("s_waitcnt vmcnt(0)" ::: "memory");
            const unsigned og = xb_add(&bar[XB_TOP], 1u);
            const unsigned tg = og / nx;
            if (og + 1u == (tg + 1u) * nx) xb_add(&bar[XB_TOPGEN], 1u);
            else XB_SPIN(xb_ld(&bar[XB_TOPGEN]) == tg, bar);
            __builtin_amdgcn_fence(__ATOMIC_ACQUIRE, "agent");
            xb_add(&bar[XB_XGEN(b.x)], 1u);
            asm volatile("s_waitcnt vmcnt(0)" ::: "memory");
        } else {
            XB_SPIN(xb_ld(&bar[XB_XGEN(b.x)]) == gen, bar);
            __builtin_amdgcn_fence(__ATOMIC_ACQUIRE, "agent");
            asm volatile("s_waitcnt vmcnt(0)" ::: "memory");
        }
    }
    __syncthreads();
}

typedef float f32x16 __attribute__((ext_vector_type(16)));
__device__ __forceinline__ int pi32(int i) { return (i & ~12) | ((i & 4) << 1) | ((i & 8) >> 1); }
__device__ __forceinline__ f32x16 zero16() { f32x16 z;
#pragma unroll
    for (int r = 0; r < 16; ++r) z[r] = 0.f;
    return z; }

__device__ __forceinline__ void xattn_phase(LAS unsigned char* lds, const bf16_t* Q, const bf16_t* Kb, const bf16_t* VT, unsigned char* O, int G, int bx, int wave) {
    const int lane = lane_id(), i = lane & 31, hh = lane >> 5;
    LAS unsigned char* ring = lds;
    for (int uid = bx; uid < BATCH * 4 * 8; uid += G) {
        const int b = uid >> 5, h = (uid >> 3) & 3, qblk = uid & 7;
        const int q0 = qblk * 256 + wave * 32;
        const bf16_t* qp = Q + (size_t)(b * SEQ + q0 + i) * 1024 + h * 256 + 8 * hh;
        bf16x8 qf[16];
#pragma unroll
        for (int ds = 0; ds < 16; ++ds) qf[ds] = *(const bf16x8*)(qp + 16 * ds);
        const bf16_t* ksrc = Kb + (size_t)(b * MEMLEN + pi32(i)) * 1024 + h * 256 + 16 * wave + 8 * hh;
        const bf16_t* vsrc = VT + (size_t)(h * 256 + i) * MROWS + b * MEMLEN + 32 * (wave >> 1) + 16 * (wave & 1) + 8 * hh;
#define XA_ISSUE(st_) do { LAS unsigned char* sl_ = ring + ((st_) & 3) * 16384; \
        if ((st_) < 8) { const bf16_t* g_ = ksrc + (size_t)(st_) * 32 * 1024; \
            __builtin_amdgcn_global_load_lds((const unsigned*)g_, (LAS unsigned*)(sl_ + wave * 1024), 16, 0, 0); \
            __builtin_amdgcn_global_load_lds((const unsigned*)(g_ + 128), (LAS unsigned*)(sl_ + (8 + wave) * 1024), 16, 0, 0); } \
        else { const bf16_t* g_ = vsrc + (size_t)((st_) - 8) * 32 * MROWS; \
            __builtin_amdgcn_global_load_lds((const unsigned*)g_, (LAS unsigned*)(sl_ + wave * 1024), 16, 0, 0); \
            __builtin_amdgcn_global_load_lds((const unsigned*)(g_ + 128), (LAS unsigned*)(sl_ + (8 + wave) * 1024), 16, 0, 0); } } while (0)
#define XA_SYNC(st_) do { const int n_ = ((st_) >= 11 ? 1 : 0) + ((st_) <= 14 ? 2 : 0) + ((st_) >= 10 ? 1 : 0) + ((st_) <= 13 ? 2 : 0) + ((st_) >= 9 ? 1 : 0); \
        if (n_ == 3) asm volatile("s_waitcnt vmcnt(3)" ::: "memory"); else if (n_ == 4) asm volatile("s_waitcnt vmcnt(4)" ::: "memory"); else if (n_ == 5) asm volatile("s_waitcnt vmcnt(5)" ::: "memory"); \
        else if (n_ == 6) asm volatile("s_waitcnt vmcnt(6)" ::: "memory"); else asm volatile("s_waitcnt vmcnt(7)" ::: "memory"); \
        __builtin_amdgcn_s_barrier(); asm volatile("" ::: "memory"); if ((st_) + 3 < 16) XA_ISSUE((st_) + 3); } while (0)
        XA_ISSUE(0); XA_ISSUE(1); XA_ISSUE(2);
        f32x16 s[8];
#pragma unroll
        for (int kt = 0; kt < 8; ++kt) { XA_SYNC(kt);
            const LAS unsigned char* sl = ring + (kt & 3) * 16384 + lane * 16;
            f32x16 acc = zero16();
#pragma unroll
            for (int q4 = 0; q4 < 4; ++q4) { __builtin_amdgcn_sched_barrier(0);
#pragma unroll
                for (int d4 = 0; d4 < 4; ++d4) { const int ds = q4 * 4 + d4; acc = __builtin_amdgcn_mfma_f32_32x32x16_bf16(*(const LAS bf16x8*)(sl + ds * 1024), qf[ds], acc, 0, 0, 0); } }
            s[kt] = acc; }
        float m = -INFINITY;
#pragma unroll
        for (int kt = 0; kt < 8; ++kt)
#pragma unroll
            for (int r = 0; r < 16; ++r) m = fmaxf(m, s[kt][r]);
        m = x32_max(m);
        const float c = 0.0625f * 1.4426950408889634f; float l = 0.f; const float mc = m * c;
        u32x4 pf[8][2];
#pragma unroll
        for (int kt = 0; kt < 8; ++kt) {
#pragma unroll
            for (int r = 0; r < 16; ++r) { const float p = __builtin_amdgcn_exp2f(s[kt][r] * c - mc); s[kt][r] = p; l += p; }
#pragma unroll
            for (int sb = 0; sb < 2; ++sb) { pf[kt][sb].x = cvt_pk_bf16(s[kt][8 * sb + 0], s[kt][8 * sb + 1]); pf[kt][sb].y = cvt_pk_bf16(s[kt][8 * sb + 2], s[kt][8 * sb + 3]);
                pf[kt][sb].z = cvt_pk_bf16(s[kt][8 * sb + 4], s[kt][8 * sb + 5]); pf[kt][sb].w = cvt_pk_bf16(s[kt][8 * sb + 6], s[kt][8 * sb + 7]); } }
        l = x32_sum(l);
        const float il = 1.0f / l;
        unsigned char* op = O + (size_t)(b * SEQ + q0 + i) * 1024 + h * 256 + 16 * hh;
#pragma unroll
        for (int dvt = 0; dvt < 8; ++dvt) { XA_SYNC(8 + dvt);
            const LAS unsigned char* sl = ring + (dvt & 3) * 16384 + lane * 16;
            f32x16 oacc = zero16();
#pragma unroll
            for (int q4 = 0; q4 < 4; ++q4) { __builtin_amdgcn_sched_barrier(0);
#pragma unroll
                for (int f4 = 0; f4 < 4; ++f4) { const int f = q4 * 4 + f4; oacc = __builtin_amdgcn_mfma_f32_32x32x16_bf16(*(const LAS bf16x8*)(sl + f * 1024), __builtin_bit_cast(bf16x8, pf[f >> 1][f & 1]), oacc, 0, 0, 0); } }
            unsigned wg[4];
#pragma unroll
            for (int g = 0; g < 4; ++g) { unsigned w = 0u; w = __builtin_amdgcn_cvt_pk_fp8_f32(c8(oacc[4 * g] * il), c8(oacc[4 * g + 1] * il), w, false); w = __builtin_amdgcn_cvt_pk_fp8_f32(c8(oacc[4 * g + 2] * il), c8(oacc[4 * g + 3] * il), w, true); wg[g] = w; }
            { const auto s02 = __builtin_amdgcn_permlane32_swap(wg[0], wg[2], false, false), s13 = __builtin_amdgcn_permlane32_swap(wg[1], wg[3], false, false);
              *(u32x4*)(op + dvt * 32) = (u32x4){s02[0], s02[1], s13[0], s13[1]}; } }
#undef XA_ISSUE
#undef XA_SYNC
    }
}

__device__ __forceinline__ void diffattn_phase(LAS unsigned char* lds, const bf16_t* P2, const bf16_t* VT, const float* dng, const float lam, bf16_t* cat, int G, int vx, int wave) {
    const int lane = lane_id(), i_ = lane & 31, hh_ = lane >> 5;
    LAS unsigned char* ring = lds;
    LAS unsigned char* ql = lds + 65536 + wave * 8192 + lane * 16;
    const float c = 0.125f * 1.4426950408889634f;
    for (int pu = vx; pu < BATCH * 4 * 4; pu += G)
        for (int side = 0; side < 2; ++side) {
            const int bh = pu >> 2, x = pu & 3, qb = side ? 7 - x : x, b = bh >> 2, h = bh & 3, q0 = qb * 256 + wave * 32;
            const int ntile = 8 * qb + 8, ktw = 8 * qb + wave;
            int i = i_, hh = hh_; asm volatile("" : "+v"(i), "+v"(hh));
            const bf16_t* qp = P2 + (size_t)(b * SEQ + q0 + i) * NP2 + h * 128 + 8 * hh;
            { bf16x8 t[8];
#pragma unroll
              for (int f = 0; f < 8; ++f) t[f] = *(const bf16x8*)(qp + 16 * f);
#pragma unroll
              for (int f = 0; f < 8; ++f) *(LAS bf16x8*)(ql + f * 1024) = t[f]; }
            const char* kbase = (const char*)(P2 + (size_t)b * SEQ * NP2 + 512 + h * 128 + (wave >> 2) * 64 + 16 * (wave & 3));
            const char* vbase = (const char*)(VT + (size_t)(h * 128 + 32 * (wave >> 1)) * T + (size_t)b * SEQ + 16 * (wave & 1));
            const unsigned koff = (unsigned)(pi32(i) * NP2 + 8 * hh) * 2u, voff = (unsigned)(i * T + 8 * hh) * 2u;
#define DA_ISSUE(kt_) do { LAS unsigned char* sl_ = ring + ((kt_) & 3) * 16384; \
        __builtin_amdgcn_global_load_lds((const unsigned*)(kbase + (size_t)(kt_) * (32 * NP2 * 2) + koff), (LAS unsigned*)(sl_ + wave * 1024), 16, 0, 0); \
        __builtin_amdgcn_global_load_lds((const unsigned*)(vbase + (kt_) * 64 + voff), (LAS unsigned*)(sl_ + (8 + wave) * 1024), 16, 0, 0); } while (0)
            f32x16 o1[4], o2[4];
#pragma unroll
            for (int d = 0; d < 4; ++d) { o1[d] = zero16(); o2[d] = zero16(); }
            float mc1 = -INFINITY, mc2 = -INFINITY, l1 = 0.f, l2 = 0.f;
            u32x4 pp1[2], pp2[2];
#pragma unroll
            for (int sb = 0; sb < 2; ++sb) { pp1[sb] = (u32x4){0u, 0u, 0u, 0u}; pp2[sb] = pp1[sb]; }
            DA_ISSUE(0); DA_ISSUE(1);
            for (int kt = 0; kt <= ntile; ++kt) {
                if (kt < ntile) {
                    if (kt + 1 < ntile) asm volatile("s_waitcnt vmcnt(2)" ::: "memory"); else asm volatile("s_waitcnt vmcnt(0)" ::: "memory");
                    __builtin_amdgcn_s_barrier(); asm volatile("" ::: "memory");
                    if (kt + 2 < ntile) DA_ISSUE(kt + 2);
                }
                if (kt <= ktw + 1) {
                    const LAS unsigned char* sl = ring + (kt & 3) * 16384 + lane * 16;
                    const LAS unsigned char* sp = ring + ((kt == 0 ? 0 : kt - 1) & 3) * 16384 + lane * 16;
                    f32x16 s1 = zero16(), s2 = zero16();
#pragma unroll
                    for (int ds = 0; ds < 4; ++ds) { s1 = __builtin_amdgcn_mfma_f32_32x32x16_bf16(*(const LAS bf16x8*)(sl + ds * 1024), *(const LAS bf16x8*)(ql + ds * 1024), s1, 0, 0, 0);
                        s2 = __builtin_amdgcn_mfma_f32_32x32x16_bf16(*(const LAS bf16x8*)(sl + (4 + ds) * 1024), *(const LAS bf16x8*)(ql + (4 + ds) * 1024), s2, 0, 0, 0);
                        if (ds & 1) __builtin_amdgcn_sched_barrier(0); }
                    if (kt >= ktw) { const int lim = (kt == ktw) ? i : -1;
#pragma unroll
                        for (int r = 0; r < 16; ++r) { const int ko = 16 * (r >> 3) + 8 * hh + (r & 7); if (ko > lim) { s1[r] = -INFINITY; s2[r] = -INFINITY; } } }
                    float f1 = 1.f, f2 = 1.f; bool rs1, rs2;
                    { float tm = s1[0];
#pragma unroll
                      for (int r = 1; r < 16; ++r) tm = fmaxf(tm, s1[r]);
                      tm = x32_max(tm); const float tmc = tm * c; rs1 = __any(tmc > mc1 + 8.0f);
                      if (rs1) { const float mn = fmaxf(mc1, tmc); f1 = __builtin_amdgcn_exp2f(mc1 - mn); mc1 = mn; } }
                    { float tm = s2[0];
#pragma unroll
                      for (int r = 1; r < 16; ++r) tm = fmaxf(tm, s2[r]);
                      tm = x32_max(tm); const float tmc = tm * c; rs2 = __any(tmc > mc2 + 8.0f);
                      if (rs2) { const float mn = fmaxf(mc2, tmc); f2 = __builtin_amdgcn_exp2f(mc2 - mn); mc2 = mn; } }
                    float ls1 = 0.f, ls2 = 0.f; u32x4 pn1[2], pn2[2];
#define DA_SM(j) do { { const float pv_ = __builtin_amdgcn_exp2f(s1[j] * c - mc1); s1[j] = pv_; ls1 += pv_; } { const float pv_ = __builtin_amdgcn_exp2f(s2[j] * c - mc2); s2[j] = pv_; ls2 += pv_; } \
                        if ((j) & 1) { pn1[(j) >> 3][((j) & 7) >> 1] = cvt_pk_bf16(s1[(j) - 1], s1[j]); pn2[(j) >> 3][((j) & 7) >> 1] = cvt_pk_bf16(s2[(j) - 1], s2[j]); } } while (0)
                    { bf16x8 va, vb;
#define DA_VLD(p) (*(const LAS bf16x8*)(sp + (8 + ((p) & 3) * 2 + ((p) >> 2)) * 1024))
#define DA_SLOT(j, VF, LDNEXT) do { if ((j) & 1) o2[((j) >> 1) & 3] = __builtin_amdgcn_mfma_f32_32x32x16_bf16(VF, __builtin_bit_cast(bf16x8, pp2[(j) >> 3]), o2[((j) >> 1) & 3], 0, 0, 0); \
                            else o1[((j) >> 1) & 3] = __builtin_amdgcn_mfma_f32_32x32x16_bf16(VF, __builtin_bit_cast(bf16x8, pp1[(j) >> 3]), o1[((j) >> 1) & 3], 0, 0, 0); \
                            LDNEXT; DA_SM(j); __builtin_amdgcn_sched_barrier(0); } while (0)
                      va = DA_VLD(0);
                      __builtin_amdgcn_sched_barrier(0);
                      DA_SLOT(0, va, vb = DA_VLD(1)); DA_SLOT(1, va, (void)0); DA_SLOT(2, vb, va = DA_VLD(2)); DA_SLOT(3, vb, (void)0);
                      DA_SLOT(4, va, vb = DA_VLD(3)); DA_SLOT(5, va, (void)0); DA_SLOT(6, vb, va = DA_VLD(4)); DA_SLOT(7, vb, (void)0);
                      DA_SLOT(8, va, vb = DA_VLD(5)); DA_SLOT(9, va, (void)0); DA_SLOT(10, vb, va = DA_VLD(6)); DA_SLOT(11, vb, (void)0);
                      DA_SLOT(12, va, vb = DA_VLD(7)); DA_SLOT(13, va, (void)0); DA_SLOT(14, vb, (void)0); DA_SLOT(15, vb, (void)0);
#undef DA_VLD
#undef DA_SLOT
                    }
#undef DA_SM
                    l1 = l1 * f1 + ls1; l2 = l2 * f2 + ls2;
                    if (rs1) {
#pragma unroll
                        for (int d = 0; d < 4; ++d)
#pragma unroll
                            for (int r = 0; r < 16; ++r) o1[d][r] *= f1; }
                    if (rs2) {
#pragma unroll
                        for (int d = 0; d < 4; ++d)
#pragma unroll
                            for (int r = 0; r < 16; ++r) o2[d][r] *= f2; }
#pragma unroll
                    for (int sb = 0; sb < 2; ++sb) { pp1[sb] = pn1[sb]; pp2[sb] = pn2[sb]; }
                }
            }
#undef DA_ISSUE
            l1 = x32_sum(l1); l2 = x32_sum(l2);
            int ie = i, he = hh; asm volatile("" : "+v"(ie), "+v"(he));
            const float i1 = 1.0f / l1, i2 = lam / l2; float ss = 0.f;
#pragma unroll
            for (int d = 0; d < 4; ++d)
#pragma unroll
                for (int r = 0; r < 16; ++r) { const float o = o1[d][r] * i1 - o2[d][r] * i2; o1[d][r] = o; ss += o * o; }
            ss = x32_sum(ss);
            const float rn = rsqrtf(ss * (1.0f / 128.0f) + EPS) * (1.0f - LAMBDA_INIT);
            bf16_t* op = cat + (size_t)(b * SEQ + q0 + ie) * DM + h * 128 + 8 * he;
            const float* gp = dng + h * 128 + 4 * he;
#pragma unroll
            for (int d = 0; d < 4; ++d)
#pragma unroll
                for (int g2 = 0; g2 < 2; ++g2) { u32x2 w[2];
#pragma unroll
                    for (int q = 0; q < 2; ++q) { const int g = 2 * g2 + q; const f32x4 gv = *(const f32x4*)(gp + d * 32 + 8 * g);
                        w[q].x = cvt_pk_bf16(o1[d][4 * g] * rn * gv[0], o1[d][4 * g + 1] * rn * gv[1]); w[q].y = cvt_pk_bf16(o1[d][4 * g + 2] * rn * gv[2], o1[d][4 * g + 3] * rn * gv[3]); }
                    const auto sa = __builtin_amdgcn_permlane32_swap(w[0].x, w[1].x, false, false), sb = __builtin_amdgcn_permlane32_swap(w[0].y, w[1].y, false, false);
                    *(u32x4*)(op + d * 32 + 16 * g2) = (u32x4){sa[0], sb[0], sa[1], sb[1]}; }
        }
}

__device__ __forceinline__ void mlstm_prep_phase(LAS unsigned char* lds, const bf16_t* P2, const bf16_t* VT, const float* gates, const float* conv_w, const float* conv_b,
                                                 bf16_t* QM, bf16_t* KM, float* BC, float* AV, float* AM, float* CH, float* NLOC, float* CLOC, int G, int vx, int wave) {
    const int lane = lane_id(), i = lane & 31, hh = lane >> 5;
    LAS unsigned char* kl = lds + wave * 16384;
    for (int task = vx * 8 + wave; task < BATCH * 4 * 16; task += G * 8) {
        const int bh = task >> 4, c = task & 15, b = bh >> 2, h = bh & 3;
        const int t0 = b * SEQ + c * 128, tA = t0 + 2 * lane;
        const float lf0 = gates[(size_t)tA * 8 + 4 + h], lf1 = gates[(size_t)(tA + 1) * 8 + 4 + h], ig0 = gates[(size_t)tA * 8 + h], ig1 = gates[(size_t)(tA + 1) * 8 + h];
        float incl = lf0 + lf1;
#pragma unroll
        for (int off = 1; off < 64; off <<= 1) { const float v = __shfl_up(incl, off); if (lane >= off) incl += v; }
        const float bc1 = incl, bc0 = incl - lf1, blast = __shfl(incl, 63);
        const float a0 = ig0 - bc0, a1 = ig1 - bc1;
        float pm = fmaxf(a0, a1);
#pragma unroll
        for (int off = 1; off < 64; off <<= 1) { const float v = __shfl_up(pm, off); if (lane >= off) pm = fmaxf(pm, v); }
        const float pmprev = __shfl_up(pm, 1);
        const float am1 = pm, am0 = (lane > 0) ? fmaxf(pmprev, a0) : a0, amall = __shfl(pm, 63);
        const float ws0 = __expf(a0 - amall), ws1 = __expf(a1 - amall);
        *(f32x2*)(BC + (size_t)h * T + tA) = (f32x2){bc0, bc1};
        *(f32x2*)(AV + (size_t)h * T + tA) = (f32x2){a0, a1};
        *(f32x2*)(AM + (size_t)h * T + tA) = (f32x2){am0, am1};
        if (lane == 0) { CH[task * 2] = blast; CH[task * 2 + 1] = blast + amall; }
        {
            const int r8 = lane >> 3, cg = lane & 7;
            float cw[2][5][8];
#pragma unroll
            for (int part = 0; part < 2; ++part) { const int ch0 = (part ? 256 : 0) + h * 64 + 8 * cg;
#pragma unroll
                for (int k = 0; k < 4; ++k) { const f32x4 a = *(const f32x4*)(conv_w + k * 512 + ch0), bq = *(const f32x4*)(conv_w + k * 512 + ch0 + 4);
#pragma unroll
                    for (int j = 0; j < 4; ++j) { cw[part][k][j] = a[j]; cw[part][k][4 + j] = bq[j]; } }
                { const f32x4 a = *(const f32x4*)(conv_b + ch0), bq = *(const f32x4*)(conv_b + ch0 + 4);
#pragma unroll
                    for (int j = 0; j < 4; ++j) { cw[part][4][j] = a[j]; cw[part][4][4 + j] = bq[j]; } } }
#pragma unroll 4
            for (int jb = 0; jb < 16; ++jb) {
                const int p = 8 * jb + r8, tg = t0 + p, tseq = c * 128 + p;
                const float wa = __shfl(ws0, p >> 1), wb = __shfl(ws1, p >> 1); const float wsp = (p & 1) ? wb : wa;
                u32x4 uw[2][4];
#pragma unroll
                for (int part = 0; part < 2; ++part)
#pragma unroll
                    for (int k = 0; k < 4; ++k) { uw[part][k] = (u32x4){0u, 0u, 0u, 0u};
                        if (tseq - 3 + k >= 0) uw[part][k] = *(const u32x4*)(P2 + (size_t)(tg - 3 + k) * NP2 + 1024 + (part ? 256 : 0) + h * 64 + 8 * cg); }
#pragma unroll
                for (int part = 0; part < 2; ++part) { float y[8];
#pragma unroll
                    for (int j = 0; j < 8; ++j) { float pj = cw[part][4][j];
#pragma unroll
                        for (int k = 0; k < 4; ++k) { const unsigned wv = (j < 2) ? uw[part][k].x : (j < 4) ? uw[part][k].y : (j < 6) ? uw[part][k].z : uw[part][k].w; pj += cw[part][k][j] * ((j & 1) ? hi_bf(wv) : lo_bf(wv)); }
                        y[j] = pj * __builtin_amdgcn_rcpf(1.0f + __expf(-pj)); }
                    if (part == 0) { u32x4 w; w.x = cvt_pk_bf16(y[0] * 0.125f, y[1] * 0.125f); w.y = cvt_pk_bf16(y[2] * 0.125f, y[3] * 0.125f); w.z = cvt_pk_bf16(y[4] * 0.125f, y[5] * 0.125f); w.w = cvt_pk_bf16(y[6] * 0.125f, y[7] * 0.125f);
                        *(u32x4*)(QM + (size_t)tg * 256 + h * 64 + 8 * cg) = w; }
                    else { u32x4 w; w.x = cvt_pk_bf16(y[0], y[1]); w.y = cvt_pk_bf16(y[2], y[3]); w.z = cvt_pk_bf16(y[4], y[5]); w.w = cvt_pk_bf16(y[6], y[7]);
                        *(u32x4*)(KM + (size_t)tg * 256 + h * 64 + 8 * cg) = w;
#pragma unroll
                        for (int j = 0; j < 8; ++j) { const int d = 8 * cg + j;
                            *(LAS unsigned short*)(kl + d * 256 + ((jb ^ (d & 15)) * 16) + r8 * 2) = (unsigned short)f2bf(y[j] * wsp); } } }
            }
        }
        { float ns = 0.f;
#pragma unroll
          for (int cq = 0; cq < 16; ++cq) { const u32x4 w = *(const LAS u32x4*)(kl + lane * 256 + ((cq ^ (lane & 15)) * 16));
              ns += (lo_bf(w.x) + hi_bf(w.x)) + (lo_bf(w.y) + hi_bf(w.y)) + (lo_bf(w.z) + hi_bf(w.z)) + (lo_bf(w.w) + hi_bf(w.w)); }
          NLOC[(size_t)task * 64 + lane] = ns; }
        f32x16 acc[4][2];
#pragma unroll
        for (int et = 0; et < 4; ++et) { acc[et][0] = zero16(); acc[et][1] = zero16(); }
        const bf16_t* vp = VT + (size_t)(512 + h * 128 + i) * T + t0 + 8 * hh;
#pragma unroll
        for (int k2 = 0; k2 < 8; k2 += 2) {
            bf16x8 af[2][4];
#pragma unroll
            for (int q = 0; q < 2; ++q)
#pragma unroll
                for (int et = 0; et < 4; ++et) af[q][et] = *(const bf16x8*)(vp + (size_t)et * 32 * T + 16 * (k2 + q));
            __builtin_amdgcn_sched_barrier(0);
#pragma unroll
            for (int q = 0; q < 2; ++q) { const int ks = k2 + q; bf16x8 bfr[2];
#pragma unroll
                for (int dt = 0; dt < 2; ++dt) { const int d = 32 * dt + i; bfr[dt] = *(const LAS bf16x8*)(kl + d * 256 + (((2 * ks + hh) ^ (d & 15)) * 16)); }
#pragma unroll
                for (int et = 0; et < 4; ++et) {
                    acc[et][0] = __builtin_amdgcn_mfma_f32_32x32x16_bf16(af[q][et], bfr[0], acc[et][0], 0, 0, 0); acc[et][1] = __builtin_amdgcn_mfma_f32_32x32x16_bf16(af[q][et], bfr[1], acc[et][1], 0, 0, 0); } }
            __builtin_amdgcn_sched_barrier(0);
        }
        float* cp = CLOC + (size_t)task * 8192 + i + 256 * hh;
#pragma unroll
        for (int et = 0; et < 4; ++et)
#pragma unroll
            for (int dt = 0; dt < 2; ++dt)
#pragma unroll
                for (int r = 0; r < 16; ++r) cp[(32 * et + (r & 3) + 8 * (r >> 2)) * 64 + 32 * dt] = acc[et][dt][r];
    }
}
__device__ __forceinline__ void mlstm_scan_phase(const float* CLOC, const float* NLOC, const float* CH, bf16_t* CSTB, float* NST, float* MSTATE, int G, int bx, int tid) {
    for (int idx = bx * 512 + tid; idx < BATCH * 4 * 1024; idx += G * 512) {
        const int bh = idx >> 10, rem = idx & 1023, e = rem >> 3, d0 = (rem & 7) * 8;
        float C[8], nr[8]; float m = 0.f;
#pragma unroll
        for (int j = 0; j < 8; ++j) { C[j] = 0.f; nr[j] = 0.f; }
#pragma unroll 1
        for (int c8 = 0; c8 < 16; c8 += 8) {
            f32x4 cl[8][2], nl[8][2]; float bl[8], ml[8];
#pragma unroll
            for (int q = 0; q < 8; ++q) { const int task = bh * 16 + c8 + q;
                cl[q][0] = *(const f32x4*)(CLOC + (size_t)task * 8192 + e * 64 + d0); cl[q][1] = *(const f32x4*)(CLOC + (size_t)task * 8192 + e * 64 + d0 + 4);
                bl[q] = CH[task * 2]; ml[q] = CH[task * 2 + 1];
                if (rem < 8) { nl[q][0] = *(const f32x4*)(NLOC + (size_t)task * 64 + rem * 8); nl[q][1] = *(const f32x4*)(NLOC + (size_t)task * 64 + rem * 8 + 4); }
                else { nl[q][0] = (f32x4){0.f, 0.f, 0.f, 0.f}; nl[q][1] = nl[q][0]; } }
#pragma unroll
            for (int q = 0; q < 8; ++q) { const int task = bh * 16 + c8 + q;
                u32x4 w; w.x = cvt_pk_bf16(C[0], C[1]); w.y = cvt_pk_bf16(C[2], C[3]); w.z = cvt_pk_bf16(C[4], C[5]); w.w = cvt_pk_bf16(C[6], C[7]);
                *(u32x4*)(CSTB + (size_t)task * 8192 + e * 64 + d0) = w;
                if (rem < 8) { *(f32x4*)(NST + (size_t)task * 64 + rem * 8) = (f32x4){nr[0], nr[1], nr[2], nr[3]}; *(f32x4*)(NST + (size_t)task * 64 + rem * 8 + 4) = (f32x4){nr[4], nr[5], nr[6], nr[7]}; }
                if (rem == 0) MSTATE[task] = m;
                const float mn = fmaxf(bl[q] + m, ml[q]), a = __expf(bl[q] + m - mn), bco = __expf(ml[q] - mn);
#pragma unroll
                for (int j = 0; j < 4; ++j) { C[j] = a * C[j] + bco * cl[q][0][j]; C[4 + j] = a * C[4 + j] + bco * cl[q][1][j]; nr[j] = a * nr[j] + bco * nl[q][0][j]; nr[4 + j] = a * nr[4 + j] + bco * nl[q][1][j]; }
                m = mn; }
        }
    }
}
__device__ __forceinline__ void mlstm_out_phase(LAS unsigned char* lds, const bf16_t* P2, const bf16_t* VT, const bf16_t* QM, const bf16_t* KM, const float* BC, const float* AV, const float* AM,
                                                const bf16_t* CSTB, const float* NST, const float* MSTATE, const float* mng, bf16_t* cat, int G, int vx, int wave) {
    const int lane_ = lane_id();
    const int cw = wave >> 2, tq = wave & 3;
    LAS unsigned char* reg = lds + cw * 65536;
    for (int un = vx; un < BATCH * 4 * 8; un += G) {
        int lane = lane_; asm volatile("" : "+v"(lane));
        const int i = lane & 31, hh = lane >> 5;
        const int task = 2 * un + cw, bh = task >> 4, c = task & 15, b = bh >> 2, h = bh & 3;
        const int t0 = b * SEQ + c * 128;
        { const bf16_t* ks = KM + (size_t)(t0 + 32 * tq + pi32(i)) * 256 + h * 64 + 8 * hh;
          const bf16_t* cs = CSTB + (size_t)task * 8192 + (32 * tq + i) * 64 + 8 * hh;
          const bf16_t* vs = VT + (size_t)(512 + h * 128 + 32 * tq + i) * T + t0 + 8 * hh;
#pragma unroll
          for (int ds = 0; ds < 4; ++ds) { __builtin_amdgcn_global_load_lds((const unsigned*)(ks + 16 * ds), (LAS unsigned*)(reg + (tq * 4 + ds) * 1024), 16, 0, 0);
              __builtin_amdgcn_global_load_lds((const unsigned*)(cs + 16 * ds), (LAS unsigned*)(reg + 16384 + (tq * 4 + ds) * 1024), 16, 0, 0); }
#pragma unroll
          for (int k8 = 0; k8 < 8; ++k8) __builtin_amdgcn_global_load_lds((const unsigned*)(vs + 16 * k8), (LAS unsigned*)(reg + 32768 + (tq * 8 + k8) * 1024), 16, 0, 0); }
        const float m_c = MSTATE[task];
        const int tg = t0 + 32 * tq + i;
        const float bct = BC[(size_t)h * T + tg], amt = AM[(size_t)h * T + tg];
        bf16x8 qf[4];
#pragma unroll
        for (int ds = 0; ds < 4; ++ds) qf[ds] = *(const bf16x8*)(QM + (size_t)tg * 256 + h * 64 + 16 * ds + 8 * hh);
        float qn = 0.f;
#pragma unroll
        for (int ds = 0; ds < 4; ++ds) { const f32x4 n0 = *(const f32x4*)(NST + (size_t)task * 64 + 16 * ds + 8 * hh), n1 = *(const f32x4*)(NST + (size_t)task * 64 + 16 * ds + 8 * hh + 4);
            const u32x4 w = __builtin_bit_cast(u32x4, qf[ds]);
            qn += lo_bf(w.x) * n0[0] + hi_bf(w.x) * n0[1] + lo_bf(w.y) * n0[2] + hi_bf(w.y) * n0[3] + lo_bf(w.z) * n1[0] + hi_bf(w.z) * n1[1] + lo_bf(w.w) * n1[2] + hi_bf(w.w) * n1[3]; }
        qn = x32_sum(qn);
        const float M = fmaxf(m_c, amt), g = __expf(m_c - M), emt = __expf(-(bct + M));
        const bf16_t* mop = P2 + (size_t)tg * NP2 + 1536 + h * 128 + 4 * hh;
        u32x2 mov[4][4];
#pragma unroll
        for (int et = 0; et < 4; ++et)
#pragma unroll
            for (int g4 = 0; g4 < 4; ++g4) mov[et][g4] = *(const u32x2*)(mop + et * 32 + 8 * g4);
        asm volatile("s_waitcnt vmcnt(0)" ::: "memory"); __builtin_amdgcn_s_barrier(); asm volatile("" ::: "memory");
        const LAS unsigned char* rl = reg + lane * 16;
        f32x16 acc[4];
#pragma unroll
        for (int et = 0; et < 4; ++et) { acc[et] = zero16();
#pragma unroll
            for (int ds = 0; ds < 4; ++ds) acc[et] = __builtin_amdgcn_mfma_f32_32x32x16_bf16(*(const LAS bf16x8*)(rl + 16384 + (et * 4 + ds) * 1024), qf[ds], acc[et], 0, 0, 0);
#pragma unroll
            for (int r = 0; r < 16; ++r) acc[et][r] *= g; }
        float wsum = 0.f;
        for (int kt = 0; kt <= tq; ++kt) {
            f32x16 sc = zero16();
#pragma unroll
            for (int ds = 0; ds < 4; ++ds) sc = __builtin_amdgcn_mfma_f32_32x32x16_bf16(*(const LAS bf16x8*)(rl + (kt * 4 + ds) * 1024), qf[ds], sc, 0, 0, 0);
            const float* ap = AV + (size_t)h * T + t0 + 32 * kt + 8 * hh;
            const f32x4 a00 = *(const f32x4*)(ap), a01 = *(const f32x4*)(ap + 4), a10 = *(const f32x4*)(ap + 16), a11 = *(const f32x4*)(ap + 20);
#pragma unroll
            for (int r = 0; r < 16; ++r) { const float av = (r < 4) ? a00[r & 3] : (r < 8) ? a01[r & 3] : (r < 12) ? a10[r & 3] : a11[r & 3];
                const int ko = 16 * (r >> 3) + 8 * hh + (r & 7);
                float w = sc[r] * __expf(av - M);
                w = (kt == tq && ko > i) ? 0.f : w;
                sc[r] = w; wsum += w; }
            u32x4 wf[2];
#pragma unroll
            for (int sb = 0; sb < 2; ++sb) { wf[sb].x = cvt_pk_bf16(sc[8 * sb + 0], sc[8 * sb + 1]); wf[sb].y = cvt_pk_bf16(sc[8 * sb + 2], sc[8 * sb + 3]); wf[sb].z = cvt_pk_bf16(sc[8 * sb + 4], sc[8 * sb + 5]); wf[sb].w = cvt_pk_bf16(sc[8 * sb + 6], sc[8 * sb + 7]); }
#pragma unroll
            for (int et = 0; et < 4; ++et)
#pragma unroll
                for (int sb = 0; sb < 2; ++sb) acc[et] = __builtin_amdgcn_mfma_f32_32x32x16_bf16(*(const LAS bf16x8*)(rl + 32768 + (et * 8 + 2 * kt + sb) * 1024), __builtin_bit_cast(bf16x8, wf[sb]), acc[et], 0, 0, 0);
        }
        wsum = x32_sum(wsum);
        const float den = g * qn + wsum, idd = 1.0f / fmaxf(fabsf(den), emt);
        float ss = 0.f;
#pragma unroll
        for (int et = 0; et < 4; ++et)
#pragma unroll
            for (int r = 0; r < 16; ++r) { const float hv = acc[et][r] * idd; acc[et][r] = hv; ss += hv * hv; }
        ss = x32_sum(ss);
        const float rn = rsqrtf(ss * (1.0f / 128.0f) + EPS);
        bf16_t* op = cat + (size_t)tg * DM + 512 + h * 128 + 8 * hh;
        const float* gp = mng + h * 128 + 4 * hh;
#pragma unroll
        for (int et = 0; et < 4; ++et)
#pragma unroll
            for (int gq = 0; gq < 2; ++gq) { u32x2 w[2];
#pragma unroll
                for (int q = 0; q < 2; ++q) { const int g4 = 2 * gq + q; const f32x4 gv = *(const f32x4*)(gp + et * 32 + 8 * g4); const u32x2 mo = mov[et][g4];
                    const float o0 = lo_bf(mo.x), o1 = hi_bf(mo.x), o2 = lo_bf(mo.y), o3 = hi_bf(mo.y);
                    const float y0 = acc[et][4 * g4] * rn * gv[0] * __builtin_amdgcn_rcpf(1.0f + __expf(-o0)), y1 = acc[et][4 * g4 + 1] * rn * gv[1] * __builtin_amdgcn_rcpf(1.0f + __expf(-o1));
                    const float y2 = acc[et][4 * g4 + 2] * rn * gv[2] * __builtin_amdgcn_rcpf(1.0f + __expf(-o2)), y3 = acc[et][4 * g4 + 3] * rn * gv[3] * __builtin_amdgcn_rcpf(1.0f + __expf(-o3));
                    w[q].x = cvt_pk_bf16(y0, y1); w[q].y = cvt_pk_bf16(y2, y3); }
                const auto sa = __builtin_amdgcn_permlane32_swap(w[0].x, w[1].x, false, false), sb = __builtin_amdgcn_permlane32_swap(w[0].y, w[1].y, false, false);
                *(u32x4*)(op + et * 32 + 16 * gq) = (u32x4){sa[0], sb[0], sa[1], sb[1]}; }
        asm volatile("s_waitcnt lgkmcnt(0)" ::: "memory"); __builtin_amdgcn_s_barrier(); asm volatile("" ::: "memory");
    }
}

constexpr int NWAVES = 8;
constexpr int RING_BYTES = 131072;
constexpr int LDSCTL_OFF = RING_BYTES;
constexpr int LDS_BYTES = RING_BYTES + 5120;

enum Phase { PH_PREP = 0, PH_INPROJ = 1, PH_MIX0 = 2, PH_MIX1 = 3, PH_MIX2 = 4, PH_OUTPROJ = 5, PH_QKV = 6, PH_XATTN = 7, PH_COPROJ = 8, PH_ROUTER = 9, PH_G1 = 10, PH_G2 = 11, PH_COMBINE = 12, PH_END = 13 };

struct Args { const float* in[28]; float* out; unsigned char* ws; int ph_lo, ph_hi, pass_lo, pass_hi; };

struct CJob { const float* src; const float* g; unsigned char* dst; int Nsrc, k0, n0, mode, f8; float scale; };
__device__ __forceinline__ void conv_load(const CJob& j, f32x4 (&v)[2], int tid) {
    const int kk = tid >> 4, c4 = (tid & 15) * 4;
#pragma unroll
    for (int rep = 0; rep < 2; ++rep) v[rep] = *(const f32x4*)(j.src + (size_t)(j.k0 + kk + 32 * rep) * j.Nsrc + j.n0 + c4);
}
__device__ __forceinline__ void conv_put(LAS float* tile, const f32x4 (&v)[2], int tid) {
    const int kk = tid >> 4, c4 = (tid & 15) * 4;
#pragma unroll
    for (int rep = 0; rep < 2; ++rep)
#pragma unroll
        for (int q = 0; q < 4; ++q) tile[(kk + 32 * rep) * 65 + c4 + q] = v[rep][q];
}
__device__ __forceinline__ void conv_store(const LAS float* tile, const CJob& j, int tid) {
    const int n = tid >> 3, kc = tid & 7; float vals[8];
    f32x4 g0 = (f32x4){1.f, 1.f, 1.f, 1.f}, g1 = g0;
    if (j.g) { g0 = *(const f32x4*)(j.g + j.k0 + 8 * kc); g1 = *(const f32x4*)(j.g + j.k0 + 8 * kc + 4); }
#pragma unroll
    for (int q = 0; q < 8; ++q) vals[q] = tile[(8 * kc + q) * 65 + n] * (q < 4 ? g0[q & 3] : g1[q & 3]) * j.scale;
    const int sc = j.n0 + n; int drow = sc;
    if (j.mode == 1) { const int jj = sc >> 1, s = sc & 1; drow = 256 * (jj >> 7) + 128 * s + (jj & 127); }
    if (j.mode == 2) { drow = sc < 1024 ? sc : sc < 1536 ? sc + 1024 : sc < 2048 ? sc - 512 : sc < 2560 ? sc + 512 : sc - 1024; }
    if (j.f8) { unsigned w0 = 0u, w1 = 0u;
        w0 = __builtin_amdgcn_cvt_pk_fp8_f32(c8(vals[0]), c8(vals[1]), w0, false); w0 = __builtin_amdgcn_cvt_pk_fp8_f32(c8(vals[2]), c8(vals[3]), w0, true);
        w1 = __builtin_amdgcn_cvt_pk_fp8_f32(c8(vals[4]), c8(vals[5]), w1, false); w1 = __builtin_amdgcn_cvt_pk_fp8_f32(c8(vals[6]), c8(vals[7]), w1, true);
        *(u32x2*)(j.dst + (size_t)drow * 1024 + j.k0 + 8 * kc) = (u32x2){w0, w1}; }
    else { u32x4 w; w.x = cvt_pk_bf16(vals[0], vals[1]); w.y = cvt_pk_bf16(vals[2], vals[3]); w.z = cvt_pk_bf16(vals[4], vals[5]); w.w = cvt_pk_bf16(vals[6], vals[7]);
        *(u32x4*)(j.dst + ((size_t)drow * 1024 + j.k0 + 8 * kc) * 2) = w; }
}

__global__ void __launch_bounds__(NWAVES * 64, 2) fwd(Args args) {
    extern __shared__ __attribute__((aligned(16))) unsigned char lds_raw[];
    LAS unsigned char* lds = (LAS unsigned char*)lds_raw;
    volatile LAS unsigned* LCTL = (volatile LAS unsigned*)(lds + LDSCTL_OFF);
    const int wave = __builtin_amdgcn_readfirstlane(threadIdx.x >> 6);
#define lane lane_id()
#define tid (wave * 64 + lane_id())
    const int G = gridDim.x, bx = blockIdx.x;
    unsigned char* ws = args.ws;
    unsigned* ctl = (unsigned*)(ws + WS_CTL);
    const int lo = args.ph_lo, hi = args.ph_hi;
#ifndef PHMASK
#define PHMASK 0xffffff
#endif
#ifndef DUPMASK
#define DUPMASK 0x0
#endif
#define IN(k) (((PHMASK >> (k)) & 1) && lo <= (k) && (k) < hi)
#define NREP(k) ((((DUPMASK) >> (k)) & 1) ? 2 : 1)
#define ENDBAR(k) (BOTH(k) || (((DUPMASK) >> (k)) & 1))
#define BOTH(k) (IN(k) && IN((k) + 1))
    for (int u = tid; u < (LDS_BYTES - LDSCTL_OFF) / 4; u += NWAVES * 64) LCTL[u] = 0u;
    __syncthreads();
    XcdBarrier bar; bar.bar = ctl + CW_BAR; bar.x = 0; bar.st = LCTL; bar.wave = wave;
    const bool multi = (hi - lo) > 1 || (args.pass_hi - args.pass_lo) > 1 || (IN(PH_G1) && IN(PH_G2));
    if (multi) bar = xcd_barrier_post(ctl + CW_BAR, LCTL, wave);
#define GRID_BAR() xcd_barrier(bar)

    const float* x = args.in[0]; const float* mem = args.in[1];
    bf16_t* XB = (bf16_t*)(ws + WS_XB); bf16_t* PROJ = (bf16_t*)(ws + WS_PROJ); bf16_t* CAT = (bf16_t*)(ws + WS_CAT);
    bf16_t* MEMB = (bf16_t*)(ws + WS_MEMB); bf16_t* KV = (bf16_t*)(ws + WS_KV); bf16_t* VT2 = (bf16_t*)(ws + WS_VT2); bf16_t* VT1 = (bf16_t*)(ws + WS_VT1); unsigned char* H1F = ws + WS_H1F;
    bf16_t* WIN = (bf16_t*)(ws + WS_WIN); bf16_t* WOUT = (bf16_t*)(ws + WS_WOUT); bf16_t* WCQ = (bf16_t*)(ws + WS_WCQ); bf16_t* WCKV = (bf16_t*)(ws + WS_WCKV);
    bf16_t* WCO = (bf16_t*)(ws + WS_WCO); bf16_t* WR = (bf16_t*)(ws + WS_WR); unsigned char* W1F = ws + WS_W1; unsigned char* W2F = ws + WS_W2; unsigned char* H2F = ws + WS_H2F;
    float* RSTDX = (float*)(ws + WS_RSTDX); float* RSTDM = (float*)(ws + WS_RSTDM); float* B1P = (float*)(ws + WS_B1P); float* MISC = (float*)(ws + WS_MISC); float* RSTD2 = (float*)(ws + WS_RSTD2);
    float* SSP1 = (float*)(ws + WS_SSP1); float* SSP2 = (float*)(ws + WS_SSP2); float* GATES = (float*)(ws + WS_GATES);
    unsigned* TOKMAP = (unsigned*)(ws + WS_TOKMAP); float* GATEV = (float*)(ws + WS_GATEV); unsigned* LIST = (unsigned*)(ws + WS_LIST);
    unsigned char* YB = ws + WS_Y; unsigned char* HID = ws + WS_HID;

    if (IN(PH_PREP)) for (int rep_ = 0; rep_ < NREP(PH_PREP); ++rep_) {
        constexpr int J0 = 768, J1 = J0 + 256, J2 = J1 + 256, J3 = J2 + 512, J4 = J3 + 256, J5 = J4 + 16384, J6 = J5 + 8192;
        auto decode = [&](int it, CJob& j) {
            if (it < J0) { j = CJob{args.in[3], args.in[2], (unsigned char*)WIN, DIN, (it / 48) * 64, (it % 48) * 64, 2, 0, 1.0f}; }
            else if (it < J1) { const int r = it - J0; j = CJob{args.in[14], nullptr, (unsigned char*)WOUT, 1024, (r / 16) * 64, (r % 16) * 64, 0, 0, 1.0f}; }
            else if (it < J2) { const int r = it - J1; j = CJob{args.in[17], args.in[15], (unsigned char*)WCQ, 1024, (r / 16) * 64, (r % 16) * 64, 0, 1, 64.0f}; }
            else if (it < J3) { const int r = it - J2; j = CJob{args.in[18], args.in[16], (unsigned char*)WCKV, 2048, (r / 32) * 64, (r % 32) * 64, 0, 1, 64.0f}; }
            else if (it < J4) { const int r = it - J3; j = CJob{args.in[19], nullptr, (unsigned char*)WCO, 1024, (r / 16) * 64, (r % 16) * 64, 0, 1, 64.0f}; }
            else if (it < J5) { const int r = it - J4; const int e = r >> 9, q = r & 511; j = CJob{args.in[23] + (size_t)e * 1024 * 2048, args.in[20], W1F + (size_t)e * 2048 * 1024, 2048, (q / 32) * 64, (q % 32) * 64, 1, 1, 64.0f}; }
            else { const int r = it - J5; const int e = r >> 8, q = r & 255; j = CJob{args.in[25] + (size_t)e * 1024 * 1024, nullptr, W2F + (size_t)e * 1024 * 1024, 1024, (q / 16) * 64, (q % 16) * 64, 0, 1, 64.0f}; } };
        static_assert(J0 % 4 == 0 && J1 % 4 == 0 && J2 % 4 == 0 && J3 % 4 == 0 && J4 % 4 == 0 && J5 % 4 == 0 && J6 % 4 == 0, "rounds of four jobs");
#define LDS_BAR() do { asm volatile("s_waitcnt lgkmcnt(0)" ::: "memory"); __builtin_amdgcn_s_barrier(); asm volatile("" ::: "memory"); } while (0)
        { f32x4 v[8]; int it0 = bx * 4; CJob jc;
          if (it0 < J6) { decode(it0, jc);
#pragma unroll
              for (int r = 0; r < 8; ++r) v[r] = *(const f32x4*)(jc.src + (size_t)(jc.k0 + wave * 8 + r) * jc.Nsrc + jc.n0 + 4 * lane); }
          for (; it0 < J6; it0 += G * 4) {
            { LAS float* tq = (LAS float*)lds + (lane >> 4) * (64 * 65) + ((4 * lane) & 63) + (wave * 8) * 65;
#pragma unroll
              for (int r = 0; r < 8; ++r)
#pragma unroll
                  for (int q = 0; q < 4; ++q) tq[r * 65 + q] = v[r][q]; }
            LDS_BAR();
            CJob js = jc; const int nx = it0 + G * 4;
            if (nx < J6) { decode(nx, jc);
#pragma unroll
                for (int r = 0; r < 8; ++r) v[r] = *(const f32x4*)(jc.src + (size_t)(jc.k0 + wave * 8 + r) * jc.Nsrc + jc.n0 + 4 * lane); }
#pragma unroll
            for (int q = 0; q < 4; ++q) { conv_store((const LAS float*)lds + q * (64 * 65), js, tid); js.n0 += 64; }
            LDS_BAR();
          } }
        __syncthreads();
        for (int i = bx * 512 + tid; i < NEXP * 1024; i += G * 512) { const int e = i >> 10, k = i & 1023; WR[i] = (bf16_t)f2bf(args.in[21][k * NEXP + e] * args.in[20][k]); }
        for (int i = bx * 512 + tid; i < NEXP * 2048; i += G * 512) { const int e = i >> 11, rho = i & 2047; const int pn = rho >> 8, s = (rho >> 7) & 1, ii = rho & 127; B1P[i] = args.in[24][e * 2048 + 2 * (128 * pn + ii) + s]; }
        if (bx == 0 && wave == 0) { const float a = wave_sum(args.in[9][lane] * args.in[10][lane]), b = wave_sum(args.in[11][lane] * args.in[12][lane]);
            if (lane == 0) MISC[0] = expf(a) - expf(b) + LAMBDA_INIT; }
        {
            const float* win = args.in[3]; const float* g = args.in[2];
            float wg[4][4][8];
#pragma unroll
            for (int jj = 0; jj < 4; ++jj)
#pragma unroll
                for (int q = 0; q < 4; ++q) { const int k = 4 * lane + 256 * jj + q; const float gk = g[k];
                    const f32x4 a = *(const f32x4*)(win + (size_t)k * DIN + 3072), b = *(const f32x4*)(win + (size_t)k * DIN + 3076);
#pragma unroll
                    for (int j = 0; j < 4; ++j) { wg[jj][q][j] = a[j] * gk; wg[jj][q][4 + j] = b[j] * gk; } }
            const int gw = bx * NWAVES + wave, NGW = G * NWAVES;
            f32x4 vn[4];
            if (gw < T) { const f32x4* xr = (const f32x4*)(x + (size_t)gw * DM) + lane;
#pragma unroll
                for (int jj = 0; jj < 4; ++jj) vn[jj] = xr[64 * jj]; }
            for (int row = gw; row < T; row += NGW) {
                f32x4 v[4]; float ss = 0.f; float d[8];
#pragma unroll
                for (int jj = 0; jj < 4; ++jj) v[jj] = vn[jj];
                if (row + NGW < T) { const f32x4* xr = (const f32x4*)(x + (size_t)(row + NGW) * DM) + lane;
#pragma unroll
                    for (int jj = 0; jj < 4; ++jj) vn[jj] = xr[64 * jj]; }
#pragma unroll
                for (int j = 0; j < 8; ++j) d[j] = 0.f;
#pragma unroll
                for (int jj = 0; jj < 4; ++jj) {
#pragma unroll
                    for (int q = 0; q < 4; ++q) { ss += v[jj][q] * v[jj][q];
#pragma unroll
                        for (int j = 0; j < 8; ++j) d[j] += v[jj][q] * wg[jj][q][j]; } }
                ss = wave_sum(ss);
#pragma unroll
                for (int j = 0; j < 8; ++j) d[j] = wave_sum(d[j]);
                const float rs = rsqrtf(ss * (1.0f / DM) + EPS);
                u32x2* o8 = (u32x2*)(XB + (size_t)row * DM) + lane;
#pragma unroll
                for (int jj = 0; jj < 4; ++jj) { u32x2 w; w.x = cvt_pk_bf16(v[jj][0], v[jj][1]); w.y = cvt_pk_bf16(v[jj][2], v[jj][3]); o8[64 * jj] = w; }
                if (lane == 0) RSTDX[row] = rs;
                if (lane < 8) { float dv = d[0];
#pragma unroll
                    for (int j = 1; j < 8; ++j) dv = (lane == j) ? d[j] : dv;
                    dv *= rs; float r;
                    if (lane < 4) r = dv + args.in[6][lane];
                    else { const float z = dv + args.in[7][lane - 4]; r = (z >= 0.f) ? -log1pf(expf(-z)) : (z - log1pf(expf(z))); }
                    GATES[(size_t)row * 8 + lane] = r; }
            }
            for (int row = gw; row < MROWS; row += NGW) {
                const f32x4* xr = (const f32x4*)(mem + (size_t)row * DM) + lane;
                f32x4 v[4]; float ss = 0.f;
#pragma unroll
                for (int jj = 0; jj < 4; ++jj) { v[jj] = xr[64 * jj]; ss += (v[jj][0] * v[jj][0] + v[jj][1] * v[jj][1]) + (v[jj][2] * v[jj][2] + v[jj][3] * v[jj][3]); }
                ss = wave_sum(ss);
                unsigned* o4 = (unsigned*)((unsigned char*)MEMB + (size_t)row * DM) + lane;
#pragma unroll
                for (int jj = 0; jj < 4; ++jj) { unsigned w = 0u; w = __builtin_amdgcn_cvt_pk_fp8_f32(c8(v[jj][0]), c8(v[jj][1]), w, false); w = __builtin_amdgcn_cvt_pk_fp8_f32(c8(v[jj][2]), c8(v[jj][3]), w, true); o4[64 * jj] = w; }
                if (lane == 0) RSTDM[row] = rsqrtf(ss * (1.0f / DM) + EPS);
            }
        }
        if (ENDBAR(PH_PREP)) GRID_BAR();
    }

    if (IN(PH_INPROJ)) for (int rep_ = 0; rep_ < NREP(PH_INPROJ); ++rep_) {
        { ProbScaleBf16 P{(LAS unsigned*)(lds + LDSCTL_OFF + 2048), XB, WIN, T / 256, NP2 / 256, G, bx, PROJ, NP2, RSTDX, nullptr};
          pg8::gemm_phase<ProbScaleBf16, true>(lds, P, wave); }
        { ProbColScaleBf16 P{WIN + (size_t)NP2 * 1024, XB, 4, T / 256, G, bx, VT1, T, RSTDX};
          pg8::gemm_phase<ProbColScaleBf16, true>(lds, P, wave); }
        if (ENDBAR(PH_INPROJ)) GRID_BAR();
    }

    const int vx = (G % 8 == 0) ? (bx % 8) * (G / 8) + bx / 8 : bx;
    bf16_t* QM = (bf16_t*)(ws + WS_QM); bf16_t* KM = (bf16_t*)(ws + WS_KM); bf16_t* CSTB = (bf16_t*)(ws + WS_CSTB);
    float* BC = (float*)(ws + WS_BC); float* AV = (float*)(ws + WS_AV); float* AM = (float*)(ws + WS_AM); float* NLOC = (float*)(ws + WS_NLOC); float* NST = (float*)(ws + WS_NST);
    float* CH = (float*)(ws + WS_CH); float* MSTATE = (float*)(ws + WS_MSTATE); float* CLOC = (float*)(ws + WS_MST);
    if (IN(PH_MIX0)) for (int rep_ = 0; rep_ < NREP(PH_MIX0); ++rep_) {
        mlstm_prep_phase(lds, PROJ, VT1, GATES, args.in[4], args.in[5], QM, KM, BC, AV, AM, CH, NLOC, CLOC, G, vx, wave);
        if (ENDBAR(PH_MIX0)) GRID_BAR();
    }
    if (IN(PH_MIX1)) for (int rep_ = 0; rep_ < NREP(PH_MIX1); ++rep_) {
        mlstm_scan_phase(CLOC, NLOC, CH, CSTB, NST, MSTATE, G, bx, tid);
        if (ENDBAR(PH_MIX1)) GRID_BAR();
    }
    if (IN(PH_MIX2)) for (int rep_ = 0; rep_ < NREP(PH_MIX2); ++rep_) {
        mlstm_out_phase(lds, PROJ, VT1, QM, KM, BC, AV, AM, CSTB, NST, MSTATE, args.in[8], CAT, G, vx, wave);
        __syncthreads();
        const float lam = __hip_atomic_load(MISC, __ATOMIC_RELAXED, __HIP_MEMORY_SCOPE_AGENT);
        diffattn_phase(lds, PROJ, VT1, args.in[13], lam, CAT, G, vx, wave);
        if (ENDBAR(PH_MIX2)) GRID_BAR();
    }

    if (IN(PH_OUTPROJ)) for (int rep_ = 0; rep_ < NREP(PH_OUTPROJ); ++rep_) {
        ProbResidT<false, true, false> P{(LAS unsigned*)(lds + LDSCTL_OFF + 2048), CAT, WOUT, T / 256, 4, G, bx, nullptr, XB, XB, H1F, SSP1};
        pg8::gemm_phase<ProbResidT<false, true, false>, true>(lds, P, wave);
        if (ENDBAR(PH_OUTPROJ)) GRID_BAR();
    }

    if (IN(PH_QKV)) for (int rep_ = 0; rep_ < NREP(PH_QKV); ++rep_) {
        { ProbScaleT<true> P{(LAS unsigned*)(lds + LDSCTL_OFF + 2048), H1F, WCQ, T / 256, 4, G, bx, PROJ, 1024, nullptr, SSP1};
          pg8::gemm_phase<ProbScaleT<true>, true>(lds, P, wave); }
        { ProbKV P{(LAS unsigned*)(lds + LDSCTL_OFF + 2048), (const unsigned char*)MEMB, (const unsigned char*)WCKV, KV, VT2, RSTDM, G, bx};
          pg8::gemm_phase<ProbKV, true>(lds, P, wave); }
        if (ENDBAR(PH_QKV)) GRID_BAR();
    }

    if (IN(PH_XATTN)) for (int rep_ = 0; rep_ < NREP(PH_XATTN); ++rep_) {
        xattn_phase(lds, PROJ, KV, VT2, (unsigned char*)(PROJ + (size_t)T * 1024), G, vx, wave);
        if (ENDBAR(PH_XATTN)) GRID_BAR();
    }

    if (IN(PH_COPROJ)) for (int rep_ = 0; rep_ < NREP(PH_COPROJ); ++rep_) {
        ProbResidT<true, false, false> P{(LAS unsigned*)(lds + LDSCTL_OFF + 2048), (unsigned char*)(PROJ + (size_t)T * 1024), WCO, T / 256, 4, G, bx, nullptr, XB, CAT, nullptr, SSP2};
        pg8::gemm_phase<ProbResidT<true, false, false>, true>(lds, P, wave);
        if (ENDBAR(PH_COPROJ)) GRID_BAR();
    }

    if (IN(PH_ROUTER)) for (int rep_ = 0; rep_ < NREP(PH_ROUTER); ++rep_) {
        { u32x4 wv[8];
#pragma unroll
          for (int q = 0; q < 8; ++q) { const int idx = q * (NWAVES * 64) + tid, ks = idx >> 6, ln = idx & 63; wv[q] = *(const u32x4*)(WR + (size_t)(ln & 31) * DM + 16 * ks + 8 * (ln >> 5)); }
#pragma unroll
          for (int q = 0; q < 8; ++q) { const int idx = q * (NWAVES * 64) + tid; *(LAS u32x4*)(lds + idx * 16) = wv[q]; } }
        __syncthreads();
        const float* brt = args.in[22];
        const int i = lane & 31, hh = lane >> 5;
        volatile LAS unsigned* lcnt = (volatile LAS unsigned*)(lds + 65536);
        const int ntrip = (T / 32 + G * NWAVES - 1) / (G * NWAVES);
        for (int trip = 0; trip < ntrip; ++trip) {
            const int tile = trip * G * NWAVES + bx * NWAVES + wave; const bool act = tile < T / 32;
            if (tid < 32) lcnt[tid] = 0u;
            __syncthreads();
            const int t = (act ? tile : 0) * 32 + i;
            const bf16_t* xp = CAT + (size_t)t * DM + 8 * hh;
            const f32x4 p0 = *(const f32x4*)(SSP2 + (size_t)t * 16 + 8 * hh), p1 = *(const f32x4*)(SSP2 + (size_t)t * 16 + 8 * hh + 4);
            float sp = (p0[0] + p0[1]) + (p0[2] + p0[3]) + (p1[0] + p1[1]) + (p1[2] + p1[3]); sp = x32_sum(sp);
            const float rs = rsqrtf(sp * (1.0f / DM) + EPS);
            f32x16 acc = zero16();
#pragma unroll 8
            for (int ks = 0; ks < 64; ks += 2) { bf16x8 xf[2]; unsigned pw[2][2];
#pragma unroll
                for (int q = 0; q < 2; ++q) { xf[q] = *(const bf16x8*)(xp + 16 * (ks + q)); const bf16x8 wf = *(const LAS bf16x8*)(lds + ((ks + q) * 64 + lane) * 16);
                    acc = __builtin_amdgcn_mfma_f32_32x32x16_bf16(wf, xf[q], acc, 0, 0, 0); }
                if (act) {
#pragma unroll
                    for (int q = 0; q < 2; ++q) { const u32x4 xw = __builtin_bit_cast(u32x4, xf[q]); unsigned w0 = 0u, w1 = 0u;
                        w0 = __builtin_amdgcn_cvt_pk_fp8_f32(lo_bf(xw.x) * rs, hi_bf(xw.x) * rs, w0, false); w0 = __builtin_amdgcn_cvt_pk_fp8_f32(lo_bf(xw.y) * rs, hi_bf(xw.y) * rs, w0, true);
                        w1 = __builtin_amdgcn_cvt_pk_fp8_f32(lo_bf(xw.z) * rs, hi_bf(xw.z) * rs, w1, false); w1 = __builtin_amdgcn_cvt_pk_fp8_f32(lo_bf(xw.w) * rs, hi_bf(xw.w) * rs, w1, true);
                        pw[q][0] = w0; pw[q][1] = w1; }
                    const auto sa = __builtin_amdgcn_permlane32_swap(pw[0][0], pw[1][0], false, false), sb = __builtin_amdgcn_permlane32_swap(pw[0][1], pw[1][1], false, false);
                    *(u32x4*)(H2F + (size_t)t * DM + 16 * ks + 16 * hh) = (u32x4){sa[0], sb[0], sa[1], sb[1]}; } }
            float mine[16], oth[16];
#pragma unroll
            for (int r = 0; r < 16; ++r) { const int e = (r & 3) + 8 * (r >> 2); mine[r] = acc[r] * rs + brt[e + 4 * hh]; }
#pragma unroll
            for (int r = 0; r < 16; ++r) oth[r] = x32_other(mine[r], hh);
            float lg[NEXP];
#pragma unroll
            for (int r = 0; r < 16; ++r) { const int e = (r & 3) + 8 * (r >> 2); lg[e] = hh ? oth[r] : mine[r]; lg[e + 4] = hh ? mine[r] : oth[r]; }
            unsigned taken = 0u; float tv[4]; int te[4];
#pragma unroll
            for (int k = 0; k < TOPK; ++k) { float best = -INFINITY; int bi = 0;
#pragma unroll
                for (int e = 0; e < NEXP; ++e) { const bool ok = !((taken >> e) & 1u) && (lg[e] > best); best = ok ? lg[e] : best; bi = ok ? e : bi; }
                taken |= 1u << bi; tv[k] = best; te[k] = bi; }
            const float q1 = __expf(tv[1] - tv[0]), q2 = __expf(tv[2] - tv[0]), q3 = __expf(tv[3] - tv[0]); const float inv = 1.0f / (1.0f + q1 + q2 + q3);
            const float gk[4] = {inv, q1 * inv, q2 * inv, q3 * inv};
            unsigned lp[4] = {0u, 0u, 0u, 0u};
            if (act && hh == 0) {
#pragma unroll
                for (int k = 0; k < TOPK; ++k) lp[k] = __hip_atomic_fetch_add((LAS unsigned*)(lcnt + te[k]), 1u, __ATOMIC_RELAXED, __HIP_MEMORY_SCOPE_WORKGROUP); }
            __syncthreads();
            if (tid < 32) { const unsigned n = lcnt[tid]; lcnt[32 + tid] = n ? atomicAdd(&ctl[CW_CNT + tid], n) : 0u; }
            __syncthreads();
            if (act && hh == 0) { RSTD2[t] = rs;
                unsigned tm[4];
#pragma unroll
                for (int k = 0; k < TOPK; ++k) { const unsigned pos = lcnt[32 + te[k]] + lp[k]; LIST[(size_t)te[k] * T + pos] = (unsigned)t; tm[k] = ((unsigned)te[k] << 16) | pos; }
                *(u32x4*)(TOKMAP + (size_t)t * 4) = (u32x4){tm[0], tm[1], tm[2], tm[3]};
                *(f32x4*)(GATEV + (size_t)t * 4) = (f32x4){gk[0], gk[1], gk[2], gk[3]}; }
            __syncthreads();
        }
        if (ENDBAR(PH_ROUTER)) GRID_BAR();
    }

    volatile LAS int* tab = (volatile LAS int*)(LCTL + 16);
    int Rtot = 0;
    if (IN(PH_G1) || IN(PH_G2) || IN(PH_COMBINE)) {
        if (tid < NEXP) tab[MOE_CNT + tid] = (int)__hip_atomic_load(&ctl[CW_CNT + tid], __ATOMIC_RELAXED, __HIP_MEMORY_SCOPE_AGENT);
        __syncthreads();
        if (tid == 0) { int ts = 0, st = 0;
            for (int e = 0; e < NEXP; ++e) { const int c = tab[MOE_CNT + e]; tab[MOE_TS + e] = ts; tab[MOE_ST + e] = st; ts += (c + 255) >> 8; st += c; }
            tab[MOE_TS + NEXP] = ts; tab[MOE_ST + NEXP] = st; }
        __syncthreads();
        Rtot = tab[MOE_TS + NEXP];
    }
    if (IN(PH_G1) || IN(PH_G2)) {
        __syncthreads();
        for (int rt = tid; rt < Rtot; rt += NWAVES * 64) { int e = 0;
            for (int j = 1; j < NEXP; ++j) if (rt >= tab[MOE_TS + j]) e = j;
            ((volatile LAS unsigned char*)(tab + MOE_RTE))[rt] = (unsigned char)e; }
        __syncthreads();
        if (IN(PH_G1)) for (int rep_ = 0; rep_ < NREP(PH_G1); ++rep_) { ProbMoe1 P{H2F, W1F, B1P, RSTD2, LIST, HID, tab, (LAS unsigned*)(lds + LDSCTL_OFF + 2048), 0, Rtot, G, bx};
            pg8::gemm_phase<ProbMoe1, true>(lds, P, wave);
            if (IN(PH_G2) || NREP(PH_G1) > 1) GRID_BAR(); }
        if (IN(PH_G2)) for (int rep_ = 0; rep_ < NREP(PH_G2); ++rep_) { ProbMoe2 P{HID, W2F, args.in[26], YB, tab, (LAS unsigned*)(lds + LDSCTL_OFF + 2048), 0, Rtot, G, bx};
            pg8::gemm_phase<ProbMoe2, true>(lds, P, wave);
            if (IN(PH_COMBINE) || NREP(PH_G2) > 1) GRID_BAR(); }
    }
    if (IN(PH_COMBINE)) {
        const float* gf = args.in[27];
        const int gw = bx * NWAVES + wave, NGW = G * NWAVES;
        f32x4 gfv[4];
#pragma unroll
        for (int jj = 0; jj < 4; ++jj) gfv[jj] = *((const f32x4*)gf + 4 * lane + jj);
        u32x4 tmn = (u32x4){0u, 0u, 0u, 0u}; f32x4 gkn = (f32x4){0.f, 0.f, 0.f, 0.f};
        if (gw < T) { tmn = *(const u32x4*)(TOKMAP + (size_t)gw * 4); gkn = *(const f32x4*)(GATEV + (size_t)gw * 4); }
        for (int t = gw; t < T; t += NGW) {
            const u32x4 tm = tmn; const f32x4 gk = gkn;
            if (t + NGW < T) { tmn = *(const u32x4*)(TOKMAP + (size_t)(t + NGW) * 4); gkn = *(const f32x4*)(GATEV + (size_t)(t + NGW) * 4); }
            const u32x4* hb = (const u32x4*)(CAT + (size_t)t * DM) + 2 * lane;
            const u32x4 h0 = hb[0], h1 = hb[1];
            u32x4 yv[4];
#pragma unroll
            for (int k = 0; k < TOPK; ++k) { const int e = (int)(tm[k] >> 16), pos = (int)(tm[k] & 0xffffu); const size_t yrow = (size_t)(tab[MOE_ST + e] + pos);
                yv[k] = *((const u32x4*)(YB + yrow * DM) + lane); }
            float v[16];
            v[0] = lo_bf(h0.x); v[1] = hi_bf(h0.x); v[2] = lo_bf(h0.y); v[3] = hi_bf(h0.y); v[4] = lo_bf(h0.z); v[5] = hi_bf(h0.z); v[6] = lo_bf(h0.w); v[7] = hi_bf(h0.w);
            v[8] = lo_bf(h1.x); v[9] = hi_bf(h1.x); v[10] = lo_bf(h1.y); v[11] = hi_bf(h1.y); v[12] = lo_bf(h1.z); v[13] = hi_bf(h1.z); v[14] = lo_bf(h1.w); v[15] = hi_bf(h1.w);
#pragma unroll
            for (int k = 0; k < TOPK; ++k) { const float g16 = gk[k] * (1.0f / 16.0f);
#pragma unroll
                for (int q = 0; q < 4; ++q) { const f32x2 a = __builtin_amdgcn_cvt_pk_f32_fp8((int)yv[k][q], false), b2_ = __builtin_amdgcn_cvt_pk_f32_fp8((int)yv[k][q], true);
                    v[4 * q] += g16 * a[0]; v[4 * q + 1] += g16 * a[1]; v[4 * q + 2] += g16 * b2_[0]; v[4 * q + 3] += g16 * b2_[1]; } }
            float ss = 0.f;
#pragma unroll
            for (int q = 0; q < 16; ++q) ss += v[q] * v[q];
            ss = wave_sum(ss); const float rs = rsqrtf(ss * (1.0f / DM) + EPS);
            f32x4* orow = (f32x4*)(args.out + (size_t)t * DM) + 4 * lane;
#pragma unroll
            for (int jj = 0; jj < 4; ++jj) orow[jj] = (f32x4){v[4 * jj] * rs * gfv[jj][0], v[4 * jj + 1] * rs * gfv[jj][1], v[4 * jj + 2] * rs * gfv[jj][2], v[4 * jj + 3] * rs * gfv[jj][3]};
        }
    }
#undef IN
#undef BOTH
#undef GRID_BAR
#undef lane
#undef tid
}

extern "C" void kernel_launch(void* const* d_in, const int* in_sizes, int n_in, void* d_out, int out_size, void* d_ws, size_t ws_size, hipStream_t stream) {
    static int grid = 0;
    if (grid == 0) {
        if (n_in != 28 || out_size != T * DM || ws_size < WS_END) { fprintf(stderr, "kernel_launch: unexpected shapes: n_in %d out %d ws %zu\n", n_in, out_size, ws_size); grid = -1; return; }
        int dev = 0, cus = 0;
        if (hipGetDevice(&dev) != hipSuccess || hipDeviceGetAttribute(&cus, hipDeviceAttributeMultiprocessorCount, dev) != hipSuccess) { grid = -1; return; }
        if (hipFuncSetAttribute((const void*)fwd, hipFuncAttributeMaxDynamicSharedMemorySize, LDS_BYTES) != hipSuccess) { fprintf(stderr, "kernel_launch: hipFuncSetAttribute failed\n"); grid = -1; return; }
        int per_cu = 0;
        if (hipOccupancyMaxActiveBlocksPerMultiprocessor(&per_cu, (const void*)fwd, NWAVES * 64, LDS_BYTES) != hipSuccess || per_cu < 1) fprintf(stderr, "kernel_launch: occupancy query says %d\n", per_cu);
        (void)hipGetLastError();
        grid = cus;
    }
    if (grid < 0) return;
    (void)hipMemsetAsync((char*)d_ws + WS_CTL, 0, CTL_ZERO_BYTES, stream);
    Args a{};
    for (int i = 0; i < 28; ++i) a.in[i] = (const float*)d_in[i];
    a.out = (float*)d_out; a.ws = (unsigned char*)d_ws;
    unsigned char* ws = (unsigned char*)d_ws;
    auto run = [&](int lo, int hi, int p0, int p1) { a.ph_lo = lo; a.ph_hi = hi; a.pass_lo = p0; a.pass_hi = p1; hipLaunchKernelGGL(fwd, dim3(grid), dim3(NWAVES * 64), LDS_BYTES, stream, a); };
#ifdef MULTI_LAUNCH
    for (int ph = 0; ph < PH_G1; ++ph) run(ph, ph + 1, 0, 0);
    run(PH_G1, PH_G1 + 1, 0, 1); run(PH_G2, PH_G2 + 1, 0, 1);
    run(PH_COMBINE, PH_COMBINE + 1, 0, 0);
#else
    run(0, PH_END, 0, 5);
#endif
}
```

```cpp
#include <hip/hip_runtime.h>
#include <cstdio>
#include <cstdint>
#include <cmath>

#define GAS __attribute__((address_space(1)))
#define LAS __attribute__((address_space(3)))
typedef unsigned short bf16_t;
typedef short bf16x8 __attribute__((ext_vector_type(8)));
typedef float f32x4 __attribute__((ext_vector_type(4)));
typedef float f32x2 __attribute__((ext_vector_type(2)));
typedef unsigned u32x4 __attribute__((ext_vector_type(4)));
typedef unsigned u32x2 __attribute__((ext_vector_type(2)));
typedef int i32x8 __attribute__((ext_vector_type(8)));
typedef int i32x4 __attribute__((ext_vector_type(4)));

constexpr int BATCH = 32, SEQ = 2048, DM = 1024, T = BATCH * SEQ, MEMLEN = 256, MROWS = BATCH * MEMLEN;
constexpr int NPROJ = 3072, DIN = 3080, NP2 = 2048;
constexpr int NEXP = 32, TOPK = 4;
constexpr float EPS = 1e-5f;
constexpr float LAMBDA_INIT = 0.2f;

constexpr size_t MiB = 1u << 20;
constexpr size_t WS_CTL = 0, CTL_ZERO_BYTES = 64 * 1024;
constexpr size_t WS_RSTDX = 1 * MiB;
constexpr size_t WS_RSTDM = WS_RSTDX + (size_t)T * 4;
constexpr size_t WS_B1P = WS_RSTDM + (size_t)MROWS * 4;
constexpr size_t WS_MISC = WS_B1P + (size_t)NEXP * 2048 * 4;
constexpr size_t WS_RSTD2 = WS_MISC + 4096;
static_assert(WS_RSTD2 + (size_t)T * 4 <= 2 * MiB, "small region");
constexpr size_t WS_SSP1 = 2 * MiB;
constexpr size_t WS_SSP2 = 6 * MiB;
constexpr size_t WS_GATES = 10 * MiB;
constexpr size_t WS_TOKMAP = 12 * MiB;
constexpr size_t WS_GATEV = 13 * MiB;
constexpr size_t WS_LIST = 14 * MiB;
constexpr size_t WS_WIN = 24 * MiB;
constexpr size_t WS_WOUT = 30 * MiB;
constexpr size_t WS_WCQ = 32 * MiB;
constexpr size_t WS_WCKV = 34 * MiB;
constexpr size_t WS_WCO = 38 * MiB;
constexpr size_t WS_WR = 40 * MiB;
constexpr size_t WS_W1 = 64 * MiB;
constexpr size_t WS_H2F = 128 * MiB;
constexpr size_t WS_W2 = 192 * MiB;
constexpr size_t WS_XB = 256 * MiB;
constexpr size_t WS_PROJ = 384 * MiB;
constexpr size_t WS_H1F = 640 * MiB;
constexpr size_t WS_VT1 = 640 * MiB;
constexpr size_t WS_CAT = 768 * MiB;
constexpr size_t WS_MST = 896 * MiB;
constexpr size_t WS_MEMB = 962 * MiB;
constexpr size_t WS_KV = 978 * MiB;
constexpr size_t WS_VT2 = 994 * MiB;
constexpr size_t WS_QM = 128 * MiB;
constexpr size_t WS_KM = 160 * MiB;
constexpr size_t WS_CSTB = 224 * MiB;
constexpr size_t WS_BC = 1010 * MiB;
constexpr size_t WS_AV = 1011 * MiB;
constexpr size_t WS_AM = 1012 * MiB;
constexpr size_t WS_NLOC = 1013 * MiB;
constexpr size_t WS_NST = WS_NLOC + 512 * 1024;
constexpr size_t WS_CH = 1014 * MiB;
constexpr size_t WS_MSTATE = WS_CH + 64 * 1024;
constexpr size_t WS_Y = 256 * MiB;
constexpr size_t WS_HID = 512 * MiB;
constexpr size_t WS_HID1 = 896 * MiB;
constexpr size_t WS_END = 1024 * MiB;

constexpr int CW_CNT = 64;
constexpr int CW_BAR = 4096;
static_assert((CW_BAR + 3456) * 4 <= (int)CTL_ZERO_BYTES, "control words inside the per-call memset");

__device__ __forceinline__ float bf2f(bf16_t b) { return __uint_as_float(((unsigned)b) << 16); }
__device__ __forceinline__ unsigned f2bf(float f) { unsigned u = __float_as_uint(f); return (u + 0x7fffu + ((u >> 16) & 1u)) >> 16; }
__device__ __forceinline__ unsigned cvt_pk_bf16(float lo, float hi) { unsigned r; asm volatile("v_cvt_pk_bf16_f32 %0, %1, %2" : "=v"(r) : "v"(lo), "v"(hi)); return r; }
__device__ __forceinline__ float x32_sum(float v) { auto r = __builtin_amdgcn_permlane32_swap(__float_as_uint(v), __float_as_uint(v), false, false); return __uint_as_float(r[0]) + __uint_as_float(r[1]); }
__device__ __forceinline__ float x32_max(float v) { auto r = __builtin_amdgcn_permlane32_swap(__float_as_uint(v), __float_as_uint(v), false, false); return fmaxf(__uint_as_float(r[0]), __uint_as_float(r[1])); }
__device__ __forceinline__ float x32_other(float v, int hh) { auto r = __builtin_amdgcn_permlane32_swap(__float_as_uint(v), __float_as_uint(v), false, false); return hh ? __uint_as_float(r[0]) : __uint_as_float(r[1]); }
__device__ __forceinline__ float x16_sum(float v) { auto r = __builtin_amdgcn_permlane16_swap(__float_as_uint(v), __float_as_uint(v), false, false); return __uint_as_float(r[0]) + __uint_as_float(r[1]); }
__device__ __forceinline__ float row16_sum(float v) {
    v += __uint_as_float((unsigned)__builtin_amdgcn_update_dpp(0, (int)__float_as_uint(v), 0xB1, 0xf, 0xf, true));
    v += __uint_as_float((unsigned)__builtin_amdgcn_update_dpp(0, (int)__float_as_uint(v), 0x4E, 0xf, 0xf, true));
    v += __uint_as_float((unsigned)__builtin_amdgcn_update_dpp(0, (int)__float_as_uint(v), 0x141, 0xf, 0xf, true));
    v += __uint_as_float((unsigned)__builtin_amdgcn_update_dpp(0, (int)__float_as_uint(v), 0x140, 0xf, 0xf, true));
    return v; }
__device__ __forceinline__ float wave_sum(float v) { return x32_sum(x16_sum(row16_sum(v))); }
__device__ __forceinline__ int lane_id() { int l; asm volatile("v_mbcnt_lo_u32_b32 %0, -1, 0\n\tv_mbcnt_hi_u32_b32 %0, -1, %0" : "=v"(l)); return l; }
__device__ __forceinline__ float c8(float x) { return __builtin_amdgcn_fmed3f(x, -448.0f, 448.0f); }
__device__ __forceinline__ float lo_bf(unsigned w) { return __uint_as_float(w << 16); }
__device__ __forceinline__ float hi_bf(unsigned w) { return __uint_as_float(w & 0xffff0000u); }

namespace pg8 {
constexpr int BM = 256, BK = 64, HALF = 128, HTB = HALF * BK * 2, STAGE_BYTES = 8 * HTB, NXCD = 8, WGM = 8, KD = 1024, NT = KD / BK;
__host__ __device__ __forceinline__ int lds_byte(int r, int c) { const int st = (r >> 4) * 2 + (c >> 5), rr = r & 15, cc = c & 31, ob = rr * 64 + cc * 2; return st * 1024 + (ob ^ (((ob >> 9) & 1) << 5)); }
__host__ __device__ __forceinline__ void stage_rc(int b, int& R, int& C) { const int st = b / 1024, sb = b % 1024, swz = sb ^ (((sb >> 9) & 1) << 5); R = (st >> 1) * 16 + swz / 64; C = (st & 1) * 32 + (swz % 64) / 2; }
__host__ __device__ __forceinline__ int perm32(int rho) { const int n = rho >> 4, i = rho & 15; return 8 * (i >> 2) + 4 * n + (i & 3); }

struct Unit { const char* A; const char* B; int pm, pn, e, nvalid, y0, aux; };

__device__ __forceinline__ bool static_next(int i, int G, int c, int nM, int nN, int& pm, int& pn) {
    const int nwg = nM * nN; const long L = (long)i * G + c; if (L >= nwg) return false;
    int wgid = (int)L; { const int q = nwg / NXCD, r = nwg % NXCD, xcd = wgid % NXCD, off = wgid / NXCD; wgid = (xcd < r ? xcd * (q + 1) : r * (q + 1) + (xcd - r) * q) + off; }
    const int nig = WGM * nN, gid = wgid / nig, fm = gid * WGM, gsz = (nM - fm) < WGM ? (nM - fm) : WGM;
    pm = fm + ((wgid % nig) % gsz); pn = (wgid % nig) / gsz; return true;
}

template <class P, bool ALIGN_EPI>
__device__ __forceinline__ void gemm_phase(LAS unsigned char* lds, const P& prob, const int wid) {
    const int lane = lane_id(), tid = wid * 64 + lane, wr = wid >> 2, wc = wid & 3, fr = lane & 15, fq = lane >> 4;
    constexpr int ROWB = P::FP8 ? KD : 2 * KD;
    constexpr int nt = ROWB / 128;
    int RA[2], CA[2]; unsigned voffA[2], voffB[2];
#pragma unroll
    for (int i = 0; i < 2; ++i) { int R, C; stage_rc(tid * 16 + i * 8192, R, C); const int Rb = P::PERM ? ((R & ~31) + perm32(R & 31)) : R;
        RA[i] = R; CA[i] = C * 2; voffA[i] = (unsigned)(R * ROWB + C * 2); voffB[i] = (unsigned)(Rb * ROWB + C * 2); }
    constexpr int kstep = BK * 2;
    constexpr size_t hstep = (size_t)HALF * ROWB;
    const unsigned ldsw = (unsigned)wid * 1024u;
    const int aoff = lds_byte(wr * 64 + fr, fq * 8), boff = lds_byte(wc * 32 + fr, fq * 8);
#define PG8_SA(b, h) (((b) * 2 + (h)) * HTB)
#define PG8_SB(b, h) ((4 + (b) * 2 + (h)) * HTB)
#define PG8_STAGE_B(bufoff, gbase) do { _Pragma("unroll") for (int _i = 0; _i < 2; ++_i) \
        __builtin_amdgcn_global_load_lds((const unsigned*)((const char*)(gbase) + voffB[_i]), (LAS unsigned*)(lds + (bufoff) + ldsw + _i * 8192), 16, 0, 0); } while (0)
#define PG8_STAGE_A(bufoff, gbase, off, h) do { _Pragma("unroll") for (int _i = 0; _i < 2; ++_i) { const char* _p; \
        if constexpr (P::GATHER) _p = (const char*)(gbase) + (off)[h][_i]; else _p = (const char*)(gbase) + (size_t)(h) * hstep + voffA[_i]; \
        __builtin_amdgcn_global_load_lds((const unsigned*)_p, (LAS unsigned*)(lds + (bufoff) + ldsw + _i * 8192), 16, 0, 0); } } while (0)
#define PG8_LDA(dst, b, h) do { _Pragma("unroll") for (int m = 0; m < 4; ++m) _Pragma("unroll") for (int k = 0; k < 2; ++k) dst[m][k] = *(const LAS bf16x8*)(lds + PG8_SA(b, h) + aoff + m * 2048 + k * 1024); } while (0)
#define PG8_LDB(dst, b, h) do { _Pragma("unroll") for (int n = 0; n < 2; ++n) _Pragma("unroll") for (int k = 0; k < 2; ++k) dst[n][k] = *(const LAS bf16x8*)(lds + PG8_SB(b, h) + boff + n * 2048 + k * 1024); } while (0)
#define PG8_MMA(ai, bj, At, Bt) do { __builtin_amdgcn_s_setprio(1); _Pragma("unroll") for (int m = 0; m < 4; ++m) _Pragma("unroll") for (int n = 0; n < 2; ++n) { \
        if constexpr (P::FP8) { const i32x4 b0_ = __builtin_bit_cast(i32x4, Bt[n][0]), b1_ = __builtin_bit_cast(i32x4, Bt[n][1]), a0_ = __builtin_bit_cast(i32x4, At[m][0]), a1_ = __builtin_bit_cast(i32x4, At[m][1]); \
            acc[ai][bj][m][n] = __builtin_amdgcn_mfma_scale_f32_16x16x128_f8f6f4((i32x8){b0_[0], b0_[1], b0_[2], b0_[3], b1_[0], b1_[1], b1_[2], b1_[3]}, (i32x8){a0_[0], a0_[1], a0_[2], a0_[3], a1_[0], a1_[1], a1_[2], a1_[3]}, \
                acc[ai][bj][m][n], 0, 0, 0, 0x7f7f7f7f, 0, 0x7f7f7f7f); } \
        else { _Pragma("unroll") for (int k = 0; k < 2; ++k) acc[ai][bj][m][n] = __builtin_amdgcn_mfma_f32_16x16x32_bf16(Bt[n][k], At[m][k], acc[ai][bj][m][n], 0, 0, 0); } } \
        __builtin_amdgcn_s_setprio(0); } while (0)
#define PG8_WAIT_V(n) asm volatile("s_waitcnt vmcnt(" #n ")" ::: "memory")
#define PG8_WAIT_L(n) asm volatile("s_waitcnt lgkmcnt(" #n ")" ::: "memory")
#define PG8_BAR __builtin_amdgcn_s_barrier()
#define PG8_SCHED __builtin_amdgcn_sched_barrier(0)
    Unit cur, nxt; int ui = 0;
    if (!prob.next(0, cur)) return;
    f32x4 acc[2][2][4][2];
#pragma unroll
    for (int a = 0; a < 2; ++a)
#pragma unroll
        for (int b = 0; b < 2; ++b)
#pragma unroll
            for (int m = 0; m < 4; ++m)
#pragma unroll
                for (int n = 0; n < 2; ++n) acc[a][b][m][n] = (f32x4){0.f, 0.f, 0.f, 0.f};
    bf16x8 At[4][2], B0[2][2], B1[2][2];
    unsigned offC[2][2] = {{0u, 0u}, {0u, 0u}};
#define PG8_FILL(u, buf) do { if (tid < 256) prob.gtab[(buf) * 256 + tid] = prob.a_off(u, tid); } while (0)
#define PG8_OFFS(buf) do { _Pragma("unroll") for (int _h = 0; _h < 2; ++_h) _Pragma("unroll") for (int _i = 0; _i < 2; ++_i) offC[_h][_i] = prob.gtab[(buf) * 256 + _h * HALF + RA[_i]] + (unsigned)CA[_i]; } while (0)
    Unit nx2;
    bool has_next = prob.next(1, nxt);
    if constexpr (P::GATHER) { PG8_FILL(cur, 0); if (has_next) PG8_FILL(nxt, 1); PG8_WAIT_L(0); PG8_BAR; PG8_OFFS(0); }
    const char* cA = prob.a_tile(cur); const char* cB = cur.B;
    PG8_STAGE_B(PG8_SB(0, 0), cB); PG8_STAGE_B(PG8_SB(0, 1), cB + hstep); PG8_STAGE_A(PG8_SA(0, 0), cA, offC, 0); PG8_STAGE_A(PG8_SA(0, 1), cA, offC, 1);
    if (wr == 1) PG8_BAR;
    PG8_WAIT_V(2); PG8_BAR;
    PG8_STAGE_B(PG8_SB(1, 0), cB + kstep); PG8_STAGE_A(PG8_SA(1, 0), cA + kstep, offC, 0); PG8_STAGE_B(PG8_SB(1, 1), cB + hstep + kstep);
    PG8_WAIT_V(6); PG8_BAR;
    int bcur = 0;
    for (;;) {
        const bool has_nx2 = has_next && prob.next(ui + 2, nx2);
        const char* nA = has_next ? prob.a_tile(nxt) : cA; const char* nB = has_next ? nxt.B : cB;
        const int bnext = bcur == 2 ? 0 : bcur + 1, bnx2 = bnext == 2 ? 0 : bnext + 1;
#pragma unroll 1
        for (int t = 0; t < nt; t += 2) {
            const bool last = (t == nt - 2);
            const char* a1 = cA + (size_t)(t + 1) * kstep;
            const char* a2 = last ? nA : cA + (size_t)(t + 2) * kstep; const char* b2 = last ? nB : cB + (size_t)(t + 2) * kstep;
            const char* a3 = a2 + kstep; const char* b3 = b2 + kstep;
            PG8_LDB(B0, 0, 0); PG8_LDB(B1, 0, 1); PG8_SCHED; PG8_LDA(At, 0, 0); PG8_STAGE_A(PG8_SA(1, 1), a1, offC, 1);
            if constexpr (P::GATHER) { if (last && has_next) PG8_OFFS(bnext); }
            PG8_WAIT_V(8); PG8_WAIT_L(0); PG8_BAR; PG8_MMA(0, 0, At, B0); PG8_MMA(0, 1, At, B1); PG8_BAR; PG8_SCHED;
            PG8_LDA(At, 0, 1); PG8_STAGE_B(PG8_SB(0, 0), b2); PG8_STAGE_B(PG8_SB(0, 1), b2 + hstep); PG8_STAGE_A(PG8_SA(0, 0), a2, offC, 0);
            PG8_WAIT_V(8); PG8_WAIT_L(0); PG8_BAR; PG8_MMA(1, 0, At, B0); PG8_MMA(1, 1, At, B1); PG8_BAR; PG8_SCHED;
            PG8_LDB(B0, 1, 0); PG8_LDB(B1, 1, 1); PG8_SCHED; PG8_LDA(At, 1, 0); PG8_STAGE_A(PG8_SA(0, 1), a2, offC, 1);
            PG8_WAIT_V(8); PG8_WAIT_L(0); PG8_BAR; PG8_MMA(0, 0, At, B0); PG8_MMA(0, 1, At, B1); PG8_BAR; PG8_SCHED;
            PG8_LDA(At, 1, 1); PG8_STAGE_B(PG8_SB(1, 0), b3); PG8_STAGE_B(PG8_SB(1, 1), b3 + hstep); PG8_STAGE_A(PG8_SA(1, 0), a3, offC, 0);
            PG8_WAIT_V(8); PG8_WAIT_L(0); PG8_BAR; PG8_MMA(1, 0, At, B0); PG8_MMA(1, 1, At, B1); PG8_BAR; PG8_SCHED;
        }
        if constexpr (ALIGN_EPI) { if (wr == 0) PG8_BAR; }
        if constexpr (P::GATHER) { if (has_nx2) PG8_FILL(nx2, bnx2); }
        cur.aux = bcur;
        prob.epi(acc, cur, wr, wc, fr, fq);
        if (!has_next) break;
#pragma unroll
        for (int a = 0; a < 2; ++a)
#pragma unroll
            for (int b = 0; b < 2; ++b)
#pragma unroll
                for (int m = 0; m < 4; ++m)
#pragma unroll
                    for (int n = 0; n < 2; ++n) acc[a][b][m][n] = (f32x4){0.f, 0.f, 0.f, 0.f};
        cur = nxt; nxt = nx2; has_next = has_nx2; cA = nA; cB = nB; ++ui; bcur = bnext;
        if constexpr (ALIGN_EPI) { if (wr == 1) PG8_BAR; }
    }
    PG8_WAIT_V(0);
    if constexpr (!ALIGN_EPI) { if (wr == 0) PG8_BAR; }
    PG8_BAR;
#undef PG8_SA
#undef PG8_SB
#undef PG8_STAGE_A
#undef PG8_STAGE_B
#undef PG8_LDA
#undef PG8_LDB
#undef PG8_MMA
#undef PG8_WAIT_V
#undef PG8_WAIT_L
#undef PG8_BAR
#undef PG8_SCHED
#undef PG8_OFFS
#undef PG8_FILL
}
}

template <bool F8> struct ProbScaleT {
    static constexpr bool FP8 = F8, PERM = true, GATHER = F8;
    static constexpr int RB = F8 ? 1024 : 2048;
    __device__ __forceinline__ const char* a_tile(const pg8::Unit& u) const { return F8 ? u.A : u.A + (size_t)u.pm * (256 * RB); }
    LAS unsigned* gtab;
    const void* A; const void* Bt; int nM, nN, G, c;
    bf16_t* O; int ldo; const float* rstd; const float* ssp;
    __device__ __forceinline__ bool next(int i, pg8::Unit& u) const {
        int pm, pn; if (!pg8::static_next(i, G, c, nM, nN, pm, pn)) return false;
        u.A = (const char*)A; u.B = (const char*)Bt + (size_t)pn * 256 * RB; u.pm = pm; u.pn = pn; u.e = 0; u.nvalid = 256; u.y0 = 0; u.aux = 0; return true; }
    __device__ __forceinline__ unsigned a_off(const pg8::Unit& u, int r) const { return (unsigned)(u.pm * 256 + r) * (unsigned)RB; }
    __device__ __forceinline__ void epi(const f32x4 (&acc)[2][2][4][2], const pg8::Unit& u, int wr, int wc, int fr, int fq) const {
        asm volatile("" : "+v"(fr), "+v"(fq));
        const int rowu = u.pm * 256 + wr * 64;
        char* ub = (char*)O + ((size_t)rowu * ldo + u.pn * 256 + wc * 32) * 2;
        const unsigned lo = (unsigned)(fr * ldo + 8 * fq) * 2u;
        float rsv[8];
        if (rstd) {
#pragma unroll
            for (int q = 0; q < 8; ++q) rsv[q] = rstd[rowu + fr + (q >> 2) * 128 + (q & 3) * 16];
        } else { f32x4 pv[8];
#pragma unroll
            for (int q = 0; q < 8; ++q) pv[q] = *(const f32x4*)(ssp + (size_t)(rowu + fr + (q >> 2) * 128 + (q & 3) * 16) * 16 + fq * 4);
#pragma unroll
            for (int q = 0; q < 8; ++q) { float sq = (pv[q][0] + pv[q][1]) + (pv[q][2] + pv[q][3]); sq = x16_sum(sq); sq = x32_sum(sq); rsv[q] = rsqrtf(sq * (1.0f / 1024.0f) + EPS); } }
#pragma unroll
        for (int ai = 0; ai < 2; ++ai)
#pragma unroll
            for (int m = 0; m < 4; ++m) { const float rs = rsv[ai * 4 + m] * (F8 ? (1.0f / 64.0f) : 1.0f);
                char* rowp = ub + (size_t)(ai * 128 + m * 16) * ldo * 2 + lo;
#pragma unroll
                for (int bj = 0; bj < 2; ++bj) { const f32x4 v0 = acc[ai][bj][m][0] * rs, v1 = acc[ai][bj][m][1] * rs;
                    u32x4 w; w.x = cvt_pk_bf16(v0[0], v0[1]); w.y = cvt_pk_bf16(v0[2], v0[3]); w.z = cvt_pk_bf16(v1[0], v1[1]); w.w = cvt_pk_bf16(v1[2], v1[3]);
                    *(u32x4*)(rowp + bj * 256) = w; } }
    }
};
typedef ProbScaleT<false> ProbScaleBf16;
struct ProbColScaleBf16 {
    static constexpr bool FP8 = false, PERM = true, GATHER = false;
    __device__ __forceinline__ const char* a_tile(const pg8::Unit& u) const { return u.A + (size_t)u.pm * (256 * 2048); }
    const bf16_t* A; const bf16_t* Bt; int nM, nN, G, c;
    bf16_t* O; int ldo; const float* cs;
    __device__ __forceinline__ bool next(int i, pg8::Unit& u) const {
        const long L = (long)i * G + c; if (L >= (long)nM * nN) return false;
        const int pm = (int)(L % nM), pn = (int)(L / nM);
        u.A = (const char*)A; u.B = (const char*)(Bt + (size_t)pn * 256 * 1024); u.pm = pm; u.pn = pn; u.e = 0; u.nvalid = 256; u.y0 = 0; u.aux = 0; return true; }
    __device__ __forceinline__ unsigned a_off(const pg8::Unit& u, int r) const { return 0u; }
    __device__ __forceinline__ void epi(const f32x4 (&acc)[2][2][4][2], const pg8::Unit& u, int wr, int wc, int fr, int fq) const {
        asm volatile("" : "+v"(fr), "+v"(fq));
        const float* cp = cs + u.pn * 256 + wc * 32 + 8 * fq;
        f32x4 sc[2][2];
#pragma unroll
        for (int bj = 0; bj < 2; ++bj)
#pragma unroll
            for (int n = 0; n < 2; ++n) sc[bj][n] = *(const f32x4*)(cp + bj * 128 + 4 * n);
        char* ub = (char*)O + ((size_t)(u.pm * 256 + wr * 64) * ldo + u.pn * 256 + wc * 32) * 2;
        const unsigned lo = (unsigned)(fr * ldo + 8 * fq) * 2u;
#pragma unroll
        for (int ai = 0; ai < 2; ++ai)
#pragma unroll
            for (int m = 0; m < 4; ++m) { char* rowp = ub + (size_t)(ai * 128 + m * 16) * ldo * 2 + lo;
#pragma unroll
                for (int bj = 0; bj < 2; ++bj) { const f32x4 v0 = acc[ai][bj][m][0] * sc[bj][0], v1 = acc[ai][bj][m][1] * sc[bj][1];
                    u32x4 w; w.x = cvt_pk_bf16(v0[0], v0[1]); w.y = cvt_pk_bf16(v0[2], v0[3]); w.z = cvt_pk_bf16(v1[0], v1[1]); w.w = cvt_pk_bf16(v1[2], v1[3]);
                    *(u32x4*)(rowp + bj * 256) = w; } }
    }
};
struct ProbKV {
    static constexpr bool FP8 = true, PERM = true, GATHER = true;
    __device__ __forceinline__ const char* a_tile(const pg8::Unit& u) const { return u.A; }
    LAS unsigned* gtab;
    const unsigned char* memb; const unsigned char* wckv; bf16_t* Kout; bf16_t* VTout; const float* rstdm; int G, c;
    __device__ __forceinline__ bool next(int i, pg8::Unit& u) const {
        const long L = (long)i * G + c; if (L >= 256) return false;
        if (L < 128) { u.pm = (int)(L & 31); u.pn = (int)(L >> 5); u.e = 0; u.A = (const char*)memb; u.B = (const char*)(wckv + (size_t)u.pn * 256 * 1024); }
        else { const int l2 = (int)L - 128; u.pm = l2 & 3; u.pn = l2 >> 2; u.e = 1; u.A = (const char*)(wckv + (size_t)1024 * 1024); u.B = (const char*)(memb + (size_t)u.pn * 256 * 1024); }
        u.nvalid = 256; u.y0 = 0; u.aux = 0; return true; }
    __device__ __forceinline__ unsigned a_off(const pg8::Unit& u, int r) const { return (unsigned)(u.pm * 256 + r) * 1024u; }
    __device__ __forceinline__ void epi(const f32x4 (&acc)[2][2][4][2], const pg8::Unit& u, int wr, int wc, int fr, int fq) const {
        asm volatile("" : "+v"(fr), "+v"(fq));
        const int ldo = u.e ? MROWS : 1024;
        char* ub = (char*)(u.e ? VTout : Kout) + ((size_t)(u.pm * 256 + wr * 64) * ldo + u.pn * 256 + wc * 32) * 2;
        const unsigned lo = (unsigned)(fr * ldo + 8 * fq) * 2u;
        float rsv[8]; f32x4 sc[2][2];
        if (u.e == 0) {
#pragma unroll
            for (int q = 0; q < 8; ++q) rsv[q] = rstdm[u.pm * 256 + wr * 64 + fr + (q >> 2) * 128 + (q & 3) * 16] * (1.0f / 64.0f);
#pragma unroll
            for (int bj = 0; bj < 2; ++bj)
#pragma unroll
                for (int n = 0; n < 2; ++n) sc[bj][n] = (f32x4){1.f, 1.f, 1.f, 1.f};
        } else {
#pragma unroll
            for (int q = 0; q < 8; ++q) rsv[q] = 1.0f / 64.0f;
            const float* cp = rstdm + u.pn * 256 + wc * 32 + 8 * fq;
#pragma unroll
            for (int bj = 0; bj < 2; ++bj)
#pragma unroll
                for (int n = 0; n < 2; ++n) sc[bj][n] = *(const f32x4*)(cp + bj * 128 + 4 * n); }
#pragma unroll
        for (int ai = 0; ai < 2; ++ai)
#pragma unroll
            for (int m = 0; m < 4; ++m) { const float rs = rsv[ai * 4 + m]; char* rowp = ub + (size_t)(ai * 128 + m * 16) * ldo * 2 + lo;
#pragma unroll
                for (int bj = 0; bj < 2; ++bj) { const f32x4 v0 = acc[ai][bj][m][0] * sc[bj][0] * rs, v1 = acc[ai][bj][m][1] * sc[bj][1] * rs;
                    u32x4 w; w.x = cvt_pk_bf16(v0[0], v0[1]); w.y = cvt_pk_bf16(v0[2], v0[3]); w.z = cvt_pk_bf16(v1[0], v1[1]); w.w = cvt_pk_bf16(v1[2], v1[3]);
                    *(u32x4*)(rowp + bj * 256) = w; } }
    }
};
template <bool F8, bool WF8, bool RF32> struct ProbResidT {
    static constexpr bool FP8 = F8, PERM = true, GATHER = F8;
    static constexpr int RB = F8 ? 1024 : 2048;
    __device__ __forceinline__ const char* a_tile(const pg8::Unit& u) const { return F8 ? u.A : u.A + (size_t)u.pm * (256 * RB); }
    LAS unsigned* gtab;
    const void* A; const void* Bt; int nM, nN, G, c;
    const float* rf; const bf16_t* rb; bf16_t* ob; unsigned char* of8; float* ssp;
    __device__ __forceinline__ bool next(int i, pg8::Unit& u) const {
        int pm, pn; if (!pg8::static_next(i, G, c, nM, nN, pm, pn)) return false;
        u.A = (const char*)A; u.B = (const char*)Bt + (size_t)pn * 256 * RB; u.pm = pm; u.pn = pn; u.e = 0; u.nvalid = 256; u.y0 = 0; u.aux = 0; return true; }
    __device__ __forceinline__ unsigned a_off(const pg8::Unit& u, int r) const { return (unsigned)(u.pm * 256 + r) * (unsigned)RB; }
    __device__ __forceinline__ void epi(const f32x4 (&acc)[2][2][4][2], const pg8::Unit& u, int wr, int wc, int fr, int fq) const {
        asm volatile("" : "+v"(fr), "+v"(fq));
        const int rowu = u.pm * 256 + wr * 64;
        const size_t uoff = (size_t)rowu * 1024 + u.pn * 256 + wc * 32;
        const unsigned lo = (unsigned)(fr * 1024 + 8 * fq);
        const float sc = F8 ? (1.0f / 64.0f) : 1.0f;
#pragma unroll
        for (int ai = 0; ai < 2; ++ai) {
            f32x4 rv[4][2][2];
#pragma unroll
            for (int m = 0; m < 4; ++m) { const size_t ro = uoff + (size_t)(ai * 128 + m * 16) * 1024;
#pragma unroll
                for (int bj = 0; bj < 2; ++bj) {
                    if constexpr (RF32) { rv[m][bj][0] = *(const GAS f32x4*)(rf + ro + lo + bj * 128); rv[m][bj][1] = *(const GAS f32x4*)(rf + ro + lo + bj * 128 + 4); }
                    else { const u32x4 w = *(const GAS u32x4*)(rb + ro + lo + bj * 128); rv[m][bj][0] = (f32x4){lo_bf(w.x), hi_bf(w.x), lo_bf(w.y), hi_bf(w.y)}; rv[m][bj][1] = (f32x4){lo_bf(w.z), hi_bf(w.z), lo_bf(w.w), hi_bf(w.w)}; } } }
#pragma unroll
            for (int m = 0; m < 4; ++m) { const size_t ro = uoff + (size_t)(ai * 128 + m * 16) * 1024; float ss = 0.f;
                unsigned pk[2][2];
#pragma unroll
                for (int bj = 0; bj < 2; ++bj) { const f32x4 v0 = acc[ai][bj][m][0] * sc + rv[m][bj][0], v1 = acc[ai][bj][m][1] * sc + rv[m][bj][1];
                    ss += (v0[0] * v0[0] + v0[1] * v0[1]) + (v0[2] * v0[2] + v0[3] * v0[3]) + (v1[0] * v1[0] + v1[1] * v1[1]) + (v1[2] * v1[2] + v1[3] * v1[3]);
                    u32x4 w; w.x = cvt_pk_bf16(v0[0], v0[1]); w.y = cvt_pk_bf16(v0[2], v0[3]); w.z = cvt_pk_bf16(v1[0], v1[1]); w.w = cvt_pk_bf16(v1[2], v1[3]);
                    *(u32x4*)(ob + ro + lo + bj * 128) = w;
                    if constexpr (WF8) { unsigned w0 = 0u, w1 = 0u;
                        w0 = __builtin_amdgcn_cvt_pk_fp8_f32(c8(v0[0]), c8(v0[1]), w0, false); w0 = __builtin_amdgcn_cvt_pk_fp8_f32(c8(v0[2]), c8(v0[3]), w0, true);
                        w1 = __builtin_amdgcn_cvt_pk_fp8_f32(c8(v1[0]), c8(v1[1]), w1, false); w1 = __builtin_amdgcn_cvt_pk_fp8_f32(c8(v1[2]), c8(v1[3]), w1, true);
                        pk[bj][0] = w0; pk[bj][1] = w1; } }
                if constexpr (WF8) {
                    const auto s0 = __builtin_amdgcn_permlane16_swap(pk[0][0], pk[1][0], false, false), s1 = __builtin_amdgcn_permlane16_swap(pk[0][1], pk[1][1], false, false);
                    *(u32x4*)(of8 + ro + lo + ((fq & 1) ? 120u : 0u)) = (u32x4){s0[0], s1[0], s0[1], s1[1]}; }
                ss = x16_sum(ss); ss = x32_sum(ss);
                if (fq == 0) ssp[(size_t)(rowu + ai * 128 + m * 16 + fr) * 16 + u.pn * 4 + wc] = ss; } }
    }
};
__device__ __forceinline__ size_t hid_tile_off(int rt) { return rt < 1024 ? (size_t)rt * (256 * 1024) : (WS_HID1 - WS_HID) + (size_t)(rt - 1024) * (256 * 1024); }
constexpr int MOE_TS = 0, MOE_ST = 33, MOE_CNT = 66, MOE_RTE = 100, MOE_WORDS = 100 + 264;
struct ProbMoe1 {
    static constexpr bool FP8 = true, PERM = true, GATHER = true;
    __device__ __forceinline__ const char* a_tile(const pg8::Unit& u) const { return u.A; }
    const unsigned char* hb; const unsigned char* w1b; const float* b1p; const float* rstd2; const unsigned* list; unsigned char* hid;
    const volatile LAS int* tab; LAS unsigned* gtab; int rt0, nrt, G, c;
    __device__ __forceinline__ bool next(int i, pg8::Unit& u) const {
        const long L = (long)i * G + c; if (L >= (long)nrt * 8) return false;
        const int gidx = (int)(L >> 8), within = (int)(L & 255), gsz = (nrt - gidx * 32) < 32 ? (nrt - gidx * 32) : 32;
        const int rtl = gidx * 32 + within % gsz, pn = within / gsz, rt = rt0 + rtl;
        const int e = ((const volatile LAS unsigned char*)(tab + MOE_RTE))[rt];
        const int idx0 = (rt - tab[MOE_TS + e]) * 256;
        u.A = (const char*)hb; u.B = (const char*)(w1b + ((size_t)e * 2048 + (size_t)pn * 256) * 1024); u.pm = rt; u.pn = pn; u.e = e; u.nvalid = tab[MOE_CNT + e] - idx0; u.y0 = idx0; u.aux = 0; return true; }
    __device__ __forceinline__ unsigned tok_of(const pg8::Unit& u, int r) const { const int rr = r < u.nvalid ? r : 0; return list[(size_t)u.e * T + u.y0 + rr]; }
    __device__ __forceinline__ unsigned a_off(const pg8::Unit& u, int r) const { return tok_of(u, r) * 1024u; }
    __device__ __forceinline__ void epi(const f32x4 (&acc)[2][2][4][2], const pg8::Unit& u, int wr, int wc, int fr, int fq) const {
        asm volatile("" : "+v"(fr), "+v"(fq));
        const float* bp = b1p + (size_t)u.e * 2048 + u.pn * 256 + wc * 32 + 8 * fq;
        const f32x4 bg0 = *(const f32x4*)(bp), bg1 = *(const f32x4*)(bp + 4), bl0 = *(const f32x4*)(bp + 128), bl1 = *(const f32x4*)(bp + 132);
        char* ub = (char*)hid + hid_tile_off(u.pm) + ((size_t)(wr * 64) * 1024 + u.pn * 128 + wc * 32);
        const unsigned lo = (unsigned)(fr * 1024 + 8 * fq);
        unsigned wk[2][2];
#pragma unroll
        for (int ai = 0; ai < 2; ++ai)
#pragma unroll
            for (int m = 0; m < 4; ++m) { const float rs = 1.0f / 64.0f;
                unsigned w[2];
#pragma unroll
                for (int n = 0; n < 2; ++n) { const f32x4 g4 = acc[ai][0][m][n] * rs + (n ? bg1 : bg0), l4 = acc[ai][1][m][n] * rs + (n ? bl1 : bl0);
                    unsigned wv = 0u;
#pragma unroll
                    for (int jp = 0; jp < 2; ++jp) {
                        f32x2 g2 = {fminf(g4[2 * jp], 7.0f), fminf(g4[2 * jp + 1], 7.0f)};
                        const f32x2 l2 = {__builtin_amdgcn_fmed3f(l4[2 * jp], -7.0f, 7.0f), __builtin_amdgcn_fmed3f(l4[2 * jp + 1], -7.0f, 7.0f)};
                        const f32x2 z2 = g2 * (-1.702f * 1.4426950408889634f);
                        const f32x2 d2 = (f32x2){__builtin_amdgcn_exp2f(z2[0]), __builtin_amdgcn_exp2f(z2[1])} + 1.0f;
                        const f32x2 r2 = {__builtin_amdgcn_rcpf(d2[0]), __builtin_amdgcn_rcpf(d2[1])};
                        const f32x2 o2 = (g2 * r2) * (l2 * 4.0f + 4.0f);
                        if (jp) wv = __builtin_amdgcn_cvt_pk_fp8_f32(o2[0], o2[1], wv, true); else wv = __builtin_amdgcn_cvt_pk_fp8_f32(o2[0], o2[1], wv, false); }
                    w[n] = wv; }
                wk[m & 1][0] = w[0]; wk[m & 1][1] = w[1];
                if (m & 1) {
                    const auto s0 = __builtin_amdgcn_permlane16_swap(wk[0][0], wk[1][0], false, false), s1 = __builtin_amdgcn_permlane16_swap(wk[0][1], wk[1][1], false, false);
                    *(u32x4*)(ub + (size_t)(ai * 128 + (m - 1) * 16) * 1024 + lo + ((fq & 1) ? 16u * 1024u - 8u : 0u)) = (u32x4){s0[0], s1[0], s0[1], s1[1]}; } }
    }
};
struct ProbMoe2 {
    static constexpr bool FP8 = true, PERM = true, GATHER = true;
    __device__ __forceinline__ const char* a_tile(const pg8::Unit& u) const { return u.A; }
    const unsigned char* hid; const unsigned char* w2b; const float* b2; unsigned char* y;
    const volatile LAS int* tab; LAS unsigned* gtab; int rt0, nrt, G, c;
    __device__ __forceinline__ bool next(int i, pg8::Unit& u) const {
        const long L = (long)i * G + c; if (L >= (long)nrt * 4) return false;
        const int gidx = (int)(L >> 8), within = (int)(L & 255), gsz = (nrt - gidx * 64) < 64 ? (nrt - gidx * 64) : 64;
        const int rtl = gidx * 64 + within % gsz, pn = within / gsz, rt = rt0 + rtl;
        const int e = ((const volatile LAS unsigned char*)(tab + MOE_RTE))[rt];
        const int idx0 = (rt - tab[MOE_TS + e]) * 256;
        u.A = (const char*)hid; u.B = (const char*)(w2b + ((size_t)e * 1024 + (size_t)pn * 256) * 1024); u.pm = rt; u.pn = pn; u.e = e; u.nvalid = tab[MOE_CNT + e] - idx0; u.y0 = tab[MOE_ST + e] + idx0; u.aux = 0; return true; }
    __device__ __forceinline__ unsigned a_off(const pg8::Unit& u, int r) const { return (unsigned)(hid_tile_off(u.pm) + (size_t)r * 1024u); }
    __device__ __forceinline__ void epi(const f32x4 (&acc)[2][2][4][2], const pg8::Unit& u, int wr, int wc, int fr, int fq) const {
        asm volatile("" : "+v"(fr), "+v"(fq));
        const float* bp = b2 + (size_t)u.e * 1024 + u.pn * 256 + wc * 32 + 8 * fq;
        f32x4 bv[2][2];
#pragma unroll
        for (int bj = 0; bj < 2; ++bj)
#pragma unroll
            for (int n = 0; n < 2; ++n) bv[bj][n] = *(const f32x4*)(bp + bj * 128 + 4 * n);
        char* ub = (char*)y + (((size_t)u.y0 + wr * 64) * 1024 + u.pn * 256 + wc * 32);
        const unsigned lo2 = (unsigned)(fr * 1024 + 8 * fq) + ((fq & 1) ? 120u : 0u);
        const int r0 = wr * 64 + fr;
#pragma unroll
        for (int ai = 0; ai < 2; ++ai)
#pragma unroll
            for (int m = 0; m < 4; ++m) { const int r = r0 + ai * 128 + m * 16;
                unsigned pk[2][2];
#pragma unroll
                for (int bj = 0; bj < 2; ++bj) { const f32x4 v0 = acc[ai][bj][m][0] * (1.0f / 16.0f) + bv[bj][0] * 16.0f, v1 = acc[ai][bj][m][1] * (1.0f / 16.0f) + bv[bj][1] * 16.0f;
                    unsigned w0 = 0u, w1 = 0u;
                    w0 = __builtin_amdgcn_cvt_pk_fp8_f32(c8(v0[0]), c8(v0[1]), w0, false); w0 = __builtin_amdgcn_cvt_pk_fp8_f32(c8(v0[2]), c8(v0[3]), w0, true);
                    w1 = __builtin_amdgcn_cvt_pk_fp8_f32(c8(v1[0]), c8(v1[1]), w1, false); w1 = __builtin_amdgcn_cvt_pk_fp8_f32(c8(v1[2]), c8(v1[3]), w1, true);
                    pk[bj][0] = w0; pk[bj][1] = w1; }
                const auto s0 = __builtin_amdgcn_permlane16_swap(pk[0][0], pk[1][0], false, false), s1 = __builtin_amdgcn_permlane16_swap(pk[0][1], pk[1][1], false, false);
                if (r < u.nvalid) *(u32x4*)(ub + (size_t)(ai * 128 + m * 16) * 1024 + lo2) = (u32x4){s0[0], s1[0], s0[1], s1[1]}; }
    }
};

#define XB_TMO      128
#define XB_XCNT(j)  (256  + 64 * (j))
#define XB_XSUB(j)  (1280 + 64 * (j))
#define XB_XGEN(j)  (2304 + 64 * (j))
#define XB_TOP      3328
#define XB_TOPGEN   3392
#define XCD_BAR_WORDS 3456
#define XB_SPIN_CAP (1u << 18)
__device__ __forceinline__ unsigned xb_ld(unsigned* p)              { return __hip_atomic_load(p, __ATOMIC_RELAXED, __HIP_MEMORY_SCOPE_AGENT); }
__device__ __forceinline__ unsigned xb_add(unsigned* p, unsigned v) { return __hip_atomic_fetch_add(p, v, __ATOMIC_RELAXED, __HIP_MEMORY_SCOPE_AGENT); }
__device__ __forceinline__ unsigned xb_xcc_id() { return (unsigned)__builtin_amdgcn_s_getreg((3 << 11) | 20) & 0xFu; }
#define XB_SPIN(cond, bar) do { unsigned _sp = 0; while (cond) { __builtin_amdgcn_s_sleep(1); \
    if ((++_sp & 255u) == 0u) { if (xb_ld(&(bar)[XB_TMO])) break; if (_sp > XB_SPIN_CAP) { atomicAdd(&(bar)[XB_TMO], 1u); break; } } } } while (0)
struct XcdBarrier { unsigned* bar; unsigned x; volatile LAS unsigned* st; int wave; };
__device__ __forceinline__ XcdBarrier xcd_barrier_post(unsigned* bar, volatile LAS unsigned* st, int wave) {
    XcdBarrier b; b.bar = bar; b.x = xb_xcc_id(); b.st = st; b.wave = wave;
    if (wave == 0 && lane_id() == 0) (void)xb_add(&bar[XB_XCNT(b.x)], 1u);
    return b;
}
__device__ __forceinline__ void xcd_barrier_complete(unsigned* bar, unsigned x, unsigned& nloc, unsigned& nx) {
    const unsigned G = gridDim.x * gridDim.y * gridDim.z;
    unsigned sum, cnt, mine, sp = 0u;
    for (;;) {
        sum = 0u; cnt = 0u; mine = 0u;
#pragma unroll
        for (unsigned j = 0; j < 16; ++j) { const unsigned c = xb_ld(&bar[XB_XCNT(j)]); sum += c; cnt += (c > 0u) ? 1u : 0u; mine = (j == x) ? c : mine; }
        if (sum == G) break;
        __builtin_amdgcn_s_sleep(1);
        if ((++sp & 255u) == 0u) { if (xb_ld(&bar[XB_TMO])) break; if (sp > XB_SPIN_CAP) { atomicAdd(&bar[XB_TMO], 1u); break; } }
    }
    nloc = mine > 0u ? mine : 1u; nx = cnt > 0u ? cnt : 1u;
}
__device__ __forceinline__ void xcd_barrier(const XcdBarrier& b) {
    asm volatile("s_waitcnt vmcnt(0)" ::: "memory");
    __syncthreads();
    if (b.wave == 0 && lane_id() == 0) {
        unsigned* bar = b.bar;
        __builtin_amdgcn_s_waitcnt(0);
        unsigned nloc = b.st[0], nx = b.st[1];
        if (nloc == 0u) { xcd_barrier_complete(bar, b.x, nloc, nx); b.st[0] = nloc; b.st[1] = nx; }
        const unsigned old = xb_add(&bar[XB_XSUB(b.x)], 1u);
        const unsigned gen = old / nloc;
        if (old + 1u == (gen + 1u) * nloc) {
            __builtin_amdgcn_fence(__ATOMIC_RELEASE, "agent");
            asm volatile("s_waitcnt vmcnt(0)" ::: "memory");
            const unsigned og = xb_add(&bar[XB_TOP], 1u);
            const unsigned tg = og / nx;
            if (og + 1u == (tg + 1u) * nx) xb_add(&bar[XB_TOPGEN], 1u);
            else XB_SPIN(xb_ld(&bar[XB_TOPGEN]) == tg, bar);
            __builtin_amdgcn_fence(__ATOMIC_ACQUIRE, "agent");
            xb_add(&bar[XB_XGEN(b.x)], 1u);
            asm volatile("s_waitcnt vmcnt(0)" ::: "memory");
        } else {
            XB_SPIN(xb_ld(&bar[XB_XGEN(b.x)]) == gen, bar);
            __builtin_amdgcn_fence(__ATOMIC_ACQUIRE, "agent");
            asm volatile("s_waitcnt vmcnt(0)" ::: "memory");
        }
    }
    __syncthreads();
}

typedef float f32x16 __attribute__((ext_vector_type(16)));
__device__ __forceinline__ int pi32(int i) { return (i & ~12) | ((i & 4) << 1) | ((i & 8) >> 1); }
__device__ __forceinline__ f32x16 zero16() { f32x16 z;
#pragma unroll
    for (int r = 0; r < 16; ++r) z[r] = 0.f;
    return z; }

__device__ __forceinline__ void xattn_phase(LAS unsigned char* lds, const bf16_t* Q, const bf16_t* Kb, const bf16_t* VT, unsigned char* O, int G, int bx, int wave) {
    const int lane = lane_id(), i = lane & 31, hh = lane >> 5;
    LAS unsigned char* ring = lds;
    bf16x8 qf[16];
#define XA_QLOAD(uid_) do { const int u_ = (uid_); const bf16_t* qp_ = Q + (size_t)((u_ >> 5) * SEQ + (u_ & 7) * 256 + wave * 32 + i) * 1024 + ((u_ >> 3) & 3) * 256 + 8 * hh; \
        _Pragma("unroll") for (int ds = 0; ds < 16; ++ds) qf[ds] = *(const bf16x8*)(qp_ + 16 * ds); } while (0)
    if (bx < BATCH * 4 * 8) XA_QLOAD(bx);
    for (int uid = bx; uid < BATCH * 4 * 8; uid += G) {
        const int b = uid >> 5, h = (uid >> 3) & 3, qblk = uid & 7;
        const int q0 = qblk * 256 + wave * 32;
        const bf16_t* ksrc = Kb + (size_t)(b * MEMLEN + pi32(i)) * 1024 + h * 256 + 16 * wave + 8 * hh;
        const bf16_t* vsrc = VT + (size_t)(h * 256 + i) * MROWS + b * MEMLEN + 32 * (wave >> 1) + 16 * (wave & 1) + 8 * hh;
#define XA_ISSUE(st_) do { LAS unsigned char* sl_ = ring + ((st_) & 3) * 16384; \
        if ((st_) < 8) { const bf16_t* g_ = ksrc + (size_t)(st_) * 32 * 1024; \
            __builtin_amdgcn_global_load_lds((const unsigned*)g_, (LAS unsigned*)(sl_ + wave * 1024), 16, 0, 0); \
            __builtin_amdgcn_global_load_lds((const unsigned*)(g_ + 128), (LAS unsigned*)(sl_ + (8 + wave) * 1024), 16, 0, 0); } \
        else { const bf16_t* g_ = vsrc + (size_t)((st_) - 8) * 32 * MROWS; \
            __builtin_amdgcn_global_load_lds((const unsigned*)g_, (LAS unsigned*)(sl_ + wave * 1024), 16, 0, 0); \
            __builtin_amdgcn_global_load_lds((const unsigned*)(g_ + 128), (LAS unsigned*)(sl_ + (8 + wave) * 1024), 16, 0, 0); } } while (0)
#define XA_VMCNT(n) (((n) & 15) | (7 << 4) | (15 << 8) | (((n) >> 4) << 14))
#define XA_SYNC(st_) do { const int n_ = ((st_) >= 11 ? 1 : 0) + ((st_) <= 14 ? 2 : 0) + ((st_) >= 10 ? 1 : 0) + ((st_) <= 13 ? 2 : 0) + ((st_) >= 9 ? 1 : 0) + (((st_) >= 8 && (st_) <= 10) ? 16 : 0); \
          \
        asm volatile("" ::: "memory"); \
        if (n_ == 3) __builtin_amdgcn_s_waitcnt(XA_VMCNT(3)); else if (n_ == 4) __builtin_amdgcn_s_waitcnt(XA_VMCNT(4)); else if (n_ == 5) __builtin_amdgcn_s_waitcnt(XA_VMCNT(5)); \
        else if (n_ == 20) __builtin_amdgcn_s_waitcnt(XA_VMCNT(20)); else if (n_ == 21) __builtin_amdgcn_s_waitcnt(XA_VMCNT(21)); else if (n_ == 22) __builtin_amdgcn_s_waitcnt(XA_VMCNT(22)); \
        else __builtin_amdgcn_s_waitcnt(XA_VMCNT(7)); \
        asm volatile("" ::: "memory"); \
        __builtin_amdgcn_s_barrier(); asm volatile("" ::: "memory"); if ((st_) + 3 < 16) XA_ISSUE((st_) + 3); } while (0)
        XA_ISSUE(0); XA_ISSUE(1); XA_ISSUE(2);
        f32x16 s[8];
#pragma unroll
        for (int kt = 0; kt < 8; ++kt) { XA_SYNC(kt);
            const LAS unsigned char* sl = ring + (kt & 3) * 16384 + lane * 16;
            f32x16 acc = zero16();
#pragma unroll
            for (int q4 = 0; q4 < 4; ++q4) { __builtin_amdgcn_sched_barrier(0);
#pragma unroll
                for (int d4 = 0; d4 < 4; ++d4) { const int ds = q4 * 4 + d4; acc = __builtin_amdgcn_mfma_f32_32x32x16_bf16(*(const LAS bf16x8*)(sl + ds * 1024), qf[ds], acc, 0, 0, 0); } }
            s[kt] = acc; }
        float m = -INFINITY;
#pragma unroll
        for (int kt = 0; kt < 8; ++kt)
#pragma unroll
            for (int r = 0; r < 16; ++r) m = fmaxf(m, s[kt][r]);
        m = x32_max(m);
        const float c = 0.0625f * 1.4426950408889634f; float l = 0.f; const float mc = m * c;
        u32x4 pf[8][2];
#pragma unroll
        for (int kt = 0; kt < 8; ++kt) {
#pragma unroll
            for (int r = 0; r < 16; ++r) { const float p = __builtin_amdgcn_exp2f(s[kt][r] * c - mc); s[kt][r] = p; l += p; }
#pragma unroll
            for (int sb = 0; sb < 2; ++sb) { pf[kt][sb].x = cvt_pk_bf16(s[kt][8 * sb + 0], s[kt][8 * sb + 1]); pf[kt][sb].y = cvt_pk_bf16(s[kt][8 * sb + 2], s[kt][8 * sb + 3]);
                pf[kt][sb].z = cvt_pk_bf16(s[kt][8 * sb + 4], s[kt][8 * sb + 5]); pf[kt][sb].w = cvt_pk_bf16(s[kt][8 * sb + 6], s[kt][8 * sb + 7]); } }
        l = x32_sum(l);
        const float il = 1.0f / l;
        XA_QLOAD(uid + G < BATCH * 4 * 8 ? uid + G : uid);
        unsigned char* op = O + (size_t)(b * SEQ + q0 + i) * 1024 + h * 256 + 16 * hh;
#pragma unroll
        for (int dvt = 0; dvt < 8; ++dvt) { XA_SYNC(8 + dvt);
            const LAS unsigned char* sl = ring + (dvt & 3) * 16384 + lane * 16;
            f32x16 oacc = zero16();
#pragma unroll
            for (int q4 = 0; q4 < 4; ++q4) { __builtin_amdgcn_sched_barrier(0);
#pragma unroll
                for (int f4 = 0; f4 < 4; ++f4) { const int f = q4 * 4 + f4; oacc = __builtin_amdgcn_mfma_f32_32x32x16_bf16(*(const LAS bf16x8*)(sl + f * 1024), __builtin_bit_cast(bf16x8, pf[f >> 1][f & 1]), oacc, 0, 0, 0); } }
            unsigned wg[4];
#pragma unroll
            for (int g = 0; g < 4; ++g) { unsigned w = 0u; w = __builtin_amdgcn_cvt_pk_fp8_f32(c8(oacc[4 * g] * il), c8(oacc[4 * g + 1] * il), w, false); w = __builtin_amdgcn_cvt_pk_fp8_f32(c8(oacc[4 * g + 2] * il), c8(oacc[4 * g + 3] * il), w, true); wg[g] = w; }
            { const auto s02 = __builtin_amdgcn_permlane32_swap(wg[0], wg[2], false, false), s13 = __builtin_amdgcn_permlane32_swap(wg[1], wg[3], false, false);
              *(u32x4*)(op + dvt * 32) = (u32x4){s02[0], s02[1], s13[0], s13[1]}; } }
#undef XA_ISSUE
#undef XA_SYNC
    }
}

__device__ __forceinline__ void diffattn_phase(LAS unsigned char* lds, const bf16_t* P2, const bf16_t* VT, const float* dng, const float lam, bf16_t* cat, int G, int vx, int wave) {
    const int lane = lane_id(), i_ = lane & 31, hh_ = lane >> 5;
    LAS unsigned char* ring = lds;
    LAS unsigned char* ql = lds + 65536 + wave * 8192 + lane * 16;
    const float c = 0.125f * 1.4426950408889634f;
    for (int pu = vx; pu < BATCH * 4 * 4; pu += G)
        for (int side = 0; side < 2; ++side) {
            const int bh = pu >> 2, x = pu & 3, qb = side ? 7 - x : x, b = bh >> 2, h = bh & 3, q0 = qb * 256 + wave * 32;
            const int ntile = 8 * qb + 8, ktw = 8 * qb + wave;
            int i = i_, hh = hh_; asm volatile("" : "+v"(i), "+v"(hh));
            const bf16_t* qp = P2 + (size_t)(b * SEQ + q0 + i) * NP2 + h * 128 + 8 * hh;
            { bf16x8 t[8];
#pragma unroll
              for (int f = 0; f < 8; ++f) t[f] = *(const bf16x8*)(qp + 16 * f);
#pragma unroll
              for (int f = 0; f < 8; ++f) *(LAS bf16x8*)(ql + f * 1024) = t[f]; }
            const char* kbase = (const char*)(P2 + (size_t)b * SEQ * NP2 + 512 + h * 128 + (wave >> 2) * 64 + 16 * (wave & 3));
            const char* vbase = (const char*)(VT + (size_t)(h * 128 + 32 * (wave >> 1)) * T + (size_t)b * SEQ + 16 * (wave & 1));
            const unsigned koff = (unsigned)(pi32(i) * NP2 + 8 * hh) * 2u, voff = (unsigned)(i * T + 8 * hh) * 2u;
#define DA_ISSUE(kt_) do { LAS unsigned char* sl_ = ring + ((kt_) & 3) * 16384; \
        __builtin_amdgcn_global_load_lds((const unsigned*)(kbase + (size_t)(kt_) * (32 * NP2 * 2) + koff), (LAS unsigned*)(sl_ + wave * 1024), 16, 0, 0); \
        __builtin_amdgcn_global_load_lds((const unsigned*)(vbase + (kt_) * 64 + voff), (LAS unsigned*)(sl_ + (8 + wave) * 1024), 16, 0, 0); } while (0)
            f32x16 o1[4], o2[4];
#pragma unroll
            for (int d = 0; d < 4; ++d) { o1[d] = zero16(); o2[d] = zero16(); }
            float mc1 = -INFINITY, mc2 = -INFINITY, l1 = 0.f, l2 = 0.f;
            u32x4 pp1[2], pp2[2];
#pragma unroll
            for (int sb = 0; sb < 2; ++sb) { pp1[sb] = (u32x4){0u, 0u, 0u, 0u}; pp2[sb] = pp1[sb]; }
            DA_ISSUE(0); DA_ISSUE(1);
            for (int kt = 0; kt <= ntile; ++kt) {
                if (kt < ntile) {
                    if (kt + 1 < ntile) asm volatile("s_waitcnt vmcnt(2)" ::: "memory"); else asm volatile("s_waitcnt vmcnt(0)" ::: "memory");
                    __builtin_amdgcn_s_barrier(); asm volatile("" ::: "memory");
                    if (kt + 2 < ntile) DA_ISSUE(kt + 2);
                }
                if (kt <= ktw + 1) {
                    const LAS unsigned char* sl = ring + (kt & 3) * 16384 + lane * 16;
                    const LAS unsigned char* sp = ring + ((kt == 0 ? 0 : kt - 1) & 3) * 16384 + lane * 16;
                    f32x16 s1 = zero16(), s2 = zero16();
#pragma unroll
                    for (int ds = 0; ds < 4; ++ds) { s1 = __builtin_amdgcn_mfma_f32_32x32x16_bf16(*(const LAS bf16x8*)(sl + ds * 1024), *(const LAS bf16x8*)(ql + ds * 1024), s1, 0, 0, 0);
                        s2 = __builtin_amdgcn_mfma_f32_32x32x16_bf16(*(const LAS bf16x8*)(sl + (4 + ds) * 1024), *(const LAS bf16x8*)(ql + (4 + ds) * 1024), s2, 0, 0, 0);
                        if (ds & 1) __builtin_amdgcn_sched_barrier(0); }
                    if (kt >= ktw) { const int lim = (kt == ktw) ? i : -1;
#pragma unroll
                        for (int r = 0; r < 16; ++r) { const int ko = 16 * (r >> 3) + 8 * hh + (r & 7); if (ko > lim) { s1[r] = -INFINITY; s2[r] = -INFINITY; } } }
                    float f1 = 1.f, f2 = 1.f; bool rs1, rs2;
                    { float tm = s1[0];
#pragma unroll
                      for (int r = 1; r < 16; ++r) tm = fmaxf(tm, s1[r]);
                      tm = x32_max(tm); const float tmc = tm * c; rs1 = __any(tmc > mc1 + 8.0f);
                      if (rs1) { const float mn = fmaxf(mc1, tmc); f1 = __builtin_amdgcn_exp2f(mc1 - mn); mc1 = mn; } }
                    { float tm = s2[0];
#pragma unroll
                      for (int r = 1; r < 16; ++r) tm = fmaxf(tm, s2[r]);
                      tm = x32_max(tm); const float tmc = tm * c; rs2 = __any(tmc > mc2 + 8.0f);
                      if (rs2) { const float mn = fmaxf(mc2, tmc); f2 = __builtin_amdgcn_exp2f(mc2 - mn); mc2 = mn; } }
                    float ls1 = 0.f, ls2 = 0.f; u32x4 pn1[2], pn2[2];
#define DA_SM(j) do { { const float pv_ = __builtin_amdgcn_exp2f(s1[j] * c - mc1); s1[j] = pv_; ls1 += pv_; } { const float pv_ = __builtin_amdgcn_exp2f(s2[j] * c - mc2); s2[j] = pv_; ls2 += pv_; } \
                        if ((j) & 1) { pn1[(j) >> 3][((j) & 7) >> 1] = cvt_pk_bf16(s1[(j) - 1], s1[j]); pn2[(j) >> 3][((j) & 7) >> 1] = cvt_pk_bf16(s2[(j) - 1], s2[j]); } } while (0)
                    { bf16x8 va, vb;
#define DA_VLD(p) (*(const LAS bf16x8*)(sp + (8 + ((p) & 3) * 2 + ((p) >> 2)) * 1024))
#define DA_SLOT(j, VF, LDNEXT) do { if ((j) & 1) o2[((j) >> 1) & 3] = __builtin_amdgcn_mfma_f32_32x32x16_bf16(VF, __builtin_bit_cast(bf16x8, pp2[(j) >> 3]), o2[((j) >> 1) & 3], 0, 0, 0); \
                            else o1[((j) >> 1) & 3] = __builtin_amdgcn_mfma_f32_32x32x16_bf16(VF, __builtin_bit_cast(bf16x8, pp1[(j) >> 3]), o1[((j) >> 1) & 3], 0, 0, 0); \
                            LDNEXT; DA_SM(j); __builtin_amdgcn_sched_barrier(0); } while (0)
                      va = DA_VLD(0);
                      __builtin_amdgcn_sched_barrier(0);
                      DA_SLOT(0, va, vb = DA_VLD(1)); DA_SLOT(1, va, (void)0); DA_SLOT(2, vb, va = DA_VLD(2)); DA_SLOT(3, vb, (void)0);
                      DA_SLOT(4, va, vb = DA_VLD(3)); DA_SLOT(5, va, (void)0); DA_SLOT(6, vb, va = DA_VLD(4)); DA_SLOT(7, vb, (void)0);
                      DA_SLOT(8, va, vb = DA_VLD(5)); DA_SLOT(9, va, (void)0); DA_SLOT(10, vb, va = DA_VLD(6)); DA_SLOT(11, vb, (void)0);
                      DA_SLOT(12, va, vb = DA_VLD(7)); DA_SLOT(13, va, (void)0); DA_SLOT(14, vb, (void)0); DA_SLOT(15, vb, (void)0);
#undef DA_VLD
#undef DA_SLOT
                    }
#undef DA_SM
                    l1 = l1 * f1 + ls1; l2 = l2 * f2 + ls2;
                    if (rs1) {
#pragma unroll
                        for (int d = 0; d < 4; ++d)
#pragma unroll
                            for (int r = 0; r < 16; ++r) o1[d][r] *= f1; }
                    if (rs2) {
#pragma unroll
                        for (int d = 0; d < 4; ++d)
#pragma unroll
                            for (int r = 0; r < 16; ++r) o2[d][r] *= f2; }
#pragma unroll
                    for (int sb = 0; sb < 2; ++sb) { pp1[sb] = pn1[sb]; pp2[sb] = pn2[sb]; }
                }
            }
#undef DA_ISSUE
            l1 = x32_sum(l1); l2 = x32_sum(l2);
            int ie = i, he = hh; asm volatile("" : "+v"(ie), "+v"(he));
            const float i1 = 1.0f / l1, i2 = lam / l2; float ss = 0.f;
#pragma unroll
            for (int d = 0; d < 4; ++d)
#pragma unroll
                for (int r = 0; r < 16; ++r) { const float o = o1[d][r] * i1 - o2[d][r] * i2; o1[d][r] = o; ss += o * o; }
            ss = x32_sum(ss);
            const float rn = rsqrtf(ss * (1.0f / 128.0f) + EPS) * (1.0f - LAMBDA_INIT);
            bf16_t* op = cat + (size_t)(b * SEQ + q0 + ie) * DM + h * 128 + 8 * he;
            const float* gp = dng + h * 128 + 4 * he;
#pragma unroll
            for (int d = 0; d < 4; ++d)
#pragma unroll
                for (int g2 = 0; g2 < 2; ++g2) { u32x2 w[2];
#pragma unroll
                    for (int q = 0; q < 2; ++q) { const int g = 2 * g2 + q; const f32x4 gv = *(const f32x4*)(gp + d * 32 + 8 * g);
                        w[q].x = cvt_pk_bf16(o1[d][4 * g] * rn * gv[0], o1[d][4 * g + 1] * rn * gv[1]); w[q].y = cvt_pk_bf16(o1[d][4 * g + 2] * rn * gv[2], o1[d][4 * g + 3] * rn * gv[3]); }
                    const auto sa = __builtin_amdgcn_permlane32_swap(w[0].x, w[1].x, false, false), sb = __builtin_amdgcn_permlane32_swap(w[0].y, w[1].y, false, false);
                    *(u32x4*)(op + d * 32 + 16 * g2) = (u32x4){sa[0], sb[0], sa[1], sb[1]}; }
        }
}

__device__ __forceinline__ void mlstm_prep_phase(LAS unsigned char* lds, const bf16_t* P2, const bf16_t* VT, const float* gates, const float* conv_w, const float* conv_b,
                                                 bf16_t* QM, bf16_t* KM, float* BC, float* AV, float* AM, float* CH, float* NLOC, float* CLOC, int G, int vx, int wave) {
    const int lane = lane_id(), i = lane & 31, hh = lane >> 5;
    LAS unsigned char* kl = lds + wave * 16384;
    for (int task = vx * 8 + wave; task < BATCH * 4 * 16; task += G * 8) {
        const int bh = task >> 4, c = task & 15, b = bh >> 2, h = bh & 3;
        const int t0 = b * SEQ + c * 128, tA = t0 + 2 * lane;
        const float lf0 = gates[(size_t)tA * 8 + 4 + h], lf1 = gates[(size_t)(tA + 1) * 8 + 4 + h], ig0 = gates[(size_t)tA * 8 + h], ig1 = gates[(size_t)(tA + 1) * 8 + h];
        float incl = lf0 + lf1;
#pragma unroll
        for (int off = 1; off < 64; off <<= 1) { const float v = __shfl_up(incl, off); if (lane >= off) incl += v; }
        const float bc1 = incl, bc0 = incl - lf1, blast = __shfl(incl, 63);
        const float a0 = ig0 - bc0, a1 = ig1 - bc1;
        float pm = fmaxf(a0, a1);
#pragma unroll
        for (int off = 1; off < 64; off <<= 1) { const float v = __shfl_up(pm, off); if (lane >= off) pm = fmaxf(pm, v); }
        const float pmprev = __shfl_up(pm, 1);
        const float am1 = pm, am0 = (lane > 0) ? fmaxf(pmprev, a0) : a0, amall = __shfl(pm, 63);
        const float ws0 = __expf(a0 - amall), ws1 = __expf(a1 - amall);
        *(f32x2*)(BC + (size_t)h * T + tA) = (f32x2){bc0, bc1};
        *(f32x2*)(AV + (size_t)h * T + tA) = (f32x2){a0, a1};
        *(f32x2*)(AM + (size_t)h * T + tA) = (f32x2){am0, am1};
        if (lane == 0) { CH[task * 2] = blast; CH[task * 2 + 1] = blast + amall; }
        {
            const int r8 = lane >> 3, cg = lane & 7;
            float cw[2][5][8];
#pragma unroll
            for (int part = 0; part < 2; ++part) { const int ch0 = (part ? 256 : 0) + h * 64 + 8 * cg;
#pragma unroll
                for (int k = 0; k < 4; ++k) { const f32x4 a = *(const f32x4*)(conv_w + k * 512 + ch0), bq = *(const f32x4*)(conv_w + k * 512 + ch0 + 4);
#pragma unroll
                    for (int j = 0; j < 4; ++j) { cw[part][k][j] = a[j]; cw[part][k][4 + j] = bq[j]; } }
                { const f32x4 a = *(const f32x4*)(conv_b + ch0), bq = *(const f32x4*)(conv_b + ch0 + 4);
#pragma unroll
                    for (int j = 0; j < 4; ++j) { cw[part][4][j] = a[j]; cw[part][4][4 + j] = bq[j]; } } }
#pragma unroll 4
            for (int jb = 0; jb < 16; ++jb) {
                const int p = 8 * jb + r8, tg = t0 + p, tseq = c * 128 + p;
                const float wa = __shfl(ws0, p >> 1), wb = __shfl(ws1, p >> 1); const float wsp = (p & 1) ? wb : wa;
                u32x4 uw[2][4];
#pragma unroll
                for (int part = 0; part < 2; ++part)
#pragma unroll
                    for (int k = 0; k < 4; ++k) { uw[part][k] = (u32x4){0u, 0u, 0u, 0u};
                        if (tseq - 3 + k >= 0) uw[part][k] = *(const u32x4*)(P2 + (size_t)(tg - 3 + k) * NP2 + 1024 + (part ? 256 : 0) + h * 64 + 8 * cg); }
#pragma unroll
                for (int part = 0; part < 2; ++part) { float y[8];
#pragma unroll
                    for (int j = 0; j < 8; ++j) { float pj = cw[part][4][j];
#pragma unroll
                        for (int k = 0; k < 4; ++k) { const unsigned wv = (j < 2) ? uw[part][k].x : (j < 4) ? uw[part][k].y : (j < 6) ? uw[part][k].z : uw[part][k].w; pj += cw[part][k][j] * ((j & 1) ? hi_bf(wv) : lo_bf(wv)); }
                        y[j] = pj * __builtin_amdgcn_rcpf(1.0f + __expf(-pj)); }
                    if (part == 0) { u32x4 w; w.x = cvt_pk_bf16(y[0] * 0.125f, y[1] * 0.125f); w.y = cvt_pk_bf16(y[2] * 0.125f, y[3] * 0.125f); w.z = cvt_pk_bf16(y[4] * 0.125f, y[5] * 0.125f); w.w = cvt_pk_bf16(y[6] * 0.125f, y[7] * 0.125f);
                        *(u32x4*)(QM + (size_t)tg * 256 + h * 64 + 8 * cg) = w; }
                    else { u32x4 w; w.x = cvt_pk_bf16(y[0], y[1]); w.y = cvt_pk_bf16(y[2], y[3]); w.z = cvt_pk_bf16(y[4], y[5]); w.w = cvt_pk_bf16(y[6], y[7]);
                        *(u32x4*)(KM + (size_t)tg * 256 + h * 64 + 8 * cg) = w;
#pragma unroll
                        for (int j = 0; j < 8; ++j) { const int d = 8 * cg + j;
                            *(LAS unsigned short*)(kl + d * 256 + ((jb ^ (d & 15)) * 16) + r8 * 2) = (unsigned short)f2bf(y[j] * wsp); } } }
            }
        }
        { float ns = 0.f;
#pragma unroll
          for (int cq = 0; cq < 16; ++cq) { const u32x4 w = *(const LAS u32x4*)(kl + lane * 256 + ((cq ^ (lane & 15)) * 16));
              ns += (lo_bf(w.x) + hi_bf(w.x)) + (lo_bf(w.y) + hi_bf(w.y)) + (lo_bf(w.z) + hi_bf(w.z)) + (lo_bf(w.w) + hi_bf(w.w)); }
          NLOC[(size_t)task * 64 + lane] = ns; }
        f32x16 acc[4][2];
#pragma unroll
        for (int et = 0; et < 4; ++et) { acc[et][0] = zero16(); acc[et][1] = zero16(); }
        const bf16_t* vp = VT + (size_t)(512 + h * 128 + i) * T + t0 + 8 * hh;
#pragma unroll
        for (int k2 = 0; k2 < 8; k2 += 2) {
            bf16x8 af[2][4];
#pragma unroll
            for (int q = 0; q < 2; ++q)
#pragma unroll
                for (int et = 0; et < 4; ++et) af[q][et] = *(const bf16x8*)(vp + (size_t)et * 32 * T + 16 * (k2 + q));
            __builtin_amdgcn_sched_barrier(0);
#pragma unroll
            for (int q = 0; q < 2; ++q) { const int ks = k2 + q; bf16x8 bfr[2];
#pragma unroll
                for (int dt = 0; dt < 2; ++dt) { const int d = 32 * dt + i; bfr[dt] = *(const LAS bf16x8*)(kl + d * 256 + (((2 * ks + hh) ^ (d & 15)) * 16)); }
#pragma unroll
                for (int et = 0; et < 4; ++et) {
                    acc[et][0] = __builtin_amdgcn_mfma_f32_32x32x16_bf16(af[q][et], bfr[0], acc[et][0], 0, 0, 0); acc[et][1] = __builtin_amdgcn_mfma_f32_32x32x16_bf16(af[q][et], bfr[1], acc[et][1], 0, 0, 0); } }
            __builtin_amdgcn_sched_barrier(0);
        }
        float* cp = CLOC + (size_t)task * 8192 + i + 256 * hh;
#pragma unroll
        for (int et = 0; et < 4; ++et)
#pragma unroll
            for (int dt = 0; dt < 2; ++dt)
#pragma unroll
                for (int r = 0; r < 16; ++r) cp[(32 * et + (r & 3) + 8 * (r >> 2)) * 64 + 32 * dt] = acc[et][dt][r];
    }
}
__device__ __forceinline__ void mlstm_scan_phase(const float* CLOC, const float* NLOC, const float* CH, bf16_t* CSTB, float* NST, float* MSTATE, int G, int bx, int tid) {
    for (int idx = bx * 512 + tid; idx < BATCH * 4 * 1024; idx += G * 512) {
        const int bh = idx >> 10, rem = idx & 1023, e = rem >> 3, d0 = (rem & 7) * 8;
        float C[8], nr[8]; float m = 0.f;
#pragma unroll
        for (int j = 0; j < 8; ++j) { C[j] = 0.f; nr[j] = 0.f; }
#pragma unroll 1
        for (int c8 = 0; c8 < 16; c8 += 8) {
            f32x4 cl[8][2], nl[8][2]; float bl[8], ml[8];
#pragma unroll
            for (int q = 0; q < 8; ++q) { const int task = bh * 16 + c8 + q;
                cl[q][0] = *(const f32x4*)(CLOC + (size_t)task * 8192 + e * 64 + d0); cl[q][1] = *(const f32x4*)(CLOC + (size_t)task * 8192 + e * 64 + d0 + 4);
                bl[q] = CH[task * 2]; ml[q] = CH[task * 2 + 1];
                if (rem < 8) { nl[q][0] = *(const f32x4*)(NLOC + (size_t)task * 64 + rem * 8); nl[q][1] = *(const f32x4*)(NLOC + (size_t)task * 64 + rem * 8 + 4); }
                else { nl[q][0] = (f32x4){0.f, 0.f, 0.f, 0.f}; nl[q][1] = nl[q][0]; } }
#pragma unroll
            for (int q = 0; q < 8; ++q) { const int task = bh * 16 + c8 + q;
                u32x4 w; w.x = cvt_pk_bf16(C[0], C[1]); w.y = cvt_pk_bf16(C[2], C[3]); w.z = cvt_pk_bf16(C[4], C[5]); w.w = cvt_pk_bf16(C[6], C[7]);
                *(u32x4*)(CSTB + (size_t)task * 8192 + e * 64 + d0) = w;
                if (rem < 8) { *(f32x4*)(NST + (size_t)task * 64 + rem * 8) = (f32x4){nr[0], nr[1], nr[2], nr[3]}; *(f32x4*)(NST + (size_t)task * 64 + rem * 8 + 4) = (f32x4){nr[4], nr[5], nr[6], nr[7]}; }
                if (rem == 0) MSTATE[task] = m;
                const float mn = fmaxf(bl[q] + m, ml[q]), a = __expf(bl[q] + m - mn), bco = __expf(ml[q] - mn);
#pragma unroll
                for (int j = 0; j < 4; ++j) { C[j] = a * C[j] + bco * cl[q][0][j]; C[4 + j] = a * C[4 + j] + bco * cl[q][1][j]; nr[j] = a * nr[j] + bco * nl[q][0][j]; nr[4 + j] = a * nr[4 + j] + bco * nl[q][1][j]; }
                m = mn; }
        }
    }
}
__device__ __forceinline__ void mlstm_out_phase(LAS unsigned char* lds, const bf16_t* P2, const bf16_t* VT, const bf16_t* QM, const bf16_t* KM, const float* BC, const float* AV, const float* AM,
                                                const bf16_t* CSTB, const float* NST, const float* MSTATE, const float* mng, bf16_t* cat, int G, int vx, int wave) {
    const int lane_ = lane_id();
    const int cw = wave >> 2, tq = wave & 3;
    LAS unsigned char* reg = lds + cw * 65536;
    for (int un = vx; un < BATCH * 4 * 8; un += G) {
        int lane = lane_; asm volatile("" : "+v"(lane));
        const int i = lane & 31, hh = lane >> 5;
        const int task = 2 * un + cw, bh = task >> 4, c = task & 15, b = bh >> 2, h = bh & 3;
        const int t0 = b * SEQ + c * 128;
        { const bf16_t* ks = KM + (size_t)(t0 + 32 * tq + pi32(i)) * 256 + h * 64 + 8 * hh;
          const bf16_t* cs = CSTB + (size_t)task * 8192 + (32 * tq + i) * 64 + 8 * hh;
          const bf16_t* vs = VT + (size_t)(512 + h * 128 + 32 * tq + i) * T + t0 + 8 * hh;
#pragma unroll
          for (int ds = 0; ds < 4; ++ds) { __builtin_amdgcn_global_load_lds((const unsigned*)(ks + 16 * ds), (LAS unsigned*)(reg + (tq * 4 + ds) * 1024), 16, 0, 0);
              __builtin_amdgcn_global_load_lds((const unsigned*)(cs + 16 * ds), (LAS unsigned*)(reg + 16384 + (tq * 4 + ds) * 1024), 16, 0, 0); }
#pragma unroll
          for (int k8 = 0; k8 < 8; ++k8) __builtin_amdgcn_global_load_lds((const unsigned*)(vs + 16 * k8), (LAS unsigned*)(reg + 32768 + (tq * 8 + k8) * 1024), 16, 0, 0); }
        const float m_c = MSTATE[task];
        const int tg = t0 + 32 * tq + i;
        const float bct = BC[(size_t)h * T + tg], amt = AM[(size_t)h * T + tg];
        bf16x8 qf[4];
#pragma unroll
        for (int ds = 0; ds < 4; ++ds) qf[ds] = *(const bf16x8*)(QM + (size_t)tg * 256 + h * 64 + 16 * ds + 8 * hh);
        float qn = 0.f;
#pragma unroll
        for (int ds = 0; ds < 4; ++ds) { const f32x4 n0 = *(const f32x4*)(NST + (size_t)task * 64 + 16 * ds + 8 * hh), n1 = *(const f32x4*)(NST + (size_t)task * 64 + 16 * ds + 8 * hh + 4);
            const u32x4 w = __builtin_bit_cast(u32x4, qf[ds]);
            qn += lo_bf(w.x) * n0[0] + hi_bf(w.x) * n0[1] + lo_bf(w.y) * n0[2] + hi_bf(w.y) * n0[3] + lo_bf(w.z) * n1[0] + hi_bf(w.z) * n1[1] + lo_bf(w.w) * n1[2] + hi_bf(w.w) * n1[3]; }
        qn = x32_sum(qn);
        const float M = fmaxf(m_c, amt), g = __expf(m_c - M), emt = __expf(-(bct + M));
        const bf16_t* mop = P2 + (size_t)tg * NP2 + 1536 + h * 128 + 4 * hh;
        u32x2 mov[4][4];
#pragma unroll
        for (int et = 0; et < 4; ++et)
#pragma unroll
            for (int g4 = 0; g4 < 4; ++g4) mov[et][g4] = *(const u32x2*)(mop + et * 32 + 8 * g4);
        asm volatile("s_waitcnt vmcnt(0)" ::: "memory"); __builtin_amdgcn_s_barrier(); asm volatile("" ::: "memory");
        const LAS unsigned char* rl = reg + lane * 16;
        f32x16 acc[4];
#pragma unroll
        for (int et = 0; et < 4; ++et) { acc[et] = zero16();
#pragma unroll
            for (int ds = 0; ds < 4; ++ds) acc[et] = __builtin_amdgcn_mfma_f32_32x32x16_bf16(*(const LAS bf16x8*)(rl + 16384 + (et * 4 + ds) * 1024), qf[ds], acc[et], 0, 0, 0);
#pragma unroll
            for (int r = 0; r < 16; ++r) acc[et][r] *= g; }
        float wsum = 0.f;
        for (int kt = 0; kt <= tq; ++kt) {
            f32x16 sc = zero16();
#pragma unroll
            for (int ds = 0; ds < 4; ++ds) sc = __builtin_amdgcn_mfma_f32_32x32x16_bf16(*(const LAS bf16x8*)(rl + (kt * 4 + ds) * 1024), qf[ds], sc, 0, 0, 0);
            const float* ap = AV + (size_t)h * T + t0 + 32 * kt + 8 * hh;
            const f32x4 a00 = *(const f32x4*)(ap), a01 = *(const f32x4*)(ap + 4), a10 = *(const f32x4*)(ap + 16), a11 = *(const f32x4*)(ap + 20);
#pragma unroll
            for (int r = 0; r < 16; ++r) { const float av = (r < 4) ? a00[r & 3] : (r < 8) ? a01[r & 3] : (r < 12) ? a10[r & 3] : a11[r & 3];
                const int ko = 16 * (r >> 3) + 8 * hh + (r & 7);
                float w = sc[r] * __expf(av - M);
                w = (kt == tq && ko > i) ? 0.f : w;
                sc[r] = w; wsum += w; }
            u32x4 wf[2];
#pragma unroll
            for (int sb = 0; sb < 2; ++sb) { wf[sb].x = cvt_pk_bf16(sc[8 * sb + 0], sc[8 * sb + 1]); wf[sb].y = cvt_pk_bf16(sc[8 * sb + 2], sc[8 * sb + 3]); wf[sb].z = cvt_pk_bf16(sc[8 * sb + 4], sc[8 * sb + 5]); wf[sb].w = cvt_pk_bf16(sc[8 * sb + 6], sc[8 * sb + 7]); }
#pragma unroll
            for (int et = 0; et < 4; ++et)
#pragma unroll
                for (int sb = 0; sb < 2; ++sb) acc[et] = __builtin_amdgcn_mfma_f32_32x32x16_bf16(*(const LAS bf16x8*)(rl + 32768 + (et * 8 + 2 * kt + sb) * 1024), __builtin_bit_cast(bf16x8, wf[sb]), acc[et], 0, 0, 0);
        }
        wsum = x32_sum(wsum);
        const float den = g * qn + wsum, idd = 1.0f / fmaxf(fabsf(den), emt);
        float ss = 0.f;
#pragma unroll
        for (int et = 0; et < 4; ++et)
#pragma unroll
            for (int r = 0; r < 16; ++r) { const float hv = acc[et][r] * idd; acc[et][r] = hv; ss += hv * hv; }
        ss = x32_sum(ss);
        const float rn = rsqrtf(ss * (1.0f / 128.0f) + EPS);
        bf16_t* op = cat + (size_t)tg * DM + 512 + h * 128 + 8 * hh;
        const float* gp = mng + h * 128 + 4 * hh;
#pragma unroll
        for (int et = 0; et < 4; ++et)
#pragma unroll
            for (int gq = 0; gq < 2; ++gq) { u32x2 w[2];
#pragma unroll
                for (int q = 0; q < 2; ++q) { const int g4 = 2 * gq + q; const f32x4 gv = *(const f32x4*)(gp + et * 32 + 8 * g4); const u32x2 mo = mov[et][g4];
                    const float o0 = lo_bf(mo.x), o1 = hi_bf(mo.x), o2 = lo_bf(mo.y), o3 = hi_bf(mo.y);
                    const float y0 = acc[et][4 * g4] * rn * gv[0] * __builtin_amdgcn_rcpf(1.0f + __expf(-o0)), y1 = acc[et][4 * g4 + 1] * rn * gv[1] * __builtin_amdgcn_rcpf(1.0f + __expf(-o1));
                    const float y2 = acc[et][4 * g4 + 2] * rn * gv[2] * __builtin_amdgcn_rcpf(1.0f + __expf(-o2)), y3 = acc[et][4 * g4 + 3] * rn * gv[3] * __builtin_amdgcn_rcpf(1.0f + __expf(-o3));
                    w[q].x = cvt_pk_bf16(y0, y1); w[q].y = cvt_pk_bf16(y2, y3); }
                const auto sa = __builtin_amdgcn_permlane32_swap(w[0].x, w[1].x, false, false), sb = __builtin_amdgcn_permlane32_swap(w[0].y, w[1].y, false, false);
                *(u32x4*)(op + et * 32 + 16 * gq) = (u32x4){sa[0], sb[0], sa[1], sb[1]}; }
        asm volatile("s_waitcnt lgkmcnt(0)" ::: "memory"); __builtin_amdgcn_s_barrier(); asm volatile("" ::: "memory");
    }
}

constexpr int NWAVES = 8;
constexpr int RING_BYTES = 131072;
constexpr int LDSCTL_OFF = RING_BYTES;
constexpr int LDS_BYTES = RING_BYTES + 5120;

enum Phase { PH_PREP = 0, PH_INPROJ = 1, PH_MIX0 = 2, PH_MIX1 = 3, PH_MIX2 = 4, PH_OUTPROJ = 5, PH_QKV = 6, PH_XATTN = 7, PH_COPROJ = 8, PH_ROUTER = 9, PH_G1 = 10, PH_G2 = 11, PH_COMBINE = 12, PH_END = 13 };

struct Args { const float* in[28]; float* out; unsigned char* ws; int ph_lo, ph_hi, pass_lo, pass_hi; };

struct CJob { const float* src; const float* g; unsigned char* dst; int Nsrc, k0, n0, mode, f8; float scale; };
__device__ __forceinline__ void conv_load(const CJob& j, f32x4 (&v)[2], int tid) {
    const int kk = tid >> 4, c4 = (tid & 15) * 4;
#pragma unroll
    for (int rep = 0; rep < 2; ++rep) v[rep] = *(const f32x4*)(j.src + (size_t)(j.k0 + kk + 32 * rep) * j.Nsrc + j.n0 + c4);
}
__device__ __forceinline__ void conv_put(LAS float* tile, const f32x4 (&v)[2], int tid) {
    const int kk = tid >> 4, c4 = (tid & 15) * 4;
#pragma unroll
    for (int rep = 0; rep < 2; ++rep)
#pragma unroll
        for (int q = 0; q < 4; ++q) tile[(kk + 32 * rep) * 65 + c4 + q] = v[rep][q];
}
__device__ __forceinline__ void conv_store(const LAS float* tile, const CJob& j, int tid) {
    const int n = tid >> 3, kc = tid & 7; float vals[8];
    f32x4 g0 = (f32x4){1.f, 1.f, 1.f, 1.f}, g1 = g0;
    if (j.g) { g0 = *(const f32x4*)(j.g + j.k0 + 8 * kc); g1 = *(const f32x4*)(j.g + j.k0 + 8 * kc + 4); }
#pragma unroll
    for (int q = 0; q < 8; ++q) vals[q] = tile[(8 * kc + q) * 65 + n] * (q < 4 ? g0[q & 3] : g1[q & 3]) * j.scale;
    const int sc = j.n0 + n; int drow = sc;
    if (j.mode == 1) { const int jj = sc >> 1, s = sc & 1; drow = 256 * (jj >> 7) + 128 * s + (jj & 127); }
    if (j.mode == 2) { drow = sc < 1024 ? sc : sc < 1536 ? sc + 1024 : sc < 2048 ? sc - 512 : sc < 2560 ? sc + 512 : sc - 1024; }
    if (j.f8) { unsigned w0 = 0u, w1 = 0u;
        w0 = __builtin_amdgcn_cvt_pk_fp8_f32(c8(vals[0]), c8(vals[1]), w0, false); w0 = __builtin_amdgcn_cvt_pk_fp8_f32(c8(vals[2]), c8(vals[3]), w0, true);
        w1 = __builtin_amdgcn_cvt_pk_fp8_f32(c8(vals[4]), c8(vals[5]), w1, false); w1 = __builtin_amdgcn_cvt_pk_fp8_f32(c8(vals[6]), c8(vals[7]), w1, true);
        *(u32x2*)(j.dst + (size_t)drow * 1024 + j.k0 + 8 * kc) = (u32x2){w0, w1}; }
    else { u32x4 w; w.x = cvt_pk_bf16(vals[0], vals[1]); w.y = cvt_pk_bf16(vals[2], vals[3]); w.z = cvt_pk_bf16(vals[4], vals[5]); w.w = cvt_pk_bf16(vals[6], vals[7]);
        *(u32x4*)(j.dst + ((size_t)drow * 1024 + j.k0 + 8 * kc) * 2) = w; }
}

__global__ void __launch_bounds__(NWAVES * 64, 2) fwd(Args args) {
    extern __shared__ __attribute__((aligned(16))) unsigned char lds_raw[];
    LAS unsigned char* lds = (LAS unsigned char*)lds_raw;
    volatile LAS unsigned* LCTL = (volatile LAS unsigned*)(lds + LDSCTL_OFF);
    const int wave = __builtin_amdgcn_readfirstlane(threadIdx.x >> 6);
#define lane lane_id()
#define tid (wave * 64 + lane_id())
    const int G = gridDim.x, bx = blockIdx.x;
    unsigned char* ws = args.ws;
    unsigned* ctl = (unsigned*)(ws + WS_CTL);
    const int lo = args.ph_lo, hi = args.ph_hi;
#ifndef PHMASK
#define PHMASK 0xffffff
#endif
#ifndef DUPMASK
#define DUPMASK 0x0
#endif
#define IN(k) (((PHMASK >> (k)) & 1) && lo <= (k) && (k) < hi)
#define NREP(k) ((((DUPMASK) >> (k)) & 1) ? 2 : 1)
#define ENDBAR(k) (BOTH(k) || (((DUPMASK) >> (k)) & 1))
#define BOTH(k) (IN(k) && IN((k) + 1))
    for (int u = tid; u < (LDS_BYTES - LDSCTL_OFF) / 4; u += NWAVES * 64) LCTL[u] = 0u;
    __syncthreads();
    XcdBarrier bar; bar.bar = ctl + CW_BAR; bar.x = 0; bar.st = LCTL; bar.wave = wave;
    const bool multi = (hi - lo) > 1 || (args.pass_hi - args.pass_lo) > 1 || (IN(PH_G1) && IN(PH_G2));
    if (multi) bar = xcd_barrier_post(ctl + CW_BAR, LCTL, wave);
#define GRID_BAR() xcd_barrier(bar)

    const float* x = args.in[0]; const float* mem = args.in[1];
    bf16_t* XB = (bf16_t*)(ws + WS_XB); bf16_t* PROJ = (bf16_t*)(ws + WS_PROJ); bf16_t* CAT = (bf16_t*)(ws + WS_CAT);
    bf16_t* MEMB = (bf16_t*)(ws + WS_MEMB); bf16_t* KV = (bf16_t*)(ws + WS_KV); bf16_t* VT2 = (bf16_t*)(ws + WS_VT2); bf16_t* VT1 = (bf16_t*)(ws + WS_VT1); unsigned char* H1F = ws + WS_H1F;
    bf16_t* WIN = (bf16_t*)(ws + WS_WIN); bf16_t* WOUT = (bf16_t*)(ws + WS_WOUT); bf16_t* WCQ = (bf16_t*)(ws + WS_WCQ); bf16_t* WCKV = (bf16_t*)(ws + WS_WCKV);
    bf16_t* WCO = (bf16_t*)(ws + WS_WCO); bf16_t* WR = (bf16_t*)(ws + WS_WR); unsigned char* W1F = ws + WS_W1; unsigned char* W2F = ws + WS_W2; unsigned char* H2F = ws + WS_H2F;
    float* RSTDX = (float*)(ws + WS_RSTDX); float* RSTDM = (float*)(ws + WS_RSTDM); float* B1P = (float*)(ws + WS_B1P); float* MISC = (float*)(ws + WS_MISC); float* RSTD2 = (float*)(ws + WS_RSTD2);
    float* SSP1 = (float*)(ws + WS_SSP1); float* SSP2 = (float*)(ws + WS_SSP2); float* GATES = (float*)(ws + WS_GATES);
    unsigned* TOKMAP = (unsigned*)(ws + WS_TOKMAP); float* GATEV = (float*)(ws + WS_GATEV); unsigned* LIST = (unsigned*)(ws + WS_LIST);
    unsigned char* YB = ws + WS_Y; unsigned char* HID = ws + WS_HID;

    if (IN(PH_PREP)) for (int rep_ = 0; rep_ < NREP(PH_PREP); ++rep_) {
        constexpr int J0 = 768, J1 = J0 + 256, J2 = J1 + 256, J3 = J2 + 512, J4 = J3 + 256, J5 = J4 + 16384, J6 = J5 + 8192;
        auto decode = [&](int it, CJob& j) {
            if (it < J0) { j = CJob{args.in[3], args.in[2], (unsigned char*)WIN, DIN, (it / 48) * 64, (it % 48) * 64, 2, 0, 1.0f}; }
            else if (it < J1) { const int r = it - J0; j = CJob{args.in[14], nullptr, (unsigned char*)WOUT, 1024, (r / 16) * 64, (r % 16) * 64, 0, 0, 1.0f}; }
            else if (it < J2) { const int r = it - J1; j = CJob{args.in[17], args.in[15], (unsigned char*)WCQ, 1024, (r / 16) * 64, (r % 16) * 64, 0, 1, 64.0f}; }
            else if (it < J3) { const int r = it - J2; j = CJob{args.in[18], args.in[16], (unsigned char*)WCKV, 2048, (r / 32) * 64, (r % 32) * 64, 0, 1, 64.0f}; }
            else if (it < J4) { const int r = it - J3; j = CJob{args.in[19], nullptr, (unsigned char*)WCO, 1024, (r / 16) * 64, (r % 16) * 64, 0, 1, 64.0f}; }
            else if (it < J5) { const int r = it - J4; const int e = r >> 9, q = r & 511; j = CJob{args.in[23] + (size_t)e * 1024 * 2048, args.in[20], W1F + (size_t)e * 2048 * 1024, 2048, (q / 32) * 64, (q % 32) * 64, 1, 1, 64.0f}; }
            else { const int r = it - J5; const int e = r >> 8, q = r & 255; j = CJob{args.in[25] + (size_t)e * 1024 * 1024, nullptr, W2F + (size_t)e * 1024 * 1024, 1024, (q / 16) * 64, (q % 16) * 64, 0, 1, 64.0f}; } };
        static_assert(J0 % 4 == 0 && J1 % 4 == 0 && J2 % 4 == 0 && J3 % 4 == 0 && J4 % 4 == 0 && J5 % 4 == 0 && J6 % 4 == 0, "rounds of four jobs");
#define LDS_BAR() do { asm volatile("s_waitcnt lgkmcnt(0)" ::: "memory"); __builtin_amdgcn_s_barrier(); asm volatile("" ::: "memory"); } while (0)
        { f32x4 v[8]; int it0 = bx * 4; CJob jc;
          if (it0 < J6) { decode(it0, jc);
#pragma unroll
              for (int r = 0; r < 8; ++r) v[r] = *(const f32x4*)(jc.src + (size_t)(jc.k0 + wave * 8 + r) * jc.Nsrc + jc.n0 + 4 * lane); }
          for (; it0 < J6; it0 += G * 4) {
            { LAS float* tq = (LAS float*)lds + (lane >> 4) * (64 * 65) + ((4 * lane) & 63) + (wave * 8) * 65;
#pragma unroll
              for (int r = 0; r < 8; ++r)
#pragma unroll
                  for (int q = 0; q < 4; ++q) tq[r * 65 + q] = v[r][q]; }
            LDS_BAR();
            CJob js = jc; const int nx = it0 + G * 4;
            if (nx < J6) { decode(nx, jc);
#pragma unroll
                for (int r = 0; r < 8; ++r) v[r] = *(const f32x4*)(jc.src + (size_t)(jc.k0 + wave * 8 + r) * jc.Nsrc + jc.n0 + 4 * lane); }
#pragma unroll
            for (int q = 0; q < 4; ++q) { conv_store((const LAS float*)lds + q * (64 * 65), js, tid); js.n0 += 64; }
            LDS_BAR();
          } }
        __syncthreads();
        for (int i = bx * 512 + tid; i < NEXP * 1024; i += G * 512) { const int e = i >> 10, k = i & 1023; WR[i] = (bf16_t)f2bf(args.in[21][k * NEXP + e] * args.in[20][k]); }
        for (int i = bx * 512 + tid; i < NEXP * 2048; i += G * 512) { const int e = i >> 11, rho = i & 2047; const int pn = rho >> 8, s = (rho >> 7) & 1, ii = rho & 127; B1P[i] = args.in[24][e * 2048 + 2 * (128 * pn + ii) + s]; }
        if (bx == 0 && wave == 0) { const float a = wave_sum(args.in[9][lane] * args.in[10][lane]), b = wave_sum(args.in[11][lane] * args.in[12][lane]);
            if (lane == 0) MISC[0] = expf(a) - expf(b) + LAMBDA_INIT; }
        {
            const float* win = args.in[3]; const float* g = args.in[2];
            float wg[4][4][8];
#pragma unroll
            for (int jj = 0; jj < 4; ++jj)
#pragma unroll
                for (int q = 0; q < 4; ++q) { const int k = 4 * lane + 256 * jj + q; const float gk = g[k];
                    const f32x4 a = *(const f32x4*)(win + (size_t)k * DIN + 3072), b = *(const f32x4*)(win + (size_t)k * DIN + 3076);
#pragma unroll
                    for (int j = 0; j < 4; ++j) { wg[jj][q][j] = a[j] * gk; wg[jj][q][4 + j] = b[j] * gk; } }
            const int gw = bx * NWAVES + wave, NGW = G * NWAVES;
            f32x4 vn[4];
            if (gw < T) { const f32x4* xr = (const f32x4*)(x + (size_t)gw * DM) + lane;
#pragma unroll
                for (int jj = 0; jj < 4; ++jj) vn[jj] = xr[64 * jj]; }
            for (int row = gw; row < T; row += NGW) {
                f32x4 v[4]; float ss = 0.f; float d[8];
#pragma unroll
                for (int jj = 0; jj < 4; ++jj) v[jj] = vn[jj];
                if (row + NGW < T) { const f32x4* xr = (const f32x4*)(x + (size_t)(row + NGW) * DM) + lane;
#pragma unroll
                    for (int jj = 0; jj < 4; ++jj) vn[jj] = xr[64 * jj]; }
#pragma unroll
                for (int j = 0; j < 8; ++j) d[j] = 0.f;
#pragma unroll
                for (int jj = 0; jj < 4; ++jj) {
#pragma unroll
                    for (int q = 0; q < 4; ++q) { ss += v[jj][q] * v[jj][q];
#pragma unroll
                        for (int j = 0; j < 8; ++j) d[j] += v[jj][q] * wg[jj][q][j]; } }
                ss = wave_sum(ss);
#pragma unroll
                for (int j = 0; j < 8; ++j) d[j] = wave_sum(d[j]);
                const float rs = rsqrtf(ss * (1.0f / DM) + EPS);
                u32x2* o8 = (u32x2*)(XB + (size_t)row * DM) + lane;
#pragma unroll
                for (int jj = 0; jj < 4; ++jj) { u32x2 w; w.x = cvt_pk_bf16(v[jj][0], v[jj][1]); w.y = cvt_pk_bf16(v[jj][2], v[jj][3]); o8[64 * jj] = w; }
                if (lane == 0) RSTDX[row] = rs;
                if (lane < 8) { float dv = d[0];
#pragma unroll
                    for (int j = 1; j < 8; ++j) dv = (lane == j) ? d[j] : dv;
                    dv *= rs; float r;
                    if (lane < 4) r = dv + args.in[6][lane];
                    else { const float z = dv + args.in[7][lane - 4]; r = (z >= 0.f) ? -log1pf(expf(-z)) : (z - log1pf(expf(z))); }
                    GATES[(size_t)row * 8 + lane] = r; }
            }
            for (int row = gw; row < MROWS; row += NGW) {
                const f32x4* xr = (const f32x4*)(mem + (size_t)row * DM) + lane;
                f32x4 v[4]; float ss = 0.f;
#pragma unroll
                for (int jj = 0; jj < 4; ++jj) { v[jj] = xr[64 * jj]; ss += (v[jj][0] * v[jj][0] + v[jj][1] * v[jj][1]) + (v[jj][2] * v[jj][2] + v[jj][3] * v[jj][3]); }
                ss = wave_sum(ss);
                unsigned* o4 = (unsigned*)((unsigned char*)MEMB + (size_t)row * DM) + lane;
#pragma unroll
                for (int jj = 0; jj < 4; ++jj) { unsigned w = 0u; w = __builtin_amdgcn_cvt_pk_fp8_f32(c8(v[jj][0]), c8(v[jj][1]), w, false); w = __builtin_amdgcn_cvt_pk_fp8_f32(c8(v[jj][2]), c8(v[jj][3]), w, true); o4[64 * jj] = w; }
                if (lane == 0) RSTDM[row] = rsqrtf(ss * (1.0f / DM) + EPS);
            }
        }
        if (ENDBAR(PH_PREP)) GRID_BAR();
    }

    if (IN(PH_INPROJ)) for (int rep_ = 0; rep_ < NREP(PH_INPROJ); ++rep_) {
        { ProbScaleBf16 P{(LAS unsigned*)(lds + LDSCTL_OFF + 2048), XB, WIN, T / 256, NP2 / 256, G, bx, PROJ, NP2, RSTDX, nullptr};
          pg8::gemm_phase<ProbScaleBf16, true>(lds, P, wave); }
        { ProbColScaleBf16 P{WIN + (size_t)NP2 * 1024, XB, 4, T / 256, G, bx, VT1, T, RSTDX};
          pg8::gemm_phase<ProbColScaleBf16, true>(lds, P, wave); }
        if (ENDBAR(PH_INPROJ)) GRID_BAR();
    }

    const int vx = (G % 8 == 0) ? (bx % 8) * (G / 8) + bx / 8 : bx;
    bf16_t* QM = (bf16_t*)(ws + WS_QM); bf16_t* KM = (bf16_t*)(ws + WS_KM); bf16_t* CSTB = (bf16_t*)(ws + WS_CSTB);
    float* BC = (float*)(ws + WS_BC); float* AV = (float*)(ws + WS_AV); float* AM = (float*)(ws + WS_AM); float* NLOC = (float*)(ws + WS_NLOC); float* NST = (float*)(ws + WS_NST);
    float* CH = (float*)(ws + WS_CH); float* MSTATE = (float*)(ws + WS_MSTATE); float* CLOC = (float*)(ws + WS_MST);
    if (IN(PH_MIX0)) for (int rep_ = 0; rep_ < NREP(PH_MIX0); ++rep_) {
        mlstm_prep_phase(lds, PROJ, VT1, GATES, args.in[4], args.in[5], QM, KM, BC, AV, AM, CH, NLOC, CLOC, G, vx, wave);
        if (ENDBAR(PH_MIX0)) GRID_BAR();
    }
    if (IN(PH_MIX1)) for (int rep_ = 0; rep_ < NREP(PH_MIX1); ++rep_) {
        mlstm_scan_phase(CLOC, NLOC, CH, CSTB, NST, MSTATE, G, bx, tid);
        if (ENDBAR(PH_MIX1)) GRID_BAR();
    }
    if (IN(PH_MIX2)) for (int rep_ = 0; rep_ < NREP(PH_MIX2); ++rep_) {
        mlstm_out_phase(lds, PROJ, VT1, QM, KM, BC, AV, AM, CSTB, NST, MSTATE, args.in[8], CAT, G, vx, wave);
        __syncthreads();
        const float lam = __hip_atomic_load(MISC, __ATOMIC_RELAXED, __HIP_MEMORY_SCOPE_AGENT);
        diffattn_phase(lds, PROJ, VT1, args.in[13], lam, CAT, G, vx, wave);
        if (ENDBAR(PH_MIX2)) GRID_BAR();
    }

    if (IN(PH_OUTPROJ)) for (int rep_ = 0; rep_ < NREP(PH_OUTPROJ); ++rep_) {
        ProbResidT<false, true, false> P{(LAS unsigned*)(lds + LDSCTL_OFF + 2048), CAT, WOUT, T / 256, 4, G, bx, nullptr, XB, XB, H1F, SSP1};
        pg8::gemm_phase<ProbResidT<false, true, false>, true>(lds, P, wave);
        if (ENDBAR(PH_OUTPROJ)) GRID_BAR();
    }

    if (IN(PH_QKV)) for (int rep_ = 0; rep_ < NREP(PH_QKV); ++rep_) {
        { ProbScaleT<true> P{(LAS unsigned*)(lds + LDSCTL_OFF + 2048), H1F, WCQ, T / 256, 4, G, bx, PROJ, 1024, nullptr, SSP1};
          pg8::gemm_phase<ProbScaleT<true>, true>(lds, P, wave); }
        { ProbKV P{(LAS unsigned*)(lds + LDSCTL_OFF + 2048), (const unsigned char*)MEMB, (const unsigned char*)WCKV, KV, VT2, RSTDM, G, bx};
          pg8::gemm_phase<ProbKV, true>(lds, P, wave); }
        if (ENDBAR(PH_QKV)) GRID_BAR();
    }

    if (IN(PH_XATTN)) for (int rep_ = 0; rep_ < NREP(PH_XATTN); ++rep_) {
        xattn_phase(lds, PROJ, KV, VT2, (unsigned char*)(PROJ + (size_t)T * 1024), G, vx, wave);
        if (ENDBAR(PH_XATTN)) GRID_BAR();
    }

    if (IN(PH_COPROJ)) for (int rep_ = 0; rep_ < NREP(PH_COPROJ); ++rep_) {
        ProbResidT<true, false, false> P{(LAS unsigned*)(lds + LDSCTL_OFF + 2048), (unsigned char*)(PROJ + (size_t)T * 1024), WCO, T / 256, 4, G, bx, nullptr, XB, CAT, nullptr, SSP2};
        pg8::gemm_phase<ProbResidT<true, false, false>, true>(lds, P, wave);
        if (ENDBAR(PH_COPROJ)) GRID_BAR();
    }

    if (IN(PH_ROUTER)) for (int rep_ = 0; rep_ < NREP(PH_ROUTER); ++rep_) {
        { u32x4 wv[8];
#pragma unroll
          for (int q = 0; q < 8; ++q) { const int idx = q * (NWAVES * 64) + tid, ks = idx >> 6, ln = idx & 63; wv[q] = *(const u32x4*)(WR + (size_t)(ln & 31) * DM + 16 * ks + 8 * (ln >> 5)); }
#pragma unroll
          for (int q = 0; q < 8; ++q) { const int idx = q * (NWAVES * 64) + tid; *(LAS u32x4*)(lds + idx * 16) = wv[q]; } }
        __syncthreads();
        const float* brt = args.in[22];
        const int i = lane & 31, hh = lane >> 5;
        volatile LAS unsigned* lcnt = (volatile LAS unsigned*)(lds + 65536);
        const int ntrip = (T / 32 + G * NWAVES - 1) / (G * NWAVES);
        for (int trip = 0; trip < ntrip; ++trip) {
            const int tile = trip * G * NWAVES + bx * NWAVES + wave; const bool act = tile < T / 32;
            if (tid < 32) lcnt[tid] = 0u;
            __syncthreads();
            const int t = (act ? tile : 0) * 32 + i;
            const bf16_t* xp = CAT + (size_t)t * DM + 8 * hh;
            const f32x4 p0 = *(const f32x4*)(SSP2 + (size_t)t * 16 + 8 * hh), p1 = *(const f32x4*)(SSP2 + (size_t)t * 16 + 8 * hh + 4);
            float sp = (p0[0] + p0[1]) + (p0[2] + p0[3]) + (p1[0] + p1[1]) + (p1[2] + p1[3]); sp = x32_sum(sp);
            const float rs = rsqrtf(sp * (1.0f / DM) + EPS);
            f32x16 acc = zero16();
#pragma unroll 8
            for (int ks = 0; ks < 64; ks += 2) { bf16x8 xf[2]; unsigned pw[2][2];
#pragma unroll
                for (int q = 0; q < 2; ++q) { xf[q] = *(const bf16x8*)(xp + 16 * (ks + q)); const bf16x8 wf = *(const LAS bf16x8*)(lds + ((ks + q) * 64 + lane) * 16);
                    acc = __builtin_amdgcn_mfma_f32_32x32x16_bf16(wf, xf[q], acc, 0, 0, 0); }
                if (act) {
#pragma unroll
                    for (int q = 0; q < 2; ++q) { const u32x4 xw = __builtin_bit_cast(u32x4, xf[q]); unsigned w0 = 0u, w1 = 0u;
                        w0 = __builtin_amdgcn_cvt_pk_fp8_f32(lo_bf(xw.x) * rs, hi_bf(xw.x) * rs, w0, false); w0 = __builtin_amdgcn_cvt_pk_fp8_f32(lo_bf(xw.y) * rs, hi_bf(xw.y) * rs, w0, true);
                        w1 = __builtin_amdgcn_cvt_pk_fp8_f32(lo_bf(xw.z) * rs, hi_bf(xw.z) * rs, w1, false); w1 = __builtin_amdgcn_cvt_pk_fp8_f32(lo_bf(xw.w) * rs, hi_bf(xw.w) * rs, w1, true);
                        pw[q][0] = w0; pw[q][1] = w1; }
                    const auto sa = __builtin_amdgcn_permlane32_swap(pw[0][0], pw[1][0], false, false), sb = __builtin_amdgcn_permlane32_swap(pw[0][1], pw[1][1], false, false);
                    *(u32x4*)(H2F + (size_t)t * DM + 16 * ks + 16 * hh) = (u32x4){sa[0], sb[0], sa[1], sb[1]}; } }
            float mine[16], oth[16];
#pragma unroll
            for (int r = 0; r < 16; ++r) { const int e = (r & 3) + 8 * (r >> 2); mine[r] = acc[r] * rs + brt[e + 4 * hh]; }
#pragma unroll
            for (int r = 0; r < 16; ++r) oth[r] = x32_other(mine[r], hh);
            float lg[NEXP];
#pragma unroll
            for (int r = 0; r < 16; ++r) { const int e = (r & 3) + 8 * (r >> 2); lg[e] = hh ? oth[r] : mine[r]; lg[e + 4] = hh ? mine[r] : oth[r]; }
            unsigned taken = 0u; float tv[4]; int te[4];
#pragma unroll
            for (int k = 0; k < TOPK; ++k) { float best = -INFINITY; int bi = 0;
#pragma unroll
                for (int e = 0; e < NEXP; ++e) { const bool ok = !((taken >> e) & 1u) && (lg[e] > best); best = ok ? lg[e] : best; bi = ok ? e : bi; }
                taken |= 1u << bi; tv[k] = best; te[k] = bi; }
            const float q1 = __expf(tv[1] - tv[0]), q2 = __expf(tv[2] - tv[0]), q3 = __expf(tv[3] - tv[0]); const float inv = 1.0f / (1.0f + q1 + q2 + q3);
            const float gk[4] = {inv, q1 * inv, q2 * inv, q3 * inv};
            unsigned lp[4] = {0u, 0u, 0u, 0u};
            if (act && hh == 0) {
#pragma unroll
                for (int k = 0; k < TOPK; ++k) lp[k] = __hip_atomic_fetch_add((LAS unsigned*)(lcnt + te[k]), 1u, __ATOMIC_RELAXED, __HIP_MEMORY_SCOPE_WORKGROUP); }
            __syncthreads();
            if (tid < 32) { const unsigned n = lcnt[tid]; lcnt[32 + tid] = n ? atomicAdd(&ctl[CW_CNT + tid], n) : 0u; }
            __syncthreads();
            if (act && hh == 0) { RSTD2[t] = rs;
                unsigned tm[4];
#pragma unroll
                for (int k = 0; k < TOPK; ++k) { const unsigned pos = lcnt[32 + te[k]] + lp[k]; LIST[(size_t)te[k] * T + pos] = (unsigned)t; tm[k] = ((unsigned)te[k] << 16) | pos; }
                *(u32x4*)(TOKMAP + (size_t)t * 4) = (u32x4){tm[0], tm[1], tm[2], tm[3]};
                *(f32x4*)(GATEV + (size_t)t * 4) = (f32x4){gk[0], gk[1], gk[2], gk[3]}; }
            __syncthreads();
        }
        if (ENDBAR(PH_ROUTER)) GRID_BAR();
    }

    volatile LAS int* tab = (volatile LAS int*)(LCTL + 16);
    int Rtot = 0;
    if (IN(PH_G1) || IN(PH_G2) || IN(PH_COMBINE)) {
        if (tid < NEXP) tab[MOE_CNT + tid] = (int)__hip_atomic_load(&ctl[CW_CNT + tid], __ATOMIC_RELAXED, __HIP_MEMORY_SCOPE_AGENT);
        __syncthreads();
        if (tid == 0) { int ts = 0, st = 0;
            for (int e = 0; e < NEXP; ++e) { const int c = tab[MOE_CNT + e]; tab[MOE_TS + e] = ts; tab[MOE_ST + e] = st; ts += (c + 255) >> 8; st += c; }
            tab[MOE_TS + NEXP] = ts; tab[MOE_ST + NEXP] = st; }
        __syncthreads();
        Rtot = tab[MOE_TS + NEXP];
    }
    if (IN(PH_G1) || IN(PH_G2)) {
        __syncthreads();
        for (int rt = tid; rt < Rtot; rt += NWAVES * 64) { int e = 0;
            for (int j = 1; j < NEXP; ++j) if (rt >= tab[MOE_TS + j]) e = j;
            ((volatile LAS unsigned char*)(tab + MOE_RTE))[rt] = (unsigned char)e; }
        __syncthreads();
        if (IN(PH_G1)) for (int rep_ = 0; rep_ < NREP(PH_G1); ++rep_) { ProbMoe1 P{H2F, W1F, B1P, RSTD2, LIST, HID, tab, (LAS unsigned*)(lds + LDSCTL_OFF + 2048), 0, Rtot, G, bx};
            pg8::gemm_phase<ProbMoe1, true>(lds, P, wave);
            if (IN(PH_G2) || NREP(PH_G1) > 1) GRID_BAR(); }
        if (IN(PH_G2)) for (int rep_ = 0; rep_ < NREP(PH_G2); ++rep_) { ProbMoe2 P{HID, W2F, args.in[26], YB, tab, (LAS unsigned*)(lds + LDSCTL_OFF + 2048), 0, Rtot, G, bx};
            pg8::gemm_phase<ProbMoe2, true>(lds, P, wave);
            if (IN(PH_COMBINE) || NREP(PH_G2) > 1) GRID_BAR(); }
    }
    if (IN(PH_COMBINE)) {
        const float* gf = args.in[27];
        const int gw = bx * NWAVES + wave, NGW = G * NWAVES;
        f32x4 gfv[4];
#pragma unroll
        for (int jj = 0; jj < 4; ++jj) gfv[jj] = *((const f32x4*)gf + 4 * lane + jj);
        u32x4 tmn = (u32x4){0u, 0u, 0u, 0u}; f32x4 gkn = (f32x4){0.f, 0.f, 0.f, 0.f};
        if (gw < T) { tmn = *(const u32x4*)(TOKMAP + (size_t)gw * 4); gkn = *(const f32x4*)(GATEV + (size_t)gw * 4); }
        for (int t = gw; t < T; t += NGW) {
            const u32x4 tm = tmn; const f32x4 gk = gkn;
            if (t + NGW < T) { tmn = *(const u32x4*)(TOKMAP + (size_t)(t + NGW) * 4); gkn = *(const f32x4*)(GATEV + (size_t)(t + NGW) * 4); }
            const u32x4* hb = (const u32x4*)(CAT + (size_t)t * DM) + 2 * lane;
            const u32x4 h0 = hb[0], h1 = hb[1];
            u32x4 yv[4];
#pragma unroll
            for (int k = 0; k < TOPK; ++k) { const int e = (int)(tm[k] >> 16), pos = (int)(tm[k] & 0xffffu); const size_t yrow = (size_t)(tab[MOE_ST + e] + pos);
                yv[k] = *((const u32x4*)(YB + yrow * DM) + lane); }
            float v[16];
            v[0] = lo_bf(h0.x); v[1] = hi_bf(h0.x); v[2] = lo_bf(h0.y); v[3] = hi_bf(h0.y); v[4] = lo_bf(h0.z); v[5] = hi_bf(h0.z); v[6] = lo_bf(h0.w); v[7] = hi_bf(h0.w);
            v[8] = lo_bf(h1.x); v[9] = hi_bf(h1.x); v[10] = lo_bf(h1.y); v[11] = hi_bf(h1.y); v[12] = lo_bf(h1.z); v[13] = hi_bf(h1.z); v[14] = lo_bf(h1.w); v[15] = hi_bf(h1.w);
#pragma unroll
            for (int k = 0; k < TOPK; ++k) { const float g16 = gk[k] * (1.0f / 16.0f);
#pragma unroll
                for (int q = 0; q < 4; ++q) { const f32x2 a = __builtin_amdgcn_cvt_pk_f32_fp8((int)yv[k][q], false), b2_ = __builtin_amdgcn_cvt_pk_f32_fp8((int)yv[k][q], true);
                    v[4 * q] += g16 * a[0]; v[4 * q + 1] += g16 * a[1]; v[4 * q + 2] += g16 * b2_[0]; v[4 * q + 3] += g16 * b2_[1]; } }
            float ss = 0.f;
#pragma unroll
            for (int q = 0; q < 16; ++q) ss += v[q] * v[q];
            ss = wave_sum(ss); const float rs = rsqrtf(ss * (1.0f / DM) + EPS);
            f32x4* orow = (f32x4*)(args.out + (size_t)t * DM) + 4 * lane;
#pragma unroll
            for (int jj = 0; jj < 4; ++jj) orow[jj] = (f32x4){v[4 * jj] * rs * gfv[jj][0], v[4 * jj + 1] * rs * gfv[jj][1], v[4 * jj + 2] * rs * gfv[jj][2], v[4 * jj + 3] * rs * gfv[jj][3]};
        }
    }
#undef IN
#undef BOTH
#undef GRID_BAR
#undef lane
#undef tid
}

extern "C" void kernel_launch(void* const* d_in, const int* in_sizes, int n_in, void* d_out, int out_size, void* d_ws, size_t ws_size, hipStream_t stream) {
    static int grid = 0;
    if (grid == 0) {
        if (n_in != 28 || out_size != T * DM || ws_size < WS_END) { fprintf(stderr, "kernel_launch: unexpected shapes: n_in %d out %d ws %zu\n", n_in, out_size, ws_size); grid = -1; return; }
        int dev = 0, cus = 0;
        if (hipGetDevice(&dev) != hipSuccess || hipDeviceGetAttribute(&cus, hipDeviceAttributeMultiprocessorCount, dev) != hipSuccess) { grid = -1; return; }
        if (hipFuncSetAttribute((const void*)fwd, hipFuncAttributeMaxDynamicSharedMemorySize, LDS_BYTES) != hipSuccess) { fprintf(stderr, "kernel_launch: hipFuncSetAttribute failed\n"); grid = -1; return; }
        int per_cu = 0;
        if (hipOccupancyMaxActiveBlocksPerMultiprocessor(&per_cu, (const void*)fwd, NWAVES * 64, LDS_BYTES) != hipSuccess || per_cu < 1) fprintf(stderr, "kernel_launch: occupancy query says %d\n", per_cu);
        (void)hipGetLastError();
        grid = cus;
    }
    if (grid < 0) return;
    (void)hipMemsetAsync((char*)d_ws + WS_CTL, 0, CTL_ZERO_BYTES, stream);
    Args a{};
    for (int i = 0; i < 28; ++i) a.in[i] = (const float*)d_in[i];
    a.out = (float*)d_out; a.ws = (unsigned char*)d_ws;
    unsigned char* ws = (unsigned char*)d_ws;
    auto run = [&](int lo, int hi, int p0, int p1) { a.ph_lo = lo; a.ph_hi = hi; a.pass_lo = p0; a.pass_hi = p1; hipLaunchKernelGGL(fwd, dim3(grid), dim3(NWAVES * 64), LDS_BYTES, stream, a); };
#ifdef MULTI_LAUNCH
    for (int ph = 0; ph < PH_G1; ++ph) run(ph, ph + 1, 0, 0);
    run(PH_G1, PH_G1 + 1, 0, 1); run(PH_G2, PH_G2 + 1, 0, 1);
    run(PH_COMBINE, PH_COMBINE + 1, 0, 0);
#else
    run(0, PH_END, 0, 5);
#endif
}
```

```cpp
#include <hip/hip_runtime.h>
#include <cstdio>
#include <cstdint>
#include <cmath>

#define GAS __attribute__((address_space(1)))
#define LAS __attribute__((address_space(3)))
typedef unsigned short bf16_t;
typedef short bf16x8 __attribute__((ext_vector_type(8)));
typedef float f32x4 __attribute__((ext_vector_type(4)));
typedef float f32x2 __attribute__((ext_vector_type(2)));
typedef unsigned u32x4 __attribute__((ext_vector_type(4)));
typedef unsigned u32x2 __attribute__((ext_vector_type(2)));
typedef int i32x8 __attribute__((ext_vector_type(8)));
typedef int i32x4 __attribute__((ext_vector_type(4)));

constexpr int BATCH = 32, SEQ = 2048, DM = 1024, T = BATCH * SEQ, MEMLEN = 256, MROWS = BATCH * MEMLEN;
constexpr int NPROJ = 3072, DIN = 3080, NP2 = 2048;
constexpr int NEXP = 32, TOPK = 4;
constexpr float EPS = 1e-5f;
constexpr float LAMBDA_INIT = 0.2f;

constexpr size_t MiB = 1u << 20;
constexpr size_t WS_CTL = 0, CTL_ZERO_BYTES = 64 * 1024;
constexpr size_t WS_RSTDX = 1 * MiB;
constexpr size_t WS_RSTDM = WS_RSTDX + (size_t)T * 4;
constexpr size_t WS_B1P = WS_RSTDM + (size_t)MROWS * 4;
constexpr size_t WS_MISC = WS_B1P + (size_t)NEXP * 2048 * 4;
constexpr size_t WS_RSTD2 = WS_MISC + 4096;
static_assert(WS_RSTD2 + (size_t)T * 4 <= 2 * MiB, "small region");
constexpr size_t WS_SSP1 = 2 * MiB;
constexpr size_t WS_SSP2 = 6 * MiB;
constexpr size_t WS_GATES = 10 * MiB;
constexpr size_t WS_TOKMAP = 12 * MiB;
constexpr size_t WS_GATEV = 13 * MiB;
constexpr size_t WS_LIST = 14 * MiB;
constexpr size_t WS_WIN = 24 * MiB;
constexpr size_t WS_WOUT = 30 * MiB;
constexpr size_t WS_WCQ = 32 * MiB;
constexpr size_t WS_WCKV = 34 * MiB;
constexpr size_t WS_WCO = 38 * MiB;
constexpr size_t WS_WR = 40 * MiB;
constexpr size_t WS_W1 = 64 * MiB;
constexpr size_t WS_H2F = 128 * MiB;
constexpr size_t WS_W2 = 192 * MiB;
constexpr size_t WS_XB = 256 * MiB;
constexpr size_t WS_PROJ = 384 * MiB;
constexpr size_t WS_H1F = 640 * MiB;
constexpr size_t WS_VT1 = 640 * MiB;
constexpr size_t WS_CAT = 768 * MiB;
constexpr size_t WS_MST = 896 * MiB;
constexpr size_t WS_MEMB = 962 * MiB;
constexpr size_t WS_KV = 978 * MiB;
constexpr size_t WS_VT2 = 994 * MiB;
constexpr size_t WS_QM = 128 * MiB;
constexpr size_t WS_KM = 160 * MiB;
constexpr size_t WS_CSTB = 224 * MiB;
constexpr size_t WS_BC = 1010 * MiB;
constexpr size_t WS_AV = 1011 * MiB;
constexpr size_t WS_AM = 1012 * MiB;
constexpr size_t WS_NLOC = 1013 * MiB;
constexpr size_t WS_NST = WS_NLOC + 512 * 1024;
constexpr size_t WS_CH = 1014 * MiB;
constexpr size_t WS_MSTATE = WS_CH + 64 * 1024;
constexpr size_t WS_Y = 256 * MiB;
constexpr size_t WS_HID = 512 * MiB;
constexpr size_t WS_HID1 = 896 * MiB;
constexpr size_t WS_END = 1024 * MiB;

constexpr int CW_CNT = 64;
constexpr int CW_BAR = 4096;
static_assert((CW_BAR + 3456) * 4 <= (int)CTL_ZERO_BYTES, "control words inside the per-call memset");

__device__ __forceinline__ float bf2f(bf16_t b) { return __uint_as_float(((unsigned)b) << 16); }
__device__ __forceinline__ unsigned f2bf(float f) { unsigned u = __float_as_uint(f); return (u + 0x7fffu + ((u >> 16) & 1u)) >> 16; }
__device__ __forceinline__ unsigned cvt_pk_bf16(float lo, float hi) { unsigned r; asm volatile("v_cvt_pk_bf16_f32 %0, %1, %2" : "=v"(r) : "v"(lo), "v"(hi)); return r; }
__device__ __forceinline__ float x32_sum(float v) { auto r = __builtin_amdgcn_permlane32_swap(__float_as_uint(v), __float_as_uint(v), false, false); return __uint_as_float(r[0]) + __uint_as_float(r[1]); }
__device__ __forceinline__ float x32_max(float v) { auto r = __builtin_amdgcn_permlane32_swap(__float_as_uint(v), __float_as_uint(v), false, false); return fmaxf(__uint_as_float(r[0]), __uint_as_float(r[1])); }
__device__ __forceinline__ float x32_other(float v, int hh) { auto r = __builtin_amdgcn_permlane32_swap(__float_as_uint(v), __float_as_uint(v), false, false); return hh ? __uint_as_float(r[0]) : __uint_as_float(r[1]); }
__device__ __forceinline__ float x16_sum(float v) { auto r = __builtin_amdgcn_permlane16_swap(__float_as_uint(v), __float_as_uint(v), false, false); return __uint_as_float(r[0]) + __uint_as_float(r[1]); }
__device__ __forceinline__ float row16_sum(float v) {
    v += __uint_as_float((unsigned)__builtin_amdgcn_update_dpp(0, (int)__float_as_uint(v), 0xB1, 0xf, 0xf, true));
    v += __uint_as_float((unsigned)__builtin_amdgcn_update_dpp(0, (int)__float_as_uint(v), 0x4E, 0xf, 0xf, true));
    v += __uint_as_float((unsigned)__builtin_amdgcn_update_dpp(0, (int)__float_as_uint(v), 0x141, 0xf, 0xf, true));
    v += __uint_as_float((unsigned)__builtin_amdgcn_update_dpp(0, (int)__float_as_uint(v), 0x140, 0xf, 0xf, true));
    return v; }
__device__ __forceinline__ float wave_sum(float v) { return x32_sum(x16_sum(row16_sum(v))); }
__device__ __forceinline__ int lane_id() { int l; asm volatile("v_mbcnt_lo_u32_b32 %0, -1, 0\n\tv_mbcnt_hi_u32_b32 %0, -1, %0" : "=v"(l)); return l; }
__device__ __forceinline__ float c8(float x) { return __builtin_amdgcn_fmed3f(x, -448.0f, 448.0f); }
__device__ __forceinline__ float lo_bf(unsigned w) { return __uint_as_float(w << 16); }
__device__ __forceinline__ float hi_bf(unsigned w) { return __uint_as_float(w & 0xffff0000u); }

namespace pg8 {
constexpr int BM = 256, BK = 64, HALF = 128, HTB = HALF * BK * 2, STAGE_BYTES = 8 * HTB, NXCD = 8, WGM = 8, KD = 1024, NT = KD / BK;
__host__ __device__ __forceinline__ int lds_byte(int r, int c) { const int st = (r >> 4) * 2 + (c >> 5), rr = r & 15, cc = c & 31, ob = rr * 64 + cc * 2; return st * 1024 + (ob ^ (((ob >> 9) & 1) << 5)); }
__host__ __device__ __forceinline__ void stage_rc(int b, int& R, int& C) { const int st = b / 1024, sb = b % 1024, swz = sb ^ (((sb >> 9) & 1) << 5); R = (st >> 1) * 16 + swz / 64; C = (st & 1) * 32 + (swz % 64) / 2; }
__host__ __device__ __forceinline__ int perm32(int rho) { const int n = rho >> 4, i = rho & 15; return 8 * (i >> 2) + 4 * n + (i & 3); }

struct Unit { const char* A; const char* B; int pm, pn, e, nvalid, y0, aux; };

__device__ __forceinline__ bool static_next(int i, int G, int c, int nM, int nN, int& pm, int& pn) {
    const int nwg = nM * nN; const long L = (long)i * G + c; if (L >= nwg) return false;
    int wgid = (int)L; { const int q = nwg / NXCD, r = nwg % NXCD, xcd = wgid % NXCD, off = wgid / NXCD; wgid = (xcd < r ? xcd * (q + 1) : r * (q + 1) + (xcd - r) * q) + off; }
    const int nig = WGM * nN, gid = wgid / nig, fm = gid * WGM, gsz = (nM - fm) < WGM ? (nM - fm) : WGM;
    pm = fm + ((wgid % nig) % gsz); pn = (wgid % nig) / gsz; return true;
}

template <class P, bool ALIGN_EPI>
__device__ __forceinline__ void gemm_phase(LAS unsigned char* lds, const P& prob, const int wid) {
    const int lane = lane_id(), tid = wid * 64 + lane, wr = wid >> 2, wc = wid & 3, fr = lane & 15, fq = lane >> 4;
    constexpr int ROWB = P::FP8 ? KD : 2 * KD;
    constexpr int nt = ROWB / 128;
    int RA[2], CA[2]; unsigned voffA[2], voffB[2];
#pragma unroll
    for (int i = 0; i < 2; ++i) { int R, C; stage_rc(tid * 16 + i * 8192, R, C); const int Rb = P::PERM ? ((R & ~31) + perm32(R & 31)) : R;
        RA[i] = R; CA[i] = C * 2; voffA[i] = (unsigned)(R * ROWB + C * 2); voffB[i] = (unsigned)(Rb * ROWB + C * 2); }
    constexpr int kstep = BK * 2;
    constexpr size_t hstep = (size_t)HALF * ROWB;
    const unsigned ldsw = (unsigned)wid * 1024u;
    const int aoff = lds_byte(wr * 64 + fr, fq * 8), boff = lds_byte(wc * 32 + fr, fq * 8);
#define PG8_SA(b, h) (((b) * 2 + (h)) * HTB)
#define PG8_SB(b, h) ((4 + (b) * 2 + (h)) * HTB)
#define PG8_STAGE_B(bufoff, gbase) do { _Pragma("unroll") for (int _i = 0; _i < 2; ++_i) \
        __builtin_amdgcn_global_load_lds((const unsigned*)((const char*)(gbase) + voffB[_i]), (LAS unsigned*)(lds + (bufoff) + ldsw + _i * 8192), 16, 0, 0); } while (0)
#define PG8_STAGE_A(bufoff, gbase, off, h) do { _Pragma("unroll") for (int _i = 0; _i < 2; ++_i) { const char* _p; \
        if constexpr (P::GATHER) _p = (const char*)(gbase) + (off)[h][_i]; else _p = (const char*)(gbase) + (size_t)(h) * hstep + voffA[_i]; \
        __builtin_amdgcn_global_load_lds((const unsigned*)_p, (LAS unsigned*)(lds + (bufoff) + ldsw + _i * 8192), 16, 0, 0); } } while (0)
#define PG8_LDA(dst, b, h) do { _Pragma("unroll") for (int m = 0; m < 4; ++m) _Pragma("unroll") for (int k = 0; k < 2; ++k) dst[m][k] = *(const LAS bf16x8*)(lds + PG8_SA(b, h) + aoff + m * 2048 + k * 1024); } while (0)
#define PG8_LDB(dst, b, h) do { _Pragma("unroll") for (int n = 0; n < 2; ++n) _Pragma("unroll") for (int k = 0; k < 2; ++k) dst[n][k] = *(const LAS bf16x8*)(lds + PG8_SB(b, h) + boff + n * 2048 + k * 1024); } while (0)
#define PG8_MMA(ai, bj, At, Bt) do { __builtin_amdgcn_s_setprio(1); _Pragma("unroll") for (int m = 0; m < 4; ++m) _Pragma("unroll") for (int n = 0; n < 2; ++n) { \
        if constexpr (P::FP8) { const i32x4 b0_ = __builtin_bit_cast(i32x4, Bt[n][0]), b1_ = __builtin_bit_cast(i32x4, Bt[n][1]), a0_ = __builtin_bit_cast(i32x4, At[m][0]), a1_ = __builtin_bit_cast(i32x4, At[m][1]); \
            acc[ai][bj][m][n] = __builtin_amdgcn_mfma_scale_f32_16x16x128_f8f6f4((i32x8){b0_[0], b0_[1], b0_[2], b0_[3], b1_[0], b1_[1], b1_[2], b1_[3]}, (i32x8){a0_[0], a0_[1], a0_[2], a0_[3], a1_[0], a1_[1], a1_[2], a1_[3]}, \
                acc[ai][bj][m][n], 0, 0, 0, 0x7f7f7f7f, 0, 0x7f7f7f7f); } \
        else { _Pragma("unroll") for (int k = 0; k < 2; ++k) acc[ai][bj][m][n] = __builtin_amdgcn_mfma_f32_16x16x32_bf16(Bt[n][k], At[m][k], acc[ai][bj][m][n], 0, 0, 0); } } \
        __builtin_amdgcn_s_setprio(0); } while (0)
#define PG8_WAIT_V(n) asm volatile("s_waitcnt vmcnt(" #n ")" ::: "memory")
#define PG8_WAIT_L(n) asm volatile("s_waitcnt lgkmcnt(" #n ")" ::: "memory")
#define PG8_BAR __builtin_amdgcn_s_barrier()
#define PG8_SCHED __builtin_amdgcn_sched_barrier(0)
    Unit cur, nxt; int ui = 0;
    if (!prob.next(0, cur)) return;
    f32x4 acc[2][2][4][2];
#pragma unroll
    for (int a = 0; a < 2; ++a)
#pragma unroll
        for (int b = 0; b < 2; ++b)
#pragma unroll
            for (int m = 0; m < 4; ++m)
#pragma unroll
                for (int n = 0; n < 2; ++n) acc[a][b][m][n] = (f32x4){0.f, 0.f, 0.f, 0.f};
    bf16x8 At[4][2], B0[2][2], B1[2][2];
    unsigned offC[2][2] = {{0u, 0u}, {0u, 0u}};
#define PG8_FILL(u, buf) do { if (tid < 256) prob.gtab[(buf) * 256 + tid] = prob.a_off(u, tid); } while (0)
#define PG8_OFFS(buf) do { _Pragma("unroll") for (int _h = 0; _h < 2; ++_h) _Pragma("unroll") for (int _i = 0; _i < 2; ++_i) offC[_h][_i] = prob.gtab[(buf) * 256 + _h * HALF + RA[_i]] + (unsigned)CA[_i]; } while (0)
    Unit nx2;
    bool has_next = prob.next(1, nxt);
    if constexpr (P::GATHER) { PG8_FILL(cur, 0); if (has_next) PG8_FILL(nxt, 1); PG8_WAIT_L(0); PG8_BAR; PG8_OFFS(0); }
    const char* cA = prob.a_tile(cur); const char* cB = cur.B;
    PG8_STAGE_B(PG8_SB(0, 0), cB); PG8_STAGE_B(PG8_SB(0, 1), cB + hstep); PG8_STAGE_A(PG8_SA(0, 0), cA, offC, 0); PG8_STAGE_A(PG8_SA(0, 1), cA, offC, 1);
    if (wr == 1) PG8_BAR;
    PG8_WAIT_V(2); PG8_BAR;
    PG8_STAGE_B(PG8_SB(1, 0), cB + kstep); PG8_STAGE_A(PG8_SA(1, 0), cA + kstep, offC, 0); PG8_STAGE_B(PG8_SB(1, 1), cB + hstep + kstep);
    PG8_WAIT_V(6); PG8_BAR;
    int bcur = 0;
    for (;;) {
        const bool has_nx2 = has_next && prob.next(ui + 2, nx2);
        const char* nA = has_next ? prob.a_tile(nxt) : cA; const char* nB = has_next ? nxt.B : cB;
        const int bnext = bcur == 2 ? 0 : bcur + 1, bnx2 = bnext == 2 ? 0 : bnext + 1;
#pragma unroll 1
        for (int t = 0; t < nt; t += 2) {
            const bool last = (t == nt - 2);
            const char* a1 = cA + (size_t)(t + 1) * kstep;
            const char* a2 = last ? nA : cA + (size_t)(t + 2) * kstep; const char* b2 = last ? nB : cB + (size_t)(t + 2) * kstep;
            const char* a3 = a2 + kstep; const char* b3 = b2 + kstep;
            PG8_LDB(B0, 0, 0); PG8_LDB(B1, 0, 1); PG8_SCHED; PG8_LDA(At, 0, 0); PG8_STAGE_A(PG8_SA(1, 1), a1, offC, 1);
            if constexpr (P::GATHER) { if (last && has_next) PG8_OFFS(bnext); }
            PG8_WAIT_V(8); PG8_WAIT_L(0); PG8_BAR; PG8_MMA(0, 0, At, B0); PG8_MMA(0, 1, At, B1); PG8_BAR; PG8_SCHED;
            PG8_LDA(At, 0, 1); PG8_STAGE_B(PG8_SB(0, 0), b2); PG8_STAGE_B(PG8_SB(0, 1), b2 + hstep); PG8_STAGE_A(PG8_SA(0, 0), a2, offC, 0);
            PG8_WAIT_V(8); PG8_WAIT_L(0); PG8_BAR; PG8_MMA(1, 0, At, B0); PG8_MMA(1, 1, At, B1); PG8_BAR; PG8_SCHED;
            PG8_LDB(B0, 1, 0); PG8_LDB(B1, 1, 1); PG8_SCHED; PG8_LDA(At, 1, 0); PG8_STAGE_A(PG8_SA(0, 1), a2, offC, 1);
            PG8_WAIT_V(8); PG8_WAIT_L(0); PG8_BAR; PG8_MMA(0, 0, At, B0); PG8_MMA(0, 1, At, B1); PG8_BAR; PG8_SCHED;
            PG8_LDA(At, 1, 1); PG8_STAGE_B(PG8_SB(1, 0), b3); PG8_STAGE_B(PG8_SB(1, 1), b3 + hstep); PG8_STAGE_A(PG8_SA(1, 0), a3, offC, 0);
            PG8_WAIT_V(8); PG8_WAIT_L(0); PG8_BAR; PG8_MMA(1, 0, At, B0); PG8_MMA(1, 1, At, B1); PG8_BAR; PG8_SCHED;
        }
        if constexpr (ALIGN_EPI) { if (wr == 0) PG8_BAR; }
        if constexpr (P::GATHER) { if (has_nx2) PG8_FILL(nx2, bnx2); }
        cur.aux = bcur;
        prob.epi(acc, cur, wr, wc, fr, fq);
        if (!has_next) break;
#pragma unroll
        for (int a = 0; a < 2; ++a)
#pragma unroll
            for (int b = 0; b < 2; ++b)
#pragma unroll
                for (int m = 0; m < 4; ++m)
#pragma unroll
                    for (int n = 0; n < 2; ++n) acc[a][b][m][n] = (f32x4){0.f, 0.f, 0.f, 0.f};
        cur = nxt; nxt = nx2; has_next = has_nx2; cA = nA; cB = nB; ++ui; bcur = bnext;
        if constexpr (ALIGN_EPI) { if (wr == 1) PG8_BAR; }
    }
    PG8_WAIT_V(0);
    if constexpr (!ALIGN_EPI) { if (wr == 0) PG8_BAR; }
    PG8_BAR;
#undef PG8_SA
#undef PG8_SB
#undef PG8_STAGE_A
#undef PG8_STAGE_B
#undef PG8_LDA
#undef PG8_LDB
#undef PG8_MMA
#undef PG8_WAIT_V
#undef PG8_WAIT_L
#undef PG8_BAR
#undef PG8_SCHED
#undef PG8_OFFS
#undef PG8_FILL
}
}

template <bool F8> struct ProbScaleT {
    static constexpr bool FP8 = F8, PERM = true, GATHER = F8;
    static constexpr int RB = F8 ? 1024 : 2048;
    __device__ __forceinline__ const char* a_tile(const pg8::Unit& u) const { return F8 ? u.A : u.A + (size_t)u.pm * (256 * RB); }
    LAS unsigned* gtab;
    const void* A; const void* Bt; int nM, nN, G, c;
    bf16_t* O; int ldo; const float* rstd; const float* ssp;
    __device__ __forceinline__ bool next(int i, pg8::Unit& u) const {
        int pm, pn; if (!pg8::static_next(i, G, c, nM, nN, pm, pn)) return false;
        u.A = (const char*)A; u.B = (const char*)Bt + (size_t)pn * 256 * RB; u.pm = pm; u.pn = pn; u.e = 0; u.nvalid = 256; u.y0 = 0; u.aux = 0; return true; }
    __device__ __forceinline__ unsigned a_off(const pg8::Unit& u, int r) const { return (unsigned)(u.pm * 256 + r) * (unsigned)RB; }
    __device__ __forceinline__ void epi(const f32x4 (&acc)[2][2][4][2], const pg8::Unit& u, int wr, int wc, int fr, int fq) const {
        asm volatile("" : "+v"(fr), "+v"(fq));
        const int rowu = u.pm * 256 + wr * 64;
        char* ub = (char*)O + ((size_t)rowu * ldo + u.pn * 256 + wc * 32) * 2;
        const unsigned lo = (unsigned)(fr * ldo + 8 * fq) * 2u;
        float rsv[8];
        if (rstd) {
#pragma unroll
            for (int q = 0; q < 8; ++q) rsv[q] = rstd[rowu + fr + (q >> 2) * 128 + (q & 3) * 16];
        } else { f32x4 pv[8];
#pragma unroll
            for (int q = 0; q < 8; ++q) pv[q] = *(const f32x4*)(ssp + (size_t)(rowu + fr + (q >> 2) * 128 + (q & 3) * 16) * 16 + fq * 4);
#pragma unroll
            for (int q = 0; q < 8; ++q) { float sq = (pv[q][0] + pv[q][1]) + (pv[q][2] + pv[q][3]); sq = x16_sum(sq); sq = x32_sum(sq); rsv[q] = rsqrtf(sq * (1.0f / 1024.0f) + EPS); } }
#pragma unroll
        for (int ai = 0; ai < 2; ++ai)
#pragma unroll
            for (int m = 0; m < 4; ++m) { const float rs = rsv[ai * 4 + m] * (F8 ? (1.0f / 64.0f) : 1.0f);
                char* rowp = ub + (size_t)(ai * 128 + m * 16) * ldo * 2 + lo;
#pragma unroll
                for (int bj = 0; bj < 2; ++bj) { const f32x4 v0 = acc[ai][bj][m][0] * rs, v1 = acc[ai][bj][m][1] * rs;
                    u32x4 w; w.x = cvt_pk_bf16(v0[0], v0[1]); w.y = cvt_pk_bf16(v0[2], v0[3]); w.z = cvt_pk_bf16(v1[0], v1[1]); w.w = cvt_pk_bf16(v1[2], v1[3]);
                    *(u32x4*)(rowp + bj * 256) = w; } }
    }
};
typedef ProbScaleT<false> ProbScaleBf16;
struct ProbColScaleBf16 {
    static constexpr bool FP8 = false, PERM = true, GATHER = false;
    __device__ __forceinline__ const char* a_tile(const pg8::Unit& u) const { return u.A + (size_t)u.pm * (256 * 2048); }
    const bf16_t* A; const bf16_t* Bt; int nM, nN, G, c;
    bf16_t* O; int ldo; const float* cs;
    __device__ __forceinline__ bool next(int i, pg8::Unit& u) const {
        const long L = (long)i * G + c; if (L >= (long)nM * nN) return false;
        const int pm = (int)(L % nM), pn = (int)(L / nM);
        u.A = (const char*)A; u.B = (const char*)(Bt + (size_t)pn * 256 * 1024); u.pm = pm; u.pn = pn; u.e = 0; u.nvalid = 256; u.y0 = 0; u.aux = 0; return true; }
    __device__ __forceinline__ unsigned a_off(const pg8::Unit& u, int r) const { return 0u; }
    __device__ __forceinline__ void epi(const f32x4 (&acc)[2][2][4][2], const pg8::Unit& u, int wr, int wc, int fr, int fq) const {
        asm volatile("" : "+v"(fr), "+v"(fq));
        const float* cp = cs + u.pn * 256 + wc * 32 + 8 * fq;
        f32x4 sc[2][2];
#pragma unroll
        for (int bj = 0; bj < 2; ++bj)
#pragma unroll
            for (int n = 0; n < 2; ++n) sc[bj][n] = *(const f32x4*)(cp + bj * 128 + 4 * n);
        char* ub = (char*)O + ((size_t)(u.pm * 256 + wr * 64) * ldo + u.pn * 256 + wc * 32) * 2;
        const unsigned lo = (unsigned)(fr * ldo + 8 * fq) * 2u;
#pragma unroll
        for (int ai = 0; ai < 2; ++ai)
#pragma unroll
            for (int m = 0; m < 4; ++m) { char* rowp = ub + (size_t)(ai * 128 + m * 16) * ldo * 2 + lo;
#pragma unroll
                for (int bj = 0; bj < 2; ++bj) { const f32x4 v0 = acc[ai][bj][m][0] * sc[bj][0], v1 = acc[ai][bj][m][1] * sc[bj][1];
                    u32x4 w; w.x = cvt_pk_bf16(v0[0], v0[1]); w.y = cvt_pk_bf16(v0[2], v0[3]); w.z = cvt_pk_bf16(v1[0], v1[1]); w.w = cvt_pk_bf16(v1[2], v1[3]);
                    *(u32x4*)(rowp + bj * 256) = w; } }
    }
};
struct ProbKV {
    static constexpr bool FP8 = true, PERM = true, GATHER = true;
    __device__ __forceinline__ const char* a_tile(const pg8::Unit& u) const { return u.A; }
    LAS unsigned* gtab;
    const unsigned char* memb; const unsigned char* wckv; bf16_t* Kout; bf16_t* VTout; const float* rstdm; int G, c;
    __device__ __forceinline__ bool next(int i, pg8::Unit& u) const {
        const long L = (long)i * G + c; if (L >= 256) return false;
        if (L < 128) { u.pm = (int)(L & 31); u.pn = (int)(L >> 5); u.e = 0; u.A = (const char*)memb; u.B = (const char*)(wckv + (size_t)u.pn * 256 * 1024); }
        else { const int l2 = (int)L - 128; u.pm = l2 & 3; u.pn = l2 >> 2; u.e = 1; u.A = (const char*)(wckv + (size_t)1024 * 1024); u.B = (const char*)(memb + (size_t)u.pn * 256 * 1024); }
        u.nvalid = 256; u.y0 = 0; u.aux = 0; return true; }
    __device__ __forceinline__ unsigned a_off(const pg8::Unit& u, int r) const { return (unsigned)(u.pm * 256 + r) * 1024u; }
    __device__ __forceinline__ void epi(const f32x4 (&acc)[2][2][4][2], const pg8::Unit& u, int wr, int wc, int fr, int fq) const {
        asm volatile("" : "+v"(fr), "+v"(fq));
        const int ldo = u.e ? MROWS : 1024;
        char* ub = (char*)(u.e ? VTout : Kout) + ((size_t)(u.pm * 256 + wr * 64) * ldo + u.pn * 256 + wc * 32) * 2;
        const unsigned lo = (unsigned)(fr * ldo + 8 * fq) * 2u;
        float rsv[8]; f32x4 sc[2][2];
        if (u.e == 0) {
#pragma unroll
            for (int q = 0; q < 8; ++q) rsv[q] = rstdm[u.pm * 256 + wr * 64 + fr + (q >> 2) * 128 + (q & 3) * 16] * (1.0f / 64.0f);
#pragma unroll
            for (int bj = 0; bj < 2; ++bj)
#pragma unroll
                for (int n = 0; n < 2; ++n) sc[bj][n] = (f32x4){1.f, 1.f, 1.f, 1.f};
        } else {
#pragma unroll
            for (int q = 0; q < 8; ++q) rsv[q] = 1.0f / 64.0f;
            const float* cp = rstdm + u.pn * 256 + wc * 32 + 8 * fq;
#pragma unroll
            for (int bj = 0; bj < 2; ++bj)
#pragma unroll
                for (int n = 0; n < 2; ++n) sc[bj][n] = *(const f32x4*)(cp + bj * 128 + 4 * n); }
#pragma unroll
        for (int ai = 0; ai < 2; ++ai)
#pragma unroll
            for (int m = 0; m < 4; ++m) { const float rs = rsv[ai * 4 + m]; char* rowp = ub + (size_t)(ai * 128 + m * 16) * ldo * 2 + lo;
#pragma unroll
                for (int bj = 0; bj < 2; ++bj) { const f32x4 v0 = acc[ai][bj][m][0] * sc[bj][0] * rs, v1 = acc[ai][bj][m][1] * sc[bj][1] * rs;
                    u32x4 w; w.x = cvt_pk_bf16(v0[0], v0[1]); w.y = cvt_pk_bf16(v0[2], v0[3]); w.z = cvt_pk_bf16(v1[0], v1[1]); w.w = cvt_pk_bf16(v1[2], v1[3]);
                    *(u32x4*)(rowp + bj * 256) = w; } }
    }
};
template <bool F8, bool WF8, bool RF32> struct ProbResidT {
    static constexpr bool FP8 = F8, PERM = true, GATHER = F8;
    static constexpr int RB = F8 ? 1024 : 2048;
    __device__ __forceinline__ const char* a_tile(const pg8::Unit& u) const { return F8 ? u.A : u.A + (size_t)u.pm * (256 * RB); }
    LAS unsigned* gtab;
    const void* A; const void* Bt; int nM, nN, G, c;
    const float* rf; const bf16_t* rb; bf16_t* ob; unsigned char* of8; float* ssp;
    __device__ __forceinline__ bool next(int i, pg8::Unit& u) const {
        int pm, pn; if (!pg8::static_next(i, G, c, nM, nN, pm, pn)) return false;
        u.A = (const char*)A; u.B = (const char*)Bt + (size_t)pn * 256 * RB; u.pm = pm; u.pn = pn; u.e = 0; u.nvalid = 256; u.y0 = 0; u.aux = 0; return true; }
    __device__ __forceinline__ unsigned a_off(const pg8::Unit& u, int r) const { return (unsigned)(u.pm * 256 + r) * (unsigned)RB; }
    __device__ __forceinline__ void epi(const f32x4 (&acc)[2][2][4][2], const pg8::Unit& u, int wr, int wc, int fr, int fq) const {
        asm volatile("" : "+v"(fr), "+v"(fq));
        const int rowu = u.pm * 256 + wr * 64;
        const size_t uoff = (size_t)rowu * 1024 + u.pn * 256 + wc * 32;
        const unsigned lo = (unsigned)(fr * 1024 + 8 * fq);
        const float sc = F8 ? (1.0f / 64.0f) : 1.0f;
#pragma unroll
        for (int ai = 0; ai < 2; ++ai) {
            f32x4 rv[4][2][2];
#pragma unroll
            for (int m = 0; m < 4; ++m) { const size_t ro = uoff + (size_t)(ai * 128 + m * 16) * 1024;
#pragma unroll
                for (int bj = 0; bj < 2; ++bj) {
                    if constexpr (RF32) { rv[m][bj][0] = *(const GAS f32x4*)(rf + ro + lo + bj * 128); rv[m][bj][1] = *(const GAS f32x4*)(rf + ro + lo + bj * 128 + 4); }
                    else { const u32x4 w = *(const GAS u32x4*)(rb + ro + lo + bj * 128); rv[m][bj][0] = (f32x4){lo_bf(w.x), hi_bf(w.x), lo_bf(w.y), hi_bf(w.y)}; rv[m][bj][1] = (f32x4){lo_bf(w.z), hi_bf(w.z), lo_bf(w.w), hi_bf(w.w)}; } } }
#pragma unroll
            for (int m = 0; m < 4; ++m) { const size_t ro = uoff + (size_t)(ai * 128 + m * 16) * 1024; float ss = 0.f;
                unsigned pk[2][2];
#pragma unroll
                for (int bj = 0; bj < 2; ++bj) { const f32x4 v0 = acc[ai][bj][m][0] * sc + rv[m][bj][0], v1 = acc[ai][bj][m][1] * sc + rv[m][bj][1];
                    ss += (v0[0] * v0[0] + v0[1] * v0[1]) + (v0[2] * v0[2] + v0[3] * v0[3]) + (v1[0] * v1[0] + v1[1] * v1[1]) + (v1[2] * v1[2] + v1[3] * v1[3]);
                    u32x4 w; w.x = cvt_pk_bf16(v0[0], v0[1]); w.y = cvt_pk_bf16(v0[2], v0[3]); w.z = cvt_pk_bf16(v1[0], v1[1]); w.w = cvt_pk_bf16(v1[2], v1[3]);
                    *(u32x4*)(ob + ro + lo + bj * 128) = w;
                    if constexpr (WF8) { unsigned w0 = 0u, w1 = 0u;
                        w0 = __builtin_amdgcn_cvt_pk_fp8_f32(c8(v0[0]), c8(v0[1]), w0, false); w0 = __builtin_amdgcn_cvt_pk_fp8_f32(c8(v0[2]), c8(v0[3]), w0, true);
                        w1 = __builtin_amdgcn_cvt_pk_fp8_f32(c8(v1[0]), c8(v1[1]), w1, false); w1 = __builtin_amdgcn_cvt_pk_fp8_f32(c8(v1[2]), c8(v1[3]), w1, true);
                        pk[bj][0] = w0; pk[bj][1] = w1; } }
                if constexpr (WF8) {
                    const auto s0 = __builtin_amdgcn_permlane16_swap(pk[0][0], pk[1][0], false, false), s1 = __builtin_amdgcn_permlane16_swap(pk[0][1], pk[1][1], false, false);
                    *(u32x4*)(of8 + ro + lo + ((fq & 1) ? 120u : 0u)) = (u32x4){s0[0], s1[0], s0[1], s1[1]}; }
                ss = x16_sum(ss); ss = x32_sum(ss);
                if (fq == 0) ssp[(size_t)(rowu + ai * 128 + m * 16 + fr) * 16 + u.pn * 4 + wc] = ss; } }
    }
};
__device__ __forceinline__ size_t hid_tile_off(int rt) { return rt < 1024 ? (size_t)rt * (256 * 1024) : (WS_HID1 - WS_HID) + (size_t)(rt - 1024) * (256 * 1024); }
constexpr int MOE_TS = 0, MOE_ST = 33, MOE_CNT = 66, MOE_RTE = 100, MOE_WORDS = 100 + 264;
struct ProbMoe1 {
    static constexpr bool FP8 = true, PERM = true, GATHER = true;
    __device__ __forceinline__ const char* a_tile(const pg8::Unit& u) const { return u.A; }
    const unsigned char* hb; const unsigned char* w1b; const float* b1p; const float* rstd2; const unsigned* list; unsigned char* hid;
    const volatile LAS int* tab; LAS unsigned* gtab; int rt0, nrt, G, c;
    __device__ __forceinline__ bool next(int i, pg8::Unit& u) const {
        const long L = (long)i * G + c; if (L >= (long)nrt * 8) return false;
        const int gidx = (int)(L >> 8), within = (int)(L & 255), gsz = (nrt - gidx * 32) < 32 ? (nrt - gidx * 32) : 32;
        const int rtl = gidx * 32 + within % gsz, pn = within / gsz, rt = rt0 + rtl;
        const int e = ((const volatile LAS unsigned char*)(tab + MOE_RTE))[rt];
        const int idx0 = (rt - tab[MOE_TS + e]) * 256;
        u.A = (const char*)hb; u.B = (const char*)(w1b + ((size_t)e * 2048 + (size_t)pn * 256) * 1024); u.pm = rt; u.pn = pn; u.e = e; u.nvalid = tab[MOE_CNT + e] - idx0; u.y0 = idx0; u.aux = 0; return true; }
    __device__ __forceinline__ unsigned tok_of(const pg8::Unit& u, int r) const { const int rr = r < u.nvalid ? r : 0; return list[(size_t)u.e * T + u.y0 + rr]; }
    __device__ __forceinline__ unsigned a_off(const pg8::Unit& u, int r) const { return tok_of(u, r) * 1024u; }
    __device__ __forceinline__ void epi(const f32x4 (&acc)[2][2][4][2], const pg8::Unit& u, int wr, int wc, int fr, int fq) const {
        asm volatile("" : "+v"(fr), "+v"(fq));
        const float* bp = b1p + (size_t)u.e * 2048 + u.pn * 256 + wc * 32 + 8 * fq;
        const f32x4 bg0 = *(const f32x4*)(bp), bg1 = *(const f32x4*)(bp + 4), bl0 = *(const f32x4*)(bp + 128), bl1 = *(const f32x4*)(bp + 132);
        char* ub = (char*)hid + hid_tile_off(u.pm) + ((size_t)(wr * 64) * 1024 + u.pn * 128 + wc * 32);
        const unsigned lo = (unsigned)(fr * 1024 + 8 * fq);
        unsigned wk[2][2];
#pragma unroll
        for (int ai = 0; ai < 2; ++ai)
#pragma unroll
            for (int m = 0; m < 4; ++m) { const float rs = 1.0f / 64.0f;
                unsigned w[2];
#pragma unroll
                for (int n = 0; n < 2; ++n) { const f32x4 g4 = acc[ai][0][m][n] * rs + (n ? bg1 : bg0), l4 = acc[ai][1][m][n] * rs + (n ? bl1 : bl0);
                    unsigned wv = 0u;
#pragma unroll
                    for (int jp = 0; jp < 2; ++jp) {
                        f32x2 g2 = {fminf(g4[2 * jp], 7.0f), fminf(g4[2 * jp + 1], 7.0f)};
                        const f32x2 l2 = {__builtin_amdgcn_fmed3f(l4[2 * jp], -7.0f, 7.0f), __builtin_amdgcn_fmed3f(l4[2 * jp + 1], -7.0f, 7.0f)};
                        const f32x2 z2 = g2 * (-1.702f * 1.4426950408889634f);
                        const f32x2 d2 = (f32x2){__builtin_amdgcn_exp2f(z2[0]), __builtin_amdgcn_exp2f(z2[1])} + 1.0f;
                        const f32x2 r2 = {__builtin_amdgcn_rcpf(d2[0]), __builtin_amdgcn_rcpf(d2[1])};
                        const f32x2 o2 = (g2 * r2) * (l2 * 4.0f + 4.0f);
                        if (jp) wv = __builtin_amdgcn_cvt_pk_fp8_f32(o2[0], o2[1], wv, true); else wv = __builtin_amdgcn_cvt_pk_fp8_f32(o2[0], o2[1], wv, false); }
                    w[n] = wv; }
                wk[m & 1][0] = w[0]; wk[m & 1][1] = w[1];
                if (m & 1) {
                    const auto s0 = __builtin_amdgcn_permlane16_swap(wk[0][0], wk[1][0], false, false), s1 = __builtin_amdgcn_permlane16_swap(wk[0][1], wk[1][1], false, false);
                    *(u32x4*)(ub + (size_t)(ai * 128 + (m - 1) * 16) * 1024 + lo + ((fq & 1) ? 16u * 1024u - 8u : 0u)) = (u32x4){s0[0], s1[0], s0[1], s1[1]}; } }
    }
};
struct ProbMoe2 {
    static constexpr bool FP8 = true, PERM = true, GATHER = true;
    __device__ __forceinline__ const char* a_tile(const pg8::Unit& u) const { return u.A; }
    const unsigned char* hid; const unsigned char* w2b; const float* b2; unsigned char* y;
    const volatile LAS int* tab; LAS unsigned* gtab; int rt0, nrt, G, c;
    __device__ __forceinline__ bool next(int i, pg8::Unit& u) const {
        const long L = (long)i * G + c; if (L >= (long)nrt * 4) return false;
        const int gidx = (int)(L >> 8), within = (int)(L & 255), gsz = (nrt - gidx * 64) < 64 ? (nrt - gidx * 64) : 64;
        const int rtl = gidx * 64 + within % gsz, pn = within / gsz, rt = rt0 + rtl;
        const int e = ((const volatile LAS unsigned char*)(tab + MOE_RTE))[rt];
        const int idx0 = (rt - tab[MOE_TS + e]) * 256;
        u.A = (const char*)hid; u.B = (const char*)(w2b + ((size_t)e * 1024 + (size_t)pn * 256) * 1024); u.pm = rt; u.pn = pn; u.e = e; u.nvalid = tab[MOE_CNT + e] - idx0; u.y0 = tab[MOE_ST + e] + idx0; u.aux = 0; return true; }
    __device__ __forceinline__ unsigned a_off(const pg8::Unit& u, int r) const { return (unsigned)(hid_tile_off(u.pm) + (size_t)r * 1024u); }
    __device__ __forceinline__ void epi(const f32x4 (&acc)[2][2][4][2], const pg8::Unit& u, int wr, int wc, int fr, int fq) const {
        asm volatile("" : "+v"(fr), "+v"(fq));
        const float* bp = b2 + (size_t)u.e * 1024 + u.pn * 256 + wc * 32 + 8 * fq;
        f32x4 bv[2][2];
#pragma unroll
        for (int bj = 0; bj < 2; ++bj)
#pragma unroll
            for (int n = 0; n < 2; ++n) bv[bj][n] = *(const f32x4*)(bp + bj * 128 + 4 * n);
        char* ub = (char*)y + (((size_t)u.y0 + wr * 64) * 1024 + u.pn * 256 + wc * 32);
        const unsigned lo2 = (unsigned)(fr * 1024 + 8 * fq) + ((fq & 1) ? 120u : 0u);
        const int r0 = wr * 64 + fr;
#pragma unroll
        for (int ai = 0; ai < 2; ++ai)
#pragma unroll
            for (int m = 0; m < 4; ++m) { const int r = r0 + ai * 128 + m * 16;
                unsigned pk[2][2];
#pragma unroll
                for (int bj = 0; bj < 2; ++bj) { const f32x4 v0 = acc[ai][bj][m][0] * (1.0f / 16.0f) + bv[bj][0] * 16.0f, v1 = acc[ai][bj][m][1] * (1.0f / 16.0f) + bv[bj][1] * 16.0f;
                    unsigned w0 = 0u, w1 = 0u;
                    w0 = __builtin_amdgcn_cvt_pk_fp8_f32(c8(v0[0]), c8(v0[1]), w0, false); w0 = __builtin_amdgcn_cvt_pk_fp8_f32(c8(v0[2]), c8(v0[3]), w0, true);
                    w1 = __builtin_amdgcn_cvt_pk_fp8_f32(c8(v1[0]), c8(v1[1]), w1, false); w1 = __builtin_amdgcn_cvt_pk_fp8_f32(c8(v1[2]), c8(v1[3]), w1, true);
                    pk[bj][0] = w0; pk[bj][1] = w1; }
                const auto s0 = __builtin_amdgcn_permlane16_swap(pk[0][0], pk[1][0], false, false), s1 = __builtin_amdgcn_permlane16_swap(pk[0][1], pk[1][1], false, false);
                if (r < u.nvalid) *(u32x4*)(ub + (size_t)(ai * 128 + m * 16) * 1024 + lo2) = (u32x4){s0[0], s1[0], s0[1], s1[1]}; }
    }
};

#define XB_TMO      128
#define XB_XCNT(j)  (256  + 64 * (j))
#define XB_XSUB(j)  (1280 + 64 * (j))
#define XB_XGEN(j)  (2304 + 64 * (j))
#define XB_TOP      3328
#define XB_TOPGEN   3392
#define XCD_BAR_WORDS 3456
#define XB_SPIN_CAP (1u << 18)
__device__ __forceinline__ unsigned xb_ld(unsigned* p)              { return __hip_atomic_load(p, __ATOMIC_RELAXED, __HIP_MEMORY_SCOPE_AGENT); }
__device__ __forceinline__ unsigned xb_add(unsigned* p, unsigned v) { return __hip_atomic_fetch_add(p, v, __ATOMIC_RELAXED, __HIP_MEMORY_SCOPE_AGENT); }
__device__ __forceinline__ unsigned xb_xcc_id() { return (unsigned)__builtin_amdgcn_s_getreg((3 << 11) | 20) & 0xFu; }
#define XB_SPIN(cond, bar) do { unsigned _sp = 0; while (cond) { __builtin_amdgcn_s_sleep(1); \
    if ((++_sp & 255u) == 0u) { if (xb_ld(&(bar)[XB_TMO])) break; if (_sp > XB_SPIN_CAP) { atomicAdd(&(bar)[XB_TMO], 1u); break; } } } } while (0)
struct XcdBarrier { unsigned* bar; unsigned x; volatile LAS unsigned* st; int wave; };
__device__ __forceinline__ XcdBarrier xcd_barrier_post(unsigned* bar, volatile LAS unsigned* st, int wave) {
    XcdBarrier b; b.bar = bar; b.x = xb_xcc_id(); b.st = st; b.wave = wave;
    if (wave == 0 && lane_id() == 0) (void)xb_add(&bar[XB_XCNT(b.x)], 1u);
    return b;
}
__device__ __forceinline__ void xcd_barrier_complete(unsigned* bar, unsigned x, unsigned& nloc, unsigned& nx) {
    const unsigned G = gridDim.x * gridDim.y * gridDim.z;
    unsigned sum, cnt, mine, sp = 0u;
    for (;;) {
        sum = 0u; cnt = 0u; mine = 0u;
#pragma unroll
        for (unsigned j = 0; j < 16; ++j) { const unsigned c = xb_ld(&bar[XB_XCNT(j)]); sum += c; cnt += (c > 0u) ? 1u : 0u; mine = (j == x) ? c : mine; }
        if (sum == G) break;
        __builtin_amdgcn_s_sleep(1);
        if ((++sp & 255u) == 0u) { if (xb_ld(&bar[XB_TMO])) break; if (sp > XB_SPIN_CAP) { atomicAdd(&bar[XB_TMO], 1u); break; } }
    }
    nloc = mine > 0u ? mine : 1u; nx = cnt > 0u ? cnt : 1u;
}
__device__ __forceinline__ void xcd_barrier(const XcdBarrier& b) {
    asm volatile("s_waitcnt vmcnt(0)" ::: "memory");
    __syncthreads();
    if (b.wave == 0 && lane_id() == 0) {
        unsigned* bar = b.bar;
        __builtin_amdgcn_s_waitcnt(0);
        unsigned nloc = b.st[0], nx = b.st[1];
        if (nloc == 0u) { xcd_barrier_complete(bar, b.x, nloc, nx); b.st[0] = nloc; b.st[1] = nx; }
        const unsigned old = xb_add(&bar[XB_XSUB(b.x)], 1u);
        const unsigned gen = old / nloc;
        if (old + 1u == (gen + 1u) * nloc) {
            __builtin_amdgcn_fence(__ATOMIC_RELEASE, "agent");
            asm volatile("s_waitcnt vmcnt(0)" ::: "memory");
            const unsigned og = xb_add(&bar[XB_TOP], 1u);
            const unsigned tg = og / nx;
            if (og + 1u == (tg + 1u) * nx) xb_add(&bar[XB_TOPGEN], 1u);
            else XB_SPIN(xb_ld(&bar[XB_TOPGEN]) == tg, bar);
            __builtin_amdgcn_fence(__ATOMIC_ACQUIRE, "agent");
            xb_add(&bar[XB_XGEN(b.x)], 1u);
            asm volatile("s_waitcnt vmcnt(0)" ::: "memory");
        } else {
            XB_SPIN(xb_ld(&bar[XB_XGEN(b.x)]) == gen, bar);
            __builtin_amdgcn_fence(__ATOMIC_ACQUIRE, "agent");
            asm volatile("s_waitcnt vmcnt(0)" ::: "memory");
        }
    }
    __syncthreads();
}

typedef float f32x16 __attribute__((ext_vector_type(16)));
__device__ __forceinline__ int pi32(int i) { return (i & ~12) | ((i & 4) << 1) | ((i & 8) >> 1); }
__device__ __forceinline__ f32x16 zero16() { f32x16 z;
#pragma unroll
    for (int r = 0; r < 16; ++r) z[r] = 0.f;
    return z; }

__device__ __forceinline__ void xattn_phase(LAS unsigned char* lds, const bf16_t* Q, const bf16_t* Kb, const bf16_t* VT, unsigned char* O, int G, int bx, int wave) {
    const int lane = lane_id(), i = lane & 31, hh = lane >> 5;
    LAS unsigned char* ring = lds;
    bf16x8 qf[16];
#define XA_QLOAD(uid_) do { const int u_ = (uid_); const bf16_t* qp_ = Q + (size_t)((u_ >> 5) * SEQ + (u_ & 7) * 256 + wave * 32 + i) * 1024 + ((u_ >> 3) & 3) * 256 + 8 * hh; \
        _Pragma("unroll") for (int ds = 0; ds < 16; ++ds) qf[ds] = *(const bf16x8*)(qp_ + 16 * ds); } while (0)
    if (bx < BATCH * 4 * 8) XA_QLOAD(bx);
    for (int uid = bx; uid < BATCH * 4 * 8; uid += G) {
        const int b = uid >> 5, h = (uid >> 3) & 3, qblk = uid & 7;
        const int q0 = qblk * 256 + wave * 32;
        const bf16_t* ksrc = Kb + (size_t)(b * MEMLEN + pi32(i)) * 1024 + h * 256 + 16 * wave + 8 * hh;
        const bf16_t* vsrc = VT + (size_t)(h * 256 + i) * MROWS + b * MEMLEN + 32 * (wave >> 1) + 16 * (wave & 1) + 8 * hh;
#define XA_ISSUE(st_) do { LAS unsigned char* sl_ = ring + ((st_) & 3) * 16384; \
        if ((st_) < 8) { const bf16_t* g_ = ksrc + (size_t)(st_) * 32 * 1024; \
            __builtin_amdgcn_global_load_lds((const unsigned*)g_, (LAS unsigned*)(sl_ + wave * 1024), 16, 0, 0); \
            __builtin_amdgcn_global_load_lds((const unsigned*)(g_ + 128), (LAS unsigned*)(sl_ + (8 + wave) * 1024), 16, 0, 0); } \
        else { const bf16_t* g_ = vsrc + (size_t)((st_) - 8) * 32 * MROWS; \
            __builtin_amdgcn_global_load_lds((const unsigned*)g_, (LAS unsigned*)(sl_ + wave * 1024), 16, 0, 0); \
            __builtin_amdgcn_global_load_lds((const unsigned*)(g_ + 128), (LAS unsigned*)(sl_ + (8 + wave) * 1024), 16, 0, 0); } } while (0)
#define XA_VMCNT(n) (((n) & 15) | (7 << 4) | (15 << 8) | (((n) >> 4) << 14))
#define XA_SYNC(st_) do { const int n_ = ((st_) >= 11 ? 1 : 0) + ((st_) <= 14 ? 2 : 0) + ((st_) >= 10 ? 1 : 0) + ((st_) <= 13 ? 2 : 0) + ((st_) >= 9 ? 1 : 0) + (((st_) >= 8 && (st_) <= 10) ? 16 : 0); \
          \
        asm volatile("" ::: "memory"); \
        if (n_ == 3) __builtin_amdgcn_s_waitcnt(XA_VMCNT(3)); else if (n_ == 4) __builtin_amdgcn_s_waitcnt(XA_VMCNT(4)); else if (n_ == 5) __builtin_amdgcn_s_waitcnt(XA_VMCNT(5)); \
        else if (n_ == 20) __builtin_amdgcn_s_waitcnt(XA_VMCNT(20)); else if (n_ == 21) __builtin_amdgcn_s_waitcnt(XA_VMCNT(21)); else if (n_ == 22) __builtin_amdgcn_s_waitcnt(XA_VMCNT(22)); \
        else __builtin_amdgcn_s_waitcnt(XA_VMCNT(7)); \
        asm volatile("" ::: "memory"); \
        __builtin_amdgcn_s_barrier(); asm volatile("" ::: "memory"); if ((st_) + 3 < 16) XA_ISSUE((st_) + 3); } while (0)
        XA_ISSUE(0); XA_ISSUE(1); XA_ISSUE(2);
        f32x16 s[8];
#pragma unroll
        for (int kt = 0; kt < 8; ++kt) { XA_SYNC(kt);
            const LAS unsigned char* sl = ring + (kt & 3) * 16384 + lane * 16;
            f32x16 acc = zero16();
#pragma unroll
            for (int q4 = 0; q4 < 4; ++q4) { __builtin_amdgcn_sched_barrier(0);
#pragma unroll
                for (int d4 = 0; d4 < 4; ++d4) { const int ds = q4 * 4 + d4; acc = __builtin_amdgcn_mfma_f32_32x32x16_bf16(*(const LAS bf16x8*)(sl + ds * 1024), qf[ds], acc, 0, 0, 0); } }
            s[kt] = acc; }
        float m = -INFINITY;
#pragma unroll
        for (int kt = 0; kt < 8; ++kt)
#pragma unroll
            for (int r = 0; r < 16; ++r) m = fmaxf(m, s[kt][r]);
        m = x32_max(m);
        const float c = 0.0625f * 1.4426950408889634f; float l = 0.f; const float mc = m * c;
        u32x4 pf[8][2];
#pragma unroll
        for (int kt = 0; kt < 8; ++kt) {
#pragma unroll
            for (int r = 0; r < 16; ++r) { const float p = __builtin_amdgcn_exp2f(s[kt][r] * c - mc); s[kt][r] = p; l += p; }
#pragma unroll
            for (int sb = 0; sb < 2; ++sb) { pf[kt][sb].x = cvt_pk_bf16(s[kt][8 * sb + 0], s[kt][8 * sb + 1]); pf[kt][sb].y = cvt_pk_bf16(s[kt][8 * sb + 2], s[kt][8 * sb + 3]);
                pf[kt][sb].z = cvt_pk_bf16(s[kt][8 * sb + 4], s[kt][8 * sb + 5]); pf[kt][sb].w = cvt_pk_bf16(s[kt][8 * sb + 6], s[kt][8 * sb + 7]); } }
        l = x32_sum(l);
        const float il = 1.0f / l;
        XA_QLOAD(uid + G < BATCH * 4 * 8 ? uid + G : uid);
        unsigned char* op = O + (size_t)(b * SEQ + q0 + i) * 1024 + h * 256 + 16 * hh;
#pragma unroll
        for (int dvt = 0; dvt < 8; ++dvt) { XA_SYNC(8 + dvt);
            const LAS unsigned char* sl = ring + (dvt & 3) * 16384 + lane * 16;
            f32x16 oacc = zero16();
#pragma unroll
            for (int q4 = 0; q4 < 4; ++q4) { __builtin_amdgcn_sched_barrier(0);
#pragma unroll
                for (int f4 = 0; f4 < 4; ++f4) { const int f = q4 * 4 + f4; oacc = __builtin_amdgcn_mfma_f32_32x32x16_bf16(*(const LAS bf16x8*)(sl + f * 1024), __builtin_bit_cast(bf16x8, pf[f >> 1][f & 1]), oacc, 0, 0, 0); } }
            unsigned wg[4];
#pragma unroll
            for (int g = 0; g < 4; ++g) { unsigned w = 0u; w = __builtin_amdgcn_cvt_pk_fp8_f32(c8(oacc[4 * g] * il), c8(oacc[4 * g + 1] * il), w, false); w = __builtin_amdgcn_cvt_pk_fp8_f32(c8(oacc[4 * g + 2] * il), c8(oacc[4 * g + 3] * il), w, true); wg[g] = w; }
            { const auto s02 = __builtin_amdgcn_permlane32_swap(wg[0], wg[2], false, false), s13 = __builtin_amdgcn_permlane32_swap(wg[1], wg[3], false, false);
              *(u32x4*)(op + dvt * 32) = (u32x4){s02[0], s02[1], s13[0], s13[1]}; } }
#undef XA_ISSUE
#undef XA_SYNC
    }
}

__device__ __forceinline__ void diffattn_phase(LAS unsigned char* lds, LAS float* dgl, const bf16_t* P2, const bf16_t* VT, const float* dng, const float lam, bf16_t* cat, int G, int vx, int wave) {
    const int lane = lane_id(), i_ = lane & 31, hh_ = lane >> 5;
    dgl[wave * 64 + lane] = dng[wave * 64 + lane];
    __syncthreads();
    LAS unsigned char* ring = lds;
    LAS unsigned char* ql = lds + 65536 + wave * 8192 + lane * 16;
    const float c = 0.125f * 1.4426950408889634f;
    for (int pu = vx; pu < BATCH * 4 * 4; pu += G)
        for (int side = 0; side < 2; ++side) {
            const int bh = pu >> 2, x = pu & 3, qb = side ? 7 - x : x, b = bh >> 2, h = bh & 3, q0 = qb * 256 + wave * 32;
            const int ntile = 8 * qb + 8, ktw = 8 * qb + wave;
            int i = i_, hh = hh_; asm volatile("" : "+v"(i), "+v"(hh));
            const bf16_t* qp = P2 + (size_t)(b * SEQ + q0 + i) * NP2 + h * 128 + 8 * hh;
            { bf16x8 t[8];
#pragma unroll
              for (int f = 0; f < 8; ++f) t[f] = *(const bf16x8*)(qp + 16 * f);
#pragma unroll
              for (int f = 0; f < 8; ++f) *(LAS bf16x8*)(ql + f * 1024) = t[f]; }
            const char* kbase = (const char*)(P2 + (size_t)b * SEQ * NP2 + 512 + h * 128 + (wave >> 2) * 64 + 16 * (wave & 3));
            const char* vbase = (const char*)(VT + (size_t)(h * 128 + 32 * (wave >> 1)) * T + (size_t)b * SEQ + 16 * (wave & 1));
            const unsigned koff = (unsigned)(pi32(i) * NP2 + 8 * hh) * 2u, voff = (unsigned)(i * T + 8 * hh) * 2u;
#define DA_ISSUE(kt_) do { LAS unsigned char* sl_ = ring + ((kt_) & 3) * 16384; \
        __builtin_amdgcn_global_load_lds((const unsigned*)(kbase + (size_t)(kt_) * (32 * NP2 * 2) + koff), (LAS unsigned*)(sl_ + wave * 1024), 16, 0, 0); \
        __builtin_amdgcn_global_load_lds((const unsigned*)(vbase + (kt_) * 64 + voff), (LAS unsigned*)(sl_ + (8 + wave) * 1024), 16, 0, 0); } while (0)
            f32x16 o1[4], o2[4];
#pragma unroll
            for (int d = 0; d < 4; ++d) { o1[d] = zero16(); o2[d] = zero16(); }
            float mc1 = -INFINITY, mc2 = -INFINITY, l1 = 0.f, l2 = 0.f;
            u32x4 pp1[2], pp2[2];
#pragma unroll
            for (int sb = 0; sb < 2; ++sb) { pp1[sb] = (u32x4){0u, 0u, 0u, 0u}; pp2[sb] = pp1[sb]; }
            DA_ISSUE(0); DA_ISSUE(1);
            for (int kt = 0; kt <= ntile; ++kt) {
                if (kt < ntile) {
                    if (kt + 1 < ntile) asm volatile("s_waitcnt vmcnt(2)" ::: "memory"); else asm volatile("s_waitcnt vmcnt(0)" ::: "memory");
                    __builtin_amdgcn_s_barrier(); asm volatile("" ::: "memory");
                    if (kt + 2 < ntile) DA_ISSUE(kt + 2);
                }
                if (kt <= ktw + 1) {
                    const LAS unsigned char* sl = ring + (kt & 3) * 16384 + lane * 16;
                    const LAS unsigned char* sp = ring + ((kt == 0 ? 0 : kt - 1) & 3) * 16384 + lane * 16;
                    f32x16 s1 = zero16(), s2 = zero16();
#pragma unroll
                    for (int ds = 0; ds < 4; ++ds) { s1 = __builtin_amdgcn_mfma_f32_32x32x16_bf16(*(const LAS bf16x8*)(sl + ds * 1024), *(const LAS bf16x8*)(ql + ds * 1024), s1, 0, 0, 0);
                        s2 = __builtin_amdgcn_mfma_f32_32x32x16_bf16(*(const LAS bf16x8*)(sl + (4 + ds) * 1024), *(const LAS bf16x8*)(ql + (4 + ds) * 1024), s2, 0, 0, 0);
                        if (ds & 1) __builtin_amdgcn_sched_barrier(0); }
                    if (kt >= ktw) { const int lim = (kt == ktw) ? i : -1;
#pragma unroll
                        for (int r = 0; r < 16; ++r) { const int ko = 16 * (r >> 3) + 8 * hh + (r & 7); if (ko > lim) { s1[r] = -INFINITY; s2[r] = -INFINITY; } } }
                    float f1 = 1.f, f2 = 1.f; bool rs1, rs2;
                    { float tm = s1[0];
#pragma unroll
                      for (int r = 1; r < 16; ++r) tm = fmaxf(tm, s1[r]);
                      tm = x32_max(tm); const float tmc = tm * c; rs1 = __any(tmc > mc1 + 8.0f);
                      if (rs1) { const float mn = fmaxf(mc1, tmc); f1 = __builtin_amdgcn_exp2f(mc1 - mn); mc1 = mn; } }
                    { float tm = s2[0];
#pragma unroll
                      for (int r = 1; r < 16; ++r) tm = fmaxf(tm, s2[r]);
                      tm = x32_max(tm); const float tmc = tm * c; rs2 = __any(tmc > mc2 + 8.0f);
                      if (rs2) { const float mn = fmaxf(mc2, tmc); f2 = __builtin_amdgcn_exp2f(mc2 - mn); mc2 = mn; } }
                    float ls1 = 0.f, ls2 = 0.f; u32x4 pn1[2], pn2[2];
#define DA_SM(j) do { { const float pv_ = __builtin_amdgcn_exp2f(s1[j] * c - mc1); s1[j] = pv_; ls1 += pv_; } { const float pv_ = __builtin_amdgcn_exp2f(s2[j] * c - mc2); s2[j] = pv_; ls2 += pv_; } \
                        if ((j) & 1) { pn1[(j) >> 3][((j) & 7) >> 1] = cvt_pk_bf16(s1[(j) - 1], s1[j]); pn2[(j) >> 3][((j) & 7) >> 1] = cvt_pk_bf16(s2[(j) - 1], s2[j]); } } while (0)
                    { bf16x8 va, vb;
#define DA_VLD(p) (*(const LAS bf16x8*)(sp + (8 + ((p) & 3) * 2 + ((p) >> 2)) * 1024))
#define DA_SLOT(j, VF, LDNEXT) do { if ((j) & 1) o2[((j) >> 1) & 3] = __builtin_amdgcn_mfma_f32_32x32x16_bf16(VF, __builtin_bit_cast(bf16x8, pp2[(j) >> 3]), o2[((j) >> 1) & 3], 0, 0, 0); \
                            else o1[((j) >> 1) & 3] = __builtin_amdgcn_mfma_f32_32x32x16_bf16(VF, __builtin_bit_cast(bf16x8, pp1[(j) >> 3]), o1[((j) >> 1) & 3], 0, 0, 0); \
                            LDNEXT; DA_SM(j); __builtin_amdgcn_sched_barrier(0); } while (0)
                      va = DA_VLD(0);
                      __builtin_amdgcn_sched_barrier(0);
                      DA_SLOT(0, va, vb = DA_VLD(1)); DA_SLOT(1, va, (void)0); DA_SLOT(2, vb, va = DA_VLD(2)); DA_SLOT(3, vb, (void)0);
                      DA_SLOT(4, va, vb = DA_VLD(3)); DA_SLOT(5, va, (void)0); DA_SLOT(6, vb, va = DA_VLD(4)); DA_SLOT(7, vb, (void)0);
                      DA_SLOT(8, va, vb = DA_VLD(5)); DA_SLOT(9, va, (void)0); DA_SLOT(10, vb, va = DA_VLD(6)); DA_SLOT(11, vb, (void)0);
                      DA_SLOT(12, va, vb = DA_VLD(7)); DA_SLOT(13, va, (void)0); DA_SLOT(14, vb, (void)0); DA_SLOT(15, vb, (void)0);
#undef DA_VLD
#undef DA_SLOT
                    }
#undef DA_SM
                    l1 = l1 * f1 + ls1; l2 = l2 * f2 + ls2;
                    if (rs1) {
#pragma unroll
                        for (int d = 0; d < 4; ++d)
#pragma unroll
                            for (int r = 0; r < 16; ++r) o1[d][r] *= f1; }
                    if (rs2) {
#pragma unroll
                        for (int d = 0; d < 4; ++d)
#pragma unroll
                            for (int r = 0; r < 16; ++r) o2[d][r] *= f2; }
#pragma unroll
                    for (int sb = 0; sb < 2; ++sb) { pp1[sb] = pn1[sb]; pp2[sb] = pn2[sb]; }
                }
            }
#undef DA_ISSUE
            l1 = x32_sum(l1); l2 = x32_sum(l2);
            int ie = i, he = hh; asm volatile("" : "+v"(ie), "+v"(he));
            const float i1 = 1.0f / l1, i2 = lam / l2; float ss = 0.f;
#pragma unroll
            for (int d = 0; d < 4; ++d)
#pragma unroll
                for (int r = 0; r < 16; ++r) { const float o = o1[d][r] * i1 - o2[d][r] * i2; o1[d][r] = o; ss += o * o; }
            ss = x32_sum(ss);
            const float rn = rsqrtf(ss * (1.0f / 128.0f) + EPS) * (1.0f - LAMBDA_INIT);
            bf16_t* op = cat + (size_t)(b * SEQ + q0 + ie) * DM + h * 128 + 8 * he;
            const LAS float* gp = dgl + h * 128 + 4 * he;
#pragma unroll
            for (int d = 0; d < 4; ++d)
#pragma unroll
                for (int g2 = 0; g2 < 2; ++g2) { u32x2 w[2];
#pragma unroll
                    for (int q = 0; q < 2; ++q) { const int g = 2 * g2 + q; const f32x4 gv = *(const LAS f32x4*)(gp + d * 32 + 8 * g);
                        w[q].x = cvt_pk_bf16(o1[d][4 * g] * rn * gv[0], o1[d][4 * g + 1] * rn * gv[1]); w[q].y = cvt_pk_bf16(o1[d][4 * g + 2] * rn * gv[2], o1[d][4 * g + 3] * rn * gv[3]); }
                    const auto sa = __builtin_amdgcn_permlane32_swap(w[0].x, w[1].x, false, false), sb = __builtin_amdgcn_permlane32_swap(w[0].y, w[1].y, false, false);
                    *(u32x4*)(op + d * 32 + 16 * g2) = (u32x4){sa[0], sb[0], sa[1], sb[1]}; }
        }
}

__device__ __forceinline__ void mlstm_prep_phase(LAS unsigned char* lds, const bf16_t* P2, const bf16_t* VT, const float* gates, const float* conv_w, const float* conv_b,
                                                 bf16_t* QM, bf16_t* KM, float* BC, float* AV, float* AM, float* CH, float* NLOC, float* CLOC, int G, int vx, int wave) {
    const int lane = lane_id(), i = lane & 31, hh = lane >> 5;
    LAS unsigned char* kl = lds + wave * 16384;
    for (int task = vx * 8 + wave; task < BATCH * 4 * 16; task += G * 8) {
        const int bh = task >> 4, c = task & 15, b = bh >> 2, h = bh & 3;
        const int t0 = b * SEQ + c * 128, tA = t0 + 2 * lane;
        const float lf0 = gates[(size_t)tA * 8 + 4 + h], lf1 = gates[(size_t)(tA + 1) * 8 + 4 + h], ig0 = gates[(size_t)tA * 8 + h], ig1 = gates[(size_t)(tA + 1) * 8 + h];
        float incl = lf0 + lf1;
#pragma unroll
        for (int off = 1; off < 64; off <<= 1) { const float v = __shfl_up(incl, off); if (lane >= off) incl += v; }
        const float bc1 = incl, bc0 = incl - lf1, blast = __shfl(incl, 63);
        const float a0 = ig0 - bc0, a1 = ig1 - bc1;
        float pm = fmaxf(a0, a1);
#pragma unroll
        for (int off = 1; off < 64; off <<= 1) { const float v = __shfl_up(pm, off); if (lane >= off) pm = fmaxf(pm, v); }
        const float pmprev = __shfl_up(pm, 1);
        const float am1 = pm, am0 = (lane > 0) ? fmaxf(pmprev, a0) : a0, amall = __shfl(pm, 63);
        const float ws0 = __expf(a0 - amall), ws1 = __expf(a1 - amall);
        *(f32x2*)(BC + (size_t)h * T + tA) = (f32x2){bc0, bc1};
        *(f32x2*)(AV + (size_t)h * T + tA) = (f32x2){a0, a1};
        *(f32x2*)(AM + (size_t)h * T + tA) = (f32x2){am0, am1};
        if (lane == 0) { CH[task * 2] = blast; CH[task * 2 + 1] = blast + amall; }
        {
            const int r8 = lane >> 3, cg = lane & 7;
            float cw[2][5][8];
#pragma unroll
            for (int part = 0; part < 2; ++part) { const int ch0 = (part ? 256 : 0) + h * 64 + 8 * cg;
#pragma unroll
                for (int k = 0; k < 4; ++k) { const f32x4 a = *(const f32x4*)(conv_w + k * 512 + ch0), bq = *(const f32x4*)(conv_w + k * 512 + ch0 + 4);
#pragma unroll
                    for (int j = 0; j < 4; ++j) { cw[part][k][j] = a[j]; cw[part][k][4 + j] = bq[j]; } }
                { const f32x4 a = *(const f32x4*)(conv_b + ch0), bq = *(const f32x4*)(conv_b + ch0 + 4);
#pragma unroll
                    for (int j = 0; j < 4; ++j) { cw[part][4][j] = a[j]; cw[part][4][4 + j] = bq[j]; } } }
#pragma unroll 4
            for (int jb = 0; jb < 16; ++jb) {
                const int p = 8 * jb + r8, tg = t0 + p, tseq = c * 128 + p;
                const float wa = __shfl(ws0, p >> 1), wb = __shfl(ws1, p >> 1); const float wsp = (p & 1) ? wb : wa;
                u32x4 uw[2][4];
#pragma unroll
                for (int part = 0; part < 2; ++part)
#pragma unroll
                    for (int k = 0; k < 4; ++k) { uw[part][k] = (u32x4){0u, 0u, 0u, 0u};
                        if (tseq - 3 + k >= 0) uw[part][k] = *(const u32x4*)(P2 + (size_t)(tg - 3 + k) * NP2 + 1024 + (part ? 256 : 0) + h * 64 + 8 * cg); }
#pragma unroll
                for (int part = 0; part < 2; ++part) { float y[8];
#pragma unroll
                    for (int j = 0; j < 8; ++j) { float pj = cw[part][4][j];
#pragma unroll
                        for (int k = 0; k < 4; ++k) { const unsigned wv = (j < 2) ? uw[part][k].x : (j < 4) ? uw[part][k].y : (j < 6) ? uw[part][k].z : uw[part][k].w; pj += cw[part][k][j] * ((j & 1) ? hi_bf(wv) : lo_bf(wv)); }
                        y[j] = pj * __builtin_amdgcn_rcpf(1.0f + __expf(-pj)); }
                    if (part == 0) { u32x4 w; w.x = cvt_pk_bf16(y[0] * 0.125f, y[1] * 0.125f); w.y = cvt_pk_bf16(y[2] * 0.125f, y[3] * 0.125f); w.z = cvt_pk_bf16(y[4] * 0.125f, y[5] * 0.125f); w.w = cvt_pk_bf16(y[6] * 0.125f, y[7] * 0.125f);
                        *(u32x4*)(QM + (size_t)tg * 256 + h * 64 + 8 * cg) = w; }
                    else { u32x4 w; w.x = cvt_pk_bf16(y[0], y[1]); w.y = cvt_pk_bf16(y[2], y[3]); w.z = cvt_pk_bf16(y[4], y[5]); w.w = cvt_pk_bf16(y[6], y[7]);
                        *(u32x4*)(KM + (size_t)tg * 256 + h * 64 + 8 * cg) = w;
#pragma unroll
                        for (int j = 0; j < 8; ++j) { const int d = 8 * cg + j;
                            *(LAS unsigned short*)(kl + d * 256 + ((jb ^ (d & 15)) * 16) + r8 * 2) = (unsigned short)f2bf(y[j] * wsp); } } }
            }
        }
        { float ns = 0.f;
#pragma unroll
          for (int cq = 0; cq < 16; ++cq) { const u32x4 w = *(const LAS u32x4*)(kl + lane * 256 + ((cq ^ (lane & 15)) * 16));
              ns += (lo_bf(w.x) + hi_bf(w.x)) + (lo_bf(w.y) + hi_bf(w.y)) + (lo_bf(w.z) + hi_bf(w.z)) + (lo_bf(w.w) + hi_bf(w.w)); }
          NLOC[(size_t)task * 64 + lane] = ns; }
        f32x16 acc[4][2];
#pragma unroll
        for (int et = 0; et < 4; ++et) { acc[et][0] = zero16(); acc[et][1] = zero16(); }
        const bf16_t* vp = VT + (size_t)(512 + h * 128 + i) * T + t0 + 8 * hh;
#pragma unroll
        for (int k2 = 0; k2 < 8; k2 += 2) {
            bf16x8 af[2][4];
#pragma unroll
            for (int q = 0; q < 2; ++q)
#pragma unroll
                for (int et = 0; et < 4; ++et) af[q][et] = *(const bf16x8*)(vp + (size_t)et * 32 * T + 16 * (k2 + q));
            __builtin_amdgcn_sched_barrier(0);
#pragma unroll
            for (int q = 0; q < 2; ++q) { const int ks = k2 + q; bf16x8 bfr[2];
#pragma unroll
                for (int dt = 0; dt < 2; ++dt) { const int d = 32 * dt + i; bfr[dt] = *(const LAS bf16x8*)(kl + d * 256 + (((2 * ks + hh) ^ (d & 15)) * 16)); }
#pragma unroll
                for (int et = 0; et < 4; ++et) {
                    acc[et][0] = __builtin_amdgcn_mfma_f32_32x32x16_bf16(af[q][et], bfr[0], acc[et][0], 0, 0, 0); acc[et][1] = __builtin_amdgcn_mfma_f32_32x32x16_bf16(af[q][et], bfr[1], acc[et][1], 0, 0, 0); } }
            __builtin_amdgcn_sched_barrier(0);
        }
        float* cp = CLOC + (size_t)task * 8192 + i + 256 * hh;
#pragma unroll
        for (int et = 0; et < 4; ++et)
#pragma unroll
            for (int dt = 0; dt < 2; ++dt)
#pragma unroll
                for (int r = 0; r < 16; ++r) cp[(32 * et + (r & 3) + 8 * (r >> 2)) * 64 + 32 * dt] = acc[et][dt][r];
    }
}
__device__ __forceinline__ void mlstm_scan_phase(const float* CLOC, const float* NLOC, const float* CH, bf16_t* CSTB, float* NST, float* MSTATE, int G, int bx, int tid) {
    for (int idx = bx * 512 + tid; idx < BATCH * 4 * 1024; idx += G * 512) {
        const int bh = idx >> 10, rem = idx & 1023, e = rem >> 3, d0 = (rem & 7) * 8;
        float C[8], nr[8]; float m = 0.f;
#pragma unroll
        for (int j = 0; j < 8; ++j) { C[j] = 0.f; nr[j] = 0.f; }
#pragma unroll 1
        for (int c8 = 0; c8 < 16; c8 += 8) {
            f32x4 cl[8][2], nl[8][2]; float bl[8], ml[8];
#pragma unroll
            for (int q = 0; q < 8; ++q) { const int task = bh * 16 + c8 + q;
                cl[q][0] = *(const f32x4*)(CLOC + (size_t)task * 8192 + e * 64 + d0); cl[q][1] = *(const f32x4*)(CLOC + (size_t)task * 8192 + e * 64 + d0 + 4);
                bl[q] = CH[task * 2]; ml[q] = CH[task * 2 + 1];
                if (rem < 8) { nl[q][0] = *(const f32x4*)(NLOC + (size_t)task * 64 + rem * 8); nl[q][1] = *(const f32x4*)(NLOC + (size_t)task * 64 + rem * 8 + 4); }
                else { nl[q][0] = (f32x4){0.f, 0.f, 0.f, 0.f}; nl[q][1] = nl[q][0]; } }
#pragma unroll
            for (int q = 0; q < 8; ++q) { const int task = bh * 16 + c8 + q;
                u32x4 w; w.x = cvt_pk_bf16(C[0], C[1]); w.y = cvt_pk_bf16(C[2], C[3]); w.z = cvt_pk_bf16(C[4], C[5]); w.w = cvt_pk_bf16(C[6], C[7]);
                *(u32x4*)(CSTB + (size_t)task * 8192 + e * 64 + d0) = w;
                if (rem < 8) { *(f32x4*)(NST + (size_t)task * 64 + rem * 8) = (f32x4){nr[0], nr[1], nr[2], nr[3]}; *(f32x4*)(NST + (size_t)task * 64 + rem * 8 + 4) = (f32x4){nr[4], nr[5], nr[6], nr[7]}; }
                if (rem == 0) MSTATE[task] = m;
                const float mn = fmaxf(bl[q] + m, ml[q]), a = __expf(bl[q] + m - mn), bco = __expf(ml[q] - mn);
#pragma unroll
                for (int j = 0; j < 4; ++j) { C[j] = a * C[j] + bco * cl[q][0][j]; C[4 + j] = a * C[4 + j] + bco * cl[q][1][j]; nr[j] = a * nr[j] + bco * nl[q][0][j]; nr[4 + j] = a * nr[4 + j] + bco * nl[q][1][j]; }
                m = mn; }
        }
    }
}
__device__ __forceinline__ void mlstm_out_phase(LAS unsigned char* lds, const bf16_t* P2, const bf16_t* VT, const bf16_t* QM, const bf16_t* KM, const float* BC, const float* AV, const float* AM,
                                                const bf16_t* CSTB, const float* NST, const float* MSTATE, const float* mng, bf16_t* cat, int G, int vx, int wave) {
    const int lane_ = lane_id();
    const int cw = wave >> 2, tq = wave & 3;
    LAS unsigned char* reg = lds + cw * 65536;
    for (int un = vx; un < BATCH * 4 * 8; un += G) {
        int lane = lane_; asm volatile("" : "+v"(lane));
        const int i = lane & 31, hh = lane >> 5;
        const int task = 2 * un + cw, bh = task >> 4, c = task & 15, b = bh >> 2, h = bh & 3;
        const int t0 = b * SEQ + c * 128;
        { const bf16_t* ks = KM + (size_t)(t0 + 32 * tq + pi32(i)) * 256 + h * 64 + 8 * hh;
          const bf16_t* cs = CSTB + (size_t)task * 8192 + (32 * tq + i) * 64 + 8 * hh;
          const bf16_t* vs = VT + (size_t)(512 + h * 128 + 32 * tq + i) * T + t0 + 8 * hh;
#pragma unroll
          for (int ds = 0; ds < 4; ++ds) { __builtin_amdgcn_global_load_lds((const unsigned*)(ks + 16 * ds), (LAS unsigned*)(reg + (tq * 4 + ds) * 1024), 16, 0, 0);
              __builtin_amdgcn_global_load_lds((const unsigned*)(cs + 16 * ds), (LAS unsigned*)(reg + 16384 + (tq * 4 + ds) * 1024), 16, 0, 0); }
#pragma unroll
          for (int k8 = 0; k8 < 8; ++k8) __builtin_amdgcn_global_load_lds((const unsigned*)(vs + 16 * k8), (LAS unsigned*)(reg + 32768 + (tq * 8 + k8) * 1024), 16, 0, 0); }
        const float m_c = MSTATE[task];
        const int tg = t0 + 32 * tq + i;
        const float bct = BC[(size_t)h * T + tg], amt = AM[(size_t)h * T + tg];
        bf16x8 qf[4];
#pragma unroll
        for (int ds = 0; ds < 4; ++ds) qf[ds] = *(const bf16x8*)(QM + (size_t)tg * 256 + h * 64 + 16 * ds + 8 * hh);
        float qn = 0.f;
#pragma unroll
        for (int ds = 0; ds < 4; ++ds) { const f32x4 n0 = *(const f32x4*)(NST + (size_t)task * 64 + 16 * ds + 8 * hh), n1 = *(const f32x4*)(NST + (size_t)task * 64 + 16 * ds + 8 * hh + 4);
            const u32x4 w = __builtin_bit_cast(u32x4, qf[ds]);
            qn += lo_bf(w.x) * n0[0] + hi_bf(w.x) * n0[1] + lo_bf(w.y) * n0[2] + hi_bf(w.y) * n0[3] + lo_bf(w.z) * n1[0] + hi_bf(w.z) * n1[1] + lo_bf(w.w) * n1[2] + hi_bf(w.w) * n1[3]; }
        qn = x32_sum(qn);
        const float M = fmaxf(m_c, amt), g = __expf(m_c - M), emt = __expf(-(bct + M));
        const bf16_t* mop = P2 + (size_t)tg * NP2 + 1536 + h * 128 + 4 * hh;
        u32x2 mov[4][4];
#pragma unroll
        for (int et = 0; et < 4; ++et)
#pragma unroll
            for (int g4 = 0; g4 < 4; ++g4) mov[et][g4] = *(const u32x2*)(mop + et * 32 + 8 * g4);
        asm volatile("s_waitcnt vmcnt(0)" ::: "memory"); __builtin_amdgcn_s_barrier(); asm volatile("" ::: "memory");
        const LAS unsigned char* rl = reg + lane * 16;
        f32x16 acc[4];
#pragma unroll
        for (int et = 0; et < 4; ++et) { acc[et] = zero16();
#pragma unroll
            for (int ds = 0; ds < 4; ++ds) acc[et] = __builtin_amdgcn_mfma_f32_32x32x16_bf16(*(const LAS bf16x8*)(rl + 16384 + (et * 4 + ds) * 1024), qf[ds], acc[et], 0, 0, 0);
#pragma unroll
            for (int r = 0; r < 16; ++r) acc[et][r] *= g; }
        float wsum = 0.f;
        for (int kt = 0; kt <= tq; ++kt) {
            f32x16 sc = zero16();
#pragma unroll
            for (int ds = 0; ds < 4; ++ds) sc = __builtin_amdgcn_mfma_f32_32x32x16_bf16(*(const LAS bf16x8*)(rl + (kt * 4 + ds) * 1024), qf[ds], sc, 0, 0, 0);
            const float* ap = AV + (size_t)h * T + t0 + 32 * kt + 8 * hh;
            const f32x4 a00 = *(const f32x4*)(ap), a01 = *(const f32x4*)(ap + 4), a10 = *(const f32x4*)(ap + 16), a11 = *(const f32x4*)(ap + 20);
#pragma unroll
            for (int r = 0; r < 16; ++r) { const float av = (r < 4) ? a00[r & 3] : (r < 8) ? a01[r & 3] : (r < 12) ? a10[r & 3] : a11[r & 3];
                const int ko = 16 * (r >> 3) + 8 * hh + (r & 7);
                float w = sc[r] * __expf(av - M);
                w = (kt == tq && ko > i) ? 0.f : w;
                sc[r] = w; wsum += w; }
            u32x4 wf[2];
#pragma unroll
            for (int sb = 0; sb < 2; ++sb) { wf[sb].x = cvt_pk_bf16(sc[8 * sb + 0], sc[8 * sb + 1]); wf[sb].y = cvt_pk_bf16(sc[8 * sb + 2], sc[8 * sb + 3]); wf[sb].z = cvt_pk_bf16(sc[8 * sb + 4], sc[8 * sb + 5]); wf[sb].w = cvt_pk_bf16(sc[8 * sb + 6], sc[8 * sb + 7]); }
#pragma unroll
            for (int et = 0; et < 4; ++et)
#pragma unroll
                for (int sb = 0; sb < 2; ++sb) acc[et] = __builtin_amdgcn_mfma_f32_32x32x16_bf16(*(const LAS bf16x8*)(rl + 32768 + (et * 8 + 2 * kt + sb) * 1024), __builtin_bit_cast(bf16x8, wf[sb]), acc[et], 0, 0, 0);
        }
        wsum = x32_sum(wsum);
        const float den = g * qn + wsum, idd = 1.0f / fmaxf(fabsf(den), emt);
        float ss = 0.f;
#pragma unroll
        for (int et = 0; et < 4; ++et)
#pragma unroll
            for (int r = 0; r < 16; ++r) { const float hv = acc[et][r] * idd; acc[et][r] = hv; ss += hv * hv; }
        ss = x32_sum(ss);
        const float rn = rsqrtf(ss * (1.0f / 128.0f) + EPS);
        bf16_t* op = cat + (size_t)tg * DM + 512 + h * 128 + 8 * hh;
        const float* gp = mng + h * 128 + 4 * hh;
#pragma unroll
        for (int et = 0; et < 4; ++et)
#pragma unroll
            for (int gq = 0; gq < 2; ++gq) { u32x2 w[2];
#pragma unroll
                for (int q = 0; q < 2; ++q) { const int g4 = 2 * gq + q; const f32x4 gv = *(const f32x4*)(gp + et * 32 + 8 * g4); const u32x2 mo = mov[et][g4];
                    const float o0 = lo_bf(mo.x), o1 = hi_bf(mo.x), o2 = lo_bf(mo.y), o3 = hi_bf(mo.y);
                    const float y0 = acc[et][4 * g4] * rn * gv[0] * __builtin_amdgcn_rcpf(1.0f + __expf(-o0)), y1 = acc[et][4 * g4 + 1] * rn * gv[1] * __builtin_amdgcn_rcpf(1.0f + __expf(-o1));
                    const float y2 = acc[et][4 * g4 + 2] * rn * gv[2] * __builtin_amdgcn_rcpf(1.0f + __expf(-o2)), y3 = acc[et][4 * g4 + 3] * rn * gv[3] * __builtin_amdgcn_rcpf(1.0f + __expf(-o3));
                    w[q].x = cvt_pk_bf16(y0, y1); w[q].y = cvt_pk_bf16(y2, y3); }
                const auto sa = __builtin_amdgcn_permlane32_swap(w[0].x, w[1].x, false, false), sb = __builtin_amdgcn_permlane32_swap(w[0].y, w[1].y, false, false);
                *(u32x4*)(op + et * 32 + 16 * gq) = (u32x4){sa[0], sb[0], sa[1], sb[1]}; }
        asm volatile("s_waitcnt lgkmcnt(0)" ::: "memory"); __builtin_amdgcn_s_barrier(); asm volatile("" ::: "memory");
    }
}

constexpr int NWAVES = 8;
constexpr int RING_BYTES = 131072;
constexpr int LDSCTL_OFF = RING_BYTES;
constexpr int LDS_BYTES = RING_BYTES + 5120;

enum Phase { PH_PREP = 0, PH_INPROJ = 1, PH_MIX0 = 2, PH_MIX1 = 3, PH_MIX2 = 4, PH_OUTPROJ = 5, PH_QKV = 6, PH_XATTN = 7, PH_COPROJ = 8, PH_ROUTER = 9, PH_G1 = 10, PH_G2 = 11, PH_COMBINE = 12, PH_END = 13 };

struct Args { const float* in[28]; float* out; unsigned char* ws; int ph_lo, ph_hi, pass_lo, pass_hi; };

struct CJob { const float* src; const float* g; unsigned char* dst; int Nsrc, k0, n0, mode, f8; float scale; };
__device__ __forceinline__ void conv_load(const CJob& j, f32x4 (&v)[2], int tid) {
    const int kk = tid >> 4, c4 = (tid & 15) * 4;
#pragma unroll
    for (int rep = 0; rep < 2; ++rep) v[rep] = *(const f32x4*)(j.src + (size_t)(j.k0 + kk + 32 * rep) * j.Nsrc + j.n0 + c4);
}
__device__ __forceinline__ void conv_put(LAS float* tile, const f32x4 (&v)[2], int tid) {
    const int kk = tid >> 4, c4 = (tid & 15) * 4;
#pragma unroll
    for (int rep = 0; rep < 2; ++rep)
#pragma unroll
        for (int q = 0; q < 4; ++q) tile[(kk + 32 * rep) * 65 + c4 + q] = v[rep][q];
}
__device__ __forceinline__ void conv_store(const LAS float* tile, const CJob& j, int tid) {
    const int n = tid >> 3, kc = tid & 7; float vals[8];
    f32x4 g0 = (f32x4){1.f, 1.f, 1.f, 1.f}, g1 = g0;
    if (j.g) { g0 = *(const f32x4*)(j.g + j.k0 + 8 * kc); g1 = *(const f32x4*)(j.g + j.k0 + 8 * kc + 4); }
#pragma unroll
    for (int q = 0; q < 8; ++q) vals[q] = tile[(8 * kc + q) * 65 + n] * (q < 4 ? g0[q & 3] : g1[q & 3]) * j.scale;
    const int sc = j.n0 + n; int drow = sc;
    if (j.mode == 1) { const int jj = sc >> 1, s = sc & 1; drow = 256 * (jj >> 7) + 128 * s + (jj & 127); }
    if (j.mode == 2) { drow = sc < 1024 ? sc : sc < 1536 ? sc + 1024 : sc < 2048 ? sc - 512 : sc < 2560 ? sc + 512 : sc - 1024; }
    if (j.f8) { unsigned w0 = 0u, w1 = 0u;
        w0 = __builtin_amdgcn_cvt_pk_fp8_f32(c8(vals[0]), c8(vals[1]), w0, false); w0 = __builtin_amdgcn_cvt_pk_fp8_f32(c8(vals[2]), c8(vals[3]), w0, true);
        w1 = __builtin_amdgcn_cvt_pk_fp8_f32(c8(vals[4]), c8(vals[5]), w1, false); w1 = __builtin_amdgcn_cvt_pk_fp8_f32(c8(vals[6]), c8(vals[7]), w1, true);
        *(u32x2*)(j.dst + (size_t)drow * 1024 + j.k0 + 8 * kc) = (u32x2){w0, w1}; }
    else { u32x4 w; w.x = cvt_pk_bf16(vals[0], vals[1]); w.y = cvt_pk_bf16(vals[2], vals[3]); w.z = cvt_pk_bf16(vals[4], vals[5]); w.w = cvt_pk_bf16(vals[6], vals[7]);
        *(u32x4*)(j.dst + ((size_t)drow * 1024 + j.k0 + 8 * kc) * 2) = w; }
}

__global__ void __launch_bounds__(NWAVES * 64, 2) fwd(Args args) {
    extern __shared__ __attribute__((aligned(16))) unsigned char lds_raw[];
    LAS unsigned char* lds = (LAS unsigned char*)lds_raw;
    volatile LAS unsigned* LCTL = (volatile LAS unsigned*)(lds + LDSCTL_OFF);
    const int wave = __builtin_amdgcn_readfirstlane(threadIdx.x >> 6);
#define lane lane_id()
#define tid (wave * 64 + lane_id())
    const int G = gridDim.x, bx = blockIdx.x;
    unsigned char* ws = args.ws;
    unsigned* ctl = (unsigned*)(ws + WS_CTL);
    const int lo = args.ph_lo, hi = args.ph_hi;
#ifndef PHMASK
#define PHMASK 0xffffff
#endif
#ifndef DUPMASK
#define DUPMASK 0x0
#endif
#define IN(k) (((PHMASK >> (k)) & 1) && lo <= (k) && (k) < hi)
#define NREP(k) ((((DUPMASK) >> (k)) & 1) ? 2 : 1)
#define ENDBAR(k) (BOTH(k) || (((DUPMASK) >> (k)) & 1))
#define BOTH(k) (IN(k) && IN((k) + 1))
    for (int u = tid; u < (LDS_BYTES - LDSCTL_OFF) / 4; u += NWAVES * 64) LCTL[u] = 0u;
    __syncthreads();
    XcdBarrier bar; bar.bar = ctl + CW_BAR; bar.x = 0; bar.st = LCTL; bar.wave = wave;
    const bool multi = (hi - lo) > 1 || (args.pass_hi - args.pass_lo) > 1 || (IN(PH_G1) && IN(PH_G2));
    if (multi) bar = xcd_barrier_post(ctl + CW_BAR, LCTL, wave);
#define GRID_BAR() xcd_barrier(bar)

    const float* x = args.in[0]; const float* mem = args.in[1];
    bf16_t* XB = (bf16_t*)(ws + WS_XB); bf16_t* PROJ = (bf16_t*)(ws + WS_PROJ); bf16_t* CAT = (bf16_t*)(ws + WS_CAT);
    bf16_t* MEMB = (bf16_t*)(ws + WS_MEMB); bf16_t* KV = (bf16_t*)(ws + WS_KV); bf16_t* VT2 = (bf16_t*)(ws + WS_VT2); bf16_t* VT1 = (bf16_t*)(ws + WS_VT1); unsigned char* H1F = ws + WS_H1F;
    bf16_t* WIN = (bf16_t*)(ws + WS_WIN); bf16_t* WOUT = (bf16_t*)(ws + WS_WOUT); bf16_t* WCQ = (bf16_t*)(ws + WS_WCQ); bf16_t* WCKV = (bf16_t*)(ws + WS_WCKV);
    bf16_t* WCO = (bf16_t*)(ws + WS_WCO); bf16_t* WR = (bf16_t*)(ws + WS_WR); unsigned char* W1F = ws + WS_W1; unsigned char* W2F = ws + WS_W2; unsigned char* H2F = ws + WS_H2F;
    float* RSTDX = (float*)(ws + WS_RSTDX); float* RSTDM = (float*)(ws + WS_RSTDM); float* B1P = (float*)(ws + WS_B1P); float* MISC = (float*)(ws + WS_MISC); float* RSTD2 = (float*)(ws + WS_RSTD2);
    float* SSP1 = (float*)(ws + WS_SSP1); float* SSP2 = (float*)(ws + WS_SSP2); float* GATES = (float*)(ws + WS_GATES);
    unsigned* TOKMAP = (unsigned*)(ws + WS_TOKMAP); float* GATEV = (float*)(ws + WS_GATEV); unsigned* LIST = (unsigned*)(ws + WS_LIST);
    unsigned char* YB = ws + WS_Y; unsigned char* HID = ws + WS_HID;

    if (IN(PH_PREP)) for (int rep_ = 0; rep_ < NREP(PH_PREP); ++rep_) {
        constexpr int J0 = 768, J1 = J0 + 256, J2 = J1 + 256, J3 = J2 + 512, J4 = J3 + 256, J5 = J4 + 16384, J6 = J5 + 8192;
        auto decode = [&](int it, CJob& j) {
            if (it < J0) { j = CJob{args.in[3], args.in[2], (unsigned char*)WIN, DIN, (it / 48) * 64, (it % 48) * 64, 2, 0, 1.0f}; }
            else if (it < J1) { const int r = it - J0; j = CJob{args.in[14], nullptr, (unsigned char*)WOUT, 1024, (r / 16) * 64, (r % 16) * 64, 0, 0, 1.0f}; }
            else if (it < J2) { const int r = it - J1; j = CJob{args.in[17], args.in[15], (unsigned char*)WCQ, 1024, (r / 16) * 64, (r % 16) * 64, 0, 1, 64.0f}; }
            else if (it < J3) { const int r = it - J2; j = CJob{args.in[18], args.in[16], (unsigned char*)WCKV, 2048, (r / 32) * 64, (r % 32) * 64, 0, 1, 64.0f}; }
            else if (it < J4) { const int r = it - J3; j = CJob{args.in[19], nullptr, (unsigned char*)WCO, 1024, (r / 16) * 64, (r % 16) * 64, 0, 1, 64.0f}; }
            else if (it < J5) { const int r = it - J4; const int e = r >> 9, q = r & 511; j = CJob{args.in[23] + (size_t)e * 1024 * 2048, args.in[20], W1F + (size_t)e * 2048 * 1024, 2048, (q / 32) * 64, (q % 32) * 64, 1, 1, 64.0f}; }
            else { const int r = it - J5; const int e = r >> 8, q = r & 255; j = CJob{args.in[25] + (size_t)e * 1024 * 1024, nullptr, W2F + (size_t)e * 1024 * 1024, 1024, (q / 16) * 64, (q % 16) * 64, 0, 1, 64.0f}; } };
        static_assert(J0 % 4 == 0 && J1 % 4 == 0 && J2 % 4 == 0 && J3 % 4 == 0 && J4 % 4 == 0 && J5 % 4 == 0 && J6 % 4 == 0, "rounds of four jobs");
#define LDS_BAR() do { asm volatile("s_waitcnt lgkmcnt(0)" ::: "memory"); __builtin_amdgcn_s_barrier(); asm volatile("" ::: "memory"); } while (0)
        { f32x4 v[8]; int it0 = bx * 4; CJob jc;
          if (it0 < J6) { decode(it0, jc);
#pragma unroll
              for (int r = 0; r < 8; ++r) v[r] = *(const f32x4*)(jc.src + (size_t)(jc.k0 + wave * 8 + r) * jc.Nsrc + jc.n0 + 4 * lane); }
          for (; it0 < J6; it0 += G * 4) {
            { LAS float* tq = (LAS float*)lds + (lane >> 4) * (64 * 65) + ((4 * lane) & 63) + (wave * 8) * 65;
#pragma unroll
              for (int r = 0; r < 8; ++r)
#pragma unroll
                  for (int q = 0; q < 4; ++q) tq[r * 65 + q] = v[r][q]; }
            LDS_BAR();
            CJob js = jc; const int nx = it0 + G * 4;
            if (nx < J6) { decode(nx, jc);
#pragma unroll
                for (int r = 0; r < 8; ++r) v[r] = *(const f32x4*)(jc.src + (size_t)(jc.k0 + wave * 8 + r) * jc.Nsrc + jc.n0 + 4 * lane); }
#pragma unroll
            for (int q = 0; q < 4; ++q) { conv_store((const LAS float*)lds + q * (64 * 65), js, tid); js.n0 += 64; }
            LDS_BAR();
          } }
        __syncthreads();
        for (int i = bx * 512 + tid; i < NEXP * 1024; i += G * 512) { const int e = i >> 10, k = i & 1023; WR[i] = (bf16_t)f2bf(args.in[21][k * NEXP + e] * args.in[20][k]); }
        for (int i = bx * 512 + tid; i < NEXP * 2048; i += G * 512) { const int e = i >> 11, rho = i & 2047; const int pn = rho >> 8, s = (rho >> 7) & 1, ii = rho & 127; B1P[i] = args.in[24][e * 2048 + 2 * (128 * pn + ii) + s]; }
        if (bx == 0 && wave == 0) { const float a = wave_sum(args.in[9][lane] * args.in[10][lane]), b = wave_sum(args.in[11][lane] * args.in[12][lane]);
            if (lane == 0) MISC[0] = expf(a) - expf(b) + LAMBDA_INIT; }
        {
            const float* win = args.in[3]; const float* g = args.in[2];
            float wg[4][4][8];
#pragma unroll
            for (int jj = 0; jj < 4; ++jj)
#pragma unroll
                for (int q = 0; q < 4; ++q) { const int k = 4 * lane + 256 * jj + q; const float gk = g[k];
                    const f32x4 a = *(const f32x4*)(win + (size_t)k * DIN + 3072), b = *(const f32x4*)(win + (size_t)k * DIN + 3076);
#pragma unroll
                    for (int j = 0; j < 4; ++j) { wg[jj][q][j] = a[j] * gk; wg[jj][q][4 + j] = b[j] * gk; } }
            const int gw = bx * NWAVES + wave, NGW = G * NWAVES;
            f32x4 vn[4];
            if (gw < T) { const f32x4* xr = (const f32x4*)(x + (size_t)gw * DM) + lane;
#pragma unroll
                for (int jj = 0; jj < 4; ++jj) vn[jj] = xr[64 * jj]; }
            for (int row = gw; row < T; row += NGW) {
                f32x4 v[4]; float ss = 0.f; float d[8];
#pragma unroll
                for (int jj = 0; jj < 4; ++jj) v[jj] = vn[jj];
                if (row + NGW < T) { const f32x4* xr = (const f32x4*)(x + (size_t)(row + NGW) * DM) + lane;
#pragma unroll
                    for (int jj = 0; jj < 4; ++jj) vn[jj] = xr[64 * jj]; }
#pragma unroll
                for (int j = 0; j < 8; ++j) d[j] = 0.f;
#pragma unroll
                for (int jj = 0; jj < 4; ++jj) {
#pragma unroll
                    for (int q = 0; q < 4; ++q) { ss += v[jj][q] * v[jj][q];
#pragma unroll
                        for (int j = 0; j < 8; ++j) d[j] += v[jj][q] * wg[jj][q][j]; } }
                ss = wave_sum(ss);
#pragma unroll
                for (int j = 0; j < 8; ++j) d[j] = wave_sum(d[j]);
                const float rs = rsqrtf(ss * (1.0f / DM) + EPS);
                u32x2* o8 = (u32x2*)(XB + (size_t)row * DM) + lane;
#pragma unroll
                for (int jj = 0; jj < 4; ++jj) { u32x2 w; w.x = cvt_pk_bf16(v[jj][0], v[jj][1]); w.y = cvt_pk_bf16(v[jj][2], v[jj][3]); o8[64 * jj] = w; }
                if (lane == 0) RSTDX[row] = rs;
                if (lane < 8) { float dv = d[0];
#pragma unroll
                    for (int j = 1; j < 8; ++j) dv = (lane == j) ? d[j] : dv;
                    dv *= rs; float r;
                    if (lane < 4) r = dv + args.in[6][lane];
                    else { const float z = dv + args.in[7][lane - 4]; r = (z >= 0.f) ? -log1pf(expf(-z)) : (z - log1pf(expf(z))); }
                    GATES[(size_t)row * 8 + lane] = r; }
            }
            for (int row = gw; row < MROWS; row += NGW) {
                const f32x4* xr = (const f32x4*)(mem + (size_t)row * DM) + lane;
                f32x4 v[4]; float ss = 0.f;
#pragma unroll
                for (int jj = 0; jj < 4; ++jj) { v[jj] = xr[64 * jj]; ss += (v[jj][0] * v[jj][0] + v[jj][1] * v[jj][1]) + (v[jj][2] * v[jj][2] + v[jj][3] * v[jj][3]); }
                ss = wave_sum(ss);
                unsigned* o4 = (unsigned*)((unsigned char*)MEMB + (size_t)row * DM) + lane;
#pragma unroll
                for (int jj = 0; jj < 4; ++jj) { unsigned w = 0u; w = __builtin_amdgcn_cvt_pk_fp8_f32(c8(v[jj][0]), c8(v[jj][1]), w, false); w = __builtin_amdgcn_cvt_pk_fp8_f32(c8(v[jj][2]), c8(v[jj][3]), w, true); o4[64 * jj] = w; }
                if (lane == 0) RSTDM[row] = rsqrtf(ss * (1.0f / DM) + EPS);
            }
        }
        if (ENDBAR(PH_PREP)) GRID_BAR();
    }

    if (IN(PH_INPROJ)) for (int rep_ = 0; rep_ < NREP(PH_INPROJ); ++rep_) {
        { ProbScaleBf16 P{(LAS unsigned*)(lds + LDSCTL_OFF + 2048), XB, WIN, T / 256, NP2 / 256, G, bx, PROJ, NP2, RSTDX, nullptr};
          pg8::gemm_phase<ProbScaleBf16, true>(lds, P, wave); }
        { ProbColScaleBf16 P{WIN + (size_t)NP2 * 1024, XB, 4, T / 256, G, bx, VT1, T, RSTDX};
          pg8::gemm_phase<ProbColScaleBf16, true>(lds, P, wave); }
        if (ENDBAR(PH_INPROJ)) GRID_BAR();
    }

    const int vx = (G % 8 == 0) ? (bx % 8) * (G / 8) + bx / 8 : bx;
    bf16_t* QM = (bf16_t*)(ws + WS_QM); bf16_t* KM = (bf16_t*)(ws + WS_KM); bf16_t* CSTB = (bf16_t*)(ws + WS_CSTB);
    float* BC = (float*)(ws + WS_BC); float* AV = (float*)(ws + WS_AV); float* AM = (float*)(ws + WS_AM); float* NLOC = (float*)(ws + WS_NLOC); float* NST = (float*)(ws + WS_NST);
    float* CH = (float*)(ws + WS_CH); float* MSTATE = (float*)(ws + WS_MSTATE); float* CLOC = (float*)(ws + WS_MST);
    if (IN(PH_MIX0)) for (int rep_ = 0; rep_ < NREP(PH_MIX0); ++rep_) {
        mlstm_prep_phase(lds, PROJ, VT1, GATES, args.in[4], args.in[5], QM, KM, BC, AV, AM, CH, NLOC, CLOC, G, vx, wave);
        if (ENDBAR(PH_MIX0)) GRID_BAR();
    }
    if (IN(PH_MIX1)) for (int rep_ = 0; rep_ < NREP(PH_MIX1); ++rep_) {
        mlstm_scan_phase(CLOC, NLOC, CH, CSTB, NST, MSTATE, G, bx, tid);
        if (ENDBAR(PH_MIX1)) GRID_BAR();
    }
    if (IN(PH_MIX2)) for (int rep_ = 0; rep_ < NREP(PH_MIX2); ++rep_) {
        mlstm_out_phase(lds, PROJ, VT1, QM, KM, BC, AV, AM, CSTB, NST, MSTATE, args.in[8], CAT, G, vx, wave);
        __syncthreads();
        const float lam = __hip_atomic_load(MISC, __ATOMIC_RELAXED, __HIP_MEMORY_SCOPE_AGENT);
        diffattn_phase(lds, (LAS float*)(lds + LDSCTL_OFF + 2048), PROJ, VT1, args.in[13], lam, CAT, G, vx, wave);
        if (ENDBAR(PH_MIX2)) GRID_BAR();
    }

    if (IN(PH_OUTPROJ)) for (int rep_ = 0; rep_ < NREP(PH_OUTPROJ); ++rep_) {
        ProbResidT<false, true, false> P{(LAS unsigned*)(lds + LDSCTL_OFF + 2048), CAT, WOUT, T / 256, 4, G, bx, nullptr, XB, XB, H1F, SSP1};
        pg8::gemm_phase<ProbResidT<false, true, false>, true>(lds, P, wave);
        if (ENDBAR(PH_OUTPROJ)) GRID_BAR();
    }

    if (IN(PH_QKV)) for (int rep_ = 0; rep_ < NREP(PH_QKV); ++rep_) {
        { ProbScaleT<true> P{(LAS unsigned*)(lds + LDSCTL_OFF + 2048), H1F, WCQ, T / 256, 4, G, bx, PROJ, 1024, nullptr, SSP1};
          pg8::gemm_phase<ProbScaleT<true>, true>(lds, P, wave); }
        { ProbKV P{(LAS unsigned*)(lds + LDSCTL_OFF + 2048), (const unsigned char*)MEMB, (const unsigned char*)WCKV, KV, VT2, RSTDM, G, bx};
          pg8::gemm_phase<ProbKV, true>(lds, P, wave); }
        if (ENDBAR(PH_QKV)) GRID_BAR();
    }

    if (IN(PH_XATTN)) for (int rep_ = 0; rep_ < NREP(PH_XATTN); ++rep_) {
        xattn_phase(lds, PROJ, KV, VT2, (unsigned char*)(PROJ + (size_t)T * 1024), G, vx, wave);
        if (ENDBAR(PH_XATTN)) GRID_BAR();
    }

    if (IN(PH_COPROJ)) for (int rep_ = 0; rep_ < NREP(PH_COPROJ); ++rep_) {
        ProbResidT<true, false, false> P{(LAS unsigned*)(lds + LDSCTL_OFF + 2048), (unsigned char*)(PROJ + (size_t)T * 1024), WCO, T / 256, 4, G, bx, nullptr, XB, CAT, nullptr, SSP2};
        pg8::gemm_phase<ProbResidT<true, false, false>, true>(lds, P, wave);
        if (ENDBAR(PH_COPROJ)) GRID_BAR();
    }

    if (IN(PH_ROUTER)) for (int rep_ = 0; rep_ < NREP(PH_ROUTER); ++rep_) {
        { u32x4 wv[8];
#pragma unroll
          for (int q = 0; q < 8; ++q) { const int idx = q * (NWAVES * 64) + tid, ks = idx >> 6, ln = idx & 63; wv[q] = *(const u32x4*)(WR + (size_t)(ln & 31) * DM + 16 * ks + 8 * (ln >> 5)); }
#pragma unroll
          for (int q = 0; q < 8; ++q) { const int idx = q * (NWAVES * 64) + tid; *(LAS u32x4*)(lds + idx * 16) = wv[q]; } }
        __syncthreads();
        const float* brt = args.in[22];
        const int i = lane & 31, hh = lane >> 5;
        volatile LAS unsigned* lcnt = (volatile LAS unsigned*)(lds + 65536);
        const int ntrip = (T / 32 + G * NWAVES - 1) / (G * NWAVES);
        for (int trip = 0; trip < ntrip; ++trip) {
            const int tile = trip * G * NWAVES + bx * NWAVES + wave; const bool act = tile < T / 32;
            if (tid < 32) lcnt[tid] = 0u;
            __syncthreads();
            const int t = (act ? tile : 0) * 32 + i;
            const bf16_t* xp = CAT + (size_t)t * DM + 8 * hh;
            const f32x4 p0 = *(const f32x4*)(SSP2 + (size_t)t * 16 + 8 * hh), p1 = *(const f32x4*)(SSP2 + (size_t)t * 16 + 8 * hh + 4);
            float sp = (p0[0] + p0[1]) + (p0[2] + p0[3]) + (p1[0] + p1[1]) + (p1[2] + p1[3]); sp = x32_sum(sp);
            const float rs = rsqrtf(sp * (1.0f / DM) + EPS);
            f32x16 acc = zero16();
#pragma unroll 8
            for (int ks = 0; ks < 64; ks += 2) { bf16x8 xf[2]; unsigned pw[2][2];
#pragma unroll
                for (int q = 0; q < 2; ++q) { xf[q] = *(const bf16x8*)(xp + 16 * (ks + q)); const bf16x8 wf = *(const LAS bf16x8*)(lds + ((ks + q) * 64 + lane) * 16);
                    acc = __builtin_amdgcn_mfma_f32_32x32x16_bf16(wf, xf[q], acc, 0, 0, 0); }
                if (act) {
#pragma unroll
                    for (int q = 0; q < 2; ++q) { const u32x4 xw = __builtin_bit_cast(u32x4, xf[q]); unsigned w0 = 0u, w1 = 0u;
                        w0 = __builtin_amdgcn_cvt_pk_fp8_f32(lo_bf(xw.x) * rs, hi_bf(xw.x) * rs, w0, false); w0 = __builtin_amdgcn_cvt_pk_fp8_f32(lo_bf(xw.y) * rs, hi_bf(xw.y) * rs, w0, true);
                        w1 = __builtin_amdgcn_cvt_pk_fp8_f32(lo_bf(xw.z) * rs, hi_bf(xw.z) * rs, w1, false); w1 = __builtin_amdgcn_cvt_pk_fp8_f32(lo_bf(xw.w) * rs, hi_bf(xw.w) * rs, w1, true);
                        pw[q][0] = w0; pw[q][1] = w1; }
                    const auto sa = __builtin_amdgcn_permlane32_swap(pw[0][0], pw[1][0], false, false), sb = __builtin_amdgcn_permlane32_swap(pw[0][1], pw[1][1], false, false);
                    *(u32x4*)(H2F + (size_t)t * DM + 16 * ks + 16 * hh) = (u32x4){sa[0], sb[0], sa[1], sb[1]}; } }
            float mine[16], oth[16];
#pragma unroll
            for (int r = 0; r < 16; ++r) { const int e = (r & 3) + 8 * (r >> 2); mine[r] = acc[r] * rs + brt[e + 4 * hh]; }
#pragma unroll
            for (int r = 0; r < 16; ++r) oth[r] = x32_other(mine[r], hh);
            float lg[NEXP];
#pragma unroll
            for (int r = 0; r < 16; ++r) { const int e = (r & 3) + 8 * (r >> 2); lg[e] = hh ? oth[r] : mine[r]; lg[e + 4] = hh ? mine[r] : oth[r]; }
            unsigned taken = 0u; float tv[4]; int te[4];
#pragma unroll
            for (int k = 0; k < TOPK; ++k) { float best = -INFINITY; int bi = 0;
#pragma unroll
                for (int e = 0; e < NEXP; ++e) { const bool ok = !((taken >> e) & 1u) && (lg[e] > best); best = ok ? lg[e] : best; bi = ok ? e : bi; }
                taken |= 1u << bi; tv[k] = best; te[k] = bi; }
            const float q1 = __expf(tv[1] - tv[0]), q2 = __expf(tv[2] - tv[0]), q3 = __expf(tv[3] - tv[0]); const float inv = 1.0f / (1.0f + q1 + q2 + q3);
            const float gk[4] = {inv, q1 * inv, q2 * inv, q3 * inv};
            unsigned lp[4] = {0u, 0u, 0u, 0u};
            if (act && hh == 0) {
#pragma unroll
                for (int k = 0; k < TOPK; ++k) lp[k] = __hip_atomic_fetch_add((LAS unsigned*)(lcnt + te[k]), 1u, __ATOMIC_RELAXED, __HIP_MEMORY_SCOPE_WORKGROUP); }
            __syncthreads();
            if (tid < 32) { const unsigned n = lcnt[tid]; lcnt[32 + tid] = n ? atomicAdd(&ctl[CW_CNT + tid], n) : 0u; }
            __syncthreads();
            if (act && hh == 0) { RSTD2[t] = rs;
                unsigned tm[4];
#pragma unroll
                for (int k = 0; k < TOPK; ++k) { const unsigned pos = lcnt[32 + te[k]] + lp[k]; LIST[(size_t)te[k] * T + pos] = (unsigned)t; tm[k] = ((unsigned)te[k] << 16) | pos; }
                *(u32x4*)(TOKMAP + (size_t)t * 4) = (u32x4){tm[0], tm[1], tm[2], tm[3]};
                *(f32x4*)(GATEV + (size_t)t * 4) = (f32x4){gk[0], gk[1], gk[2], gk[3]}; }
            __syncthreads();
        }
        if (ENDBAR(PH_ROUTER)) GRID_BAR();
    }

    volatile LAS int* tab = (volatile LAS int*)(LCTL + 16);
    int Rtot = 0;
    if (IN(PH_G1) || IN(PH_G2) || IN(PH_COMBINE)) {
        if (tid < NEXP) tab[MOE_CNT + tid] = (int)__hip_atomic_load(&ctl[CW_CNT + tid], __ATOMIC_RELAXED, __HIP_MEMORY_SCOPE_AGENT);
        __syncthreads();
        if (tid == 0) { int ts = 0, st = 0;
            for (int e = 0; e < NEXP; ++e) { const int c = tab[MOE_CNT + e]; tab[MOE_TS + e] = ts; tab[MOE_ST + e] = st; ts += (c + 255) >> 8; st += c; }
            tab[MOE_TS + NEXP] = ts; tab[MOE_ST + NEXP] = st; }
        __syncthreads();
        Rtot = tab[MOE_TS + NEXP];
    }
    if (IN(PH_G1) || IN(PH_G2)) {
        __syncthreads();
        for (int rt = tid; rt < Rtot; rt += NWAVES * 64) { int e = 0;
            for (int j = 1; j < NEXP; ++j) if (rt >= tab[MOE_TS + j]) e = j;
            ((volatile LAS unsigned char*)(tab + MOE_RTE))[rt] = (unsigned char)e; }
        __syncthreads();
        if (IN(PH_G1)) for (int rep_ = 0; rep_ < NREP(PH_G1); ++rep_) { ProbMoe1 P{H2F, W1F, B1P, RSTD2, LIST, HID, tab, (LAS unsigned*)(lds + LDSCTL_OFF + 2048), 0, Rtot, G, bx};
            pg8::gemm_phase<ProbMoe1, true>(lds, P, wave);
            if (IN(PH_G2) || NREP(PH_G1) > 1) GRID_BAR(); }
        if (IN(PH_G2)) for (int rep_ = 0; rep_ < NREP(PH_G2); ++rep_) { ProbMoe2 P{HID, W2F, args.in[26], YB, tab, (LAS unsigned*)(lds + LDSCTL_OFF + 2048), 0, Rtot, G, bx};
            pg8::gemm_phase<ProbMoe2, true>(lds, P, wave);
            if (IN(PH_COMBINE) || NREP(PH_G2) > 1) GRID_BAR(); }
    }
    if (IN(PH_COMBINE)) {
        const float* gf = args.in[27];
        const int gw = bx * NWAVES + wave, NGW = G * NWAVES;
        f32x4 gfv[4];
#pragma unroll
        for (int jj = 0; jj < 4; ++jj) gfv[jj] = *((const f32x4*)gf + 4 * lane + jj);
        u32x4 tmn = (u32x4){0u, 0u, 0u, 0u}; f32x4 gkn = (f32x4){0.f, 0.f, 0.f, 0.f};
        if (gw < T) { tmn = *(const u32x4*)(TOKMAP + (size_t)gw * 4); gkn = *(const f32x4*)(GATEV + (size_t)gw * 4); }
        for (int t = gw; t < T; t += NGW) {
            const u32x4 tm = tmn; const f32x4 gk = gkn;
            if (t + NGW < T) { tmn = *(const u32x4*)(TOKMAP + (size_t)(t + NGW) * 4); gkn = *(const f32x4*)(GATEV + (size_t)(t + NGW) * 4); }
            const u32x4* hb = (const u32x4*)(CAT + (size_t)t * DM) + 2 * lane;
            const u32x4 h0 = hb[0], h1 = hb[1];
            u32x4 yv[4];
#pragma unroll
            for (int k = 0; k < TOPK; ++k) { const int e = (int)(tm[k] >> 16), pos = (int)(tm[k] & 0xffffu); const size_t yrow = (size_t)(tab[MOE_ST + e] + pos);
                yv[k] = *((const u32x4*)(YB + yrow * DM) + lane); }
            float v[16];
            v[0] = lo_bf(h0.x); v[1] = hi_bf(h0.x); v[2] = lo_bf(h0.y); v[3] = hi_bf(h0.y); v[4] = lo_bf(h0.z); v[5] = hi_bf(h0.z); v[6] = lo_bf(h0.w); v[7] = hi_bf(h0.w);
            v[8] = lo_bf(h1.x); v[9] = hi_bf(h1.x); v[10] = lo_bf(h1.y); v[11] = hi_bf(h1.y); v[12] = lo_bf(h1.z); v[13] = hi_bf(h1.z); v[14] = lo_bf(h1.w); v[15] = hi_bf(h1.w);
#pragma unroll
            for (int k = 0; k < TOPK; ++k) { const float g16 = gk[k] * (1.0f / 16.0f);
#pragma unroll
                for (int q = 0; q < 4; ++q) { const f32x2 a = __builtin_amdgcn_cvt_pk_f32_fp8((int)yv[k][q], false), b2_ = __builtin_amdgcn_cvt_pk_f32_fp8((int)yv[k][q], true);
                    v[4 * q] += g16 * a[0]; v[4 * q + 1] += g16 * a[1]; v[4 * q + 2] += g16 * b2_[0]; v[4 * q + 3] += g16 * b2_[1]; } }
            float ss = 0.f;
#pragma unroll
            for (int q = 0; q < 16; ++q) ss += v[q] * v[q];
            ss = wave_sum(ss); const float rs = rsqrtf(ss * (1.0f / DM) + EPS);
            f32x4* orow = (f32x4*)(args.out + (size_t)t * DM) + 4 * lane;
#pragma unroll
            for (int jj = 0; jj < 4; ++jj) orow[jj] = (f32x4){v[4 * jj] * rs * gfv[jj][0], v[4 * jj + 1] * rs * gfv[jj][1], v[4 * jj + 2] * rs * gfv[jj][2], v[4 * jj + 3] * rs * gfv[jj][3]};
        }
    }
#undef IN
#undef BOTH
#undef GRID_BAR
#undef lane
#undef tid
}

extern "C" void kernel_launch(void* const* d_in, const int* in_sizes, int n_in, void* d_out, int out_size, void* d_ws, size_t ws_size, hipStream_t stream) {
    static int grid = 0;
    if (grid == 0) {
        if (n_in != 28 || out_size != T * DM || ws_size < WS_END) { fprintf(stderr, "kernel_launch: unexpected shapes: n_in %d out %d ws %zu\n", n_in, out_size, ws_size); grid = -1; return; }
        int dev = 0, cus = 0;
        if (hipGetDevice(&dev) != hipSuccess || hipDeviceGetAttribute(&cus, hipDeviceAttributeMultiprocessorCount, dev) != hipSuccess) { grid = -1; return; }
        if (hipFuncSetAttribute((const void*)fwd, hipFuncAttributeMaxDynamicSharedMemorySize, LDS_BYTES) != hipSuccess) { fprintf(stderr, "kernel_launch: hipFuncSetAttribute failed\n"); grid = -1; return; }
        int per_cu = 0;
        if (hipOccupancyMaxActiveBlocksPerMultiprocessor(&per_cu, (const void*)fwd, NWAVES * 64, LDS_BYTES) != hipSuccess || per_cu < 1) fprintf(stderr, "kernel_launch: occupancy query says %d\n", per_cu);
        (void)hipGetLastError();
        grid = cus;
    }
    if (grid < 0) return;
    (void)hipMemsetAsync((char*)d_ws + WS_CTL, 0, CTL_ZERO_BYTES, stream);
    Args a{};
    for (int i = 0; i < 28; ++i) a.in[i] = (const float*)d_in[i];
    a.out = (float*)d_out; a.ws = (unsigned char*)d_ws;
    unsigned char* ws = (unsigned char*)d_ws;
    auto run = [&](int lo, int hi, int p0, int p1) { a.ph_lo = lo; a.ph_hi = hi; a.pass_lo = p0; a.pass_hi = p1; hipLaunchKernelGGL(fwd, dim3(grid), dim3(NWAVES * 64), LDS_BYTES, stream, a); };
#ifdef MULTI_LAUNCH
    for (int ph = 0; ph < PH_G1; ++ph) run(ph, ph + 1, 0, 0);
    run(PH_G1, PH_G1 + 1, 0, 1); run(PH_G2, PH_G2 + 1, 0, 1);
    run(PH_COMBINE, PH_COMBINE + 1, 0, 0);
#else
    run(0, PH_END, 0, 5);
#endif
}
```

```cpp
#include <hip/hip_runtime.h>
#include <cstdio>
#include <cstdint>
#include <cmath>

#define GAS __attribute__((address_space(1)))
#define LAS __attribute__((address_space(3)))
typedef unsigned short bf16_t;
typedef short bf16x8 __attribute__((ext_vector_type(8)));
typedef float f32x4 __attribute__((ext_vector_type(4)));
typedef float f32x2 __attribute__((ext_vector_type(2)));
typedef unsigned u32x4 __attribute__((ext_vector_type(4)));
typedef unsigned u32x2 __attribute__((ext_vector_type(2)));
typedef int i32x8 __attribute__((ext_vector_type(8)));
typedef int i32x4 __attribute__((ext_vector_type(4)));

constexpr int BATCH = 32, SEQ = 2048, DM = 1024, T = BATCH * SEQ, MEMLEN = 256, MROWS = BATCH * MEMLEN;
constexpr int NPROJ = 3072, DIN = 3080, NP2 = 2048;
constexpr int NEXP = 32, TOPK = 4;
constexpr float EPS = 1e-5f;
constexpr float LAMBDA_INIT = 0.2f;

constexpr size_t MiB = 1u << 20;
constexpr size_t WS_CTL = 0, CTL_ZERO_BYTES = 64 * 1024;
constexpr size_t WS_RSTDX = 1 * MiB;
constexpr size_t WS_RSTDM = WS_RSTDX + (size_t)T * 4;
constexpr size_t WS_B1P = WS_RSTDM + (size_t)MROWS * 4;
constexpr size_t WS_MISC = WS_B1P + (size_t)NEXP * 2048 * 4;
constexpr size_t WS_RSTD2 = WS_MISC + 4096;
static_assert(WS_RSTD2 + (size_t)T * 4 <= 2 * MiB, "small region");
constexpr size_t WS_SSP1 = 2 * MiB;
constexpr size_t WS_SSP2 = 6 * MiB;
constexpr size_t WS_GATES = 10 * MiB;
constexpr size_t WS_TOKMAP = 12 * MiB;
constexpr size_t WS_GATEV = 13 * MiB;
constexpr size_t WS_LIST = 14 * MiB;
constexpr size_t WS_WIN = 24 * MiB;
constexpr size_t WS_WOUT = 30 * MiB;
constexpr size_t WS_WCQ = 32 * MiB;
constexpr size_t WS_WCKV = 34 * MiB;
constexpr size_t WS_WCO = 38 * MiB;
constexpr size_t WS_WR = 40 * MiB;
constexpr size_t WS_W1 = 64 * MiB;
constexpr size_t WS_H2F = 128 * MiB;
constexpr size_t WS_W2 = 192 * MiB;
constexpr size_t WS_XB = 256 * MiB;
constexpr size_t WS_PROJ = 384 * MiB;
constexpr size_t WS_H1F = 640 * MiB;
constexpr size_t WS_VT1 = 640 * MiB;
constexpr size_t WS_CAT = 768 * MiB;
constexpr size_t WS_MST = 896 * MiB;
constexpr size_t WS_MEMB = 962 * MiB;
constexpr size_t WS_KV = 978 * MiB;
constexpr size_t WS_VT2 = 994 * MiB;
constexpr size_t WS_QM = 128 * MiB;
constexpr size_t WS_KM = 160 * MiB;
constexpr size_t WS_CSTB = 224 * MiB;
constexpr size_t WS_BC = 1010 * MiB;
constexpr size_t WS_AV = 1011 * MiB;
constexpr size_t WS_AM = 1012 * MiB;
constexpr size_t WS_NLOC = 1013 * MiB;
constexpr size_t WS_NST = WS_NLOC + 512 * 1024;
constexpr size_t WS_CH = 1014 * MiB;
constexpr size_t WS_MSTATE = WS_CH + 64 * 1024;
constexpr size_t WS_Y = 256 * MiB;
constexpr size_t WS_HID = 512 * MiB;
constexpr size_t WS_HID1 = 896 * MiB;
constexpr size_t WS_END = 1024 * MiB;

constexpr int CW_CNT = 64;
constexpr int CW_BAR = 4096;
static_assert((CW_BAR + 3456) * 4 <= (int)CTL_ZERO_BYTES, "control words inside the per-call memset");

__device__ __forceinline__ float bf2f(bf16_t b) { return __uint_as_float(((unsigned)b) << 16); }
__device__ __forceinline__ unsigned f2bf(float f) { unsigned u = __float_as_uint(f); return (u + 0x7fffu + ((u >> 16) & 1u)) >> 16; }
__device__ __forceinline__ unsigned cvt_pk_bf16(float lo, float hi) { unsigned r; asm volatile("v_cvt_pk_bf16_f32 %0, %1, %2" : "=v"(r) : "v"(lo), "v"(hi)); return r; }
__device__ __forceinline__ float x32_sum(float v) { auto r = __builtin_amdgcn_permlane32_swap(__float_as_uint(v), __float_as_uint(v), false, false); return __uint_as_float(r[0]) + __uint_as_float(r[1]); }
__device__ __forceinline__ float x32_max(float v) { auto r = __builtin_amdgcn_permlane32_swap(__float_as_uint(v), __float_as_uint(v), false, false); return fmaxf(__uint_as_float(r[0]), __uint_as_float(r[1])); }
__device__ __forceinline__ float x32_other(float v, int hh) { auto r = __builtin_amdgcn_permlane32_swap(__float_as_uint(v), __float_as_uint(v), false, false); return hh ? __uint_as_float(r[0]) : __uint_as_float(r[1]); }
__device__ __forceinline__ float x16_sum(float v) { auto r = __builtin_amdgcn_permlane16_swap(__float_as_uint(v), __float_as_uint(v), false, false); return __uint_as_float(r[0]) + __uint_as_float(r[1]); }
__device__ __forceinline__ float row16_sum(float v) {
    v += __uint_as_float((unsigned)__builtin_amdgcn_update_dpp(0, (int)__float_as_uint(v), 0xB1, 0xf, 0xf, true));
    v += __uint_as_float((unsigned)__builtin_amdgcn_update_dpp(0, (int)__float_as_uint(v), 0x4E, 0xf, 0xf, true));
    v += __uint_as_float((unsigned)__builtin_amdgcn_update_dpp(0, (int)__float_as_uint(v), 0x141, 0xf, 0xf, true));
    v += __uint_as_float((unsigned)__builtin_amdgcn_update_dpp(0, (int)__float_as_uint(v), 0x140, 0xf, 0xf, true));
    return v; }
__device__ __forceinline__ float wave_sum(float v) { return x32_sum(x16_sum(row16_sum(v))); }
__device__ __forceinline__ int lane_id() { int l; asm volatile("v_mbcnt_lo_u32_b32 %0, -1, 0\n\tv_mbcnt_hi_u32_b32 %0, -1, %0" : "=v"(l)); return l; }
__device__ __forceinline__ float c8(float x) { return __builtin_amdgcn_fmed3f(x, -448.0f, 448.0f); }
__device__ __forceinline__ float lo_bf(unsigned w) { return __uint_as_float(w << 16); }
__device__ __forceinline__ float hi_bf(unsigned w) { return __uint_as_float(w & 0xffff0000u); }

namespace pg8 {
constexpr int BM = 256, BK = 64, HALF = 128, HTB = HALF * BK * 2, STAGE_BYTES = 8 * HTB, NXCD = 8, WGM = 8, KD = 1024, NT = KD / BK;
__host__ __device__ __forceinline__ int lds_byte(int r, int c) { const int st = (r >> 4) * 2 + (c >> 5), rr = r & 15, cc = c & 31, ob = rr * 64 + cc * 2; return st * 1024 + (ob ^ (((ob >> 9) & 1) << 5)); }
__host__ __device__ __forceinline__ void stage_rc(int b, int& R, int& C) { const int st = b / 1024, sb = b % 1024, swz = sb ^ (((sb >> 9) & 1) << 5); R = (st >> 1) * 16 + swz / 64; C = (st & 1) * 32 + (swz % 64) / 2; }
__host__ __device__ __forceinline__ int perm32(int rho) { const int n = rho >> 4, i = rho & 15; return 8 * (i >> 2) + 4 * n + (i & 3); }

struct Unit { const char* A; const char* B; int pm, pn, e, nvalid, y0, aux; };

__device__ __forceinline__ bool static_next(int i, int G, int c, int nM, int nN, int& pm, int& pn) {
    const int nwg = nM * nN; const long L = (long)i * G + c; if (L >= nwg) return false;
    int wgid = (int)L; { const int q = nwg / NXCD, r = nwg % NXCD, xcd = wgid % NXCD, off = wgid / NXCD; wgid = (xcd < r ? xcd * (q + 1) : r * (q + 1) + (xcd - r) * q) + off; }
    const int nig = WGM * nN, gid = wgid / nig, fm = gid * WGM, gsz = (nM - fm) < WGM ? (nM - fm) : WGM;
    pm = fm + ((wgid % nig) % gsz); pn = (wgid % nig) / gsz; return true;
}

template <class P, bool ALIGN_EPI>
__device__ __forceinline__ void gemm_phase(LAS unsigned char* lds, const P& prob, const int wid) {
    const int lane = lane_id(), tid = wid * 64 + lane, wr = wid >> 2, wc = wid & 3, fr = lane & 15, fq = lane >> 4;
    constexpr int ROWB = P::FP8 ? KD : 2 * KD;
    constexpr int nt = ROWB / 128;
    int RA[2], CA[2]; unsigned voffA[2], voffB[2];
#pragma unroll
    for (int i = 0; i < 2; ++i) { int R, C; stage_rc(tid * 16 + i * 8192, R, C); const int Rb = P::PERM ? ((R & ~31) + perm32(R & 31)) : R;
        RA[i] = R; CA[i] = C * 2; voffA[i] = (unsigned)(R * ROWB + C * 2); voffB[i] = (unsigned)(Rb * ROWB + C * 2); }
    constexpr int kstep = BK * 2;
    constexpr size_t hstep = (size_t)HALF * ROWB;
    const unsigned ldsw = (unsigned)wid * 1024u;
    const int aoff = lds_byte(wr * 64 + fr, fq * 8), boff = lds_byte(wc * 32 + fr, fq * 8);
#define PG8_SA(b, h) (((b) * 2 + (h)) * HTB)
#define PG8_SB(b, h) ((4 + (b) * 2 + (h)) * HTB)
#define PG8_STAGE_B(bufoff, gbase) do { _Pragma("unroll") for (int _i = 0; _i < 2; ++_i) \
        __builtin_amdgcn_global_load_lds((const unsigned*)((const char*)(gbase) + voffB[_i]), (LAS unsigned*)(lds + (bufoff) + ldsw + _i * 8192), 16, 0, 0); } while (0)
#define PG8_STAGE_A(bufoff, gbase, off, h) do { _Pragma("unroll") for (int _i = 0; _i < 2; ++_i) { const char* _p; \
        if constexpr (P::GATHER) _p = (const char*)(gbase) + (off)[h][_i]; else _p = (const char*)(gbase) + (size_t)(h) * hstep + voffA[_i]; \
        __builtin_amdgcn_global_load_lds((const unsigned*)_p, (LAS unsigned*)(lds + (bufoff) + ldsw + _i * 8192), 16, 0, 0); } } while (0)
#define PG8_LDA(dst, b, h) do { _Pragma("unroll") for (int m = 0; m < 4; ++m) _Pragma("unroll") for (int k = 0; k < 2; ++k) dst[m][k] = *(const LAS bf16x8*)(lds + PG8_SA(b, h) + aoff + m * 2048 + k * 1024); } while (0)
#define PG8_LDB(dst, b, h) do { _Pragma("unroll") for (int n = 0; n < 2; ++n) _Pragma("unroll") for (int k = 0; k < 2; ++k) dst[n][k] = *(const LAS bf16x8*)(lds + PG8_SB(b, h) + boff + n * 2048 + k * 1024); } while (0)
#define PG8_MMA(ai, bj, At, Bt) do { __builtin_amdgcn_s_setprio(1); _Pragma("unroll") for (int m = 0; m < 4; ++m) _Pragma("unroll") for (int n = 0; n < 2; ++n) { \
        if constexpr (P::FP8) { const i32x4 b0_ = __builtin_bit_cast(i32x4, Bt[n][0]), b1_ = __builtin_bit_cast(i32x4, Bt[n][1]), a0_ = __builtin_bit_cast(i32x4, At[m][0]), a1_ = __builtin_bit_cast(i32x4, At[m][1]); \
            acc[ai][bj][m][n] = __builtin_amdgcn_mfma_scale_f32_16x16x128_f8f6f4((i32x8){b0_[0], b0_[1], b0_[2], b0_[3], b1_[0], b1_[1], b1_[2], b1_[3]}, (i32x8){a0_[0], a0_[1], a0_[2], a0_[3], a1_[0], a1_[1], a1_[2], a1_[3]}, \
                acc[ai][bj][m][n], 0, 0, 0, 0x7f7f7f7f, 0, 0x7f7f7f7f); } \
        else { _Pragma("unroll") for (int k = 0; k < 2; ++k) acc[ai][bj][m][n] = __builtin_amdgcn_mfma_f32_16x16x32_bf16(Bt[n][k], At[m][k], acc[ai][bj][m][n], 0, 0, 0); } } \
        __builtin_amdgcn_s_setprio(0); } while (0)
#define PG8_WAIT_V(n) asm volatile("s_waitcnt vmcnt(" #n ")" ::: "memory")
#define PG8_WAIT_L(n) asm volatile("s_waitcnt lgkmcnt(" #n ")" ::: "memory")
#define PG8_BAR __builtin_amdgcn_s_barrier()
#define PG8_SCHED __builtin_amdgcn_sched_barrier(0)
    Unit cur, nxt; int ui = 0;
    if (!prob.next(0, cur)) return;
    f32x4 acc[2][2][4][2];
#pragma unroll
    for (int a = 0; a < 2; ++a)
#pragma unroll
        for (int b = 0; b < 2; ++b)
#pragma unroll
            for (int m = 0; m < 4; ++m)
#pragma unroll
                for (int n = 0; n < 2; ++n) acc[a][b][m][n] = (f32x4){0.f, 0.f, 0.f, 0.f};
    bf16x8 At[4][2], B0[2][2], B1[2][2];
    unsigned offC[2][2] = {{0u, 0u}, {0u, 0u}};
#define PG8_FILL(u, buf) do { if (tid < 256) prob.gtab[(buf) * 256 + tid] = prob.a_off(u, tid); } while (0)
#define PG8_OFFS(buf) do { _Pragma("unroll") for (int _h = 0; _h < 2; ++_h) _Pragma("unroll") for (int _i = 0; _i < 2; ++_i) offC[_h][_i] = prob.gtab[(buf) * 256 + _h * HALF + RA[_i]] + (unsigned)CA[_i]; } while (0)
    Unit nx2;
    bool has_next = prob.next(1, nxt);
    if constexpr (P::GATHER) { PG8_FILL(cur, 0); if (has_next) PG8_FILL(nxt, 1); PG8_WAIT_L(0); PG8_BAR; PG8_OFFS(0); }
    const char* cA = prob.a_tile(cur); const char* cB = cur.B;
    PG8_STAGE_B(PG8_SB(0, 0), cB); PG8_STAGE_B(PG8_SB(0, 1), cB + hstep); PG8_STAGE_A(PG8_SA(0, 0), cA, offC, 0); PG8_STAGE_A(PG8_SA(0, 1), cA, offC, 1);
    if (wr == 1) PG8_BAR;
    PG8_WAIT_V(2); PG8_BAR;
    PG8_STAGE_B(PG8_SB(1, 0), cB + kstep); PG8_STAGE_A(PG8_SA(1, 0), cA + kstep, offC, 0); PG8_STAGE_B(PG8_SB(1, 1), cB + hstep + kstep);
    PG8_WAIT_V(6); PG8_BAR;
    int bcur = 0;
    for (;;) {
        const bool has_nx2 = has_next && prob.next(ui + 2, nx2);
        const char* nA = has_next ? prob.a_tile(nxt) : cA; const char* nB = has_next ? nxt.B : cB;
        const int bnext = bcur == 2 ? 0 : bcur + 1, bnx2 = bnext == 2 ? 0 : bnext + 1;
#pragma unroll 1
        for (int t = 0; t < nt; t += 2) {
            const bool last = (t == nt - 2);
            const char* a1 = cA + (size_t)(t + 1) * kstep;
            const char* a2 = last ? nA : cA + (size_t)(t + 2) * kstep; const char* b2 = last ? nB : cB + (size_t)(t + 2) * kstep;
            const char* a3 = a2 + kstep; const char* b3 = b2 + kstep;
            PG8_LDB(B0, 0, 0); PG8_LDB(B1, 0, 1); PG8_SCHED; PG8_LDA(At, 0, 0); PG8_STAGE_A(PG8_SA(1, 1), a1, offC, 1);
            if constexpr (P::GATHER) { if (last && has_next) PG8_OFFS(bnext); }
            PG8_WAIT_V(8); PG8_WAIT_L(0); PG8_BAR; PG8_MMA(0, 0, At, B0); PG8_MMA(0, 1, At, B1); PG8_BAR; PG8_SCHED;
            PG8_LDA(At, 0, 1); PG8_STAGE_B(PG8_SB(0, 0), b2); PG8_STAGE_B(PG8_SB(0, 1), b2 + hstep); PG8_STAGE_A(PG8_SA(0, 0), a2, offC, 0);
            PG8_WAIT_V(8); PG8_WAIT_L(0); PG8_BAR; PG8_MMA(1, 0, At, B0); PG8_MMA(1, 1, At, B1); PG8_BAR; PG8_SCHED;
            PG8_LDB(B0, 1, 0); PG8_LDB(B1, 1, 1); PG8_SCHED; PG8_LDA(At, 1, 0); PG8_STAGE_A(PG8_SA(0, 1), a2, offC, 1);
            PG8_WAIT_V(8); PG8_WAIT_L(0); PG8_BAR; PG8_MMA(0, 0, At, B0); PG8_MMA(0, 1, At, B1); PG8_BAR; PG8_SCHED;
            PG8_LDA(At, 1, 1); PG8_STAGE_B(PG8_SB(1, 0), b3); PG8_STAGE_B(PG8_SB(1, 1), b3 + hstep); PG8_STAGE_A(PG8_SA(1, 0), a3, offC, 0);
            PG8_WAIT_V(8); PG8_WAIT_L(0); PG8_BAR; PG8_MMA(1, 0, At, B0); PG8_MMA(1, 1, At, B1); PG8_BAR; PG8_SCHED;
        }
        if constexpr (ALIGN_EPI) { if (wr == 0) PG8_BAR; }
        if constexpr (P::GATHER) { if (has_nx2) PG8_FILL(nx2, bnx2); }
        cur.aux = bcur;
        prob.epi(acc, cur, wr, wc, fr, fq);
        if (!has_next) break;
#pragma unroll
        for (int a = 0; a < 2; ++a)
#pragma unroll
            for (int b = 0; b < 2; ++b)
#pragma unroll
                for (int m = 0; m < 4; ++m)
#pragma unroll
                    for (int n = 0; n < 2; ++n) acc[a][b][m][n] = (f32x4){0.f, 0.f, 0.f, 0.f};
        cur = nxt; nxt = nx2; has_next = has_nx2; cA = nA; cB = nB; ++ui; bcur = bnext;
        if constexpr (ALIGN_EPI) { if (wr == 1) PG8_BAR; }
    }
    PG8_WAIT_V(0);
    if constexpr (!ALIGN_EPI) { if (wr == 0) PG8_BAR; }
    PG8_BAR;
#undef PG8_SA
#undef PG8_SB
#undef PG8_STAGE_A
#undef PG8_STAGE_B
#undef PG8_LDA
#undef PG8_LDB
#undef PG8_MMA
#undef PG8_WAIT_V
#undef PG8_WAIT_L
#undef PG8_BAR
#undef PG8_SCHED
#undef PG8_OFFS
#undef PG8_FILL
}
}

template <bool F8> struct ProbScaleT {
    static constexpr bool FP8 = F8, PERM = true, GATHER = F8;
    static constexpr int RB = F8 ? 1024 : 2048;
    __device__ __forceinline__ const char* a_tile(const pg8::Unit& u) const { return F8 ? u.A : u.A + (size_t)u.pm * (256 * RB); }
    LAS unsigned* gtab;
    const void* A; const void* Bt; int nM, nN, G, c;
    bf16_t* O; int ldo; const float* rstd; const float* ssp;
    __device__ __forceinline__ bool next(int i, pg8::Unit& u) const {
        int pm, pn; if (!pg8::static_next(i, G, c, nM, nN, pm, pn)) return false;
        u.A = (const char*)A; u.B = (const char*)Bt + (size_t)pn * 256 * RB; u.pm = pm; u.pn = pn; u.e = 0; u.nvalid = 256; u.y0 = 0; u.aux = 0; return true; }
    __device__ __forceinline__ unsigned a_off(const pg8::Unit& u, int r) const { return (unsigned)(u.pm * 256 + r) * (unsigned)RB; }
    __device__ __forceinline__ void epi(const f32x4 (&acc)[2][2][4][2], const pg8::Unit& u, int wr, int wc, int fr, int fq) const {
        asm volatile("" : "+v"(fr), "+v"(fq));
        const int rowu = u.pm * 256 + wr * 64;
        char* ub = (char*)O + ((size_t)rowu * ldo + u.pn * 256 + wc * 32) * 2;
        const unsigned lo = (unsigned)(fr * ldo + 8 * fq) * 2u;
        float rsv[8];
        if (rstd) {
#pragma unroll
            for (int q = 0; q < 8; ++q) rsv[q] = rstd[rowu + fr + (q >> 2) * 128 + (q & 3) * 16];
        } else { f32x4 pv[8];
#pragma unroll
            for (int q = 0; q < 8; ++q) pv[q] = *(const f32x4*)(ssp + (size_t)(rowu + fr + (q >> 2) * 128 + (q & 3) * 16) * 16 + fq * 4);
#pragma unroll
            for (int q = 0; q < 8; ++q) { float sq = (pv[q][0] + pv[q][1]) + (pv[q][2] + pv[q][3]); sq = x16_sum(sq); sq = x32_sum(sq); rsv[q] = rsqrtf(sq * (1.0f / 1024.0f) + EPS); } }
#pragma unroll
        for (int ai = 0; ai < 2; ++ai)
#pragma unroll
            for (int m = 0; m < 4; ++m) { const float rs = rsv[ai * 4 + m] * (F8 ? (1.0f / 64.0f) : 1.0f);
                char* rowp = ub + (size_t)(ai * 128 + m * 16) * ldo * 2 + lo;
#pragma unroll
                for (int bj = 0; bj < 2; ++bj) { const f32x4 v0 = acc[ai][bj][m][0] * rs, v1 = acc[ai][bj][m][1] * rs;
                    u32x4 w; w.x = cvt_pk_bf16(v0[0], v0[1]); w.y = cvt_pk_bf16(v0[2], v0[3]); w.z = cvt_pk_bf16(v1[0], v1[1]); w.w = cvt_pk_bf16(v1[2], v1[3]);
                    *(u32x4*)(rowp + bj * 256) = w; } }
    }
};
typedef ProbScaleT<false> ProbScaleBf16;
struct ProbColScaleBf16 {
    static constexpr bool FP8 = false, PERM = true, GATHER = false;
    __device__ __forceinline__ const char* a_tile(const pg8::Unit& u) const { return u.A + (size_t)u.pm * (256 * 2048); }
    const bf16_t* A; const bf16_t* Bt; int nM, nN, G, c;
    bf16_t* O; int ldo; const float* cs;
    __device__ __forceinline__ bool next(int i, pg8::Unit& u) const {
        const long L = (long)i * G + c; if (L >= (long)nM * nN) return false;
        const int pm = (int)(L % nM), pn = (int)(L / nM);
        u.A = (const char*)A; u.B = (const char*)(Bt + (size_t)pn * 256 * 1024); u.pm = pm; u.pn = pn; u.e = 0; u.nvalid = 256; u.y0 = 0; u.aux = 0; return true; }
    __device__ __forceinline__ unsigned a_off(const pg8::Unit& u, int r) const { return 0u; }
    __device__ __forceinline__ void epi(const f32x4 (&acc)[2][2][4][2], const pg8::Unit& u, int wr, int wc, int fr, int fq) const {
        asm volatile("" : "+v"(fr), "+v"(fq));
        const float* cp = cs + u.pn * 256 + wc * 32 + 8 * fq;
        f32x4 sc[2][2];
#pragma unroll
        for (int bj = 0; bj < 2; ++bj)
#pragma unroll
            for (int n = 0; n < 2; ++n) sc[bj][n] = *(const f32x4*)(cp + bj * 128 + 4 * n);
        char* ub = (char*)O + ((size_t)(u.pm * 256 + wr * 64) * ldo + u.pn * 256 + wc * 32) * 2;
        const unsigned lo = (unsigned)(fr * ldo + 8 * fq) * 2u;
#pragma unroll
        for (int ai = 0; ai < 2; ++ai)
#pragma unroll
            for (int m = 0; m < 4; ++m) { char* rowp = ub + (size_t)(ai * 128 + m * 16) * ldo * 2 + lo;
#pragma unroll
                for (int bj = 0; bj < 2; ++bj) { const f32x4 v0 = acc[ai][bj][m][0] * sc[bj][0], v1 = acc[ai][bj][m][1] * sc[bj][1];
                    u32x4 w; w.x = cvt_pk_bf16(v0[0], v0[1]); w.y = cvt_pk_bf16(v0[2], v0[3]); w.z = cvt_pk_bf16(v1[0], v1[1]); w.w = cvt_pk_bf16(v1[2], v1[3]);
                    *(u32x4*)(rowp + bj * 256) = w; } }
    }
};
struct ProbKV {
    static constexpr bool FP8 = true, PERM = true, GATHER = true;
    __device__ __forceinline__ const char* a_tile(const pg8::Unit& u) const { return u.A; }
    LAS unsigned* gtab;
    const unsigned char* memb; const unsigned char* wckv; bf16_t* Kout; bf16_t* VTout; const float* rstdm; int G, c;
    __device__ __forceinline__ bool next(int i, pg8::Unit& u) const {
        const long L = (long)i * G + c; if (L >= 256) return false;
        if (L < 128) { u.pm = (int)(L & 31); u.pn = (int)(L >> 5); u.e = 0; u.A = (const char*)memb; u.B = (const char*)(wckv + (size_t)u.pn * 256 * 1024); }
        else { const int l2 = (int)L - 128; u.pm = l2 & 3; u.pn = l2 >> 2; u.e = 1; u.A = (const char*)(wckv + (size_t)1024 * 1024); u.B = (const char*)(memb + (size_t)u.pn * 256 * 1024); }
        u.nvalid = 256; u.y0 = 0; u.aux = 0; return true; }
    __device__ __forceinline__ unsigned a_off(const pg8::Unit& u, int r) const { return (unsigned)(u.pm * 256 + r) * 1024u; }
    __device__ __forceinline__ void epi(const f32x4 (&acc)[2][2][4][2], const pg8::Unit& u, int wr, int wc, int fr, int fq) const {
        asm volatile("" : "+v"(fr), "+v"(fq));
        const int ldo = u.e ? MROWS : 1024;
        char* ub = (char*)(u.e ? VTout : Kout) + ((size_t)(u.pm * 256 + wr * 64) * ldo + u.pn * 256 + wc * 32) * 2;
        const unsigned lo = (unsigned)(fr * ldo + 8 * fq) * 2u;
        float rsv[8]; f32x4 sc[2][2];
        if (u.e == 0) {
#pragma unroll
            for (int q = 0; q < 8; ++q) rsv[q] = rstdm[u.pm * 256 + wr * 64 + fr + (q >> 2) * 128 + (q & 3) * 16] * (1.0f / 64.0f);
#pragma unroll
            for (int bj = 0; bj < 2; ++bj)
#pragma unroll
                for (int n = 0; n < 2; ++n) sc[bj][n] = (f32x4){1.f, 1.f, 1.f, 1.f};
        } else {
#pragma unroll
            for (int q = 0; q < 8; ++q) rsv[q] = 1.0f / 64.0f;
            const float* cp = rstdm + u.pn * 256 + wc * 32 + 8 * fq;
#pragma unroll
            for (int bj = 0; bj < 2; ++bj)
#pragma unroll
                for (int n = 0; n < 2; ++n) sc[bj][n] = *(const f32x4*)(cp + bj * 128 + 4 * n); }
#pragma unroll
        for (int ai = 0; ai < 2; ++ai)
#pragma unroll
            for (int m = 0; m < 4; ++m) { const float rs = rsv[ai * 4 + m]; char* rowp = ub + (size_t)(ai * 128 + m * 16) * ldo * 2 + lo;
#pragma unroll
                for (int bj = 0; bj < 2; ++bj) { const f32x4 v0 = acc[ai][bj][m][0] * sc[bj][0] * rs, v1 = acc[ai][bj][m][1] * sc[bj][1] * rs;
                    u32x4 w; w.x = cvt_pk_bf16(v0[0], v0[1]); w.y = cvt_pk_bf16(v0[2], v0[3]); w.z = cvt_pk_bf16(v1[0], v1[1]); w.w = cvt_pk_bf16(v1[2], v1[3]);
                    *(u32x4*)(rowp + bj * 256) = w; } }
    }
};
template <bool F8, bool WF8, bool RF32> struct ProbResidT {
    static constexpr bool FP8 = F8, PERM = true, GATHER = F8;
    static constexpr int RB = F8 ? 1024 : 2048;
    __device__ __forceinline__ const char* a_tile(const pg8::Unit& u) const { return F8 ? u.A : u.A + (size_t)u.pm * (256 * RB); }
    LAS unsigned* gtab;
    const void* A; const void* Bt; int nM, nN, G, c;
    const float* rf; const bf16_t* rb; bf16_t* ob; unsigned char* of8; float* ssp;
    __device__ __forceinline__ bool next(int i, pg8::Unit& u) const {
        int pm, pn; if (!pg8::static_next(i, G, c, nM, nN, pm, pn)) return false;
        u.A = (const char*)A; u.B = (const char*)Bt + (size_t)pn * 256 * RB; u.pm = pm; u.pn = pn; u.e = 0; u.nvalid = 256; u.y0 = 0; u.aux = 0; return true; }
    __device__ __forceinline__ unsigned a_off(const pg8::Unit& u, int r) const { return (unsigned)(u.pm * 256 + r) * (unsigned)RB; }
    __device__ __forceinline__ void epi(const f32x4 (&acc)[2][2][4][2], const pg8::Unit& u, int wr, int wc, int fr, int fq) const {
        asm volatile("" : "+v"(fr), "+v"(fq));
        const int rowu = u.pm * 256 + wr * 64;
        const size_t uoff = (size_t)rowu * 1024 + u.pn * 256 + wc * 32;
        const unsigned lo = (unsigned)(fr * 1024 + 8 * fq);
        const float sc = F8 ? (1.0f / 64.0f) : 1.0f;
#pragma unroll
        for (int ai = 0; ai < 2; ++ai) {
            f32x4 rv[4][2][2];
#pragma unroll
            for (int m = 0; m < 4; ++m) { const size_t ro = uoff + (size_t)(ai * 128 + m * 16) * 1024;
#pragma unroll
                for (int bj = 0; bj < 2; ++bj) {
                    if constexpr (RF32) { rv[m][bj][0] = *(const GAS f32x4*)(rf + ro + lo + bj * 128); rv[m][bj][1] = *(const GAS f32x4*)(rf + ro + lo + bj * 128 + 4); }
                    else { const u32x4 w = *(const GAS u32x4*)(rb + ro + lo + bj * 128); rv[m][bj][0] = (f32x4){lo_bf(w.x), hi_bf(w.x), lo_bf(w.y), hi_bf(w.y)}; rv[m][bj][1] = (f32x4){lo_bf(w.z), hi_bf(w.z), lo_bf(w.w), hi_bf(w.w)}; } } }
#pragma unroll
            for (int m = 0; m < 4; ++m) { const size_t ro = uoff + (size_t)(ai * 128 + m * 16) * 1024; float ss = 0.f;
                unsigned pk[2][2];
#pragma unroll
                for (int bj = 0; bj < 2; ++bj) { const f32x4 v0 = acc[ai][bj][m][0] * sc + rv[m][bj][0], v1 = acc[ai][bj][m][1] * sc + rv[m][bj][1];
                    ss += (v0[0] * v0[0] + v0[1] * v0[1]) + (v0[2] * v0[2] + v0[3] * v0[3]) + (v1[0] * v1[0] + v1[1] * v1[1]) + (v1[2] * v1[2] + v1[3] * v1[3]);
                    u32x4 w; w.x = cvt_pk_bf16(v0[0], v0[1]); w.y = cvt_pk_bf16(v0[2], v0[3]); w.z = cvt_pk_bf16(v1[0], v1[1]); w.w = cvt_pk_bf16(v1[2], v1[3]);
                    *(u32x4*)(ob + ro + lo + bj * 128) = w;
                    if constexpr (WF8) { unsigned w0 = 0u, w1 = 0u;
                        w0 = __builtin_amdgcn_cvt_pk_fp8_f32(c8(v0[0]), c8(v0[1]), w0, false); w0 = __builtin_amdgcn_cvt_pk_fp8_f32(c8(v0[2]), c8(v0[3]), w0, true);
                        w1 = __builtin_amdgcn_cvt_pk_fp8_f32(c8(v1[0]), c8(v1[1]), w1, false); w1 = __builtin_amdgcn_cvt_pk_fp8_f32(c8(v1[2]), c8(v1[3]), w1, true);
                        pk[bj][0] = w0; pk[bj][1] = w1; } }
                if constexpr (WF8) {
                    const auto s0 = __builtin_amdgcn_permlane16_swap(pk[0][0], pk[1][0], false, false), s1 = __builtin_amdgcn_permlane16_swap(pk[0][1], pk[1][1], false, false);
                    *(u32x4*)(of8 + ro + lo + ((fq & 1) ? 120u : 0u)) = (u32x4){s0[0], s1[0], s0[1], s1[1]}; }
                ss = x16_sum(ss); ss = x32_sum(ss);
                if (fq == 0) ssp[(size_t)(rowu + ai * 128 + m * 16 + fr) * 16 + u.pn * 4 + wc] = ss; } }
    }
};
__device__ __forceinline__ size_t hid_tile_off(int rt) { return rt < 1024 ? (size_t)rt * (256 * 1024) : (WS_HID1 - WS_HID) + (size_t)(rt - 1024) * (256 * 1024); }
constexpr int MOE_TS = 0, MOE_ST = 33, MOE_CNT = 66, MOE_RTE = 100, MOE_WORDS = 100 + 264;
struct ProbMoe1 {
    static constexpr bool FP8 = true, PERM = true, GATHER = true;
    __device__ __forceinline__ const char* a_tile(const pg8::Unit& u) const { return u.A; }
    const unsigned char* hb; const unsigned char* w1b; const float* b1p; const float* rstd2; const unsigned* list; unsigned char* hid;
    const volatile LAS int* tab; LAS unsigned* gtab; int rt0, nrt, G, c;
    __device__ __forceinline__ bool next(int i, pg8::Unit& u) const {
        const long L = (long)i * G + c; if (L >= (long)nrt * 8) return false;
        const int gidx = (int)(L >> 8), within = (int)(L & 255), gsz = (nrt - gidx * 32) < 32 ? (nrt - gidx * 32) : 32;
        const int rtl = gidx * 32 + within % gsz, pn = within / gsz, rt = rt0 + rtl;
        const int e = ((const volatile LAS unsigned char*)(tab + MOE_RTE))[rt];
        const int idx0 = (rt - tab[MOE_TS + e]) * 256;
        u.A = (const char*)hb; u.B = (const char*)(w1b + ((size_t)e * 2048 + (size_t)pn * 256) * 1024); u.pm = rt; u.pn = pn; u.e = e; u.nvalid = tab[MOE_CNT + e] - idx0; u.y0 = idx0; u.aux = 0; return true; }
    __device__ __forceinline__ unsigned tok_of(const pg8::Unit& u, int r) const { const int rr = r < u.nvalid ? r : 0; return list[(size_t)u.e * T + u.y0 + rr]; }
    __device__ __forceinline__ unsigned a_off(const pg8::Unit& u, int r) const { return tok_of(u, r) * 1024u; }
    __device__ __forceinline__ void epi(const f32x4 (&acc)[2][2][4][2], const pg8::Unit& u, int wr, int wc, int fr, int fq) const {
        asm volatile("" : "+v"(fr), "+v"(fq));
        const float* bp = b1p + (size_t)u.e * 2048 + u.pn * 256 + wc * 32 + 8 * fq;
        const f32x4 bg0 = *(const f32x4*)(bp), bg1 = *(const f32x4*)(bp + 4), bl0 = *(const f32x4*)(bp + 128), bl1 = *(const f32x4*)(bp + 132);
        char* ub = (char*)hid + hid_tile_off(u.pm) + ((size_t)(wr * 64) * 1024 + u.pn * 128 + wc * 32);
        const unsigned lo = (unsigned)(fr * 1024 + 8 * fq);
        unsigned wk[2][2];
#pragma unroll
        for (int ai = 0; ai < 2; ++ai)
#pragma unroll
            for (int m = 0; m < 4; ++m) { const float rs = 1.0f / 64.0f;
                unsigned w[2];
#pragma unroll
                for (int n = 0; n < 2; ++n) { const f32x4 g4 = acc[ai][0][m][n] * rs + (n ? bg1 : bg0), l4 = acc[ai][1][m][n] * rs + (n ? bl1 : bl0);
                    unsigned wv = 0u;
#pragma unroll
                    for (int jp = 0; jp < 2; ++jp) {
                        f32x2 g2 = {fminf(g4[2 * jp], 7.0f), fminf(g4[2 * jp + 1], 7.0f)};
                        const f32x2 l2 = {__builtin_amdgcn_fmed3f(l4[2 * jp], -7.0f, 7.0f), __builtin_amdgcn_fmed3f(l4[2 * jp + 1], -7.0f, 7.0f)};
                        const f32x2 z2 = g2 * (-1.702f * 1.4426950408889634f);
                        const f32x2 d2 = (f32x2){__builtin_amdgcn_exp2f(z2[0]), __builtin_amdgcn_exp2f(z2[1])} + 1.0f;
                        const f32x2 r2 = {__builtin_amdgcn_rcpf(d2[0]), __builtin_amdgcn_rcpf(d2[1])};
                        const f32x2 o2 = (g2 * r2) * (l2 * 4.0f + 4.0f);
                        if (jp) wv = __builtin_amdgcn_cvt_pk_fp8_f32(o2[0], o2[1], wv, true); else wv = __builtin_amdgcn_cvt_pk_fp8_f32(o2[0], o2[1], wv, false); }
                    w[n] = wv; }
                wk[m & 1][0] = w[0]; wk[m & 1][1] = w[1];
                if (m & 1) {
                    const auto s0 = __builtin_amdgcn_permlane16_swap(wk[0][0], wk[1][0], false, false), s1 = __builtin_amdgcn_permlane16_swap(wk[0][1], wk[1][1], false, false);
                    *(u32x4*)(ub + (size_t)(ai * 128 + (m - 1) * 16) * 1024 + lo + ((fq & 1) ? 16u * 1024u - 8u : 0u)) = (u32x4){s0[0], s1[0], s0[1], s1[1]}; } }
    }
};
struct ProbMoe2 {
    static constexpr bool FP8 = true, PERM = true, GATHER = true;
    __device__ __forceinline__ const char* a_tile(const pg8::Unit& u) const { return u.A; }
    const unsigned char* hid; const unsigned char* w2b; const float* b2; unsigned char* y;
    const volatile LAS int* tab; LAS unsigned* gtab; int rt0, nrt, G, c;
    __device__ __forceinline__ bool next(int i, pg8::Unit& u) const {
        const long L = (long)i * G + c; if (L >= (long)nrt * 4) return false;
        const int gidx = (int)(L >> 8), within = (int)(L & 255), gsz = (nrt - gidx * 64) < 64 ? (nrt - gidx * 64) : 64;
        const int rtl = gidx * 64 + within % gsz, pn = within / gsz, rt = rt0 + rtl;
        const int e = ((const volatile LAS unsigned char*)(tab + MOE_RTE))[rt];
        const int idx0 = (rt - tab[MOE_TS + e]) * 256;
        u.A = (const char*)hid; u.B = (const char*)(w2b + ((size_t)e * 1024 + (size_t)pn * 256) * 1024); u.pm = rt; u.pn = pn; u.e = e; u.nvalid = tab[MOE_CNT + e] - idx0; u.y0 = tab[MOE_ST + e] + idx0; u.aux = 0; return true; }
    __device__ __forceinline__ unsigned a_off(const pg8::Unit& u, int r) const { return (unsigned)(hid_tile_off(u.pm) + (size_t)r * 1024u); }
    __device__ __forceinline__ void epi(const f32x4 (&acc)[2][2][4][2], const pg8::Unit& u, int wr, int wc, int fr, int fq) const {
        asm volatile("" : "+v"(fr), "+v"(fq));
        const float* bp = b2 + (size_t)u.e * 1024 + u.pn * 256 + wc * 32 + 8 * fq;
        f32x4 bv[2][2];
#pragma unroll
        for (int bj = 0; bj < 2; ++bj)
#pragma unroll
            for (int n = 0; n < 2; ++n) bv[bj][n] = *(const f32x4*)(bp + bj * 128 + 4 * n);
        char* ub = (char*)y + (((size_t)u.y0 + wr * 64) * 1024 + u.pn * 256 + wc * 32);
        const unsigned lo2 = (unsigned)(fr * 1024 + 8 * fq) + ((fq & 1) ? 120u : 0u);
        const int r0 = wr * 64 + fr;
#pragma unroll
        for (int ai = 0; ai < 2; ++ai)
#pragma unroll
            for (int m = 0; m < 4; ++m) { const int r = r0 + ai * 128 + m * 16;
                unsigned pk[2][2];
#pragma unroll
                for (int bj = 0; bj < 2; ++bj) { const f32x4 v0 = acc[ai][bj][m][0] * (1.0f / 16.0f) + bv[bj][0] * 16.0f, v1 = acc[ai][bj][m][1] * (1.0f / 16.0f) + bv[bj][1] * 16.0f;
                    unsigned w0 = 0u, w1 = 0u;
                    w0 = __builtin_amdgcn_cvt_pk_fp8_f32(c8(v0[0]), c8(v0[1]), w0, false); w0 = __builtin_amdgcn_cvt_pk_fp8_f32(c8(v0[2]), c8(v0[3]), w0, true);
                    w1 = __builtin_amdgcn_cvt_pk_fp8_f32(c8(v1[0]), c8(v1[1]), w1, false); w1 = __builtin_amdgcn_cvt_pk_fp8_f32(c8(v1[2]), c8(v1[3]), w1, true);
                    pk[bj][0] = w0; pk[bj][1] = w1; }
                const auto s0 = __builtin_amdgcn_permlane16_swap(pk[0][0], pk[1][0], false, false), s1 = __builtin_amdgcn_permlane16_swap(pk[0][1], pk[1][1], false, false);
                if (r < u.nvalid) *(u32x4*)(ub + (size_t)(ai * 128 + m * 16) * 1024 + lo2) = (u32x4){s0[0], s1[0], s0[1], s1[1]}; }
    }
};

#define XB_TMO      128
#define XB_XCNT(j)  (256  + 64 * (j))
#define XB_XSUB(j)  (1280 + 64 * (j))
#define XB_XGEN(j)  (2304 + 64 * (j))
#define XB_TOP      3328
#define XB_TOPGEN   3392
#define XCD_BAR_WORDS 3456
#define XB_SPIN_CAP (1u << 18)
__device__ __forceinline__ unsigned xb_ld(unsigned* p)              { return __hip_atomic_load(p, __ATOMIC_RELAXED, __HIP_MEMORY_SCOPE_AGENT); }
__device__ __forceinline__ unsigned xb_add(unsigned* p, unsigned v) { return __hip_atomic_fetch_add(p, v, __ATOMIC_RELAXED, __HIP_MEMORY_SCOPE_AGENT); }
__device__ __forceinline__ unsigned xb_xcc_id() { return (unsigned)__builtin_amdgcn_s_getreg((3 << 11) | 20) & 0xFu; }
#define XB_SPIN(cond, bar) do { unsigned _sp = 0; while (cond) { __builtin_amdgcn_s_sleep(1); \
    if ((++_sp & 255u) == 0u) { if (xb_ld(&(bar)[XB_TMO])) break; if (_sp > XB_SPIN_CAP) { atomicAdd(&(bar)[XB_TMO], 1u); break; } } } } while (0)
struct XcdBarrier { unsigned* bar; unsigned x; volatile LAS unsigned* st; int wave; };
__device__ __forceinline__ XcdBarrier xcd_barrier_post(unsigned* bar, volatile LAS unsigned* st, int wave) {
    XcdBarrier b; b.bar = bar; b.x = xb_xcc_id(); b.st = st; b.wave = wave;
    if (wave == 0 && lane_id() == 0) (void)xb_add(&bar[XB_XCNT(b.x)], 1u);
    return b;
}
__device__ __forceinline__ void xcd_barrier_complete(unsigned* bar, unsigned x, unsigned& nloc, unsigned& nx) {
    const unsigned G = gridDim.x * gridDim.y * gridDim.z;
    unsigned sum, cnt, mine, sp = 0u;
    for (;;) {
        sum = 0u; cnt = 0u; mine = 0u;
#pragma unroll
        for (unsigned j = 0; j < 16; ++j) { const unsigned c = xb_ld(&bar[XB_XCNT(j)]); sum += c; cnt += (c > 0u) ? 1u : 0u; mine = (j == x) ? c : mine; }
        if (sum == G) break;
        __builtin_amdgcn_s_sleep(1);
        if ((++sp & 255u) == 0u) { if (xb_ld(&bar[XB_TMO])) break; if (sp > XB_SPIN_CAP) { atomicAdd(&bar[XB_TMO], 1u); break; } }
    }
    nloc = mine > 0u ? mine : 1u; nx = cnt > 0u ? cnt : 1u;
}
__device__ __forceinline__ void xcd_barrier(const XcdBarrier& b) {
    asm volatile("s_waitcnt vmcnt(0)" ::: "memory");
    __syncthreads();
    if (b.wave == 0 && lane_id() == 0) {
        unsigned* bar = b.bar;
        __builtin_amdgcn_s_waitcnt(0);
        unsigned nloc = b.st[0], nx = b.st[1];
        if (nloc == 0u) { xcd_barrier_complete(bar, b.x, nloc, nx); b.st[0] = nloc; b.st[1] = nx; }
        const unsigned old = xb_add(&bar[XB_XSUB(b.x)], 1u);
        const unsigned gen = old / nloc;
        if (old + 1u == (gen + 1u) * nloc) {
            __builtin_amdgcn_fence(__ATOMIC_RELEASE, "agent");
            asm volatile("s_waitcnt vmcnt(0)" ::: "memory");
            const unsigned og = xb_add(&bar[XB_TOP], 1u);
            const unsigned tg = og / nx;
            if (og + 1u == (tg + 1u) * nx) xb_add(&bar[XB_TOPGEN], 1u);
            else XB_SPIN(xb_ld(&bar[XB_TOPGEN]) == tg, bar);
            __builtin_amdgcn_fence(__ATOMIC_ACQUIRE, "agent");
            xb_add(&bar[XB_XGEN(b.x)], 1u);
            asm volatile("s_waitcnt vmcnt(0)" ::: "memory");
        } else {
            XB_SPIN(xb_ld(&bar[XB_XGEN(b.x)]) == gen, bar);
            __builtin_amdgcn_fence(__ATOMIC_ACQUIRE, "agent");
            asm volatile("s_waitcnt vmcnt(0)" ::: "memory");
        }
    }
    __syncthreads();
}

typedef float f32x16 __attribute__((ext_vector_type(16)));
__device__ __forceinline__ int pi32(int i) { return (i & ~12) | ((i & 4) << 1) | ((i & 8) >> 1); }
__device__ __forceinline__ f32x16 zero16() { f32x16 z;
#pragma unroll
    for (int r = 0; r < 16; ++r) z[r] = 0.f;
    return z; }

__device__ __forceinline__ void xattn_phase(LAS unsigned char* lds, const bf16_t* Q, const bf16_t* Kb, const bf16_t* VT, unsigned char* O, int G, int bx, int wave) {
    const int lane = lane_id(), i = lane & 31, hh = lane >> 5;
    LAS unsigned char* ring = lds;
    bf16x8 qf[16];
#define XA_QLOAD(uid_) do { const int u_ = (uid_); const bf16_t* qp_ = Q + (size_t)((u_ >> 5) * SEQ + (u_ & 7) * 256 + wave * 32 + i) * 1024 + ((u_ >> 3) & 3) * 256 + 8 * hh; \
        _Pragma("unroll") for (int ds = 0; ds < 16; ++ds) qf[ds] = *(const bf16x8*)(qp_ + 16 * ds); } while (0)
    if (bx < BATCH * 4 * 8) XA_QLOAD(bx);
    for (int uid = bx; uid < BATCH * 4 * 8; uid += G) {
        const int b = uid >> 5, h = (uid >> 3) & 3, qblk = uid & 7;
        const int q0 = qblk * 256 + wave * 32;
        const bf16_t* ksrc = Kb + (size_t)(b * MEMLEN + pi32(i)) * 1024 + h * 256 + 16 * wave + 8 * hh;
        const bf16_t* vsrc = VT + (size_t)(h * 256 + i) * MROWS + b * MEMLEN + 32 * (wave >> 1) + 16 * (wave & 1) + 8 * hh;
#define XA_ISSUE(st_) do { LAS unsigned char* sl_ = ring + ((st_) & 3) * 16384; \
        if ((st_) < 8) { const bf16_t* g_ = ksrc + (size_t)(st_) * 32 * 1024; \
            __builtin_amdgcn_global_load_lds((const unsigned*)g_, (LAS unsigned*)(sl_ + wave * 1024), 16, 0, 0); \
            __builtin_amdgcn_global_load_lds((const unsigned*)(g_ + 128), (LAS unsigned*)(sl_ + (8 + wave) * 1024), 16, 0, 0); } \
        else { const bf16_t* g_ = vsrc + (size_t)((st_) - 8) * 32 * MROWS; \
            __builtin_amdgcn_global_load_lds((const unsigned*)g_, (LAS unsigned*)(sl_ + wave * 1024), 16, 0, 0); \
            __builtin_amdgcn_global_load_lds((const unsigned*)(g_ + 128), (LAS unsigned*)(sl_ + (8 + wave) * 1024), 16, 0, 0); } } while (0)
#define XA_VMCNT(n) (((n) & 15) | (7 << 4) | (15 << 8) | (((n) >> 4) << 14))
#define XA_SYNC(st_) do { const int n_ = ((st_) >= 11 ? 1 : 0) + ((st_) <= 14 ? 2 : 0) + ((st_) >= 10 ? 1 : 0) + ((st_) <= 13 ? 2 : 0) + ((st_) >= 9 ? 1 : 0) + (((st_) >= 8 && (st_) <= 10) ? 16 : 0); \
          \
        asm volatile("" ::: "memory"); \
        if (n_ == 3) __builtin_amdgcn_s_waitcnt(XA_VMCNT(3)); else if (n_ == 4) __builtin_amdgcn_s_waitcnt(XA_VMCNT(4)); else if (n_ == 5) __builtin_amdgcn_s_waitcnt(XA_VMCNT(5)); \
        else if (n_ == 20) __builtin_amdgcn_s_waitcnt(XA_VMCNT(20)); else if (n_ == 21) __builtin_amdgcn_s_waitcnt(XA_VMCNT(21)); else if (n_ == 22) __builtin_amdgcn_s_waitcnt(XA_VMCNT(22)); \
        else __builtin_amdgcn_s_waitcnt(XA_VMCNT(7)); \
        asm volatile("" ::: "memory"); \
        __builtin_amdgcn_s_barrier(); asm volatile("" ::: "memory"); if ((st_) + 3 < 16) XA_ISSUE((st_) + 3); } while (0)
        XA_ISSUE(0); XA_ISSUE(1); XA_ISSUE(2);
        f32x16 s[8];
#pragma unroll
        for (int kt = 0; kt < 8; ++kt) { XA_SYNC(kt);
            const LAS unsigned char* sl = ring + (kt & 3) * 16384 + lane * 16;
            f32x16 acc = zero16();
#pragma unroll
            for (int q4 = 0; q4 < 4; ++q4) { __builtin_amdgcn_sched_barrier(0);
#pragma unroll
                for (int d4 = 0; d4 < 4; ++d4) { const int ds = q4 * 4 + d4; acc = __builtin_amdgcn_mfma_f32_32x32x16_bf16(*(const LAS bf16x8*)(sl + ds * 1024), qf[ds], acc, 0, 0, 0); } }
            s[kt] = acc; }
        float m = -INFINITY;
#pragma unroll
        for (int kt = 0; kt < 8; ++kt)
#pragma unroll
            for (int r = 0; r < 16; ++r) m = fmaxf(m, s[kt][r]);
        m = x32_max(m);
        const float c = 0.0625f * 1.4426950408889634f; float l = 0.f; const float mc = m * c;
        u32x4 pf[8][2];
#pragma unroll
        for (int kt = 0; kt < 8; ++kt) {
#pragma unroll
            for (int r = 0; r < 16; ++r) { const float p = __builtin_amdgcn_exp2f(s[kt][r] * c - mc); s[kt][r] = p; l += p; }
#pragma unroll
            for (int sb = 0; sb < 2; ++sb) { pf[kt][sb].x = cvt_pk_bf16(s[kt][8 * sb + 0], s[kt][8 * sb + 1]); pf[kt][sb].y = cvt_pk_bf16(s[kt][8 * sb + 2], s[kt][8 * sb + 3]);
                pf[kt][sb].z = cvt_pk_bf16(s[kt][8 * sb + 4], s[kt][8 * sb + 5]); pf[kt][sb].w = cvt_pk_bf16(s[kt][8 * sb + 6], s[kt][8 * sb + 7]); } }
        l = x32_sum(l);
        const float il = 1.0f / l;
        XA_QLOAD(uid + G < BATCH * 4 * 8 ? uid + G : uid);
        unsigned char* op = O + (size_t)(b * SEQ + q0 + i) * 1024 + h * 256 + 16 * hh;
#pragma unroll
        for (int dvt = 0; dvt < 8; ++dvt) { XA_SYNC(8 + dvt);
            const LAS unsigned char* sl = ring + (dvt & 3) * 16384 + lane * 16;
            f32x16 oacc = zero16();
#pragma unroll
            for (int q4 = 0; q4 < 4; ++q4) { __builtin_amdgcn_sched_barrier(0);
#pragma unroll
                for (int f4 = 0; f4 < 4; ++f4) { const int f = q4 * 4 + f4; oacc = __builtin_amdgcn_mfma_f32_32x32x16_bf16(*(const LAS bf16x8*)(sl + f * 1024), __builtin_bit_cast(bf16x8, pf[f >> 1][f & 1]), oacc, 0, 0, 0); } }
            unsigned wg[4];
#pragma unroll
            for (int g = 0; g < 4; ++g) { unsigned w = 0u; w = __builtin_amdgcn_cvt_pk_fp8_f32(c8(oacc[4 * g] * il), c8(oacc[4 * g + 1] * il), w, false); w = __builtin_amdgcn_cvt_pk_fp8_f32(c8(oacc[4 * g + 2] * il), c8(oacc[4 * g + 3] * il), w, true); wg[g] = w; }
            { const auto s02 = __builtin_amdgcn_permlane32_swap(wg[0], wg[2], false, false), s13 = __builtin_amdgcn_permlane32_swap(wg[1], wg[3], false, false);
              *(u32x4*)(op + dvt * 32) = (u32x4){s02[0], s02[1], s13[0], s13[1]}; } }
#undef XA_ISSUE
#undef XA_SYNC
    }
}

__device__ __forceinline__ void diffattn_phase(LAS unsigned char* lds, LAS float* dgl, const bf16_t* P2, const bf16_t* VT, const float* dng, const float lam, bf16_t* cat, int G, int vx, int wave) {
    const int lane = lane_id(), i_ = lane & 31, hh_ = lane >> 5;
    dgl[wave * 64 + lane] = dng[wave * 64 + lane];
    __syncthreads();
    LAS unsigned char* ring = lds;
    LAS unsigned char* ql = lds + 65536 + wave * 8192 + lane * 16;
    const float c = 0.125f * 1.4426950408889634f;
    for (int pu = vx; pu < BATCH * 4 * 4; pu += G)
        for (int side = 0; side < 2; ++side) {
            const int bh = pu >> 2, x = pu & 3, qb = side ? 7 - x : x, b = bh >> 2, h = bh & 3, q0 = qb * 256 + wave * 32;
            const int ntile = 8 * qb + 8, ktw = 8 * qb + wave;
            int i = i_, hh = hh_; asm volatile("" : "+v"(i), "+v"(hh));
            const bf16_t* qp = P2 + (size_t)(b * SEQ + q0 + i) * NP2 + h * 128 + 8 * hh;
            { bf16x8 t[8];
#pragma unroll
              for (int f = 0; f < 8; ++f) t[f] = *(const bf16x8*)(qp + 16 * f);
#pragma unroll
              for (int f = 0; f < 8; ++f) *(LAS bf16x8*)(ql + f * 1024) = t[f]; }
            const char* kbase = (const char*)(P2 + (size_t)b * SEQ * NP2 + 512 + h * 128 + (wave >> 2) * 64 + 16 * (wave & 3));
            const char* vbase = (const char*)(VT + (size_t)(h * 128 + 32 * (wave >> 1)) * T + (size_t)b * SEQ + 16 * (wave & 1));
            const unsigned koff = (unsigned)(pi32(i) * NP2 + 8 * hh) * 2u, voff = (unsigned)(i * T + 8 * hh) * 2u;
#define DA_ISSUE(kt_) do { LAS unsigned char* sl_ = ring + ((kt_) & 3) * 16384; \
        __builtin_amdgcn_global_load_lds((const unsigned*)(kbase + (size_t)(kt_) * (32 * NP2 * 2) + koff), (LAS unsigned*)(sl_ + wave * 1024), 16, 0, 0); \
        __builtin_amdgcn_global_load_lds((const unsigned*)(vbase + (kt_) * 64 + voff), (LAS unsigned*)(sl_ + (8 + wave) * 1024), 16, 0, 0); } while (0)
            f32x16 o1[4], o2[4];
#pragma unroll
            for (int d = 0; d < 4; ++d) { o1[d] = zero16(); o2[d] = zero16(); }
            float mc1 = -INFINITY, mc2 = -INFINITY, l1 = 0.f, l2 = 0.f;
            u32x4 pp1[2], pp2[2];
#pragma unroll
            for (int sb = 0; sb < 2; ++sb) { pp1[sb] = (u32x4){0u, 0u, 0u, 0u}; pp2[sb] = pp1[sb]; }
            DA_ISSUE(0); DA_ISSUE(1);
            for (int kt = 0; kt <= ntile; ++kt) {
                if (kt < ntile) {
                    if (kt + 1 < ntile) asm volatile("s_waitcnt vmcnt(2)" ::: "memory"); else asm volatile("s_waitcnt vmcnt(0)" ::: "memory");
                    __builtin_amdgcn_s_barrier(); asm volatile("" ::: "memory");
                    if (kt + 2 < ntile) DA_ISSUE(kt + 2);
                }
                if (kt <= ktw + 1) {
                    const LAS unsigned char* sl = ring + (kt & 3) * 16384 + lane * 16;
                    const LAS unsigned char* sp = ring + ((kt == 0 ? 0 : kt - 1) & 3) * 16384 + lane * 16;
                    f32x16 s1 = zero16(), s2 = zero16();
#pragma unroll
                    for (int ds = 0; ds < 4; ++ds) { s1 = __builtin_amdgcn_mfma_f32_32x32x16_bf16(*(const LAS bf16x8*)(sl + ds * 1024), *(const LAS bf16x8*)(ql + ds * 1024), s1, 0, 0, 0);
                        s2 = __builtin_amdgcn_mfma_f32_32x32x16_bf16(*(const LAS bf16x8*)(sl + (4 + ds) * 1024), *(const LAS bf16x8*)(ql + (4 + ds) * 1024), s2, 0, 0, 0);
                        if (ds & 1) __builtin_amdgcn_sched_barrier(0); }
                    if (kt >= ktw) { const int lim = (kt == ktw) ? i : -1;
#pragma unroll
                        for (int r = 0; r < 16; ++r) { const int ko = 16 * (r >> 3) + 8 * hh + (r & 7); if (ko > lim) { s1[r] = -INFINITY; s2[r] = -INFINITY; } } }
                    float f1 = 1.f, f2 = 1.f; bool rs1, rs2;
                    { float tm = s1[0];
#pragma unroll
                      for (int r = 1; r < 16; ++r) tm = fmaxf(tm, s1[r]);
                      tm = x32_max(tm); const float tmc = tm * c; rs1 = __any(tmc > mc1 + 8.0f);
                      if (rs1) { const float mn = fmaxf(mc1, tmc); f1 = __builtin_amdgcn_exp2f(mc1 - mn); mc1 = mn; } }
                    { float tm = s2[0];
#pragma unroll
                      for (int r = 1; r < 16; ++r) tm = fmaxf(tm, s2[r]);
                      tm = x32_max(tm); const float tmc = tm * c; rs2 = __any(tmc > mc2 + 8.0f);
                      if (rs2) { const float mn = fmaxf(mc2, tmc); f2 = __builtin_amdgcn_exp2f(mc2 - mn); mc2 = mn; } }
                    float ls1 = 0.f, ls2 = 0.f; u32x4 pn1[2], pn2[2];
#define DA_SM(j) do { { const float pv_ = __builtin_amdgcn_exp2f(s1[j] * c - mc1); s1[j] = pv_; ls1 += pv_; } { const float pv_ = __builtin_amdgcn_exp2f(s2[j] * c - mc2); s2[j] = pv_; ls2 += pv_; } \
                        if ((j) & 1) { pn1[(j) >> 3][((j) & 7) >> 1] = cvt_pk_bf16(s1[(j) - 1], s1[j]); pn2[(j) >> 3][((j) & 7) >> 1] = cvt_pk_bf16(s2[(j) - 1], s2[j]); } } while (0)
                    { bf16x8 va, vb;
#define DA_VLD(p) (*(const LAS bf16x8*)(sp + (8 + ((p) & 3) * 2 + ((p) >> 2)) * 1024))
#define DA_SLOT(j, VF, LDNEXT) do { if ((j) & 1) o2[((j) >> 1) & 3] = __builtin_amdgcn_mfma_f32_32x32x16_bf16(VF, __builtin_bit_cast(bf16x8, pp2[(j) >> 3]), o2[((j) >> 1) & 3], 0, 0, 0); \
                            else o1[((j) >> 1) & 3] = __builtin_amdgcn_mfma_f32_32x32x16_bf16(VF, __builtin_bit_cast(bf16x8, pp1[(j) >> 3]), o1[((j) >> 1) & 3], 0, 0, 0); \
                            LDNEXT; DA_SM(j); __builtin_amdgcn_sched_barrier(0); } while (0)
                      va = DA_VLD(0);
                      __builtin_amdgcn_sched_barrier(0);
                      DA_SLOT(0, va, vb = DA_VLD(1)); DA_SLOT(1, va, (void)0); DA_SLOT(2, vb, va = DA_VLD(2)); DA_SLOT(3, vb, (void)0);
                      DA_SLOT(4, va, vb = DA_VLD(3)); DA_SLOT(5, va, (void)0); DA_SLOT(6, vb, va = DA_VLD(4)); DA_SLOT(7, vb, (void)0);
                      DA_SLOT(8, va, vb = DA_VLD(5)); DA_SLOT(9, va, (void)0); DA_SLOT(10, vb, va = DA_VLD(6)); DA_SLOT(11, vb, (void)0);
                      DA_SLOT(12, va, vb = DA_VLD(7)); DA_SLOT(13, va, (void)0); DA_SLOT(14, vb, (void)0); DA_SLOT(15, vb, (void)0);
#undef DA_VLD
#undef DA_SLOT
                    }
#undef DA_SM
                    l1 = l1 * f1 + ls1; l2 = l2 * f2 + ls2;
                    if (rs1) {
#pragma unroll
                        for (int d = 0; d < 4; ++d)
#pragma unroll
                            for (int r = 0; r < 16; ++r) o1[d][r] *= f1; }
                    if (rs2) {
#pragma unroll
                        for (int d = 0; d < 4; ++d)
#pragma unroll
                            for (int r = 0; r < 16; ++r) o2[d][r] *= f2; }
#pragma unroll
                    for (int sb = 0; sb < 2; ++sb) { pp1[sb] = pn1[sb]; pp2[sb] = pn2[sb]; }
                }
            }
#undef DA_ISSUE
            l1 = x32_sum(l1); l2 = x32_sum(l2);
            int ie = i, he = hh; asm volatile("" : "+v"(ie), "+v"(he));
            const float i1 = 1.0f / l1, i2 = lam / l2; float ss = 0.f;
#pragma unroll
            for (int d = 0; d < 4; ++d)
#pragma unroll
                for (int r = 0; r < 16; ++r) { const float o = o1[d][r] * i1 - o2[d][r] * i2; o1[d][r] = o; ss += o * o; }
            ss = x32_sum(ss);
            const float rn = rsqrtf(ss * (1.0f / 128.0f) + EPS) * (1.0f - LAMBDA_INIT);
            bf16_t* op = cat + (size_t)(b * SEQ + q0 + ie) * DM + h * 128 + 8 * he;
            const LAS float* gp = dgl + h * 128 + 4 * he;
#pragma unroll
            for (int d = 0; d < 4; ++d)
#pragma unroll
                for (int g2 = 0; g2 < 2; ++g2) { u32x2 w[2];
#pragma unroll
                    for (int q = 0; q < 2; ++q) { const int g = 2 * g2 + q; const f32x4 gv = *(const LAS f32x4*)(gp + d * 32 + 8 * g);
                        w[q].x = cvt_pk_bf16(o1[d][4 * g] * rn * gv[0], o1[d][4 * g + 1] * rn * gv[1]); w[q].y = cvt_pk_bf16(o1[d][4 * g + 2] * rn * gv[2], o1[d][4 * g + 3] * rn * gv[3]); }
                    const auto sa = __builtin_amdgcn_permlane32_swap(w[0].x, w[1].x, false, false), sb = __builtin_amdgcn_permlane32_swap(w[0].y, w[1].y, false, false);
                    *(u32x4*)(op + d * 32 + 16 * g2) = (u32x4){sa[0], sb[0], sa[1], sb[1]}; }
        }
}

__device__ __forceinline__ void mlstm_prep_phase(LAS unsigned char* lds, const bf16_t* P2, const bf16_t* VT, const float* gates, const float* conv_w, const float* conv_b,
                                                 bf16_t* QM, bf16_t* KM, float* BC, float* AV, float* AM, float* CH, float* NLOC, float* CLOC, int G, int vx, int wave) {
    const int lane = lane_id(), i = lane & 31, hh = lane >> 5;
    LAS unsigned char* kl = lds + wave * 16384;
    for (int task = vx * 8 + wave; task < BATCH * 4 * 16; task += G * 8) {
        const int bh = task >> 4, c = task & 15, b = bh >> 2, h = bh & 3;
        const int t0 = b * SEQ + c * 128, tA = t0 + 2 * lane;
        const float lf0 = gates[(size_t)tA * 8 + 4 + h], lf1 = gates[(size_t)(tA + 1) * 8 + 4 + h], ig0 = gates[(size_t)tA * 8 + h], ig1 = gates[(size_t)(tA + 1) * 8 + h];
        float incl = lf0 + lf1;
#pragma unroll
        for (int off = 1; off < 64; off <<= 1) { const float v = __shfl_up(incl, off); if (lane >= off) incl += v; }
        const float bc1 = incl, bc0 = incl - lf1, blast = __shfl(incl, 63);
        const float a0 = ig0 - bc0, a1 = ig1 - bc1;
        float pm = fmaxf(a0, a1);
#pragma unroll
        for (int off = 1; off < 64; off <<= 1) { const float v = __shfl_up(pm, off); if (lane >= off) pm = fmaxf(pm, v); }
        const float pmprev = __shfl_up(pm, 1);
        const float am1 = pm, am0 = (lane > 0) ? fmaxf(pmprev, a0) : a0, amall = __shfl(pm, 63);
        const float ws0 = __expf(a0 - amall), ws1 = __expf(a1 - amall);
        *(f32x2*)(BC + (size_t)h * T + tA) = (f32x2){bc0, bc1};
        *(f32x2*)(AV + (size_t)h * T + tA) = (f32x2){a0, a1};
        *(f32x2*)(AM + (size_t)h * T + tA) = (f32x2){am0, am1};
        if (lane == 0) { CH[task * 2] = blast; CH[task * 2 + 1] = blast + amall; }
        {
            const int r8 = lane >> 3, cg = lane & 7;
            float cw[2][5][8];
#pragma unroll
            for (int part = 0; part < 2; ++part) { const int ch0 = (part ? 256 : 0) + h * 64 + 8 * cg;
#pragma unroll
                for (int k = 0; k < 4; ++k) { const f32x4 a = *(const f32x4*)(conv_w + k * 512 + ch0), bq = *(const f32x4*)(conv_w + k * 512 + ch0 + 4);
#pragma unroll
                    for (int j = 0; j < 4; ++j) { cw[part][k][j] = a[j]; cw[part][k][4 + j] = bq[j]; } }
                { const f32x4 a = *(const f32x4*)(conv_b + ch0), bq = *(const f32x4*)(conv_b + ch0 + 4);
#pragma unroll
                    for (int j = 0; j < 4; ++j) { cw[part][4][j] = a[j]; cw[part][4][4 + j] = bq[j]; } } }
#pragma unroll 4
            for (int jb = 0; jb < 16; ++jb) {
                const int p = 8 * jb + r8, tg = t0 + p, tseq = c * 128 + p;
                const float wa = __shfl(ws0, p >> 1), wb = __shfl(ws1, p >> 1); const float wsp = (p & 1) ? wb : wa;
                u32x4 uw[2][4];
#pragma unroll
                for (int part = 0; part < 2; ++part)
#pragma unroll
                    for (int k = 0; k < 4; ++k) { uw[part][k] = (u32x4){0u, 0u, 0u, 0u};
                        if (tseq - 3 + k >= 0) uw[part][k] = *(const u32x4*)(P2 + (size_t)(tg - 3 + k) * NP2 + 1024 + (part ? 256 : 0) + h * 64 + 8 * cg); }
#pragma unroll
                for (int part = 0; part < 2; ++part) { float y[8];
#pragma unroll
                    for (int j = 0; j < 8; ++j) { float pj = cw[part][4][j];
#pragma unroll
                        for (int k = 0; k < 4; ++k) { const unsigned wv = (j < 2) ? uw[part][k].x : (j < 4) ? uw[part][k].y : (j < 6) ? uw[part][k].z : uw[part][k].w; pj += cw[part][k][j] * ((j & 1) ? hi_bf(wv) : lo_bf(wv)); }
                        y[j] = pj * __builtin_amdgcn_rcpf(1.0f + __expf(-pj)); }
                    if (part == 0) { u32x4 w; w.x = cvt_pk_bf16(y[0] * 0.125f, y[1] * 0.125f); w.y = cvt_pk_bf16(y[2] * 0.125f, y[3] * 0.125f); w.z = cvt_pk_bf16(y[4] * 0.125f, y[5] * 0.125f); w.w = cvt_pk_bf16(y[6] * 0.125f, y[7] * 0.125f);
                        *(u32x4*)(QM + (size_t)tg * 256 + h * 64 + 8 * cg) = w; }
                    else { u32x4 w; w.x = cvt_pk_bf16(y[0], y[1]); w.y = cvt_pk_bf16(y[2], y[3]); w.z = cvt_pk_bf16(y[4], y[5]); w.w = cvt_pk_bf16(y[6], y[7]);
                        *(u32x4*)(KM + (size_t)tg * 256 + h * 64 + 8 * cg) = w;
#pragma unroll
                        for (int j = 0; j < 8; ++j) { const int d = 8 * cg + j;
                            *(LAS unsigned short*)(kl + d * 256 + ((jb ^ (d & 15)) * 16) + r8 * 2) = (unsigned short)f2bf(y[j] * wsp); } } }
            }
        }
        { float ns = 0.f;
#pragma unroll
          for (int cq = 0; cq < 16; ++cq) { const u32x4 w = *(const LAS u32x4*)(kl + lane * 256 + ((cq ^ (lane & 15)) * 16));
              ns += (lo_bf(w.x) + hi_bf(w.x)) + (lo_bf(w.y) + hi_bf(w.y)) + (lo_bf(w.z) + hi_bf(w.z)) + (lo_bf(w.w) + hi_bf(w.w)); }
          NLOC[(size_t)task * 64 + lane] = ns; }
        f32x16 acc[4][2];
#pragma unroll
        for (int et = 0; et < 4; ++et) { acc[et][0] = zero16(); acc[et][1] = zero16(); }
        const bf16_t* vp = VT + (size_t)(512 + h * 128 + i) * T + t0 + 8 * hh;
#pragma unroll
        for (int k2 = 0; k2 < 8; k2 += 2) {
            bf16x8 af[2][4];
#pragma unroll
            for (int q = 0; q < 2; ++q)
#pragma unroll
                for (int et = 0; et < 4; ++et) af[q][et] = *(const bf16x8*)(vp + (size_t)et * 32 * T + 16 * (k2 + q));
            __builtin_amdgcn_sched_barrier(0);
#pragma unroll
            for (int q = 0; q < 2; ++q) { const int ks = k2 + q; bf16x8 bfr[2];
#pragma unroll
                for (int dt = 0; dt < 2; ++dt) { const int d = 32 * dt + i; bfr[dt] = *(const LAS bf16x8*)(kl + d * 256 + (((2 * ks + hh) ^ (d & 15)) * 16)); }
#pragma unroll
                for (int et = 0; et < 4; ++et) {
                    acc[et][0] = __builtin_amdgcn_mfma_f32_32x32x16_bf16(af[q][et], bfr[0], acc[et][0], 0, 0, 0); acc[et][1] = __builtin_amdgcn_mfma_f32_32x32x16_bf16(af[q][et], bfr[1], acc[et][1], 0, 0, 0); } }
            __builtin_amdgcn_sched_barrier(0);
        }
        float* cp = CLOC + (size_t)task * 8192 + i + 256 * hh;
#pragma unroll
        for (int et = 0; et < 4; ++et)
#pragma unroll
            for (int dt = 0; dt < 2; ++dt)
#pragma unroll
                for (int r = 0; r < 16; ++r) cp[(32 * et + (r & 3) + 8 * (r >> 2)) * 64 + 32 * dt] = acc[et][dt][r];
    }
}
__device__ __forceinline__ void mlstm_scan_phase(const float* CLOC, const float* NLOC, const float* CH, bf16_t* CSTB, float* NST, float* MSTATE, int G, int bx, int tid) {
    for (int idx = bx * 512 + tid; idx < BATCH * 4 * 1024; idx += G * 512) {
        const int bh = idx >> 10, rem = idx & 1023, e = rem >> 3, d0 = (rem & 7) * 8;
        float C[8], nr[8]; float m = 0.f;
#pragma unroll
        for (int j = 0; j < 8; ++j) { C[j] = 0.f; nr[j] = 0.f; }
#pragma unroll 1
        for (int c8 = 0; c8 < 16; c8 += 8) {
            f32x4 cl[8][2], nl[8][2]; float bl[8], ml[8];
#pragma unroll
            for (int q = 0; q < 8; ++q) { const int task = bh * 16 + c8 + q;
                cl[q][0] = *(const f32x4*)(CLOC + (size_t)task * 8192 + e * 64 + d0); cl[q][1] = *(const f32x4*)(CLOC + (size_t)task * 8192 + e * 64 + d0 + 4);
                bl[q] = CH[task * 2]; ml[q] = CH[task * 2 + 1];
                if (rem < 8) { nl[q][0] = *(const f32x4*)(NLOC + (size_t)task * 64 + rem * 8); nl[q][1] = *(const f32x4*)(NLOC + (size_t)task * 64 + rem * 8 + 4); }
                else { nl[q][0] = (f32x4){0.f, 0.f, 0.f, 0.f}; nl[q][1] = nl[q][0]; } }
#pragma unroll
            for (int q = 0; q < 8; ++q) { const int task = bh * 16 + c8 + q;
                u32x4 w; w.x = cvt_pk_bf16(C[0], C[1]); w.y = cvt_pk_bf16(C[2], C[3]); w.z = cvt_pk_bf16(C[4], C[5]); w.w = cvt_pk_bf16(C[6], C[7]);
                *(u32x4*)(CSTB + (size_t)task * 8192 + e * 64 + d0) = w;
                if (rem < 8) { *(f32x4*)(NST + (size_t)task * 64 + rem * 8) = (f32x4){nr[0], nr[1], nr[2], nr[3]}; *(f32x4*)(NST + (size_t)task * 64 + rem * 8 + 4) = (f32x4){nr[4], nr[5], nr[6], nr[7]}; }
                if (rem == 0) MSTATE[task] = m;
                const float mn = fmaxf(bl[q] + m, ml[q]), a = __expf(bl[q] + m - mn), bco = __expf(ml[q] - mn);
#pragma unroll
                for (int j = 0; j < 4; ++j) { C[j] = a * C[j] + bco * cl[q][0][j]; C[4 + j] = a * C[4 + j] + bco * cl[q][1][j]; nr[j] = a * nr[j] + bco * nl[q][0][j]; nr[4 + j] = a * nr[4 + j] + bco * nl[q][1][j]; }
                m = mn; }
        }
    }
}
__device__ __forceinline__ void mlstm_out_phase(LAS unsigned char* lds, const bf16_t* P2, const bf16_t* VT, const bf16_t* QM, const bf16_t* KM, const float* BC, const float* AV, const float* AM,
                                                const bf16_t* CSTB, const float* NST, const float* MSTATE, const float* mng, bf16_t* cat, int G, int vx, int wave) {
    const int lane_ = lane_id();
    const int cw = wave >> 2, tq = wave & 3;
    LAS unsigned char* reg = lds + cw * 65536;
    for (int un = vx; un < BATCH * 4 * 8; un += G) {
        int lane = lane_; asm volatile("" : "+v"(lane));
        const int i = lane & 31, hh = lane >> 5;
        const int task = 2 * un + cw, bh = task >> 4, c = task & 15, b = bh >> 2, h = bh & 3;
        const int t0 = b * SEQ + c * 128;
        { const bf16_t* ks = KM + (size_t)(t0 + 32 * tq + pi32(i)) * 256 + h * 64 + 8 * hh;
          const bf16_t* cs = CSTB + (size_t)task * 8192 + (32 * tq + i) * 64 + 8 * hh;
          const bf16_t* vs = VT + (size_t)(512 + h * 128 + 32 * tq + i) * T + t0 + 8 * hh;
#pragma unroll
          for (int ds = 0; ds < 4; ++ds) { __builtin_amdgcn_global_load_lds((const unsigned*)(ks + 16 * ds), (LAS unsigned*)(reg + (tq * 4 + ds) * 1024), 16, 0, 0);
              __builtin_amdgcn_global_load_lds((const unsigned*)(cs + 16 * ds), (LAS unsigned*)(reg + 16384 + (tq * 4 + ds) * 1024), 16, 0, 0); }
#pragma unroll
          for (int k8 = 0; k8 < 8; ++k8) __builtin_amdgcn_global_load_lds((const unsigned*)(vs + 16 * k8), (LAS unsigned*)(reg + 32768 + (tq * 8 + k8) * 1024), 16, 0, 0); }
        const float m_c = MSTATE[task];
        const int tg = t0 + 32 * tq + i;
        const float bct = BC[(size_t)h * T + tg], amt = AM[(size_t)h * T + tg];
        bf16x8 qf[4];
#pragma unroll
        for (int ds = 0; ds < 4; ++ds) qf[ds] = *(const bf16x8*)(QM + (size_t)tg * 256 + h * 64 + 16 * ds + 8 * hh);
        float qn = 0.f;
#pragma unroll
        for (int ds = 0; ds < 4; ++ds) { const f32x4 n0 = *(const f32x4*)(NST + (size_t)task * 64 + 16 * ds + 8 * hh), n1 = *(const f32x4*)(NST + (size_t)task * 64 + 16 * ds + 8 * hh + 4);
            const u32x4 w = __builtin_bit_cast(u32x4, qf[ds]);
            qn += lo_bf(w.x) * n0[0] + hi_bf(w.x) * n0[1] + lo_bf(w.y) * n0[2] + hi_bf(w.y) * n0[3] + lo_bf(w.z) * n1[0] + hi_bf(w.z) * n1[1] + lo_bf(w.w) * n1[2] + hi_bf(w.w) * n1[3]; }
        qn = x32_sum(qn);
        const float M = fmaxf(m_c, amt), g = __expf(m_c - M), emt = __expf(-(bct + M));
        const bf16_t* mop = P2 + (size_t)tg * NP2 + 1536 + h * 128 + 4 * hh;
        u32x2 mov[4][4];
#pragma unroll
        for (int et = 0; et < 4; ++et)
#pragma unroll
            for (int g4 = 0; g4 < 4; ++g4) mov[et][g4] = *(const u32x2*)(mop + et * 32 + 8 * g4);
        asm volatile("s_waitcnt vmcnt(0)" ::: "memory"); __builtin_amdgcn_s_barrier(); asm volatile("" ::: "memory");
        const LAS unsigned char* rl = reg + lane * 16;
        f32x16 acc[4];
#pragma unroll
        for (int et = 0; et < 4; ++et) { acc[et] = zero16();
#pragma unroll
            for (int ds = 0; ds < 4; ++ds) acc[et] = __builtin_amdgcn_mfma_f32_32x32x16_bf16(*(const LAS bf16x8*)(rl + 16384 + (et * 4 + ds) * 1024), qf[ds], acc[et], 0, 0, 0);
#pragma unroll
            for (int r = 0; r < 16; ++r) acc[et][r] *= g; }
        float wsum = 0.f;
        for (int kt = 0; kt <= tq; ++kt) {
            f32x16 sc = zero16();
#pragma unroll
            for (int ds = 0; ds < 4; ++ds) sc = __builtin_amdgcn_mfma_f32_32x32x16_bf16(*(const LAS bf16x8*)(rl + (kt * 4 + ds) * 1024), qf[ds], sc, 0, 0, 0);
            const float* ap = AV + (size_t)h * T + t0 + 32 * kt + 8 * hh;
            const f32x4 a00 = *(const f32x4*)(ap), a01 = *(const f32x4*)(ap + 4), a10 = *(const f32x4*)(ap + 16), a11 = *(const f32x4*)(ap + 20);
#pragma unroll
            for (int r = 0; r < 16; ++r) { const float av = (r < 4) ? a00[r & 3] : (r < 8) ? a01[r & 3] : (r < 12) ? a10[r & 3] : a11[r & 3];
                const int ko = 16 * (r >> 3) + 8 * hh + (r & 7);
                float w = sc[r] * __expf(av - M);
                w = (kt == tq && ko > i) ? 0.f : w;
                sc[r] = w; wsum += w; }
            u32x4 wf[2];
#pragma unroll
            for (int sb = 0; sb < 2; ++sb) { wf[sb].x = cvt_pk_bf16(sc[8 * sb + 0], sc[8 * sb + 1]); wf[sb].y = cvt_pk_bf16(sc[8 * sb + 2], sc[8 * sb + 3]); wf[sb].z = cvt_pk_bf16(sc[8 * sb + 4], sc[8 * sb + 5]); wf[sb].w = cvt_pk_bf16(sc[8 * sb + 6], sc[8 * sb + 7]); }
#pragma unroll
            for (int et = 0; et < 4; ++et)
#pragma unroll
                for (int sb = 0; sb < 2; ++sb) acc[et] = __builtin_amdgcn_mfma_f32_32x32x16_bf16(*(const LAS bf16x8*)(rl + 32768 + (et * 8 + 2 * kt + sb) * 1024), __builtin_bit_cast(bf16x8, wf[sb]), acc[et], 0, 0, 0);
        }
        wsum = x32_sum(wsum);
        const float den = g * qn + wsum, idd = 1.0f / fmaxf(fabsf(den), emt);
        float ss = 0.f;
#pragma unroll
        for (int et = 0; et < 4; ++et)
#pragma unroll
            for (int r = 0; r < 16; ++r) { const float hv = acc[et][r] * idd; acc[et][r] = hv; ss += hv * hv; }
        ss = x32_sum(ss);
        const float rn = rsqrtf(ss * (1.0f / 128.0f) + EPS);
        bf16_t* op = cat + (size_t)tg * DM + 512 + h * 128 + 8 * hh;
        const float* gp = mng + h * 128 + 4 * hh;
#pragma unroll
        for (int et = 0; et < 4; ++et)
#pragma unroll
            for (int gq = 0; gq < 2; ++gq) { u32x2 w[2];
#pragma unroll
                for (int q = 0; q < 2; ++q) { const int g4 = 2 * gq + q; const f32x4 gv = *(const f32x4*)(gp + et * 32 + 8 * g4); const u32x2 mo = mov[et][g4];
                    const float o0 = lo_bf(mo.x), o1 = hi_bf(mo.x), o2 = lo_bf(mo.y), o3 = hi_bf(mo.y);
                    const float y0 = acc[et][4 * g4] * rn * gv[0] * __builtin_amdgcn_rcpf(1.0f + __expf(-o0)), y1 = acc[et][4 * g4 + 1] * rn * gv[1] * __builtin_amdgcn_rcpf(1.0f + __expf(-o1));
                    const float y2 = acc[et][4 * g4 + 2] * rn * gv[2] * __builtin_amdgcn_rcpf(1.0f + __expf(-o2)), y3 = acc[et][4 * g4 + 3] * rn * gv[3] * __builtin_amdgcn_rcpf(1.0f + __expf(-o3));
                    w[q].x = cvt_pk_bf16(y0, y1); w[q].y = cvt_pk_bf16(y2, y3); }
                const auto sa = __builtin_amdgcn_permlane32_swap(w[0].x, w[1].x, false, false), sb = __builtin_amdgcn_permlane32_swap(w[0].y, w[1].y, false, false);
                *(u32x4*)(op + et * 32 + 16 * gq) = (u32x4){sa[0], sb[0], sa[1], sb[1]}; }
        asm volatile("s_waitcnt lgkmcnt(0)" ::: "memory"); __builtin_amdgcn_s_barrier(); asm volatile("" ::: "memory");
    }
}

constexpr int NWAVES = 8;
constexpr int RING_BYTES = 131072;
constexpr int LDSCTL_OFF = RING_BYTES;
constexpr int LDS_BYTES = RING_BYTES + 5120;

enum Phase { PH_PREP = 0, PH_INPROJ = 1, PH_MIX0 = 2, PH_MIX1 = 3, PH_MIX2 = 4, PH_OUTPROJ = 5, PH_QKV = 6, PH_XATTN = 7, PH_COPROJ = 8, PH_ROUTER = 9, PH_G1 = 10, PH_G2 = 11, PH_COMBINE = 12, PH_END = 13 };

struct Args { const float* in[28]; float* out; unsigned char* ws; int ph_lo, ph_hi, pass_lo, pass_hi; };

struct CJob { const float* src; const float* g; unsigned char* dst; int Nsrc, k0, n0, mode, f8; float scale; };
__device__ __forceinline__ void conv_load(const CJob& j, f32x4 (&v)[2], int tid) {
    const int kk = tid >> 4, c4 = (tid & 15) * 4;
#pragma unroll
    for (int rep = 0; rep < 2; ++rep) v[rep] = *(const f32x4*)(j.src + (size_t)(j.k0 + kk + 32 * rep) * j.Nsrc + j.n0 + c4);
}
__device__ __forceinline__ void conv_put(LAS float* tile, const f32x4 (&v)[2], int tid) {
    const int kk = tid >> 4, c4 = (tid & 15) * 4;
#pragma unroll
    for (int rep = 0; rep < 2; ++rep)
#pragma unroll
        for (int q = 0; q < 4; ++q) tile[(kk + 32 * rep) * 65 + c4 + q] = v[rep][q];
}
__device__ __forceinline__ void conv_store(const LAS float* tile, const CJob& j, int tid) {
    const int n = tid >> 3, kc = tid & 7; float vals[8];
    f32x4 g0 = (f32x4){1.f, 1.f, 1.f, 1.f}, g1 = g0;
    if (j.g) { g0 = *(const f32x4*)(j.g + j.k0 + 8 * kc); g1 = *(const f32x4*)(j.g + j.k0 + 8 * kc + 4); }
#pragma unroll
    for (int q = 0; q < 8; ++q) vals[q] = tile[(8 * kc + q) * 65 + n] * (q < 4 ? g0[q & 3] : g1[q & 3]) * j.scale;
    const int sc = j.n0 + n; int drow = sc;
    if (j.mode == 1) { const int jj = sc >> 1, s = sc & 1; drow = 256 * (jj >> 7) + 128 * s + (jj & 127); }
    if (j.mode == 2) { drow = sc < 1024 ? sc : sc < 1536 ? sc + 1024 : sc < 2048 ? sc - 512 : sc < 2560 ? sc + 512 : sc - 1024; }
    if (j.f8) { unsigned w0 = 0u, w1 = 0u;
        w0 = __builtin_amdgcn_cvt_pk_fp8_f32(c8(vals[0]), c8(vals[1]), w0, false); w0 = __builtin_amdgcn_cvt_pk_fp8_f32(c8(vals[2]), c8(vals[3]), w0, true);
        w1 = __builtin_amdgcn_cvt_pk_fp8_f32(c8(vals[4]), c8(vals[5]), w1, false); w1 = __builtin_amdgcn_cvt_pk_fp8_f32(c8(vals[6]), c8(vals[7]), w1, true);
        *(u32x2*)(j.dst + (size_t)drow * 1024 + j.k0 + 8 * kc) = (u32x2){w0, w1}; }
    else { u32x4 w; w.x = cvt_pk_bf16(vals[0], vals[1]); w.y = cvt_pk_bf16(vals[2], vals[3]); w.z = cvt_pk_bf16(vals[4], vals[5]); w.w = cvt_pk_bf16(vals[6], vals[7]);
        *(u32x4*)(j.dst + ((size_t)drow * 1024 + j.k0 + 8 * kc) * 2) = w; }
}

__global__ void __launch_bounds__(NWAVES * 64, 2) fwd(Args args) {
    extern __shared__ __attribute__((aligned(16))) unsigned char lds_raw[];
    LAS unsigned char* lds = (LAS unsigned char*)lds_raw;
    volatile LAS unsigned* LCTL = (volatile LAS unsigned*)(lds + LDSCTL_OFF);
    const int wave = __builtin_amdgcn_readfirstlane(threadIdx.x >> 6);
#define lane lane_id()
#define tid (wave * 64 + lane_id())
    const int G = gridDim.x, bx = blockIdx.x;
    unsigned char* ws = args.ws;
    unsigned* ctl = (unsigned*)(ws + WS_CTL);
    const int lo = args.ph_lo, hi = args.ph_hi;
#ifndef PHMASK
#define PHMASK 0xffffff
#endif
#ifndef DUPMASK
#define DUPMASK 0x0
#endif
#define IN(k) (((PHMASK >> (k)) & 1) && lo <= (k) && (k) < hi)
#define NREP(k) ((((DUPMASK) >> (k)) & 1) ? 2 : 1)
#define ENDBAR(k) (BOTH(k) || (((DUPMASK) >> (k)) & 1))
#define BOTH(k) (IN(k) && IN((k) + 1))
    for (int u = tid; u < (LDS_BYTES - LDSCTL_OFF) / 4; u += NWAVES * 64) LCTL[u] = 0u;
    __syncthreads();
    XcdBarrier bar; bar.bar = ctl + CW_BAR; bar.x = 0; bar.st = LCTL; bar.wave = wave;
    const bool multi = (hi - lo) > 1 || (args.pass_hi - args.pass_lo) > 1 || (IN(PH_G1) && IN(PH_G2));
    if (multi) bar = xcd_barrier_post(ctl + CW_BAR, LCTL, wave);
#define GRID_BAR() xcd_barrier(bar)

    const float* x = args.in[0]; const float* mem = args.in[1];
    bf16_t* XB = (bf16_t*)(ws + WS_XB); bf16_t* PROJ = (bf16_t*)(ws + WS_PROJ); bf16_t* CAT = (bf16_t*)(ws + WS_CAT);
    bf16_t* MEMB = (bf16_t*)(ws + WS_MEMB); bf16_t* KV = (bf16_t*)(ws + WS_KV); bf16_t* VT2 = (bf16_t*)(ws + WS_VT2); bf16_t* VT1 = (bf16_t*)(ws + WS_VT1); unsigned char* H1F = ws + WS_H1F;
    bf16_t* WIN = (bf16_t*)(ws + WS_WIN); bf16_t* WOUT = (bf16_t*)(ws + WS_WOUT); bf16_t* WCQ = (bf16_t*)(ws + WS_WCQ); bf16_t* WCKV = (bf16_t*)(ws + WS_WCKV);
    bf16_t* WCO = (bf16_t*)(ws + WS_WCO); bf16_t* WR = (bf16_t*)(ws + WS_WR); unsigned char* W1F = ws + WS_W1; unsigned char* W2F = ws + WS_W2; unsigned char* H2F = ws + WS_H2F;
    float* RSTDX = (float*)(ws + WS_RSTDX); float* RSTDM = (float*)(ws + WS_RSTDM); float* B1P = (float*)(ws + WS_B1P); float* MISC = (float*)(ws + WS_MISC); float* RSTD2 = (float*)(ws + WS_RSTD2);
    float* SSP1 = (float*)(ws + WS_SSP1); float* SSP2 = (float*)(ws + WS_SSP2); float* GATES = (float*)(ws + WS_GATES);
    unsigned* TOKMAP = (unsigned*)(ws + WS_TOKMAP); float* GATEV = (float*)(ws + WS_GATEV); unsigned* LIST = (unsigned*)(ws + WS_LIST);
    unsigned char* YB = ws + WS_Y; unsigned char* HID = ws + WS_HID;

    if (IN(PH_PREP)) for (int rep_ = 0; rep_ < NREP(PH_PREP); ++rep_) {
        constexpr int J0 = 768, J1 = J0 + 256, J2 = J1 + 256, J3 = J2 + 512, J4 = J3 + 256, J5 = J4 + 16384, J6 = J5 + 8192;
        auto decode = [&](int it, CJob& j) {
            if (it < J0) { j = CJob{args.in[3], args.in[2], (unsigned char*)WIN, DIN, (it / 48) * 64, (it % 48) * 64, 2, 0, 1.0f}; }
            else if (it < J1) { const int r = it - J0; j = CJob{args.in[14], nullptr, (unsigned char*)WOUT, 1024, (r / 16) * 64, (r % 16) * 64, 0, 0, 1.0f}; }
            else if (it < J2) { const int r = it - J1; j = CJob{args.in[17], args.in[15], (unsigned char*)WCQ, 1024, (r / 16) * 64, (r % 16) * 64, 0, 1, 64.0f}; }
            else if (it < J3) { const int r = it - J2; j = CJob{args.in[18], args.in[16], (unsigned char*)WCKV, 2048, (r / 32) * 64, (r % 32) * 64, 0, 1, 64.0f}; }
            else if (it < J4) { const int r = it - J3; j = CJob{args.in[19], nullptr, (unsigned char*)WCO, 1024, (r / 16) * 64, (r % 16) * 64, 0, 1, 64.0f}; }
            else if (it < J5) { const int r = it - J4; const int e = r >> 9, q = r & 511; j = CJob{args.in[23] + (size_t)e * 1024 * 2048, args.in[20], W1F + (size_t)e * 2048 * 1024, 2048, (q / 32) * 64, (q % 32) * 64, 1, 1, 64.0f}; }
            else { const int r = it - J5; const int e = r >> 8, q = r & 255; j = CJob{args.in[25] + (size_t)e * 1024 * 1024, nullptr, W2F + (size_t)e * 1024 * 1024, 1024, (q / 16) * 64, (q % 16) * 64, 0, 1, 64.0f}; } };
        static_assert(J0 % 4 == 0 && J1 % 4 == 0 && J2 % 4 == 0 && J3 % 4 == 0 && J4 % 4 == 0 && J5 % 4 == 0 && J6 % 4 == 0, "rounds of four jobs");
#define LDS_BAR() do { asm volatile("s_waitcnt lgkmcnt(0)" ::: "memory"); __builtin_amdgcn_s_barrier(); asm volatile("" ::: "memory"); } while (0)
        { f32x4 v[8]; int it0 = bx * 4; CJob jc;
          if (it0 < J6) { decode(it0, jc);
#pragma unroll
              for (int r = 0; r < 8; ++r) v[r] = *(const f32x4*)(jc.src + (size_t)(jc.k0 + wave * 8 + r) * jc.Nsrc + jc.n0 + 4 * lane); }
          for (; it0 < J6; it0 += G * 4) {
            { LAS float* tq = (LAS float*)lds + (lane >> 4) * (64 * 65) + ((4 * lane) & 63) + (wave * 8) * 65;
#pragma unroll
              for (int r = 0; r < 8; ++r)
#pragma unroll
                  for (int q = 0; q < 4; ++q) tq[r * 65 + q] = v[r][q]; }
            LDS_BAR();
            CJob js = jc; const int nx = it0 + G * 4;
            if (nx < J6) { decode(nx, jc);
#pragma unroll
                for (int r = 0; r < 8; ++r) v[r] = *(const f32x4*)(jc.src + (size_t)(jc.k0 + wave * 8 + r) * jc.Nsrc + jc.n0 + 4 * lane); }
#pragma unroll
            for (int q = 0; q < 4; ++q) { conv_store((const LAS float*)lds + q * (64 * 65), js, tid); js.n0 += 64; }
            LDS_BAR();
          } }
        __syncthreads();
        for (int i = bx * 512 + tid; i < NEXP * 1024; i += G * 512) { const int e = i >> 10, k = i & 1023; WR[i] = (bf16_t)f2bf(args.in[21][k * NEXP + e] * args.in[20][k]); }
        for (int i = bx * 512 + tid; i < NEXP * 2048; i += G * 512) { const int e = i >> 11, rho = i & 2047; const int pn = rho >> 8, s = (rho >> 7) & 1, ii = rho & 127; B1P[i] = args.in[24][e * 2048 + 2 * (128 * pn + ii) + s]; }
        if (bx == 0 && wave == 0) { const float a = wave_sum(args.in[9][lane] * args.in[10][lane]), b = wave_sum(args.in[11][lane] * args.in[12][lane]);
            if (lane == 0) MISC[0] = expf(a) - expf(b) + LAMBDA_INIT; }
        {
            const float* win = args.in[3]; const float* g = args.in[2];
            float wg[4][4][8];
#pragma unroll
            for (int jj = 0; jj < 4; ++jj)
#pragma unroll
                for (int q = 0; q < 4; ++q) { const int k = 4 * lane + 256 * jj + q; const float gk = g[k];
                    const f32x4 a = *(const f32x4*)(win + (size_t)k * DIN + 3072), b = *(const f32x4*)(win + (size_t)k * DIN + 3076);
#pragma unroll
                    for (int j = 0; j < 4; ++j) { wg[jj][q][j] = a[j] * gk; wg[jj][q][4 + j] = b[j] * gk; } }
            const int gw = bx * NWAVES + wave, NGW = G * NWAVES;
            f32x4 vn[4];
            if (gw < T) { const f32x4* xr = (const f32x4*)(x + (size_t)gw * DM) + lane;
#pragma unroll
                for (int jj = 0; jj < 4; ++jj) vn[jj] = xr[64 * jj]; }
            for (int row = gw; row < T; row += NGW) {
                f32x4 v[4]; float ss = 0.f; float d[8];
#pragma unroll
                for (int jj = 0; jj < 4; ++jj) v[jj] = vn[jj];
                if (row + NGW < T) { const f32x4* xr = (const f32x4*)(x + (size_t)(row + NGW) * DM) + lane;
#pragma unroll
                    for (int jj = 0; jj < 4; ++jj) vn[jj] = xr[64 * jj]; }
#pragma unroll
                for (int j = 0; j < 8; ++j) d[j] = 0.f;
#pragma unroll
                for (int jj = 0; jj < 4; ++jj) {
#pragma unroll
                    for (int q = 0; q < 4; ++q) { ss += v[jj][q] * v[jj][q];
#pragma unroll
                        for (int j = 0; j < 8; ++j) d[j] += v[jj][q] * wg[jj][q][j]; } }
                ss = wave_sum(ss);
#pragma unroll
                for (int j = 0; j < 8; ++j) d[j] = wave_sum(d[j]);
                const float rs = rsqrtf(ss * (1.0f / DM) + EPS);
                u32x2* o8 = (u32x2*)(XB + (size_t)row * DM) + lane;
#pragma unroll
                for (int jj = 0; jj < 4; ++jj) { u32x2 w; w.x = cvt_pk_bf16(v[jj][0], v[jj][1]); w.y = cvt_pk_bf16(v[jj][2], v[jj][3]); o8[64 * jj] = w; }
                if (lane == 0) RSTDX[row] = rs;
                if (lane < 8) { float dv = d[0];
#pragma unroll
                    for (int j = 1; j < 8; ++j) dv = (lane == j) ? d[j] : dv;
                    dv *= rs; float r;
                    if (lane < 4) r = dv + args.in[6][lane];
                    else { const float z = dv + args.in[7][lane - 4]; r = (z >= 0.f) ? -log1pf(expf(-z)) : (z - log1pf(expf(z))); }
                    GATES[(size_t)row * 8 + lane] = r; }
            }
            for (int row = gw; row < MROWS; row += NGW) {
                const f32x4* xr = (const f32x4*)(mem + (size_t)row * DM) + lane;
                f32x4 v[4]; float ss = 0.f;
#pragma unroll
                for (int jj = 0; jj < 4; ++jj) { v[jj] = xr[64 * jj]; ss += (v[jj][0] * v[jj][0] + v[jj][1] * v[jj][1]) + (v[jj][2] * v[jj][2] + v[jj][3] * v[jj][3]); }
                ss = wave_sum(ss);
                unsigned* o4 = (unsigned*)((unsigned char*)MEMB + (size_t)row * DM) + lane;
#pragma unroll
                for (int jj = 0; jj < 4; ++jj) { unsigned w = 0u; w = __builtin_amdgcn_cvt_pk_fp8_f32(c8(v[jj][0]), c8(v[jj][1]), w, false); w = __builtin_amdgcn_cvt_pk_fp8_f32(c8(v[jj][2]), c8(v[jj][3]), w, true); o4[64 * jj] = w; }
                if (lane == 0) RSTDM[row] = rsqrtf(ss * (1.0f / DM) + EPS);
            }
        }
        if (ENDBAR(PH_PREP)) GRID_BAR();
    }

    if (IN(PH_INPROJ)) for (int rep_ = 0; rep_ < NREP(PH_INPROJ); ++rep_) {
        { ProbScaleBf16 P{(LAS unsigned*)(lds + LDSCTL_OFF + 2048), XB, WIN, T / 256, NP2 / 256, G, bx, PROJ, NP2, RSTDX, nullptr};
          pg8::gemm_phase<ProbScaleBf16, true>(lds, P, wave); }
        { ProbColScaleBf16 P{WIN + (size_t)NP2 * 1024, XB, 4, T / 256, G, bx, VT1, T, RSTDX};
          pg8::gemm_phase<ProbColScaleBf16, true>(lds, P, wave); }
        if (ENDBAR(PH_INPROJ)) GRID_BAR();
    }

    const int vx = (G % 8 == 0) ? (bx % 8) * (G / 8) + bx / 8 : bx;
    bf16_t* QM = (bf16_t*)(ws + WS_QM); bf16_t* KM = (bf16_t*)(ws + WS_KM); bf16_t* CSTB = (bf16_t*)(ws + WS_CSTB);
    float* BC = (float*)(ws + WS_BC); float* AV = (float*)(ws + WS_AV); float* AM = (float*)(ws + WS_AM); float* NLOC = (float*)(ws + WS_NLOC); float* NST = (float*)(ws + WS_NST);
    float* CH = (float*)(ws + WS_CH); float* MSTATE = (float*)(ws + WS_MSTATE); float* CLOC = (float*)(ws + WS_MST);
    if (IN(PH_MIX0)) for (int rep_ = 0; rep_ < NREP(PH_MIX0); ++rep_) {
        mlstm_prep_phase(lds, PROJ, VT1, GATES, args.in[4], args.in[5], QM, KM, BC, AV, AM, CH, NLOC, CLOC, G, vx, wave);
        if (ENDBAR(PH_MIX0)) GRID_BAR();
    }
    if (IN(PH_MIX1)) for (int rep_ = 0; rep_ < NREP(PH_MIX1); ++rep_) {
        mlstm_scan_phase(CLOC, NLOC, CH, CSTB, NST, MSTATE, G, bx, tid);
        if (ENDBAR(PH_MIX1)) GRID_BAR();
    }
    if (IN(PH_MIX2)) for (int rep_ = 0; rep_ < NREP(PH_MIX2); ++rep_) {
        mlstm_out_phase(lds, PROJ, VT1, QM, KM, BC, AV, AM, CSTB, NST, MSTATE, args.in[8], CAT, G, vx, wave);
        __syncthreads();
        const float lam = __hip_atomic_load(MISC, __ATOMIC_RELAXED, __HIP_MEMORY_SCOPE_AGENT);
        diffattn_phase(lds, (LAS float*)(lds + LDSCTL_OFF + 2048), PROJ, VT1, args.in[13], lam, CAT, G, vx, wave);
        if (ENDBAR(PH_MIX2)) GRID_BAR();
    }

    if (IN(PH_OUTPROJ)) for (int rep_ = 0; rep_ < NREP(PH_OUTPROJ); ++rep_) {
        ProbResidT<false, true, false> P{(LAS unsigned*)(lds + LDSCTL_OFF + 2048), CAT, WOUT, T / 256, 4, G, bx, nullptr, XB, XB, H1F, SSP1};
        pg8::gemm_phase<ProbResidT<false, true, false>, true>(lds, P, wave);
        if (ENDBAR(PH_OUTPROJ)) GRID_BAR();
    }

    if (IN(PH_QKV)) for (int rep_ = 0; rep_ < NREP(PH_QKV); ++rep_) {
        { ProbScaleT<true> P{(LAS unsigned*)(lds + LDSCTL_OFF + 2048), H1F, WCQ, T / 256, 4, G, bx, PROJ, 1024, nullptr, SSP1};
          pg8::gemm_phase<ProbScaleT<true>, true>(lds, P, wave); }
        { ProbKV P{(LAS unsigned*)(lds + LDSCTL_OFF + 2048), (const unsigned char*)MEMB, (const unsigned char*)WCKV, KV, VT2, RSTDM, G, bx};
          pg8::gemm_phase<ProbKV, true>(lds, P, wave); }
        if (ENDBAR(PH_QKV)) GRID_BAR();
    }

    if (IN(PH_XATTN)) for (int rep_ = 0; rep_ < NREP(PH_XATTN); ++rep_) {
        xattn_phase(lds, PROJ, KV, VT2, (unsigned char*)(PROJ + (size_t)T * 1024), G, vx, wave);
        if (ENDBAR(PH_XATTN)) GRID_BAR();
    }

    if (IN(PH_COPROJ)) for (int rep_ = 0; rep_ < NREP(PH_COPROJ); ++rep_) {
        ProbResidT<true, false, false> P{(LAS unsigned*)(lds + LDSCTL_OFF + 2048), (unsigned char*)(PROJ + (size_t)T * 1024), WCO, T / 256, 4, G, bx, nullptr, XB, CAT, nullptr, SSP2};
        pg8::gemm_phase<ProbResidT<true, false, false>, true>(lds, P, wave);
        if (ENDBAR(PH_COPROJ)) GRID_BAR();
    }

    if (IN(PH_ROUTER)) for (int rep_ = 0; rep_ < NREP(PH_ROUTER); ++rep_) {
        { u32x4 wv[8];
#pragma unroll
          for (int q = 0; q < 8; ++q) { const int idx = q * (NWAVES * 64) + tid, ks = idx >> 6, ln = idx & 63; wv[q] = *(const u32x4*)(WR + (size_t)(ln & 31) * DM + 16 * ks + 8 * (ln >> 5)); }
#pragma unroll
          for (int q = 0; q < 8; ++q) { const int idx = q * (NWAVES * 64) + tid; *(LAS u32x4*)(lds + idx * 16) = wv[q]; } }
        __syncthreads();
        const float* brt = args.in[22];
        const int i = lane & 31, hh = lane >> 5;
        volatile LAS unsigned* lcnt = (volatile LAS unsigned*)(lds + 65536);
        const int ntrip = (T / 32 + G * NWAVES - 1) / (G * NWAVES);
        for (int trip = 0; trip < ntrip; ++trip) {
            const int tile = trip * G * NWAVES + bx * NWAVES + wave; const bool act = tile < T / 32;
            if (tid < 32) lcnt[tid] = 0u;
            __syncthreads();
            const int t = (act ? tile : 0) * 32 + i;
            const bf16_t* xp = CAT + (size_t)t * DM + 8 * hh;
            const f32x4 p0 = *(const f32x4*)(SSP2 + (size_t)t * 16 + 8 * hh), p1 = *(const f32x4*)(SSP2 + (size_t)t * 16 + 8 * hh + 4);
            float sp = (p0[0] + p0[1]) + (p0[2] + p0[3]) + (p1[0] + p1[1]) + (p1[2] + p1[3]); sp = x32_sum(sp);
            const float rs = rsqrtf(sp * (1.0f / DM) + EPS);
            f32x16 acc = zero16();
#pragma unroll 1
            for (int kb = 0; kb < 64; kb += 16) { bf16x8 xf[16];
#pragma unroll
                for (int q = 0; q < 16; ++q) xf[q] = *(const bf16x8*)(xp + 16 * (kb + q));
#pragma unroll
                for (int q = 0; q < 16; ++q) { const bf16x8 wf = *(const LAS bf16x8*)(lds + ((kb + q) * 64 + lane) * 16); acc = __builtin_amdgcn_mfma_f32_32x32x16_bf16(wf, xf[q], acc, 0, 0, 0); }
#pragma unroll
                for (int q2 = 0; q2 < 8; ++q2) { unsigned pw[2][2];
#pragma unroll
                    for (int q = 0; q < 2; ++q) { const u32x4 xw = __builtin_bit_cast(u32x4, xf[2 * q2 + q]); unsigned w0 = 0u, w1 = 0u;
                        w0 = __builtin_amdgcn_cvt_pk_fp8_f32(lo_bf(xw.x) * rs, hi_bf(xw.x) * rs, w0, false); w0 = __builtin_amdgcn_cvt_pk_fp8_f32(lo_bf(xw.y) * rs, hi_bf(xw.y) * rs, w0, true);
                        w1 = __builtin_amdgcn_cvt_pk_fp8_f32(lo_bf(xw.z) * rs, hi_bf(xw.z) * rs, w1, false); w1 = __builtin_amdgcn_cvt_pk_fp8_f32(lo_bf(xw.w) * rs, hi_bf(xw.w) * rs, w1, true);
                        pw[q][0] = w0; pw[q][1] = w1; }
                    const auto sa = __builtin_amdgcn_permlane32_swap(pw[0][0], pw[1][0], false, false), sb = __builtin_amdgcn_permlane32_swap(pw[0][1], pw[1][1], false, false);
                    *(u32x4*)(H2F + (size_t)t * DM + 16 * (kb + 2 * q2) + 16 * hh) = (u32x4){sa[0], sb[0], sa[1], sb[1]}; } }
            float mine[16], oth[16];
#pragma unroll
            for (int r = 0; r < 16; ++r) { const int e = (r & 3) + 8 * (r >> 2); mine[r] = acc[r] * rs + brt[e + 4 * hh]; }
#pragma unroll
            for (int r = 0; r < 16; ++r) oth[r] = x32_other(mine[r], hh);
            float lg[NEXP];
#pragma unroll
            for (int r = 0; r < 16; ++r) { const int e = (r & 3) + 8 * (r >> 2); lg[e] = hh ? oth[r] : mine[r]; lg[e + 4] = hh ? mine[r] : oth[r]; }
            unsigned taken = 0u; float tv[4]; int te[4];
#pragma unroll
            for (int k = 0; k < TOPK; ++k) { float best = -INFINITY; int bi = 0;
#pragma unroll
                for (int e = 0; e < NEXP; ++e) { const bool ok = !((taken >> e) & 1u) && (lg[e] > best); best = ok ? lg[e] : best; bi = ok ? e : bi; }
                taken |= 1u << bi; tv[k] = best; te[k] = bi; }
            const float q1 = __expf(tv[1] - tv[0]), q2 = __expf(tv[2] - tv[0]), q3 = __expf(tv[3] - tv[0]); const float inv = 1.0f / (1.0f + q1 + q2 + q3);
            const float gk[4] = {inv, q1 * inv, q2 * inv, q3 * inv};
            unsigned lp[4] = {0u, 0u, 0u, 0u};
            if (act && hh == 0) {
#pragma unroll
                for (int k = 0; k < TOPK; ++k) lp[k] = __hip_atomic_fetch_add((LAS unsigned*)(lcnt + te[k]), 1u, __ATOMIC_RELAXED, __HIP_MEMORY_SCOPE_WORKGROUP); }
            __syncthreads();
            if (tid < 32) { const unsigned n = lcnt[tid]; lcnt[32 + tid] = n ? atomicAdd(&ctl[CW_CNT + tid], n) : 0u; }
            __syncthreads();
            if (act && hh == 0) { RSTD2[t] = rs;
                unsigned tm[4];
#pragma unroll
                for (int k = 0; k < TOPK; ++k) { const unsigned pos = lcnt[32 + te[k]] + lp[k]; LIST[(size_t)te[k] * T + pos] = (unsigned)t; tm[k] = ((unsigned)te[k] << 16) | pos; }
                *(u32x4*)(TOKMAP + (size_t)t * 4) = (u32x4){tm[0], tm[1], tm[2], tm[3]};
                *(f32x4*)(GATEV + (size_t)t * 4) = (f32x4){gk[0], gk[1], gk[2], gk[3]}; }
            __syncthreads();
        }
        if (ENDBAR(PH_ROUTER)) GRID_BAR();
    }

    volatile LAS int* tab = (volatile LAS int*)(LCTL + 16);
    int Rtot = 0;
    if (IN(PH_G1) || IN(PH_G2) || IN(PH_COMBINE)) {
        if (tid < NEXP) tab[MOE_CNT + tid] = (int)__hip_atomic_load(&ctl[CW_CNT + tid], __ATOMIC_RELAXED, __HIP_MEMORY_SCOPE_AGENT);
        __syncthreads();
        if (tid == 0) { int ts = 0, st = 0;
            for (int e = 0; e < NEXP; ++e) { const int c = tab[MOE_CNT + e]; tab[MOE_TS + e] = ts; tab[MOE_ST + e] = st; ts += (c + 255) >> 8; st += c; }
            tab[MOE_TS + NEXP] = ts; tab[MOE_ST + NEXP] = st; }
        __syncthreads();
        Rtot = tab[MOE_TS + NEXP];
    }
    if (IN(PH_G1) || IN(PH_G2)) {
        __syncthreads();
        for (int rt = tid; rt < Rtot; rt += NWAVES * 64) { int e = 0;
            for (int j = 1; j < NEXP; ++j) if (rt >= tab[MOE_TS + j]) e = j;
            ((volatile LAS unsigned char*)(tab + MOE_RTE))[rt] = (unsigned char)e; }
        __syncthreads();
        if (IN(PH_G1)) for (int rep_ = 0; rep_ < NREP(PH_G1); ++rep_) { ProbMoe1 P{H2F, W1F, B1P, RSTD2, LIST, HID, tab, (LAS unsigned*)(lds + LDSCTL_OFF + 2048), 0, Rtot, G, bx};
            pg8::gemm_phase<ProbMoe1, true>(lds, P, wave);
            if (IN(PH_G2) || NREP(PH_G1) > 1) GRID_BAR(); }
        if (IN(PH_G2)) for (int rep_ = 0; rep_ < NREP(PH_G2); ++rep_) { ProbMoe2 P{HID, W2F, args.in[26], YB, tab, (LAS unsigned*)(lds + LDSCTL_OFF + 2048), 0, Rtot, G, bx};
            pg8::gemm_phase<ProbMoe2, true>(lds, P, wave);
            if (IN(PH_COMBINE) || NREP(PH_G2) > 1) GRID_BAR(); }
    }
    if (IN(PH_COMBINE)) {
        const float* gf = args.in[27];
        const int gw = bx * NWAVES + wave, NGW = G * NWAVES;
        f32x4 gfv[4];
#pragma unroll
        for (int jj = 0; jj < 4; ++jj) gfv[jj] = *((const f32x4*)gf + 4 * lane + jj);
        u32x4 tmn = (u32x4){0u, 0u, 0u, 0u}; f32x4 gkn = (f32x4){0.f, 0.f, 0.f, 0.f};
        if (gw < T) { tmn = *(const u32x4*)(TOKMAP + (size_t)gw * 4); gkn = *(const f32x4*)(GATEV + (size_t)gw * 4); }
        for (int t = gw; t < T; t += NGW) {
            const u32x4 tm = tmn; const f32x4 gk = gkn;
            if (t + NGW < T) { tmn = *(const u32x4*)(TOKMAP + (size_t)(t + NGW) * 4); gkn = *(const f32x4*)(GATEV + (size_t)(t + NGW) * 4); }
            const u32x4* hb = (const u32x4*)(CAT + (size_t)t * DM) + 2 * lane;
            const u32x4 h0 = hb[0], h1 = hb[1];
            u32x4 yv[4];
#pragma unroll
            for (int k = 0; k < TOPK; ++k) { const int e = (int)(tm[k] >> 16), pos = (int)(tm[k] & 0xffffu); const size_t yrow = (size_t)(tab[MOE_ST + e] + pos);
                yv[k] = *((const u32x4*)(YB + yrow * DM) + lane); }
            float v[16];
            v[0] = lo_bf(h0.x); v[1] = hi_bf(h0.x); v[2] = lo_bf(h0.y); v[3] = hi_bf(h0.y); v[4] = lo_bf(h0.z); v[5] = hi_bf(h0.z); v[6] = lo_bf(h0.w); v[7] = hi_bf(h0.w);
            v[8] = lo_bf(h1.x); v[9] = hi_bf(h1.x); v[10] = lo_bf(h1.y); v[11] = hi_bf(h1.y); v[12] = lo_bf(h1.z); v[13] = hi_bf(h1.z); v[14] = lo_bf(h1.w); v[15] = hi_bf(h1.w);
#pragma unroll
            for (int k = 0; k < TOPK; ++k) { const float g16 = gk[k] * (1.0f / 16.0f);
#pragma unroll
                for (int q = 0; q < 4; ++q) { const f32x2 a = __builtin_amdgcn_cvt_pk_f32_fp8((int)yv[k][q], false), b2_ = __builtin_amdgcn_cvt_pk_f32_fp8((int)yv[k][q], true);
                    v[4 * q] += g16 * a[0]; v[4 * q + 1] += g16 * a[1]; v[4 * q + 2] += g16 * b2_[0]; v[4 * q + 3] += g16 * b2_[1]; } }
            float ss = 0.f;
#pragma unroll
            for (int q = 0; q < 16; ++q) ss += v[q] * v[q];
            ss = wave_sum(ss); const float rs = rsqrtf(ss * (1.0f / DM) + EPS);
            f32x4* orow = (f32x4*)(args.out + (size_t)t * DM) + 4 * lane;
#pragma unroll
            for (int jj = 0; jj < 4; ++jj) orow[jj] = (f32x4){v[4 * jj] * rs * gfv[jj][0], v[4 * jj + 1] * rs * gfv[jj][1], v[4 * jj + 2] * rs * gfv[jj][2], v[4 * jj + 3] * rs * gfv[jj][3]};
        }
    }
#undef IN
#undef BOTH
#undef GRID_BAR
#undef lane
#undef tid
}

extern "C" void kernel_launch(void* const* d_in, const int* in_sizes, int n_in, void* d_out, int out_size, void* d_ws, size_t ws_size, hipStream_t stream) {
    static int grid = 0;
    if (grid == 0) {
        if (n_in != 28 || out_size != T * DM || ws_size < WS_END) { fprintf(stderr, "kernel_launch: unexpected shapes: n_in %d out %d ws %zu\n", n_in, out_size, ws_size); grid = -1; return; }
        int dev = 0, cus = 0;
        if (hipGetDevice(&dev) != hipSuccess || hipDeviceGetAttribute(&cus, hipDeviceAttributeMultiprocessorCount, dev) != hipSuccess) { grid = -1; return; }
        if (hipFuncSetAttribute((const void*)fwd, hipFuncAttributeMaxDynamicSharedMemorySize, LDS_BYTES) != hipSuccess) { fprintf(stderr, "kernel_launch: hipFuncSetAttribute failed\n"); grid = -1; return; }
        int per_cu = 0;
        if (hipOccupancyMaxActiveBlocksPerMultiprocessor(&per_cu, (const void*)fwd, NWAVES * 64, LDS_BYTES) != hipSuccess || per_cu < 1) fprintf(stderr, "kernel_launch: occupancy query says %d\n", per_cu);
        (void)hipGetLastError();
        grid = cus;
    }
    if (grid < 0) return;
    (void)hipMemsetAsync((char*)d_ws + WS_CTL, 0, CTL_ZERO_BYTES, stream);
    Args a{};
    for (int i = 0; i < 28; ++i) a.in[i] = (const float*)d_in[i];
    a.out = (float*)d_out; a.ws = (unsigned char*)d_ws;
    unsigned char* ws = (unsigned char*)d_ws;
    auto run = [&](int lo, int hi, int p0, int p1) { a.ph_lo = lo; a.ph_hi = hi; a.pass_lo = p0; a.pass_hi = p1; hipLaunchKernelGGL(fwd, dim3(grid), dim3(NWAVES * 64), LDS_BYTES, stream, a); };
#ifdef MULTI_LAUNCH
    for (int ph = 0; ph < PH_G1; ++ph) run(ph, ph + 1, 0, 0);
    run(PH_G1, PH_G1 + 1, 0, 1); run(PH_G2, PH_G2 + 1, 0, 1);
    run(PH_COMBINE, PH_COMBINE + 1, 0, 0);
#else
    run(0, PH_END, 0, 5);
#endif
}
```

```cpp
#include <hip/hip_runtime.h>
#include <cstdio>
#include <cstdint>
#include <cmath>

#define GAS __attribute__((address_space(1)))
#define LAS __attribute__((address_space(3)))
typedef unsigned short bf16_t;
typedef short bf16x8 __attribute__((ext_vector_type(8)));
typedef float f32x4 __attribute__((ext_vector_type(4)));
typedef float f32x2 __attribute__((ext_vector_type(2)));
typedef unsigned u32x4 __attribute__((ext_vector_type(4)));
typedef unsigned u32x2 __attribute__((ext_vector_type(2)));
typedef int i32x8 __attribute__((ext_vector_type(8)));
typedef int i32x4 __attribute__((ext_vector_type(4)));

constexpr int BATCH = 32, SEQ = 2048, DM = 1024, T = BATCH * SEQ, MEMLEN = 256, MROWS = BATCH * MEMLEN;
constexpr int NPROJ = 3072, DIN = 3080, NP2 = 2048;
constexpr int NEXP = 32, TOPK = 4;
constexpr float EPS = 1e-5f;
constexpr float LAMBDA_INIT = 0.2f;

constexpr size_t MiB = 1u << 20;
constexpr size_t WS_CTL = 0, CTL_ZERO_BYTES = 64 * 1024;
constexpr size_t WS_RSTDX = 1 * MiB;
constexpr size_t WS_RSTDM = WS_RSTDX + (size_t)T * 4;
constexpr size_t WS_B1P = WS_RSTDM + (size_t)MROWS * 4;
constexpr size_t WS_MISC = WS_B1P + (size_t)NEXP * 2048 * 4;
constexpr size_t WS_RSTD2 = WS_MISC + 4096;
static_assert(WS_RSTD2 + (size_t)T * 4 <= 2 * MiB, "small region");
constexpr size_t WS_SSP1 = 2 * MiB;
constexpr size_t WS_SSP2 = 6 * MiB;
constexpr size_t WS_GATES = 10 * MiB;
constexpr size_t WS_TOKMAP = 12 * MiB;
constexpr size_t WS_GATEV = 13 * MiB;
constexpr size_t WS_LIST = 14 * MiB;
constexpr size_t WS_WIN = 24 * MiB;
constexpr size_t WS_WOUT = 30 * MiB;
constexpr size_t WS_WCQ = 32 * MiB;
constexpr size_t WS_WCKV = 34 * MiB;
constexpr size_t WS_WCO = 38 * MiB;
constexpr size_t WS_WR = 40 * MiB;
constexpr size_t WS_W1 = 64 * MiB;
constexpr size_t WS_H2F = 128 * MiB;
constexpr size_t WS_W2 = 192 * MiB;
constexpr size_t WS_XB = 256 * MiB;
constexpr size_t WS_PROJ = 384 * MiB;
constexpr size_t WS_H1F = 640 * MiB;
constexpr size_t WS_VT1 = 640 * MiB;
constexpr size_t WS_CAT = 768 * MiB;
constexpr size_t WS_MST = 896 * MiB;
constexpr size_t WS_MEMB = 962 * MiB;
constexpr size_t WS_KV = 978 * MiB;
constexpr size_t WS_VT2 = 994 * MiB;
constexpr size_t WS_QM = 128 * MiB;
constexpr size_t WS_KM = 160 * MiB;
constexpr size_t WS_CSTB = 224 * MiB;
constexpr size_t WS_BC = 1010 * MiB;
constexpr size_t WS_AV = 1011 * MiB;
constexpr size_t WS_AM = 1012 * MiB;
constexpr size_t WS_NLOC = 1013 * MiB;
constexpr size_t WS_NST = WS_NLOC + 512 * 1024;
constexpr size_t WS_CH = 1014 * MiB;
constexpr size_t WS_MSTATE = WS_CH + 64 * 1024;
constexpr size_t WS_Y = 256 * MiB;
constexpr size_t WS_HID = 512 * MiB;
constexpr size_t WS_HID1 = 896 * MiB;
constexpr size_t WS_END = 1024 * MiB;

constexpr int CW_CNT = 64;
constexpr int CW_BAR = 4096;
static_assert((CW_BAR + 3456) * 4 <= (int)CTL_ZERO_BYTES, "control words inside the per-call memset");

__device__ __forceinline__ float bf2f(bf16_t b) { return __uint_as_float(((unsigned)b) << 16); }
__device__ __forceinline__ unsigned f2bf(float f) { unsigned u = __float_as_uint(f); return (u + 0x7fffu + ((u >> 16) & 1u)) >> 16; }
__device__ __forceinline__ unsigned cvt_pk_bf16(float lo, float hi) { unsigned r; asm volatile("v_cvt_pk_bf16_f32 %0, %1, %2" : "=v"(r) : "v"(lo), "v"(hi)); return r; }
__device__ __forceinline__ float x32_sum(float v) { auto r = __builtin_amdgcn_permlane32_swap(__float_as_uint(v), __float_as_uint(v), false, false); return __uint_as_float(r[0]) + __uint_as_float(r[1]); }
__device__ __forceinline__ float x32_max(float v) { auto r = __builtin_amdgcn_permlane32_swap(__float_as_uint(v), __float_as_uint(v), false, false); return fmaxf(__uint_as_float(r[0]), __uint_as_float(r[1])); }
__device__ __forceinline__ float x32_other(float v, int hh) { auto r = __builtin_amdgcn_permlane32_swap(__float_as_uint(v), __float_as_uint(v), false, false); return hh ? __uint_as_float(r[0]) : __uint_as_float(r[1]); }
__device__ __forceinline__ float x16_sum(float v) { auto r = __builtin_amdgcn_permlane16_swap(__float_as_uint(v), __float_as_uint(v), false, false); return __uint_as_float(r[0]) + __uint_as_float(r[1]); }
__device__ __forceinline__ float row16_sum(float v) {
    v += __uint_as_float((unsigned)__builtin_amdgcn_update_dpp(0, (int)__float_as_uint(v), 0xB1, 0xf, 0xf, true));
    v += __uint_as_float((unsigned)__builtin_amdgcn_update_dpp(0, (int)__float_as_uint(v), 0x4E, 0xf, 0xf, true));
    v += __uint_as_float((unsigned)__builtin_amdgcn_update_dpp(0, (int)__float_as_uint(v), 0x141, 0xf, 0xf, true));
    v += __uint_as_float((unsigned)__builtin_amdgcn_update_dpp(0, (int)__float_as_uint(v), 0x140, 0xf, 0xf, true));
    return v; }
__device__ __forceinline__ float wave_sum(float v) { return x32_sum(x16_sum(row16_sum(v))); }
__device__ __forceinline__ int lane_id() { int l; asm volatile("v_mbcnt_lo_u32_b32 %0, -1, 0\n\tv_mbcnt_hi_u32_b32 %0, -1, %0" : "=v"(l)); return l; }
__device__ __forceinline__ float c8(float x) { return __builtin_amdgcn_fmed3f(x, -448.0f, 448.0f); }
__device__ __forceinline__ float lo_bf(unsigned w) { return __uint_as_float(w << 16); }
__device__ __forceinline__ float hi_bf(unsigned w) { return __uint_as_float(w & 0xffff0000u); }

namespace pg8 {
constexpr int BM = 256, BK = 64, HALF = 128, HTB = HALF * BK * 2, STAGE_BYTES = 8 * HTB, NXCD = 8, WGM = 8, KD = 1024, NT = KD / BK;
__host__ __device__ __forceinline__ int lds_byte(int r, int c) { const int st = (r >> 4) * 2 + (c >> 5), rr = r & 15, cc = c & 31, ob = rr * 64 + cc * 2; return st * 1024 + (ob ^ (((ob >> 9) & 1) << 5)); }
__host__ __device__ __forceinline__ void stage_rc(int b, int& R, int& C) { const int st = b / 1024, sb = b % 1024, swz = sb ^ (((sb >> 9) & 1) << 5); R = (st >> 1) * 16 + swz / 64; C = (st & 1) * 32 + (swz % 64) / 2; }
__host__ __device__ __forceinline__ int perm32(int rho) { const int n = rho >> 4, i = rho & 15; return 8 * (i >> 2) + 4 * n + (i & 3); }

struct Unit { const char* A; const char* B; int pm, pn, e, nvalid, y0, aux; };

__device__ __forceinline__ bool static_next(int i, int G, int c, int nM, int nN, int& pm, int& pn) {
    const int nwg = nM * nN; const long L = (long)i * G + c; if (L >= nwg) return false;
    int wgid = (int)L; { const int q = nwg / NXCD, r = nwg % NXCD, xcd = wgid % NXCD, off = wgid / NXCD; wgid = (xcd < r ? xcd * (q + 1) : r * (q + 1) + (xcd - r) * q) + off; }
    const int nig = WGM * nN, gid = wgid / nig, fm = gid * WGM, gsz = (nM - fm) < WGM ? (nM - fm) : WGM;
    pm = fm + ((wgid % nig) % gsz); pn = (wgid % nig) / gsz; return true;
}

template <class P, bool ALIGN_EPI>
__device__ __forceinline__ void gemm_phase(LAS unsigned char* lds, const P& prob, const int wid) {
    const int lane = lane_id(), tid = wid * 64 + lane, wr = wid >> 2, wc = wid & 3, fr = lane & 15, fq = lane >> 4;
    constexpr int ROWB = P::FP8 ? KD : 2 * KD;
    constexpr int nt = ROWB / 128;
    int RA[2], CA[2]; unsigned voffA[2], voffB[2];
#pragma unroll
    for (int i = 0; i < 2; ++i) { int R, C; stage_rc(tid * 16 + i * 8192, R, C); const int Rb = P::PERM ? ((R & ~31) + perm32(R & 31)) : R;
        RA[i] = R; CA[i] = C * 2; voffA[i] = (unsigned)(R * ROWB + C * 2); voffB[i] = (unsigned)(Rb * ROWB + C * 2); }
    constexpr int kstep = BK * 2;
    constexpr size_t hstep = (size_t)HALF * ROWB;
    const unsigned ldsw = (unsigned)wid * 1024u;
    const int aoff = lds_byte(wr * 64 + fr, fq * 8), boff = lds_byte(wc * 32 + fr, fq * 8);
#define PG8_SA(b, h) (((b) * 2 + (h)) * HTB)
#define PG8_SB(b, h) ((4 + (b) * 2 + (h)) * HTB)
#define PG8_STAGE_B(bufoff, gbase) do { _Pragma("unroll") for (int _i = 0; _i < 2; ++_i) \
        __builtin_amdgcn_global_load_lds((const unsigned*)((const char*)(gbase) + voffB[_i]), (LAS unsigned*)(lds + (bufoff) + ldsw + _i * 8192), 16, 0, 0); } while (0)
#define PG8_STAGE_A(bufoff, gbase, off, h) do { _Pragma("unroll") for (int _i = 0; _i < 2; ++_i) { const char* _p; \
        if constexpr (P::GATHER) _p = (const char*)(gbase) + (off)[h][_i]; else _p = (const char*)(gbase) + (size_t)(h) * hstep + voffA[_i]; \
        __builtin_amdgcn_global_load_lds((const unsigned*)_p, (LAS unsigned*)(lds + (bufoff) + ldsw + _i * 8192), 16, 0, 0); } } while (0)
#define PG8_LDA(dst, b, h) do { _Pragma("unroll") for (int m = 0; m < 4; ++m) _Pragma("unroll") for (int k = 0; k < 2; ++k) dst[m][k] = *(const LAS bf16x8*)(lds + PG8_SA(b, h) + aoff + m * 2048 + k * 1024); } while (0)
#define PG8_LDB(dst, b, h) do { _Pragma("unroll") for (int n = 0; n < 2; ++n) _Pragma("unroll") for (int k = 0; k < 2; ++k) dst[n][k] = *(const LAS bf16x8*)(lds + PG8_SB(b, h) + boff + n * 2048 + k * 1024); } while (0)
#define PG8_MMA(ai, bj, At, Bt) do { __builtin_amdgcn_s_setprio(1); _Pragma("unroll") for (int m = 0; m < 4; ++m) _Pragma("unroll") for (int n = 0; n < 2; ++n) { \
        if constexpr (P::FP8) { const i32x4 b0_ = __builtin_bit_cast(i32x4, Bt[n][0]), b1_ = __builtin_bit_cast(i32x4, Bt[n][1]), a0_ = __builtin_bit_cast(i32x4, At[m][0]), a1_ = __builtin_bit_cast(i32x4, At[m][1]); \
            acc[ai][bj][m][n] = __builtin_amdgcn_mfma_scale_f32_16x16x128_f8f6f4((i32x8){b0_[0], b0_[1], b0_[2], b0_[3], b1_[0], b1_[1], b1_[2], b1_[3]}, (i32x8){a0_[0], a0_[1], a0_[2], a0_[3], a1_[0], a1_[1], a1_[2], a1_[3]}, \
                acc[ai][bj][m][n], 0, 0, 0, 0x7f7f7f7f, 0, 0x7f7f7f7f); } \
        else { _Pragma("unroll") for (int k = 0; k < 2; ++k) acc[ai][bj][m][n] = __builtin_amdgcn_mfma_f32_16x16x32_bf16(Bt[n][k], At[m][k], acc[ai][bj][m][n], 0, 0, 0); } } \
        __builtin_amdgcn_s_setprio(0); } while (0)
#define PG8_WAIT_V(n) asm volatile("s_waitcnt vmcnt(" #n ")" ::: "memory")
#define PG8_WAIT_L(n) asm volatile("s_waitcnt lgkmcnt(" #n ")" ::: "memory")
#define PG8_BAR __builtin_amdgcn_s_barrier()
#define PG8_SCHED __builtin_amdgcn_sched_barrier(0)
    Unit cur, nxt; int ui = 0;
    if (!prob.next(0, cur)) return;
    f32x4 acc[2][2][4][2];
#pragma unroll
    for (int a = 0; a < 2; ++a)
#pragma unroll
        for (int b = 0; b < 2; ++b)
#pragma unroll
            for (int m = 0; m < 4; ++m)
#pragma unroll
                for (int n = 0; n < 2; ++n) acc[a][b][m][n] = (f32x4){0.f, 0.f, 0.f, 0.f};
    bf16x8 At[4][2], B0[2][2], B1[2][2];
    unsigned offC[2][2] = {{0u, 0u}, {0u, 0u}};
#define PG8_FILL(u, buf) do { if (tid < 256) prob.gtab[(buf) * 256 + tid] = prob.a_off(u, tid); } while (0)
#define PG8_OFFS(buf) do { _Pragma("unroll") for (int _h = 0; _h < 2; ++_h) _Pragma("unroll") for (int _i = 0; _i < 2; ++_i) offC[_h][_i] = prob.gtab[(buf) * 256 + _h * HALF + RA[_i]] + (unsigned)CA[_i]; } while (0)
    Unit nx2;
    bool has_next = prob.next(1, nxt);
    if constexpr (P::GATHER) { PG8_FILL(cur, 0); if (has_next) PG8_FILL(nxt, 1); PG8_WAIT_L(0); PG8_BAR; PG8_OFFS(0); }
    const char* cA = prob.a_tile(cur); const char* cB = cur.B;
    PG8_STAGE_B(PG8_SB(0, 0), cB); PG8_STAGE_B(PG8_SB(0, 1), cB + hstep); PG8_STAGE_A(PG8_SA(0, 0), cA, offC, 0); PG8_STAGE_A(PG8_SA(0, 1), cA, offC, 1);
    if (wr == 1) PG8_BAR;
    PG8_WAIT_V(2); PG8_BAR;
    PG8_STAGE_B(PG8_SB(1, 0), cB + kstep); PG8_STAGE_A(PG8_SA(1, 0), cA + kstep, offC, 0); PG8_STAGE_B(PG8_SB(1, 1), cB + hstep + kstep);
    PG8_WAIT_V(6); PG8_BAR;
    int bcur = 0;
    for (;;) {
        const bool has_nx2 = has_next && prob.next(ui + 2, nx2);
        const char* nA = has_next ? prob.a_tile(nxt) : cA; const char* nB = has_next ? nxt.B : cB;
        const int bnext = bcur == 2 ? 0 : bcur + 1, bnx2 = bnext == 2 ? 0 : bnext + 1;
#pragma unroll 1
        for (int t = 0; t < nt; t += 2) {
            const bool last = (t == nt - 2);
            const char* a1 = cA + (size_t)(t + 1) * kstep;
            const char* a2 = last ? nA : cA + (size_t)(t + 2) * kstep; const char* b2 = last ? nB : cB + (size_t)(t + 2) * kstep;
            const char* a3 = a2 + kstep; const char* b3 = b2 + kstep;
            PG8_LDB(B0, 0, 0); PG8_LDB(B1, 0, 1); PG8_SCHED; PG8_LDA(At, 0, 0); PG8_STAGE_A(PG8_SA(1, 1), a1, offC, 1);
            if constexpr (P::GATHER) { if (last && has_next) PG8_OFFS(bnext); }
            PG8_WAIT_V(8); PG8_WAIT_L(0); PG8_BAR; PG8_MMA(0, 0, At, B0); PG8_MMA(0, 1, At, B1); PG8_BAR; PG8_SCHED;
            PG8_LDA(At, 0, 1); PG8_STAGE_B(PG8_SB(0, 0), b2); PG8_STAGE_B(PG8_SB(0, 1), b2 + hstep); PG8_STAGE_A(PG8_SA(0, 0), a2, offC, 0);
            PG8_WAIT_V(8); PG8_WAIT_L(0); PG8_BAR; PG8_MMA(1, 0, At, B0); PG8_MMA(1, 1, At, B1); PG8_BAR; PG8_SCHED;
            PG8_LDB(B0, 1, 0); PG8_LDB(B1, 1, 1); PG8_SCHED; PG8_LDA(At, 1, 0); PG8_STAGE_A(PG8_SA(0, 1), a2, offC, 1);
            PG8_WAIT_V(8); PG8_WAIT_L(0); PG8_BAR; PG8_MMA(0, 0, At, B0); PG8_MMA(0, 1, At, B1); PG8_BAR; PG8_SCHED;
            PG8_LDA(At, 1, 1); PG8_STAGE_B(PG8_SB(1, 0), b3); PG8_STAGE_B(PG8_SB(1, 1), b3 + hstep); PG8_STAGE_A(PG8_SA(1, 0), a3, offC, 0);
            PG8_WAIT_V(8); PG8_WAIT_L(0); PG8_BAR; PG8_MMA(1, 0, At, B0); PG8_MMA(1, 1, At, B1); PG8_BAR; PG8_SCHED;
        }
        if constexpr (ALIGN_EPI) { if (wr == 0) PG8_BAR; }
        if constexpr (P::GATHER) { if (has_nx2) PG8_FILL(nx2, bnx2); }
        cur.aux = bcur;
        prob.epi(acc, cur, wr, wc, fr, fq);
        if (!has_next) break;
#pragma unroll
        for (int a = 0; a < 2; ++a)
#pragma unroll
            for (int b = 0; b < 2; ++b)
#pragma unroll
                for (int m = 0; m < 4; ++m)
#pragma unroll
                    for (int n = 0; n < 2; ++n) acc[a][b][m][n] = (f32x4){0.f, 0.f, 0.f, 0.f};
        cur = nxt; nxt = nx2; has_next = has_nx2; cA = nA; cB = nB; ++ui; bcur = bnext;
        if constexpr (ALIGN_EPI) { if (wr == 1) PG8_BAR; }
    }
    PG8_WAIT_V(0);
    if constexpr (!ALIGN_EPI) { if (wr == 0) PG8_BAR; }
    PG8_BAR;
#undef PG8_SA
#undef PG8_SB
#undef PG8_STAGE_A
#undef PG8_STAGE_B
#undef PG8_LDA
#undef PG8_LDB
#undef PG8_MMA
#undef PG8_WAIT_V
#undef PG8_WAIT_L
#undef PG8_BAR
#undef PG8_SCHED
#undef PG8_OFFS
#undef PG8_FILL
}
}

template <bool F8> struct ProbScaleT {
    static constexpr bool FP8 = F8, PERM = true, GATHER = F8;
    static constexpr int RB = F8 ? 1024 : 2048;
    __device__ __forceinline__ const char* a_tile(const pg8::Unit& u) const { return F8 ? u.A : u.A + (size_t)u.pm * (256 * RB); }
    LAS unsigned* gtab;
    const void* A; const void* Bt; int nM, nN, G, c;
    bf16_t* O; int ldo; const float* rstd; const float* ssp;
    __device__ __forceinline__ bool next(int i, pg8::Unit& u) const {
        int pm, pn; if (!pg8::static_next(i, G, c, nM, nN, pm, pn)) return false;
        u.A = (const char*)A; u.B = (const char*)Bt + (size_t)pn * 256 * RB; u.pm = pm; u.pn = pn; u.e = 0; u.nvalid = 256; u.y0 = 0; u.aux = 0; return true; }
    __device__ __forceinline__ unsigned a_off(const pg8::Unit& u, int r) const { return (unsigned)(u.pm * 256 + r) * (unsigned)RB; }
    __device__ __forceinline__ void epi(const f32x4 (&acc)[2][2][4][2], const pg8::Unit& u, int wr, int wc, int fr, int fq) const {
        asm volatile("" : "+v"(fr), "+v"(fq));
        const int rowu = u.pm * 256 + wr * 64;
        char* ub = (char*)O + ((size_t)rowu * ldo + u.pn * 256 + wc * 32) * 2;
        const unsigned lo = (unsigned)(fr * ldo + 8 * fq) * 2u;
        float rsv[8];
        if (rstd) {
#pragma unroll
            for (int q = 0; q < 8; ++q) rsv[q] = rstd[rowu + fr + (q >> 2) * 128 + (q & 3) * 16];
        } else { f32x4 pv[8];
#pragma unroll
            for (int q = 0; q < 8; ++q) pv[q] = *(const f32x4*)(ssp + (size_t)(rowu + fr + (q >> 2) * 128 + (q & 3) * 16) * 16 + fq * 4);
#pragma unroll
            for (int q = 0; q < 8; ++q) { float sq = (pv[q][0] + pv[q][1]) + (pv[q][2] + pv[q][3]); sq = x16_sum(sq); sq = x32_sum(sq); rsv[q] = rsqrtf(sq * (1.0f / 1024.0f) + EPS); } }
#pragma unroll
        for (int ai = 0; ai < 2; ++ai)
#pragma unroll
            for (int m = 0; m < 4; ++m) { const float rs = rsv[ai * 4 + m] * (F8 ? (1.0f / 64.0f) : 1.0f);
                char* rowp = ub + (size_t)(ai * 128 + m * 16) * ldo * 2 + lo;
#pragma unroll
                for (int bj = 0; bj < 2; ++bj) { const f32x4 v0 = acc[ai][bj][m][0] * rs, v1 = acc[ai][bj][m][1] * rs;
                    u32x4 w; w.x = cvt_pk_bf16(v0[0], v0[1]); w.y = cvt_pk_bf16(v0[2], v0[3]); w.z = cvt_pk_bf16(v1[0], v1[1]); w.w = cvt_pk_bf16(v1[2], v1[3]);
                    *(u32x4*)(rowp + bj * 256) = w; } }
    }
};
typedef ProbScaleT<false> ProbScaleBf16;
struct ProbColScaleBf16 {
    static constexpr bool FP8 = false, PERM = true, GATHER = false;
    __device__ __forceinline__ const char* a_tile(const pg8::Unit& u) const { return u.A + (size_t)u.pm * (256 * 2048); }
    const bf16_t* A; const bf16_t* Bt; int nM, nN, G, c;
    bf16_t* O; int ldo; const float* cs;
    __device__ __forceinline__ bool next(int i, pg8::Unit& u) const {
        const long L = (long)i * G + c; if (L >= (long)nM * nN) return false;
        const int pm = (int)(L % nM), pn = (int)(L / nM);
        u.A = (const char*)A; u.B = (const char*)(Bt + (size_t)pn * 256 * 1024); u.pm = pm; u.pn = pn; u.e = 0; u.nvalid = 256; u.y0 = 0; u.aux = 0; return true; }
    __device__ __forceinline__ unsigned a_off(const pg8::Unit& u, int r) const { return 0u; }
    __device__ __forceinline__ void epi(const f32x4 (&acc)[2][2][4][2], const pg8::Unit& u, int wr, int wc, int fr, int fq) const {
        asm volatile("" : "+v"(fr), "+v"(fq));
        const float* cp = cs + u.pn * 256 + wc * 32 + 8 * fq;
        f32x4 sc[2][2];
#pragma unroll
        for (int bj = 0; bj < 2; ++bj)
#pragma unroll
            for (int n = 0; n < 2; ++n) sc[bj][n] = *(const f32x4*)(cp + bj * 128 + 4 * n);
        char* ub = (char*)O + ((size_t)(u.pm * 256 + wr * 64) * ldo + u.pn * 256 + wc * 32) * 2;
        const unsigned lo = (unsigned)(fr * ldo + 8 * fq) * 2u;
#pragma unroll
        for (int ai = 0; ai < 2; ++ai)
#pragma unroll
            for (int m = 0; m < 4; ++m) { char* rowp = ub + (size_t)(ai * 128 + m * 16) * ldo * 2 + lo;
#pragma unroll
                for (int bj = 0; bj < 2; ++bj) { const f32x4 v0 = acc[ai][bj][m][0] * sc[bj][0], v1 = acc[ai][bj][m][1] * sc[bj][1];
                    u32x4 w; w.x = cvt_pk_bf16(v0[0], v0[1]); w.y = cvt_pk_bf16(v0[2], v0[3]); w.z = cvt_pk_bf16(v1[0], v1[1]); w.w = cvt_pk_bf16(v1[2], v1[3]);
                    *(u32x4*)(rowp + bj * 256) = w; } }
    }
};
struct ProbKV {
    static constexpr bool FP8 = true, PERM = true, GATHER = true;
    __device__ __forceinline__ const char* a_tile(const pg8::Unit& u) const { return u.A; }
    LAS unsigned* gtab;
    const unsigned char* memb; const unsigned char* wckv; bf16_t* Kout; bf16_t* VTout; const float* rstdm; int G, c;
    __device__ __forceinline__ bool next(int i, pg8::Unit& u) const {
        const long L = (long)i * G + c; if (L >= 256) return false;
        if (L < 128) { u.pm = (int)(L & 31); u.pn = (int)(L >> 5); u.e = 0; u.A = (const char*)memb; u.B = (const char*)(wckv + (size_t)u.pn * 256 * 1024); }
        else { const int l2 = (int)L - 128; u.pm = l2 & 3; u.pn = l2 >> 2; u.e = 1; u.A = (const char*)(wckv + (size_t)1024 * 1024); u.B = (const char*)(memb + (size_t)u.pn * 256 * 1024); }
        u.nvalid = 256; u.y0 = 0; u.aux = 0; return true; }
    __device__ __forceinline__ unsigned a_off(const pg8::Unit& u, int r) const { return (unsigned)(u.pm * 256 + r) * 1024u; }
    __device__ __forceinline__ void epi(const f32x4 (&acc)[2][2][4][2], const pg8::Unit& u, int wr, int wc, int fr, int fq) const {
        asm volatile("" : "+v"(fr), "+v"(fq));
        const int ldo = u.e ? MROWS : 1024;
        char* ub = (char*)(u.e ? VTout : Kout) + ((size_t)(u.pm * 256 + wr * 64) * ldo + u.pn * 256 + wc * 32) * 2;
        const unsigned lo = (unsigned)(fr * ldo + 8 * fq) * 2u;
        float rsv[8]; f32x4 sc[2][2];
        if (u.e == 0) {
#pragma unroll
            for (int q = 0; q < 8; ++q) rsv[q] = rstdm[u.pm * 256 + wr * 64 + fr + (q >> 2) * 128 + (q & 3) * 16] * (1.0f / 64.0f);
#pragma unroll
            for (int bj = 0; bj < 2; ++bj)
#pragma unroll
                for (int n = 0; n < 2; ++n) sc[bj][n] = (f32x4){1.f, 1.f, 1.f, 1.f};
        } else {
#pragma unroll
            for (int q = 0; q < 8; ++q) rsv[q] = 1.0f / 64.0f;
            const float* cp = rstdm + u.pn * 256 + wc * 32 + 8 * fq;
#pragma unroll
            for (int bj = 0; bj < 2; ++bj)
#pragma unroll
                for (int n = 0; n < 2; ++n) sc[bj][n] = *(const f32x4*)(cp + bj * 128 + 4 * n); }
#pragma unroll
        for (int ai = 0; ai < 2; ++ai)
#pragma unroll
            for (int m = 0; m < 4; ++m) { const float rs = rsv[ai * 4 + m]; char* rowp = ub + (size_t)(ai * 128 + m * 16) * ldo * 2 + lo;
#pragma unroll
                for (int bj = 0; bj < 2; ++bj) { const f32x4 v0 = acc[ai][bj][m][0] * sc[bj][0] * rs, v1 = acc[ai][bj][m][1] * sc[bj][1] * rs;
                    u32x4 w; w.x = cvt_pk_bf16(v0[0], v0[1]); w.y = cvt_pk_bf16(v0[2], v0[3]); w.z = cvt_pk_bf16(v1[0], v1[1]); w.w = cvt_pk_bf16(v1[2], v1[3]);
                    *(u32x4*)(rowp + bj * 256) = w; } }
    }
};
template <bool F8, bool WF8, bool RF32> struct ProbResidT {
    static constexpr bool FP8 = F8, PERM = true, GATHER = F8;
    static constexpr int RB = F8 ? 1024 : 2048;
    __device__ __forceinline__ const char* a_tile(const pg8::Unit& u) const { return F8 ? u.A : u.A + (size_t)u.pm * (256 * RB); }
    LAS unsigned* gtab;
    const void* A; const void* Bt; int nM, nN, G, c;
    const float* rf; const bf16_t* rb; bf16_t* ob; unsigned char* of8; float* ssp;
    __device__ __forceinline__ bool next(int i, pg8::Unit& u) const {
        int pm, pn; if (!pg8::static_next(i, G, c, nM, nN, pm, pn)) return false;
        u.A = (const char*)A; u.B = (const char*)Bt + (size_t)pn * 256 * RB; u.pm = pm; u.pn = pn; u.e = 0; u.nvalid = 256; u.y0 = 0; u.aux = 0; return true; }
    __device__ __forceinline__ unsigned a_off(const pg8::Unit& u, int r) const { return (unsigned)(u.pm * 256 + r) * (unsigned)RB; }
    __device__ __forceinline__ void epi(const f32x4 (&acc)[2][2][4][2], const pg8::Unit& u, int wr, int wc, int fr, int fq) const {
        asm volatile("" : "+v"(fr), "+v"(fq));
        const int rowu = u.pm * 256 + wr * 64;
        const size_t uoff = (size_t)rowu * 1024 + u.pn * 256 + wc * 32;
        const unsigned lo = (unsigned)(fr * 1024 + 8 * fq);
        const float sc = F8 ? (1.0f / 64.0f) : 1.0f;
#pragma unroll
        for (int ai = 0; ai < 2; ++ai) {
            f32x4 rv[4][2][2];
#pragma unroll
            for (int m = 0; m < 4; ++m) { const size_t ro = uoff + (size_t)(ai * 128 + m * 16) * 1024;
#pragma unroll
                for (int bj = 0; bj < 2; ++bj) {
                    if constexpr (RF32) { rv[m][bj][0] = *(const GAS f32x4*)(rf + ro + lo + bj * 128); rv[m][bj][1] = *(const GAS f32x4*)(rf + ro + lo + bj * 128 + 4); }
                    else { const u32x4 w = *(const GAS u32x4*)(rb + ro + lo + bj * 128); rv[m][bj][0] = (f32x4){lo_bf(w.x), hi_bf(w.x), lo_bf(w.y), hi_bf(w.y)}; rv[m][bj][1] = (f32x4){lo_bf(w.z), hi_bf(w.z), lo_bf(w.w), hi_bf(w.w)}; } } }
#pragma unroll
            for (int m = 0; m < 4; ++m) { const size_t ro = uoff + (size_t)(ai * 128 + m * 16) * 1024; float ss = 0.f;
                unsigned pk[2][2];
#pragma unroll
                for (int bj = 0; bj < 2; ++bj) { const f32x4 v0 = acc[ai][bj][m][0] * sc + rv[m][bj][0], v1 = acc[ai][bj][m][1] * sc + rv[m][bj][1];
                    ss += (v0[0] * v0[0] + v0[1] * v0[1]) + (v0[2] * v0[2] + v0[3] * v0[3]) + (v1[0] * v1[0] + v1[1] * v1[1]) + (v1[2] * v1[2] + v1[3] * v1[3]);
                    u32x4 w; w.x = cvt_pk_bf16(v0[0], v0[1]); w.y = cvt_pk_bf16(v0[2], v0[3]); w.z = cvt_pk_bf16(v1[0], v1[1]); w.w = cvt_pk_bf16(v1[2], v1[3]);
                    *(u32x4*)(ob + ro + lo + bj * 128) = w;
                    if constexpr (WF8) { unsigned w0 = 0u, w1 = 0u;
                        w0 = __builtin_amdgcn_cvt_pk_fp8_f32(c8(v0[0]), c8(v0[1]), w0, false); w0 = __builtin_amdgcn_cvt_pk_fp8_f32(c8(v0[2]), c8(v0[3]), w0, true);
                        w1 = __builtin_amdgcn_cvt_pk_fp8_f32(c8(v1[0]), c8(v1[1]), w1, false); w1 = __builtin_amdgcn_cvt_pk_fp8_f32(c8(v1[2]), c8(v1[3]), w1, true);
                        pk[bj][0] = w0; pk[bj][1] = w1; } }
                if constexpr (WF8) {
                    const auto s0 = __builtin_amdgcn_permlane16_swap(pk[0][0], pk[1][0], false, false), s1 = __builtin_amdgcn_permlane16_swap(pk[0][1], pk[1][1], false, false);
                    *(u32x4*)(of8 + ro + lo + ((fq & 1) ? 120u : 0u)) = (u32x4){s0[0], s1[0], s0[1], s1[1]}; }
                ss = x16_sum(ss); ss = x32_sum(ss);
                if (fq == 0) ssp[(size_t)(rowu + ai * 128 + m * 16 + fr) * 16 + u.pn * 4 + wc] = ss; } }
    }
};
__device__ __forceinline__ size_t hid_tile_off(int rt) { return rt < 1024 ? (size_t)rt * (256 * 1024) : (WS_HID1 - WS_HID) + (size_t)(rt - 1024) * (256 * 1024); }
constexpr int MOE_TS = 0, MOE_ST = 33, MOE_CNT = 66, MOE_RTE = 100, MOE_WORDS = 100 + 264;
struct ProbMoe1 {
    static constexpr bool FP8 = true, PERM = true, GATHER = true;
    __device__ __forceinline__ const char* a_tile(const pg8::Unit& u) const { return u.A; }
    const unsigned char* hb; const unsigned char* w1b; const float* b1p; const float* rstd2; const unsigned* list; unsigned char* hid;
    const volatile LAS int* tab; LAS unsigned* gtab; int rt0, nrt, G, c;
    __device__ __forceinline__ bool next(int i, pg8::Unit& u) const {
        const long L = (long)i * G + c; if (L >= (long)nrt * 8) return false;
        const int gidx = (int)(L >> 8), within = (int)(L & 255), gsz = (nrt - gidx * 32) < 32 ? (nrt - gidx * 32) : 32;
        const int rtl = gidx * 32 + within % gsz, pn = within / gsz, rt = rt0 + rtl;
        const int e = ((const volatile LAS unsigned char*)(tab + MOE_RTE))[rt];
        const int idx0 = (rt - tab[MOE_TS + e]) * 256;
        u.A = (const char*)hb; u.B = (const char*)(w1b + ((size_t)e * 2048 + (size_t)pn * 256) * 1024); u.pm = rt; u.pn = pn; u.e = e; u.nvalid = tab[MOE_CNT + e] - idx0; u.y0 = idx0; u.aux = 0; return true; }
    __device__ __forceinline__ unsigned tok_of(const pg8::Unit& u, int r) const { const int rr = r < u.nvalid ? r : 0; return list[(size_t)u.e * T + u.y0 + rr]; }
    __device__ __forceinline__ unsigned a_off(const pg8::Unit& u, int r) const { return tok_of(u, r) * 1024u; }
    __device__ __forceinline__ void epi(const f32x4 (&acc)[2][2][4][2], const pg8::Unit& u, int wr, int wc, int fr, int fq) const {
        asm volatile("" : "+v"(fr), "+v"(fq));
        const float* bp = b1p + (size_t)u.e * 2048 + u.pn * 256 + wc * 32 + 8 * fq;
        const f32x4 bg0 = *(const f32x4*)(bp), bg1 = *(const f32x4*)(bp + 4), bl0 = *(const f32x4*)(bp + 128), bl1 = *(const f32x4*)(bp + 132);
        char* ub = (char*)hid + hid_tile_off(u.pm) + ((size_t)(wr * 64) * 1024 + u.pn * 128 + wc * 32);
        const unsigned lo = (unsigned)(fr * 1024 + 8 * fq);
        unsigned wk[2][2];
#pragma unroll
        for (int ai = 0; ai < 2; ++ai)
#pragma unroll
            for (int m = 0; m < 4; ++m) { const float rs = 1.0f / 64.0f;
                unsigned w[2];
#pragma unroll
                for (int n = 0; n < 2; ++n) { const f32x4 g4 = acc[ai][0][m][n] * rs + (n ? bg1 : bg0), l4 = acc[ai][1][m][n] * rs + (n ? bl1 : bl0);
                    unsigned wv = 0u;
#pragma unroll
                    for (int jp = 0; jp < 2; ++jp) {
                        f32x2 g2 = {fminf(g4[2 * jp], 7.0f), fminf(g4[2 * jp + 1], 7.0f)};
                        const f32x2 l2 = {__builtin_amdgcn_fmed3f(l4[2 * jp], -7.0f, 7.0f), __builtin_amdgcn_fmed3f(l4[2 * jp + 1], -7.0f, 7.0f)};
                        const f32x2 z2 = g2 * (-1.702f * 1.4426950408889634f);
                        const f32x2 d2 = (f32x2){__builtin_amdgcn_exp2f(z2[0]), __builtin_amdgcn_exp2f(z2[1])} + 1.0f;
                        const f32x2 r2 = {__builtin_amdgcn_rcpf(d2[0]), __builtin_amdgcn_rcpf(d2[1])};
                        const f32x2 o2 = (g2 * r2) * (l2 * 4.0f + 4.0f);
                        if (jp) wv = __builtin_amdgcn_cvt_pk_fp8_f32(o2[0], o2[1], wv, true); else wv = __builtin_amdgcn_cvt_pk_fp8_f32(o2[0], o2[1], wv, false); }
                    w[n] = wv; }
                wk[m & 1][0] = w[0]; wk[m & 1][1] = w[1];
                if (m & 1) {
                    const auto s0 = __builtin_amdgcn_permlane16_swap(wk[0][0], wk[1][0], false, false), s1 = __builtin_amdgcn_permlane16_swap(wk[0][1], wk[1][1], false, false);
                    *(u32x4*)(ub + (size_t)(ai * 128 + (m - 1) * 16) * 1024 + lo + ((fq & 1) ? 16u * 1024u - 8u : 0u)) = (u32x4){s0[0], s1[0], s0[1], s1[1]}; } }
    }
};
struct ProbMoe2 {
    static constexpr bool FP8 = true, PERM = true, GATHER = true;
    __device__ __forceinline__ const char* a_tile(const pg8::Unit& u) const { return u.A; }
    const unsigned char* hid; const unsigned char* w2b; const float* b2; unsigned char* y;
    const volatile LAS int* tab; LAS unsigned* gtab; int rt0, nrt, G, c;
    __device__ __forceinline__ bool next(int i, pg8::Unit& u) const {
        const long L = (long)i * G + c; if (L >= (long)nrt * 4) return false;
        const int gidx = (int)(L >> 8), within = (int)(L & 255), gsz = (nrt - gidx * 64) < 64 ? (nrt - gidx * 64) : 64;
        const int rtl = gidx * 64 + within % gsz, pn = within / gsz, rt = rt0 + rtl;
        const int e = ((const volatile LAS unsigned char*)(tab + MOE_RTE))[rt];
        const int idx0 = (rt - tab[MOE_TS + e]) * 256;
        u.A = (const char*)hid; u.B = (const char*)(w2b + ((size_t)e * 1024 + (size_t)pn * 256) * 1024); u.pm = rt; u.pn = pn; u.e = e; u.nvalid = tab[MOE_CNT + e] - idx0; u.y0 = tab[MOE_ST + e] + idx0; u.aux = 0; return true; }
    __device__ __forceinline__ unsigned a_off(const pg8::Unit& u, int r) const { return (unsigned)(hid_tile_off(u.pm) + (size_t)r * 1024u); }
    __device__ __forceinline__ void epi(const f32x4 (&acc)[2][2][4][2], const pg8::Unit& u, int wr, int wc, int fr, int fq) const {
        asm volatile("" : "+v"(fr), "+v"(fq));
        const float* bp = b2 + (size_t)u.e * 1024 + u.pn * 256 + wc * 32 + 8 * fq;
        f32x4 bv[2][2];
#pragma unroll
        for (int bj = 0; bj < 2; ++bj)
#pragma unroll
            for (int n = 0; n < 2; ++n) bv[bj][n] = *(const f32x4*)(bp + bj * 128 + 4 * n);
        char* ub = (char*)y + (((size_t)u.y0 + wr * 64) * 1024 + u.pn * 256 + wc * 32);
        const unsigned lo2 = (unsigned)(fr * 1024 + 8 * fq) + ((fq & 1) ? 120u : 0u);
        const int r0 = wr * 64 + fr;
#pragma unroll
        for (int ai = 0; ai < 2; ++ai)
#pragma unroll
            for (int m = 0; m < 4; ++m) { const int r = r0 + ai * 128 + m * 16;
                unsigned pk[2][2];
#pragma unroll
                for (int bj = 0; bj < 2; ++bj) { const f32x4 v0 = acc[ai][bj][m][0] * (1.0f / 16.0f) + bv[bj][0] * 16.0f, v1 = acc[ai][bj][m][1] * (1.0f / 16.0f) + bv[bj][1] * 16.0f;
                    unsigned w0 = 0u, w1 = 0u;
                    w0 = __builtin_amdgcn_cvt_pk_fp8_f32(c8(v0[0]), c8(v0[1]), w0, false); w0 = __builtin_amdgcn_cvt_pk_fp8_f32(c8(v0[2]), c8(v0[3]), w0, true);
                    w1 = __builtin_amdgcn_cvt_pk_fp8_f32(c8(v1[0]), c8(v1[1]), w1, false); w1 = __builtin_amdgcn_cvt_pk_fp8_f32(c8(v1[2]), c8(v1[3]), w1, true);
                    pk[bj][0] = w0; pk[bj][1] = w1; }
                const auto s0 = __builtin_amdgcn_permlane16_swap(pk[0][0], pk[1][0], false, false), s1 = __builtin_amdgcn_permlane16_swap(pk[0][1], pk[1][1], false, false);
                if (r < u.nvalid) *(u32x4*)(ub + (size_t)(ai * 128 + m * 16) * 1024 + lo2) = (u32x4){s0[0], s1[0], s0[1], s1[1]}; }
    }
};

#define XB_TMO      128
#define XB_XCNT(j)  (256  + 64 * (j))
#define XB_XSUB(j)  (1280 + 64 * (j))
#define XB_XGEN(j)  (2304 + 64 * (j))
#define XB_TOP      3328
#define XB_TOPGEN   3392
#define XCD_BAR_WORDS 3456
#define XB_SPIN_CAP (1u << 18)
__device__ __forceinline__ unsigned xb_ld(unsigned* p)              { return __hip_atomic_load(p, __ATOMIC_RELAXED, __HIP_MEMORY_SCOPE_AGENT); }
__device__ __forceinline__ unsigned xb_add(unsigned* p, unsigned v) { return __hip_atomic_fetch_add(p, v, __ATOMIC_RELAXED, __HIP_MEMORY_SCOPE_AGENT); }
__device__ __forceinline__ unsigned xb_xcc_id() { return (unsigned)__builtin_amdgcn_s_getreg((3 << 11) | 20) & 0xFu; }
#define XB_SPIN(cond, bar) do { unsigned _sp = 0; while (cond) { __builtin_amdgcn_s_sleep(1); \
    if ((++_sp & 255u) == 0u) { if (xb_ld(&(bar)[XB_TMO])) break; if (_sp > XB_SPIN_CAP) { atomicAdd(&(bar)[XB_TMO], 1u); break; } } } } while (0)
struct XcdBarrier { unsigned* bar; unsigned x; volatile LAS unsigned* st; int wave; };
__device__ __forceinline__ XcdBarrier xcd_barrier_post(unsigned* bar, volatile LAS unsigned* st, int wave) {
    XcdBarrier b; b.bar = bar; b.x = xb_xcc_id(); b.st = st; b.wave = wave;
    if (wave == 0 && lane_id() == 0) (void)xb_add(&bar[XB_XCNT(b.x)], 1u);
    return b;
}
__device__ __forceinline__ void xcd_barrier_complete(unsigned* bar, unsigned x, unsigned& nloc, unsigned& nx) {
    const unsigned G = gridDim.x * gridDim.y * gridDim.z;
    unsigned sum, cnt, mine, sp = 0u;
    for (;;) {
        sum = 0u; cnt = 0u; mine = 0u;
#pragma unroll
        for (unsigned j = 0; j < 16; ++j) { const unsigned c = xb_ld(&bar[XB_XCNT(j)]); sum += c; cnt += (c > 0u) ? 1u : 0u; mine = (j == x) ? c : mine; }
        if (sum == G) break;
        __builtin_amdgcn_s_sleep(1);
        if ((++sp & 255u) == 0u) { if (xb_ld(&bar[XB_TMO])) break; if (sp > XB_SPIN_CAP) { atomicAdd(&bar[XB_TMO], 1u); break; } }
    }
    nloc = mine > 0u ? mine : 1u; nx = cnt > 0u ? cnt : 1u;
}
__device__ __forceinline__ void xcd_barrier(const XcdBarrier& b) {
    asm volatile("s_waitcnt vmcnt(0)" ::: "memory");
    __syncthreads();
    if (b.wave == 0 && lane_id() == 0) {
        unsigned* bar = b.bar;
        __builtin_amdgcn_s_waitcnt(0);
        unsigned nloc = b.st[0], nx = b.st[1];
        if (nloc == 0u) { xcd_barrier_complete(bar, b.x, nloc, nx); b.st[0] = nloc; b.st[1] = nx; }
        const unsigned old = xb_add(&bar[XB_XSUB(b.x)], 1u);
        const unsigned gen = old / nloc;
        if (old + 1u == (gen + 1u) * nloc) {
            __builtin_amdgcn_fence(__ATOMIC_RELEASE, "agent");
            asm volatile("s_waitcnt vmcnt(0)" ::: "memory");
            const unsigned og = xb_add(&bar[XB_TOP], 1u);
            const unsigned tg = og / nx;
            if (og + 1u == (tg + 1u) * nx) xb_add(&bar[XB_TOPGEN], 1u);
            else XB_SPIN(xb_ld(&bar[XB_TOPGEN]) == tg, bar);
            __builtin_amdgcn_fence(__ATOMIC_ACQUIRE, "agent");
            xb_add(&bar[XB_XGEN(b.x)], 1u);
            asm volatile("s_waitcnt vmcnt(0)" ::: "memory");
        } else {
            XB_SPIN(xb_ld(&bar[XB_XGEN(b.x)]) == gen, bar);
            __builtin_amdgcn_fence(__ATOMIC_ACQUIRE, "agent");
            asm volatile("s_waitcnt vmcnt(0)" ::: "memory");
        }
    }
    __syncthreads();
}

typedef float f32x16 __attribute__((ext_vector_type(16)));
__device__ __forceinline__ int pi32(int i) { return (i & ~12) | ((i & 4) << 1) | ((i & 8) >> 1); }
__device__ __forceinline__ f32x16 zero16() { f32x16 z;
#pragma unroll
    for (int r = 0; r < 16; ++r) z[r] = 0.f;
    return z; }

__device__ __forceinline__ void xattn_phase(LAS unsigned char* lds, const bf16_t* Q, const bf16_t* Kb, const bf16_t* VT, unsigned char* O, int G, int bx, int wave) {
    const int lane = lane_id(), i = lane & 31, hh = lane >> 5;
    LAS unsigned char* ring = lds;
    bf16x8 qf[16];
#define XA_QLOAD(uid_) do { const int u_ = (uid_); const bf16_t* qp_ = Q + (size_t)((u_ >> 5) * SEQ + (u_ & 7) * 256 + wave * 32 + i) * 1024 + ((u_ >> 3) & 3) * 256 + 8 * hh; \
        _Pragma("unroll") for (int ds = 0; ds < 16; ++ds) qf[ds] = *(const bf16x8*)(qp_ + 16 * ds); } while (0)
    if (bx < BATCH * 4 * 8) XA_QLOAD(bx);
    for (int uid = bx; uid < BATCH * 4 * 8; uid += G) {
        const int b = uid >> 5, h = (uid >> 3) & 3, qblk = uid & 7;
        const int q0 = qblk * 256 + wave * 32;
        const bf16_t* ksrc = Kb + (size_t)(b * MEMLEN + pi32(i)) * 1024 + h * 256 + 16 * wave + 8 * hh;
        const bf16_t* vsrc = VT + (size_t)(h * 256 + i) * MROWS + b * MEMLEN + 32 * (wave >> 1) + 16 * (wave & 1) + 8 * hh;
#define XA_ISSUE(st_) do { LAS unsigned char* sl_ = ring + ((st_) & 3) * 16384; \
        if ((st_) < 8) { const bf16_t* g_ = ksrc + (size_t)(st_) * 32 * 1024; \
            __builtin_amdgcn_global_load_lds((const unsigned*)g_, (LAS unsigned*)(sl_ + wave * 1024), 16, 0, 0); \
            __builtin_amdgcn_global_load_lds((const unsigned*)(g_ + 128), (LAS unsigned*)(sl_ + (8 + wave) * 1024), 16, 0, 0); } \
        else { const bf16_t* g_ = vsrc + (size_t)((st_) - 8) * 32 * MROWS; \
            __builtin_amdgcn_global_load_lds((const unsigned*)g_, (LAS unsigned*)(sl_ + wave * 1024), 16, 0, 0); \
            __builtin_amdgcn_global_load_lds((const unsigned*)(g_ + 128), (LAS unsigned*)(sl_ + (8 + wave) * 1024), 16, 0, 0); } } while (0)
#define XA_VMCNT(n) (((n) & 15) | (7 << 4) | (15 << 8) | (((n) >> 4) << 14))
#define XA_SYNC(st_) do { const int n_ = ((st_) >= 11 ? 1 : 0) + ((st_) <= 14 ? 2 : 0) + ((st_) >= 10 ? 1 : 0) + ((st_) <= 13 ? 2 : 0) + ((st_) >= 9 ? 1 : 0) + (((st_) >= 8 && (st_) <= 10) ? 16 : 0); \
          \
        asm volatile("" ::: "memory"); \
        if (n_ == 3) __builtin_amdgcn_s_waitcnt(XA_VMCNT(3)); else if (n_ == 4) __builtin_amdgcn_s_waitcnt(XA_VMCNT(4)); else if (n_ == 5) __builtin_amdgcn_s_waitcnt(XA_VMCNT(5)); \
        else if (n_ == 20) __builtin_amdgcn_s_waitcnt(XA_VMCNT(20)); else if (n_ == 21) __builtin_amdgcn_s_waitcnt(XA_VMCNT(21)); else if (n_ == 22) __builtin_amdgcn_s_waitcnt(XA_VMCNT(22)); \
        else __builtin_amdgcn_s_waitcnt(XA_VMCNT(7)); \
        asm volatile("" ::: "memory"); \
        __builtin_amdgcn_s_barrier(); asm volatile("" ::: "memory"); if ((st_) + 3 < 16) XA_ISSUE((st_) + 3); } while (0)
        XA_ISSUE(0); XA_ISSUE(1); XA_ISSUE(2);
        f32x16 s[8];
#pragma unroll
        for (int kt = 0; kt < 8; ++kt) { XA_SYNC(kt);
            const LAS unsigned char* sl = ring + (kt & 3) * 16384 + lane * 16;
            f32x16 acc = zero16();
#pragma unroll
            for (int q4 = 0; q4 < 4; ++q4) { __builtin_amdgcn_sched_barrier(0);
#pragma unroll
                for (int d4 = 0; d4 < 4; ++d4) { const int ds = q4 * 4 + d4; acc = __builtin_amdgcn_mfma_f32_32x32x16_bf16(*(const LAS bf16x8*)(sl + ds * 1024), qf[ds], acc, 0, 0, 0); } }
            s[kt] = acc; }
        float m = -INFINITY;
#pragma unroll
        for (int kt = 0; kt < 8; ++kt)
#pragma unroll
            for (int r = 0; r < 16; ++r) m = fmaxf(m, s[kt][r]);
        m = x32_max(m);
        const float c = 0.0625f * 1.4426950408889634f; float l = 0.f; const float mc = m * c;
        u32x4 pf[8][2];
#pragma unroll
        for (int kt = 0; kt < 8; ++kt) {
#pragma unroll
            for (int r = 0; r < 16; ++r) { const float p = __builtin_amdgcn_exp2f(s[kt][r] * c - mc); s[kt][r] = p; l += p; }
#pragma unroll
            for (int sb = 0; sb < 2; ++sb) { pf[kt][sb].x = cvt_pk_bf16(s[kt][8 * sb + 0], s[kt][8 * sb + 1]); pf[kt][sb].y = cvt_pk_bf16(s[kt][8 * sb + 2], s[kt][8 * sb + 3]);
                pf[kt][sb].z = cvt_pk_bf16(s[kt][8 * sb + 4], s[kt][8 * sb + 5]); pf[kt][sb].w = cvt_pk_bf16(s[kt][8 * sb + 6], s[kt][8 * sb + 7]); } }
        l = x32_sum(l);
        const float il = 1.0f / l;
        XA_QLOAD(uid + G < BATCH * 4 * 8 ? uid + G : uid);
        unsigned char* op = O + (size_t)(b * SEQ + q0 + i) * 1024 + h * 256 + 16 * hh;
#pragma unroll
        for (int dvt = 0; dvt < 8; ++dvt) { XA_SYNC(8 + dvt);
            const LAS unsigned char* sl = ring + (dvt & 3) * 16384 + lane * 16;
            f32x16 oacc = zero16();
#pragma unroll
            for (int q4 = 0; q4 < 4; ++q4) { __builtin_amdgcn_sched_barrier(0);
#pragma unroll
                for (int f4 = 0; f4 < 4; ++f4) { const int f = q4 * 4 + f4; oacc = __builtin_amdgcn_mfma_f32_32x32x16_bf16(*(const LAS bf16x8*)(sl + f * 1024), __builtin_bit_cast(bf16x8, pf[f >> 1][f & 1]), oacc, 0, 0, 0); } }
            unsigned wg[4];
#pragma unroll
            for (int g = 0; g < 4; ++g) { unsigned w = 0u; w = __builtin_amdgcn_cvt_pk_fp8_f32(c8(oacc[4 * g] * il), c8(oacc[4 * g + 1] * il), w, false); w = __builtin_amdgcn_cvt_pk_fp8_f32(c8(oacc[4 * g + 2] * il), c8(oacc[4 * g + 3] * il), w, true); wg[g] = w; }
            { const auto s02 = __builtin_amdgcn_permlane32_swap(wg[0], wg[2], false, false), s13 = __builtin_amdgcn_permlane32_swap(wg[1], wg[3], false, false);
              *(u32x4*)(op + dvt * 32) = (u32x4){s02[0], s02[1], s13[0], s13[1]}; } }
#undef XA_ISSUE
#undef XA_SYNC
    }
}

__device__ __forceinline__ void diffattn_phase(LAS unsigned char* lds, LAS float* dgl, const bf16_t* P2, const bf16_t* VT, const float* dng, const float lam, bf16_t* cat, int G, int vx, int wave) {
    const int lane = lane_id(), i_ = lane & 31, hh_ = lane >> 5;
    dgl[wave * 64 + lane] = dng[wave * 64 + lane];
    __syncthreads();
    LAS unsigned char* ring = lds;
    LAS unsigned char* ql = lds + 65536 + wave * 8192 + lane * 16;
    const float c = 0.125f * 1.4426950408889634f;
    for (int pu = vx; pu < BATCH * 4 * 4; pu += G)
        for (int side = 0; side < 2; ++side) {
            const int bh = pu >> 2, x = pu & 3, qb = side ? 7 - x : x, b = bh >> 2, h = bh & 3, q0 = qb * 256 + wave * 32;
            const int ntile = 8 * qb + 8, ktw = 8 * qb + wave;
            int i = i_, hh = hh_; asm volatile("" : "+v"(i), "+v"(hh));
            const bf16_t* qp = P2 + (size_t)(b * SEQ + q0 + i) * NP2 + h * 128 + 8 * hh;
            { bf16x8 t[8];
#pragma unroll
              for (int f = 0; f < 8; ++f) t[f] = *(const bf16x8*)(qp + 16 * f);
#pragma unroll
              for (int f = 0; f < 8; ++f) *(LAS bf16x8*)(ql + f * 1024) = t[f]; }
            const char* kbase = (const char*)(P2 + (size_t)b * SEQ * NP2 + 512 + h * 128 + (wave >> 2) * 64 + 16 * (wave & 3));
            const char* vbase = (const char*)(VT + (size_t)(h * 128 + 32 * (wave >> 1)) * T + (size_t)b * SEQ + 16 * (wave & 1));
            const unsigned koff = (unsigned)(pi32(i) * NP2 + 8 * hh) * 2u, voff = (unsigned)(i * T + 8 * hh) * 2u;
#define DA_ISSUE(kt_) do { LAS unsigned char* sl_ = ring + ((kt_) & 3) * 16384; \
        __builtin_amdgcn_global_load_lds((const unsigned*)(kbase + (size_t)(kt_) * (32 * NP2 * 2) + koff), (LAS unsigned*)(sl_ + wave * 1024), 16, 0, 0); \
        __builtin_amdgcn_global_load_lds((const unsigned*)(vbase + (kt_) * 64 + voff), (LAS unsigned*)(sl_ + (8 + wave) * 1024), 16, 0, 0); } while (0)
            f32x16 o1[4], o2[4];
#pragma unroll
            for (int d = 0; d < 4; ++d) { o1[d] = zero16(); o2[d] = zero16(); }
            float mc1 = -INFINITY, mc2 = -INFINITY, l1 = 0.f, l2 = 0.f;
            u32x4 pp1[2], pp2[2];
#pragma unroll
            for (int sb = 0; sb < 2; ++sb) { pp1[sb] = (u32x4){0u, 0u, 0u, 0u}; pp2[sb] = pp1[sb]; }
            DA_ISSUE(0); DA_ISSUE(1);
            for (int kt = 0; kt <= ntile; ++kt) {
                if (kt < ntile) {
                    if (kt + 1 < ntile) asm volatile("s_waitcnt vmcnt(2)" ::: "memory"); else asm volatile("s_waitcnt vmcnt(0)" ::: "memory");
                    __builtin_amdgcn_s_barrier(); asm volatile("" ::: "memory");
                    if (kt + 2 < ntile) DA_ISSUE(kt + 2);
                }
                if (kt <= ktw + 1) {
                    const LAS unsigned char* sl = ring + (kt & 3) * 16384 + lane * 16;
                    const LAS unsigned char* sp = ring + ((kt == 0 ? 0 : kt - 1) & 3) * 16384 + lane * 16;
                    f32x16 s1 = zero16(), s2 = zero16();
#pragma unroll
                    for (int ds = 0; ds < 4; ++ds) { s1 = __builtin_amdgcn_mfma_f32_32x32x16_bf16(*(const LAS bf16x8*)(sl + ds * 1024), *(const LAS bf16x8*)(ql + ds * 1024), s1, 0, 0, 0);
                        s2 = __builtin_amdgcn_mfma_f32_32x32x16_bf16(*(const LAS bf16x8*)(sl + (4 + ds) * 1024), *(const LAS bf16x8*)(ql + (4 + ds) * 1024), s2, 0, 0, 0);
                        if (ds & 1) __builtin_amdgcn_sched_barrier(0); }
                    if (kt >= ktw) { const int lim = (kt == ktw) ? i : -1;
#pragma unroll
                        for (int r = 0; r < 16; ++r) { const int ko = 16 * (r >> 3) + 8 * hh + (r & 7); if (ko > lim) { s1[r] = -INFINITY; s2[r] = -INFINITY; } } }
                    float f1 = 1.f, f2 = 1.f; bool rs1, rs2;
                    { float tm = s1[0];
#pragma unroll
                      for (int r = 1; r < 16; ++r) tm = fmaxf(tm, s1[r]);
                      tm = x32_max(tm); const float tmc = tm * c; rs1 = __any(tmc > mc1 + 8.0f);
                      if (rs1) { const float mn = fmaxf(mc1, tmc); f1 = __builtin_amdgcn_exp2f(mc1 - mn); mc1 = mn; } }
                    { float tm = s2[0];
#pragma unroll
                      for (int r = 1; r < 16; ++r) tm = fmaxf(tm, s2[r]);
                      tm = x32_max(tm); const float tmc = tm * c; rs2 = __any(tmc > mc2 + 8.0f);
                      if (rs2) { const float mn = fmaxf(mc2, tmc); f2 = __builtin_amdgcn_exp2f(mc2 - mn); mc2 = mn; } }
                    float ls1 = 0.f, ls2 = 0.f; u32x4 pn1[2], pn2[2];
#define DA_SM(j) do { { const float pv_ = __builtin_amdgcn_exp2f(s1[j] * c - mc1); s1[j] = pv_; ls1 += pv_; } { const float pv_ = __builtin_amdgcn_exp2f(s2[j] * c - mc2); s2[j] = pv_; ls2 += pv_; } \
                        if ((j) & 1) { pn1[(j) >> 3][((j) & 7) >> 1] = cvt_pk_bf16(s1[(j) - 1], s1[j]); pn2[(j) >> 3][((j) & 7) >> 1] = cvt_pk_bf16(s2[(j) - 1], s2[j]); } } while (0)
                    { bf16x8 va, vb;
#define DA_VLD(p) (*(const LAS bf16x8*)(sp + (8 + ((p) & 3) * 2 + ((p) >> 2)) * 1024))
#define DA_SLOT(j, VF, LDNEXT) do { if ((j) & 1) o2[((j) >> 1) & 3] = __builtin_amdgcn_mfma_f32_32x32x16_bf16(VF, __builtin_bit_cast(bf16x8, pp2[(j) >> 3]), o2[((j) >> 1) & 3], 0, 0, 0); \
                            else o1[((j) >> 1) & 3] = __builtin_amdgcn_mfma_f32_32x32x16_bf16(VF, __builtin_bit_cast(bf16x8, pp1[(j) >> 3]), o1[((j) >> 1) & 3], 0, 0, 0); \
                            LDNEXT; DA_SM(j); __builtin_amdgcn_sched_barrier(0); } while (0)
                      va = DA_VLD(0);
                      __builtin_amdgcn_sched_barrier(0);
                      DA_SLOT(0, va, vb = DA_VLD(1)); DA_SLOT(1, va, (void)0); DA_SLOT(2, vb, va = DA_VLD(2)); DA_SLOT(3, vb, (void)0);
                      DA_SLOT(4, va, vb = DA_VLD(3)); DA_SLOT(5, va, (void)0); DA_SLOT(6, vb, va = DA_VLD(4)); DA_SLOT(7, vb, (void)0);
                      DA_SLOT(8, va, vb = DA_VLD(5)); DA_SLOT(9, va, (void)0); DA_SLOT(10, vb, va = DA_VLD(6)); DA_SLOT(11, vb, (void)0);
                      DA_SLOT(12, va, vb = DA_VLD(7)); DA_SLOT(13, va, (void)0); DA_SLOT(14, vb, (void)0); DA_SLOT(15, vb, (void)0);
#undef DA_VLD
#undef DA_SLOT
                    }
#undef DA_SM
                    l1 = l1 * f1 + ls1; l2 = l2 * f2 + ls2;
                    if (rs1) {
#pragma unroll
                        for (int d = 0; d < 4; ++d)
#pragma unroll
                            for (int r = 0; r < 16; ++r) o1[d][r] *= f1; }
                    if (rs2) {
#pragma unroll
                        for (int d = 0; d < 4; ++d)
#pragma unroll
                            for (int r = 0; r < 16; ++r) o2[d][r] *= f2; }
#pragma unroll
                    for (int sb = 0; sb < 2; ++sb) { pp1[sb] = pn1[sb]; pp2[sb] = pn2[sb]; }
                }
            }
#undef DA_ISSUE
            l1 = x32_sum(l1); l2 = x32_sum(l2);
            int ie = i, he = hh; asm volatile("" : "+v"(ie), "+v"(he));
            const float i1 = 1.0f / l1, i2 = lam / l2; float ss = 0.f;
#pragma unroll
            for (int d = 0; d < 4; ++d)
#pragma unroll
                for (int r = 0; r < 16; ++r) { const float o = o1[d][r] * i1 - o2[d][r] * i2; o1[d][r] = o; ss += o * o; }
            ss = x32_sum(ss);
            const float rn = rsqrtf(ss * (1.0f / 128.0f) + EPS) * (1.0f - LAMBDA_INIT);
            bf16_t* op = cat + (size_t)(b * SEQ + q0 + ie) * DM + h * 128 + 8 * he;
            const LAS float* gp = dgl + h * 128 + 4 * he;
#pragma unroll
            for (int d = 0; d < 4; ++d)
#pragma unroll
                for (int g2 = 0; g2 < 2; ++g2) { u32x2 w[2];
#pragma unroll
                    for (int q = 0; q < 2; ++q) { const int g = 2 * g2 + q; const f32x4 gv = *(const LAS f32x4*)(gp + d * 32 + 8 * g);
                        w[q].x = cvt_pk_bf16(o1[d][4 * g] * rn * gv[0], o1[d][4 * g + 1] * rn * gv[1]); w[q].y = cvt_pk_bf16(o1[d][4 * g + 2] * rn * gv[2], o1[d][4 * g + 3] * rn * gv[3]); }
                    const auto sa = __builtin_amdgcn_permlane32_swap(w[0].x, w[1].x, false, false), sb = __builtin_amdgcn_permlane32_swap(w[0].y, w[1].y, false, false);
                    *(u32x4*)(op + d * 32 + 16 * g2) = (u32x4){sa[0], sb[0], sa[1], sb[1]}; }
        }
}

__device__ __forceinline__ void mlstm_prep_phase(LAS unsigned char* lds, const bf16_t* P2, const bf16_t* VT, const float* gates, const float* conv_w, const float* conv_b,
                                                 bf16_t* QM, bf16_t* KM, float* BC, float* AV, float* AM, float* CH, float* NLOC, float* CLOC, int G, int vx, int wave) {
    const int lane = lane_id(), i = lane & 31, hh = lane >> 5;
    LAS unsigned char* kl = lds + wave * 16384;
    for (int task = vx * 8 + wave; task < BATCH * 4 * 16; task += G * 8) {
        const int bh = task >> 4, c = task & 15, b = bh >> 2, h = bh & 3;
        const int t0 = b * SEQ + c * 128, tA = t0 + 2 * lane;
        const float lf0 = gates[(size_t)tA * 8 + 4 + h], lf1 = gates[(size_t)(tA + 1) * 8 + 4 + h], ig0 = gates[(size_t)tA * 8 + h], ig1 = gates[(size_t)(tA + 1) * 8 + h];
        float incl = lf0 + lf1;
#pragma unroll
        for (int off = 1; off < 64; off <<= 1) { const float v = __shfl_up(incl, off); if (lane >= off) incl += v; }
        const float bc1 = incl, bc0 = incl - lf1, blast = __shfl(incl, 63);
        const float a0 = ig0 - bc0, a1 = ig1 - bc1;
        float pm = fmaxf(a0, a1);
#pragma unroll
        for (int off = 1; off < 64; off <<= 1) { const float v = __shfl_up(pm, off); if (lane >= off) pm = fmaxf(pm, v); }
        const float pmprev = __shfl_up(pm, 1);
        const float am1 = pm, am0 = (lane > 0) ? fmaxf(pmprev, a0) : a0, amall = __shfl(pm, 63);
        const float ws0 = __expf(a0 - amall), ws1 = __expf(a1 - amall);
        *(f32x2*)(BC + (size_t)h * T + tA) = (f32x2){bc0, bc1};
        *(f32x2*)(AV + (size_t)h * T + tA) = (f32x2){a0, a1};
        *(f32x2*)(AM + (size_t)h * T + tA) = (f32x2){am0, am1};
        if (lane == 0) { CH[task * 2] = blast; CH[task * 2 + 1] = blast + amall; }
        {
            const int r8 = lane >> 3, cg = lane & 7;
            float cw[2][5][8];
#pragma unroll
            for (int part = 0; part < 2; ++part) { const int ch0 = (part ? 256 : 0) + h * 64 + 8 * cg;
#pragma unroll
                for (int k = 0; k < 4; ++k) { const f32x4 a = *(const f32x4*)(conv_w + k * 512 + ch0), bq = *(const f32x4*)(conv_w + k * 512 + ch0 + 4);
#pragma unroll
                    for (int j = 0; j < 4; ++j) { cw[part][k][j] = a[j]; cw[part][k][4 + j] = bq[j]; } }
                { const f32x4 a = *(const f32x4*)(conv_b + ch0), bq = *(const f32x4*)(conv_b + ch0 + 4);
#pragma unroll
                    for (int j = 0; j < 4; ++j) { cw[part][4][j] = a[j]; cw[part][4][4 + j] = bq[j]; } } }
#pragma unroll 4
            for (int jb = 0; jb < 16; ++jb) {
                const int p = 8 * jb + r8, tg = t0 + p, tseq = c * 128 + p;
                const float wa = __shfl(ws0, p >> 1), wb = __shfl(ws1, p >> 1); const float wsp = (p & 1) ? wb : wa;
                u32x4 uw[2][4];
#pragma unroll
                for (int part = 0; part < 2; ++part)
#pragma unroll
                    for (int k = 0; k < 4; ++k) { uw[part][k] = (u32x4){0u, 0u, 0u, 0u};
                        if (tseq - 3 + k >= 0) uw[part][k] = *(const u32x4*)(P2 + (size_t)(tg - 3 + k) * NP2 + 1024 + (part ? 256 : 0) + h * 64 + 8 * cg); }
#pragma unroll
                for (int part = 0; part < 2; ++part) { float y[8];
#pragma unroll
                    for (int j = 0; j < 8; ++j) { float pj = cw[part][4][j];
#pragma unroll
                        for (int k = 0; k < 4; ++k) { const unsigned wv = (j < 2) ? uw[part][k].x : (j < 4) ? uw[part][k].y : (j < 6) ? uw[part][k].z : uw[part][k].w; pj += cw[part][k][j] * ((j & 1) ? hi_bf(wv) : lo_bf(wv)); }
                        y[j] = pj * __builtin_amdgcn_rcpf(1.0f + __expf(-pj)); }
                    if (part == 0) { u32x4 w; w.x = cvt_pk_bf16(y[0] * 0.125f, y[1] * 0.125f); w.y = cvt_pk_bf16(y[2] * 0.125f, y[3] * 0.125f); w.z = cvt_pk_bf16(y[4] * 0.125f, y[5] * 0.125f); w.w = cvt_pk_bf16(y[6] * 0.125f, y[7] * 0.125f);
                        *(u32x4*)(QM + (size_t)tg * 256 + h * 64 + 8 * cg) = w; }
                    else { u32x4 w; w.x = cvt_pk_bf16(y[0], y[1]); w.y = cvt_pk_bf16(y[2], y[3]); w.z = cvt_pk_bf16(y[4], y[5]); w.w = cvt_pk_bf16(y[6], y[7]);
                        *(u32x4*)(KM + (size_t)tg * 256 + h * 64 + 8 * cg) = w;
#pragma unroll
                        for (int j = 0; j < 8; ++j) { const int d = 8 * cg + j;
                            *(LAS unsigned short*)(kl + d * 256 + ((jb ^ (d & 15)) * 16) + r8 * 2) = (unsigned short)f2bf(y[j] * wsp); } } }
            }
        }
        { float ns = 0.f;
#pragma unroll
          for (int cq = 0; cq < 16; ++cq) { const u32x4 w = *(const LAS u32x4*)(kl + lane * 256 + ((cq ^ (lane & 15)) * 16));
              ns += (lo_bf(w.x) + hi_bf(w.x)) + (lo_bf(w.y) + hi_bf(w.y)) + (lo_bf(w.z) + hi_bf(w.z)) + (lo_bf(w.w) + hi_bf(w.w)); }
          NLOC[(size_t)task * 64 + lane] = ns; }
        f32x16 acc[4][2];
#pragma unroll
        for (int et = 0; et < 4; ++et) { acc[et][0] = zero16(); acc[et][1] = zero16(); }
        const bf16_t* vp = VT + (size_t)(512 + h * 128 + i) * T + t0 + 8 * hh;
#pragma unroll
        for (int k2 = 0; k2 < 8; k2 += 2) {
            bf16x8 af[2][4];
#pragma unroll
            for (int q = 0; q < 2; ++q)
#pragma unroll
                for (int et = 0; et < 4; ++et) af[q][et] = *(const bf16x8*)(vp + (size_t)et * 32 * T + 16 * (k2 + q));
            __builtin_amdgcn_sched_barrier(0);
#pragma unroll
            for (int q = 0; q < 2; ++q) { const int ks = k2 + q; bf16x8 bfr[2];
#pragma unroll
                for (int dt = 0; dt < 2; ++dt) { const int d = 32 * dt + i; bfr[dt] = *(const LAS bf16x8*)(kl + d * 256 + (((2 * ks + hh) ^ (d & 15)) * 16)); }
#pragma unroll
                for (int et = 0; et < 4; ++et) {
                    acc[et][0] = __builtin_amdgcn_mfma_f32_32x32x16_bf16(af[q][et], bfr[0], acc[et][0], 0, 0, 0); acc[et][1] = __builtin_amdgcn_mfma_f32_32x32x16_bf16(af[q][et], bfr[1], acc[et][1], 0, 0, 0); } }
            __builtin_amdgcn_sched_barrier(0);
        }
        float* cp = CLOC + (size_t)task * 8192 + i + 256 * hh;
#pragma unroll
        for (int et = 0; et < 4; ++et)
#pragma unroll
            for (int dt = 0; dt < 2; ++dt)
#pragma unroll
                for (int r = 0; r < 16; ++r) cp[(32 * et + (r & 3) + 8 * (r >> 2)) * 64 + 32 * dt] = acc[et][dt][r];
    }
}
__device__ __forceinline__ void mlstm_scan_phase(const float* CLOC, const float* NLOC, const float* CH, bf16_t* CSTB, float* NST, float* MSTATE, int G, int bx, int tid) {
    for (int idx = bx * 512 + tid; idx < BATCH * 4 * 1024; idx += G * 512) {
        const int bh = idx >> 10, rem = idx & 1023, e = rem >> 3, d0 = (rem & 7) * 8;
        float C[8], nr[8]; float m = 0.f;
#pragma unroll
        for (int j = 0; j < 8; ++j) { C[j] = 0.f; nr[j] = 0.f; }
#pragma unroll 1
        for (int c8 = 0; c8 < 16; c8 += 8) {
            f32x4 cl[8][2], nl[8][2]; float bl[8], ml[8];
#pragma unroll
            for (int q = 0; q < 8; ++q) { const int task = bh * 16 + c8 + q;
                cl[q][0] = *(const f32x4*)(CLOC + (size_t)task * 8192 + e * 64 + d0); cl[q][1] = *(const f32x4*)(CLOC + (size_t)task * 8192 + e * 64 + d0 + 4);
                bl[q] = CH[task * 2]; ml[q] = CH[task * 2 + 1];
                if (rem < 8) { nl[q][0] = *(const f32x4*)(NLOC + (size_t)task * 64 + rem * 8); nl[q][1] = *(const f32x4*)(NLOC + (size_t)task * 64 + rem * 8 + 4); }
                else { nl[q][0] = (f32x4){0.f, 0.f, 0.f, 0.f}; nl[q][1] = nl[q][0]; } }
#pragma unroll
            for (int q = 0; q < 8; ++q) { const int task = bh * 16 + c8 + q;
                u32x4 w; w.x = cvt_pk_bf16(C[0], C[1]); w.y = cvt_pk_bf16(C[2], C[3]); w.z = cvt_pk_bf16(C[4], C[5]); w.w = cvt_pk_bf16(C[6], C[7]);
                *(u32x4*)(CSTB + (size_t)task * 8192 + e * 64 + d0) = w;
                if (rem < 8) { *(f32x4*)(NST + (size_t)task * 64 + rem * 8) = (f32x4){nr[0], nr[1], nr[2], nr[3]}; *(f32x4*)(NST + (size_t)task * 64 + rem * 8 + 4) = (f32x4){nr[4], nr[5], nr[6], nr[7]}; }
                if (rem == 0) MSTATE[task] = m;
                const float mn = fmaxf(bl[q] + m, ml[q]), a = __expf(bl[q] + m - mn), bco = __expf(ml[q] - mn);
#pragma unroll
                for (int j = 0; j < 4; ++j) { C[j] = a * C[j] + bco * cl[q][0][j]; C[4 + j] = a * C[4 + j] + bco * cl[q][1][j]; nr[j] = a * nr[j] + bco * nl[q][0][j]; nr[4 + j] = a * nr[4 + j] + bco * nl[q][1][j]; }
                m = mn; }
        }
    }
}
__device__ __forceinline__ void mlstm_out_phase(LAS unsigned char* lds, LAS float* mgl, const bf16_t* P2, const bf16_t* VT, const bf16_t* QM, const bf16_t* KM, const float* BC, const float* AV, const float* AM,
                                                const bf16_t* CSTB, const float* NST, const float* MSTATE, const float* mng, bf16_t* cat, int G, int vx, int wave) {
    const int lane_ = lane_id();
    const int cw = wave >> 2, tq = wave & 3;
    mgl[wave * 64 + lane_] = mng[wave * 64 + lane_];
    __syncthreads();
    LAS unsigned char* reg = lds + cw * 65536;
    for (int un = vx; un < BATCH * 4 * 8; un += G) {
        int lane = lane_; asm volatile("" : "+v"(lane));
        const int i = lane & 31, hh = lane >> 5;
        const int task = 2 * un + cw, bh = task >> 4, c = task & 15, b = bh >> 2, h = bh & 3;
        const int t0 = b * SEQ + c * 128;
        { const bf16_t* ks = KM + (size_t)(t0 + 32 * tq + pi32(i)) * 256 + h * 64 + 8 * hh;
          const bf16_t* cs = CSTB + (size_t)task * 8192 + (32 * tq + i) * 64 + 8 * hh;
          const bf16_t* vs = VT + (size_t)(512 + h * 128 + 32 * tq + i) * T + t0 + 8 * hh;
#pragma unroll
          for (int ds = 0; ds < 4; ++ds) { __builtin_amdgcn_global_load_lds((const unsigned*)(ks + 16 * ds), (LAS unsigned*)(reg + (tq * 4 + ds) * 1024), 16, 0, 0);
              __builtin_amdgcn_global_load_lds((const unsigned*)(cs + 16 * ds), (LAS unsigned*)(reg + 16384 + (tq * 4 + ds) * 1024), 16, 0, 0); }
#pragma unroll
          for (int k8 = 0; k8 < 8; ++k8) __builtin_amdgcn_global_load_lds((const unsigned*)(vs + 16 * k8), (LAS unsigned*)(reg + 32768 + (tq * 8 + k8) * 1024), 16, 0, 0); }
        const float m_c = MSTATE[task];
        const int tg = t0 + 32 * tq + i;
        const float bct = BC[(size_t)h * T + tg], amt = AM[(size_t)h * T + tg];
        bf16x8 qf[4];
#pragma unroll
        for (int ds = 0; ds < 4; ++ds) qf[ds] = *(const bf16x8*)(QM + (size_t)tg * 256 + h * 64 + 16 * ds + 8 * hh);
        float qn = 0.f;
        f32x4 nn[4][2];
#pragma unroll
        for (int ds = 0; ds < 4; ++ds) { nn[ds][0] = *(const f32x4*)(NST + (size_t)task * 64 + 16 * ds + 8 * hh); nn[ds][1] = *(const f32x4*)(NST + (size_t)task * 64 + 16 * ds + 8 * hh + 4); }
#pragma unroll
        for (int ds = 0; ds < 4; ++ds) { const f32x4 n0 = nn[ds][0], n1 = nn[ds][1];
            const u32x4 w = __builtin_bit_cast(u32x4, qf[ds]);
            qn += lo_bf(w.x) * n0[0] + hi_bf(w.x) * n0[1] + lo_bf(w.y) * n0[2] + hi_bf(w.y) * n0[3] + lo_bf(w.z) * n1[0] + hi_bf(w.z) * n1[1] + lo_bf(w.w) * n1[2] + hi_bf(w.w) * n1[3]; }
        qn = x32_sum(qn);
        const float M = fmaxf(m_c, amt), g = __expf(m_c - M), emt = __expf(-(bct + M));
        const bf16_t* mop = P2 + (size_t)tg * NP2 + 1536 + h * 128 + 4 * hh;
        u32x2 mov[4][4];
#pragma unroll
        for (int et = 0; et < 4; ++et)
#pragma unroll
            for (int g4 = 0; g4 < 4; ++g4) mov[et][g4] = *(const u32x2*)(mop + et * 32 + 8 * g4);
        asm volatile("s_waitcnt vmcnt(0)" ::: "memory"); __builtin_amdgcn_s_barrier(); asm volatile("" ::: "memory");
        const LAS unsigned char* rl = reg + lane * 16;
        f32x16 acc[4];
#pragma unroll
        for (int et = 0; et < 4; ++et) { acc[et] = zero16();
#pragma unroll
            for (int ds = 0; ds < 4; ++ds) acc[et] = __builtin_amdgcn_mfma_f32_32x32x16_bf16(*(const LAS bf16x8*)(rl + 16384 + (et * 4 + ds) * 1024), qf[ds], acc[et], 0, 0, 0);
#pragma unroll
            for (int r = 0; r < 16; ++r) acc[et][r] *= g; }
        float wsum = 0.f;
        for (int kt = 0; kt <= tq; ++kt) {
            f32x16 sc = zero16();
#pragma unroll
            for (int ds = 0; ds < 4; ++ds) sc = __builtin_amdgcn_mfma_f32_32x32x16_bf16(*(const LAS bf16x8*)(rl + (kt * 4 + ds) * 1024), qf[ds], sc, 0, 0, 0);
            const float* ap = AV + (size_t)h * T + t0 + 32 * kt + 8 * hh;
            const f32x4 a00 = *(const f32x4*)(ap), a01 = *(const f32x4*)(ap + 4), a10 = *(const f32x4*)(ap + 16), a11 = *(const f32x4*)(ap + 20);
#pragma unroll
            for (int r = 0; r < 16; ++r) { const float av = (r < 4) ? a00[r & 3] : (r < 8) ? a01[r & 3] : (r < 12) ? a10[r & 3] : a11[r & 3];
                const int ko = 16 * (r >> 3) + 8 * hh + (r & 7);
                float w = sc[r] * __expf(av - M);
                w = (kt == tq && ko > i) ? 0.f : w;
                sc[r] = w; wsum += w; }
            u32x4 wf[2];
#pragma unroll
            for (int sb = 0; sb < 2; ++sb) { wf[sb].x = cvt_pk_bf16(sc[8 * sb + 0], sc[8 * sb + 1]); wf[sb].y = cvt_pk_bf16(sc[8 * sb + 2], sc[8 * sb + 3]); wf[sb].z = cvt_pk_bf16(sc[8 * sb + 4], sc[8 * sb + 5]); wf[sb].w = cvt_pk_bf16(sc[8 * sb + 6], sc[8 * sb + 7]); }
#pragma unroll
            for (int et = 0; et < 4; ++et)
#pragma unroll
                for (int sb = 0; sb < 2; ++sb) acc[et] = __builtin_amdgcn_mfma_f32_32x32x16_bf16(*(const LAS bf16x8*)(rl + 32768 + (et * 8 + 2 * kt + sb) * 1024), __builtin_bit_cast(bf16x8, wf[sb]), acc[et], 0, 0, 0);
        }
        wsum = x32_sum(wsum);
        const float den = g * qn + wsum, idd = 1.0f / fmaxf(fabsf(den), emt);
        float ss = 0.f;
#pragma unroll
        for (int et = 0; et < 4; ++et)
#pragma unroll
            for (int r = 0; r < 16; ++r) { const float hv = acc[et][r] * idd; acc[et][r] = hv; ss += hv * hv; }
        ss = x32_sum(ss);
        const float rn = rsqrtf(ss * (1.0f / 128.0f) + EPS);
        bf16_t* op = cat + (size_t)tg * DM + 512 + h * 128 + 8 * hh;
        const LAS float* gp = mgl + h * 128 + 4 * hh;
#pragma unroll
        for (int et = 0; et < 4; ++et)
#pragma unroll
            for (int gq = 0; gq < 2; ++gq) { u32x2 w[2];
#pragma unroll
                for (int q = 0; q < 2; ++q) { const int g4 = 2 * gq + q; const f32x4 gv = *(const LAS f32x4*)(gp + et * 32 + 8 * g4); const u32x2 mo = mov[et][g4];
                    const float o0 = lo_bf(mo.x), o1 = hi_bf(mo.x), o2 = lo_bf(mo.y), o3 = hi_bf(mo.y);
                    const float y0 = acc[et][4 * g4] * rn * gv[0] * __builtin_amdgcn_rcpf(1.0f + __expf(-o0)), y1 = acc[et][4 * g4 + 1] * rn * gv[1] * __builtin_amdgcn_rcpf(1.0f + __expf(-o1));
                    const float y2 = acc[et][4 * g4 + 2] * rn * gv[2] * __builtin_amdgcn_rcpf(1.0f + __expf(-o2)), y3 = acc[et][4 * g4 + 3] * rn * gv[3] * __builtin_amdgcn_rcpf(1.0f + __expf(-o3));
                    w[q].x = cvt_pk_bf16(y0, y1); w[q].y = cvt_pk_bf16(y2, y3); }
                const auto sa = __builtin_amdgcn_permlane32_swap(w[0].x, w[1].x, false, false), sb = __builtin_amdgcn_permlane32_swap(w[0].y, w[1].y, false, false);
                *(u32x4*)(op + et * 32 + 16 * gq) = (u32x4){sa[0], sb[0], sa[1], sb[1]}; }
        asm volatile("s_waitcnt lgkmcnt(0)" ::: "memory"); __builtin_amdgcn_s_barrier(); asm volatile("" ::: "memory");
    }
}

constexpr int NWAVES = 8;
constexpr int RING_BYTES = 131072;
constexpr int LDSCTL_OFF = RING_BYTES;
constexpr int LDS_BYTES = RING_BYTES + 5120;

enum Phase { PH_PREP = 0, PH_INPROJ = 1, PH_MIX0 = 2, PH_MIX1 = 3, PH_MIX2 = 4, PH_OUTPROJ = 5, PH_QKV = 6, PH_XATTN = 7, PH_COPROJ = 8, PH_ROUTER = 9, PH_G1 = 10, PH_G2 = 11, PH_COMBINE = 12, PH_END = 13 };

struct Args { const float* in[28]; float* out; unsigned char* ws; int ph_lo, ph_hi, pass_lo, pass_hi; };

struct CJob { const float* src; const float* g; unsigned char* dst; int Nsrc, k0, n0, mode, f8; float scale; };
__device__ __forceinline__ void conv_load(const CJob& j, f32x4 (&v)[2], int tid) {
    const int kk = tid >> 4, c4 = (tid & 15) * 4;
#pragma unroll
    for (int rep = 0; rep < 2; ++rep) v[rep] = *(const f32x4*)(j.src + (size_t)(j.k0 + kk + 32 * rep) * j.Nsrc + j.n0 + c4);
}
__device__ __forceinline__ void conv_put(LAS float* tile, const f32x4 (&v)[2], int tid) {
    const int kk = tid >> 4, c4 = (tid & 15) * 4;
#pragma unroll
    for (int rep = 0; rep < 2; ++rep)
#pragma unroll
        for (int q = 0; q < 4; ++q) tile[(kk + 32 * rep) * 65 + c4 + q] = v[rep][q];
}
__device__ __forceinline__ void conv_store(const LAS float* tile, const CJob& j, int tid) {
    const int n = tid >> 3, kc = tid & 7; float vals[8];
    f32x4 g0 = (f32x4){1.f, 1.f, 1.f, 1.f}, g1 = g0;
    if (j.g) { g0 = *(const f32x4*)(j.g + j.k0 + 8 * kc); g1 = *(const f32x4*)(j.g + j.k0 + 8 * kc + 4); }
#pragma unroll
    for (int q = 0; q < 8; ++q) vals[q] = tile[(8 * kc + q) * 65 + n] * (q < 4 ? g0[q & 3] : g1[q & 3]) * j.scale;
    const int sc = j.n0 + n; int drow = sc;
    if (j.mode == 1) { const int jj = sc >> 1, s = sc & 1; drow = 256 * (jj >> 7) + 128 * s + (jj & 127); }
    if (j.mode == 2) { drow = sc < 1024 ? sc : sc < 1536 ? sc + 1024 : sc < 2048 ? sc - 512 : sc < 2560 ? sc + 512 : sc - 1024; }
    if (j.f8) { unsigned w0 = 0u, w1 = 0u;
        w0 = __builtin_amdgcn_cvt_pk_fp8_f32(c8(vals[0]), c8(vals[1]), w0, false); w0 = __builtin_amdgcn_cvt_pk_fp8_f32(c8(vals[2]), c8(vals[3]), w0, true);
        w1 = __builtin_amdgcn_cvt_pk_fp8_f32(c8(vals[4]), c8(vals[5]), w1, false); w1 = __builtin_amdgcn_cvt_pk_fp8_f32(c8(vals[6]), c8(vals[7]), w1, true);
        *(u32x2*)(j.dst + (size_t)drow * 1024 + j.k0 + 8 * kc) = (u32x2){w0, w1}; }
    else { u32x4 w; w.x = cvt_pk_bf16(vals[0], vals[1]); w.y = cvt_pk_bf16(vals[2], vals[3]); w.z = cvt_pk_bf16(vals[4], vals[5]); w.w = cvt_pk_bf16(vals[6], vals[7]);
        *(u32x4*)(j.dst + ((size_t)drow * 1024 + j.k0 + 8 * kc) * 2) = w; }
}

__global__ void __launch_bounds__(NWAVES * 64, 2) fwd(Args args) {
    extern __shared__ __attribute__((aligned(16))) unsigned char lds_raw[];
    LAS unsigned char* lds = (LAS unsigned char*)lds_raw;
    volatile LAS unsigned* LCTL = (volatile LAS unsigned*)(lds + LDSCTL_OFF);
    const int wave = __builtin_amdgcn_readfirstlane(threadIdx.x >> 6);
#define lane lane_id()
#define tid (wave * 64 + lane_id())
    const int G = gridDim.x, bx = blockIdx.x;
    unsigned char* ws = args.ws;
    unsigned* ctl = (unsigned*)(ws + WS_CTL);
    const int lo = args.ph_lo, hi = args.ph_hi;
#ifndef PHMASK
#define PHMASK 0xffffff
#endif
#ifndef DUPMASK
#define DUPMASK 0x0
#endif
#define IN(k) (((PHMASK >> (k)) & 1) && lo <= (k) && (k) < hi)
#define NREP(k) ((((DUPMASK) >> (k)) & 1) ? 2 : 1)
#define ENDBAR(k) (BOTH(k) || (((DUPMASK) >> (k)) & 1))
#define BOTH(k) (IN(k) && IN((k) + 1))
    for (int u = tid; u < (LDS_BYTES - LDSCTL_OFF) / 4; u += NWAVES * 64) LCTL[u] = 0u;
    __syncthreads();
    XcdBarrier bar; bar.bar = ctl + CW_BAR; bar.x = 0; bar.st = LCTL; bar.wave = wave;
    const bool multi = (hi - lo) > 1 || (args.pass_hi - args.pass_lo) > 1 || (IN(PH_G1) && IN(PH_G2));
    if (multi) bar = xcd_barrier_post(ctl + CW_BAR, LCTL, wave);
#define GRID_BAR() xcd_barrier(bar)

    const float* x = args.in[0]; const float* mem = args.in[1];
    bf16_t* XB = (bf16_t*)(ws + WS_XB); bf16_t* PROJ = (bf16_t*)(ws + WS_PROJ); bf16_t* CAT = (bf16_t*)(ws + WS_CAT);
    bf16_t* MEMB = (bf16_t*)(ws + WS_MEMB); bf16_t* KV = (bf16_t*)(ws + WS_KV); bf16_t* VT2 = (bf16_t*)(ws + WS_VT2); bf16_t* VT1 = (bf16_t*)(ws + WS_VT1); unsigned char* H1F = ws + WS_H1F;
    bf16_t* WIN = (bf16_t*)(ws + WS_WIN); bf16_t* WOUT = (bf16_t*)(ws + WS_WOUT); bf16_t* WCQ = (bf16_t*)(ws + WS_WCQ); bf16_t* WCKV = (bf16_t*)(ws + WS_WCKV);
    bf16_t* WCO = (bf16_t*)(ws + WS_WCO); bf16_t* WR = (bf16_t*)(ws + WS_WR); unsigned char* W1F = ws + WS_W1; unsigned char* W2F = ws + WS_W2; unsigned char* H2F = ws + WS_H2F;
    float* RSTDX = (float*)(ws + WS_RSTDX); float* RSTDM = (float*)(ws + WS_RSTDM); float* B1P = (float*)(ws + WS_B1P); float* MISC = (float*)(ws + WS_MISC); float* RSTD2 = (float*)(ws + WS_RSTD2);
    float* SSP1 = (float*)(ws + WS_SSP1); float* SSP2 = (float*)(ws + WS_SSP2); float* GATES = (float*)(ws + WS_GATES);
    unsigned* TOKMAP = (unsigned*)(ws + WS_TOKMAP); float* GATEV = (float*)(ws + WS_GATEV); unsigned* LIST = (unsigned*)(ws + WS_LIST);
    unsigned char* YB = ws + WS_Y; unsigned char* HID = ws + WS_HID;

    if (IN(PH_PREP)) for (int rep_ = 0; rep_ < NREP(PH_PREP); ++rep_) {
        constexpr int J0 = 768, J1 = J0 + 256, J2 = J1 + 256, J3 = J2 + 512, J4 = J3 + 256, J5 = J4 + 16384, J6 = J5 + 8192;
        auto decode = [&](int it, CJob& j) {
            if (it < J0) { j = CJob{args.in[3], args.in[2], (unsigned char*)WIN, DIN, (it / 48) * 64, (it % 48) * 64, 2, 0, 1.0f}; }
            else if (it < J1) { const int r = it - J0; j = CJob{args.in[14], nullptr, (unsigned char*)WOUT, 1024, (r / 16) * 64, (r % 16) * 64, 0, 0, 1.0f}; }
            else if (it < J2) { const int r = it - J1; j = CJob{args.in[17], args.in[15], (unsigned char*)WCQ, 1024, (r / 16) * 64, (r % 16) * 64, 0, 1, 64.0f}; }
            else if (it < J3) { const int r = it - J2; j = CJob{args.in[18], args.in[16], (unsigned char*)WCKV, 2048, (r / 32) * 64, (r % 32) * 64, 0, 1, 64.0f}; }
            else if (it < J4) { const int r = it - J3; j = CJob{args.in[19], nullptr, (unsigned char*)WCO, 1024, (r / 16) * 64, (r % 16) * 64, 0, 1, 64.0f}; }
            else if (it < J5) { const int r = it - J4; const int e = r >> 9, q = r & 511; j = CJob{args.in[23] + (size_t)e * 1024 * 2048, args.in[20], W1F + (size_t)e * 2048 * 1024, 2048, (q / 32) * 64, (q % 32) * 64, 1, 1, 64.0f}; }
            else { const int r = it - J5; const int e = r >> 8, q = r & 255; j = CJob{args.in[25] + (size_t)e * 1024 * 1024, nullptr, W2F + (size_t)e * 1024 * 1024, 1024, (q / 16) * 64, (q % 16) * 64, 0, 1, 64.0f}; } };
        static_assert(J0 % 4 == 0 && J1 % 4 == 0 && J2 % 4 == 0 && J3 % 4 == 0 && J4 % 4 == 0 && J5 % 4 == 0 && J6 % 4 == 0, "rounds of four jobs");
#define LDS_BAR() do { asm volatile("s_waitcnt lgkmcnt(0)" ::: "memory"); __builtin_amdgcn_s_barrier(); asm volatile("" ::: "memory"); } while (0)
        { f32x4 v[8]; int it0 = bx * 4; CJob jc;
          if (it0 < J6) { decode(it0, jc);
#pragma unroll
              for (int r = 0; r < 8; ++r) v[r] = *(const f32x4*)(jc.src + (size_t)(jc.k0 + wave * 8 + r) * jc.Nsrc + jc.n0 + 4 * lane); }
          for (; it0 < J6; it0 += G * 4) {
            { LAS float* tq = (LAS float*)lds + (lane >> 4) * (64 * 65) + ((4 * lane) & 63) + (wave * 8) * 65;
#pragma unroll
              for (int r = 0; r < 8; ++r)
#pragma unroll
                  for (int q = 0; q < 4; ++q) tq[r * 65 + q] = v[r][q]; }
            LDS_BAR();
            CJob js = jc; const int nx = it0 + G * 4;
            if (nx < J6) { decode(nx, jc);
#pragma unroll
                for (int r = 0; r < 8; ++r) v[r] = *(const f32x4*)(jc.src + (size_t)(jc.k0 + wave * 8 + r) * jc.Nsrc + jc.n0 + 4 * lane); }
#pragma unroll
            for (int q = 0; q < 4; ++q) { conv_store((const LAS float*)lds + q * (64 * 65), js, tid); js.n0 += 64; }
            LDS_BAR();
          } }
        __syncthreads();
        for (int i = bx * 512 + tid; i < NEXP * 1024; i += G * 512) { const int e = i >> 10, k = i & 1023; WR[i] = (bf16_t)f2bf(args.in[21][k * NEXP + e] * args.in[20][k]); }
        for (int i = bx * 512 + tid; i < NEXP * 2048; i += G * 512) { const int e = i >> 11, rho = i & 2047; const int pn = rho >> 8, s = (rho >> 7) & 1, ii = rho & 127; B1P[i] = args.in[24][e * 2048 + 2 * (128 * pn + ii) + s]; }
        if (bx == 0 && wave == 0) { const float a = wave_sum(args.in[9][lane] * args.in[10][lane]), b = wave_sum(args.in[11][lane] * args.in[12][lane]);
            if (lane == 0) MISC[0] = expf(a) - expf(b) + LAMBDA_INIT; }
        {
            const float* win = args.in[3]; const float* g = args.in[2];
            float wg[4][4][8];
#pragma unroll
            for (int jj = 0; jj < 4; ++jj)
#pragma unroll
                for (int q = 0; q < 4; ++q) { const int k = 4 * lane + 256 * jj + q; const float gk = g[k];
                    const f32x4 a = *(const f32x4*)(win + (size_t)k * DIN + 3072), b = *(const f32x4*)(win + (size_t)k * DIN + 3076);
#pragma unroll
                    for (int j = 0; j < 4; ++j) { wg[jj][q][j] = a[j] * gk; wg[jj][q][4 + j] = b[j] * gk; } }
            const int gw = bx * NWAVES + wave, NGW = G * NWAVES;
            f32x4 vn[4];
            if (gw < T) { const f32x4* xr = (const f32x4*)(x + (size_t)gw * DM) + lane;
#pragma unroll
                for (int jj = 0; jj < 4; ++jj) vn[jj] = xr[64 * jj]; }
            for (int row = gw; row < T; row += NGW) {
                f32x4 v[4]; float ss = 0.f; float d[8];
#pragma unroll
                for (int jj = 0; jj < 4; ++jj) v[jj] = vn[jj];
                if (row + NGW < T) { const f32x4* xr = (const f32x4*)(x + (size_t)(row + NGW) * DM) + lane;
#pragma unroll
                    for (int jj = 0; jj < 4; ++jj) vn[jj] = xr[64 * jj]; }
#pragma unroll
                for (int j = 0; j < 8; ++j) d[j] = 0.f;
#pragma unroll
                for (int jj = 0; jj < 4; ++jj) {
#pragma unroll
                    for (int q = 0; q < 4; ++q) { ss += v[jj][q] * v[jj][q];
#pragma unroll
                        for (int j = 0; j < 8; ++j) d[j] += v[jj][q] * wg[jj][q][j]; } }
                ss = wave_sum(ss);
#pragma unroll
                for (int j = 0; j < 8; ++j) d[j] = wave_sum(d[j]);
                const float rs = rsqrtf(ss * (1.0f / DM) + EPS);
                u32x2* o8 = (u32x2*)(XB + (size_t)row * DM) + lane;
#pragma unroll
                for (int jj = 0; jj < 4; ++jj) { u32x2 w; w.x = cvt_pk_bf16(v[jj][0], v[jj][1]); w.y = cvt_pk_bf16(v[jj][2], v[jj][3]); o8[64 * jj] = w; }
                if (lane == 0) RSTDX[row] = rs;
                if (lane < 8) { float dv = d[0];
#pragma unroll
                    for (int j = 1; j < 8; ++j) dv = (lane == j) ? d[j] : dv;
                    dv *= rs; float r;
                    if (lane < 4) r = dv + args.in[6][lane];
                    else { const float z = dv + args.in[7][lane - 4]; r = (z >= 0.f) ? -log1pf(expf(-z)) : (z - log1pf(expf(z))); }
                    GATES[(size_t)row * 8 + lane] = r; }
            }
            for (int row = gw; row < MROWS; row += NGW) {
                const f32x4* xr = (const f32x4*)(mem + (size_t)row * DM) + lane;
                f32x4 v[4]; float ss = 0.f;
#pragma unroll
                for (int jj = 0; jj < 4; ++jj) { v[jj] = xr[64 * jj]; ss += (v[jj][0] * v[jj][0] + v[jj][1] * v[jj][1]) + (v[jj][2] * v[jj][2] + v[jj][3] * v[jj][3]); }
                ss = wave_sum(ss);
                unsigned* o4 = (unsigned*)((unsigned char*)MEMB + (size_t)row * DM) + lane;
#pragma unroll
                for (int jj = 0; jj < 4; ++jj) { unsigned w = 0u; w = __builtin_amdgcn_cvt_pk_fp8_f32(c8(v[jj][0]), c8(v[jj][1]), w, false); w = __builtin_amdgcn_cvt_pk_fp8_f32(c8(v[jj][2]), c8(v[jj][3]), w, true); o4[64 * jj] = w; }
                if (lane == 0) RSTDM[row] = rsqrtf(ss * (1.0f / DM) + EPS);
            }
        }
        if (ENDBAR(PH_PREP)) GRID_BAR();
    }

    if (IN(PH_INPROJ)) for (int rep_ = 0; rep_ < NREP(PH_INPROJ); ++rep_) {
        { ProbScaleBf16 P{(LAS unsigned*)(lds + LDSCTL_OFF + 2048), XB, WIN, T / 256, NP2 / 256, G, bx, PROJ, NP2, RSTDX, nullptr};
          pg8::gemm_phase<ProbScaleBf16, true>(lds, P, wave); }
        { ProbColScaleBf16 P{WIN + (size_t)NP2 * 1024, XB, 4, T / 256, G, bx, VT1, T, RSTDX};
          pg8::gemm_phase<ProbColScaleBf16, true>(lds, P, wave); }
        if (ENDBAR(PH_INPROJ)) GRID_BAR();
    }

    const int vx = (G % 8 == 0) ? (bx % 8) * (G / 8) + bx / 8 : bx;
    bf16_t* QM = (bf16_t*)(ws + WS_QM); bf16_t* KM = (bf16_t*)(ws + WS_KM); bf16_t* CSTB = (bf16_t*)(ws + WS_CSTB);
    float* BC = (float*)(ws + WS_BC); float* AV = (float*)(ws + WS_AV); float* AM = (float*)(ws + WS_AM); float* NLOC = (float*)(ws + WS_NLOC); float* NST = (float*)(ws + WS_NST);
    float* CH = (float*)(ws + WS_CH); float* MSTATE = (float*)(ws + WS_MSTATE); float* CLOC = (float*)(ws + WS_MST);
    if (IN(PH_MIX0)) for (int rep_ = 0; rep_ < NREP(PH_MIX0); ++rep_) {
        mlstm_prep_phase(lds, PROJ, VT1, GATES, args.in[4], args.in[5], QM, KM, BC, AV, AM, CH, NLOC, CLOC, G, vx, wave);
        if (ENDBAR(PH_MIX0)) GRID_BAR();
    }
    if (IN(PH_MIX1)) for (int rep_ = 0; rep_ < NREP(PH_MIX1); ++rep_) {
        mlstm_scan_phase(CLOC, NLOC, CH, CSTB, NST, MSTATE, G, bx, tid);
        if (ENDBAR(PH_MIX1)) GRID_BAR();
    }
    if (IN(PH_MIX2)) for (int rep_ = 0; rep_ < NREP(PH_MIX2); ++rep_) {
        mlstm_out_phase(lds, (LAS float*)(lds + LDSCTL_OFF + 2048), PROJ, VT1, QM, KM, BC, AV, AM, CSTB, NST, MSTATE, args.in[8], CAT, G, vx, wave);
        __syncthreads();
        const float lam = __hip_atomic_load(MISC, __ATOMIC_RELAXED, __HIP_MEMORY_SCOPE_AGENT);
        diffattn_phase(lds, (LAS float*)(lds + LDSCTL_OFF + 2048), PROJ, VT1, args.in[13], lam, CAT, G, vx, wave);
        if (ENDBAR(PH_MIX2)) GRID_BAR();
    }

    if (IN(PH_OUTPROJ)) for (int rep_ = 0; rep_ < NREP(PH_OUTPROJ); ++rep_) {
        ProbResidT<false, true, false> P{(LAS unsigned*)(lds + LDSCTL_OFF + 2048), CAT, WOUT, T / 256, 4, G, bx, nullptr, XB, XB, H1F, SSP1};
        pg8::gemm_phase<ProbResidT<false, true, false>, true>(lds, P, wave);
        if (ENDBAR(PH_OUTPROJ)) GRID_BAR();
    }

    if (IN(PH_QKV)) for (int rep_ = 0; rep_ < NREP(PH_QKV); ++rep_) {
        { ProbScaleT<true> P{(LAS unsigned*)(lds + LDSCTL_OFF + 2048), H1F, WCQ, T / 256, 4, G, bx, PROJ, 1024, nullptr, SSP1};
          pg8::gemm_phase<ProbScaleT<true>, true>(lds, P, wave); }
        { ProbKV P{(LAS unsigned*)(lds + LDSCTL_OFF + 2048), (const unsigned char*)MEMB, (const unsigned char*)WCKV, KV, VT2, RSTDM, G, bx};
          pg8::gemm_phase<ProbKV, true>(lds, P, wave); }
        if (ENDBAR(PH_QKV)) GRID_BAR();
    }

    if (IN(PH_XATTN)) for (int rep_ = 0; rep_ < NREP(PH_XATTN); ++rep_) {
        xattn_phase(lds, PROJ, KV, VT2, (unsigned char*)(PROJ + (size_t)T * 1024), G, vx, wave);
        if (ENDBAR(PH_XATTN)) GRID_BAR();
    }

    if (IN(PH_COPROJ)) for (int rep_ = 0; rep_ < NREP(PH_COPROJ); ++rep_) {
        ProbResidT<true, false, false> P{(LAS unsigned*)(lds + LDSCTL_OFF + 2048), (unsigned char*)(PROJ + (size_t)T * 1024), WCO, T / 256, 4, G, bx, nullptr, XB, CAT, nullptr, SSP2};
        pg8::gemm_phase<ProbResidT<true, false, false>, true>(lds, P, wave);
        if (ENDBAR(PH_COPROJ)) GRID_BAR();
    }

    if (IN(PH_ROUTER)) for (int rep_ = 0; rep_ < NREP(PH_ROUTER); ++rep_) {
        { u32x4 wv[8];
#pragma unroll
          for (int q = 0; q < 8; ++q) { const int idx = q * (NWAVES * 64) + tid, ks = idx >> 6, ln = idx & 63; wv[q] = *(const u32x4*)(WR + (size_t)(ln & 31) * DM + 16 * ks + 8 * (ln >> 5)); }
#pragma unroll
          for (int q = 0; q < 8; ++q) { const int idx = q * (NWAVES * 64) + tid; *(LAS u32x4*)(lds + idx * 16) = wv[q]; } }
        __syncthreads();
        const float* brt = args.in[22];
        const int i = lane & 31, hh = lane >> 5;
        volatile LAS unsigned* lcnt = (volatile LAS unsigned*)(lds + 65536);
        const int ntrip = (T / 32 + G * NWAVES - 1) / (G * NWAVES);
        for (int trip = 0; trip < ntrip; ++trip) {
            const int tile = trip * G * NWAVES + bx * NWAVES + wave; const bool act = tile < T / 32;
            if (tid < 32) lcnt[tid] = 0u;
            __syncthreads();
            const int t = (act ? tile : 0) * 32 + i;
            const bf16_t* xp = CAT + (size_t)t * DM + 8 * hh;
            const f32x4 p0 = *(const f32x4*)(SSP2 + (size_t)t * 16 + 8 * hh), p1 = *(const f32x4*)(SSP2 + (size_t)t * 16 + 8 * hh + 4);
            float sp = (p0[0] + p0[1]) + (p0[2] + p0[3]) + (p1[0] + p1[1]) + (p1[2] + p1[3]); sp = x32_sum(sp);
            const float rs = rsqrtf(sp * (1.0f / DM) + EPS);
            f32x16 acc = zero16();
#pragma unroll 1
            for (int kb = 0; kb < 64; kb += 16) { bf16x8 xf[16];
#pragma unroll
                for (int q = 0; q < 16; ++q) xf[q] = *(const bf16x8*)(xp + 16 * (kb + q));
#pragma unroll
                for (int q = 0; q < 16; ++q) { const bf16x8 wf = *(const LAS bf16x8*)(lds + ((kb + q) * 64 + lane) * 16); acc = __builtin_amdgcn_mfma_f32_32x32x16_bf16(wf, xf[q], acc, 0, 0, 0); }
#pragma unroll
                for (int q2 = 0; q2 < 8; ++q2) { unsigned pw[2][2];
#pragma unroll
                    for (int q = 0; q < 2; ++q) { const u32x4 xw = __builtin_bit_cast(u32x4, xf[2 * q2 + q]); unsigned w0 = 0u, w1 = 0u;
                        w0 = __builtin_amdgcn_cvt_pk_fp8_f32(lo_bf(xw.x) * rs, hi_bf(xw.x) * rs, w0, false); w0 = __builtin_amdgcn_cvt_pk_fp8_f32(lo_bf(xw.y) * rs, hi_bf(xw.y) * rs, w0, true);
                        w1 = __builtin_amdgcn_cvt_pk_fp8_f32(lo_bf(xw.z) * rs, hi_bf(xw.z) * rs, w1, false); w1 = __builtin_amdgcn_cvt_pk_fp8_f32(lo_bf(xw.w) * rs, hi_bf(xw.w) * rs, w1, true);
                        pw[q][0] = w0; pw[q][1] = w1; }
                    const auto sa = __builtin_amdgcn_permlane32_swap(pw[0][0], pw[1][0], false, false), sb = __builtin_amdgcn_permlane32_swap(pw[0][1], pw[1][1], false, false);
                    *(u32x4*)(H2F + (size_t)t * DM + 16 * (kb + 2 * q2) + 16 * hh) = (u32x4){sa[0], sb[0], sa[1], sb[1]}; } }
            float mine[16], oth[16];
#pragma unroll
            for (int r = 0; r < 16; ++r) { const int e = (r & 3) + 8 * (r >> 2); mine[r] = acc[r] * rs + brt[e + 4 * hh]; }
#pragma unroll
            for (int r = 0; r < 16; ++r) oth[r] = x32_other(mine[r], hh);
            float lg[NEXP];
#pragma unroll
            for (int r = 0; r < 16; ++r) { const int e = (r & 3) + 8 * (r >> 2); lg[e] = hh ? oth[r] : mine[r]; lg[e + 4] = hh ? mine[r] : oth[r]; }
            unsigned taken = 0u; float tv[4]; int te[4];
#pragma unroll
            for (int k = 0; k < TOPK; ++k) { float best = -INFINITY; int bi = 0;
#pragma unroll
                for (int e = 0; e < NEXP; ++e) { const bool ok = !((taken >> e) & 1u) && (lg[e] > best); best = ok ? lg[e] : best; bi = ok ? e : bi; }
                taken |= 1u << bi; tv[k] = best; te[k] = bi; }
            const float q1 = __expf(tv[1] - tv[0]), q2 = __expf(tv[2] - tv[0]), q3 = __expf(tv[3] - tv[0]); const float inv = 1.0f / (1.0f + q1 + q2 + q3);
            const float gk[4] = {inv, q1 * inv, q2 * inv, q3 * inv};
            unsigned lp[4] = {0u, 0u, 0u, 0u};
            if (act && hh == 0) {
#pragma unroll
                for (int k = 0; k < TOPK; ++k) lp[k] = __hip_atomic_fetch_add((LAS unsigned*)(lcnt + te[k]), 1u, __ATOMIC_RELAXED, __HIP_MEMORY_SCOPE_WORKGROUP); }
            __syncthreads();
            if (tid < 32) { const unsigned n = lcnt[tid]; lcnt[32 + tid] = n ? atomicAdd(&ctl[CW_CNT + tid], n) : 0u; }
            __syncthreads();
            if (act && hh == 0) { RSTD2[t] = rs;
                unsigned tm[4];
#pragma unroll
                for (int k = 0; k < TOPK; ++k) { const unsigned pos = lcnt[32 + te[k]] + lp[k]; LIST[(size_t)te[k] * T + pos] = (unsigned)t; tm[k] = ((unsigned)te[k] << 16) | pos; }
                *(u32x4*)(TOKMAP + (size_t)t * 4) = (u32x4){tm[0], tm[1], tm[2], tm[3]};
                *(f32x4*)(GATEV + (size_t)t * 4) = (f32x4){gk[0], gk[1], gk[2], gk[3]}; }
            __syncthreads();
        }
        if (ENDBAR(PH_ROUTER)) GRID_BAR();
    }

    volatile LAS int* tab = (volatile LAS int*)(LCTL + 16);
    int Rtot = 0;
    if (IN(PH_G1) || IN(PH_G2) || IN(PH_COMBINE)) {
        if (tid < NEXP) tab[MOE_CNT + tid] = (int)__hip_atomic_load(&ctl[CW_CNT + tid], __ATOMIC_RELAXED, __HIP_MEMORY_SCOPE_AGENT);
        __syncthreads();
        if (tid == 0) { int ts = 0, st = 0;
            for (int e = 0; e < NEXP; ++e) { const int c = tab[MOE_CNT + e]; tab[MOE_TS + e] = ts; tab[MOE_ST + e] = st; ts += (c + 255) >> 8; st += c; }
            tab[MOE_TS + NEXP] = ts; tab[MOE_ST + NEXP] = st; }
        __syncthreads();
        Rtot = tab[MOE_TS + NEXP];
    }
    if (IN(PH_G1) || IN(PH_G2)) {
        __syncthreads();
        for (int rt = tid; rt < Rtot; rt += NWAVES * 64) { int e = 0;
            for (int j = 1; j < NEXP; ++j) if (rt >= tab[MOE_TS + j]) e = j;
            ((volatile LAS unsigned char*)(tab + MOE_RTE))[rt] = (unsigned char)e; }
        __syncthreads();
        if (IN(PH_G1)) for (int rep_ = 0; rep_ < NREP(PH_G1); ++rep_) { ProbMoe1 P{H2F, W1F, B1P, RSTD2, LIST, HID, tab, (LAS unsigned*)(lds + LDSCTL_OFF + 2048), 0, Rtot, G, bx};
            pg8::gemm_phase<ProbMoe1, true>(lds, P, wave);
            if (IN(PH_G2) || NREP(PH_G1) > 1) GRID_BAR(); }
        if (IN(PH_G2)) for (int rep_ = 0; rep_ < NREP(PH_G2); ++rep_) { ProbMoe2 P{HID, W2F, args.in[26], YB, tab, (LAS unsigned*)(lds + LDSCTL_OFF + 2048), 0, Rtot, G, bx};
            pg8::gemm_phase<ProbMoe2, true>(lds, P, wave);
            if (IN(PH_COMBINE) || NREP(PH_G2) > 1) GRID_BAR(); }
    }
    if (IN(PH_COMBINE)) {
        const float* gf = args.in[27];
        const int gw = bx * NWAVES + wave, NGW = G * NWAVES;
        f32x4 gfv[4];
#pragma unroll
        for (int jj = 0; jj < 4; ++jj) gfv[jj] = *((const f32x4*)gf + 4 * lane + jj);
        u32x4 tmn = (u32x4){0u, 0u, 0u, 0u}; f32x4 gkn = (f32x4){0.f, 0.f, 0.f, 0.f};
        if (gw < T) { tmn = *(const u32x4*)(TOKMAP + (size_t)gw * 4); gkn = *(const f32x4*)(GATEV + (size_t)gw * 4); }
        for (int t = gw; t < T; t += NGW) {
            const u32x4 tm = tmn; const f32x4 gk = gkn;
            if (t + NGW < T) { tmn = *(const u32x4*)(TOKMAP + (size_t)(t + NGW) * 4); gkn = *(const f32x4*)(GATEV + (size_t)(t + NGW) * 4); }
            const u32x4* hb = (const u32x4*)(CAT + (size_t)t * DM) + 2 * lane;
            const u32x4 h0 = hb[0], h1 = hb[1];
            u32x4 yv[4];
#pragma unroll
            for (int k = 0; k < TOPK; ++k) { const int e = (int)(tm[k] >> 16), pos = (int)(tm[k] & 0xffffu); const size_t yrow = (size_t)(tab[MOE_ST + e] + pos);
                yv[k] = *((const u32x4*)(YB + yrow * DM) + lane); }
            float v[16];
            v[0] = lo_bf(h0.x); v[1] = hi_bf(h0.x); v[2] = lo_bf(h0.y); v[3] = hi_bf(h0.y); v[4] = lo_bf(h0.z); v[5] = hi_bf(h0.z); v[6] = lo_bf(h0.w); v[7] = hi_bf(h0.w);
            v[8] = lo_bf(h1.x); v[9] = hi_bf(h1.x); v[10] = lo_bf(h1.y); v[11] = hi_bf(h1.y); v[12] = lo_bf(h1.z); v[13] = hi_bf(h1.z); v[14] = lo_bf(h1.w); v[15] = hi_bf(h1.w);
#pragma unroll
            for (int k = 0; k < TOPK; ++k) { const float g16 = gk[k] * (1.0f / 16.0f);
#pragma unroll
                for (int q = 0; q < 4; ++q) { const f32x2 a = __builtin_amdgcn_cvt_pk_f32_fp8((int)yv[k][q], false), b2_ = __builtin_amdgcn_cvt_pk_f32_fp8((int)yv[k][q], true);
                    v[4 * q] += g16 * a[0]; v[4 * q + 1] += g16 * a[1]; v[4 * q + 2] += g16 * b2_[0]; v[4 * q + 3] += g16 * b2_[1]; } }
            float ss = 0.f;
#pragma unroll
            for (int q = 0; q < 16; ++q) ss += v[q] * v[q];
            ss = wave_sum(ss); const float rs = rsqrtf(ss * (1.0f / DM) + EPS);
            f32x4* orow = (f32x4*)(args.out + (size_t)t * DM) + 4 * lane;
#pragma unroll
            for (int jj = 0; jj < 4; ++jj) orow[jj] = (f32x4){v[4 * jj] * rs * gfv[jj][0], v[4 * jj + 1] * rs * gfv[jj][1], v[4 * jj + 2] * rs * gfv[jj][2], v[4 * jj + 3] * rs * gfv[jj][3]};
        }
    }
#undef IN
#undef BOTH
#undef GRID_BAR
#undef lane
#undef tid
}

extern "C" void kernel_launch(void* const* d_in, const int* in_sizes, int n_in, void* d_out, int out_size, void* d_ws, size_t ws_size, hipStream_t stream) {
    static int grid = 0;
    if (grid == 0) {
        if (n_in != 28 || out_size != T * DM || ws_size < WS_END) { fprintf(stderr, "kernel_launch: unexpected shapes: n_in %d out %d ws %zu\n", n_in, out_size, ws_size); grid = -1; return; }
        int dev = 0, cus = 0;
        if (hipGetDevice(&dev) != hipSuccess || hipDeviceGetAttribute(&cus, hipDeviceAttributeMultiprocessorCount, dev) != hipSuccess) { grid = -1; return; }
        if (hipFuncSetAttribute((const void*)fwd, hipFuncAttributeMaxDynamicSharedMemorySize, LDS_BYTES) != hipSuccess) { fprintf(stderr, "kernel_launch: hipFuncSetAttribute failed\n"); grid = -1; return; }
        int per_cu = 0;
        if (hipOccupancyMaxActiveBlocksPerMultiprocessor(&per_cu, (const void*)fwd, NWAVES * 64, LDS_BYTES) != hipSuccess || per_cu < 1) fprintf(stderr, "kernel_launch: occupancy query says %d\n", per_cu);
        (void)hipGetLastError();
        grid = cus;
    }
    if (grid < 0) return;
    (void)hipMemsetAsync((char*)d_ws + WS_CTL, 0, CTL_ZERO_BYTES, stream);
    Args a{};
    for (int i = 0; i < 28; ++i) a.in[i] = (const float*)d_in[i];
    a.out = (float*)d_out; a.ws = (unsigned char*)d_ws;
    unsigned char* ws = (unsigned char*)d_ws;
    auto run = [&](int lo, int hi, int p0, int p1) { a.ph_lo = lo; a.ph_hi = hi; a.pass_lo = p0; a.pass_hi = p1; hipLaunchKernelGGL(fwd, dim3(grid), dim3(NWAVES * 64), LDS_BYTES, stream, a); };
#ifdef MULTI_LAUNCH
    for (int ph = 0; ph < PH_G1; ++ph) run(ph, ph + 1, 0, 0);
    run(PH_G1, PH_G1 + 1, 0, 1); run(PH_G2, PH_G2 + 1, 0, 1);
    run(PH_COMBINE, PH_COMBINE + 1, 0, 0);
#else
    run(0, PH_END, 0, 5);
#endif
}
```

```cpp
#include <hip/hip_runtime.h>
#include <cstdio>
#include <cstdint>
#include <cmath>

#define GAS __attribute__((address_space(1)))
#define LAS __attribute__((address_space(3)))
typedef unsigned short bf16_t;
typedef short bf16x8 __attribute__((ext_vector_type(8)));
typedef float f32x4 __attribute__((ext_vector_type(4)));
typedef float f32x2 __attribute__((ext_vector_type(2)));
typedef unsigned u32x4 __attribute__((ext_vector_type(4)));
typedef unsigned u32x2 __attribute__((ext_vector_type(2)));
typedef int i32x8 __attribute__((ext_vector_type(8)));
typedef int i32x4 __attribute__((ext_vector_type(4)));

constexpr int BATCH = 32, SEQ = 2048, DM = 1024, T = BATCH * SEQ, MEMLEN = 256, MROWS = BATCH * MEMLEN;
constexpr int NPROJ = 3072, DIN = 3080, NP2 = 2048;
constexpr int NEXP = 32, TOPK = 4;
constexpr float EPS = 1e-5f;
constexpr float LAMBDA_INIT = 0.2f;

constexpr size_t MiB = 1u << 20;
constexpr size_t WS_CTL = 0, CTL_ZERO_BYTES = 64 * 1024;
constexpr size_t WS_RSTDX = 1 * MiB;
constexpr size_t WS_RSTDM = WS_RSTDX + (size_t)T * 4;
constexpr size_t WS_B1P = WS_RSTDM + (size_t)MROWS * 4;
constexpr size_t WS_MISC = WS_B1P + (size_t)NEXP * 2048 * 4;
constexpr size_t WS_RSTD2 = WS_MISC + 4096;
static_assert(WS_RSTD2 + (size_t)T * 4 <= 2 * MiB, "small region");
constexpr size_t WS_SSP1 = 2 * MiB;
constexpr size_t WS_SSP2 = 6 * MiB;
constexpr size_t WS_GATES = 10 * MiB;
constexpr size_t WS_TOKMAP = 12 * MiB;
constexpr size_t WS_GATEV = 13 * MiB;
constexpr size_t WS_LIST = 14 * MiB;
constexpr size_t WS_WIN = 24 * MiB;
constexpr size_t WS_WOUT = 30 * MiB;
constexpr size_t WS_WCQ = 32 * MiB;
constexpr size_t WS_WCKV = 34 * MiB;
constexpr size_t WS_WCO = 38 * MiB;
constexpr size_t WS_WR = 40 * MiB;
constexpr size_t WS_W1 = 64 * MiB;
constexpr size_t WS_H2F = 128 * MiB;
constexpr size_t WS_W2 = 192 * MiB;
constexpr size_t WS_XB = 256 * MiB;
constexpr size_t WS_PROJ = 384 * MiB;
constexpr size_t WS_H1F = 640 * MiB;
constexpr size_t WS_VT1 = 640 * MiB;
constexpr size_t WS_CAT = 768 * MiB;
constexpr size_t WS_MST = 896 * MiB;
constexpr size_t WS_MEMB = 962 * MiB;
constexpr size_t WS_KV = 978 * MiB;
constexpr size_t WS_VT2 = 994 * MiB;
constexpr size_t WS_QM = 128 * MiB;
constexpr size_t WS_KM = 160 * MiB;
constexpr size_t WS_CSTB = 224 * MiB;
constexpr size_t WS_BC = 1010 * MiB;
constexpr size_t WS_AV = 1011 * MiB;
constexpr size_t WS_AM = 1012 * MiB;
constexpr size_t WS_NLOC = 1013 * MiB;
constexpr size_t WS_NST = WS_NLOC + 512 * 1024;
constexpr size_t WS_CH = 1014 * MiB;
constexpr size_t WS_MSTATE = WS_CH + 64 * 1024;
constexpr size_t WS_Y = 256 * MiB;
constexpr size_t WS_HID = 512 * MiB;
constexpr size_t WS_HID1 = 896 * MiB;
constexpr size_t WS_END = 1024 * MiB;

constexpr int CW_CNT = 64;
constexpr int CW_BAR = 4096;
static_assert((CW_BAR + 3456) * 4 <= (int)CTL_ZERO_BYTES, "control words inside the per-call memset");

__device__ __forceinline__ float bf2f(bf16_t b) { return __uint_as_float(((unsigned)b) << 16); }
__device__ __forceinline__ unsigned f2bf(float f) { unsigned u = __float_as_uint(f); return (u + 0x7fffu + ((u >> 16) & 1u)) >> 16; }
__device__ __forceinline__ unsigned cvt_pk_bf16(float lo, float hi) { unsigned r; asm volatile("v_cvt_pk_bf16_f32 %0, %1, %2" : "=v"(r) : "v"(lo), "v"(hi)); return r; }
__device__ __forceinline__ float x32_sum(float v) { auto r = __builtin_amdgcn_permlane32_swap(__float_as_uint(v), __float_as_uint(v), false, false); return __uint_as_float(r[0]) + __uint_as_float(r[1]); }
__device__ __forceinline__ float x32_max(float v) { auto r = __builtin_amdgcn_permlane32_swap(__float_as_uint(v), __float_as_uint(v), false, false); return fmaxf(__uint_as_float(r[0]), __uint_as_float(r[1])); }
__device__ __forceinline__ float x32_other(float v, int hh) { auto r = __builtin_amdgcn_permlane32_swap(__float_as_uint(v), __float_as_uint(v), false, false); return hh ? __uint_as_float(r[0]) : __uint_as_float(r[1]); }
__device__ __forceinline__ float x16_sum(float v) { auto r = __builtin_amdgcn_permlane16_swap(__float_as_uint(v), __float_as_uint(v), false, false); return __uint_as_float(r[0]) + __uint_as_float(r[1]); }
__device__ __forceinline__ float row16_sum(float v) {
    v += __uint_as_float((unsigned)__builtin_amdgcn_update_dpp(0, (int)__float_as_uint(v), 0xB1, 0xf, 0xf, true));
    v += __uint_as_float((unsigned)__builtin_amdgcn_update_dpp(0, (int)__float_as_uint(v), 0x4E, 0xf, 0xf, true));
    v += __uint_as_float((unsigned)__builtin_amdgcn_update_dpp(0, (int)__float_as_uint(v), 0x141, 0xf, 0xf, true));
    v += __uint_as_float((unsigned)__builtin_amdgcn_update_dpp(0, (int)__float_as_uint(v), 0x140, 0xf, 0xf, true));
    return v; }
__device__ __forceinline__ float wave_sum(float v) { return x32_sum(x16_sum(row16_sum(v))); }
__device__ __forceinline__ int lane_id() { int l; asm volatile("v_mbcnt_lo_u32_b32 %0, -1, 0\n\tv_mbcnt_hi_u32_b32 %0, -1, %0" : "=v"(l)); return l; }
__device__ __forceinline__ float c8(float x) { return __builtin_amdgcn_fmed3f(x, -448.0f, 448.0f); }
__device__ __forceinline__ float lo_bf(unsigned w) { return __uint_as_float(w << 16); }
__device__ __forceinline__ float hi_bf(unsigned w) { return __uint_as_float(w & 0xffff0000u); }

namespace pg8 {
constexpr int BM = 256, BK = 64, HALF = 128, HTB = HALF * BK * 2, STAGE_BYTES = 8 * HTB, NXCD = 8, WGM = 8, KD = 1024, NT = KD / BK;
__host__ __device__ __forceinline__ int lds_byte(int r, int c) { const int st = (r >> 4) * 2 + (c >> 5), rr = r & 15, cc = c & 31, ob = rr * 64 + cc * 2; return st * 1024 + (ob ^ (((ob >> 9) & 1) << 5)); }
__host__ __device__ __forceinline__ void stage_rc(int b, int& R, int& C) { const int st = b / 1024, sb = b % 1024, swz = sb ^ (((sb >> 9) & 1) << 5); R = (st >> 1) * 16 + swz / 64; C = (st & 1) * 32 + (swz % 64) / 2; }
__host__ __device__ __forceinline__ int perm32(int rho) { const int n = rho >> 4, i = rho & 15; return 8 * (i >> 2) + 4 * n + (i & 3); }

struct Unit { const char* A; const char* B; int pm, pn, e, nvalid, y0, aux; };

__device__ __forceinline__ bool static_next(int i, int G, int c, int nM, int nN, int& pm, int& pn) {
    const int nwg = nM * nN; const long L = (long)i * G + c; if (L >= nwg) return false;
    int wgid = (int)L; { const int q = nwg / NXCD, r = nwg % NXCD, xcd = wgid % NXCD, off = wgid / NXCD; wgid = (xcd < r ? xcd * (q + 1) : r * (q + 1) + (xcd - r) * q) + off; }
    const int nig = WGM * nN, gid = wgid / nig, fm = gid * WGM, gsz = (nM - fm) < WGM ? (nM - fm) : WGM;
    pm = fm + ((wgid % nig) % gsz); pn = (wgid % nig) / gsz; return true;
}

template <class P, bool ALIGN_EPI>
__device__ __forceinline__ void gemm_phase(LAS unsigned char* lds, const P& prob, const int wid) {
    const int lane = lane_id(), tid = wid * 64 + lane, wr = wid >> 2, wc = wid & 3, fr = lane & 15, fq = lane >> 4;
    constexpr int ROWB = P::FP8 ? KD : 2 * KD;
    constexpr int nt = ROWB / 128;
    int RA[2], CA[2]; unsigned voffA[2], voffB[2];
#pragma unroll
    for (int i = 0; i < 2; ++i) { int R, C; stage_rc(tid * 16 + i * 8192, R, C); const int Rb = P::PERM ? ((R & ~31) + perm32(R & 31)) : R;
        RA[i] = R; CA[i] = C * 2; voffA[i] = (unsigned)(R * ROWB + C * 2); voffB[i] = (unsigned)(Rb * ROWB + C * 2); }
    constexpr int kstep = BK * 2;
    constexpr size_t hstep = (size_t)HALF * ROWB;
    const unsigned ldsw = (unsigned)wid * 1024u;
    const int aoff = lds_byte(wr * 64 + fr, fq * 8), boff = lds_byte(wc * 32 + fr, fq * 8);
#define PG8_SA(b, h) (((b) * 2 + (h)) * HTB)
#define PG8_SB(b, h) ((4 + (b) * 2 + (h)) * HTB)
#define PG8_STAGE_B(bufoff, gbase) do { _Pragma("unroll") for (int _i = 0; _i < 2; ++_i) \
        __builtin_amdgcn_global_load_lds((const unsigned*)((const char*)(gbase) + voffB[_i]), (LAS unsigned*)(lds + (bufoff) + ldsw + _i * 8192), 16, 0, 0); } while (0)
#define PG8_STAGE_A(bufoff, gbase, off, h) do { _Pragma("unroll") for (int _i = 0; _i < 2; ++_i) { const char* _p; \
        if constexpr (P::GATHER) _p = (const char*)(gbase) + (off)[h][_i]; else _p = (const char*)(gbase) + (size_t)(h) * hstep + voffA[_i]; \
        __builtin_amdgcn_global_load_lds((const unsigned*)_p, (LAS unsigned*)(lds + (bufoff) + ldsw + _i * 8192), 16, 0, 0); } } while (0)
#define PG8_LDA(dst, b, h) do { _Pragma("unroll") for (int m = 0; m < 4; ++m) _Pragma("unroll") for (int k = 0; k < 2; ++k) dst[m][k] = *(const LAS bf16x8*)(lds + PG8_SA(b, h) + aoff + m * 2048 + k * 1024); } while (0)
#define PG8_LDB(dst, b, h) do { _Pragma("unroll") for (int n = 0; n < 2; ++n) _Pragma("unroll") for (int k = 0; k < 2; ++k) dst[n][k] = *(const LAS bf16x8*)(lds + PG8_SB(b, h) + boff + n * 2048 + k * 1024); } while (0)
#define PG8_MMA(ai, bj, At, Bt) do { __builtin_amdgcn_s_setprio(1); _Pragma("unroll") for (int m = 0; m < 4; ++m) _Pragma("unroll") for (int n = 0; n < 2; ++n) { \
        if constexpr (P::FP8) { const i32x4 b0_ = __builtin_bit_cast(i32x4, Bt[n][0]), b1_ = __builtin_bit_cast(i32x4, Bt[n][1]), a0_ = __builtin_bit_cast(i32x4, At[m][0]), a1_ = __builtin_bit_cast(i32x4, At[m][1]); \
            acc[ai][bj][m][n] = __builtin_amdgcn_mfma_scale_f32_16x16x128_f8f6f4((i32x8){b0_[0], b0_[1], b0_[2], b0_[3], b1_[0], b1_[1], b1_[2], b1_[3]}, (i32x8){a0_[0], a0_[1], a0_[2], a0_[3], a1_[0], a1_[1], a1_[2], a1_[3]}, \
                acc[ai][bj][m][n], 0, 0, 0, 0x7f7f7f7f, 0, 0x7f7f7f7f); } \
        else { _Pragma("unroll") for (int k = 0; k < 2; ++k) acc[ai][bj][m][n] = __builtin_amdgcn_mfma_f32_16x16x32_bf16(Bt[n][k], At[m][k], acc[ai][bj][m][n], 0, 0, 0); } } \
        __builtin_amdgcn_s_setprio(0); } while (0)
#define PG8_WAIT_V(n) do { asm volatile("" ::: "memory"); __builtin_amdgcn_s_waitcnt(((n) & 15) | (7 << 4) | (15 << 8) | (((n) >> 4) << 14)); asm volatile("" ::: "memory"); } while (0)
#define PG8_WAIT_L(n) asm volatile("s_waitcnt lgkmcnt(" #n ")" ::: "memory")
#define PG8_BAR __builtin_amdgcn_s_barrier()
#define PG8_SCHED __builtin_amdgcn_sched_barrier(0)
    Unit cur, nxt; int ui = 0;
    if (!prob.next(0, cur)) return;
    f32x4 acc[2][2][4][2];
#pragma unroll
    for (int a = 0; a < 2; ++a)
#pragma unroll
        for (int b = 0; b < 2; ++b)
#pragma unroll
            for (int m = 0; m < 4; ++m)
#pragma unroll
                for (int n = 0; n < 2; ++n) acc[a][b][m][n] = (f32x4){0.f, 0.f, 0.f, 0.f};
    bf16x8 At[4][2], B0[2][2], B1[2][2];
    unsigned offC[2][2] = {{0u, 0u}, {0u, 0u}};
#define PG8_FILL(u, buf) do { if (tid < 256) { if constexpr (P::GATHER) prob.gtab[(buf) * 256 + tid] = prob.a_off(u, tid); \
        if constexpr (P::ETAB) ((LAS float*)prob.gtab)[768 + (buf) * 256 + tid] = prob.e_val(u, tid); } } while (0)
#define PG8_OFFS(buf) do { _Pragma("unroll") for (int _h = 0; _h < 2; ++_h) _Pragma("unroll") for (int _i = 0; _i < 2; ++_i) offC[_h][_i] = prob.gtab[(buf) * 256 + _h * HALF + RA[_i]] + (unsigned)CA[_i]; } while (0)
    Unit nx2;
    bool has_next = prob.next(1, nxt);
    if constexpr (P::GATHER || P::ETAB) { PG8_FILL(cur, 0); if (has_next) PG8_FILL(nxt, 1); PG8_WAIT_L(0); PG8_BAR; if constexpr (P::GATHER) PG8_OFFS(0); }
    const char* cA = prob.a_tile(cur); const char* cB = cur.B;
    PG8_STAGE_B(PG8_SB(0, 0), cB); PG8_STAGE_B(PG8_SB(0, 1), cB + hstep); PG8_STAGE_A(PG8_SA(0, 0), cA, offC, 0); PG8_STAGE_A(PG8_SA(0, 1), cA, offC, 1);
    if (wr == 1) PG8_BAR;
    PG8_WAIT_V(2); PG8_BAR;
    PG8_STAGE_B(PG8_SB(1, 0), cB + kstep); PG8_STAGE_A(PG8_SA(1, 0), cA + kstep, offC, 0); PG8_STAGE_B(PG8_SB(1, 1), cB + hstep + kstep);
    PG8_WAIT_V(6); PG8_BAR;
    int bcur = 0;
    for (;;) {
        const bool has_nx2 = has_next && prob.next(ui + 2, nx2);
        const char* nA = has_next ? prob.a_tile(nxt) : cA; const char* nB = has_next ? nxt.B : cB;
        const int bnext = bcur == 2 ? 0 : bcur + 1, bnx2 = bnext == 2 ? 0 : bnext + 1;
        unsigned fg_ = 0u; float fe_ = 0.f; const bool fill_ = has_nx2 && tid < 256;
        if constexpr (P::GATHER) { if (fill_) fg_ = prob.a_off(nx2, tid); }
        if constexpr (P::ETAB) { if (fill_) fe_ = prob.e_val(nx2, tid); }
#pragma unroll 1
        for (int t = 0; t < nt; t += 2) {
            const bool last = (t == nt - 2);
            const char* a1 = cA + (size_t)(t + 1) * kstep;
            const char* a2 = last ? nA : cA + (size_t)(t + 2) * kstep; const char* b2 = last ? nB : cB + (size_t)(t + 2) * kstep;
            const char* a3 = a2 + kstep; const char* b3 = b2 + kstep;
            PG8_LDB(B0, 0, 0); PG8_LDB(B1, 0, 1); PG8_SCHED; PG8_LDA(At, 0, 0); PG8_STAGE_A(PG8_SA(1, 1), a1, offC, 1);
            if constexpr (P::GATHER) { if (last && has_next) PG8_OFFS(bnext); }
            PG8_WAIT_V(8); PG8_WAIT_L(0); PG8_BAR; PG8_MMA(0, 0, At, B0); PG8_MMA(0, 1, At, B1); PG8_BAR; PG8_SCHED;
            PG8_LDA(At, 0, 1); PG8_STAGE_B(PG8_SB(0, 0), b2); PG8_STAGE_B(PG8_SB(0, 1), b2 + hstep); PG8_STAGE_A(PG8_SA(0, 0), a2, offC, 0);
            PG8_WAIT_V(8); PG8_WAIT_L(0); PG8_BAR; PG8_MMA(1, 0, At, B0); PG8_MMA(1, 1, At, B1); PG8_BAR; PG8_SCHED;
            PG8_LDB(B0, 1, 0); PG8_LDB(B1, 1, 1); PG8_SCHED; PG8_LDA(At, 1, 0); PG8_STAGE_A(PG8_SA(0, 1), a2, offC, 1);
            PG8_WAIT_V(8); PG8_WAIT_L(0); PG8_BAR; PG8_MMA(0, 0, At, B0); PG8_MMA(0, 1, At, B1); PG8_BAR; PG8_SCHED;
            PG8_LDA(At, 1, 1); PG8_STAGE_B(PG8_SB(1, 0), b3); PG8_STAGE_B(PG8_SB(1, 1), b3 + hstep); PG8_STAGE_A(PG8_SA(1, 0), a3, offC, 0);
            PG8_WAIT_V(8); PG8_WAIT_L(0); PG8_BAR; PG8_MMA(1, 0, At, B0); PG8_MMA(1, 1, At, B1); PG8_BAR; PG8_SCHED;
        }
        if constexpr (ALIGN_EPI) { if (wr == 0) PG8_BAR; }
        if constexpr (P::GATHER) { if (fill_) prob.gtab[bnx2 * 256 + tid] = fg_; }
        if constexpr (P::ETAB) { if (fill_) ((LAS float*)prob.gtab)[768 + bnx2 * 256 + tid] = fe_; }
        cur.aux = bcur;
        prob.epi(acc, cur, wr, wc, fr, fq);
        if (!has_next) break;
#pragma unroll
        for (int a = 0; a < 2; ++a)
#pragma unroll
            for (int b = 0; b < 2; ++b)
#pragma unroll
                for (int m = 0; m < 4; ++m)
#pragma unroll
                    for (int n = 0; n < 2; ++n) acc[a][b][m][n] = (f32x4){0.f, 0.f, 0.f, 0.f};
        cur = nxt; nxt = nx2; has_next = has_nx2; cA = nA; cB = nB; ++ui; bcur = bnext;
        if constexpr (ALIGN_EPI) { if (wr == 1) PG8_BAR; }
    }
    PG8_WAIT_V(0);
    if constexpr (!ALIGN_EPI) { if (wr == 0) PG8_BAR; }
    PG8_BAR;
#undef PG8_SA
#undef PG8_SB
#undef PG8_STAGE_A
#undef PG8_STAGE_B
#undef PG8_LDA
#undef PG8_LDB
#undef PG8_MMA
#undef PG8_WAIT_V
#undef PG8_WAIT_L
#undef PG8_BAR
#undef PG8_SCHED
#undef PG8_OFFS
#undef PG8_FILL
}
}

template <bool F8> struct ProbScaleT {
    static constexpr bool FP8 = F8, PERM = true, GATHER = F8, ETAB = true;
    static constexpr int RB = F8 ? 1024 : 2048;
    __device__ __forceinline__ const char* a_tile(const pg8::Unit& u) const { return F8 ? u.A : u.A + (size_t)u.pm * (256 * RB); }
    LAS unsigned* gtab;
    const void* A; const void* Bt; int nM, nN, G, c;
    bf16_t* O; int ldo; const float* rstd; const float* ssp;
    __device__ __forceinline__ bool next(int i, pg8::Unit& u) const {
        int pm, pn; if (!pg8::static_next(i, G, c, nM, nN, pm, pn)) return false;
        u.A = (const char*)A; u.B = (const char*)Bt + (size_t)pn * 256 * RB; u.pm = pm; u.pn = pn; u.e = 0; u.nvalid = 256; u.y0 = 0; u.aux = 0; return true; }
    __device__ __forceinline__ unsigned a_off(const pg8::Unit& u, int r) const { return (unsigned)(u.pm * 256 + r) * (unsigned)RB; }
    __device__ __forceinline__ float e_val(const pg8::Unit& u, int r) const {
        const int row = u.pm * 256 + r; float sc;
        if (rstd) sc = rstd[row];
        else { const f32x4* p = (const f32x4*)(ssp + (size_t)row * 16); const f32x4 a = p[0], b = p[1], c2 = p[2], d = p[3];
            const float sq = (((a[0] + a[1]) + (a[2] + a[3])) + ((b[0] + b[1]) + (b[2] + b[3]))) + (((c2[0] + c2[1]) + (c2[2] + c2[3])) + ((d[0] + d[1]) + (d[2] + d[3])));
            sc = rsqrtf(sq * (1.0f / 1024.0f) + EPS); }
        return sc * (F8 ? (1.0f / 64.0f) : 1.0f); }
    __device__ __forceinline__ void epi(const f32x4 (&acc)[2][2][4][2], const pg8::Unit& u, int wr, int wc, int fr, int fq) const {
        asm volatile("" : "+v"(fr), "+v"(fq));
        const int rowu = u.pm * 256 + wr * 64;
        char* ub = (char*)O + ((size_t)rowu * ldo + u.pn * 256 + wc * 32) * 2;
        const unsigned lo = (unsigned)(fr * ldo + 8 * fq) * 2u;
        const LAS float* et = (const LAS float*)gtab + 768 + u.aux * 256 + wr * 64 + fr;
        float rsv[8];
#pragma unroll
        for (int q = 0; q < 8; ++q) rsv[q] = et[(q >> 2) * 128 + (q & 3) * 16];
#pragma unroll
        for (int ai = 0; ai < 2; ++ai)
#pragma unroll
            for (int m = 0; m < 4; ++m) { const float rs = rsv[ai * 4 + m];
                char* rowp = ub + (size_t)(ai * 128 + m * 16) * ldo * 2 + lo;
#pragma unroll
                for (int bj = 0; bj < 2; ++bj) { const f32x4 v0 = acc[ai][bj][m][0] * rs, v1 = acc[ai][bj][m][1] * rs;
                    u32x4 w; w.x = cvt_pk_bf16(v0[0], v0[1]); w.y = cvt_pk_bf16(v0[2], v0[3]); w.z = cvt_pk_bf16(v1[0], v1[1]); w.w = cvt_pk_bf16(v1[2], v1[3]);
                    *(u32x4*)(rowp + bj * 256) = w; } }
    }
};
typedef ProbScaleT<false> ProbScaleBf16;
struct ProbColScaleBf16 {
    static constexpr bool FP8 = false, PERM = true, GATHER = false, ETAB = true;
    __device__ __forceinline__ const char* a_tile(const pg8::Unit& u) const { return u.A + (size_t)u.pm * (256 * 2048); }
    LAS unsigned* gtab;
    const bf16_t* A; const bf16_t* Bt; int nM, nN, G, c;
    bf16_t* O; int ldo; const float* cs;
    __device__ __forceinline__ bool next(int i, pg8::Unit& u) const {
        const long L = (long)i * G + c; if (L >= (long)nM * nN) return false;
        const int pm = (int)(L % nM), pn = (int)(L / nM);
        u.A = (const char*)A; u.B = (const char*)(Bt + (size_t)pn * 256 * 1024); u.pm = pm; u.pn = pn; u.e = 0; u.nvalid = 256; u.y0 = 0; u.aux = 0; return true; }
    __device__ __forceinline__ unsigned a_off(const pg8::Unit& u, int r) const { return 0u; }
    __device__ __forceinline__ float e_val(const pg8::Unit& u, int r) const { return cs[u.pn * 256 + r]; }
    __device__ __forceinline__ void epi(const f32x4 (&acc)[2][2][4][2], const pg8::Unit& u, int wr, int wc, int fr, int fq) const {
        asm volatile("" : "+v"(fr), "+v"(fq));
        const LAS float* cp = (const LAS float*)gtab + 768 + u.aux * 256 + wc * 32 + 8 * fq;
        f32x4 sc[2][2];
#pragma unroll
        for (int bj = 0; bj < 2; ++bj)
#pragma unroll
            for (int n = 0; n < 2; ++n) sc[bj][n] = *(const LAS f32x4*)(cp + bj * 128 + 4 * n);
        char* ub = (char*)O + ((size_t)(u.pm * 256 + wr * 64) * ldo + u.pn * 256 + wc * 32) * 2;
        const unsigned lo = (unsigned)(fr * ldo + 8 * fq) * 2u;
#pragma unroll
        for (int ai = 0; ai < 2; ++ai)
#pragma unroll
            for (int m = 0; m < 4; ++m) { char* rowp = ub + (size_t)(ai * 128 + m * 16) * ldo * 2 + lo;
#pragma unroll
                for (int bj = 0; bj < 2; ++bj) { const f32x4 v0 = acc[ai][bj][m][0] * sc[bj][0], v1 = acc[ai][bj][m][1] * sc[bj][1];
                    u32x4 w; w.x = cvt_pk_bf16(v0[0], v0[1]); w.y = cvt_pk_bf16(v0[2], v0[3]); w.z = cvt_pk_bf16(v1[0], v1[1]); w.w = cvt_pk_bf16(v1[2], v1[3]);
                    *(u32x4*)(rowp + bj * 256) = w; } }
    }
};
struct ProbKV {
    static constexpr bool FP8 = true, PERM = true, GATHER = true, ETAB = false;
    __device__ __forceinline__ const char* a_tile(const pg8::Unit& u) const { return u.A; }
    LAS unsigned* gtab;
    const unsigned char* memb; const unsigned char* wckv; bf16_t* Kout; bf16_t* VTout; const float* rstdm; int G, c;
    __device__ __forceinline__ bool next(int i, pg8::Unit& u) const {
        const long L = (long)i * G + c; if (L >= 256) return false;
        if (L < 128) { u.pm = (int)(L & 31); u.pn = (int)(L >> 5); u.e = 0; u.A = (const char*)memb; u.B = (const char*)(wckv + (size_t)u.pn * 256 * 1024); }
        else { const int l2 = (int)L - 128; u.pm = l2 & 3; u.pn = l2 >> 2; u.e = 1; u.A = (const char*)(wckv + (size_t)1024 * 1024); u.B = (const char*)(memb + (size_t)u.pn * 256 * 1024); }
        u.nvalid = 256; u.y0 = 0; u.aux = 0; return true; }
    __device__ __forceinline__ unsigned a_off(const pg8::Unit& u, int r) const { return (unsigned)(u.pm * 256 + r) * 1024u; }
    __device__ __forceinline__ void epi(const f32x4 (&acc)[2][2][4][2], const pg8::Unit& u, int wr, int wc, int fr, int fq) const {
        asm volatile("" : "+v"(fr), "+v"(fq));
        const int ldo = u.e ? MROWS : 1024;
        char* ub = (char*)(u.e ? VTout : Kout) + ((size_t)(u.pm * 256 + wr * 64) * ldo + u.pn * 256 + wc * 32) * 2;
        const unsigned lo = (unsigned)(fr * ldo + 8 * fq) * 2u;
        float rsv[8]; f32x4 sc[2][2];
        if (u.e == 0) {
#pragma unroll
            for (int q = 0; q < 8; ++q) rsv[q] = rstdm[u.pm * 256 + wr * 64 + fr + (q >> 2) * 128 + (q & 3) * 16] * (1.0f / 64.0f);
#pragma unroll
            for (int bj = 0; bj < 2; ++bj)
#pragma unroll
                for (int n = 0; n < 2; ++n) sc[bj][n] = (f32x4){1.f, 1.f, 1.f, 1.f};
        } else {
#pragma unroll
            for (int q = 0; q < 8; ++q) rsv[q] = 1.0f / 64.0f;
            const float* cp = rstdm + u.pn * 256 + wc * 32 + 8 * fq;
#pragma unroll
            for (int bj = 0; bj < 2; ++bj)
#pragma unroll
                for (int n = 0; n < 2; ++n) sc[bj][n] = *(const f32x4*)(cp + bj * 128 + 4 * n); }
#pragma unroll
        for (int ai = 0; ai < 2; ++ai)
#pragma unroll
            for (int m = 0; m < 4; ++m) { const float rs = rsv[ai * 4 + m]; char* rowp = ub + (size_t)(ai * 128 + m * 16) * ldo * 2 + lo;
#pragma unroll
                for (int bj = 0; bj < 2; ++bj) { const f32x4 v0 = acc[ai][bj][m][0] * sc[bj][0] * rs, v1 = acc[ai][bj][m][1] * sc[bj][1] * rs;
                    u32x4 w; w.x = cvt_pk_bf16(v0[0], v0[1]); w.y = cvt_pk_bf16(v0[2], v0[3]); w.z = cvt_pk_bf16(v1[0], v1[1]); w.w = cvt_pk_bf16(v1[2], v1[3]);
                    *(u32x4*)(rowp + bj * 256) = w; } }
    }
};
template <bool F8, bool WF8, bool RF32> struct ProbResidT {
    static constexpr bool FP8 = F8, PERM = true, GATHER = F8, ETAB = false;
    static constexpr int RB = F8 ? 1024 : 2048;
    __device__ __forceinline__ const char* a_tile(const pg8::Unit& u) const { return F8 ? u.A : u.A + (size_t)u.pm * (256 * RB); }
    LAS unsigned* gtab;
    const void* A; const void* Bt; int nM, nN, G, c;
    const float* rf; const bf16_t* rb; bf16_t* ob; unsigned char* of8; float* ssp;
    __device__ __forceinline__ bool next(int i, pg8::Unit& u) const {
        int pm, pn; if (!pg8::static_next(i, G, c, nM, nN, pm, pn)) return false;
        u.A = (const char*)A; u.B = (const char*)Bt + (size_t)pn * 256 * RB; u.pm = pm; u.pn = pn; u.e = 0; u.nvalid = 256; u.y0 = 0; u.aux = 0; return true; }
    __device__ __forceinline__ unsigned a_off(const pg8::Unit& u, int r) const { return (unsigned)(u.pm * 256 + r) * (unsigned)RB; }
    __device__ __forceinline__ void epi(const f32x4 (&acc)[2][2][4][2], const pg8::Unit& u, int wr, int wc, int fr, int fq) const {
        asm volatile("" : "+v"(fr), "+v"(fq));
        const int rowu = u.pm * 256 + wr * 64;
        const size_t uoff = (size_t)rowu * 1024 + u.pn * 256 + wc * 32;
        const unsigned lo = (unsigned)(fr * 1024 + 8 * fq);
        const float sc = F8 ? (1.0f / 64.0f) : 1.0f;
#pragma unroll
        for (int ai = 0; ai < 2; ++ai) {
            f32x4 rv[4][2][2];
#pragma unroll
            for (int m = 0; m < 4; ++m) { const size_t ro = uoff + (size_t)(ai * 128 + m * 16) * 1024;
#pragma unroll
                for (int bj = 0; bj < 2; ++bj) {
                    if constexpr (RF32) { rv[m][bj][0] = *(const GAS f32x4*)(rf + ro + lo + bj * 128); rv[m][bj][1] = *(const GAS f32x4*)(rf + ro + lo + bj * 128 + 4); }
                    else { const u32x4 w = *(const GAS u32x4*)(rb + ro + lo + bj * 128); rv[m][bj][0] = (f32x4){lo_bf(w.x), hi_bf(w.x), lo_bf(w.y), hi_bf(w.y)}; rv[m][bj][1] = (f32x4){lo_bf(w.z), hi_bf(w.z), lo_bf(w.w), hi_bf(w.w)}; } } }
#pragma unroll
            for (int m = 0; m < 4; ++m) { const size_t ro = uoff + (size_t)(ai * 128 + m * 16) * 1024; float ss = 0.f;
                unsigned pk[2][2];
#pragma unroll
                for (int bj = 0; bj < 2; ++bj) { const f32x4 v0 = acc[ai][bj][m][0] * sc + rv[m][bj][0], v1 = acc[ai][bj][m][1] * sc + rv[m][bj][1];
                    ss += (v0[0] * v0[0] + v0[1] * v0[1]) + (v0[2] * v0[2] + v0[3] * v0[3]) + (v1[0] * v1[0] + v1[1] * v1[1]) + (v1[2] * v1[2] + v1[3] * v1[3]);
                    u32x4 w; w.x = cvt_pk_bf16(v0[0], v0[1]); w.y = cvt_pk_bf16(v0[2], v0[3]); w.z = cvt_pk_bf16(v1[0], v1[1]); w.w = cvt_pk_bf16(v1[2], v1[3]);
                    *(u32x4*)(ob + ro + lo + bj * 128) = w;
                    if constexpr (WF8) { unsigned w0 = 0u, w1 = 0u;
                        w0 = __builtin_amdgcn_cvt_pk_fp8_f32(c8(v0[0]), c8(v0[1]), w0, false); w0 = __builtin_amdgcn_cvt_pk_fp8_f32(c8(v0[2]), c8(v0[3]), w0, true);
                        w1 = __builtin_amdgcn_cvt_pk_fp8_f32(c8(v1[0]), c8(v1[1]), w1, false); w1 = __builtin_amdgcn_cvt_pk_fp8_f32(c8(v1[2]), c8(v1[3]), w1, true);
                        pk[bj][0] = w0; pk[bj][1] = w1; } }
                if constexpr (WF8) {
                    const auto s0 = __builtin_amdgcn_permlane16_swap(pk[0][0], pk[1][0], false, false), s1 = __builtin_amdgcn_permlane16_swap(pk[0][1], pk[1][1], false, false);
                    *(u32x4*)(of8 + ro + lo + ((fq & 1) ? 120u : 0u)) = (u32x4){s0[0], s1[0], s0[1], s1[1]}; }
                ss = x16_sum(ss); ss = x32_sum(ss);
                if (fq == 0) ssp[(size_t)(rowu + ai * 128 + m * 16 + fr) * 16 + u.pn * 4 + wc] = ss; } }
    }
};
__device__ __forceinline__ size_t hid_tile_off(int rt) { return rt < 1024 ? (size_t)rt * (256 * 1024) : (WS_HID1 - WS_HID) + (size_t)(rt - 1024) * (256 * 1024); }
constexpr int MOE_TS = 0, MOE_ST = 33, MOE_CNT = 66, MOE_RTE = 100, MOE_WORDS = 100 + 264;
struct ProbMoe1 {
    static constexpr bool FP8 = true, PERM = true, GATHER = true, ETAB = true;
    __device__ __forceinline__ const char* a_tile(const pg8::Unit& u) const { return u.A; }
    const unsigned char* hb; const unsigned char* w1b; const float* b1p; const float* rstd2; const unsigned* list; unsigned char* hid;
    const volatile LAS int* tab; LAS unsigned* gtab; int rt0, nrt, G, c;
    __device__ __forceinline__ bool next(int i, pg8::Unit& u) const {
        const long L = (long)i * G + c; if (L >= (long)nrt * 8) return false;
        const int gidx = (int)(L >> 8), within = (int)(L & 255), gsz = (nrt - gidx * 32) < 32 ? (nrt - gidx * 32) : 32;
        const int rtl = gidx * 32 + within % gsz, pn = within / gsz, rt = rt0 + rtl;
        const int e = ((const volatile LAS unsigned char*)(tab + MOE_RTE))[rt];
        const int idx0 = (rt - tab[MOE_TS + e]) * 256;
        u.A = (const char*)hb; u.B = (const char*)(w1b + ((size_t)e * 2048 + (size_t)pn * 256) * 1024); u.pm = rt; u.pn = pn; u.e = e; u.nvalid = tab[MOE_CNT + e] - idx0; u.y0 = idx0; u.aux = 0; return true; }
    __device__ __forceinline__ unsigned tok_of(const pg8::Unit& u, int r) const { const int rr = r < u.nvalid ? r : 0; return list[(size_t)u.e * T + u.y0 + rr]; }
    __device__ __forceinline__ unsigned a_off(const pg8::Unit& u, int r) const { return tok_of(u, r) * 1024u; }
    __device__ __forceinline__ float e_val(const pg8::Unit& u, int r) const { return b1p[(size_t)u.e * 2048 + u.pn * 256 + r]; }
    __device__ __forceinline__ void epi(const f32x4 (&acc)[2][2][4][2], const pg8::Unit& u, int wr, int wc, int fr, int fq) const {
        asm volatile("" : "+v"(fr), "+v"(fq));
        const LAS float* bp = (const LAS float*)gtab + 768 + u.aux * 256 + wc * 32 + 8 * fq;
        const f32x4 bg0 = *(const LAS f32x4*)(bp), bg1 = *(const LAS f32x4*)(bp + 4), bl0 = *(const LAS f32x4*)(bp + 128), bl1 = *(const LAS f32x4*)(bp + 132);
        char* ub = (char*)hid + hid_tile_off(u.pm) + ((size_t)(wr * 64) * 1024 + u.pn * 128 + wc * 32);
        const unsigned lo = (unsigned)(fr * 1024 + 8 * fq);
        unsigned wk[2][2];
#pragma unroll
        for (int ai = 0; ai < 2; ++ai)
#pragma unroll
            for (int m = 0; m < 4; ++m) { const float rs = 1.0f / 64.0f;
                unsigned w[2];
#pragma unroll
                for (int n = 0; n < 2; ++n) { const f32x4 g4 = acc[ai][0][m][n] * rs + (n ? bg1 : bg0), l4 = acc[ai][1][m][n] * rs + (n ? bl1 : bl0);
                    unsigned wv = 0u;
#pragma unroll
                    for (int jp = 0; jp < 2; ++jp) {
                        f32x2 g2 = {fminf(g4[2 * jp], 7.0f), fminf(g4[2 * jp + 1], 7.0f)};
                        const f32x2 l2 = {__builtin_amdgcn_fmed3f(l4[2 * jp], -7.0f, 7.0f), __builtin_amdgcn_fmed3f(l4[2 * jp + 1], -7.0f, 7.0f)};
                        const f32x2 z2 = g2 * (-1.702f * 1.4426950408889634f);
                        const f32x2 d2 = (f32x2){__builtin_amdgcn_exp2f(z2[0]), __builtin_amdgcn_exp2f(z2[1])} + 1.0f;
                        const f32x2 r2 = {__builtin_amdgcn_rcpf(d2[0]), __builtin_amdgcn_rcpf(d2[1])};
                        const f32x2 o2 = (g2 * r2) * (l2 * 4.0f + 4.0f);
                        if (jp) wv = __builtin_amdgcn_cvt_pk_fp8_f32(o2[0], o2[1], wv, true); else wv = __builtin_amdgcn_cvt_pk_fp8_f32(o2[0], o2[1], wv, false); }
                    w[n] = wv; }
                wk[m & 1][0] = w[0]; wk[m & 1][1] = w[1];
                if (m & 1) {
                    const auto s0 = __builtin_amdgcn_permlane16_swap(wk[0][0], wk[1][0], false, false), s1 = __builtin_amdgcn_permlane16_swap(wk[0][1], wk[1][1], false, false);
                    *(u32x4*)(ub + (size_t)(ai * 128 + (m - 1) * 16) * 1024 + lo + ((fq & 1) ? 16u * 1024u - 8u : 0u)) = (u32x4){s0[0], s1[0], s0[1], s1[1]}; } }
    }
};
struct ProbMoe2 {
    static constexpr bool FP8 = true, PERM = true, GATHER = true, ETAB = true;
    __device__ __forceinline__ const char* a_tile(const pg8::Unit& u) const { return u.A; }
    const unsigned char* hid; const unsigned char* w2b; const float* b2; unsigned char* y;
    const volatile LAS int* tab; LAS unsigned* gtab; int rt0, nrt, G, c;
    __device__ __forceinline__ bool next(int i, pg8::Unit& u) const {
        const long L = (long)i * G + c; if (L >= (long)nrt * 4) return false;
        const int gidx = (int)(L >> 8), within = (int)(L & 255), gsz = (nrt - gidx * 64) < 64 ? (nrt - gidx * 64) : 64;
        const int rtl = gidx * 64 + within % gsz, pn = within / gsz, rt = rt0 + rtl;
        const int e = ((const volatile LAS unsigned char*)(tab + MOE_RTE))[rt];
        const int idx0 = (rt - tab[MOE_TS + e]) * 256;
        u.A = (const char*)hid; u.B = (const char*)(w2b + ((size_t)e * 1024 + (size_t)pn * 256) * 1024); u.pm = rt; u.pn = pn; u.e = e; u.nvalid = tab[MOE_CNT + e] - idx0; u.y0 = tab[MOE_ST + e] + idx0; u.aux = 0; return true; }
    __device__ __forceinline__ unsigned a_off(const pg8::Unit& u, int r) const { return (unsigned)(hid_tile_off(u.pm) + (size_t)r * 1024u); }
    __device__ __forceinline__ float e_val(const pg8::Unit& u, int r) const { return 16.0f * b2[(size_t)u.e * 1024 + u.pn * 256 + r]; }
    __device__ __forceinline__ void epi(const f32x4 (&acc)[2][2][4][2], const pg8::Unit& u, int wr, int wc, int fr, int fq) const {
        asm volatile("" : "+v"(fr), "+v"(fq));
        const LAS float* bp = (const LAS float*)gtab + 768 + u.aux * 256 + wc * 32 + 8 * fq;
        f32x4 bv[2][2];
#pragma unroll
        for (int bj = 0; bj < 2; ++bj)
#pragma unroll
            for (int n = 0; n < 2; ++n) bv[bj][n] = *(const LAS f32x4*)(bp + bj * 128 + 4 * n);
        char* ub = (char*)y + (((size_t)u.y0 + wr * 64) * 1024 + u.pn * 256 + wc * 32);
        const unsigned lo2 = (unsigned)(fr * 1024 + 8 * fq) + ((fq & 1) ? 120u : 0u);
        const int r0 = wr * 64 + fr;
#pragma unroll
        for (int ai = 0; ai < 2; ++ai)
#pragma unroll
            for (int m = 0; m < 4; ++m) { const int r = r0 + ai * 128 + m * 16;
                unsigned pk[2][2];
#pragma unroll
                for (int bj = 0; bj < 2; ++bj) { const f32x4 v0 = acc[ai][bj][m][0] * (1.0f / 16.0f) + bv[bj][0], v1 = acc[ai][bj][m][1] * (1.0f / 16.0f) + bv[bj][1];
                    unsigned w0 = 0u, w1 = 0u;
                    w0 = __builtin_amdgcn_cvt_pk_fp8_f32(c8(v0[0]), c8(v0[1]), w0, false); w0 = __builtin_amdgcn_cvt_pk_fp8_f32(c8(v0[2]), c8(v0[3]), w0, true);
                    w1 = __builtin_amdgcn_cvt_pk_fp8_f32(c8(v1[0]), c8(v1[1]), w1, false); w1 = __builtin_amdgcn_cvt_pk_fp8_f32(c8(v1[2]), c8(v1[3]), w1, true);
                    pk[bj][0] = w0; pk[bj][1] = w1; }
                const auto s0 = __builtin_amdgcn_permlane16_swap(pk[0][0], pk[1][0], false, false), s1 = __builtin_amdgcn_permlane16_swap(pk[0][1], pk[1][1], false, false);
                if (r < u.nvalid) *(u32x4*)(ub + (size_t)(ai * 128 + m * 16) * 1024 + lo2) = (u32x4){s0[0], s1[0], s0[1], s1[1]}; }
    }
};

#define XB_TMO      128
#define XB_XCNT(j)  (256  + 64 * (j))
#define XB_XSUB(j)  (1280 + 64 * (j))
#define XB_XGEN(j)  (2304 + 64 * (j))
#define XB_TOP      3328
#define XB_TOPGEN   3392
#define XCD_BAR_WORDS 3456
#define XB_SPIN_CAP (1u << 18)
__device__ __forceinline__ unsigned xb_ld(unsigned* p)              { return __hip_atomic_load(p, __ATOMIC_RELAXED, __HIP_MEMORY_SCOPE_AGENT); }
__device__ __forceinline__ unsigned xb_add(unsigned* p, unsigned v) { return __hip_atomic_fetch_add(p, v, __ATOMIC_RELAXED, __HIP_MEMORY_SCOPE_AGENT); }
__device__ __forceinline__ unsigned xb_xcc_id() { return (unsigned)__builtin_amdgcn_s_getreg((3 << 11) | 20) & 0xFu; }
#define XB_SPIN(cond, bar) do { unsigned _sp = 0; while (cond) { __builtin_amdgcn_s_sleep(1); \
    if ((++_sp & 255u) == 0u) { if (xb_ld(&(bar)[XB_TMO])) break; if (_sp > XB_SPIN_CAP) { atomicAdd(&(bar)[XB_TMO], 1u); break; } } } } while (0)
struct XcdBarrier { unsigned* bar; unsigned x; volatile LAS unsigned* st; int wave; };
__device__ __forceinline__ XcdBarrier xcd_barrier_post(unsigned* bar, volatile LAS unsigned* st, int wave) {
    XcdBarrier b; b.bar = bar; b.x = xb_xcc_id(); b.st = st; b.wave = wave;
    if (wave == 0 && lane_id() == 0) (void)xb_add(&bar[XB_XCNT(b.x)], 1u);
    return b;
}
__device__ __forceinline__ void xcd_barrier_complete(unsigned* bar, unsigned x, unsigned& nloc, unsigned& nx) {
    const unsigned G = gridDim.x * gridDim.y * gridDim.z;
    unsigned sum, cnt, mine, sp = 0u;
    for (;;) {
        sum = 0u; cnt = 0u; mine = 0u;
#pragma unroll
        for (unsigned j = 0; j < 16; ++j) { const unsigned c = xb_ld(&bar[XB_XCNT(j)]); sum += c; cnt += (c > 0u) ? 1u : 0u; mine = (j == x) ? c : mine; }
        if (sum == G) break;
        __builtin_amdgcn_s_sleep(1);
        if ((++sp & 255u) == 0u) { if (xb_ld(&bar[XB_TMO])) break; if (sp > XB_SPIN_CAP) { atomicAdd(&bar[XB_TMO], 1u); break; } }
    }
    nloc = mine > 0u ? mine : 1u; nx = cnt > 0u ? cnt : 1u;
}
__device__ __forceinline__ void xcd_barrier(const XcdBarrier& b) {
    asm volatile("s_waitcnt vmcnt(0)" ::: "memory");
    __syncthreads();
    if (b.wave == 0 && lane_id() == 0) {
        unsigned* bar = b.bar;
        __builtin_amdgcn_s_waitcnt(0);
        unsigned nloc = b.st[0], nx = b.st[1];
        if (nloc == 0u) { xcd_barrier_complete(bar, b.x, nloc, nx); b.st[0] = nloc; b.st[1] = nx; }
        const unsigned old = xb_add(&bar[XB_XSUB(b.x)], 1u);
        const unsigned gen = old / nloc;
        if (old + 1u == (gen + 1u) * nloc) {
            __builtin_amdgcn_fence(__ATOMIC_RELEASE, "agent");
            asm volatile("s_waitcnt vmcnt(0)" ::: "memory");
            const unsigned og = xb_add(&bar[XB_TOP], 1u);
            const unsigned tg = og / nx;
            if (og + 1u == (tg + 1u) * nx) xb_add(&bar[XB_TOPGEN], 1u);
            else XB_SPIN(xb_ld(&bar[XB_TOPGEN]) == tg, bar);
            __builtin_amdgcn_fence(__ATOMIC_ACQUIRE, "agent");
            xb_add(&bar[XB_XGEN(b.x)], 1u);
            asm volatile("s_waitcnt vmcnt(0)" ::: "memory");
        } else {
            XB_SPIN(xb_ld(&bar[XB_XGEN(b.x)]) == gen, bar);
            __builtin_amdgcn_fence(__ATOMIC_ACQUIRE, "agent");
            asm volatile("s_waitcnt vmcnt(0)" ::: "memory");
        }
    }
    __syncthreads();
}

typedef float f32x16 __attribute__((ext_vector_type(16)));
__device__ __forceinline__ int pi32(int i) { return (i & ~12) | ((i & 4) << 1) | ((i & 8) >> 1); }
__device__ __forceinline__ f32x16 zero16() { f32x16 z;
#pragma unroll
    for (int r = 0; r < 16; ++r) z[r] = 0.f;
    return z; }

__device__ __forceinline__ void xattn_phase(LAS unsigned char* lds, const bf16_t* Q, const bf16_t* Kb, const bf16_t* VT, unsigned char* O, int G, int bx, int wave) {
    const int lane = lane_id(), i = lane & 31, hh = lane >> 5;
    LAS unsigned char* ring = lds;
    bf16x8 qf[16];
#define XA_QLOAD(uid_) do { const int u_ = (uid_); const bf16_t* qp_ = Q + (size_t)((u_ >> 5) * SEQ + (u_ & 7) * 256 + wave * 32 + i) * 1024 + ((u_ >> 3) & 3) * 256 + 8 * hh; \
        _Pragma("unroll") for (int ds = 0; ds < 16; ++ds) qf[ds] = *(const bf16x8*)(qp_ + 16 * ds); } while (0)
    if (bx < BATCH * 4 * 8) XA_QLOAD(bx);
    for (int uid = bx; uid < BATCH * 4 * 8; uid += G) {
        const int b = uid >> 5, h = (uid >> 3) & 3, qblk = uid & 7;
        const int q0 = qblk * 256 + wave * 32;
        const bf16_t* ksrc = Kb + (size_t)(b * MEMLEN + pi32(i)) * 1024 + h * 256 + 16 * wave + 8 * hh;
        const bf16_t* vsrc = VT + (size_t)(h * 256 + i) * MROWS + b * MEMLEN + 32 * (wave >> 1) + 16 * (wave & 1) + 8 * hh;
#define XA_ISSUE(st_) do { LAS unsigned char* sl_ = ring + ((st_) & 3) * 16384; \
        if ((st_) < 8) { const bf16_t* g_ = ksrc + (size_t)(st_) * 32 * 1024; \
            __builtin_amdgcn_global_load_lds((const unsigned*)g_, (LAS unsigned*)(sl_ + wave * 1024), 16, 0, 0); \
            __builtin_amdgcn_global_load_lds((const unsigned*)(g_ + 128), (LAS unsigned*)(sl_ + (8 + wave) * 1024), 16, 0, 0); } \
        else { const bf16_t* g_ = vsrc + (size_t)((st_) - 8) * 32 * MROWS; \
            __builtin_amdgcn_global_load_lds((const unsigned*)g_, (LAS unsigned*)(sl_ + wave * 1024), 16, 0, 0); \
            __builtin_amdgcn_global_load_lds((const unsigned*)(g_ + 128), (LAS unsigned*)(sl_ + (8 + wave) * 1024), 16, 0, 0); } } while (0)
#define XA_VMCNT(n) (((n) & 15) | (7 << 4) | (15 << 8) | (((n) >> 4) << 14))
#define XA_SYNC(st_) do { const int n_ = ((st_) >= 11 ? 1 : 0) + ((st_) <= 14 ? 2 : 0) + ((st_) >= 10 ? 1 : 0) + ((st_) <= 13 ? 2 : 0) + ((st_) >= 9 ? 1 : 0) + (((st_) >= 8 && (st_) <= 10) ? 16 : 0); \
          \
        asm volatile("" ::: "memory"); \
        if (n_ == 3) __builtin_amdgcn_s_waitcnt(XA_VMCNT(3)); else if (n_ == 4) __builtin_amdgcn_s_waitcnt(XA_VMCNT(4)); else if (n_ == 5) __builtin_amdgcn_s_waitcnt(XA_VMCNT(5)); \
        else if (n_ == 20) __builtin_amdgcn_s_waitcnt(XA_VMCNT(20)); else if (n_ == 21) __builtin_amdgcn_s_waitcnt(XA_VMCNT(21)); else if (n_ == 22) __builtin_amdgcn_s_waitcnt(XA_VMCNT(22)); \
        else __builtin_amdgcn_s_waitcnt(XA_VMCNT(7)); \
        asm volatile("" ::: "memory"); \
        __builtin_amdgcn_s_barrier(); asm volatile("" ::: "memory"); if ((st_) + 3 < 16) XA_ISSUE((st_) + 3); } while (0)
        XA_ISSUE(0); XA_ISSUE(1); XA_ISSUE(2);
        f32x16 s[8];
#pragma unroll
        for (int kt = 0; kt < 8; ++kt) { XA_SYNC(kt);
            const LAS unsigned char* sl = ring + (kt & 3) * 16384 + lane * 16;
            f32x16 acc = zero16();
#pragma unroll
            for (int q4 = 0; q4 < 4; ++q4) { __builtin_amdgcn_sched_barrier(0);
#pragma unroll
                for (int d4 = 0; d4 < 4; ++d4) { const int ds = q4 * 4 + d4; acc = __builtin_amdgcn_mfma_f32_32x32x16_bf16(*(const LAS bf16x8*)(sl + ds * 1024), qf[ds], acc, 0, 0, 0); } }
            s[kt] = acc; }
        float m = -INFINITY;
#pragma unroll
        for (int kt = 0; kt < 8; ++kt)
#pragma unroll
            for (int r = 0; r < 16; ++r) m = fmaxf(m, s[kt][r]);
        m = x32_max(m);
        const float c = 0.0625f * 1.4426950408889634f; float l = 0.f; const float mc = m * c;
        u32x4 pf[8][2];
#pragma unroll
        for (int kt = 0; kt < 8; ++kt) {
#pragma unroll
            for (int r = 0; r < 16; ++r) { const float p = __builtin_amdgcn_exp2f(s[kt][r] * c - mc); s[kt][r] = p; l += p; }
#pragma unroll
            for (int sb = 0; sb < 2; ++sb) { pf[kt][sb].x = cvt_pk_bf16(s[kt][8 * sb + 0], s[kt][8 * sb + 1]); pf[kt][sb].y = cvt_pk_bf16(s[kt][8 * sb + 2], s[kt][8 * sb + 3]);
                pf[kt][sb].z = cvt_pk_bf16(s[kt][8 * sb + 4], s[kt][8 * sb + 5]); pf[kt][sb].w = cvt_pk_bf16(s[kt][8 * sb + 6], s[kt][8 * sb + 7]); } }
        l = x32_sum(l);
        const float il = 1.0f / l;
        XA_QLOAD(uid + G < BATCH * 4 * 8 ? uid + G : uid);
        unsigned char* op = O + (size_t)(b * SEQ + q0 + i) * 1024 + h * 256 + 16 * hh;
#pragma unroll
        for (int dvt = 0; dvt < 8; ++dvt) { XA_SYNC(8 + dvt);
            const LAS unsigned char* sl = ring + (dvt & 3) * 16384 + lane * 16;
            f32x16 oacc = zero16();
#pragma unroll
            for (int q4 = 0; q4 < 4; ++q4) { __builtin_amdgcn_sched_barrier(0);
#pragma unroll
                for (int f4 = 0; f4 < 4; ++f4) { const int f = q4 * 4 + f4; oacc = __builtin_amdgcn_mfma_f32_32x32x16_bf16(*(const LAS bf16x8*)(sl + f * 1024), __builtin_bit_cast(bf16x8, pf[f >> 1][f & 1]), oacc, 0, 0, 0); } }
            unsigned wg[4];
#pragma unroll
            for (int g = 0; g < 4; ++g) { unsigned w = 0u; w = __builtin_amdgcn_cvt_pk_fp8_f32(c8(oacc[4 * g] * il), c8(oacc[4 * g + 1] * il), w, false); w = __builtin_amdgcn_cvt_pk_fp8_f32(c8(oacc[4 * g + 2] * il), c8(oacc[4 * g + 3] * il), w, true); wg[g] = w; }
            { const auto s02 = __builtin_amdgcn_permlane32_swap(wg[0], wg[2], false, false), s13 = __builtin_amdgcn_permlane32_swap(wg[1], wg[3], false, false);
              *(u32x4*)(op + dvt * 32) = (u32x4){s02[0], s02[1], s13[0], s13[1]}; } }
#undef XA_ISSUE
#undef XA_SYNC
    }
}

__device__ __forceinline__ void diffattn_phase(LAS unsigned char* lds, LAS float* dgl, const bf16_t* P2, const bf16_t* VT, const float* dng, const float lam, bf16_t* cat, int G, int vx, int wave) {
    const int lane = lane_id(), i_ = lane & 31, hh_ = lane >> 5;
    dgl[wave * 64 + lane] = dng[wave * 64 + lane];
    __syncthreads();
    LAS unsigned char* ring = lds;
    LAS unsigned char* ql = lds + 65536 + wave * 8192 + lane * 16;
    const float c = 0.125f * 1.4426950408889634f;
    for (int pu = vx; pu < BATCH * 4 * 4; pu += G)
        for (int side = 0; side < 2; ++side) {
            const int bh = pu >> 2, x = pu & 3, qb = side ? 7 - x : x, b = bh >> 2, h = bh & 3, q0 = qb * 256 + wave * 32;
            const int ntile = 8 * qb + 8, ktw = 8 * qb + wave;
            int i = i_, hh = hh_; asm volatile("" : "+v"(i), "+v"(hh));
            const bf16_t* qp = P2 + (size_t)(b * SEQ + q0 + i) * NP2 + h * 128 + 8 * hh;
            { bf16x8 t[8];
#pragma unroll
              for (int f = 0; f < 8; ++f) t[f] = *(const bf16x8*)(qp + 16 * f);
#pragma unroll
              for (int f = 0; f < 8; ++f) *(LAS bf16x8*)(ql + f * 1024) = t[f]; }
            const char* kbase = (const char*)(P2 + (size_t)b * SEQ * NP2 + 512 + h * 128 + (wave >> 2) * 64 + 16 * (wave & 3));
            const char* vbase = (const char*)(VT + (size_t)(h * 128 + 32 * (wave >> 1)) * T + (size_t)b * SEQ + 16 * (wave & 1));
            const unsigned koff = (unsigned)(pi32(i) * NP2 + 8 * hh) * 2u, voff = (unsigned)(i * T + 8 * hh) * 2u;
#define DA_ISSUE(kt_) do { LAS unsigned char* sl_ = ring + ((kt_) & 3) * 16384; \
        __builtin_amdgcn_global_load_lds((const unsigned*)(kbase + (size_t)(kt_) * (32 * NP2 * 2) + koff), (LAS unsigned*)(sl_ + wave * 1024), 16, 0, 0); \
        __builtin_amdgcn_global_load_lds((const unsigned*)(vbase + (kt_) * 64 + voff), (LAS unsigned*)(sl_ + (8 + wave) * 1024), 16, 0, 0); } while (0)
            f32x16 o1[4], o2[4];
#pragma unroll
            for (int d = 0; d < 4; ++d) { o1[d] = zero16(); o2[d] = zero16(); }
            float mc1 = -INFINITY, mc2 = -INFINITY, l1 = 0.f, l2 = 0.f;
            u32x4 pp1[2], pp2[2];
#pragma unroll
            for (int sb = 0; sb < 2; ++sb) { pp1[sb] = (u32x4){0u, 0u, 0u, 0u}; pp2[sb] = pp1[sb]; }
            DA_ISSUE(0); DA_ISSUE(1);
            for (int kt = 0; kt <= ntile; ++kt) {
                if (kt < ntile) {
                    if (kt + 1 < ntile) asm volatile("s_waitcnt vmcnt(2)" ::: "memory"); else asm volatile("s_waitcnt vmcnt(0)" ::: "memory");
                    __builtin_amdgcn_s_barrier(); asm volatile("" ::: "memory");
                    if (kt + 2 < ntile) DA_ISSUE(kt + 2);
                }
                if (kt <= ktw + 1) {
                    const LAS unsigned char* sl = ring + (kt & 3) * 16384 + lane * 16;
                    const LAS unsigned char* sp = ring + ((kt == 0 ? 0 : kt - 1) & 3) * 16384 + lane * 16;
                    f32x16 s1 = zero16(), s2 = zero16();
#pragma unroll
                    for (int ds = 0; ds < 4; ++ds) { s1 = __builtin_amdgcn_mfma_f32_32x32x16_bf16(*(const LAS bf16x8*)(sl + ds * 1024), *(const LAS bf16x8*)(ql + ds * 1024), s1, 0, 0, 0);
                        s2 = __builtin_amdgcn_mfma_f32_32x32x16_bf16(*(const LAS bf16x8*)(sl + (4 + ds) * 1024), *(const LAS bf16x8*)(ql + (4 + ds) * 1024), s2, 0, 0, 0);
                        if (ds & 1) __builtin_amdgcn_sched_barrier(0); }
                    if (kt >= ktw) { const int lim = (kt == ktw) ? i : -1;
#pragma unroll
                        for (int r = 0; r < 16; ++r) { const int ko = 16 * (r >> 3) + 8 * hh + (r & 7); if (ko > lim) { s1[r] = -INFINITY; s2[r] = -INFINITY; } } }
                    float f1 = 1.f, f2 = 1.f; bool rs1, rs2;
                    { float tm = s1[0];
#pragma unroll
                      for (int r = 1; r < 16; ++r) tm = fmaxf(tm, s1[r]);
                      tm = x32_max(tm); const float tmc = tm * c; rs1 = __any(tmc > mc1 + 8.0f);
                      if (rs1) { const float mn = fmaxf(mc1, tmc); f1 = __builtin_amdgcn_exp2f(mc1 - mn); mc1 = mn; } }
                    { float tm = s2[0];
#pragma unroll
                      for (int r = 1; r < 16; ++r) tm = fmaxf(tm, s2[r]);
                      tm = x32_max(tm); const float tmc = tm * c; rs2 = __any(tmc > mc2 + 8.0f);
                      if (rs2) { const float mn = fmaxf(mc2, tmc); f2 = __builtin_amdgcn_exp2f(mc2 - mn); mc2 = mn; } }
                    float ls1 = 0.f, ls2 = 0.f; u32x4 pn1[2], pn2[2];
#define DA_SM(j) do { { const float pv_ = __builtin_amdgcn_exp2f(s1[j] * c - mc1); s1[j] = pv_; ls1 += pv_; } { const float pv_ = __builtin_amdgcn_exp2f(s2[j] * c - mc2); s2[j] = pv_; ls2 += pv_; } \
                        if ((j) & 1) { pn1[(j) >> 3][((j) & 7) >> 1] = cvt_pk_bf16(s1[(j) - 1], s1[j]); pn2[(j) >> 3][((j) & 7) >> 1] = cvt_pk_bf16(s2[(j) - 1], s2[j]); } } while (0)
                    { bf16x8 va, vb;
#define DA_VLD(p) (*(const LAS bf16x8*)(sp + (8 + ((p) & 3) * 2 + ((p) >> 2)) * 1024))
#define DA_SLOT(j, VF, LDNEXT) do { if ((j) & 1) o2[((j) >> 1) & 3] = __builtin_amdgcn_mfma_f32_32x32x16_bf16(VF, __builtin_bit_cast(bf16x8, pp2[(j) >> 3]), o2[((j) >> 1) & 3], 0, 0, 0); \
                            else o1[((j) >> 1) & 3] = __builtin_amdgcn_mfma_f32_32x32x16_bf16(VF, __builtin_bit_cast(bf16x8, pp1[(j) >> 3]), o1[((j) >> 1) & 3], 0, 0, 0); \
                            LDNEXT; DA_SM(j); __builtin_amdgcn_sched_barrier(0); } while (0)
                      va = DA_VLD(0);
                      __builtin_amdgcn_sched_barrier(0);
                      DA_SLOT(0, va, vb = DA_VLD(1)); DA_SLOT(1, va, (void)0); DA_SLOT(2, vb, va = DA_VLD(2)); DA_SLOT(3, vb, (void)0);
                      DA_SLOT(4, va, vb = DA_VLD(3)); DA_SLOT(5, va, (void)0); DA_SLOT(6, vb, va = DA_VLD(4)); DA_SLOT(7, vb, (void)0);
                      DA_SLOT(8, va, vb = DA_VLD(5)); DA_SLOT(9, va, (void)0); DA_SLOT(10, vb, va = DA_VLD(6)); DA_SLOT(11, vb, (void)0);
                      DA_SLOT(12, va, vb = DA_VLD(7)); DA_SLOT(13, va, (void)0); DA_SLOT(14, vb, (void)0); DA_SLOT(15, vb, (void)0);
#undef DA_VLD
#undef DA_SLOT
                    }
#undef DA_SM
                    l1 = l1 * f1 + ls1; l2 = l2 * f2 + ls2;
                    if (rs1) {
#pragma unroll
                        for (int d = 0; d < 4; ++d)
#pragma unroll
                            for (int r = 0; r < 16; ++r) o1[d][r] *= f1; }
                    if (rs2) {
#pragma unroll
                        for (int d = 0; d < 4; ++d)
#pragma unroll
                            for (int r = 0; r < 16; ++r) o2[d][r] *= f2; }
#pragma unroll
                    for (int sb = 0; sb < 2; ++sb) { pp1[sb] = pn1[sb]; pp2[sb] = pn2[sb]; }
                }
            }
#undef DA_ISSUE
            l1 = x32_sum(l1); l2 = x32_sum(l2);
            int ie = i, he = hh; asm volatile("" : "+v"(ie), "+v"(he));
            const float i1 = 1.0f / l1, i2 = lam / l2; float ss = 0.f;
#pragma unroll
            for (int d = 0; d < 4; ++d)
#pragma unroll
                for (int r = 0; r < 16; ++r) { const float o = o1[d][r] * i1 - o2[d][r] * i2; o1[d][r] = o; ss += o * o; }
            ss = x32_sum(ss);
            const float rn = rsqrtf(ss * (1.0f / 128.0f) + EPS) * (1.0f - LAMBDA_INIT);
            bf16_t* op = cat + (size_t)(b * SEQ + q0 + ie) * DM + h * 128 + 8 * he;
            const LAS float* gp = dgl + h * 128 + 4 * he;
#pragma unroll
            for (int d = 0; d < 4; ++d)
#pragma unroll
                for (int g2 = 0; g2 < 2; ++g2) { u32x2 w[2];
#pragma unroll
                    for (int q = 0; q < 2; ++q) { const int g = 2 * g2 + q; const f32x4 gv = *(const LAS f32x4*)(gp + d * 32 + 8 * g);
                        w[q].x = cvt_pk_bf16(o1[d][4 * g] * rn * gv[0], o1[d][4 * g + 1] * rn * gv[1]); w[q].y = cvt_pk_bf16(o1[d][4 * g + 2] * rn * gv[2], o1[d][4 * g + 3] * rn * gv[3]); }
                    const auto sa = __builtin_amdgcn_permlane32_swap(w[0].x, w[1].x, false, false), sb = __builtin_amdgcn_permlane32_swap(w[0].y, w[1].y, false, false);
                    *(u32x4*)(op + d * 32 + 16 * g2) = (u32x4){sa[0], sb[0], sa[1], sb[1]}; }
        }
}

__device__ __forceinline__ void mlstm_prep_phase(LAS unsigned char* lds, const bf16_t* P2, const bf16_t* VT, const float* gates, const float* conv_w, const float* conv_b,
                                                 bf16_t* QM, bf16_t* KM, float* BC, float* AV, float* AM, float* CH, float* NLOC, float* CLOC, int G, int vx, int wave) {
    const int lane = lane_id(), i = lane & 31, hh = lane >> 5;
    LAS unsigned char* kl = lds + wave * 16384;
    for (int task = vx * 8 + wave; task < BATCH * 4 * 16; task += G * 8) {
        const int bh = task >> 4, c = task & 15, b = bh >> 2, h = bh & 3;
        const int t0 = b * SEQ + c * 128, tA = t0 + 2 * lane;
        const float lf0 = gates[(size_t)tA * 8 + 4 + h], lf1 = gates[(size_t)(tA + 1) * 8 + 4 + h], ig0 = gates[(size_t)tA * 8 + h], ig1 = gates[(size_t)(tA + 1) * 8 + h];
        float incl = lf0 + lf1;
#pragma unroll
        for (int off = 1; off < 64; off <<= 1) { const float v = __shfl_up(incl, off); if (lane >= off) incl += v; }
        const float bc1 = incl, bc0 = incl - lf1, blast = __shfl(incl, 63);
        const float a0 = ig0 - bc0, a1 = ig1 - bc1;
        float pm = fmaxf(a0, a1);
#pragma unroll
        for (int off = 1; off < 64; off <<= 1) { const float v = __shfl_up(pm, off); if (lane >= off) pm = fmaxf(pm, v); }
        const float pmprev = __shfl_up(pm, 1);
        const float am1 = pm, am0 = (lane > 0) ? fmaxf(pmprev, a0) : a0, amall = __shfl(pm, 63);
        const float ws0 = __expf(a0 - amall), ws1 = __expf(a1 - amall);
        *(f32x2*)(BC + (size_t)h * T + tA) = (f32x2){bc0, bc1};
        *(f32x2*)(AV + (size_t)h * T + tA) = (f32x2){a0, a1};
        *(f32x2*)(AM + (size_t)h * T + tA) = (f32x2){am0, am1};
        if (lane == 0) { CH[task * 2] = blast; CH[task * 2 + 1] = blast + amall; }
        {
            const int r8 = lane >> 3, cg = lane & 7;
            float cw[2][5][8];
#pragma unroll
            for (int part = 0; part < 2; ++part) { const int ch0 = (part ? 256 : 0) + h * 64 + 8 * cg;
#pragma unroll
                for (int k = 0; k < 4; ++k) { const f32x4 a = *(const f32x4*)(conv_w + k * 512 + ch0), bq = *(const f32x4*)(conv_w + k * 512 + ch0 + 4);
#pragma unroll
                    for (int j = 0; j < 4; ++j) { cw[part][k][j] = a[j]; cw[part][k][4 + j] = bq[j]; } }
                { const f32x4 a = *(const f32x4*)(conv_b + ch0), bq = *(const f32x4*)(conv_b + ch0 + 4);
#pragma unroll
                    for (int j = 0; j < 4; ++j) { cw[part][4][j] = a[j]; cw[part][4][4 + j] = bq[j]; } } }
#pragma unroll 4
            for (int jb = 0; jb < 16; ++jb) {
                const int p = 8 * jb + r8, tg = t0 + p, tseq = c * 128 + p;
                const float wa = __shfl(ws0, p >> 1), wb = __shfl(ws1, p >> 1); const float wsp = (p & 1) ? wb : wa;
                u32x4 uw[2][4];
#pragma unroll
                for (int part = 0; part < 2; ++part)
#pragma unroll
                    for (int k = 0; k < 4; ++k) { uw[part][k] = (u32x4){0u, 0u, 0u, 0u};
                        if (tseq - 3 + k >= 0) uw[part][k] = *(const u32x4*)(P2 + (size_t)(tg - 3 + k) * NP2 + 1024 + (part ? 256 : 0) + h * 64 + 8 * cg); }
#pragma unroll
                for (int part = 0; part < 2; ++part) { float y[8];
#pragma unroll
                    for (int j = 0; j < 8; ++j) { float pj = cw[part][4][j];
#pragma unroll
                        for (int k = 0; k < 4; ++k) { const unsigned wv = (j < 2) ? uw[part][k].x : (j < 4) ? uw[part][k].y : (j < 6) ? uw[part][k].z : uw[part][k].w; pj += cw[part][k][j] * ((j & 1) ? hi_bf(wv) : lo_bf(wv)); }
                        y[j] = pj * __builtin_amdgcn_rcpf(1.0f + __expf(-pj)); }
                    if (part == 0) { u32x4 w; w.x = cvt_pk_bf16(y[0] * 0.125f, y[1] * 0.125f); w.y = cvt_pk_bf16(y[2] * 0.125f, y[3] * 0.125f); w.z = cvt_pk_bf16(y[4] * 0.125f, y[5] * 0.125f); w.w = cvt_pk_bf16(y[6] * 0.125f, y[7] * 0.125f);
                        *(u32x4*)(QM + (size_t)tg * 256 + h * 64 + 8 * cg) = w; }
                    else { u32x4 w; w.x = cvt_pk_bf16(y[0], y[1]); w.y = cvt_pk_bf16(y[2], y[3]); w.z = cvt_pk_bf16(y[4], y[5]); w.w = cvt_pk_bf16(y[6], y[7]);
                        *(u32x4*)(KM + (size_t)tg * 256 + h * 64 + 8 * cg) = w;
#pragma unroll
                        for (int j = 0; j < 8; ++j) { const int d = 8 * cg + j;
                            *(LAS unsigned short*)(kl + d * 256 + ((jb ^ (d & 15)) * 16) + r8 * 2) = (unsigned short)f2bf(y[j] * wsp); } } }
            }
        }
        { float ns = 0.f;
#pragma unroll
          for (int cq = 0; cq < 16; ++cq) { const u32x4 w = *(const LAS u32x4*)(kl + lane * 256 + ((cq ^ (lane & 15)) * 16));
              ns += (lo_bf(w.x) + hi_bf(w.x)) + (lo_bf(w.y) + hi_bf(w.y)) + (lo_bf(w.z) + hi_bf(w.z)) + (lo_bf(w.w) + hi_bf(w.w)); }
          NLOC[(size_t)task * 64 + lane] = ns; }
        f32x16 acc[4][2];
#pragma unroll
        for (int et = 0; et < 4; ++et) { acc[et][0] = zero16(); acc[et][1] = zero16(); }
        const bf16_t* vp = VT + (size_t)(512 + h * 128 + i) * T + t0 + 8 * hh;
#pragma unroll
        for (int k2 = 0; k2 < 8; k2 += 2) {
            bf16x8 af[2][4];
#pragma unroll
            for (int q = 0; q < 2; ++q)
#pragma unroll
                for (int et = 0; et < 4; ++et) af[q][et] = *(const bf16x8*)(vp + (size_t)et * 32 * T + 16 * (k2 + q));
            __builtin_amdgcn_sched_barrier(0);
#pragma unroll
            for (int q = 0; q < 2; ++q) { const int ks = k2 + q; bf16x8 bfr[2];
#pragma unroll
                for (int dt = 0; dt < 2; ++dt) { const int d = 32 * dt + i; bfr[dt] = *(const LAS bf16x8*)(kl + d * 256 + (((2 * ks + hh) ^ (d & 15)) * 16)); }
#pragma unroll
                for (int et = 0; et < 4; ++et) {
                    acc[et][0] = __builtin_amdgcn_mfma_f32_32x32x16_bf16(af[q][et], bfr[0], acc[et][0], 0, 0, 0); acc[et][1] = __builtin_amdgcn_mfma_f32_32x32x16_bf16(af[q][et], bfr[1], acc[et][1], 0, 0, 0); } }
            __builtin_amdgcn_sched_barrier(0);
        }
        float* cp = CLOC + (size_t)task * 8192 + i + 256 * hh;
#pragma unroll
        for (int et = 0; et < 4; ++et)
#pragma unroll
            for (int dt = 0; dt < 2; ++dt)
#pragma unroll
                for (int r = 0; r < 16; ++r) cp[(32 * et + (r & 3) + 8 * (r >> 2)) * 64 + 32 * dt] = acc[et][dt][r];
    }
}
__device__ __forceinline__ void mlstm_scan_phase(const float* CLOC, const float* NLOC, const float* CH, bf16_t* CSTB, float* NST, float* MSTATE, int G, int bx, int tid) {
    for (int idx = bx * 512 + tid; idx < BATCH * 4 * 1024; idx += G * 512) {
        const int bh = idx >> 10, rem = idx & 1023, e = rem >> 3, d0 = (rem & 7) * 8;
        float C[8], nr[8]; float m = 0.f;
#pragma unroll
        for (int j = 0; j < 8; ++j) { C[j] = 0.f; nr[j] = 0.f; }
#pragma unroll 1
        for (int c8 = 0; c8 < 16; c8 += 8) {
            f32x4 cl[8][2], nl[8][2]; float bl[8], ml[8];
#pragma unroll
            for (int q = 0; q < 8; ++q) { const int task = bh * 16 + c8 + q;
                cl[q][0] = *(const f32x4*)(CLOC + (size_t)task * 8192 + e * 64 + d0); cl[q][1] = *(const f32x4*)(CLOC + (size_t)task * 8192 + e * 64 + d0 + 4);
                bl[q] = CH[task * 2]; ml[q] = CH[task * 2 + 1];
                if (rem < 8) { nl[q][0] = *(const f32x4*)(NLOC + (size_t)task * 64 + rem * 8); nl[q][1] = *(const f32x4*)(NLOC + (size_t)task * 64 + rem * 8 + 4); }
                else { nl[q][0] = (f32x4){0.f, 0.f, 0.f, 0.f}; nl[q][1] = nl[q][0]; } }
#pragma unroll
            for (int q = 0; q < 8; ++q) { const int task = bh * 16 + c8 + q;
                u32x4 w; w.x = cvt_pk_bf16(C[0], C[1]); w.y = cvt_pk_bf16(C[2], C[3]); w.z = cvt_pk_bf16(C[4], C[5]); w.w = cvt_pk_bf16(C[6], C[7]);
                *(u32x4*)(CSTB + (size_t)task * 8192 + e * 64 + d0) = w;
                if (rem < 8) { *(f32x4*)(NST + (size_t)task * 64 + rem * 8) = (f32x4){nr[0], nr[1], nr[2], nr[3]}; *(f32x4*)(NST + (size_t)task * 64 + rem * 8 + 4) = (f32x4){nr[4], nr[5], nr[6], nr[7]}; }
                if (rem == 0) MSTATE[task] = m;
                const float mn = fmaxf(bl[q] + m, ml[q]), a = __expf(bl[q] + m - mn), bco = __expf(ml[q] - mn);
#pragma unroll
                for (int j = 0; j < 4; ++j) { C[j] = a * C[j] + bco * cl[q][0][j]; C[4 + j] = a * C[4 + j] + bco * cl[q][1][j]; nr[j] = a * nr[j] + bco * nl[q][0][j]; nr[4 + j] = a * nr[4 + j] + bco * nl[q][1][j]; }
                m = mn; }
        }
    }
}
__device__ __forceinline__ void mlstm_out_phase(LAS unsigned char* lds, LAS float* mgl, const bf16_t* P2, const bf16_t* VT, const bf16_t* QM, const bf16_t* KM, const float* BC, const float* AV, const float* AM,
                                                const bf16_t* CSTB, const float* NST, const float* MSTATE, const float* mng, bf16_t* cat, int G, int vx, int wave) {
    const int lane_ = lane_id();
    const int cw = wave >> 2, tq = wave & 3;
    mgl[wave * 64 + lane_] = mng[wave * 64 + lane_];
    __syncthreads();
    LAS unsigned char* reg = lds + cw * 65536;
    for (int un = vx; un < BATCH * 4 * 8; un += G) {
        int lane = lane_; asm volatile("" : "+v"(lane));
        const int i = lane & 31, hh = lane >> 5;
        const int task = 2 * un + cw, bh = task >> 4, c = task & 15, b = bh >> 2, h = bh & 3;
        const int t0 = b * SEQ + c * 128;
        { const bf16_t* ks = KM + (size_t)(t0 + 32 * tq + pi32(i)) * 256 + h * 64 + 8 * hh;
          const bf16_t* cs = CSTB + (size_t)task * 8192 + (32 * tq + i) * 64 + 8 * hh;
          const bf16_t* vs = VT + (size_t)(512 + h * 128 + 32 * tq + i) * T + t0 + 8 * hh;
#pragma unroll
          for (int ds = 0; ds < 4; ++ds) { __builtin_amdgcn_global_load_lds((const unsigned*)(ks + 16 * ds), (LAS unsigned*)(reg + (tq * 4 + ds) * 1024), 16, 0, 0);
              __builtin_amdgcn_global_load_lds((const unsigned*)(cs + 16 * ds), (LAS unsigned*)(reg + 16384 + (tq * 4 + ds) * 1024), 16, 0, 0); }
#pragma unroll
          for (int k8 = 0; k8 < 8; ++k8) __builtin_amdgcn_global_load_lds((const unsigned*)(vs + 16 * k8), (LAS unsigned*)(reg + 32768 + (tq * 8 + k8) * 1024), 16, 0, 0); }
        const float m_c = MSTATE[task];
        const int tg = t0 + 32 * tq + i;
        const float bct = BC[(size_t)h * T + tg], amt = AM[(size_t)h * T + tg];
        bf16x8 qf[4];
#pragma unroll
        for (int ds = 0; ds < 4; ++ds) qf[ds] = *(const bf16x8*)(QM + (size_t)tg * 256 + h * 64 + 16 * ds + 8 * hh);
        float qn = 0.f;
        f32x4 nn[4][2];
#pragma unroll
        for (int ds = 0; ds < 4; ++ds) { nn[ds][0] = *(const f32x4*)(NST + (size_t)task * 64 + 16 * ds + 8 * hh); nn[ds][1] = *(const f32x4*)(NST + (size_t)task * 64 + 16 * ds + 8 * hh + 4); }
#pragma unroll
        for (int ds = 0; ds < 4; ++ds) { const f32x4 n0 = nn[ds][0], n1 = nn[ds][1];
            const u32x4 w = __builtin_bit_cast(u32x4, qf[ds]);
            qn += lo_bf(w.x) * n0[0] + hi_bf(w.x) * n0[1] + lo_bf(w.y) * n0[2] + hi_bf(w.y) * n0[3] + lo_bf(w.z) * n1[0] + hi_bf(w.z) * n1[1] + lo_bf(w.w) * n1[2] + hi_bf(w.w) * n1[3]; }
        qn = x32_sum(qn);
        const float M = fmaxf(m_c, amt), g = __expf(m_c - M), emt = __expf(-(bct + M));
        const bf16_t* mop = P2 + (size_t)tg * NP2 + 1536 + h * 128 + 4 * hh;
        u32x2 mov[4][4];
#pragma unroll
        for (int et = 0; et < 4; ++et)
#pragma unroll
            for (int g4 = 0; g4 < 4; ++g4) mov[et][g4] = *(const u32x2*)(mop + et * 32 + 8 * g4);
        asm volatile("s_waitcnt vmcnt(0)" ::: "memory"); __builtin_amdgcn_s_barrier(); asm volatile("" ::: "memory");
        const LAS unsigned char* rl = reg + lane * 16;
        f32x16 acc[4];
#pragma unroll
        for (int et = 0; et < 4; ++et) { acc[et] = zero16();
#pragma unroll
            for (int ds = 0; ds < 4; ++ds) acc[et] = __builtin_amdgcn_mfma_f32_32x32x16_bf16(*(const LAS bf16x8*)(rl + 16384 + (et * 4 + ds) * 1024), qf[ds], acc[et], 0, 0, 0);
#pragma unroll
            for (int r = 0; r < 16; ++r) acc[et][r] *= g; }
        float wsum = 0.f;
        for (int kt = 0; kt <= tq; ++kt) {
            f32x16 sc = zero16();
#pragma unroll
            for (int ds = 0; ds < 4; ++ds) sc = __builtin_amdgcn_mfma_f32_32x32x16_bf16(*(const LAS bf16x8*)(rl + (kt * 4 + ds) * 1024), qf[ds], sc, 0, 0, 0);
            const float* ap = AV + (size_t)h * T + t0 + 32 * kt + 8 * hh;
            const f32x4 a00 = *(const f32x4*)(ap), a01 = *(const f32x4*)(ap + 4), a10 = *(const f32x4*)(ap + 16), a11 = *(const f32x4*)(ap + 20);
#pragma unroll
            for (int r = 0; r < 16; ++r) { const float av = (r < 4) ? a00[r & 3] : (r < 8) ? a01[r & 3] : (r < 12) ? a10[r & 3] : a11[r & 3];
                const int ko = 16 * (r >> 3) + 8 * hh + (r & 7);
                float w = sc[r] * __expf(av - M);
                w = (kt == tq && ko > i) ? 0.f : w;
                sc[r] = w; wsum += w; }
            u32x4 wf[2];
#pragma unroll
            for (int sb = 0; sb < 2; ++sb) { wf[sb].x = cvt_pk_bf16(sc[8 * sb + 0], sc[8 * sb + 1]); wf[sb].y = cvt_pk_bf16(sc[8 * sb + 2], sc[8 * sb + 3]); wf[sb].z = cvt_pk_bf16(sc[8 * sb + 4], sc[8 * sb + 5]); wf[sb].w = cvt_pk_bf16(sc[8 * sb + 6], sc[8 * sb + 7]); }
#pragma unroll
            for (int et = 0; et < 4; ++et)
#pragma unroll
                for (int sb = 0; sb < 2; ++sb) acc[et] = __builtin_amdgcn_mfma_f32_32x32x16_bf16(*(const LAS bf16x8*)(rl + 32768 + (et * 8 + 2 * kt + sb) * 1024), __builtin_bit_cast(bf16x8, wf[sb]), acc[et], 0, 0, 0);
        }
        wsum = x32_sum(wsum);
        const float den = g * qn + wsum, idd = 1.0f / fmaxf(fabsf(den), emt);
        float ss = 0.f;
#pragma unroll
        for (int et = 0; et < 4; ++et)
#pragma unroll
            for (int r = 0; r < 16; ++r) { const float hv = acc[et][r] * idd; acc[et][r] = hv; ss += hv * hv; }
        ss = x32_sum(ss);
        const float rn = rsqrtf(ss * (1.0f / 128.0f) + EPS);
        bf16_t* op = cat + (size_t)tg * DM + 512 + h * 128 + 8 * hh;
        const LAS float* gp = mgl + h * 128 + 4 * hh;
#pragma unroll
        for (int et = 0; et < 4; ++et)
#pragma unroll
            for (int gq = 0; gq < 2; ++gq) { u32x2 w[2];
#pragma unroll
                for (int q = 0; q < 2; ++q) { const int g4 = 2 * gq + q; const f32x4 gv = *(const LAS f32x4*)(gp + et * 32 + 8 * g4); const u32x2 mo = mov[et][g4];
                    const float o0 = lo_bf(mo.x), o1 = hi_bf(mo.x), o2 = lo_bf(mo.y), o3 = hi_bf(mo.y);
                    const float y0 = acc[et][4 * g4] * rn * gv[0] * __builtin_amdgcn_rcpf(1.0f + __expf(-o0)), y1 = acc[et][4 * g4 + 1] * rn * gv[1] * __builtin_amdgcn_rcpf(1.0f + __expf(-o1));
                    const float y2 = acc[et][4 * g4 + 2] * rn * gv[2] * __builtin_amdgcn_rcpf(1.0f + __expf(-o2)), y3 = acc[et][4 * g4 + 3] * rn * gv[3] * __builtin_amdgcn_rcpf(1.0f + __expf(-o3));
                    w[q].x = cvt_pk_bf16(y0, y1); w[q].y = cvt_pk_bf16(y2, y3); }
                const auto sa = __builtin_amdgcn_permlane32_swap(w[0].x, w[1].x, false, false), sb = __builtin_amdgcn_permlane32_swap(w[0].y, w[1].y, false, false);
                *(u32x4*)(op + et * 32 + 16 * gq) = (u32x4){sa[0], sb[0], sa[1], sb[1]}; }
        asm volatile("s_waitcnt lgkmcnt(0)" ::: "memory"); __builtin_amdgcn_s_barrier(); asm volatile("" ::: "memory");
    }
}

constexpr int NWAVES = 8;
constexpr int RING_BYTES = 131072;
constexpr int LDSCTL_OFF = RING_BYTES;
constexpr int LDS_BYTES = RING_BYTES + 5120 + 3072;

enum Phase { PH_PREP = 0, PH_INPROJ = 1, PH_MIX0 = 2, PH_MIX1 = 3, PH_MIX2 = 4, PH_OUTPROJ = 5, PH_QKV = 6, PH_XATTN = 7, PH_COPROJ = 8, PH_ROUTER = 9, PH_G1 = 10, PH_G2 = 11, PH_COMBINE = 12, PH_END = 13 };

struct Args { const float* in[28]; float* out; unsigned char* ws; int ph_lo, ph_hi, pass_lo, pass_hi; };

struct CJob { const float* src; const float* g; unsigned char* dst; int Nsrc, k0, n0, mode, f8; float scale; };
__device__ __forceinline__ void conv_load(const CJob& j, f32x4 (&v)[2], int tid) {
    const int kk = tid >> 4, c4 = (tid & 15) * 4;
#pragma unroll
    for (int rep = 0; rep < 2; ++rep) v[rep] = *(const f32x4*)(j.src + (size_t)(j.k0 + kk + 32 * rep) * j.Nsrc + j.n0 + c4);
}
__device__ __forceinline__ void conv_put(LAS float* tile, const f32x4 (&v)[2], int tid) {
    const int kk = tid >> 4, c4 = (tid & 15) * 4;
#pragma unroll
    for (int rep = 0; rep < 2; ++rep)
#pragma unroll
        for (int q = 0; q < 4; ++q) tile[(kk + 32 * rep) * 65 + c4 + q] = v[rep][q];
}
__device__ __forceinline__ void conv_store(const LAS float* tile, const CJob& j, int tid) {
    const int n = tid >> 3, kc = tid & 7; float vals[8];
    f32x4 g0 = (f32x4){1.f, 1.f, 1.f, 1.f}, g1 = g0;
    if (j.g) { g0 = *(const f32x4*)(j.g + j.k0 + 8 * kc); g1 = *(const f32x4*)(j.g + j.k0 + 8 * kc + 4); }
#pragma unroll
    for (int q = 0; q < 8; ++q) vals[q] = tile[(8 * kc + q) * 65 + n] * (q < 4 ? g0[q & 3] : g1[q & 3]) * j.scale;
    const int sc = j.n0 + n; int drow = sc;
    if (j.mode == 1) { const int jj = sc >> 1, s = sc & 1; drow = 256 * (jj >> 7) + 128 * s + (jj & 127); }
    if (j.mode == 2) { drow = sc < 1024 ? sc : sc < 1536 ? sc + 1024 : sc < 2048 ? sc - 512 : sc < 2560 ? sc + 512 : sc - 1024; }
    if (j.f8) { unsigned w0 = 0u, w1 = 0u;
        w0 = __builtin_amdgcn_cvt_pk_fp8_f32(c8(vals[0]), c8(vals[1]), w0, false); w0 = __builtin_amdgcn_cvt_pk_fp8_f32(c8(vals[2]), c8(vals[3]), w0, true);
        w1 = __builtin_amdgcn_cvt_pk_fp8_f32(c8(vals[4]), c8(vals[5]), w1, false); w1 = __builtin_amdgcn_cvt_pk_fp8_f32(c8(vals[6]), c8(vals[7]), w1, true);
        *(u32x2*)(j.dst + (size_t)drow * 1024 + j.k0 + 8 * kc) = (u32x2){w0, w1}; }
    else { u32x4 w; w.x = cvt_pk_bf16(vals[0], vals[1]); w.y = cvt_pk_bf16(vals[2], vals[3]); w.z = cvt_pk_bf16(vals[4], vals[5]); w.w = cvt_pk_bf16(vals[6], vals[7]);
        *(u32x4*)(j.dst + ((size_t)drow * 1024 + j.k0 + 8 * kc) * 2) = w; }
}

__global__ void __launch_bounds__(NWAVES * 64, 2) fwd(Args args) {
    extern __shared__ __attribute__((aligned(16))) unsigned char lds_raw[];
    LAS unsigned char* lds = (LAS unsigned char*)lds_raw;
    volatile LAS unsigned* LCTL = (volatile LAS unsigned*)(lds + LDSCTL_OFF);
    const int wave = __builtin_amdgcn_readfirstlane(threadIdx.x >> 6);
#define lane lane_id()
#define tid (wave * 64 + lane_id())
    const int G = gridDim.x, bx = blockIdx.x;
    unsigned char* ws = args.ws;
    unsigned* ctl = (unsigned*)(ws + WS_CTL);
    const int lo = args.ph_lo, hi = args.ph_hi;
#ifndef PHMASK
#define PHMASK 0xffffff
#endif
#ifndef DUPMASK
#define DUPMASK 0x0
#endif
#define IN(k) (((PHMASK >> (k)) & 1) && lo <= (k) && (k) < hi)
#define NREP(k) ((((DUPMASK) >> (k)) & 1) ? 2 : 1)
#define ENDBAR(k) (BOTH(k) || (((DUPMASK) >> (k)) & 1))
#define BOTH(k) (IN(k) && IN((k) + 1))
    for (int u = tid; u < (LDS_BYTES - LDSCTL_OFF) / 4; u += NWAVES * 64) LCTL[u] = 0u;
    __syncthreads();
    XcdBarrier bar; bar.bar = ctl + CW_BAR; bar.x = 0; bar.st = LCTL; bar.wave = wave;
    const bool multi = (hi - lo) > 1 || (args.pass_hi - args.pass_lo) > 1 || (IN(PH_G1) && IN(PH_G2));
    if (multi) bar = xcd_barrier_post(ctl + CW_BAR, LCTL, wave);
#define GRID_BAR() xcd_barrier(bar)

    const float* x = args.in[0]; const float* mem = args.in[1];
    bf16_t* XB = (bf16_t*)(ws + WS_XB); bf16_t* PROJ = (bf16_t*)(ws + WS_PROJ); bf16_t* CAT = (bf16_t*)(ws + WS_CAT);
    bf16_t* MEMB = (bf16_t*)(ws + WS_MEMB); bf16_t* KV = (bf16_t*)(ws + WS_KV); bf16_t* VT2 = (bf16_t*)(ws + WS_VT2); bf16_t* VT1 = (bf16_t*)(ws + WS_VT1); unsigned char* H1F = ws + WS_H1F;
    bf16_t* WIN = (bf16_t*)(ws + WS_WIN); bf16_t* WOUT = (bf16_t*)(ws + WS_WOUT); bf16_t* WCQ = (bf16_t*)(ws + WS_WCQ); bf16_t* WCKV = (bf16_t*)(ws + WS_WCKV);
    bf16_t* WCO = (bf16_t*)(ws + WS_WCO); bf16_t* WR = (bf16_t*)(ws + WS_WR); unsigned char* W1F = ws + WS_W1; unsigned char* W2F = ws + WS_W2; unsigned char* H2F = ws + WS_H2F;
    float* RSTDX = (float*)(ws + WS_RSTDX); float* RSTDM = (float*)(ws + WS_RSTDM); float* B1P = (float*)(ws + WS_B1P); float* MISC = (float*)(ws + WS_MISC); float* RSTD2 = (float*)(ws + WS_RSTD2);
    float* SSP1 = (float*)(ws + WS_SSP1); float* SSP2 = (float*)(ws + WS_SSP2); float* GATES = (float*)(ws + WS_GATES);
    unsigned* TOKMAP = (unsigned*)(ws + WS_TOKMAP); float* GATEV = (float*)(ws + WS_GATEV); unsigned* LIST = (unsigned*)(ws + WS_LIST);
    unsigned char* YB = ws + WS_Y; unsigned char* HID = ws + WS_HID;

    if (IN(PH_PREP)) for (int rep_ = 0; rep_ < NREP(PH_PREP); ++rep_) {
        constexpr int J0 = 768, J1 = J0 + 256, J2 = J1 + 256, J3 = J2 + 512, J4 = J3 + 256, J5 = J4 + 16384, J6 = J5 + 8192;
        auto decode = [&](int it, CJob& j) {
            if (it < J0) { j = CJob{args.in[3], args.in[2], (unsigned char*)WIN, DIN, (it / 48) * 64, (it % 48) * 64, 2, 0, 1.0f}; }
            else if (it < J1) { const int r = it - J0; j = CJob{args.in[14], nullptr, (unsigned char*)WOUT, 1024, (r / 16) * 64, (r % 16) * 64, 0, 0, 1.0f}; }
            else if (it < J2) { const int r = it - J1; j = CJob{args.in[17], args.in[15], (unsigned char*)WCQ, 1024, (r / 16) * 64, (r % 16) * 64, 0, 1, 64.0f}; }
            else if (it < J3) { const int r = it - J2; j = CJob{args.in[18], args.in[16], (unsigned char*)WCKV, 2048, (r / 32) * 64, (r % 32) * 64, 0, 1, 64.0f}; }
            else if (it < J4) { const int r = it - J3; j = CJob{args.in[19], nullptr, (unsigned char*)WCO, 1024, (r / 16) * 64, (r % 16) * 64, 0, 1, 64.0f}; }
            else if (it < J5) { const int r = it - J4; const int e = r >> 9, q = r & 511; j = CJob{args.in[23] + (size_t)e * 1024 * 2048, args.in[20], W1F + (size_t)e * 2048 * 1024, 2048, (q / 32) * 64, (q % 32) * 64, 1, 1, 64.0f}; }
            else { const int r = it - J5; const int e = r >> 8, q = r & 255; j = CJob{args.in[25] + (size_t)e * 1024 * 1024, nullptr, W2F + (size_t)e * 1024 * 1024, 1024, (q / 16) * 64, (q % 16) * 64, 0, 1, 64.0f}; } };
        static_assert(J0 % 4 == 0 && J1 % 4 == 0 && J2 % 4 == 0 && J3 % 4 == 0 && J4 % 4 == 0 && J5 % 4 == 0 && J6 % 4 == 0, "rounds of four jobs");
#define LDS_BAR() do { asm volatile("s_waitcnt lgkmcnt(0)" ::: "memory"); __builtin_amdgcn_s_barrier(); asm volatile("" ::: "memory"); } while (0)
        { f32x4 v[8]; int it0 = bx * 4; CJob jc;
          if (it0 < J6) { decode(it0, jc);
#pragma unroll
              for (int r = 0; r < 8; ++r) v[r] = *(const f32x4*)(jc.src + (size_t)(jc.k0 + wave * 8 + r) * jc.Nsrc + jc.n0 + 4 * lane); }
          for (; it0 < J6; it0 += G * 4) {
            { LAS float* tq = (LAS float*)lds + (lane >> 4) * (64 * 65) + ((4 * lane) & 63) + (wave * 8) * 65;
#pragma unroll
              for (int r = 0; r < 8; ++r)
#pragma unroll
                  for (int q = 0; q < 4; ++q) tq[r * 65 + q] = v[r][q]; }
            LDS_BAR();
            CJob js = jc; const int nx = it0 + G * 4;
            if (nx < J6) { decode(nx, jc);
#pragma unroll
                for (int r = 0; r < 8; ++r) v[r] = *(const f32x4*)(jc.src + (size_t)(jc.k0 + wave * 8 + r) * jc.Nsrc + jc.n0 + 4 * lane); }
#pragma unroll
            for (int q = 0; q < 4; ++q) { conv_store((const LAS float*)lds + q * (64 * 65), js, tid); js.n0 += 64; }
            LDS_BAR();
          } }
        __syncthreads();
        for (int i = bx * 512 + tid; i < NEXP * 1024; i += G * 512) { const int e = i >> 10, k = i & 1023; WR[i] = (bf16_t)f2bf(args.in[21][k * NEXP + e] * args.in[20][k]); }
        for (int i = bx * 512 + tid; i < NEXP * 2048; i += G * 512) { const int e = i >> 11, rho = i & 2047; const int pn = rho >> 8, s = (rho >> 7) & 1, ii = rho & 127; B1P[i] = args.in[24][e * 2048 + 2 * (128 * pn + ii) + s]; }
        if (bx == 0 && wave == 0) { const float a = wave_sum(args.in[9][lane] * args.in[10][lane]), b = wave_sum(args.in[11][lane] * args.in[12][lane]);
            if (lane == 0) MISC[0] = expf(a) - expf(b) + LAMBDA_INIT; }
        {
            const float* win = args.in[3]; const float* g = args.in[2];
            float wg[4][4][8];
#pragma unroll
            for (int jj = 0; jj < 4; ++jj)
#pragma unroll
                for (int q = 0; q < 4; ++q) { const int k = 4 * lane + 256 * jj + q; const float gk = g[k];
                    const f32x4 a = *(const f32x4*)(win + (size_t)k * DIN + 3072), b = *(const f32x4*)(win + (size_t)k * DIN + 3076);
#pragma unroll
                    for (int j = 0; j < 4; ++j) { wg[jj][q][j] = a[j] * gk; wg[jj][q][4 + j] = b[j] * gk; } }
            const int gw = bx * NWAVES + wave, NGW = G * NWAVES;
            f32x4 vn[4];
            if (gw < T) { const f32x4* xr = (const f32x4*)(x + (size_t)gw * DM) + lane;
#pragma unroll
                for (int jj = 0; jj < 4; ++jj) vn[jj] = xr[64 * jj]; }
            for (int row = gw; row < T; row += NGW) {
                f32x4 v[4]; float ss = 0.f; float d[8];
#pragma unroll
                for (int jj = 0; jj < 4; ++jj) v[jj] = vn[jj];
                if (row + NGW < T) { const f32x4* xr = (const f32x4*)(x + (size_t)(row + NGW) * DM) + lane;
#pragma unroll
                    for (int jj = 0; jj < 4; ++jj) vn[jj] = xr[64 * jj]; }
#pragma unroll
                for (int j = 0; j < 8; ++j) d[j] = 0.f;
#pragma unroll
                for (int jj = 0; jj < 4; ++jj) {
#pragma unroll
                    for (int q = 0; q < 4; ++q) { ss += v[jj][q] * v[jj][q];
#pragma unroll
                        for (int j = 0; j < 8; ++j) d[j] += v[jj][q] * wg[jj][q][j]; } }
                ss = wave_sum(ss);
#pragma unroll
                for (int j = 0; j < 8; ++j) d[j] = wave_sum(d[j]);
                const float rs = rsqrtf(ss * (1.0f / DM) + EPS);
                u32x2* o8 = (u32x2*)(XB + (size_t)row * DM) + lane;
#pragma unroll
                for (int jj = 0; jj < 4; ++jj) { u32x2 w; w.x = cvt_pk_bf16(v[jj][0], v[jj][1]); w.y = cvt_pk_bf16(v[jj][2], v[jj][3]); o8[64 * jj] = w; }
                if (lane == 0) RSTDX[row] = rs;
                if (lane < 8) { float dv = d[0];
#pragma unroll
                    for (int j = 1; j < 8; ++j) dv = (lane == j) ? d[j] : dv;
                    dv *= rs; float r;
                    if (lane < 4) r = dv + args.in[6][lane];
                    else { const float z = dv + args.in[7][lane - 4]; r = (z >= 0.f) ? -log1pf(expf(-z)) : (z - log1pf(expf(z))); }
                    GATES[(size_t)row * 8 + lane] = r; }
            }
            for (int row = gw; row < MROWS; row += NGW) {
                const f32x4* xr = (const f32x4*)(mem + (size_t)row * DM) + lane;
                f32x4 v[4]; float ss = 0.f;
#pragma unroll
                for (int jj = 0; jj < 4; ++jj) { v[jj] = xr[64 * jj]; ss += (v[jj][0] * v[jj][0] + v[jj][1] * v[jj][1]) + (v[jj][2] * v[jj][2] + v[jj][3] * v[jj][3]); }
                ss = wave_sum(ss);
                unsigned* o4 = (unsigned*)((unsigned char*)MEMB + (size_t)row * DM) + lane;
#pragma unroll
                for (int jj = 0; jj < 4; ++jj) { unsigned w = 0u; w = __builtin_amdgcn_cvt_pk_fp8_f32(c8(v[jj][0]), c8(v[jj][1]), w, false); w = __builtin_amdgcn_cvt_pk_fp8_f32(c8(v[jj][2]), c8(v[jj][3]), w, true); o4[64 * jj] = w; }
                if (lane == 0) RSTDM[row] = rsqrtf(ss * (1.0f / DM) + EPS);
            }
        }
        if (ENDBAR(PH_PREP)) GRID_BAR();
    }

    if (IN(PH_INPROJ)) for (int rep_ = 0; rep_ < NREP(PH_INPROJ); ++rep_) {
        { ProbScaleBf16 P{(LAS unsigned*)(lds + LDSCTL_OFF + 2048), XB, WIN, T / 256, NP2 / 256, G, bx, PROJ, NP2, RSTDX, nullptr};
          pg8::gemm_phase<ProbScaleBf16, true>(lds, P, wave); }
        { ProbColScaleBf16 P{(LAS unsigned*)(lds + LDSCTL_OFF + 2048), WIN + (size_t)NP2 * 1024, XB, 4, T / 256, G, bx, VT1, T, RSTDX};
          pg8::gemm_phase<ProbColScaleBf16, true>(lds, P, wave); }
        if (ENDBAR(PH_INPROJ)) GRID_BAR();
    }

    const int vx = (G % 8 == 0) ? (bx % 8) * (G / 8) + bx / 8 : bx;
    bf16_t* QM = (bf16_t*)(ws + WS_QM); bf16_t* KM = (bf16_t*)(ws + WS_KM); bf16_t* CSTB = (bf16_t*)(ws + WS_CSTB);
    float* BC = (float*)(ws + WS_BC); float* AV = (float*)(ws + WS_AV); float* AM = (float*)(ws + WS_AM); float* NLOC = (float*)(ws + WS_NLOC); float* NST = (float*)(ws + WS_NST);
    float* CH = (float*)(ws + WS_CH); float* MSTATE = (float*)(ws + WS_MSTATE); float* CLOC = (float*)(ws + WS_MST);
    if (IN(PH_MIX0)) for (int rep_ = 0; rep_ < NREP(PH_MIX0); ++rep_) {
        mlstm_prep_phase(lds, PROJ, VT1, GATES, args.in[4], args.in[5], QM, KM, BC, AV, AM, CH, NLOC, CLOC, G, vx, wave);
        if (ENDBAR(PH_MIX0)) GRID_BAR();
    }
    if (IN(PH_MIX1)) for (int rep_ = 0; rep_ < NREP(PH_MIX1); ++rep_) {
        mlstm_scan_phase(CLOC, NLOC, CH, CSTB, NST, MSTATE, G, bx, tid);
        if (ENDBAR(PH_MIX1)) GRID_BAR();
    }
    if (IN(PH_MIX2)) for (int rep_ = 0; rep_ < NREP(PH_MIX2); ++rep_) {
        mlstm_out_phase(lds, (LAS float*)(lds + LDSCTL_OFF + 2048), PROJ, VT1, QM, KM, BC, AV, AM, CSTB, NST, MSTATE, args.in[8], CAT, G, vx, wave);
        __syncthreads();
        const float lam = __hip_atomic_load(MISC, __ATOMIC_RELAXED, __HIP_MEMORY_SCOPE_AGENT);
        diffattn_phase(lds, (LAS float*)(lds + LDSCTL_OFF + 2048), PROJ, VT1, args.in[13], lam, CAT, G, vx, wave);
        if (ENDBAR(PH_MIX2)) GRID_BAR();
    }

    if (IN(PH_OUTPROJ)) for (int rep_ = 0; rep_ < NREP(PH_OUTPROJ); ++rep_) {
        ProbResidT<false, true, false> P{(LAS unsigned*)(lds + LDSCTL_OFF + 2048), CAT, WOUT, T / 256, 4, G, bx, nullptr, XB, XB, H1F, SSP1};
        pg8::gemm_phase<ProbResidT<false, true, false>, true>(lds, P, wave);
        if (ENDBAR(PH_OUTPROJ)) GRID_BAR();
    }

    if (IN(PH_QKV)) for (int rep_ = 0; rep_ < NREP(PH_QKV); ++rep_) {
        { ProbScaleT<true> P{(LAS unsigned*)(lds + LDSCTL_OFF + 2048), H1F, WCQ, T / 256, 4, G, bx, PROJ, 1024, nullptr, SSP1};
          pg8::gemm_phase<ProbScaleT<true>, true>(lds, P, wave); }
        { ProbKV P{(LAS unsigned*)(lds + LDSCTL_OFF + 2048), (const unsigned char*)MEMB, (const unsigned char*)WCKV, KV, VT2, RSTDM, G, bx};
          pg8::gemm_phase<ProbKV, true>(lds, P, wave); }
        if (ENDBAR(PH_QKV)) GRID_BAR();
    }

    if (IN(PH_XATTN)) for (int rep_ = 0; rep_ < NREP(PH_XATTN); ++rep_) {
        xattn_phase(lds, PROJ, KV, VT2, (unsigned char*)(PROJ + (size_t)T * 1024), G, vx, wave);
        if (ENDBAR(PH_XATTN)) GRID_BAR();
    }

    if (IN(PH_COPROJ)) for (int rep_ = 0; rep_ < NREP(PH_COPROJ); ++rep_) {
        ProbResidT<true, false, false> P{(LAS unsigned*)(lds + LDSCTL_OFF + 2048), (unsigned char*)(PROJ + (size_t)T * 1024), WCO, T / 256, 4, G, bx, nullptr, XB, CAT, nullptr, SSP2};
        pg8::gemm_phase<ProbResidT<true, false, false>, true>(lds, P, wave);
        if (ENDBAR(PH_COPROJ)) GRID_BAR();
    }

    if (IN(PH_ROUTER)) for (int rep_ = 0; rep_ < NREP(PH_ROUTER); ++rep_) {
        { u32x4 wv[8];
#pragma unroll
          for (int q = 0; q < 8; ++q) { const int idx = q * (NWAVES * 64) + tid, ks = idx >> 6, ln = idx & 63; wv[q] = *(const u32x4*)(WR + (size_t)(ln & 31) * DM + 16 * ks + 8 * (ln >> 5)); }
#pragma unroll
          for (int q = 0; q < 8; ++q) { const int idx = q * (NWAVES * 64) + tid; *(LAS u32x4*)(lds + idx * 16) = wv[q]; } }
        __syncthreads();
        const float* brt = args.in[22];
        const int i = lane & 31, hh = lane >> 5;
        volatile LAS unsigned* lcnt = (volatile LAS unsigned*)(lds + 65536);
        const int ntrip = (T / 32 + G * NWAVES - 1) / (G * NWAVES);
        for (int trip = 0; trip < ntrip; ++trip) {
            const int tile = trip * G * NWAVES + bx * NWAVES + wave; const bool act = tile < T / 32;
            if (tid < 32) lcnt[tid] = 0u;
            __syncthreads();
            const int t = (act ? tile : 0) * 32 + i;
            const bf16_t* xp = CAT + (size_t)t * DM + 8 * hh;
            const f32x4 p0 = *(const f32x4*)(SSP2 + (size_t)t * 16 + 8 * hh), p1 = *(const f32x4*)(SSP2 + (size_t)t * 16 + 8 * hh + 4);
            float sp = (p0[0] + p0[1]) + (p0[2] + p0[3]) + (p1[0] + p1[1]) + (p1[2] + p1[3]); sp = x32_sum(sp);
            const float rs = rsqrtf(sp * (1.0f / DM) + EPS);
            f32x16 acc = zero16();
#pragma unroll 1
            for (int kb = 0; kb < 64; kb += 16) { bf16x8 xf[16];
#pragma unroll
                for (int q = 0; q < 16; ++q) xf[q] = *(const bf16x8*)(xp + 16 * (kb + q));
#pragma unroll
                for (int q = 0; q < 16; ++q) { const bf16x8 wf = *(const LAS bf16x8*)(lds + ((kb + q) * 64 + lane) * 16); acc = __builtin_amdgcn_mfma_f32_32x32x16_bf16(wf, xf[q], acc, 0, 0, 0); }
#pragma unroll
                for (int q2 = 0; q2 < 8; ++q2) { unsigned pw[2][2];
#pragma unroll
                    for (int q = 0; q < 2; ++q) { const u32x4 xw = __builtin_bit_cast(u32x4, xf[2 * q2 + q]); unsigned w0 = 0u, w1 = 0u;
                        w0 = __builtin_amdgcn_cvt_pk_fp8_f32(lo_bf(xw.x) * rs, hi_bf(xw.x) * rs, w0, false); w0 = __builtin_amdgcn_cvt_pk_fp8_f32(lo_bf(xw.y) * rs, hi_bf(xw.y) * rs, w0, true);
                        w1 = __builtin_amdgcn_cvt_pk_fp8_f32(lo_bf(xw.z) * rs, hi_bf(xw.z) * rs, w1, false); w1 = __builtin_amdgcn_cvt_pk_fp8_f32(lo_bf(xw.w) * rs, hi_bf(xw.w) * rs, w1, true);
                        pw[q][0] = w0; pw[q][1] = w1; }
                    const auto sa = __builtin_amdgcn_permlane32_swap(pw[0][0], pw[1][0], false, false), sb = __builtin_amdgcn_permlane32_swap(pw[0][1], pw[1][1], false, false);
                    *(u32x4*)(H2F + (size_t)t * DM + 16 * (kb + 2 * q2) + 16 * hh) = (u32x4){sa[0], sb[0], sa[1], sb[1]}; } }
            float mine[16], oth[16];
#pragma unroll
            for (int r = 0; r < 16; ++r) { const int e = (r & 3) + 8 * (r >> 2); mine[r] = acc[r] * rs + brt[e + 4 * hh]; }
#pragma unroll
            for (int r = 0; r < 16; ++r) oth[r] = x32_other(mine[r], hh);
            float lg[NEXP];
#pragma unroll
            for (int r = 0; r < 16; ++r) { const int e = (r & 3) + 8 * (r >> 2); lg[e] = hh ? oth[r] : mine[r]; lg[e + 4] = hh ? mine[r] : oth[r]; }
            unsigned taken = 0u; float tv[4]; int te[4];
#pragma unroll
            for (int k = 0; k < TOPK; ++k) { float best = -INFINITY; int bi = 0;
#pragma unroll
                for (int e = 0; e < NEXP; ++e) { const bool ok = !((taken >> e) & 1u) && (lg[e] > best); best = ok ? lg[e] : best; bi = ok ? e : bi; }
                taken |= 1u << bi; tv[k] = best; te[k] = bi; }
            const float q1 = __expf(tv[1] - tv[0]), q2 = __expf(tv[2] - tv[0]), q3 = __expf(tv[3] - tv[0]); const float inv = 1.0f / (1.0f + q1 + q2 + q3);
            const float gk[4] = {inv, q1 * inv, q2 * inv, q3 * inv};
            unsigned lp[4] = {0u, 0u, 0u, 0u};
            if (act && hh == 0) {
#pragma unroll
                for (int k = 0; k < TOPK; ++k) lp[k] = __hip_atomic_fetch_add((LAS unsigned*)(lcnt + te[k]), 1u, __ATOMIC_RELAXED, __HIP_MEMORY_SCOPE_WORKGROUP); }
            __syncthreads();
            if (tid < 32) { const unsigned n = lcnt[tid]; lcnt[32 + tid] = n ? atomicAdd(&ctl[CW_CNT + tid], n) : 0u; }
            __syncthreads();
            if (act && hh == 0) { RSTD2[t] = rs;
                unsigned tm[4];
#pragma unroll
                for (int k = 0; k < TOPK; ++k) { const unsigned pos = lcnt[32 + te[k]] + lp[k]; LIST[(size_t)te[k] * T + pos] = (unsigned)t; tm[k] = ((unsigned)te[k] << 16) | pos; }
                *(u32x4*)(TOKMAP + (size_t)t * 4) = (u32x4){tm[0], tm[1], tm[2], tm[3]};
                *(f32x4*)(GATEV + (size_t)t * 4) = (f32x4){gk[0], gk[1], gk[2], gk[3]}; }
            __syncthreads();
        }
        if (ENDBAR(PH_ROUTER)) GRID_BAR();
    }

    volatile LAS int* tab = (volatile LAS int*)(LCTL + 16);
    int Rtot = 0;
    if (IN(PH_G1) || IN(PH_G2) || IN(PH_COMBINE)) {
        if (tid < NEXP) tab[MOE_CNT + tid] = (int)__hip_atomic_load(&ctl[CW_CNT + tid], __ATOMIC_RELAXED, __HIP_MEMORY_SCOPE_AGENT);
        __syncthreads();
        if (tid == 0) { int ts = 0, st = 0;
            for (int e = 0; e < NEXP; ++e) { const int c = tab[MOE_CNT + e]; tab[MOE_TS + e] = ts; tab[MOE_ST + e] = st; ts += (c + 255) >> 8; st += c; }
            tab[MOE_TS + NEXP] = ts; tab[MOE_ST + NEXP] = st; }
        __syncthreads();
        Rtot = tab[MOE_TS + NEXP];
    }
    if (IN(PH_G1) || IN(PH_G2)) {
        __syncthreads();
        for (int rt = tid; rt < Rtot; rt += NWAVES * 64) { int e = 0;
            for (int j = 1; j < NEXP; ++j) if (rt >= tab[MOE_TS + j]) e = j;
            ((volatile LAS unsigned char*)(tab + MOE_RTE))[rt] = (unsigned char)e; }
        __syncthreads();
        if (IN(PH_G1)) for (int rep_ = 0; rep_ < NREP(PH_G1); ++rep_) { ProbMoe1 P{H2F, W1F, B1P, RSTD2, LIST, HID, tab, (LAS unsigned*)(lds + LDSCTL_OFF + 2048), 0, Rtot, G, bx};
            pg8::gemm_phase<ProbMoe1, true>(lds, P, wave);
            if (IN(PH_G2) || NREP(PH_G1) > 1) GRID_BAR(); }
        if (IN(PH_G2)) for (int rep_ = 0; rep_ < NREP(PH_G2); ++rep_) { ProbMoe2 P{HID, W2F, args.in[26], YB, tab, (LAS unsigned*)(lds + LDSCTL_OFF + 2048), 0, Rtot, G, bx};
            pg8::gemm_phase<ProbMoe2, true>(lds, P, wave);
            if (IN(PH_COMBINE) || NREP(PH_G2) > 1) GRID_BAR(); }
    }
    if (IN(PH_COMBINE)) {
        const float* gf = args.in[27];
        const int gw = bx * NWAVES + wave, NGW = G * NWAVES;
        f32x4 gfv[4];
#pragma unroll
        for (int jj = 0; jj < 4; ++jj) gfv[jj] = *((const f32x4*)gf + 4 * lane + jj);
        u32x4 tmn = (u32x4){0u, 0u, 0u, 0u}; f32x4 gkn = (f32x4){0.f, 0.f, 0.f, 0.f};
        if (gw < T) { tmn = *(const u32x4*)(TOKMAP + (size_t)gw * 4); gkn = *(const f32x4*)(GATEV + (size_t)gw * 4); }
        for (int t = gw; t < T; t += NGW) {
            const u32x4 tm = tmn; const f32x4 gk = gkn;
            if (t + NGW < T) { tmn = *(const u32x4*)(TOKMAP + (size_t)(t + NGW) * 4); gkn = *(const f32x4*)(GATEV + (size_t)(t + NGW) * 4); }
            const u32x4* hb = (const u32x4*)(CAT + (size_t)t * DM) + 2 * lane;
            const u32x4 h0 = hb[0], h1 = hb[1];
            u32x4 yv[4];
#pragma unroll
            for (int k = 0; k < TOPK; ++k) { const int e = (int)(tm[k] >> 16), pos = (int)(tm[k] & 0xffffu); const size_t yrow = (size_t)(tab[MOE_ST + e] + pos);
                yv[k] = *((const u32x4*)(YB + yrow * DM) + lane); }
            float v[16];
            v[0] = lo_bf(h0.x); v[1] = hi_bf(h0.x); v[2] = lo_bf(h0.y); v[3] = hi_bf(h0.y); v[4] = lo_bf(h0.z); v[5] = hi_bf(h0.z); v[6] = lo_bf(h0.w); v[7] = hi_bf(h0.w);
            v[8] = lo_bf(h1.x); v[9] = hi_bf(h1.x); v[10] = lo_bf(h1.y); v[11] = hi_bf(h1.y); v[12] = lo_bf(h1.z); v[13] = hi_bf(h1.z); v[14] = lo_bf(h1.w); v[15] = hi_bf(h1.w);
#pragma unroll
            for (int k = 0; k < TOPK; ++k) { const float g16 = gk[k] * (1.0f / 16.0f);
#pragma unroll
                for (int q = 0; q < 4; ++q) { const f32x2 a = __builtin_amdgcn_cvt_pk_f32_fp8((int)yv[k][q], false), b2_ = __builtin_amdgcn_cvt_pk_f32_fp8((int)yv[k][q], true);
                    v[4 * q] += g16 * a[0]; v[4 * q + 1] += g16 * a[1]; v[4 * q + 2] += g16 * b2_[0]; v[4 * q + 3] += g16 * b2_[1]; } }
            float ss = 0.f;
#pragma unroll
            for (int q = 0; q < 16; ++q) ss += v[q] * v[q];
            ss = wave_sum(ss); const float rs = rsqrtf(ss * (1.0f / DM) + EPS);
            f32x4* orow = (f32x4*)(args.out + (size_t)t * DM) + 4 * lane;
#pragma unroll
            for (int jj = 0; jj < 4; ++jj) orow[jj] = (f32x4){v[4 * jj] * rs * gfv[jj][0], v[4 * jj + 1] * rs * gfv[jj][1], v[4 * jj + 2] * rs * gfv[jj][2], v[4 * jj + 3] * rs * gfv[jj][3]};
        }
    }
#undef IN
#undef BOTH
#undef GRID_BAR
#undef lane
#undef tid
}

extern "C" void kernel_launch(void* const* d_in, const int* in_sizes, int n_in, void* d_out, int out_size, void* d_ws, size_t ws_size, hipStream_t stream) {
    static int grid = 0;
    if (grid == 0) {
        if (n_in != 28 || out_size != T * DM || ws_size < WS_END) { fprintf(stderr, "kernel_launch: unexpected shapes: n_in %d out %d ws %zu\n", n_in, out_size, ws_size); grid = -1; return; }
        int dev = 0, cus = 0;
        if (hipGetDevice(&dev) != hipSuccess || hipDeviceGetAttribute(&cus, hipDeviceAttributeMultiprocessorCount, dev) != hipSuccess) { grid = -1; return; }
        if (hipFuncSetAttribute((const void*)fwd, hipFuncAttributeMaxDynamicSharedMemorySize, LDS_BYTES) != hipSuccess) { fprintf(stderr, "kernel_launch: hipFuncSetAttribute failed\n"); grid = -1; return; }
        int per_cu = 0;
        if (hipOccupancyMaxActiveBlocksPerMultiprocessor(&per_cu, (const void*)fwd, NWAVES * 64, LDS_BYTES) != hipSuccess || per_cu < 1) fprintf(stderr, "kernel_launch: occupancy query says %d\n", per_cu);
        (void)hipGetLastError();
        grid = cus;
    }
    if (grid < 0) return;
    (void)hipMemsetAsync((char*)d_ws + WS_CTL, 0, CTL_ZERO_BYTES, stream);
    Args a{};
    for (int i = 0; i < 28; ++i) a.in[i] = (const float*)d_in[i];
    a.out = (float*)d_out; a.ws = (unsigned char*)d_ws;
    unsigned char* ws = (unsigned char*)d_ws;
    auto run = [&](int lo, int hi, int p0, int p1) { a.ph_lo = lo; a.ph_hi = hi; a.pass_lo = p0; a.pass_hi = p1; hipLaunchKernelGGL(fwd, dim3(grid), dim3(NWAVES * 64), LDS_BYTES, stream, a); };
#ifdef MULTI_LAUNCH
    for (int ph = 0; ph < PH_G1; ++ph) run(ph, ph + 1, 0, 0);
    run(PH_G1, PH_G1 + 1, 0, 1); run(PH_G2, PH_G2 + 1, 0, 1);
    run(PH_COMBINE, PH_COMBINE + 1, 0, 0);
#else
    run(0, PH_END, 0, 5);
#endif
}
```

```cpp
#include <hip/hip_runtime.h>
#include <cstdio>
#include <cstdint>
#include <cmath>

#define GAS __attribute__((address_space(1)))
#define LAS __attribute__((address_space(3)))
typedef unsigned short bf16_t;
typedef short bf16x8 __attribute__((ext_vector_type(8)));
typedef float f32x4 __attribute__((ext_vector_type(4)));
typedef float f32x2 __attribute__((ext_vector_type(2)));
typedef unsigned u32x4 __attribute__((ext_vector_type(4)));
typedef unsigned u32x2 __attribute__((ext_vector_type(2)));
typedef int i32x8 __attribute__((ext_vector_type(8)));
typedef int i32x4 __attribute__((ext_vector_type(4)));

constexpr int BATCH = 32, SEQ = 2048, DM = 1024, T = BATCH * SEQ, MEMLEN = 256, MROWS = BATCH * MEMLEN;
constexpr int NPROJ = 3072, DIN = 3080, NP2 = 2048;
constexpr int NEXP = 32, TOPK = 4;
constexpr float EPS = 1e-5f;
constexpr float LAMBDA_INIT = 0.2f;

constexpr size_t MiB = 1u << 20;
constexpr size_t WS_CTL = 0, CTL_ZERO_BYTES = 64 * 1024;
constexpr size_t WS_RSTDX = 1 * MiB;
constexpr size_t WS_RSTDM = WS_RSTDX + (size_t)T * 4;
constexpr size_t WS_B1P = WS_RSTDM + (size_t)MROWS * 4;
constexpr size_t WS_MISC = WS_B1P + (size_t)NEXP * 2048 * 4;
constexpr size_t WS_RSTD2 = WS_MISC + 4096;
static_assert(WS_RSTD2 + (size_t)T * 4 <= 2 * MiB, "small region");
constexpr size_t WS_SSP1 = 2 * MiB;
constexpr size_t WS_SSP2 = 6 * MiB;
constexpr size_t WS_GATES = 10 * MiB;
constexpr size_t WS_TOKMAP = 12 * MiB;
constexpr size_t WS_GATEV = 13 * MiB;
constexpr size_t WS_LIST = 14 * MiB;
constexpr size_t WS_WIN = 24 * MiB;
constexpr size_t WS_WOUT = 30 * MiB;
constexpr size_t WS_WCQ = 32 * MiB;
constexpr size_t WS_WCKV = 34 * MiB;
constexpr size_t WS_WCO = 38 * MiB;
constexpr size_t WS_WR = 40 * MiB;
constexpr size_t WS_W1 = 64 * MiB;
constexpr size_t WS_H2F = 128 * MiB;
constexpr size_t WS_W2 = 192 * MiB;
constexpr size_t WS_XB = 256 * MiB;
constexpr size_t WS_PROJ = 384 * MiB;
constexpr size_t WS_H1F = 640 * MiB;
constexpr size_t WS_VT1 = 640 * MiB;
constexpr size_t WS_CAT = 768 * MiB;
constexpr size_t WS_MST = 896 * MiB;
constexpr size_t WS_MEMB = 962 * MiB;
constexpr size_t WS_KV = 978 * MiB;
constexpr size_t WS_VT2 = 994 * MiB;
constexpr size_t WS_QM = 128 * MiB;
constexpr size_t WS_KM = 160 * MiB;
constexpr size_t WS_CSTB = 224 * MiB;
constexpr size_t WS_BC = 1010 * MiB;
constexpr size_t WS_AV = 1011 * MiB;
constexpr size_t WS_AM = 1012 * MiB;
constexpr size_t WS_NLOC = 1013 * MiB;
constexpr size_t WS_NST = WS_NLOC + 512 * 1024;
constexpr size_t WS_CH = 1014 * MiB;
constexpr size_t WS_MSTATE = WS_CH + 64 * 1024;
constexpr size_t WS_Y = 256 * MiB;
constexpr size_t WS_HID = 512 * MiB;
constexpr size_t WS_HID1 = 896 * MiB;
constexpr size_t WS_END = 1024 * MiB;

constexpr int CW_CNT = 64;
constexpr int CW_BAR = 4096;
static_assert((CW_BAR + 3456) * 4 <= (int)CTL_ZERO_BYTES, "control words inside the per-call memset");

__device__ __forceinline__ float bf2f(bf16_t b) { return __uint_as_float(((unsigned)b) << 16); }
__device__ __forceinline__ unsigned f2bf(float f) { unsigned u = __float_as_uint(f); return (u + 0x7fffu + ((u >> 16) & 1u)) >> 16; }
__device__ __forceinline__ unsigned cvt_pk_bf16(float lo, float hi) { unsigned r; asm volatile("v_cvt_pk_bf16_f32 %0, %1, %2" : "=v"(r) : "v"(lo), "v"(hi)); return r; }
__device__ __forceinline__ float x32_sum(float v) { auto r = __builtin_amdgcn_permlane32_swap(__float_as_uint(v), __float_as_uint(v), false, false); return __uint_as_float(r[0]) + __uint_as_float(r[1]); }
__device__ __forceinline__ float x32_max(float v) { auto r = __builtin_amdgcn_permlane32_swap(__float_as_uint(v), __float_as_uint(v), false, false); return fmaxf(__uint_as_float(r[0]), __uint_as_float(r[1])); }
__device__ __forceinline__ float x32_other(float v, int hh) { auto r = __builtin_amdgcn_permlane32_swap(__float_as_uint(v), __float_as_uint(v), false, false); return hh ? __uint_as_float(r[0]) : __uint_as_float(r[1]); }
__device__ __forceinline__ float x16_sum(float v) { auto r = __builtin_amdgcn_permlane16_swap(__float_as_uint(v), __float_as_uint(v), false, false); return __uint_as_float(r[0]) + __uint_as_float(r[1]); }
__device__ __forceinline__ float row16_sum(float v) {
    v += __uint_as_float((unsigned)__builtin_amdgcn_update_dpp(0, (int)__float_as_uint(v), 0xB1, 0xf, 0xf, true));
    v += __uint_as_float((unsigned)__builtin_amdgcn_update_dpp(0, (int)__float_as_uint(v), 0x4E, 0xf, 0xf, true));
    v += __uint_as_float((unsigned)__builtin_amdgcn_update_dpp(0, (int)__float_as_uint(v), 0x141, 0xf, 0xf, true));
    v += __uint_as_float((unsigned)__builtin_amdgcn_update_dpp(0, (int)__float_as_uint(v), 0x140, 0xf, 0xf, true));
    return v; }
__device__ __forceinline__ float wave_sum(float v) { return x32_sum(x16_sum(row16_sum(v))); }
__device__ __forceinline__ int lane_id() { int l; asm volatile("v_mbcnt_lo_u32_b32 %0, -1, 0\n\tv_mbcnt_hi_u32_b32 %0, -1, %0" : "=v"(l)); return l; }
__device__ __forceinline__ float c8(float x) { return __builtin_amdgcn_fmed3f(x, -448.0f, 448.0f); }
__device__ __forceinline__ float lo_bf(unsigned w) { return __uint_as_float(w << 16); }
__device__ __forceinline__ float hi_bf(unsigned w) { return __uint_as_float(w & 0xffff0000u); }

namespace pg8 {
constexpr int BM = 256, BK = 64, HALF = 128, HTB = HALF * BK * 2, STAGE_BYTES = 8 * HTB, NXCD = 8, WGM = 8, KD = 1024, NT = KD / BK;
__host__ __device__ __forceinline__ int lds_byte(int r, int c) { const int st = (r >> 4) * 2 + (c >> 5), rr = r & 15, cc = c & 31, ob = rr * 64 + cc * 2; return st * 1024 + (ob ^ (((ob >> 9) & 1) << 5)); }
__host__ __device__ __forceinline__ void stage_rc(int b, int& R, int& C) { const int st = b / 1024, sb = b % 1024, swz = sb ^ (((sb >> 9) & 1) << 5); R = (st >> 1) * 16 + swz / 64; C = (st & 1) * 32 + (swz % 64) / 2; }
__host__ __device__ __forceinline__ int perm32(int rho) { const int n = rho >> 4, i = rho & 15; return 8 * (i >> 2) + 4 * n + (i & 3); }

template <class P, class = void> struct has_ablk { static constexpr bool v = false; };
template <class P> struct has_ablk<P, decltype((void)P::ABLK)> { static constexpr bool v = true; };
struct Unit { const char* A; const char* B; int pm, pn, e, nvalid, y0, aux; };

__device__ __forceinline__ bool static_next(int i, int G, int c, int nM, int nN, int& pm, int& pn) {
    const int nwg = nM * nN; const long L = (long)i * G + c; if (L >= nwg) return false;
    int wgid = (int)L; { const int q = nwg / NXCD, r = nwg % NXCD, xcd = wgid % NXCD, off = wgid / NXCD; wgid = (xcd < r ? xcd * (q + 1) : r * (q + 1) + (xcd - r) * q) + off; }
    const int nig = WGM * nN, gid = wgid / nig, fm = gid * WGM, gsz = (nM - fm) < WGM ? (nM - fm) : WGM;
    pm = fm + ((wgid % nig) % gsz); pn = (wgid % nig) / gsz; return true;
}

template <class P, bool ALIGN_EPI>
__device__ __forceinline__ void gemm_phase(LAS unsigned char* lds, const P& prob, const int wid) {
    const int lane = lane_id(), tid = wid * 64 + lane, wr = wid >> 2, wc = wid & 3, fr = lane & 15, fq = lane >> 4;
    constexpr int ROWB = P::FP8 ? KD : 2 * KD;
    constexpr int nt = ROWB / 128;
    int RA[2], CA[2]; unsigned voffA[2], voffB[2];
#pragma unroll
    for (int i = 0; i < 2; ++i) { int R, C; stage_rc(tid * 16 + i * 8192, R, C); const int Rb = P::ADJ ? (64 * (R >> 5) + perm32(R & 31)) : P::PERM ? ((R & ~31) + perm32(R & 31)) : R;
        RA[i] = R; CA[i] = has_ablk<P>::v ? (((C * 2) >> 5) * 8192 + ((C * 2) & 31)) : C * 2; voffA[i] = (unsigned)(R * ROWB + C * 2); voffB[i] = (unsigned)(Rb * ROWB + C * 2); }
    constexpr int kstep = BK * 2;
    constexpr int akstep = has_ablk<P>::v ? 4 * 8192 : kstep;
    constexpr size_t hstep = (size_t)HALF * ROWB;
    constexpr size_t bhstep = P::ADJ ? (size_t)32 * ROWB : hstep;
    const unsigned ldsw = (unsigned)wid * 1024u;
    const int aoff = lds_byte(wr * 64 + fr, fq * 8), boff = lds_byte(wc * 32 + fr, fq * 8);
#define PG8_SA(b, h) (((b) * 2 + (h)) * HTB)
#define PG8_SB(b, h) ((4 + (b) * 2 + (h)) * HTB)
#define PG8_STAGE_B(bufoff, gbase) do { _Pragma("unroll") for (int _i = 0; _i < 2; ++_i) \
        __builtin_amdgcn_global_load_lds((const unsigned*)((const char*)(gbase) + voffB[_i]), (LAS unsigned*)(lds + (bufoff) + ldsw + _i * 8192), 16, 0, 0); } while (0)
#define PG8_STAGE_A(bufoff, gbase, off, h) do { _Pragma("unroll") for (int _i = 0; _i < 2; ++_i) { const char* _p; \
        if constexpr (P::GATHER) _p = (const char*)(gbase) + (off)[h][_i]; else _p = (const char*)(gbase) + (size_t)(h) * hstep + voffA[_i]; \
        __builtin_amdgcn_global_load_lds((const unsigned*)_p, (LAS unsigned*)(lds + (bufoff) + ldsw + _i * 8192), 16, 0, 0); } } while (0)
#define PG8_LDA(dst, b, h) do { _Pragma("unroll") for (int m = 0; m < 4; ++m) _Pragma("unroll") for (int k = 0; k < 2; ++k) dst[m][k] = *(const LAS bf16x8*)(lds + PG8_SA(b, h) + aoff + m * 2048 + k * 1024); } while (0)
#define PG8_LDB(dst, b, h) do { _Pragma("unroll") for (int n = 0; n < 2; ++n) _Pragma("unroll") for (int k = 0; k < 2; ++k) dst[n][k] = *(const LAS bf16x8*)(lds + PG8_SB(b, h) + boff + n * 2048 + k * 1024); } while (0)
#define PG8_MMA(ai, bj, At, Bt) do { __builtin_amdgcn_s_setprio(1); _Pragma("unroll") for (int m = 0; m < 4; ++m) _Pragma("unroll") for (int n = 0; n < 2; ++n) { \
        if constexpr (P::FP8) { const i32x4 b0_ = __builtin_bit_cast(i32x4, Bt[n][0]), b1_ = __builtin_bit_cast(i32x4, Bt[n][1]), a0_ = __builtin_bit_cast(i32x4, At[m][0]), a1_ = __builtin_bit_cast(i32x4, At[m][1]); \
            acc[ai][bj][m][n] = __builtin_amdgcn_mfma_scale_f32_16x16x128_f8f6f4((i32x8){b0_[0], b0_[1], b0_[2], b0_[3], b1_[0], b1_[1], b1_[2], b1_[3]}, (i32x8){a0_[0], a0_[1], a0_[2], a0_[3], a1_[0], a1_[1], a1_[2], a1_[3]}, \
                acc[ai][bj][m][n], 0, 0, 0, 0x7f7f7f7f, 0, 0x7f7f7f7f); } \
        else { _Pragma("unroll") for (int k = 0; k < 2; ++k) acc[ai][bj][m][n] = __builtin_amdgcn_mfma_f32_16x16x32_bf16(Bt[n][k], At[m][k], acc[ai][bj][m][n], 0, 0, 0); } } \
        __builtin_amdgcn_s_setprio(0); } while (0)
#define PG8_WAIT_V(n) do { asm volatile("" ::: "memory"); __builtin_amdgcn_s_waitcnt(((n) & 15) | (7 << 4) | (15 << 8) | (((n) >> 4) << 14)); asm volatile("" ::: "memory"); } while (0)
#define PG8_WAIT_L(n) asm volatile("s_waitcnt lgkmcnt(" #n ")" ::: "memory")
#define PG8_BAR __builtin_amdgcn_s_barrier()
#define PG8_SCHED __builtin_amdgcn_sched_barrier(0)
    Unit cur, nxt; int ui = 0;
    if (!prob.next(0, cur)) return;
    f32x4 acc[2][2][4][2];
#pragma unroll
    for (int a = 0; a < 2; ++a)
#pragma unroll
        for (int b = 0; b < 2; ++b)
#pragma unroll
            for (int m = 0; m < 4; ++m)
#pragma unroll
                for (int n = 0; n < 2; ++n) acc[a][b][m][n] = (f32x4){0.f, 0.f, 0.f, 0.f};
    bf16x8 At[4][2], B0[2][2], B1[2][2];
    unsigned offC[2][2] = {{0u, 0u}, {0u, 0u}};
#define PG8_FILL(u, buf) do { if (tid < 256) { if constexpr (P::GATHER) prob.gtab[(buf) * 256 + tid] = prob.a_off(u, tid); \
        if constexpr (P::ETAB) ((LAS float*)prob.gtab)[768 + (buf) * 256 + tid] = prob.e_val(u, tid); } } while (0)
#define PG8_OFFS(buf) do { _Pragma("unroll") for (int _h = 0; _h < 2; ++_h) _Pragma("unroll") for (int _i = 0; _i < 2; ++_i) offC[_h][_i] = prob.gtab[(buf) * 256 + _h * HALF + RA[_i]] + (unsigned)CA[_i]; } while (0)
    Unit nx2;
    bool has_next = prob.next(1, nxt);
    if constexpr (P::GATHER || P::ETAB) { PG8_FILL(cur, 0); if (has_next) PG8_FILL(nxt, 1); PG8_WAIT_L(0); PG8_BAR; if constexpr (P::GATHER) PG8_OFFS(0); }
    const char* cA = prob.a_tile(cur); const char* cB = cur.B;
    PG8_STAGE_B(PG8_SB(0, 0), cB); PG8_STAGE_B(PG8_SB(0, 1), cB + bhstep); PG8_STAGE_A(PG8_SA(0, 0), cA, offC, 0); PG8_STAGE_A(PG8_SA(0, 1), cA, offC, 1);
    if (wr == 1) PG8_BAR;
    PG8_WAIT_V(2); PG8_BAR;
    PG8_STAGE_B(PG8_SB(1, 0), cB + kstep); PG8_STAGE_A(PG8_SA(1, 0), cA + akstep, offC, 0); PG8_STAGE_B(PG8_SB(1, 1), cB + bhstep + kstep);
    PG8_WAIT_V(6); PG8_BAR;
    int bcur = 0;
    for (;;) {
        const bool has_nx2 = has_next && prob.next(ui + 2, nx2);
        const char* nA = has_next ? prob.a_tile(nxt) : cA; const char* nB = has_next ? nxt.B : cB;
        const int bnext = bcur == 2 ? 0 : bcur + 1, bnx2 = bnext == 2 ? 0 : bnext + 1;
        unsigned fg_ = 0u; float fe_ = 0.f; const bool fill_ = has_nx2 && tid < 256;
        if constexpr (P::GATHER) { if (fill_) fg_ = prob.a_off(nx2, tid); }
        if constexpr (P::ETAB) { if (fill_) fe_ = prob.e_val(nx2, tid); }
#pragma unroll 1
        for (int t = 0; t < nt; t += 2) {
            const bool last = (t == nt - 2);
            const char* a1 = cA + (size_t)(t + 1) * akstep;
            const char* a2 = last ? nA : cA + (size_t)(t + 2) * akstep; const char* b2 = last ? nB : cB + (size_t)(t + 2) * kstep;
            const char* a3 = a2 + akstep; const char* b3 = b2 + kstep;
            const bool ae = P::NST > 0 && t == 0 && ui > 0;
            PG8_LDB(B0, 0, 0); PG8_LDB(B1, 0, 1); PG8_SCHED; PG8_LDA(At, 0, 0); PG8_STAGE_A(PG8_SA(1, 1), a1, offC, 1);
            if constexpr (P::GATHER) { if (last && has_next) PG8_OFFS(bnext); }
            if (ae) PG8_WAIT_V(8 + P::NST); else PG8_WAIT_V(8);
            PG8_WAIT_L(0); PG8_BAR; PG8_MMA(0, 0, At, B0); PG8_MMA(0, 1, At, B1); PG8_BAR; PG8_SCHED;
            PG8_LDA(At, 0, 1); PG8_STAGE_B(PG8_SB(0, 0), b2); PG8_STAGE_B(PG8_SB(0, 1), b2 + bhstep); PG8_STAGE_A(PG8_SA(0, 0), a2, offC, 0);
            if (ae) PG8_WAIT_V(8 + P::NST); else PG8_WAIT_V(8);
            PG8_WAIT_L(0); PG8_BAR; PG8_MMA(1, 0, At, B0); PG8_MMA(1, 1, At, B1); PG8_BAR; PG8_SCHED;
            PG8_LDB(B0, 1, 0); PG8_LDB(B1, 1, 1); PG8_SCHED; PG8_LDA(At, 1, 0); PG8_STAGE_A(PG8_SA(0, 1), a2, offC, 1);
            PG8_WAIT_V(8); PG8_WAIT_L(0); PG8_BAR; PG8_MMA(0, 0, At, B0); PG8_MMA(0, 1, At, B1); PG8_BAR; PG8_SCHED;
            PG8_LDA(At, 1, 1); PG8_STAGE_B(PG8_SB(1, 0), b3); PG8_STAGE_B(PG8_SB(1, 1), b3 + bhstep); PG8_STAGE_A(PG8_SA(1, 0), a3, offC, 0);
            PG8_WAIT_V(8); PG8_WAIT_L(0); PG8_BAR; PG8_MMA(1, 0, At, B0); PG8_MMA(1, 1, At, B1); PG8_BAR; PG8_SCHED;
        }
        if constexpr (ALIGN_EPI) { if (wr == 0) PG8_BAR; }
        if constexpr (P::GATHER) { if (fill_) prob.gtab[bnx2 * 256 + tid] = fg_; }
        if constexpr (P::ETAB) { if (fill_) ((LAS float*)prob.gtab)[768 + bnx2 * 256 + tid] = fe_; }
        cur.aux = bcur;
        prob.epi(acc, cur, wr, wc, fr, fq);
        if (!has_next) break;
#pragma unroll
        for (int a = 0; a < 2; ++a)
#pragma unroll
            for (int b = 0; b < 2; ++b)
#pragma unroll
                for (int m = 0; m < 4; ++m)
#pragma unroll
                    for (int n = 0; n < 2; ++n) acc[a][b][m][n] = (f32x4){0.f, 0.f, 0.f, 0.f};
        cur = nxt; nxt = nx2; has_next = has_nx2; cA = nA; cB = nB; ++ui; bcur = bnext;
        if constexpr (ALIGN_EPI) { if (wr == 1) PG8_BAR; }
    }
    PG8_WAIT_V(0);
    if constexpr (!ALIGN_EPI) { if (wr == 0) PG8_BAR; }
    PG8_BAR;
#undef PG8_SA
#undef PG8_SB
#undef PG8_STAGE_A
#undef PG8_STAGE_B
#undef PG8_LDA
#undef PG8_LDB
#undef PG8_MMA
#undef PG8_WAIT_V
#undef PG8_WAIT_L
#undef PG8_BAR
#undef PG8_SCHED
#undef PG8_OFFS
#undef PG8_FILL
}
}

__device__ __forceinline__ void store_block16(char* base, size_t rowstride, const u32x4& w0, const u32x4& w1, int fr, int fq) {
    u32x4 rx;
#pragma unroll
    for (int d = 0; d < 4; ++d) rx[d] = (unsigned)__builtin_amdgcn_update_dpp(0, (int)w1[d], 0x128, 0xf, 0xf, true);
    const bool low = fr < 8;
    u32x4 da, db;
#pragma unroll
    for (int d = 0; d < 4; ++d) { da[d] = low ? w0[d] : rx[d]; db[d] = low ? rx[d] : w0[d]; }
    const unsigned ca = (low ? 0u : 64u) + 16u * (unsigned)fq, cb = (low ? 64u : 0u) + 16u * (unsigned)fq;
    *(u32x4*)(base + (size_t)(fr & 7) * rowstride + ca) = da;
    *(u32x4*)(base + (size_t)(8 + (fr & 7)) * rowstride + cb) = db;
}
template <bool F8> struct ProbScaleT {
    static constexpr bool FP8 = F8, PERM = true, GATHER = F8, ETAB = true, ADJ = true;
    static constexpr int NST = F8 ? 0 : 16;
    static constexpr int RB = F8 ? 1024 : 2048;
    __device__ __forceinline__ const char* a_tile(const pg8::Unit& u) const { return F8 ? u.A : u.A + (size_t)u.pm * (256 * RB); }
    LAS unsigned* gtab;
    const void* A; const void* Bt; int nM, nN, G, c;
    bf16_t* O; int ldo; const float* rstd; const float* ssp;
    __device__ __forceinline__ bool next(int i, pg8::Unit& u) const {
        int pm, pn; if (!pg8::static_next(i, G, c, nM, nN, pm, pn)) return false;
        u.A = (const char*)A; u.B = (const char*)Bt + (size_t)pn * 256 * RB; u.pm = pm; u.pn = pn; u.e = 0; u.nvalid = 256; u.y0 = 0; u.aux = 0; return true; }
    __device__ __forceinline__ unsigned a_off(const pg8::Unit& u, int r) const { return (unsigned)(u.pm * 256 + r) * (unsigned)RB; }
    __device__ __forceinline__ float e_val(const pg8::Unit& u, int r) const {
        const int row = u.pm * 256 + r; float sc;
        if (rstd) sc = rstd[row];
        else { const f32x4* p = (const f32x4*)(ssp + (size_t)row * 16); const f32x4 a = p[0], b = p[1], c2 = p[2], d = p[3];
            const float sq = (((a[0] + a[1]) + (a[2] + a[3])) + ((b[0] + b[1]) + (b[2] + b[3]))) + (((c2[0] + c2[1]) + (c2[2] + c2[3])) + ((d[0] + d[1]) + (d[2] + d[3])));
            sc = rsqrtf(sq * (1.0f / 1024.0f) + EPS); }
        return sc * (F8 ? (1.0f / 64.0f) : 1.0f); }
    __device__ __forceinline__ void epi(const f32x4 (&acc)[2][2][4][2], const pg8::Unit& u, int wr, int wc, int fr, int fq) const {
        asm volatile("" : "+v"(fr), "+v"(fq));
        const int rowu = u.pm * 256 + wr * 64;
        char* ub = (char*)O + ((size_t)rowu * ldo + u.pn * 256 + wc * 64) * 2;
        const LAS float* et = (const LAS float*)gtab + 768 + u.aux * 256 + wr * 64 + fr;
        float rsv[8];
#pragma unroll
        for (int q = 0; q < 8; ++q) rsv[q] = et[(q >> 2) * 128 + (q & 3) * 16];
#pragma unroll
        for (int ai = 0; ai < 2; ++ai)
#pragma unroll
            for (int m = 0; m < 4; ++m) { const float rs = rsv[ai * 4 + m];
                if constexpr (F8) {
                    unsigned pk[2][2];
#pragma unroll
                    for (int bj = 0; bj < 2; ++bj) { const f32x4 v0 = acc[ai][bj][m][0] * rs, v1 = acc[ai][bj][m][1] * rs; unsigned w0 = 0u, w1 = 0u;
                        w0 = __builtin_amdgcn_cvt_pk_fp8_f32(c8(v0[0]), c8(v0[1]), w0, false); w0 = __builtin_amdgcn_cvt_pk_fp8_f32(c8(v0[2]), c8(v0[3]), w0, true);
                        w1 = __builtin_amdgcn_cvt_pk_fp8_f32(c8(v1[0]), c8(v1[1]), w1, false); w1 = __builtin_amdgcn_cvt_pk_fp8_f32(c8(v1[2]), c8(v1[3]), w1, true);
                        pk[bj][0] = w0; pk[bj][1] = w1; }
                    const auto s0 = __builtin_amdgcn_permlane16_swap(pk[0][0], pk[1][0], false, false), s1 = __builtin_amdgcn_permlane16_swap(pk[0][1], pk[1][1], false, false);
                    *(u32x4*)((char*)O + ((size_t)rowu + ai * 128 + m * 16 + fr) * ldo + u.pn * 256 + wc * 64 + 8 * fq + ((fq & 1) ? 24 : 0)) = (u32x4){s0[0], s1[0], s0[1], s1[1]};
                } else {
                u32x4 w[2];
#pragma unroll
                for (int bj = 0; bj < 2; ++bj) { const f32x4 v0 = acc[ai][bj][m][0] * rs, v1 = acc[ai][bj][m][1] * rs;
                    w[bj].x = cvt_pk_bf16(v0[0], v0[1]); w[bj].y = cvt_pk_bf16(v0[2], v0[3]); w[bj].z = cvt_pk_bf16(v1[0], v1[1]); w[bj].w = cvt_pk_bf16(v1[2], v1[3]); }
                store_block16(ub + (size_t)(ai * 128 + m * 16) * ldo * 2, (size_t)ldo * 2, w[0], w[1], fr, fq); } }
    }
};
typedef ProbScaleT<false> ProbScaleBf16;
struct ProbColScaleBf16 {
    static constexpr bool FP8 = false, PERM = true, GATHER = false, ETAB = true, ADJ = true;
    static constexpr int NST = 16;
    __device__ __forceinline__ const char* a_tile(const pg8::Unit& u) const { return u.A + (size_t)u.pm * (256 * 2048); }
    LAS unsigned* gtab;
    const bf16_t* A; const bf16_t* Bt; int nM, nN, G, c;
    bf16_t* O; int ldo; const float* cs;
    __device__ __forceinline__ bool next(int i, pg8::Unit& u) const {
        const long L = (long)i * G + c; if (L >= (long)nM * nN) return false;
        const int pm = (int)(L % nM), pn = (int)(L / nM);
        u.A = (const char*)A; u.B = (const char*)(Bt + (size_t)pn * 256 * 1024); u.pm = pm; u.pn = pn; u.e = 0; u.nvalid = 256; u.y0 = 0; u.aux = 0; return true; }
    __device__ __forceinline__ unsigned a_off(const pg8::Unit& u, int r) const { return 0u; }
    __device__ __forceinline__ float e_val(const pg8::Unit& u, int r) const { return cs[u.pn * 256 + r]; }
    __device__ __forceinline__ void epi(const f32x4 (&acc)[2][2][4][2], const pg8::Unit& u, int wr, int wc, int fr, int fq) const {
        asm volatile("" : "+v"(fr), "+v"(fq));
        const LAS float* cp = (const LAS float*)gtab + 768 + u.aux * 256 + wc * 64 + 8 * fq;
        f32x4 sc[2][2];
#pragma unroll
        for (int bj = 0; bj < 2; ++bj)
#pragma unroll
            for (int n = 0; n < 2; ++n) sc[bj][n] = *(const LAS f32x4*)(cp + bj * 32 + 4 * n);
        char* ub = (char*)O + ((size_t)(u.pm * 256 + wr * 64) * ldo + u.pn * 256 + wc * 64) * 2;
#pragma unroll
        for (int ai = 0; ai < 2; ++ai)
#pragma unroll
            for (int m = 0; m < 4; ++m) { u32x4 w[2];
#pragma unroll
                for (int bj = 0; bj < 2; ++bj) { const f32x4 v0 = acc[ai][bj][m][0] * sc[bj][0], v1 = acc[ai][bj][m][1] * sc[bj][1];
                    w[bj].x = cvt_pk_bf16(v0[0], v0[1]); w[bj].y = cvt_pk_bf16(v0[2], v0[3]); w[bj].z = cvt_pk_bf16(v1[0], v1[1]); w[bj].w = cvt_pk_bf16(v1[2], v1[3]); }
                store_block16(ub + (size_t)(ai * 128 + m * 16) * ldo * 2, (size_t)ldo * 2, w[0], w[1], fr, fq); }
    }
};
struct ProbKV {
    static constexpr int NST = 0;
    static constexpr bool FP8 = true, PERM = true, GATHER = true, ETAB = false, ADJ = false;
    __device__ __forceinline__ const char* a_tile(const pg8::Unit& u) const { return u.A; }
    LAS unsigned* gtab;
    const unsigned char* memb; const unsigned char* wckv; bf16_t* Kout; bf16_t* VTout; const float* rstdm; int G, c;
    __device__ __forceinline__ bool next(int i, pg8::Unit& u) const {
        const long L = (long)i * G + c; if (L >= 256) return false;
        if (L < 128) { u.pm = (int)(L & 31); u.pn = (int)(L >> 5); u.e = 0; u.A = (const char*)memb; u.B = (const char*)(wckv + (size_t)u.pn * 256 * 1024); }
        else { const int l2 = (int)L - 128; u.pm = l2 & 3; u.pn = l2 >> 2; u.e = 1; u.A = (const char*)(wckv + (size_t)1024 * 1024); u.B = (const char*)(memb + (size_t)u.pn * 256 * 1024); }
        u.nvalid = 256; u.y0 = 0; u.aux = 0; return true; }
    __device__ __forceinline__ unsigned a_off(const pg8::Unit& u, int r) const { return (unsigned)(u.pm * 256 + r) * 1024u; }
    __device__ __forceinline__ void epi(const f32x4 (&acc)[2][2][4][2], const pg8::Unit& u, int wr, int wc, int fr, int fq) const {
        asm volatile("" : "+v"(fr), "+v"(fq));
        const int ldo = u.e ? MROWS : 1024;
        float rsv[8]; f32x4 sc[2][2];
        if (u.e == 0) {
#pragma unroll
            for (int q = 0; q < 8; ++q) rsv[q] = rstdm[u.pm * 256 + wr * 64 + fr + (q >> 2) * 128 + (q & 3) * 16] * (1.0f / 64.0f);
#pragma unroll
            for (int bj = 0; bj < 2; ++bj)
#pragma unroll
                for (int n = 0; n < 2; ++n) sc[bj][n] = (f32x4){1.f, 1.f, 1.f, 1.f};
        } else {
#pragma unroll
            for (int q = 0; q < 8; ++q) rsv[q] = 1.0f / 64.0f;
            const float* cp = rstdm + u.pn * 256 + wc * 32 + 8 * fq;
#pragma unroll
            for (int bj = 0; bj < 2; ++bj)
#pragma unroll
                for (int n = 0; n < 2; ++n) sc[bj][n] = *(const f32x4*)(cp + bj * 128 + 4 * n); }
        unsigned char* kb8 = (unsigned char*)(u.e ? VTout : Kout) + ((size_t)(u.pm * 256 + wr * 64) * ldo + u.pn * 256 + wc * 32) + (size_t)(fr * ldo + 8 * fq);
#pragma unroll
        for (int ai = 0; ai < 2; ++ai)
#pragma unroll
            for (int m = 0; m < 4; ++m) { const float rs = rsv[ai * 4 + m];
#pragma unroll
                for (int bj = 0; bj < 2; ++bj) { const f32x4 v0 = acc[ai][bj][m][0] * sc[bj][0] * rs, v1 = acc[ai][bj][m][1] * sc[bj][1] * rs;
                    unsigned w0 = 0u, w1 = 0u;
                    w0 = __builtin_amdgcn_cvt_pk_fp8_f32(c8(v0[0]), c8(v0[1]), w0, false); w0 = __builtin_amdgcn_cvt_pk_fp8_f32(c8(v0[2]), c8(v0[3]), w0, true);
                    w1 = __builtin_amdgcn_cvt_pk_fp8_f32(c8(v1[0]), c8(v1[1]), w1, false); w1 = __builtin_amdgcn_cvt_pk_fp8_f32(c8(v1[2]), c8(v1[3]), w1, true);
                    *(u32x2*)(kb8 + (size_t)(ai * 128 + m * 16) * ldo + bj * 128) = (u32x2){w0, w1}; } }
    }
};
template <bool F8, bool WF8, bool RF32> struct ProbResidT {
    static constexpr bool FP8 = F8, PERM = true, GATHER = F8, ETAB = false, ADJ = false;
    static constexpr int NST = F8 ? 0 : 16 + (WF8 ? 8 : 0) + 8;
    static constexpr int RB = F8 ? 1024 : 2048;
    __device__ __forceinline__ const char* a_tile(const pg8::Unit& u) const { return F8 ? u.A : u.A + (size_t)u.pm * (256 * RB); }
    LAS unsigned* gtab;
    const void* A; const void* Bt; int nM, nN, G, c;
    const float* rf; const bf16_t* rb; bf16_t* ob; unsigned char* of8; float* ssp;
    __device__ __forceinline__ bool next(int i, pg8::Unit& u) const {
        int pm, pn; if (!pg8::static_next(i, G, c, nM, nN, pm, pn)) return false;
        u.A = (const char*)A; u.B = (const char*)Bt + (size_t)pn * 256 * RB; u.pm = pm; u.pn = pn; u.e = 0; u.nvalid = 256; u.y0 = 0; u.aux = 0; return true; }
    __device__ __forceinline__ unsigned a_off(const pg8::Unit& u, int r) const { return (unsigned)(u.pm * 256 + r) * (unsigned)RB; }
    __device__ __forceinline__ void epi(const f32x4 (&acc)[2][2][4][2], const pg8::Unit& u, int wr, int wc, int fr, int fq) const {
        asm volatile("" : "+v"(fr), "+v"(fq));
        const int rowu = u.pm * 256 + wr * 64;
        const size_t uoff = (size_t)rowu * 1024 + u.pn * 256 + wc * 32;
        const unsigned lo = (unsigned)(fr * 1024 + 8 * fq);
        const float sc = F8 ? (1.0f / 64.0f) : 1.0f;
        u32x4 rw[2][4][2];
        if constexpr (!RF32) {
#pragma unroll
            for (int ai = 0; ai < 2; ++ai)
#pragma unroll
                for (int m = 0; m < 4; ++m)
#pragma unroll
                    for (int bj = 0; bj < 2; ++bj) rw[ai][m][bj] = *(const GAS u32x4*)(rb + uoff + (size_t)(ai * 128 + m * 16) * 1024 + lo + bj * 128); }
#pragma unroll
        for (int ai = 0; ai < 2; ++ai) {
            f32x4 rv[4][2][2];
#pragma unroll
            for (int m = 0; m < 4; ++m) { const size_t ro = uoff + (size_t)(ai * 128 + m * 16) * 1024;
#pragma unroll
                for (int bj = 0; bj < 2; ++bj) {
                    if constexpr (RF32) { rv[m][bj][0] = *(const GAS f32x4*)(rf + ro + lo + bj * 128); rv[m][bj][1] = *(const GAS f32x4*)(rf + ro + lo + bj * 128 + 4); }
                    else { const u32x4 w = rw[ai][m][bj]; rv[m][bj][0] = (f32x4){lo_bf(w.x), hi_bf(w.x), lo_bf(w.y), hi_bf(w.y)}; rv[m][bj][1] = (f32x4){lo_bf(w.z), hi_bf(w.z), lo_bf(w.w), hi_bf(w.w)}; } } }
#pragma unroll
            for (int m = 0; m < 4; ++m) { const size_t ro = uoff + (size_t)(ai * 128 + m * 16) * 1024; float ss = 0.f;
                unsigned pk[2][2];
#pragma unroll
                for (int bj = 0; bj < 2; ++bj) { const f32x4 v0 = acc[ai][bj][m][0] * sc + rv[m][bj][0], v1 = acc[ai][bj][m][1] * sc + rv[m][bj][1];
                    ss += (v0[0] * v0[0] + v0[1] * v0[1]) + (v0[2] * v0[2] + v0[3] * v0[3]) + (v1[0] * v1[0] + v1[1] * v1[1]) + (v1[2] * v1[2] + v1[3] * v1[3]);
                    u32x4 w; w.x = cvt_pk_bf16(v0[0], v0[1]); w.y = cvt_pk_bf16(v0[2], v0[3]); w.z = cvt_pk_bf16(v1[0], v1[1]); w.w = cvt_pk_bf16(v1[2], v1[3]);
                    *(u32x4*)(ob + ro + lo + bj * 128) = w;
                    if constexpr (WF8) { unsigned w0 = 0u, w1 = 0u;
                        w0 = __builtin_amdgcn_cvt_pk_fp8_f32(c8(v0[0]), c8(v0[1]), w0, false); w0 = __builtin_amdgcn_cvt_pk_fp8_f32(c8(v0[2]), c8(v0[3]), w0, true);
                        w1 = __builtin_amdgcn_cvt_pk_fp8_f32(c8(v1[0]), c8(v1[1]), w1, false); w1 = __builtin_amdgcn_cvt_pk_fp8_f32(c8(v1[2]), c8(v1[3]), w1, true);
                        pk[bj][0] = w0; pk[bj][1] = w1; } }
                if constexpr (WF8) {
                    const auto s0 = __builtin_amdgcn_permlane16_swap(pk[0][0], pk[1][0], false, false), s1 = __builtin_amdgcn_permlane16_swap(pk[0][1], pk[1][1], false, false);
                    *(u32x4*)(of8 + ro + lo + ((fq & 1) ? 120u : 0u)) = (u32x4){s0[0], s1[0], s0[1], s1[1]}; }
                ss = x16_sum(ss); ss = x32_sum(ss);
                if (fq == 0) ssp[(size_t)(rowu + ai * 128 + m * 16 + fr) * 16 + u.pn * 4 + wc] = ss; } }
    }
};
__device__ __forceinline__ size_t hid_tile_off(int rt) { return rt < 1024 ? (size_t)rt * (256 * 1024) : (WS_HID1 - WS_HID) + (size_t)(rt - 1024) * (256 * 1024); }
constexpr int MOE_TS = 0, MOE_ST = 33, MOE_CNT = 66, MOE_RTE = 100, MOE_WORDS = 100 + 264;
struct ProbMoe1 {
    static constexpr bool FP8 = true, PERM = true, GATHER = true, ETAB = true, ADJ = false;
    static constexpr int NST = 0;
    __device__ __forceinline__ const char* a_tile(const pg8::Unit& u) const { return u.A; }
    const unsigned char* hb; const unsigned char* w1b; const float* b1p; const float* rstd2; const unsigned* list; unsigned char* hid;
    const volatile LAS int* tab; LAS unsigned* gtab; int rt0, nrt, G, c;
    __device__ __forceinline__ bool next(int i, pg8::Unit& u) const {
        const long L = (long)i * G + c; if (L >= (long)nrt * 8) return false;
        const int gidx = (int)(L >> 8), within = (int)(L & 255), gsz = (nrt - gidx * 32) < 32 ? (nrt - gidx * 32) : 32;
        const int rtl = gidx * 32 + within % gsz, pn = within / gsz, rt = rt0 + rtl;
        const int e = ((const volatile LAS unsigned char*)(tab + MOE_RTE))[rt];
        const int idx0 = (rt - tab[MOE_TS + e]) * 256;
        u.A = (const char*)hb; u.B = (const char*)(w1b + ((size_t)e * 2048 + (size_t)pn * 256) * 1024); u.pm = rt; u.pn = pn; u.e = e; u.nvalid = tab[MOE_CNT + e] - idx0; u.y0 = idx0; u.aux = 0; return true; }
    __device__ __forceinline__ unsigned tok_of(const pg8::Unit& u, int r) const { const int rr = r < u.nvalid ? r : 0; return list[(size_t)u.e * T + u.y0 + rr]; }
    __device__ __forceinline__ unsigned a_off(const pg8::Unit& u, int r) const { return tok_of(u, r) * 1024u; }
    __device__ __forceinline__ float e_val(const pg8::Unit& u, int r) const { return b1p[(size_t)u.e * 2048 + u.pn * 256 + r]; }
    __device__ __forceinline__ void epi(const f32x4 (&acc)[2][2][4][2], const pg8::Unit& u, int wr, int wc, int fr, int fq) const {
        asm volatile("" : "+v"(fr), "+v"(fq));
        const LAS float* bp = (const LAS float*)gtab + 768 + u.aux * 256 + wc * 32 + 8 * fq;
        const f32x4 bg0 = *(const LAS f32x4*)(bp), bg1 = *(const LAS f32x4*)(bp + 4), bl0 = *(const LAS f32x4*)(bp + 128), bl1 = *(const LAS f32x4*)(bp + 132);
        char* ub = (char*)hid + hid_tile_off(u.pm) + ((size_t)(u.pn * 4 + wc) * 8192 + (size_t)(wr * 64) * 32);
        const unsigned lo = (unsigned)(fr * 32 + 8 * fq);
        unsigned wk[2][2];
#pragma unroll
        for (int ai = 0; ai < 2; ++ai)
#pragma unroll
            for (int m = 0; m < 4; ++m) { const float rs = 1.0f / 64.0f;
                unsigned w[2];
#pragma unroll
                for (int n = 0; n < 2; ++n) { const f32x4 g4 = acc[ai][0][m][n] * rs + (n ? bg1 : bg0), l4 = acc[ai][1][m][n] * rs + (n ? bl1 : bl0);
                    unsigned wv = 0u;
#pragma unroll
                    for (int jp = 0; jp < 2; ++jp) {
                        f32x2 g2 = {fminf(g4[2 * jp], 7.0f), fminf(g4[2 * jp + 1], 7.0f)};
                        const f32x2 l2 = {__builtin_amdgcn_fmed3f(l4[2 * jp], -7.0f, 7.0f), __builtin_amdgcn_fmed3f(l4[2 * jp + 1], -7.0f, 7.0f)};
                        const f32x2 z2 = g2 * (-1.702f * 1.4426950408889634f);
                        const f32x2 d2 = (f32x2){__builtin_amdgcn_exp2f(z2[0]), __builtin_amdgcn_exp2f(z2[1])} + 1.0f;
                        const f32x2 r2 = {__builtin_amdgcn_rcpf(d2[0]), __builtin_amdgcn_rcpf(d2[1])};
                        const f32x2 o2 = (g2 * r2) * (l2 * 4.0f + 4.0f);
                        if (jp) wv = __builtin_amdgcn_cvt_pk_fp8_f32(o2[0], o2[1], wv, true); else wv = __builtin_amdgcn_cvt_pk_fp8_f32(o2[0], o2[1], wv, false); }
                    w[n] = wv; }
                wk[m & 1][0] = w[0]; wk[m & 1][1] = w[1];
                if (m & 1) {
                    const auto s0 = __builtin_amdgcn_permlane16_swap(wk[0][0], wk[1][0], false, false), s1 = __builtin_amdgcn_permlane16_swap(wk[0][1], wk[1][1], false, false);
                    *(u32x4*)(ub + (size_t)(ai * 128 + (m - 1) * 16) * 32 + lo + ((fq & 1) ? 16u * 32u - 8u : 0u)) = (u32x4){s0[0], s1[0], s0[1], s1[1]}; } }
    }
};
struct ProbMoe2 {
    static constexpr int NST = 0;
    static constexpr bool FP8 = true, PERM = true, GATHER = true, ETAB = true, ADJ = true;
    __device__ __forceinline__ const char* a_tile(const pg8::Unit& u) const { return u.A; }
    const unsigned char* hid; const unsigned char* w2b; const float* b2; unsigned char* y;
    const volatile LAS int* tab; LAS unsigned* gtab; int rt0, nrt, G, c;
    __device__ __forceinline__ bool next(int i, pg8::Unit& u) const {
        const long L = (long)i * G + c; if (L >= (long)nrt * 4) return false;
        const int gidx = (int)(L >> 8), within = (int)(L & 255), gsz = (nrt - gidx * 64) < 64 ? (nrt - gidx * 64) : 64;
        const int rtl = gidx * 64 + within % gsz, pn = within / gsz, rt = rt0 + rtl;
        const int e = ((const volatile LAS unsigned char*)(tab + MOE_RTE))[rt];
        const int idx0 = (rt - tab[MOE_TS + e]) * 256;
        u.A = (const char*)hid; u.B = (const char*)(w2b + ((size_t)e * 1024 + (size_t)pn * 256) * 1024); u.pm = rt; u.pn = pn; u.e = e; u.nvalid = tab[MOE_CNT + e] - idx0; u.y0 = tab[MOE_ST + e] + idx0; u.aux = 0; return true; }
    static constexpr bool ABLK = true;
    __device__ __forceinline__ unsigned a_off(const pg8::Unit& u, int r) const { return (unsigned)(hid_tile_off(u.pm) + (size_t)r * 32u); }
    __device__ __forceinline__ float e_val(const pg8::Unit& u, int r) const { return 16.0f * b2[(size_t)u.e * 1024 + u.pn * 256 + r]; }
    __device__ __forceinline__ void epi(const f32x4 (&acc)[2][2][4][2], const pg8::Unit& u, int wr, int wc, int fr, int fq) const {
        asm volatile("" : "+v"(fr), "+v"(fq));
        const LAS float* bp = (const LAS float*)gtab + 768 + u.aux * 256 + wc * 64 + 8 * fq;
        f32x4 bv[2][2];
#pragma unroll
        for (int bj = 0; bj < 2; ++bj)
#pragma unroll
            for (int n = 0; n < 2; ++n) bv[bj][n] = *(const LAS f32x4*)(bp + bj * 32 + 4 * n);
        char* ub = (char*)y + (((size_t)u.y0 + wr * 64) * 1024 + u.pn * 256 + wc * 64);
        const unsigned lo2 = (unsigned)(fr * 1024 + 8 * fq) + ((fq & 1) ? 24u : 0u);
        const int r0 = wr * 64 + fr;
#pragma unroll
        for (int ai = 0; ai < 2; ++ai)
#pragma unroll
            for (int m = 0; m < 4; ++m) { const int r = r0 + ai * 128 + m * 16;
                unsigned pk[2][2];
#pragma unroll
                for (int bj = 0; bj < 2; ++bj) { const f32x4 v0 = acc[ai][bj][m][0] * (1.0f / 16.0f) + bv[bj][0], v1 = acc[ai][bj][m][1] * (1.0f / 16.0f) + bv[bj][1];
                    unsigned w0 = 0u, w1 = 0u;
                    w0 = __builtin_amdgcn_cvt_pk_fp8_f32(c8(v0[0]), c8(v0[1]), w0, false); w0 = __builtin_amdgcn_cvt_pk_fp8_f32(c8(v0[2]), c8(v0[3]), w0, true);
                    w1 = __builtin_amdgcn_cvt_pk_fp8_f32(c8(v1[0]), c8(v1[1]), w1, false); w1 = __builtin_amdgcn_cvt_pk_fp8_f32(c8(v1[2]), c8(v1[3]), w1, true);
                    pk[bj][0] = w0; pk[bj][1] = w1; }
                const auto s0 = __builtin_amdgcn_permlane16_swap(pk[0][0], pk[1][0], false, false), s1 = __builtin_amdgcn_permlane16_swap(pk[0][1], pk[1][1], false, false);
                if (r < u.nvalid) *(u32x4*)(ub + (size_t)(ai * 128 + m * 16) * 1024 + lo2) = (u32x4){s0[0], s1[0], s0[1], s1[1]}; }
    }
};

#define XB_TMO      128
#define XB_XCNT(j)  (256  + 64 * (j))
#define XB_XSUB(j)  (1280 + 64 * (j))
#define XB_XGEN(j)  (2304 + 64 * (j))
#define XB_TOP      3328
#define XB_TOPGEN   3392
#define XCD_BAR_WORDS 3456
#define XB_SPIN_CAP (1u << 18)
__device__ __forceinline__ unsigned xb_ld(unsigned* p)              { return __hip_atomic_load(p, __ATOMIC_RELAXED, __HIP_MEMORY_SCOPE_AGENT); }
__device__ __forceinline__ unsigned xb_add(unsigned* p, unsigned v) { return __hip_atomic_fetch_add(p, v, __ATOMIC_RELAXED, __HIP_MEMORY_SCOPE_AGENT); }
__device__ __forceinline__ unsigned xb_xcc_id() { return (unsigned)__builtin_amdgcn_s_getreg((3 << 11) | 20) & 0xFu; }
#define XB_SPIN(cond, bar) do { unsigned _sp = 0; while (cond) { __builtin_amdgcn_s_sleep(1); \
    if ((++_sp & 255u) == 0u) { if (xb_ld(&(bar)[XB_TMO])) break; if (_sp > XB_SPIN_CAP) { atomicAdd(&(bar)[XB_TMO], 1u); break; } } } } while (0)
struct XcdBarrier { unsigned* bar; unsigned x; volatile LAS unsigned* st; int wave; };
__device__ __forceinline__ XcdBarrier xcd_barrier_post(unsigned* bar, volatile LAS unsigned* st, int wave) {
    XcdBarrier b; b.bar = bar; b.x = xb_xcc_id(); b.st = st; b.wave = wave;
    if (wave == 0 && lane_id() == 0) (void)xb_add(&bar[XB_XCNT(b.x)], 1u);
    return b;
}
__device__ __forceinline__ void xcd_barrier_complete(unsigned* bar, unsigned x, unsigned& nloc, unsigned& nx) {
    const unsigned G = gridDim.x * gridDim.y * gridDim.z;
    unsigned sum, cnt, mine, sp = 0u;
    for (;;) {
        sum = 0u; cnt = 0u; mine = 0u;
#pragma unroll
        for (unsigned j = 0; j < 16; ++j) { const unsigned c = xb_ld(&bar[XB_XCNT(j)]); sum += c; cnt += (c > 0u) ? 1u : 0u; mine = (j == x) ? c : mine; }
        if (sum == G) break;
        __builtin_amdgcn_s_sleep(1);
        if ((++sp & 255u) == 0u) { if (xb_ld(&bar[XB_TMO])) break; if (sp > XB_SPIN_CAP) { atomicAdd(&bar[XB_TMO], 1u); break; } }
    }
    nloc = mine > 0u ? mine : 1u; nx = cnt > 0u ? cnt : 1u;
}
__device__ __forceinline__ void xcd_barrier(const XcdBarrier& b) {
    asm volatile("s_waitcnt vmcnt(0)" ::: "memory");
    __syncthreads();
    if (b.wave == 0 && lane_id() == 0) {
        unsigned* bar = b.bar;
        __builtin_amdgcn_s_waitcnt(0);
        unsigned nloc = b.st[0], nx = b.st[1];
        if (nloc == 0u) { xcd_barrier_complete(bar, b.x, nloc, nx); b.st[0] = nloc; b.st[1] = nx; }
        const unsigned old = xb_add(&bar[XB_XSUB(b.x)], 1u);
        const unsigned gen = old / nloc;
        if (old + 1u == (gen + 1u) * nloc) {
            __builtin_amdgcn_fence(__ATOMIC_RELEASE, "agent");
            asm volatile("s_waitcnt vmcnt(0)" ::: "memory");
            const unsigned og = xb_add(&bar[XB_TOP], 1u);
            const unsigned tg = og / nx;
            if (og + 1u == (tg + 1u) * nx) xb_add(&bar[XB_TOPGEN], 1u);
            else XB_SPIN(xb_ld(&bar[XB_TOPGEN]) == tg, bar);
            __builtin_amdgcn_fence(__ATOMIC_ACQUIRE, "agent");
            xb_add(&bar[XB_XGEN(b.x)], 1u);
            asm volatile("s_waitcnt vmcnt(0)" ::: "memory");
        } else {
            XB_SPIN(xb_ld(&bar[XB_XGEN(b.x)]) == gen, bar);
            __builtin_amdgcn_fence(__ATOMIC_ACQUIRE, "agent");
            asm volatile("s_waitcnt vmcnt(0)" ::: "memory");
        }
    }
    __syncthreads();
}

typedef float f32x16 __attribute__((ext_vector_type(16)));
__device__ __forceinline__ int pi32(int i) { return (i & ~12) | ((i & 4) << 1) | ((i & 8) >> 1); }
__device__ __forceinline__ f32x16 zero16() { f32x16 z;
#pragma unroll
    for (int r = 0; r < 16; ++r) z[r] = 0.f;
    return z; }

__device__ __forceinline__ int pi64(int i) { return 32 * ((i >> 2) & 1) + 4 * (i >> 3) + (i & 3); }
__device__ __forceinline__ void xattn_phase(LAS unsigned char* lds, const unsigned char* Q, const unsigned char* Kb, const unsigned char* VT, unsigned char* O, int G, int bx, int wave) {
    const int lane = lane_id(), i = lane & 31, hh = lane >> 5;
    LAS unsigned char* ring = lds;
    u32x4 qf[8];
#define XA_QLOAD(uid_) do { const int u_ = (uid_); const unsigned char* qp_ = Q + (size_t)((u_ >> 5) * SEQ + (u_ & 7) * 256 + wave * 32 + i) * 1024 + ((u_ >> 3) & 3) * 256 + 32 * hh; \
        _Pragma("unroll") for (int s_ = 0; s_ < 4; ++s_) { qf[2 * s_] = *(const u32x4*)(qp_ + 64 * s_); qf[2 * s_ + 1] = *(const u32x4*)(qp_ + 64 * s_ + 16); } } while (0)
#define XA_VMCNT(n) (((n) & 15) | (7 << 4) | (15 << 8) | (((n) >> 4) << 14))
    for (int job = bx; job < BATCH * 4 * 2; job += G) {
        const int b = job >> 3, h = (job >> 1) & 3, uid0 = b * 32 + h * 8 + (job & 1) * 4;
        __syncthreads();
        XA_QLOAD(uid0);
        { const unsigned char* ksrc = Kb + (size_t)(b * MEMLEN + pi64(i)) * 1024 + h * 256 + 64 * (wave >> 1) + 16 * (wave & 1) + 32 * hh;
          const unsigned char* vsrc = VT + (size_t)(h * 256 + i) * MROWS + b * MEMLEN + 64 * (wave >> 1) + 16 * (wave & 1) + 32 * hh;
#pragma unroll
          for (int st = 0; st < 16; ++st) { const unsigned char* g_ = st < 8 ? ksrc + (size_t)(64 * (st >> 1) + 16 * (st & 1)) * 1024 : vsrc + (size_t)(st - 8) * 32 * MROWS;
              __builtin_amdgcn_global_load_lds((const unsigned*)g_, (LAS unsigned*)(ring + st * 8192 + wave * 1024), 16, 0, 0); } }
        asm volatile("" ::: "memory"); __builtin_amdgcn_s_waitcnt(XA_VMCNT(0)); asm volatile("" ::: "memory"); __builtin_amdgcn_s_barrier(); asm volatile("" ::: "memory");
#pragma unroll 1
      for (int qi = 0; qi < 4; ++qi) {
        const int q0 = ((job & 1) * 4 + qi) * 256 + wave * 32;
        asm volatile("" ::: "memory"); __builtin_amdgcn_s_waitcnt(XA_VMCNT(8)); asm volatile("" ::: "memory");
#define XA_SYNC(st_) do { } while (0)
        f32x16 s[8];
        const LAS unsigned char* slb = ring + lane * 16;
        i32x4 fa0 = *(const LAS i32x4*)(slb), fa1 = *(const LAS i32x4*)(slb + 1024);
#pragma unroll
        for (int kt = 0; kt < 8; ++kt) {
            f32x16 acc = zero16();
#pragma unroll
            for (int s4 = 0; s4 < 4; ++s4) { const int nn = kt * 4 + s4 + 1;
                const i32x4 na0 = *(const LAS i32x4*)(slb + (nn >> 2) * 8192 + (2 * (nn & 3)) * 1024), na1 = *(const LAS i32x4*)(slb + (nn >> 2) * 8192 + (2 * (nn & 3) + 1) * 1024);
                __builtin_amdgcn_sched_barrier(0);
                const i32x4 b0 = __builtin_bit_cast(i32x4, qf[2 * s4]), b1 = __builtin_bit_cast(i32x4, qf[2 * s4 + 1]);
                acc = __builtin_amdgcn_mfma_scale_f32_32x32x64_f8f6f4((i32x8){fa0[0], fa0[1], fa0[2], fa0[3], fa1[0], fa1[1], fa1[2], fa1[3]}, (i32x8){b0[0], b0[1], b0[2], b0[3], b1[0], b1[1], b1[2], b1[3]},
                                                                        acc, 0, 0, 0, 0x7f7f7f7f, 0, 0x7f7f7f7f);
                __builtin_amdgcn_sched_barrier(0);
                fa0 = na0; fa1 = na1; }
            s[kt] = acc; }
        float m = -INFINITY;
#pragma unroll
        for (int kt = 0; kt < 8; ++kt)
#pragma unroll
            for (int r = 0; r < 16; ++r) m = fmaxf(m, s[kt][r]);
        m = x32_max(m);
        const float c = 0.0625f * 1.4426950408889634f; float l = 0.f; const float mc = m * c - 8.0f;
        u32x4 pf[8];
#pragma unroll
        for (int kt = 0; kt < 8; ++kt) {
#pragma unroll
            for (int r = 0; r < 16; ++r) { const float p = __builtin_amdgcn_exp2f(s[kt][r] * c - mc); s[kt][r] = p; l += p; }
#pragma unroll
            for (int d = 0; d < 4; ++d) { unsigned w = 0u; w = __builtin_amdgcn_cvt_pk_fp8_f32(s[kt][4 * d], s[kt][4 * d + 1], w, false); w = __builtin_amdgcn_cvt_pk_fp8_f32(s[kt][4 * d + 2], s[kt][4 * d + 3], w, true); pf[kt][d] = w; } }
        l = x32_sum(l);
        const float il = 1.0f / l;
        XA_QLOAD(uid0 + (qi < 3 ? qi + 1 : 3));
        unsigned char* op = O + (size_t)(b * SEQ + q0 + i) * 1024 + h * 256 + 16 * hh;
#pragma unroll
        for (int dvt = 0; dvt < 8; ++dvt) {
            f32x16 oacc = zero16();
#pragma unroll
            for (int t4 = 0; t4 < 4; ++t4) { const int nn = (32 + dvt * 4 + t4 + 1) & 63;
                const i32x4 na0 = *(const LAS i32x4*)(slb + (nn >> 2) * 8192 + (2 * (nn & 3)) * 1024), na1 = *(const LAS i32x4*)(slb + (nn >> 2) * 8192 + (2 * (nn & 3) + 1) * 1024);
                __builtin_amdgcn_sched_barrier(0);
                const i32x4 b0 = __builtin_bit_cast(i32x4, pf[2 * t4]), b1 = __builtin_bit_cast(i32x4, pf[2 * t4 + 1]);
                oacc = __builtin_amdgcn_mfma_scale_f32_32x32x64_f8f6f4((i32x8){fa0[0], fa0[1], fa0[2], fa0[3], fa1[0], fa1[1], fa1[2], fa1[3]}, (i32x8){b0[0], b0[1], b0[2], b0[3], b1[0], b1[1], b1[2], b1[3]},
                                                                         oacc, 0, 0, 0, 0x7f7f7f7f, 0, 0x7f7f7f7f);
                __builtin_amdgcn_sched_barrier(0);
                fa0 = na0; fa1 = na1; }
            unsigned wg[4];
#pragma unroll
            for (int g = 0; g < 4; ++g) { unsigned w = 0u; w = __builtin_amdgcn_cvt_pk_fp8_f32(c8(oacc[4 * g] * il), c8(oacc[4 * g + 1] * il), w, false); w = __builtin_amdgcn_cvt_pk_fp8_f32(c8(oacc[4 * g + 2] * il), c8(oacc[4 * g + 3] * il), w, true); wg[g] = w; }
            { const auto s02 = __builtin_amdgcn_permlane32_swap(wg[0], wg[2], false, false), s13 = __builtin_amdgcn_permlane32_swap(wg[1], wg[3], false, false);
              *(u32x4*)(op + dvt * 32) = (u32x4){s02[0], s02[1], s13[0], s13[1]}; } }
#undef XA_SYNC
      }
    }
}

__device__ __forceinline__ void diffattn_phase(LAS unsigned char* lds, LAS float* dgl, const bf16_t* P2, const bf16_t* VT, const float* dng, const float lam, bf16_t* cat, int G, int vx, int wave) {
    const int lane = lane_id(), i_ = lane & 31, hh_ = lane >> 5;
    dgl[wave * 64 + lane] = dng[wave * 64 + lane];
    __syncthreads();
    LAS unsigned char* ring = lds;
    LAS unsigned char* ql = lds + 65536 + wave * 8192 + lane * 16;
    const float c = 0.125f * 1.4426950408889634f;
    const int nunit = vx < BATCH * 4 * 4 ? 2 * ((BATCH * 4 * 4 - vx + G - 1) / G) : 0;
#define DA_PREFETCH_DMA(n_) do { int ip_ = i_, hp_ = hh_; asm volatile("" : "+v"(ip_), "+v"(hp_)); \
        const int pu_ = vx + ((n_) >> 1) * G, bh_ = pu_ >> 2, x_ = pu_ & 3, qb_ = ((n_) & 1) ? 7 - x_ : x_, b_ = bh_ >> 2, h_ = bh_ & 3; \
        const bf16_t* qp_ = P2 + (size_t)(b_ * SEQ + qb_ * 256 + wave * 32 + ip_) * NP2 + h_ * 128 + 8 * hp_;        \
        _Pragma("unroll") for (int f = 0; f < 8; ++f) __builtin_amdgcn_global_load_lds((const unsigned*)(qp_ + 16 * f), (LAS unsigned*)(lds + 65536 + wave * 8192 + f * 1024), 16, 0, 0); \
        const char* kb_ = (const char*)(P2 + (size_t)b_ * SEQ * NP2 + 512 + h_ * 128 + (wave >> 2) * 64 + 16 * (wave & 3)) + (unsigned)(pi32(ip_) * NP2 + 8 * hp_) * 2u; \
        const char* vb_ = (const char*)(VT + (size_t)(h_ * 128 + 32 * (wave >> 1)) * T + (size_t)b_ * SEQ + 16 * (wave & 1)) + (unsigned)(ip_ * T + 8 * hp_) * 2u; \
        _Pragma("unroll") for (int kt_ = 0; kt_ < 2; ++kt_) { \
            __builtin_amdgcn_global_load_lds((const unsigned*)(kb_ + (size_t)kt_ * (32 * NP2 * 2)), (LAS unsigned*)(ring + kt_ * 16384 + wave * 1024), 16, 0, 0); \
            __builtin_amdgcn_global_load_lds((const unsigned*)(vb_ + kt_ * 64), (LAS unsigned*)(ring + kt_ * 16384 + (8 + wave) * 1024), 16, 0, 0); } } while (0)
    if (nunit > 0) DA_PREFETCH_DMA(0);
    for (int un = 0; un < nunit; ++un) {
        {
            const int pu = vx + (un >> 1) * G, side = un & 1;
            const int bh = pu >> 2, x = pu & 3, qb = side ? 7 - x : x, b = bh >> 2, h = bh & 3, q0 = qb * 256 + wave * 32;
            const int ntile = 8 * qb + 8, ktw = 8 * qb + wave;
            int i = i_, hh = hh_; asm volatile("" : "+v"(i), "+v"(hh));
            if (un == 0) asm volatile("s_waitcnt vmcnt(0)" ::: "memory"); else asm volatile("s_waitcnt vmcnt(8)" ::: "memory");
            const char* kbase = (const char*)(P2 + (size_t)b * SEQ * NP2 + 512 + h * 128 + (wave >> 2) * 64 + 16 * (wave & 3));
            const char* vbase = (const char*)(VT + (size_t)(h * 128 + 32 * (wave >> 1)) * T + (size_t)b * SEQ + 16 * (wave & 1));
            const unsigned koff = (unsigned)(pi32(i) * NP2 + 8 * hh) * 2u, voff = (unsigned)(i * T + 8 * hh) * 2u;
#define DA_ISSUE(kt_) do { LAS unsigned char* sl_ = ring + ((kt_) & 3) * 16384; \
        __builtin_amdgcn_global_load_lds((const unsigned*)(kbase + (size_t)(kt_) * (32 * NP2 * 2) + koff), (LAS unsigned*)(sl_ + wave * 1024), 16, 0, 0); \
        __builtin_amdgcn_global_load_lds((const unsigned*)(vbase + (kt_) * 64 + voff), (LAS unsigned*)(sl_ + (8 + wave) * 1024), 16, 0, 0); } while (0)
            f32x16 o1[4], o2[4];
#pragma unroll
            for (int d = 0; d < 4; ++d) { o1[d] = zero16(); o2[d] = zero16(); }
            float mc1 = -INFINITY, mc2 = -INFINITY, l1 = 0.f, l2 = 0.f;
            u32x4 pp1[2], pp2[2];
#pragma unroll
            for (int sb = 0; sb < 2; ++sb) { pp1[sb] = (u32x4){0u, 0u, 0u, 0u}; pp2[sb] = pp1[sb]; }
            for (int kt = 0; kt <= ntile; ++kt) {
                if (kt < ntile) {
                    if (kt == 0) { }
                    else if (kt + 1 < ntile) asm volatile("s_waitcnt vmcnt(2)" ::: "memory"); else asm volatile("s_waitcnt vmcnt(0)" ::: "memory");
                    __builtin_amdgcn_s_barrier(); asm volatile("" ::: "memory");
                    if (kt + 2 < ntile) DA_ISSUE(kt + 2);
                }
                if (kt <= ktw + 1) {
                    const LAS unsigned char* sl = ring + (kt & 3) * 16384 + lane * 16;
                    const LAS unsigned char* sp = ring + ((kt == 0 ? 0 : kt - 1) & 3) * 16384 + lane * 16;
                    f32x16 s1 = zero16(), s2 = zero16();
#pragma unroll
                    for (int ds = 0; ds < 4; ++ds) { s1 = __builtin_amdgcn_mfma_f32_32x32x16_bf16(*(const LAS bf16x8*)(sl + ds * 1024), *(const LAS bf16x8*)(ql + ds * 1024), s1, 0, 0, 0);
                        s2 = __builtin_amdgcn_mfma_f32_32x32x16_bf16(*(const LAS bf16x8*)(sl + (4 + ds) * 1024), *(const LAS bf16x8*)(ql + (4 + ds) * 1024), s2, 0, 0, 0);
                        if (ds & 1) __builtin_amdgcn_sched_barrier(0); }
                    if (kt >= ktw) { const int lim = (kt == ktw) ? i : -1;
#pragma unroll
                        for (int r = 0; r < 16; ++r) { const int ko = 16 * (r >> 3) + 8 * hh + (r & 7); if (ko > lim) { s1[r] = -INFINITY; s2[r] = -INFINITY; } } }
                    float f1 = 1.f, f2 = 1.f; bool rs1, rs2;
                    { float tm = s1[0];
#pragma unroll
                      for (int r = 1; r < 16; ++r) tm = fmaxf(tm, s1[r]);
                      tm = x32_max(tm); const float tmc = tm * c; rs1 = __any(tmc > mc1 + 8.0f);
                      if (rs1) { const float mn = fmaxf(mc1, tmc); f1 = __builtin_amdgcn_exp2f(mc1 - mn); mc1 = mn; } }
                    { float tm = s2[0];
#pragma unroll
                      for (int r = 1; r < 16; ++r) tm = fmaxf(tm, s2[r]);
                      tm = x32_max(tm); const float tmc = tm * c; rs2 = __any(tmc > mc2 + 8.0f);
                      if (rs2) { const float mn = fmaxf(mc2, tmc); f2 = __builtin_amdgcn_exp2f(mc2 - mn); mc2 = mn; } }
                    float ls1 = 0.f, ls2 = 0.f; u32x4 pn1[2], pn2[2];
#define DA_SM(j) do { { const float pv_ = __builtin_amdgcn_exp2f(s1[j] * c - mc1); s1[j] = pv_; ls1 += pv_; } { const float pv_ = __builtin_amdgcn_exp2f(s2[j] * c - mc2); s2[j] = pv_; ls2 += pv_; } \
                        if ((j) & 1) { pn1[(j) >> 3][((j) & 7) >> 1] = cvt_pk_bf16(s1[(j) - 1], s1[j]); pn2[(j) >> 3][((j) & 7) >> 1] = cvt_pk_bf16(s2[(j) - 1], s2[j]); } } while (0)
                    { bf16x8 va, vb;
#define DA_VLD(p) (*(const LAS bf16x8*)(sp + (8 + ((p) & 3) * 2 + ((p) >> 2)) * 1024))
#define DA_SLOT(j, VF, LDNEXT) do { if ((j) & 1) o2[((j) >> 1) & 3] = __builtin_amdgcn_mfma_f32_32x32x16_bf16(VF, __builtin_bit_cast(bf16x8, pp2[(j) >> 3]), o2[((j) >> 1) & 3], 0, 0, 0); \
                            else o1[((j) >> 1) & 3] = __builtin_amdgcn_mfma_f32_32x32x16_bf16(VF, __builtin_bit_cast(bf16x8, pp1[(j) >> 3]), o1[((j) >> 1) & 3], 0, 0, 0); \
                            LDNEXT; DA_SM(j); __builtin_amdgcn_sched_barrier(0); } while (0)
                      va = DA_VLD(0);
                      __builtin_amdgcn_sched_barrier(0);
                      DA_SLOT(0, va, vb = DA_VLD(1)); DA_SLOT(1, va, (void)0); DA_SLOT(2, vb, va = DA_VLD(2)); DA_SLOT(3, vb, (void)0);
                      DA_SLOT(4, va, vb = DA_VLD(3)); DA_SLOT(5, va, (void)0); DA_SLOT(6, vb, va = DA_VLD(4)); DA_SLOT(7, vb, (void)0);
                      DA_SLOT(8, va, vb = DA_VLD(5)); DA_SLOT(9, va, (void)0); DA_SLOT(10, vb, va = DA_VLD(6)); DA_SLOT(11, vb, (void)0);
                      DA_SLOT(12, va, vb = DA_VLD(7)); DA_SLOT(13, va, (void)0); DA_SLOT(14, vb, (void)0); DA_SLOT(15, vb, (void)0);
#undef DA_VLD
#undef DA_SLOT
                    }
#undef DA_SM
                    l1 = l1 * f1 + ls1; l2 = l2 * f2 + ls2;
                    if (rs1) {
#pragma unroll
                        for (int d = 0; d < 4; ++d)
#pragma unroll
                            for (int r = 0; r < 16; ++r) o1[d][r] *= f1; }
                    if (rs2) {
#pragma unroll
                        for (int d = 0; d < 4; ++d)
#pragma unroll
                            for (int r = 0; r < 16; ++r) o2[d][r] *= f2; }
#pragma unroll
                    for (int sb = 0; sb < 2; ++sb) { pp1[sb] = pn1[sb]; pp2[sb] = pn2[sb]; }
                }
            }
#undef DA_ISSUE
            if (un + 1 < nunit) DA_PREFETCH_DMA(un + 1);
            l1 = x32_sum(l1); l2 = x32_sum(l2);
            int ie = i, he = hh; asm volatile("" : "+v"(ie), "+v"(he));
            const float i1 = 1.0f / l1, i2 = lam / l2; float ss = 0.f;
#pragma unroll
            for (int d = 0; d < 4; ++d)
#pragma unroll
                for (int r = 0; r < 16; ++r) { const float o = o1[d][r] * i1 - o2[d][r] * i2; o1[d][r] = o; ss += o * o; }
            ss = x32_sum(ss);
            const float rn = rsqrtf(ss * (1.0f / 128.0f) + EPS) * (1.0f - LAMBDA_INIT);
            bf16_t* op = cat + (size_t)(b * SEQ + q0 + ie) * DM + h * 128 + 8 * he;
            const LAS float* gp = dgl + h * 128 + 4 * he;
#pragma unroll
            for (int d = 0; d < 4; ++d)
#pragma unroll
                for (int g2 = 0; g2 < 2; ++g2) { u32x2 w[2];
#pragma unroll
                    for (int q = 0; q < 2; ++q) { const int g = 2 * g2 + q; const f32x4 gv = *(const LAS f32x4*)(gp + d * 32 + 8 * g);
                        w[q].x = cvt_pk_bf16(o1[d][4 * g] * rn * gv[0], o1[d][4 * g + 1] * rn * gv[1]); w[q].y = cvt_pk_bf16(o1[d][4 * g + 2] * rn * gv[2], o1[d][4 * g + 3] * rn * gv[3]); }
                    const auto sa = __builtin_amdgcn_permlane32_swap(w[0].x, w[1].x, false, false), sb = __builtin_amdgcn_permlane32_swap(w[0].y, w[1].y, false, false);
                    *(u32x4*)(op + d * 32 + 16 * g2) = (u32x4){sa[0], sb[0], sa[1], sb[1]}; }
        }
    }
#undef DA_PREFETCH_DMA
}

__device__ __forceinline__ void mlstm_prep_phase(LAS unsigned char* lds, const bf16_t* P2, const bf16_t* VT, const float* gates, const float* conv_w, const float* conv_b,
                                                 bf16_t* QM, bf16_t* KM, float* BC, float* AV, float* AM, float* CH, float* NLOC, float* CLOC, int G, int vx, int wave) {
    const int lane = lane_id(), i = lane & 31, hh = lane >> 5;
    LAS unsigned char* kl = lds + wave * 16384;
    for (int task = vx * 8 + wave; task < BATCH * 4 * 16; task += G * 8) {
        const int bh = task >> 4, c = task & 15, b = bh >> 2, h = bh & 3;
        const int t0 = b * SEQ + c * 128, tA = t0 + 2 * lane;
        const float lf0 = gates[(size_t)tA * 8 + 4 + h], lf1 = gates[(size_t)(tA + 1) * 8 + 4 + h], ig0 = gates[(size_t)tA * 8 + h], ig1 = gates[(size_t)(tA + 1) * 8 + h];
        float incl = lf0 + lf1;
#pragma unroll
        for (int off = 1; off < 64; off <<= 1) { const float v = __shfl_up(incl, off); if (lane >= off) incl += v; }
        const float bc1 = incl, bc0 = incl - lf1, blast = __shfl(incl, 63);
        const float a0 = ig0 - bc0, a1 = ig1 - bc1;
        float pm = fmaxf(a0, a1);
#pragma unroll
        for (int off = 1; off < 64; off <<= 1) { const float v = __shfl_up(pm, off); if (lane >= off) pm = fmaxf(pm, v); }
        const float pmprev = __shfl_up(pm, 1);
        const float am1 = pm, am0 = (lane > 0) ? fmaxf(pmprev, a0) : a0, amall = __shfl(pm, 63);
        const float ws0 = __expf(a0 - amall), ws1 = __expf(a1 - amall);
        *(f32x2*)(BC + (size_t)h * T + tA) = (f32x2){bc0, bc1};
        *(f32x2*)(AV + (size_t)h * T + tA) = (f32x2){a0, a1};
        *(f32x2*)(AM + (size_t)h * T + tA) = (f32x2){am0, am1};
        if (lane == 0) { CH[task * 2] = blast; CH[task * 2 + 1] = blast + amall; }
        {
            const int r8 = lane >> 3, cg = lane & 7;
            float cw[2][5][8];
#pragma unroll
            for (int part = 0; part < 2; ++part) { const int ch0 = (part ? 256 : 0) + h * 64 + 8 * cg;
#pragma unroll
                for (int k = 0; k < 4; ++k) { const f32x4 a = *(const f32x4*)(conv_w + k * 512 + ch0), bq = *(const f32x4*)(conv_w + k * 512 + ch0 + 4);
#pragma unroll
                    for (int j = 0; j < 4; ++j) { cw[part][k][j] = a[j]; cw[part][k][4 + j] = bq[j]; } }
                { const f32x4 a = *(const f32x4*)(conv_b + ch0), bq = *(const f32x4*)(conv_b + ch0 + 4);
#pragma unroll
                    for (int j = 0; j < 4; ++j) { cw[part][4][j] = a[j]; cw[part][4][4 + j] = bq[j]; } } }
#define MP_ROWS(jb_, U) do { const int pl_ = 8 * (jb_) + r8; \
                _Pragma("unroll") for (int part = 0; part < 2; ++part) _Pragma("unroll") for (int k = 0; k < 4; ++k) { const int tt_ = (c * 128 + pl_ - 3 + k >= 0) ? t0 + pl_ - 3 + k : t0 + pl_; \
                    U[part][k] = *(const u32x4*)(P2 + (size_t)tt_ * NP2 + 1024 + (part ? 256 : 0) + h * 64 + 8 * cg); } } while (0)
            u32x4 uw[2][4], un_[2][4];
            MP_ROWS(0, uw);
#pragma unroll 2
            for (int jb = 0; jb < 16; ++jb) {
                const int p = 8 * jb + r8, tg = t0 + p, tseq = c * 128 + p;
                const float wa = __shfl(ws0, p >> 1), wb = __shfl(ws1, p >> 1); const float wsp = (p & 1) ? wb : wa;
                MP_ROWS(jb < 15 ? jb + 1 : 15, un_);
                asm volatile("" ::: "memory"); __builtin_amdgcn_s_waitcnt((8 & 15) | (7 << 4) | (15 << 8) | ((8 >> 4) << 14)); asm volatile("" ::: "memory");
#pragma unroll
                for (int part = 0; part < 2; ++part)
#pragma unroll
                    for (int k = 0; k < 4; ++k) { asm volatile("" : "+v"(uw[part][k])); if (tseq - 3 + k < 0) uw[part][k] = (u32x4){0u, 0u, 0u, 0u}; }
#pragma unroll
                for (int part = 0; part < 2; ++part) { float y[8];
#pragma unroll
                    for (int j = 0; j < 8; ++j) { float pj = cw[part][4][j];
#pragma unroll
                        for (int k = 0; k < 4; ++k) { const unsigned wv = (j < 2) ? uw[part][k].x : (j < 4) ? uw[part][k].y : (j < 6) ? uw[part][k].z : uw[part][k].w; pj += cw[part][k][j] * ((j & 1) ? hi_bf(wv) : lo_bf(wv)); }
                        y[j] = pj * __builtin_amdgcn_rcpf(1.0f + __expf(-pj)); }
                    if (part == 0) { u32x4 w; w.x = cvt_pk_bf16(y[0] * 0.125f, y[1] * 0.125f); w.y = cvt_pk_bf16(y[2] * 0.125f, y[3] * 0.125f); w.z = cvt_pk_bf16(y[4] * 0.125f, y[5] * 0.125f); w.w = cvt_pk_bf16(y[6] * 0.125f, y[7] * 0.125f);
                        *(u32x4*)(QM + (size_t)tg * 256 + h * 64 + 8 * cg) = w; }
                    else { u32x4 w; w.x = cvt_pk_bf16(y[0], y[1]); w.y = cvt_pk_bf16(y[2], y[3]); w.z = cvt_pk_bf16(y[4], y[5]); w.w = cvt_pk_bf16(y[6], y[7]);
                        *(u32x4*)(KM + (size_t)tg * 256 + h * 64 + 8 * cg) = w;
#pragma unroll
                        for (int j = 0; j < 8; ++j) { const int d = 8 * cg + j;
                            *(LAS unsigned short*)(kl + d * 256 + ((jb ^ (d & 15)) * 16) + r8 * 2) = (unsigned short)f2bf(y[j] * wsp); } } }
#pragma unroll
                for (int part = 0; part < 2; ++part)
#pragma unroll
                    for (int k = 0; k < 4; ++k) uw[part][k] = un_[part][k];
            }
#undef MP_ROWS
        }
        { float ns = 0.f;
#pragma unroll
          for (int cq = 0; cq < 16; ++cq) { const u32x4 w = *(const LAS u32x4*)(kl + lane * 256 + ((cq ^ (lane & 15)) * 16));
              ns += (lo_bf(w.x) + hi_bf(w.x)) + (lo_bf(w.y) + hi_bf(w.y)) + (lo_bf(w.z) + hi_bf(w.z)) + (lo_bf(w.w) + hi_bf(w.w)); }
          NLOC[(size_t)task * 64 + lane] = ns; }
        f32x16 acc[4][2];
#pragma unroll
        for (int et = 0; et < 4; ++et) { acc[et][0] = zero16(); acc[et][1] = zero16(); }
        const bf16_t* vp = VT + (size_t)(512 + h * 128 + i) * T + t0 + 8 * hh;
#pragma unroll
        for (int k2 = 0; k2 < 8; k2 += 2) {
            bf16x8 af[2][4];
#pragma unroll
            for (int q = 0; q < 2; ++q)
#pragma unroll
                for (int et = 0; et < 4; ++et) af[q][et] = *(const bf16x8*)(vp + (size_t)et * 32 * T + 16 * (k2 + q));
            __builtin_amdgcn_sched_barrier(0);
#pragma unroll
            for (int q = 0; q < 2; ++q) { const int ks = k2 + q; bf16x8 bfr[2];
#pragma unroll
                for (int dt = 0; dt < 2; ++dt) { const int d = 32 * dt + i; bfr[dt] = *(const LAS bf16x8*)(kl + d * 256 + (((2 * ks + hh) ^ (d & 15)) * 16)); }
#pragma unroll
                for (int et = 0; et < 4; ++et) {
                    acc[et][0] = __builtin_amdgcn_mfma_f32_32x32x16_bf16(af[q][et], bfr[0], acc[et][0], 0, 0, 0); acc[et][1] = __builtin_amdgcn_mfma_f32_32x32x16_bf16(af[q][et], bfr[1], acc[et][1], 0, 0, 0); } }
            __builtin_amdgcn_sched_barrier(0);
        }
        { int ln_ = lane, i2_ = i, h2_ = hh; asm volatile("" : "+v"(ln_), "+v"(i2_), "+v"(h2_));
          LAS float* st = (LAS float*)kl; bf16_t* cg = (bf16_t*)CLOC + (size_t)task * 8192;
#pragma unroll
          for (int hf = 0; hf < 2; ++hf) {
#pragma unroll
              for (int e2 = 0; e2 < 2; ++e2)
#pragma unroll
                  for (int dt = 0; dt < 2; ++dt)
#pragma unroll
                      for (int r = 0; r < 16; ++r) st[(32 * e2 + (r & 3) + 8 * (r >> 2) + 4 * h2_) * 64 + 32 * dt + i2_] = acc[2 * hf + e2][dt][r];
#pragma unroll
              for (int k2 = 0; k2 < 8; k2 += 2) { f32x4 v[2][2];
                  __builtin_amdgcn_sched_barrier(0);
#pragma unroll
                  for (int q = 0; q < 2; ++q) { v[q][0] = *(const LAS f32x4*)(st + ((k2 + q) * 64 + ln_) * 8); v[q][1] = *(const LAS f32x4*)(st + ((k2 + q) * 64 + ln_) * 8 + 4); }
#pragma unroll
                  for (int q = 0; q < 2; ++q) { u32x4 w; w.x = cvt_pk_bf16(v[q][0][0], v[q][0][1]); w.y = cvt_pk_bf16(v[q][0][2], v[q][0][3]); w.z = cvt_pk_bf16(v[q][1][0], v[q][1][1]); w.w = cvt_pk_bf16(v[q][1][2], v[q][1][3]);
                      *(u32x4*)(cg + hf * 4096 + ((k2 + q) * 64 + ln_) * 8) = w; }
                  __builtin_amdgcn_sched_barrier(0); } } }
    }
}
__device__ __forceinline__ void mlstm_scan_phase(const float* CLOC, const float* NLOC, const float* CH, bf16_t* CSTB, float* NST, float* MSTATE, int G, int bx, int tid) {
    for (int idx = bx * 512 + tid; idx < BATCH * 4 * 1024; idx += G * 512) {
        const int bh = idx >> 10, rem = idx & 1023, e = rem >> 3, d0 = (rem & 7) * 8;
        float C[8], nr[8]; float m = 0.f;
#pragma unroll
        for (int j = 0; j < 8; ++j) { C[j] = 0.f; nr[j] = 0.f; }
#pragma unroll 1
        for (int c8 = 0; c8 < 16; c8 += 8) {
            u32x4 cl[8]; f32x4 nl[8][2]; float bl[8], ml[8];
#pragma unroll
            for (int q = 0; q < 8; ++q) { const int task = bh * 16 + c8 + q;
                cl[q] = *(const u32x4*)((const bf16_t*)CLOC + (size_t)task * 8192 + e * 64 + d0);
                bl[q] = CH[task * 2]; ml[q] = CH[task * 2 + 1];
                if (rem < 8) { nl[q][0] = *(const f32x4*)(NLOC + (size_t)task * 64 + rem * 8); nl[q][1] = *(const f32x4*)(NLOC + (size_t)task * 64 + rem * 8 + 4); }
                else { nl[q][0] = (f32x4){0.f, 0.f, 0.f, 0.f}; nl[q][1] = nl[q][0]; } }
#pragma unroll
            for (int q = 0; q < 8; ++q) { const int task = bh * 16 + c8 + q;
                u32x4 w; w.x = cvt_pk_bf16(C[0], C[1]); w.y = cvt_pk_bf16(C[2], C[3]); w.z = cvt_pk_bf16(C[4], C[5]); w.w = cvt_pk_bf16(C[6], C[7]);
                *(u32x4*)(CSTB + (size_t)task * 8192 + e * 64 + d0) = w;
                if (rem < 8) { *(f32x4*)(NST + (size_t)task * 64 + rem * 8) = (f32x4){nr[0], nr[1], nr[2], nr[3]}; *(f32x4*)(NST + (size_t)task * 64 + rem * 8 + 4) = (f32x4){nr[4], nr[5], nr[6], nr[7]}; }
                if (rem == 0) MSTATE[task] = m;
                const float mn = fmaxf(bl[q] + m, ml[q]), a = __expf(bl[q] + m - mn), bco = __expf(ml[q] - mn);
#pragma unroll
                for (int j = 0; j < 4; ++j) { const unsigned wv = cl[q][j]; C[2 * j] = a * C[2 * j] + bco * lo_bf(wv); C[2 * j + 1] = a * C[2 * j + 1] + bco * hi_bf(wv); nr[j] = a * nr[j] + bco * nl[q][0][j]; nr[4 + j] = a * nr[4 + j] + bco * nl[q][1][j]; }
                m = mn; }
        }
    }
}
__device__ __forceinline__ void mlstm_out_phase(LAS unsigned char* lds, LAS float* mgl, const bf16_t* P2, const bf16_t* VT, const bf16_t* QM, const bf16_t* KM, const float* BC, const float* AV, const float* AM,
                                                const bf16_t* CSTB, const float* NST, const float* MSTATE, const float* mng, bf16_t* cat, int G, int vx, int wave) {
    const int lane_ = lane_id();
    const int cw = wave >> 2, tq = wave & 3;
    mgl[wave * 64 + lane_] = mng[wave * 64 + lane_];
    __syncthreads();
    LAS unsigned char* reg = lds + cw * 65536;
#define ML_DMA(un_) do { int l_ = lane_; asm volatile("" : "+v"(l_)); const int i_ = l_ & 31, h_ = l_ >> 5; \
        const int task_ = 2 * (un_) + cw, bh_ = task_ >> 4, hd_ = bh_ & 3, t0_ = (bh_ >> 2) * SEQ + (task_ & 15) * 128; \
        const bf16_t* ks = KM + (size_t)(t0_ + 32 * tq + pi32(i_)) * 256 + hd_ * 64 + 8 * h_; \
        const bf16_t* cs = CSTB + (size_t)task_ * 8192 + (32 * tq + i_) * 64 + 8 * h_; \
        const bf16_t* vs = VT + (size_t)(512 + hd_ * 128 + 32 * tq + i_) * T + t0_ + 8 * h_; \
        _Pragma("unroll") for (int ds = 0; ds < 4; ++ds) { __builtin_amdgcn_global_load_lds((const unsigned*)(ks + 16 * ds), (LAS unsigned*)(reg + (tq * 4 + ds) * 1024), 16, 0, 0); \
            __builtin_amdgcn_global_load_lds((const unsigned*)(cs + 16 * ds), (LAS unsigned*)(reg + 16384 + (tq * 4 + ds) * 1024), 16, 0, 0); } \
        _Pragma("unroll") for (int k8 = 0; k8 < 8; ++k8) __builtin_amdgcn_global_load_lds((const unsigned*)(vs + 16 * k8), (LAS unsigned*)(reg + 32768 + (tq * 8 + k8) * 1024), 16, 0, 0); } while (0)
    float m_c = 0.f, bct = 0.f, amt = 0.f; bf16x8 qf[4]; f32x4 nn[4][2]; f32x4 avv;
    LAS float* avl = mgl + 512 + cw * 128;
#define ML_LOADS(un_) do { int l_ = lane_; asm volatile("" : "+v"(l_)); const int i_ = l_ & 31, h_ = l_ >> 5; \
        const int task_ = 2 * (un_) + cw, bh_ = task_ >> 4, hd_ = bh_ & 3, tg_ = (bh_ >> 2) * SEQ + (task_ & 15) * 128 + 32 * tq + i_; \
        m_c = MSTATE[task_]; bct = BC[(size_t)hd_ * T + tg_]; amt = AM[(size_t)hd_ * T + tg_]; avv = *(const f32x4*)(AV + (size_t)hd_ * T + (bh_ >> 2) * SEQ + (task_ & 15) * 128 + 4 * i_); \
        _Pragma("unroll") for (int ds = 0; ds < 4; ++ds) qf[ds] = *(const bf16x8*)(QM + (size_t)tg_ * 256 + hd_ * 64 + 16 * ds + 8 * h_); \
        _Pragma("unroll") for (int ds = 0; ds < 4; ++ds) { nn[ds][0] = *(const f32x4*)(NST + (size_t)task_ * 64 + 16 * ds + 8 * h_); nn[ds][1] = *(const f32x4*)(NST + (size_t)task_ * 64 + 16 * ds + 8 * h_ + 4); } } while (0)
    if (vx < BATCH * 4 * 8) { ML_DMA(vx); ML_LOADS(vx); }
    for (int un = vx; un < BATCH * 4 * 8; un += G) {
        int lane = lane_; asm volatile("" : "+v"(lane));
        const int i = lane & 31, hh = lane >> 5;
        const int task = 2 * un + cw, bh = task >> 4, c = task & 15, b = bh >> 2, h = bh & 3;
        const int t0 = b * SEQ + c * 128;
        const int tg = t0 + 32 * tq + i;
        const bf16_t* mop = P2 + (size_t)tg * NP2 + 1536 + h * 128 + 4 * hh;
        u32x2 mov[4][4];
#pragma unroll
        for (int et = 0; et < 4; ++et)
#pragma unroll
            for (int g4 = 0; g4 < 4; ++g4) mov[et][g4] = *(const u32x2*)(mop + et * 32 + 8 * g4);
        asm volatile("" ::: "memory"); __builtin_amdgcn_s_waitcnt((16 & 15) | (7 << 4) | (15 << 8) | ((16 >> 4) << 14)); asm volatile("" ::: "memory");
        asm volatile("" : "+v"(avv));
        if (tq == 0 && lane < 32) *(LAS f32x4*)(avl + 4 * lane) = avv;
        asm volatile("s_waitcnt lgkmcnt(0)" ::: "memory");
        __builtin_amdgcn_s_barrier(); asm volatile("" ::: "memory");
#pragma unroll
        for (int ds = 0; ds < 4; ++ds) { u32x4 t_ = __builtin_bit_cast(u32x4, qf[ds]); asm volatile("" : "+v"(t_), "+v"(nn[ds][0]), "+v"(nn[ds][1])); qf[ds] = __builtin_bit_cast(bf16x8, t_); }
        asm volatile("" : "+v"(m_c), "+v"(bct), "+v"(amt));
        float qn = 0.f;
#pragma unroll
        for (int ds = 0; ds < 4; ++ds) { const f32x4 n0 = nn[ds][0], n1 = nn[ds][1];
            const u32x4 w = __builtin_bit_cast(u32x4, qf[ds]);
            qn += lo_bf(w.x) * n0[0] + hi_bf(w.x) * n0[1] + lo_bf(w.y) * n0[2] + hi_bf(w.y) * n0[3] + lo_bf(w.z) * n1[0] + hi_bf(w.z) * n1[1] + lo_bf(w.w) * n1[2] + hi_bf(w.w) * n1[3]; }
        qn = x32_sum(qn);
        const float M = fmaxf(m_c, amt), g = __expf(m_c - M), emt = __expf(-(bct + M));
        const LAS unsigned char* rl = reg + lane * 16;
        f32x16 acc[4];
#pragma unroll
        for (int et = 0; et < 4; ++et) { acc[et] = zero16();
#pragma unroll
            for (int ds = 0; ds < 4; ++ds) acc[et] = __builtin_amdgcn_mfma_f32_32x32x16_bf16(*(const LAS bf16x8*)(rl + 16384 + (et * 4 + ds) * 1024), qf[ds], acc[et], 0, 0, 0);
#pragma unroll
            for (int r = 0; r < 16; ++r) acc[et][r] *= g; }
        float wsum = 0.f;
        for (int kt = 0; kt <= tq; ++kt) {
            f32x16 sc = zero16();
#pragma unroll
            for (int ds = 0; ds < 4; ++ds) sc = __builtin_amdgcn_mfma_f32_32x32x16_bf16(*(const LAS bf16x8*)(rl + (kt * 4 + ds) * 1024), qf[ds], sc, 0, 0, 0);
            const LAS float* ap = avl + 32 * kt + 8 * hh;
            const f32x4 a00 = *(const LAS f32x4*)(ap), a01 = *(const LAS f32x4*)(ap + 4), a10 = *(const LAS f32x4*)(ap + 16), a11 = *(const LAS f32x4*)(ap + 20);
#pragma unroll
            for (int r = 0; r < 16; ++r) { const float av = (r < 4) ? a00[r & 3] : (r < 8) ? a01[r & 3] : (r < 12) ? a10[r & 3] : a11[r & 3];
                const int ko = 16 * (r >> 3) + 8 * hh + (r & 7);
                float w = sc[r] * __expf(av - M);
                w = (kt == tq && ko > i) ? 0.f : w;
                sc[r] = w; wsum += w; }
            u32x4 wf[2];
#pragma unroll
            for (int sb = 0; sb < 2; ++sb) { wf[sb].x = cvt_pk_bf16(sc[8 * sb + 0], sc[8 * sb + 1]); wf[sb].y = cvt_pk_bf16(sc[8 * sb + 2], sc[8 * sb + 3]); wf[sb].z = cvt_pk_bf16(sc[8 * sb + 4], sc[8 * sb + 5]); wf[sb].w = cvt_pk_bf16(sc[8 * sb + 6], sc[8 * sb + 7]); }
#pragma unroll
            for (int et = 0; et < 4; ++et)
#pragma unroll
                for (int sb = 0; sb < 2; ++sb) acc[et] = __builtin_amdgcn_mfma_f32_32x32x16_bf16(*(const LAS bf16x8*)(rl + 32768 + (et * 8 + 2 * kt + sb) * 1024), __builtin_bit_cast(bf16x8, wf[sb]), acc[et], 0, 0, 0);
        }
        asm volatile("s_waitcnt lgkmcnt(0)" ::: "memory"); __builtin_amdgcn_s_barrier(); asm volatile("" ::: "memory");
        if (un + G < BATCH * 4 * 8) { ML_DMA(un + G); ML_LOADS(un + G); }
        wsum = x32_sum(wsum);
        const float den = g * qn + wsum, idd = 1.0f / fmaxf(fabsf(den), emt);
        float ss = 0.f;
#pragma unroll
        for (int et = 0; et < 4; ++et)
#pragma unroll
            for (int r = 0; r < 16; ++r) { const float hv = acc[et][r] * idd; acc[et][r] = hv; ss += hv * hv; }
        ss = x32_sum(ss);
        const float rn = rsqrtf(ss * (1.0f / 128.0f) + EPS);
        bf16_t* op = cat + (size_t)tg * DM + 512 + h * 128 + 8 * hh;
        const LAS float* gp = mgl + h * 128 + 4 * hh;
#pragma unroll
        for (int et = 0; et < 4; ++et)
#pragma unroll
            for (int gq = 0; gq < 2; ++gq) { u32x2 w[2];
#pragma unroll
                for (int q = 0; q < 2; ++q) { const int g4 = 2 * gq + q; const f32x4 gv = *(const LAS f32x4*)(gp + et * 32 + 8 * g4); const u32x2 mo = mov[et][g4];
                    const float o0 = lo_bf(mo.x), o1 = hi_bf(mo.x), o2 = lo_bf(mo.y), o3 = hi_bf(mo.y);
                    const float y0 = acc[et][4 * g4] * rn * gv[0] * __builtin_amdgcn_rcpf(1.0f + __expf(-o0)), y1 = acc[et][4 * g4 + 1] * rn * gv[1] * __builtin_amdgcn_rcpf(1.0f + __expf(-o1));
                    const float y2 = acc[et][4 * g4 + 2] * rn * gv[2] * __builtin_amdgcn_rcpf(1.0f + __expf(-o2)), y3 = acc[et][4 * g4 + 3] * rn * gv[3] * __builtin_amdgcn_rcpf(1.0f + __expf(-o3));
                    w[q].x = cvt_pk_bf16(y0, y1); w[q].y = cvt_pk_bf16(y2, y3); }
                const auto sa = __builtin_amdgcn_permlane32_swap(w[0].x, w[1].x, false, false), sb = __builtin_amdgcn_permlane32_swap(w[0].y, w[1].y, false, false);
                *(u32x4*)(op + et * 32 + 16 * gq) = (u32x4){sa[0], sb[0], sa[1], sb[1]}; }
    }
#undef ML_DMA
#undef ML_LOADS
}

constexpr int NWAVES = 8;
constexpr int RING_BYTES = 131072;
constexpr int LDSCTL_OFF = RING_BYTES;
constexpr int LDS_BYTES = RING_BYTES + 5120 + 3072;

enum Phase { PH_PREP = 0, PH_INPROJ = 1, PH_MIX0 = 2, PH_MIX1 = 3, PH_MIX2 = 4, PH_OUTPROJ = 5, PH_QKV = 6, PH_XATTN = 7, PH_COPROJ = 8, PH_ROUTER = 9, PH_G1 = 10, PH_G2 = 11, PH_COMBINE = 12, PH_END = 13 };

struct Args { const float* in[28]; float* out; unsigned char* ws; int ph_lo, ph_hi, pass_lo, pass_hi; };

struct CJob { const float* src; const float* g; unsigned char* dst; int Nsrc, k0, n0, mode, f8; float scale; };
__device__ __forceinline__ void conv_load(const CJob& j, f32x4 (&v)[2], int tid) {
    const int kk = tid >> 4, c4 = (tid & 15) * 4;
#pragma unroll
    for (int rep = 0; rep < 2; ++rep) v[rep] = *(const f32x4*)(j.src + (size_t)(j.k0 + kk + 32 * rep) * j.Nsrc + j.n0 + c4);
}
__device__ __forceinline__ void conv_put(LAS float* tile, const f32x4 (&v)[2], int tid) {
    const int kk = tid >> 4, c4 = (tid & 15) * 4;
#pragma unroll
    for (int rep = 0; rep < 2; ++rep)
#pragma unroll
        for (int q = 0; q < 4; ++q) tile[(kk + 32 * rep) * 65 + c4 + q] = v[rep][q];
}
__device__ __forceinline__ void conv_store(const LAS float* tile, const CJob& j, int tid) {
    const int n = tid >> 3, kc = tid & 7; float vals[8];
    f32x4 g0 = (f32x4){1.f, 1.f, 1.f, 1.f}, g1 = g0;
    if (j.g) { g0 = *(const f32x4*)(j.g + j.k0 + 8 * kc); g1 = *(const f32x4*)(j.g + j.k0 + 8 * kc + 4); }
#pragma unroll
    for (int q = 0; q < 8; ++q) vals[q] = tile[(8 * kc + q) * 65 + n] * (q < 4 ? g0[q & 3] : g1[q & 3]) * j.scale;
    const int sc = j.n0 + n; int drow = sc;
    if (j.mode == 1) { const int jj = sc >> 1, s = sc & 1; drow = 256 * (jj >> 7) + 128 * s + (jj & 127); }
    if (j.mode == 2) { drow = sc < 1024 ? sc : sc < 1536 ? sc + 1024 : sc < 2048 ? sc - 512 : sc < 2560 ? sc + 512 : sc - 1024; }
    if (j.f8) { unsigned w0 = 0u, w1 = 0u;
        w0 = __builtin_amdgcn_cvt_pk_fp8_f32(c8(vals[0]), c8(vals[1]), w0, false); w0 = __builtin_amdgcn_cvt_pk_fp8_f32(c8(vals[2]), c8(vals[3]), w0, true);
        w1 = __builtin_amdgcn_cvt_pk_fp8_f32(c8(vals[4]), c8(vals[5]), w1, false); w1 = __builtin_amdgcn_cvt_pk_fp8_f32(c8(vals[6]), c8(vals[7]), w1, true);
        *(u32x2*)(j.dst + (size_t)drow * 1024 + j.k0 + 8 * kc) = (u32x2){w0, w1}; }
    else { u32x4 w; w.x = cvt_pk_bf16(vals[0], vals[1]); w.y = cvt_pk_bf16(vals[2], vals[3]); w.z = cvt_pk_bf16(vals[4], vals[5]); w.w = cvt_pk_bf16(vals[6], vals[7]);
        *(u32x4*)(j.dst + ((size_t)drow * 1024 + j.k0 + 8 * kc) * 2) = w; }
}

__global__ void __launch_bounds__(NWAVES * 64, 2) fwd(Args args) {
    extern __shared__ __attribute__((aligned(16))) unsigned char lds_raw[];
    LAS unsigned char* lds = (LAS unsigned char*)lds_raw;
    volatile LAS unsigned* LCTL = (volatile LAS unsigned*)(lds + LDSCTL_OFF);
    const int wave = __builtin_amdgcn_readfirstlane(threadIdx.x >> 6);
#define lane lane_id()
#define tid (wave * 64 + lane_id())
    const int G = gridDim.x, bx = blockIdx.x;
    unsigned char* ws = args.ws;
    unsigned* ctl = (unsigned*)(ws + WS_CTL);
    const int lo = args.ph_lo, hi = args.ph_hi;
#ifndef PHMASK
#define PHMASK 0xffffff
#endif
#ifndef DUPMASK
#define DUPMASK 0x0
#endif
#define IN(k) (((PHMASK >> (k)) & 1) && lo <= (k) && (k) < hi)
#define NREP(k) ((((DUPMASK) >> (k)) & 1) ? 2 : 1)
#define ENDBAR(k) (BOTH(k) || (((DUPMASK) >> (k)) & 1))
#define BOTH(k) (IN(k) && IN((k) + 1))
    for (int u = tid; u < (LDS_BYTES - LDSCTL_OFF) / 4; u += NWAVES * 64) LCTL[u] = 0u;
    __syncthreads();
    XcdBarrier bar; bar.bar = ctl + CW_BAR; bar.x = 0; bar.st = LCTL; bar.wave = wave;
    const bool multi = (hi - lo) > 1 || (args.pass_hi - args.pass_lo) > 1 || (IN(PH_G1) && IN(PH_G2));
    if (multi) bar = xcd_barrier_post(ctl + CW_BAR, LCTL, wave);
#define GRID_BAR() xcd_barrier(bar)

    const float* x = args.in[0]; const float* mem = args.in[1];
    bf16_t* XB = (bf16_t*)(ws + WS_XB); bf16_t* PROJ = (bf16_t*)(ws + WS_PROJ); bf16_t* CAT = (bf16_t*)(ws + WS_CAT);
    bf16_t* MEMB = (bf16_t*)(ws + WS_MEMB); bf16_t* KV = (bf16_t*)(ws + WS_KV); bf16_t* VT2 = (bf16_t*)(ws + WS_VT2); bf16_t* VT1 = (bf16_t*)(ws + WS_VT1); unsigned char* H1F = ws + WS_H1F;
    bf16_t* WIN = (bf16_t*)(ws + WS_WIN); bf16_t* WOUT = (bf16_t*)(ws + WS_WOUT); bf16_t* WCQ = (bf16_t*)(ws + WS_WCQ); bf16_t* WCKV = (bf16_t*)(ws + WS_WCKV);
    bf16_t* WCO = (bf16_t*)(ws + WS_WCO); bf16_t* WR = (bf16_t*)(ws + WS_WR); unsigned char* W1F = ws + WS_W1; unsigned char* W2F = ws + WS_W2; unsigned char* H2F = ws + WS_H2F;
    float* RSTDX = (float*)(ws + WS_RSTDX); float* RSTDM = (float*)(ws + WS_RSTDM); float* B1P = (float*)(ws + WS_B1P); float* MISC = (float*)(ws + WS_MISC); float* RSTD2 = (float*)(ws + WS_RSTD2);
    float* SSP1 = (float*)(ws + WS_SSP1); float* SSP2 = (float*)(ws + WS_SSP2); float* GATES = (float*)(ws + WS_GATES);
    unsigned* TOKMAP = (unsigned*)(ws + WS_TOKMAP); float* GATEV = (float*)(ws + WS_GATEV); unsigned* LIST = (unsigned*)(ws + WS_LIST);
    unsigned char* YB = ws + WS_Y; unsigned char* HID = ws + WS_HID;

    if (IN(PH_PREP)) for (int rep_ = 0; rep_ < NREP(PH_PREP); ++rep_) {
        constexpr int J0 = 768, J1 = J0 + 256, J2 = J1 + 256, J3 = J2 + 512, J4 = J3 + 256, J5 = J4 + 16384, J6 = J5 + 8192;
        auto decode = [&](int it, CJob& j) {
            if (it < J0) { j = CJob{args.in[3], args.in[2], (unsigned char*)WIN, DIN, (it / 48) * 64, (it % 48) * 64, 2, 0, 1.0f}; }
            else if (it < J1) { const int r = it - J0; j = CJob{args.in[14], nullptr, (unsigned char*)WOUT, 1024, (r / 16) * 64, (r % 16) * 64, 0, 0, 1.0f}; }
            else if (it < J2) { const int r = it - J1; j = CJob{args.in[17], args.in[15], (unsigned char*)WCQ, 1024, (r / 16) * 64, (r % 16) * 64, 0, 1, 64.0f}; }
            else if (it < J3) { const int r = it - J2; j = CJob{args.in[18], args.in[16], (unsigned char*)WCKV, 2048, (r / 32) * 64, (r % 32) * 64, 0, 1, 64.0f}; }
            else if (it < J4) { const int r = it - J3; j = CJob{args.in[19], nullptr, (unsigned char*)WCO, 1024, (r / 16) * 64, (r % 16) * 64, 0, 1, 64.0f}; }
            else if (it < J5) { const int r = it - J4; const int e = r >> 9, q = r & 511; j = CJob{args.in[23] + (size_t)e * 1024 * 2048, args.in[20], W1F + (size_t)e * 2048 * 1024, 2048, (q / 32) * 64, (q % 32) * 64, 1, 1, 64.0f}; }
            else { const int r = it - J5; const int e = r >> 8, q = r & 255; j = CJob{args.in[25] + (size_t)e * 1024 * 1024, nullptr, W2F + (size_t)e * 1024 * 1024, 1024, (q / 16) * 64, (q % 16) * 64, 0, 1, 64.0f}; } };
        static_assert(J0 % 4 == 0 && J1 % 4 == 0 && J2 % 4 == 0 && J3 % 4 == 0 && J4 % 4 == 0 && J5 % 4 == 0 && J6 % 4 == 0, "rounds of four jobs");
#define LDS_BAR() do { asm volatile("s_waitcnt lgkmcnt(0)" ::: "memory"); __builtin_amdgcn_s_barrier(); asm volatile("" ::: "memory"); } while (0)
        { f32x4 v[8]; int it0 = bx * 4; CJob jc;
          if (it0 < J6) { decode(it0, jc);
#pragma unroll
              for (int r = 0; r < 8; ++r) v[r] = *(const f32x4*)(jc.src + (size_t)(jc.k0 + wave * 8 + r) * jc.Nsrc + jc.n0 + 4 * lane); }
          for (; it0 < J6; it0 += G * 4) {
            { LAS float* tq = (LAS float*)lds + (lane >> 4) * (64 * 65) + ((4 * lane) & 63) + (wave * 8) * 65;
#pragma unroll
              for (int r = 0; r < 8; ++r)
#pragma unroll
                  for (int q = 0; q < 4; ++q) tq[r * 65 + q] = v[r][q]; }
            LDS_BAR();
            CJob js = jc; const int nx = it0 + G * 4;
            if (nx < J6) { decode(nx, jc);
#pragma unroll
                for (int r = 0; r < 8; ++r) v[r] = *(const f32x4*)(jc.src + (size_t)(jc.k0 + wave * 8 + r) * jc.Nsrc + jc.n0 + 4 * lane); }
#pragma unroll
            for (int q = 0; q < 4; ++q) { conv_store((const LAS float*)lds + q * (64 * 65), js, tid); js.n0 += 64; }
            LDS_BAR();
          } }
        __syncthreads();
        for (int i = bx * 512 + tid; i < NEXP * 1024; i += G * 512) { const int e = i >> 10, k = i & 1023; WR[i] = (bf16_t)f2bf(args.in[21][k * NEXP + e] * args.in[20][k]); }
        for (int i = bx * 512 + tid; i < NEXP * 2048; i += G * 512) { const int e = i >> 11, rho = i & 2047; const int pn = rho >> 8, s = (rho >> 7) & 1, ii = rho & 127; B1P[i] = args.in[24][e * 2048 + 2 * (128 * pn + ii) + s]; }
        if (bx == 0 && wave == 0) { const float a = wave_sum(args.in[9][lane] * args.in[10][lane]), b = wave_sum(args.in[11][lane] * args.in[12][lane]);
            if (lane == 0) MISC[0] = expf(a) - expf(b) + LAMBDA_INIT; }
        {
            const float* win = args.in[3]; const float* g = args.in[2];
            const int ln = lane_id();
            float wg[4][4][8];
#pragma unroll
            for (int jj = 0; jj < 4; ++jj)
#pragma unroll
                for (int q = 0; q < 4; ++q) { const int k = 4 * ln + 256 * jj + q; const float gk = g[k];
                    const f32x4 a = *(const f32x4*)(win + (size_t)k * DIN + 3072), b = *(const f32x4*)(win + (size_t)k * DIN + 3076);
#pragma unroll
                    for (int j = 0; j < 4; ++j) { wg[jj][q][j] = a[j] * gk; wg[jj][q][4 + j] = b[j] * gk; } }
            const int gw = bx * NWAVES + wave, NGW = G * NWAVES;
            f32x4 vn[4];
            if (gw < T) { const f32x4* xr = (const f32x4*)(x + (size_t)gw * DM) + ln;
#pragma unroll
                for (int jj = 0; jj < 4; ++jj) vn[jj] = xr[64 * jj]; }
            for (int row = gw; row < T; row += NGW) {
                f32x4 v[4]; float ss = 0.f; float d[8];
#pragma unroll
                for (int jj = 0; jj < 4; ++jj) v[jj] = vn[jj];
                if (row + NGW < T) { const f32x4* xr = (const f32x4*)(x + (size_t)(row + NGW) * DM) + ln;
#pragma unroll
                    for (int jj = 0; jj < 4; ++jj) vn[jj] = xr[64 * jj]; }
#pragma unroll
                for (int j = 0; j < 8; ++j) d[j] = 0.f;
#pragma unroll
                for (int jj = 0; jj < 4; ++jj) {
#pragma unroll
                    for (int q = 0; q < 4; ++q) { ss += v[jj][q] * v[jj][q];
#pragma unroll
                        for (int j = 0; j < 8; ++j) d[j] += v[jj][q] * wg[jj][q][j]; } }
                ss = wave_sum(ss);
#pragma unroll
                for (int j = 0; j < 8; ++j) d[j] = wave_sum(d[j]);
                const float rs = rsqrtf(ss * (1.0f / DM) + EPS);
                u32x2* o8 = (u32x2*)(XB + (size_t)row * DM) + ln;
#pragma unroll
                for (int jj = 0; jj < 4; ++jj) { u32x2 w; w.x = cvt_pk_bf16(v[jj][0], v[jj][1]); w.y = cvt_pk_bf16(v[jj][2], v[jj][3]); o8[64 * jj] = w; }
                if (ln == 0) RSTDX[row] = rs;
                if (ln < 8) { float dv = d[0];
#pragma unroll
                    for (int j = 1; j < 8; ++j) dv = (ln == j) ? d[j] : dv;
                    dv *= rs; float r;
                    if (ln < 4) r = dv + args.in[6][ln];
                    else { const float z = dv + args.in[7][ln - 4]; r = (z >= 0.f) ? -log1pf(expf(-z)) : (z - log1pf(expf(z))); }
                    GATES[(size_t)row * 8 + ln] = r; }
            }
            for (int row = gw; row < MROWS; row += NGW) {
                const f32x4* xr = (const f32x4*)(mem + (size_t)row * DM) + ln;
                f32x4 v[4]; float ss = 0.f;
#pragma unroll
                for (int jj = 0; jj < 4; ++jj) { v[jj] = xr[64 * jj]; ss += (v[jj][0] * v[jj][0] + v[jj][1] * v[jj][1]) + (v[jj][2] * v[jj][2] + v[jj][3] * v[jj][3]); }
                ss = wave_sum(ss);
                unsigned* o4 = (unsigned*)((unsigned char*)MEMB + (size_t)row * DM) + ln;
#pragma unroll
                for (int jj = 0; jj < 4; ++jj) { unsigned w = 0u; w = __builtin_amdgcn_cvt_pk_fp8_f32(c8(v[jj][0]), c8(v[jj][1]), w, false); w = __builtin_amdgcn_cvt_pk_fp8_f32(c8(v[jj][2]), c8(v[jj][3]), w, true); o4[64 * jj] = w; }
                if (ln == 0) RSTDM[row] = rsqrtf(ss * (1.0f / DM) + EPS);
            }
        }
        if (ENDBAR(PH_PREP)) GRID_BAR();
    }

    if (IN(PH_INPROJ)) for (int rep_ = 0; rep_ < NREP(PH_INPROJ); ++rep_) {
        { ProbScaleBf16 P{(LAS unsigned*)(lds + LDSCTL_OFF + 2048), XB, WIN, T / 256, NP2 / 256, G, bx, PROJ, NP2, RSTDX, nullptr};
          pg8::gemm_phase<ProbScaleBf16, true>(lds, P, wave); }
        { ProbColScaleBf16 P{(LAS unsigned*)(lds + LDSCTL_OFF + 2048), WIN + (size_t)NP2 * 1024, XB, 4, T / 256, G, bx, VT1, T, RSTDX};
          pg8::gemm_phase<ProbColScaleBf16, true>(lds, P, wave); }
        if (ENDBAR(PH_INPROJ)) GRID_BAR();
    }

    const int vx = (G % 8 == 0) ? (bx % 8) * (G / 8) + bx / 8 : bx;
    bf16_t* QM = (bf16_t*)(ws + WS_QM); bf16_t* KM = (bf16_t*)(ws + WS_KM); bf16_t* CSTB = (bf16_t*)(ws + WS_CSTB);
    float* BC = (float*)(ws + WS_BC); float* AV = (float*)(ws + WS_AV); float* AM = (float*)(ws + WS_AM); float* NLOC = (float*)(ws + WS_NLOC); float* NST = (float*)(ws + WS_NST);
    float* CH = (float*)(ws + WS_CH); float* MSTATE = (float*)(ws + WS_MSTATE); float* CLOC = (float*)(ws + WS_MST);
    if (IN(PH_MIX0)) for (int rep_ = 0; rep_ < NREP(PH_MIX0); ++rep_) {
        mlstm_prep_phase(lds, PROJ, VT1, GATES, args.in[4], args.in[5], QM, KM, BC, AV, AM, CH, NLOC, CLOC, G, vx, wave);
        if (ENDBAR(PH_MIX0)) GRID_BAR();
    }
    if (IN(PH_MIX1)) for (int rep_ = 0; rep_ < NREP(PH_MIX1); ++rep_) {
        mlstm_scan_phase(CLOC, NLOC, CH, CSTB, NST, MSTATE, G, bx, tid);
        if (ENDBAR(PH_MIX1)) GRID_BAR();
    }
    if (IN(PH_MIX2)) for (int rep_ = 0; rep_ < NREP(PH_MIX2); ++rep_) {
        mlstm_out_phase(lds, (LAS float*)(lds + LDSCTL_OFF + 2048), PROJ, VT1, QM, KM, BC, AV, AM, CSTB, NST, MSTATE, args.in[8], CAT, G, vx, wave);
        __syncthreads();
        const float lam = __hip_atomic_load(MISC, __ATOMIC_RELAXED, __HIP_MEMORY_SCOPE_AGENT);
        diffattn_phase(lds, (LAS float*)(lds + LDSCTL_OFF + 2048), PROJ, VT1, args.in[13], lam, CAT, G, vx, wave);
        if (ENDBAR(PH_MIX2)) GRID_BAR();
    }

    if (IN(PH_OUTPROJ)) for (int rep_ = 0; rep_ < NREP(PH_OUTPROJ); ++rep_) {
        ProbResidT<false, true, false> P{(LAS unsigned*)(lds + LDSCTL_OFF + 2048), CAT, WOUT, T / 256, 4, G, bx, nullptr, XB, XB, H1F, SSP1};
        pg8::gemm_phase<ProbResidT<false, true, false>, true>(lds, P, wave);
        if (ENDBAR(PH_OUTPROJ)) GRID_BAR();
    }

    if (IN(PH_QKV)) for (int rep_ = 0; rep_ < NREP(PH_QKV); ++rep_) {
        { ProbScaleT<true> P{(LAS unsigned*)(lds + LDSCTL_OFF + 2048), H1F, WCQ, T / 256, 4, G, bx, PROJ, 1024, nullptr, SSP1};
          pg8::gemm_phase<ProbScaleT<true>, true>(lds, P, wave); }
        { ProbKV P{(LAS unsigned*)(lds + LDSCTL_OFF + 2048), (const unsigned char*)MEMB, (const unsigned char*)WCKV, KV, VT2, RSTDM, G, bx};
          pg8::gemm_phase<ProbKV, true>(lds, P, wave); }
        if (ENDBAR(PH_QKV)) GRID_BAR();
    }

    if (IN(PH_XATTN)) for (int rep_ = 0; rep_ < NREP(PH_XATTN); ++rep_) {
        xattn_phase(lds, (const unsigned char*)PROJ, (const unsigned char*)KV, (const unsigned char*)VT2, (unsigned char*)(PROJ + (size_t)T * 1024), G, vx, wave);
        if (ENDBAR(PH_XATTN)) GRID_BAR();
    }

    if (IN(PH_COPROJ)) for (int rep_ = 0; rep_ < NREP(PH_COPROJ); ++rep_) {
        ProbResidT<true, false, false> P{(LAS unsigned*)(lds + LDSCTL_OFF + 2048), (unsigned char*)(PROJ + (size_t)T * 1024), WCO, T / 256, 4, G, bx, nullptr, XB, CAT, nullptr, SSP2};
        pg8::gemm_phase<ProbResidT<true, false, false>, true>(lds, P, wave);
        if (ENDBAR(PH_COPROJ)) GRID_BAR();
    }

    if (IN(PH_ROUTER)) for (int rep_ = 0; rep_ < NREP(PH_ROUTER); ++rep_) {
        { u32x4 wv[8];
#pragma unroll
          for (int q = 0; q < 8; ++q) { const int idx = q * (NWAVES * 64) + tid, ks = idx >> 6, ln = idx & 63; wv[q] = *(const u32x4*)(WR + (size_t)(ln & 31) * DM + 16 * ks + 8 * (ln >> 5)); }
#pragma unroll
          for (int q = 0; q < 8; ++q) { const int idx = q * (NWAVES * 64) + tid; *(LAS u32x4*)(lds + idx * 16) = wv[q]; } }
        __syncthreads();
        const float* brt = args.in[22];
        const int i = lane & 31, hh = lane >> 5;
        volatile LAS unsigned* lcnt = (volatile LAS unsigned*)(lds + 65536);
        const int ntrip = (T / 32 + G * NWAVES - 1) / (G * NWAVES);
        for (int trip = 0; trip < ntrip; ++trip) {
            const int tile = trip * G * NWAVES + bx * NWAVES + wave; const bool act = tile < T / 32;
            if (tid < 32) lcnt[tid] = 0u;
            __syncthreads();
            const int t = (act ? tile : 0) * 32 + i;
            const bf16_t* xp = CAT + (size_t)t * DM + 8 * hh;
            const f32x4 p0 = *(const f32x4*)(SSP2 + (size_t)t * 16 + 8 * hh), p1 = *(const f32x4*)(SSP2 + (size_t)t * 16 + 8 * hh + 4);
            float sp = (p0[0] + p0[1]) + (p0[2] + p0[3]) + (p1[0] + p1[1]) + (p1[2] + p1[3]); sp = x32_sum(sp);
            const float rs = rsqrtf(sp * (1.0f / DM) + EPS);
            f32x16 acc = zero16();
#pragma unroll 1
            for (int kb = 0; kb < 64; kb += 16) { bf16x8 xf[16];
#pragma unroll
                for (int q = 0; q < 16; ++q) xf[q] = *(const bf16x8*)(xp + 16 * (kb + q));
#pragma unroll
                for (int q = 0; q < 16; ++q) { const bf16x8 wf = *(const LAS bf16x8*)(lds + ((kb + q) * 64 + lane) * 16); acc = __builtin_amdgcn_mfma_f32_32x32x16_bf16(wf, xf[q], acc, 0, 0, 0); }
#pragma unroll
                for (int q2 = 0; q2 < 8; ++q2) { unsigned pw[2][2];
#pragma unroll
                    for (int q = 0; q < 2; ++q) { const u32x4 xw = __builtin_bit_cast(u32x4, xf[2 * q2 + q]); unsigned w0 = 0u, w1 = 0u;
                        w0 = __builtin_amdgcn_cvt_pk_fp8_f32(lo_bf(xw.x) * rs, hi_bf(xw.x) * rs, w0, false); w0 = __builtin_amdgcn_cvt_pk_fp8_f32(lo_bf(xw.y) * rs, hi_bf(xw.y) * rs, w0, true);
                        w1 = __builtin_amdgcn_cvt_pk_fp8_f32(lo_bf(xw.z) * rs, hi_bf(xw.z) * rs, w1, false); w1 = __builtin_amdgcn_cvt_pk_fp8_f32(lo_bf(xw.w) * rs, hi_bf(xw.w) * rs, w1, true);
                        pw[q][0] = w0; pw[q][1] = w1; }
                    const auto sa = __builtin_amdgcn_permlane32_swap(pw[0][0], pw[1][0], false, false), sb = __builtin_amdgcn_permlane32_swap(pw[0][1], pw[1][1], false, false);
                    *(u32x4*)(H2F + (size_t)t * DM + 16 * (kb + 2 * q2) + 16 * hh) = (u32x4){sa[0], sb[0], sa[1], sb[1]}; } }
            float mine[16], oth[16];
#pragma unroll
            for (int r = 0; r < 16; ++r) { const int e = (r & 3) + 8 * (r >> 2); mine[r] = acc[r] * rs + brt[e + 4 * hh]; }
#pragma unroll
            for (int r = 0; r < 16; ++r) oth[r] = x32_other(mine[r], hh);
            float lg[NEXP];
#pragma unroll
            for (int r = 0; r < 16; ++r) { const int e = (r & 3) + 8 * (r >> 2); lg[e] = hh ? oth[r] : mine[r]; lg[e + 4] = hh ? mine[r] : oth[r]; }
            unsigned taken = 0u; float tv[4]; int te[4];
#pragma unroll
            for (int k = 0; k < TOPK; ++k) { float best = -INFINITY; int bi = 0;
#pragma unroll
                for (int e = 0; e < NEXP; ++e) { const bool ok = !((taken >> e) & 1u) && (lg[e] > best); best = ok ? lg[e] : best; bi = ok ? e : bi; }
                taken |= 1u << bi; tv[k] = best; te[k] = bi; }
            const float q1 = __expf(tv[1] - tv[0]), q2 = __expf(tv[2] - tv[0]), q3 = __expf(tv[3] - tv[0]); const float inv = 1.0f / (1.0f + q1 + q2 + q3);
            const float gk[4] = {inv, q1 * inv, q2 * inv, q3 * inv};
            unsigned lp[4] = {0u, 0u, 0u, 0u};
            if (act && hh == 0) {
#pragma unroll
                for (int k = 0; k < TOPK; ++k) lp[k] = __hip_atomic_fetch_add((LAS unsigned*)(lcnt + te[k]), 1u, __ATOMIC_RELAXED, __HIP_MEMORY_SCOPE_WORKGROUP); }
            __syncthreads();
            if (tid < 32) { const unsigned n = lcnt[tid]; lcnt[32 + tid] = n ? atomicAdd(&ctl[CW_CNT + tid], n) : 0u; }
            __syncthreads();
            if (act && hh == 0) { RSTD2[t] = rs;
                unsigned tm[4];
#pragma unroll
                for (int k = 0; k < TOPK; ++k) { const unsigned pos = lcnt[32 + te[k]] + lp[k]; LIST[(size_t)te[k] * T + pos] = (unsigned)t; tm[k] = ((unsigned)te[k] << 16) | pos; }
                *(u32x4*)(TOKMAP + (size_t)t * 4) = (u32x4){tm[0], tm[1], tm[2], tm[3]};
                *(f32x4*)(GATEV + (size_t)t * 4) = (f32x4){gk[0], gk[1], gk[2], gk[3]}; }
            __syncthreads();
        }
        if (ENDBAR(PH_ROUTER)) GRID_BAR();
    }

    volatile LAS int* tab = (volatile LAS int*)(LCTL + 16);
    int Rtot = 0;
    if (IN(PH_G1) || IN(PH_G2) || IN(PH_COMBINE)) {
        if (tid < NEXP) tab[MOE_CNT + tid] = (int)__hip_atomic_load(&ctl[CW_CNT + tid], __ATOMIC_RELAXED, __HIP_MEMORY_SCOPE_AGENT);
        __syncthreads();
        if (tid == 0) { int ts = 0, st = 0;
            for (int e = 0; e < NEXP; ++e) { const int c = tab[MOE_CNT + e]; tab[MOE_TS + e] = ts; tab[MOE_ST + e] = st; ts += (c + 255) >> 8; st += c; }
            tab[MOE_TS + NEXP] = ts; tab[MOE_ST + NEXP] = st; }
        __syncthreads();
        Rtot = tab[MOE_TS + NEXP];
    }
    if (IN(PH_G1) || IN(PH_G2)) {
        __syncthreads();
        for (int rt = tid; rt < Rtot; rt += NWAVES * 64) { int e = 0;
            for (int j = 1; j < NEXP; ++j) if (rt >= tab[MOE_TS + j]) e = j;
            ((volatile LAS unsigned char*)(tab + MOE_RTE))[rt] = (unsigned char)e; }
        __syncthreads();
        if (IN(PH_G1)) for (int rep_ = 0; rep_ < NREP(PH_G1); ++rep_) { ProbMoe1 P{H2F, W1F, B1P, RSTD2, LIST, HID, tab, (LAS unsigned*)(lds + LDSCTL_OFF + 2048), 0, Rtot, G, bx};
            pg8::gemm_phase<ProbMoe1, true>(lds, P, wave);
            if (IN(PH_G2) || NREP(PH_G1) > 1) GRID_BAR(); }
        if (IN(PH_G2)) for (int rep_ = 0; rep_ < NREP(PH_G2); ++rep_) { ProbMoe2 P{HID, W2F, args.in[26], YB, tab, (LAS unsigned*)(lds + LDSCTL_OFF + 2048), 0, Rtot, G, bx};
            pg8::gemm_phase<ProbMoe2, true>(lds, P, wave);
            if (IN(PH_COMBINE) || NREP(PH_G2) > 1) GRID_BAR(); }
    }
    if (IN(PH_COMBINE)) {
        const float* gf = args.in[27];
        const int ln = lane_id();
        const int gw = bx * NWAVES + wave, NGW = G * NWAVES;
        f32x4 gfv[4];
#pragma unroll
        for (int jj = 0; jj < 4; ++jj) gfv[jj] = *((const f32x4*)gf + 4 * ln + jj);
#define CB_REC(tt_, tm_, gk_) do { tm_ = *(const u32x4*)(TOKMAP + (size_t)(tt_) * 4); gk_ = *(const f32x4*)(GATEV + (size_t)(tt_) * 4); } while (0)
#define CB_DATA(tt_, tm_, h0_, h1_, y_) do { const u32x4* hb_ = (const u32x4*)(CAT + (size_t)(tt_) * DM) + ln; h0_ = hb_[0]; h1_ = hb_[64];        \
            _Pragma("unroll") for (int k = 0; k < TOPK; ++k) { const int e = (int)(tm_[k] >> 16), pos = (int)(tm_[k] & 0xffffu); const size_t yrow = (size_t)(tab[MOE_ST + e] + pos); \
                y_[k] = *((const u32x4*)(YB + yrow * DM) + ln); } } while (0)
        if (gw < T) {
        u32x4 tmn, tmq, hc0, hc1, yv[4], hn0, hn1, yn[4]; f32x4 gk, gkn, gkq;
        { u32x4 tmc; const int tn0 = gw + NGW < T ? gw + NGW : gw; CB_REC(gw, tmc, gk); CB_REC(tn0, tmn, gkn); CB_DATA(gw, tmc, hc0, hc1, yv); }
        asm volatile("" ::: "memory"); __builtin_amdgcn_s_waitcnt((0 & 15) | (7 << 4) | (15 << 8) | ((0 >> 4) << 14)); asm volatile("" ::: "memory");
        for (int t = gw; t < T; t += NGW) {
            const int tn_ = t + NGW < T ? t + NGW : t, tq_ = tn_ + NGW < T ? tn_ + NGW : tn_;
            CB_REC(tq_, tmq, gkq);
            asm volatile("" ::: "memory"); __builtin_amdgcn_s_waitcnt((6 & 15) | (7 << 4) | (15 << 8) | ((6 >> 4) << 14)); asm volatile("" ::: "memory");
            asm volatile("" : "+v"(tmn), "+v"(gk), "+v"(hc0), "+v"(hc1), "+v"(yv[0]), "+v"(yv[1]), "+v"(yv[2]), "+v"(yv[3]));
            CB_DATA(tn_, tmn, hn0, hn1, yn);
            LAS u32x4* ht = (LAS u32x4*)(lds + wave * 4096);
            ht[ln] = hc0; ht[64 + ln] = hc1;
            const u32x4 h0 = ht[2 * ln], h1 = ht[2 * ln + 1];
            float v[16];
            v[0] = lo_bf(h0.x); v[1] = hi_bf(h0.x); v[2] = lo_bf(h0.y); v[3] = hi_bf(h0.y); v[4] = lo_bf(h0.z); v[5] = hi_bf(h0.z); v[6] = lo_bf(h0.w); v[7] = hi_bf(h0.w);
            v[8] = lo_bf(h1.x); v[9] = hi_bf(h1.x); v[10] = lo_bf(h1.y); v[11] = hi_bf(h1.y); v[12] = lo_bf(h1.z); v[13] = hi_bf(h1.z); v[14] = lo_bf(h1.w); v[15] = hi_bf(h1.w);
#pragma unroll
            for (int k = 0; k < TOPK; ++k) { const float g16 = gk[k] * (1.0f / 16.0f);
#pragma unroll
                for (int q = 0; q < 4; ++q) { const f32x2 a = __builtin_amdgcn_cvt_pk_f32_fp8((int)yv[k][q], false), b2_ = __builtin_amdgcn_cvt_pk_f32_fp8((int)yv[k][q], true);
                    v[4 * q] += g16 * a[0]; v[4 * q + 1] += g16 * a[1]; v[4 * q + 2] += g16 * b2_[0]; v[4 * q + 3] += g16 * b2_[1]; } }
            float ss = 0.f;
#pragma unroll
            for (int q = 0; q < 16; ++q) ss += v[q] * v[q];
            ss = wave_sum(ss); const float rs = rsqrtf(ss * (1.0f / DM) + EPS);
            LAS f32x4* ot = (LAS f32x4*)(lds + wave * 4096);
#pragma unroll
            for (int jj = 0; jj < 4; ++jj) ot[4 * ln + jj] = (f32x4){v[4 * jj] * rs * gfv[jj][0], v[4 * jj + 1] * rs * gfv[jj][1], v[4 * jj + 2] * rs * gfv[jj][2], v[4 * jj + 3] * rs * gfv[jj][3]};
            f32x4* orow = (f32x4*)(args.out + (size_t)t * DM) + ln;
#pragma unroll
            for (int jj = 0; jj < 4; ++jj) orow[64 * jj] = ot[64 * jj + ln];
            gk = gkn; tmn = tmq; gkn = gkq; hc0 = hn0; hc1 = hn1;
#pragma unroll
            for (int k = 0; k < TOPK; ++k) yv[k] = yn[k];
        }
        }
#undef CB_REC
#undef CB_DATA
    }
#undef IN
#undef BOTH
#undef GRID_BAR
#undef lane
#undef tid
}

extern "C" void kernel_launch(void* const* d_in, const int* in_sizes, int n_in, void* d_out, int out_size, void* d_ws, size_t ws_size, hipStream_t stream) {
    static int grid = 0;
    if (grid == 0) {
        if (n_in != 28 || out_size != T * DM || ws_size < WS_END) { fprintf(stderr, "kernel_launch: unexpected shapes: n_in %d out %d ws %zu\n", n_in, out_size, ws_size); grid = -1; return; }
        int dev = 0, cus = 0;
        if (hipGetDevice(&dev) != hipSuccess || hipDeviceGetAttribute(&cus, hipDeviceAttributeMultiprocessorCount, dev) != hipSuccess) { grid = -1; return; }
        if (hipFuncSetAttribute((const void*)fwd, hipFuncAttributeMaxDynamicSharedMemorySize, LDS_BYTES) != hipSuccess) { fprintf(stderr, "kernel_launch: hipFuncSetAttribute failed\n"); grid = -1; return; }
        int per_cu = 0;
        if (hipOccupancyMaxActiveBlocksPerMultiprocessor(&per_cu, (const void*)fwd, NWAVES * 64, LDS_BYTES) != hipSuccess || per_cu < 1) fprintf(stderr, "kernel_launch: occupancy query says %d\n", per_cu);
        (void)hipGetLastError();
        grid = cus;
    }
    if (grid < 0) return;
    (void)hipMemsetAsync((char*)d_ws + WS_CTL, 0, CTL_ZERO_BYTES, stream);
    Args a{};
    for (int i = 0; i < 28; ++i) a.in[i] = (const float*)d_in[i];
    a.out = (float*)d_out; a.ws = (unsigned char*)d_ws;
    unsigned char* ws = (unsigned char*)d_ws;
    auto run = [&](int lo, int hi, int p0, int p1) { a.ph_lo = lo; a.ph_hi = hi; a.pass_lo = p0; a.pass_hi = p1; hipLaunchKernelGGL(fwd, dim3(grid), dim3(NWAVES * 64), LDS_BYTES, stream, a); };
#ifdef MULTI_LAUNCH
    for (int ph = 0; ph < PH_G1; ++ph) run(ph, ph + 1, 0, 0);
    run(PH_G1, PH_G1 + 1, 0, 1); run(PH_G2, PH_G2 + 1, 0, 1);
    run(PH_COMBINE, PH_COMBINE + 1, 0, 0);
#else
    run(0, PH_END, 0, 5);
#endif
}
```
